# Optimizing an MI355X kernel written in HIP

```python
import jax, jax.numpy as jnp
from jax import lax
import numpy as np

D_MODEL = 1024
BATCH = 8
SEQ = 4096
DEPTH = 1

GRID_W = 64
CTX_LEN = 256
GMLP_WIDTH = 1024
GMLP_GROUPS = 8
GMLP_GROUP_CH = GMLP_WIDTH // GMLP_GROUPS
CHUNK = 128
NA_HEADS = 16
HEAD_DIM = 64
NA_WIDTH = NA_HEADS * HEAD_DIM
WIN_ROWS = 8
WIN_W = 16
ROPE_THETA = 10000.0
OFF_Q = 2 * GMLP_WIDTH
OFF_K = OFF_Q + NA_WIDTH
OFF_V = OFF_K + NA_WIDTH
OFF_GATE = OFF_V + NA_WIDTH
IN_WIDTH = OFF_GATE + 2 * D_MODEL
N_EXPERTS = 32
TOP_K = 4
EXPERT_FF = 1024
SWIGLU_LIMIT = 7.0
SWIGLU_ALPHA = 1.702
DISPATCH_BLOCK = 128
DEEPNORM_ALPHA = (2.0 * DEPTH) ** 0.25
DEEPNORM_BETA = (8.0 * DEPTH) ** -0.25
LN_EPS = 1e-5
NEG_INF = -1e30

kernel_name = "hybrid_gmlp_natten_moe_dit_block"


def layer_norm(x, g, b):
    xf = x.astype(jnp.float32)
    mu = jnp.mean(xf, axis=-1, keepdims=True)
    var = jnp.mean(jnp.square(xf - mu), axis=-1, keepdims=True)
    return ((xf - mu) * lax.rsqrt(var + LN_EPS) * g + b).astype(x.dtype)


def adaln_params(cond, w_ada, b_ada):
    m = jax.nn.silu(cond) @ w_ada + b_ada
    return jnp.split(m, 6, axis=-1)


def modulate(x, shift, scale):
    return x * (1.0 + scale) + shift


def split_heads(t):
    return t.reshape(t.shape[0], t.shape[1], NA_HEADS, HEAD_DIM)


def rope_axis(x, pos):
    n = x.shape[-1]
    half = n // 2
    inv = 1.0 / (ROPE_THETA ** (np.arange(half, dtype=np.float32) * 2.0 / n))
    ang = pos.astype(jnp.float32)[:, None] * inv[None, :]
    cos = jnp.cos(ang)[:, None, :].astype(x.dtype)
    sin = jnp.sin(ang)[:, None, :].astype(x.dtype)
    x1, x2 = x[..., :half], x[..., half:]
    return jnp.concatenate([x1 * cos - x2 * sin, x2 * cos + x1 * sin], axis=-1)


def rope_2d(x):
    t = jnp.arange(x.shape[1])
    xr = rope_axis(x[..., :HEAD_DIM // 2], t // GRID_W)
    xc = rope_axis(x[..., HEAD_DIM // 2:], t % GRID_W)
    return jnp.concatenate([xr, xc], axis=-1)


def spatial_gating(z_pre, ln_g, ln_b, ws, bs):
    b, length, _ = z_pre.shape
    z = jax.nn.gelu(z_pre, approximate=False)
    zu, zv = z[..., :GMLP_WIDTH], z[..., GMLP_WIDTH:]
    zv = layer_norm(zv, ln_g, ln_b)
    zv = zv.reshape(b, length // CHUNK, CHUNK, GMLP_GROUPS, GMLP_GROUP_CH)
    s = jnp.einsum('gpq,bnqgc->bnpgc', ws, zv) + bs.T[None, None, :, :, None]
    return zu * s.reshape(b, length, GMLP_WIDTH)


def na_column_tables():
    n_cb = GRID_W // WIN_W
    span = 2 * WIN_W
    cb = np.arange(n_cb)
    cs = np.clip(cb * WIN_W - WIN_W // 2, 0, GRID_W - span)
    col_idx = cs[:, None] + np.arange(span)[None, :]
    qc = cb[:, None] * WIN_W + np.arange(WIN_W)[None, :]
    c0 = np.clip(qc - WIN_W // 2, 0, GRID_W - WIN_W)
    kc = col_idx[:, None, :]
    mask = (kc >= c0[..., None]) & (kc < c0[..., None] + WIN_W)
    dc_idx = np.clip(kc - qc[..., None] + WIN_W - 1, 0, 2 * WIN_W - 2)
    return col_idx, mask, dc_idx


def neighbourhood_attention(q, k, v, k_ctx, v_ctx, rpb, rows):
    b, length, h, dh = q.shape
    kr = min(WIN_ROWS, rows)
    scale = HEAD_DIM ** -0.5
    col_idx, col_mask, dc_idx = na_column_tables()
    n_cb, span = col_idx.shape
    q_rot = rope_2d(q).reshape(b, rows, GRID_W, h, dh)
    k_grid = rope_2d(k).reshape(b, rows, GRID_W, h, dh)
    v_grid = v.reshape(b, rows, GRID_W, h, dh)
    q_rows = jnp.moveaxis(q_rot, 1, 0)
    qp_rows = jnp.moveaxis(q.reshape(b, rows, GRID_W, h, dh), 1, 0)
    mask_b = jnp.asarray(col_mask)[None, None, :, :, None, :]

    def row_block(args):
        q_r, qp_r, r = args
        r0 = jnp.clip(r - kr // 2, 0, rows - kr)
        kb = lax.dynamic_slice_in_dim(k_grid, r0, kr, axis=1)
        vb = lax.dynamic_slice_in_dim(v_grid, r0, kr, axis=1)
        kg = kb[:, :, col_idx]
        vg = vb[:, :, col_idx]
        qb = q_r.reshape(b, n_cb, WIN_W, h, dh)
        qpb = qp_r.reshape(b, n_cb, WIN_W, h, dh)
        s_lat = jnp.einsum('bjihd,brjthd->bhjirt', qb, kg).astype(jnp.float32) * scale
        dr_idx = r0 + jnp.arange(kr) - r + (WIN_ROWS - 1)
        bias = rpb[:, dr_idx][:, :, dc_idx]
        bias = jnp.transpose(bias, (0, 2, 3, 1, 4)).astype(jnp.float32)
        s_lat = jnp.where(mask_b, s_lat + bias[None], NEG_INF)
        s_ctx = jnp.einsum('bjihd,bnhd->bhjin', qpb, k_ctx).astype(jnp.float32) * scale
        s = jnp.concatenate([s_lat.reshape(b, h, n_cb, WIN_W, kr * span), s_ctx], axis=-1)
        p = jax.nn.softmax(s, axis=-1).astype(v.dtype)
        p_lat = p[..., :kr * span].reshape(b, h, n_cb, WIN_W, kr, span)
        p_ctx = p[..., kr * span:]
        o = (jnp.einsum('bhjirt,brjthd->bjihd', p_lat, vg)
             + jnp.einsum('bhjin,bnhd->bjihd', p_ctx, v_ctx))
        return o.reshape(b, GRID_W, h, dh)

    out = lax.map(row_block, (q_rows, qp_rows, jnp.arange(rows)))
    return jnp.moveaxis(out, 0, 1).reshape(b, length, h * dh)


def context_attention(q, k, v):
    s = jnp.einsum('bqhd,bkhd->bhqk', q, k).astype(jnp.float32) * (HEAD_DIM ** -0.5)
    p = jax.nn.softmax(s, axis=-1).astype(v.dtype)
    o = jnp.einsum('bhqk,bkhd->bqhd', p, v)
    return o.reshape(q.shape[0], q.shape[1], NA_WIDTH)


def merge_branches(y_a, y_b, gate_pre, w_pa, w_pb, w_out, b_out):
    g_a = jax.nn.sigmoid(gate_pre[..., :D_MODEL])
    g_b = jax.nn.sigmoid(gate_pre[..., D_MODEL:])
    return (g_a * (y_a @ w_pa) + g_b * (y_b @ w_pb)) @ w_out + b_out


def expert_block(xb, w1, b1, w2, b2):
    z = xb @ w1 + b1
    zg = jnp.minimum(z[..., :EXPERT_FF], SWIGLU_LIMIT)
    zl = jnp.clip(z[..., EXPERT_FF:], -SWIGLU_LIMIT, SWIGLU_LIMIT)
    act = zg * jax.nn.sigmoid(SWIGLU_ALPHA * zg) * (zl + 1.0)
    return act @ w2 + b2


def moe_ffn(h, router_w, router_b, w1, b1, w2, b2):
    n, d = h.shape
    logits = (h @ router_w + router_b).astype(jnp.float32)
    top_val, top_idx = lax.top_k(logits, TOP_K)
    gates = jax.nn.softmax(top_val, axis=-1).astype(h.dtype)
    n_assign = n * TOP_K
    flat_e = top_idx.reshape(-1)
    flat_tok = jnp.arange(n_assign) // TOP_K
    flat_g = gates.reshape(-1)
    order = jnp.argsort(flat_e)
    e_sorted = flat_e[order]
    counts = jnp.bincount(flat_e, length=N_EXPERTS)
    padded = (counts + DISPATCH_BLOCK - 1) // DISPATCH_BLOCK * DISPATCH_BLOCK
    start = jnp.cumsum(counts) - counts
    pend = jnp.cumsum(padded)
    pstart = pend - padded
    dest = pstart[e_sorted] + jnp.arange(n_assign) - start[e_sorted]
    n_blocks = (n_assign + N_EXPERTS * (DISPATCH_BLOCK - 1) + DISPATCH_BLOCK - 1) // DISPATCH_BLOCK
    n_rows = n_blocks * DISPATCH_BLOCK
    slot_tok = jnp.full((n_rows,), n, jnp.int32).at[dest].set(flat_tok[order])
    slot_gate = jnp.zeros((n_rows,), h.dtype).at[dest].set(flat_g[order])
    block_e = jnp.clip(jnp.searchsorted(pend, jnp.arange(n_blocks) * DISPATCH_BLOCK, side='right'), 0, N_EXPERTS - 1)
    h_pad = jnp.concatenate([h, jnp.zeros((1, d), h.dtype)], axis=0)
    xs = h_pad[slot_tok].reshape(n_blocks, DISPATCH_BLOCK, d)

    def run_block(args):
        xb, e = args
        return expert_block(xb, w1[e], b1[e], w2[e], b2[e])

    ys = lax.map(run_block, (xs, block_e)).reshape(n_rows, d)
    out = jnp.zeros((n + 1, d), h.dtype).at[slot_tok].add(ys * slot_gate[:, None])
    return out[:n]


def setup_inputs(seed: int = 0) -> dict:
    key = jax.random.key(seed)
    ks = jax.random.split(key, 31)

    def nrm(k, shape, s):
        return s * jax.random.normal(k, shape, jnp.float32)

    D = D_MODEL
    return {
        "x": nrm(ks[0], (BATCH, SEQ, D), 1.0),
        "c": nrm(ks[1], (BATCH, D), 1.0),
        "ctx": nrm(ks[2], (BATCH, CTX_LEN, D), 1.0),
        "c_ctx": nrm(ks[3], (D,), 1.0),
        "ln_x_g": 1.0 + nrm(ks[4], (D,), 0.01),
        "ln_x_b": nrm(ks[5], (D,), 0.01),
        "ln_ctx_g": 1.0 + nrm(ks[6], (D,), 0.01),
        "ln_ctx_b": nrm(ks[7], (D,), 0.01),
        "w_ada": nrm(ks[8], (DEPTH, D, 6 * D), 0.5 * D ** -0.5),
        "b_ada": nrm(ks[9], (DEPTH, 6 * D), 0.01),
        "w_in": nrm(ks[10], (DEPTH, D, IN_WIDTH), D ** -0.5),
        "b_in": nrm(ks[11], (DEPTH, IN_WIDTH), 0.01),
        "gmlp_ln_g": 1.0 + nrm(ks[12], (DEPTH, GMLP_WIDTH), 0.01),
        "gmlp_ln_b": nrm(ks[13], (DEPTH, GMLP_WIDTH), 0.01),
        "gmlp_ws": nrm(ks[14], (DEPTH, GMLP_GROUPS, CHUNK, CHUNK), CHUNK ** -0.5),
        "gmlp_bs": 1.0 + nrm(ks[15], (DEPTH, GMLP_GROUPS, CHUNK), 0.01),
        "na_rpb": nrm(ks[16], (DEPTH, NA_HEADS, 2 * WIN_ROWS - 1, 2 * WIN_W - 1), 0.1),
        "w_pa": nrm(ks[17], (DEPTH, GMLP_WIDTH, D), GMLP_WIDTH ** -0.5),
        "w_pb": nrm(ks[18], (DEPTH, NA_WIDTH, D), NA_WIDTH ** -0.5),
        "w_out": nrm(ks[19], (DEPTH, D, D), DEEPNORM_BETA * D ** -0.5),
        "b_out": nrm(ks[20], (DEPTH, D), 0.01),
        "ln1_g": 1.0 + nrm(ks[21], (DEPTH, D), 0.01),
        "ln1_b": nrm(ks[22], (DEPTH, D), 0.01),
        "ln2_g": 1.0 + nrm(ks[23], (DEPTH, D), 0.01),
        "ln2_b": nrm(ks[24], (DEPTH, D), 0.01),
        "router_w": nrm(ks[25], (DEPTH, D, N_EXPERTS), D ** -0.5),
        "router_b": nrm(ks[26], (DEPTH, N_EXPERTS), 0.01),
        "exp_w1": nrm(ks[27], (DEPTH, N_EXPERTS, D, 2 * EXPERT_FF), D ** -0.5),
        "exp_b1": nrm(ks[28], (DEPTH, N_EXPERTS, 2 * EXPERT_FF), 0.01),
        "exp_w2": nrm(ks[29], (DEPTH, N_EXPERTS, EXPERT_FF, D), DEEPNORM_BETA * EXPERT_FF ** -0.5),
        "exp_b2": nrm(ks[30], (DEPTH, N_EXPERTS, D), 0.01),
    }


def reference(x, c, ctx, c_ctx, ln_x_g, ln_x_b, ln_ctx_g, ln_ctx_b, w_ada, b_ada, w_in, b_in,
              gmlp_ln_g, gmlp_ln_b, gmlp_ws, gmlp_bs, na_rpb, w_pa, w_pb, w_out, b_out,
              ln1_g, ln1_b, ln2_g, ln2_b, router_w, router_b, exp_w1, exp_b1, exp_w2, exp_b2):
    batch, length, d = x.shape
    rows = length // GRID_W
    x = layer_norm(x, ln_x_g, ln_x_b)
    ctx = layer_norm(ctx, ln_ctx_g, ln_ctx_b)
    for l in range(DEPTH):
        last = l == DEPTH - 1
        sh1, sc1, g1, sh2, sc2, g2 = adaln_params(c, w_ada[l], b_ada[l])
        sh1c, sc1c, g1c, sh2c, sc2c, g2c = adaln_params(c_ctx, w_ada[l], b_ada[l])
        u = modulate(x, sh1[:, None], sc1[:, None])
        u_c = modulate(ctx, sh1c, sc1c)
        proj = u @ w_in[l] + b_in[l]
        if last:
            kv_c = u_c @ w_in[l][:, OFF_K:OFF_GATE] + b_in[l][OFF_K:OFF_GATE]
        else:
            proj_c = u_c @ w_in[l] + b_in[l]
            kv_c = proj_c[..., OFF_K:OFF_GATE]
        k_c = split_heads(kv_c[..., :NA_WIDTH])
        v_c = split_heads(kv_c[..., NA_WIDTH:])
        y_a = spatial_gating(proj[..., :OFF_Q], gmlp_ln_g[l], gmlp_ln_b[l], gmlp_ws[l], gmlp_bs[l])
        y_b = neighbourhood_attention(split_heads(proj[..., OFF_Q:OFF_K]),
                                      split_heads(proj[..., OFF_K:OFF_V]),
                                      split_heads(proj[..., OFF_V:OFF_GATE]),
                                      k_c, v_c, na_rpb[l], rows)
        mix = merge_branches(y_a, y_b, proj[..., OFF_GATE:], w_pa[l], w_pb[l], w_out[l], b_out[l])
        x_new = layer_norm(DEEPNORM_ALPHA * x + g1[:, None] * mix, ln1_g[l], ln1_b[l])
        u2 = modulate(x_new, sh2[:, None], sc2[:, None])
        ff = moe_ffn(u2.reshape(batch * length, d), router_w[l], router_b[l],
                     exp_w1[l], exp_b1[l], exp_w2[l], exp_b2[l]).reshape(batch, length, d)
        x_new = layer_norm(DEEPNORM_ALPHA * x_new + g2[:, None] * ff, ln2_g[l], ln2_b[l])
        if not last:
            y_a_c = spatial_gating(proj_c[..., :OFF_Q], gmlp_ln_g[l], gmlp_ln_b[l], gmlp_ws[l], gmlp_bs[l])
            y_b_c = context_attention(split_heads(proj_c[..., OFF_Q:OFF_K]), k_c, v_c)
            mix_c = merge_branches(y_a_c, y_b_c, proj_c[..., OFF_GATE:], w_pa[l], w_pb[l], w_out[l], b_out[l])
            ctx = layer_norm(DEEPNORM_ALPHA * ctx + g1c * mix_c, ln1_g[l], ln1_b[l])
            u2c = modulate(ctx, sh2c, sc2c)
            ff_c = moe_ffn(u2c.reshape(-1, d), router_w[l], router_b[l],
                           exp_w1[l], exp_b1[l], exp_w2[l], exp_b2[l]).reshape(ctx.shape)
            ctx = layer_norm(DEEPNORM_ALPHA * ctx + g2c * ff_c, ln2_g[l], ln2_b[l])
        x = x_new
    return x
```

```cpp
#include <hip/hip_runtime.h>
#include <cstdio>
#include <cstdint>

typedef unsigned short bf16_t;
typedef short bf16x8 __attribute__((ext_vector_type(8)));
typedef float f32x4 __attribute__((ext_vector_type(4)));
typedef unsigned u32x4 __attribute__((ext_vector_type(4)));
typedef unsigned u32x2 __attribute__((ext_vector_type(2)));

constexpr int DM = 1024, NB = 8, SEQ = 4096, NTOK = NB * SEQ, CTXL = 256, NCTX = NB * CTXL, INW = 7168;
constexpr int NE = 32, TOPK = 4, FF = 1024, NASSIGN = NTOK * TOPK;
constexpr int NHEAD = 16, HD = 64, GW = 64;
constexpr float LN_EPS = 1e-5f;
constexpr float ALPHA = 1.189207115002721f;
constexpr int MAXTILES = NASSIGN / 256 + NE;

constexpr size_t MiB = 1u << 20;
constexpr size_t WS_CTL = 0;
constexpr size_t WS_MOD = 1 * MiB;
constexpr size_t WS_ROPE = 1 * MiB + 512 * 1024;
constexpr size_t WS_ROWSTAT = 2 * MiB;
constexpr size_t WS_ZSTAT = 2 * MiB + 512 * 1024;
constexpr size_t WS_TOPE = 3 * MiB;
constexpr size_t WS_TOPG = 4 * MiB;
constexpr size_t WS_SLOT = 5 * MiB;
constexpr size_t WS_PERM = 6 * MiB;
constexpr size_t WS_TILES = 7 * MiB;
constexpr size_t WS_WIN = 8 * MiB;
constexpr size_t WS_WPA = 22 * MiB, WS_WPB = 24 * MiB, WS_WOUT = 26 * MiB, WS_WSB = 28 * MiB;
constexpr size_t WS_KC = 30 * MiB;
constexpr size_t WS_VCT = 34 * MiB;
constexpr size_t WS_UC = 38 * MiB;
constexpr size_t WS_W1 = 48 * MiB;
constexpr size_t WS_W2 = 176 * MiB;
constexpr size_t WS_U = 240 * MiB;
constexpr size_t WS_ZU = 304 * MiB;
constexpr size_t WS_ZVT = 368 * MiB;
constexpr size_t WS_Q = 432 * MiB;
constexpr size_t WS_K = 496 * MiB;
constexpr size_t WS_VT = 560 * MiB;
constexpr size_t WS_G = 624 * MiB;
constexpr size_t WS_YB = 752 * MiB;
constexpr size_t WS_INNER = 816 * MiB;
constexpr size_t WS_ACT = WS_ZU;
constexpr size_t WS_YS = WS_G;
constexpr size_t WS_END = 880 * MiB;

struct P {
    const float *x, *c, *ctx, *c_ctx, *ln_x_g, *ln_x_b, *ln_ctx_g, *ln_ctx_b, *w_ada, *b_ada, *w_in, *b_in, *gmlp_ln_g, *gmlp_ln_b, *gmlp_ws, *gmlp_bs,
        *na_rpb, *w_pa, *w_pb, *w_out, *b_out, *ln1_g, *ln1_b, *ln2_g, *ln2_b, *router_w, *router_b, *exp_w1, *exp_b1, *exp_w2, *exp_b2;
    float* out; unsigned char* ws; int ph_lo, ph_hi;
};

__device__ __forceinline__ unsigned f2bf(float f) { unsigned u = __builtin_bit_cast(unsigned, f); return (u + 0x7fffu + ((u >> 16) & 1u)) >> 16; }
__device__ __forceinline__ unsigned pk2(float lo, float hi) { return f2bf(lo) | (f2bf(hi) << 16); }
__device__ __forceinline__ float bf2f(unsigned h) { return __builtin_bit_cast(float, (h & 0xffffu) << 16); }
__device__ __forceinline__ float bflo(unsigned w) { return __builtin_bit_cast(float, w << 16); }
__device__ __forceinline__ float bfhi(unsigned w) { return __builtin_bit_cast(float, w & 0xffff0000u); }
__device__ __forceinline__ float wave_sum(float v) {
#pragma unroll
    for (int o = 1; o < 64; o <<= 1) v += __shfl_xor(v, o);
    return v;
}
__device__ __forceinline__ float wave_max(float v) {
#pragma unroll
    for (int o = 1; o < 64; o <<= 1) v = fmaxf(v, __shfl_xor(v, o));
    return v;
}
__device__ __forceinline__ float gelu_exact(float v) { return 0.5f * v * (1.0f + erff(v * 0.70710678118654752f)); }
__device__ __forceinline__ float sigmoidf_(float v) { return 1.0f / (1.0f + __expf(-v)); }

__device__ __forceinline__ void mod_item(const P& p, int item, float* red  ) {
    const int tid = threadIdx.x, wave = tid >> 6, lane = tid & 63;
    const int col = item * 32 + (lane & 31), kpar = lane >> 5;
    float acc[9];
#pragma unroll
    for (int r = 0; r < 9; ++r) acc[r] = 0.f;
    for (int kk = 0; kk < 64; ++kk) {
        const int k = wave * 128 + kk * 2 + kpar;
        const float w = p.w_ada[(size_t)k * 6144 + col];
#pragma unroll
        for (int r = 0; r < 9; ++r) { const float cv = (r < 8) ? p.c[r * 1024 + k] : p.c_ctx[k]; const float s = cv / (1.0f + __expf(-cv)); acc[r] += s * w; }
    }
#pragma unroll
    for (int r = 0; r < 9; ++r) red[((wave * 2 + kpar) * 9 + r) * 32 + (lane & 31)] = acc[r];
    __syncthreads();
    if (tid < 288) {
        const int r = tid >> 5, cc = tid & 31; float s = 0.f;
#pragma unroll
        for (int q = 0; q < 16; ++q) s += red[(q * 9 + r) * 32 + cc];
        ((float*)(p.ws + WS_MOD))[r * 6144 + item * 32 + cc] = s + p.b_ada[item * 32 + cc];
    }
    __syncthreads();
}
__device__ __forceinline__ void transpose_item(const float* W, int K, int N, bf16_t* WT, int k0, int n0, int drow0, float* scr, int lane) {
#pragma unroll 8
    for (int i = 0; i < 32; ++i) { const int kk = 2 * i + (lane >> 5); scr[kk * 33 + (lane & 31)] = W[(size_t)(k0 + kk) * N + n0 + (lane & 31)]; }
    __builtin_amdgcn_wave_barrier();
    asm volatile("s_waitcnt lgkmcnt(0)" ::: "memory");
    const int c = lane & 7;
#pragma unroll
    for (int j = 0; j < 4; ++j) { const int n = (lane >> 3) + 8 * j; const float* s = scr + (8 * c) * 33 + n;
        u32x4 o; o.x = pk2(s[0 * 33], s[1 * 33]); o.y = pk2(s[2 * 33], s[3 * 33]); o.z = pk2(s[4 * 33], s[5 * 33]); o.w = pk2(s[6 * 33], s[7 * 33]);
        *(u32x4*)(WT + (size_t)(drow0 + n) * K + k0 + 8 * c) = o; }
    asm volatile("s_waitcnt lgkmcnt(0)" ::: "memory");
    __builtin_amdgcn_wave_barrier();
}
constexpr int IT_WIN = 16 * 224, IT_SQ = 16 * 32, IT_W1 = 32 * 16 * 64, IT_W2 = 32 * 16 * 32, IT_WS = 32;
constexpr int IT_TOTAL = IT_WIN + 3 * IT_SQ + IT_W1 + IT_W2 + IT_WS;
__device__ __forceinline__ void convert_item(const P& p, int it, float* scr, int lane) {
    unsigned char* ws = p.ws;
    if (it < IT_WIN) { const int kb = it / 224, nb = it % 224; transpose_item(p.w_in, 1024, INW, (bf16_t*)(ws + WS_WIN), kb * 64, nb * 32, nb * 32, scr, lane); return; } it -= IT_WIN;
    if (it < IT_SQ) { const int kb = it / 32, nb = it % 32; transpose_item(p.w_pa, 1024, 1024, (bf16_t*)(ws + WS_WPA), kb * 64, nb * 32, nb * 32, scr, lane); return; } it -= IT_SQ;
    if (it < IT_SQ) { const int kb = it / 32, nb = it % 32; transpose_item(p.w_pb, 1024, 1024, (bf16_t*)(ws + WS_WPB), kb * 64, nb * 32, nb * 32, scr, lane); return; } it -= IT_SQ;
    if (it < IT_SQ) { const int kb = it / 32, nb = it % 32; transpose_item(p.w_out, 1024, 1024, (bf16_t*)(ws + WS_WOUT), kb * 64, nb * 32, nb * 32, scr, lane); return; } it -= IT_SQ;
    if (it < IT_W1) { const int e = it / 1024, r = it % 1024, kb = r / 64, nb = r % 64, n0 = nb * 32;
        const int half = n0 >> 10, nn = n0 & 1023, drow0 = (nn >> 7) * 256 + half * 128 + (nn & 127);
        transpose_item(p.exp_w1 + (size_t)e * 1024 * 2048, 1024, 2048, (bf16_t*)(ws + WS_W1) + (size_t)e * 2048 * 1024, kb * 64, n0, drow0, scr, lane); return; } it -= IT_W1;
    if (it < IT_W2) { const int e = it / 512, r = it % 512, kb = r / 32, nb = r % 32;
        transpose_item(p.exp_w2 + (size_t)e * 1024 * 1024, 1024, 1024, (bf16_t*)(ws + WS_W2) + (size_t)e * 1024 * 1024, kb * 64, nb * 32, nb * 32, scr, lane); return; } it -= IT_W2;
    { bf16_t* o = (bf16_t*)(ws + WS_WSB); const float* s = p.gmlp_ws + it * 4096;
      for (int i = lane; i < 4096; i += 64) o[it * 4096 + i] = (bf16_t)f2bf(s[i]); }
}
__device__ __forceinline__ void phase_prologue_a(const P& p, int bid, int nblk, unsigned char* lds) {
    const int tid = threadIdx.x, wave = tid >> 6, lane = tid & 63;
    for (int item = bid; item < 192; item += nblk) mod_item(p, item, (float*)lds);
    if (bid == nblk - 1) {
        for (int i = tid; i < 1024; i += 512) { const int pos = i >> 4, fi = i & 15;
            const float inv = __builtin_amdgcn_exp2f(-(float)fi * (13.287712379549449f / 16.0f));
            const float ang = (float)pos * inv; const float rev = ang * 0.15915494309189535f;
            float* t = (float*)(p.ws + WS_ROPE); t[2 * i] = __builtin_amdgcn_cosf(rev); t[2 * i + 1] = __builtin_amdgcn_sinf(rev); }
    }
    __syncthreads();
    float* scr = (float*)lds + wave * (64 * 33 + 32);
    const int gw = bid * 8 + wave, ngw = nblk * 8;
    for (int it = gw; it < IT_TOTAL; it += ngw) convert_item(p, it, scr, lane);
}
__device__ __forceinline__ void ln_mod_row(const float* xrow, const float* g, const float* b, const float* sh, const float* sc, bf16_t* orow, float* stat, int lane) {
    const f32x4* xr = (const f32x4*)xrow + lane;
    f32x4 v[4]; float s = 0.f;
#pragma unroll
    for (int j = 0; j < 4; ++j) { v[j] = xr[64 * j]; s += (v[j].x + v[j].y) + (v[j].z + v[j].w); }
    const float mean = wave_sum(s) * (1.f / DM); float s2 = 0.f;
#pragma unroll
    for (int j = 0; j < 4; ++j) { v[j] = v[j] - mean; s2 += (v[j].x * v[j].x + v[j].y * v[j].y) + (v[j].z * v[j].z + v[j].w * v[j].w); }
    const float rstd = 1.f / sqrtf(wave_sum(s2) * (1.f / DM) + LN_EPS);
    if (stat && lane == 0) { stat[0] = mean; stat[1] = rstd; }
    u32x2* o8 = (u32x2*)orow + lane;
#pragma unroll
    for (int j = 0; j < 4; ++j) { const int col = 4 * lane + 256 * j;
        const f32x4 gg = *(const f32x4*)(g + col), bb = *(const f32x4*)(b + col), shv = *(const f32x4*)(sh + col), scv = *(const f32x4*)(sc + col);
        f32x4 y = (v[j] * rstd) * gg + bb; y = y * (1.0f + scv) + shv;
        u32x2 w; w.x = pk2(y.x, y.y); w.y = pk2(y.z, y.w); o8[64 * j] = w; }
}
__device__ __forceinline__ void phase_prologue_b(const P& p, int bid, int nblk) {
    const int tid = threadIdx.x, wave = tid >> 6, lane = tid & 63;
    const int gw = bid * 8 + wave, ngw = nblk * 8;
    const float* mod = (const float*)(p.ws + WS_MOD);
    for (int row = gw; row < NTOK + NCTX; row += ngw) {
        if (row < NTOK) { const int b = row >> 12;
            ln_mod_row(p.x + (size_t)row * DM, p.ln_x_g, p.ln_x_b, mod + b * 6144, mod + b * 6144 + 1024, (bf16_t*)(p.ws + WS_U) + (size_t)row * DM, (float*)(p.ws + WS_ROWSTAT) + 2 * row, lane);
        } else { const int r = row - NTOK;
            ln_mod_row(p.ctx + (size_t)r * DM, p.ln_ctx_g, p.ln_ctx_b, mod + 8 * 6144, mod + 8 * 6144 + 1024, (bf16_t*)(p.ws + WS_UC) + (size_t)r * DM, nullptr, lane); }
    }
}

template <class ARow, class BRow, class Epi>
__device__ __forceinline__ void sgemm_wave_tile(int r0, int n0, int K, const ARow& arow, const BRow& brow, const Epi& epi, int lane) {
    const int fr = lane & 15, fq = lane >> 4;
    f32x4 acc[2][2];
#pragma unroll
    for (int a = 0; a < 2; ++a)
#pragma unroll
        for (int b = 0; b < 2; ++b) acc[a][b] = (f32x4){0.f, 0.f, 0.f, 0.f};
    const bf16_t* ap[2]; const bf16_t* bp[2];
#pragma unroll
    for (int a = 0; a < 2; ++a) { ap[a] = arow(r0 + 16 * a + fr) + 8 * fq; bp[a] = brow(n0 + 16 * a + fr) + 8 * fq; }
    for (int k0 = 0; k0 < K; k0 += 32) {
        bf16x8 af[2], bfr[2];
#pragma unroll
        for (int a = 0; a < 2; ++a) { af[a] = *(const bf16x8*)(ap[a] + k0); bfr[a] = *(const bf16x8*)(bp[a] + k0); }
#pragma unroll
        for (int a = 0; a < 2; ++a)
#pragma unroll
            for (int b = 0; b < 2; ++b) acc[a][b] = __builtin_amdgcn_mfma_f32_16x16x32_bf16(af[a], bfr[b], acc[a][b], 0, 0, 0);
    }
#pragma unroll
    for (int a = 0; a < 2; ++a)
#pragma unroll
        for (int b = 0; b < 2; ++b)
#pragma unroll
            for (int i = 0; i < 4; ++i) epi(r0 + 16 * a + 4 * fq + i, n0 + 16 * b + fr, acc[a][b][i]);
}

struct ARowDense { const bf16_t* A; int lda; __device__ __forceinline__ const bf16_t* operator()(int r) const { return A + (size_t)r * lda; } };
struct EpiProj {
    const float* b_in; bf16_t *ZU, *ZVT, *Q, *K, *VT, *G;
    __device__ __forceinline__ void operator()(int r, int n, float v) const {
        v += b_in[n];
        if (n < 1024) ZU[(size_t)r * 1024 + n] = (bf16_t)f2bf(gelu_exact(v));
        else if (n < 2048) ZVT[(size_t)(n - 1024) * NTOK + r] = (bf16_t)f2bf(gelu_exact(v));
        else if (n < 3072) Q[(size_t)r * 1024 + (n - 2048)] = (bf16_t)f2bf(v);
        else if (n < 4096) K[(size_t)r * 1024 + (n - 3072)] = (bf16_t)f2bf(v);
        else if (n < 5120) VT[(size_t)(n - 4096) * NTOK + r] = (bf16_t)f2bf(v);
        else G[(size_t)r * 2048 + (n - 5120)] = (bf16_t)f2bf(sigmoidf_(v));
    }
};
__global__ void __launch_bounds__(512) k_proj(P p) {
    const int wave = threadIdx.x >> 6, lane = threadIdx.x & 63; unsigned char* ws = p.ws;
    ARowDense ar{(const bf16_t*)(ws + WS_U), 1024}, br{(const bf16_t*)(ws + WS_WIN), 1024};
    EpiProj e{p.b_in, (bf16_t*)(ws + WS_ZU), (bf16_t*)(ws + WS_ZVT), (bf16_t*)(ws + WS_Q), (bf16_t*)(ws + WS_K), (bf16_t*)(ws + WS_VT), (bf16_t*)(ws + WS_G)};
    const int ntn = INW / 32, ntiles = (NTOK / 32) * ntn;
    for (int t = blockIdx.x * 8 + wave; t < ntiles; t += gridDim.x * 8) sgemm_wave_tile((t / ntn) * 32, (t % ntn) * 32, 1024, ar, br, e, lane);
}
struct EpiCtxKV {
    const float* b_in; bf16_t *KC, *VCT;
    __device__ __forceinline__ void operator()(int r, int n, float v) const {
        v += b_in[3072 + n];
        if (n < 1024) KC[(size_t)r * 1024 + n] = (bf16_t)f2bf(v); else VCT[(size_t)(n - 1024) * NCTX + r] = (bf16_t)f2bf(v);
    }
};
__global__ void __launch_bounds__(512) k_ctxkv(P p) {
    const int wave = threadIdx.x >> 6, lane = threadIdx.x & 63; unsigned char* ws = p.ws;
    ARowDense ar{(const bf16_t*)(ws + WS_UC), 1024}, br{(const bf16_t*)(ws + WS_WIN) + (size_t)3072 * 1024, 1024};
    EpiCtxKV e{p.b_in, (bf16_t*)(ws + WS_KC), (bf16_t*)(ws + WS_VCT)};
    const int ntn = 2048 / 32, ntiles = (NCTX / 32) * ntn;
    for (int t = blockIdx.x * 8 + wave; t < ntiles; t += gridDim.x * 8) sgemm_wave_tile((t / ntn) * 32, (t % ntn) * 32, 1024, ar, br, e, lane);
}
__global__ void __launch_bounds__(512) k_rope(P p) {
    bf16_t* K = (bf16_t*)(p.ws + WS_K); const float* tab = (const float*)(p.ws + WS_ROPE);
    const size_t total = (size_t)NTOK * NHEAD * 32;
    for (size_t i = (size_t)blockIdx.x * 512 + threadIdx.x; i < total; i += (size_t)gridDim.x * 512) {
        const int pi = (int)(i & 31), h = (int)((i >> 5) & 15), t = (int)(i >> 9);
        const int pos = t & 4095, axis = pi >> 4, fi = pi & 15, ps = axis ? (pos & 63) : (pos >> 6);
        const float cs = tab[2 * (ps * 16 + fi)], sn = tab[2 * (ps * 16 + fi) + 1];
        bf16_t* base = K + (size_t)t * 1024 + h * 64 + axis * 32 + fi;
        const float x1 = bf2f(base[0]), x2 = bf2f(base[16]);
        base[0] = (bf16_t)f2bf(x1 * cs - x2 * sn); base[16] = (bf16_t)f2bf(x2 * cs + x1 * sn);
    }
}
__global__ void __launch_bounds__(512) k_zstat(P p) {
    const bf16_t* ZVT = (const bf16_t*)(p.ws + WS_ZVT); float* zs = (float*)(p.ws + WS_ZSTAT);
    for (int t = blockIdx.x * 512 + threadIdx.x; t < NTOK; t += gridDim.x * 512) {
        float s = 0.f, s2 = 0.f;
        for (int c = 0; c < 1024; ++c) { const float v = bf2f(ZVT[(size_t)c * NTOK + t]); s += v; s2 += v * v; }
        const float mean = s * (1.f / 1024.f); const float var = fmaxf(s2 * (1.f / 1024.f) - mean * mean, 0.f);
        zs[2 * t] = mean; zs[2 * t + 1] = 1.f / sqrtf(var + LN_EPS);
    }
}
__global__ void __launch_bounds__(512) k_gmlp(P p) {
    extern __shared__ __attribute__((aligned(16))) unsigned char lds[];
    float* zvn = (float*)lds;
    float* wsm = zvn + 128 * 128;
    const bf16_t* ZVT = (const bf16_t*)(p.ws + WS_ZVT); const bf16_t* ZU = (const bf16_t*)(p.ws + WS_ZU); const float* zs = (const float*)(p.ws + WS_ZSTAT);
    bf16_t* YA = (bf16_t*)(p.ws + WS_U);
    const int tid = threadIdx.x;
    for (int item = blockIdx.x; item < (NTOK / 128) * 8; item += gridDim.x) {
        const int chunk = item >> 3, g = item & 7, tok0 = chunk * 128;
        __syncthreads();
        for (int i = tid; i < 128 * 128; i += 512) { const int c = i >> 7, q = i & 127; const int ch = g * 128 + c;
            const float v = bf2f(ZVT[(size_t)ch * NTOK + tok0 + q]);
            zvn[q * 128 + c] = (v - zs[2 * (tok0 + q)]) * zs[2 * (tok0 + q) + 1] * p.gmlp_ln_g[ch] + p.gmlp_ln_b[ch];
            wsm[i] = p.gmlp_ws[g * 16384 + i]; }
        __syncthreads();
        const int c = tid & 127, pq = tid >> 7;
        for (int pp = 0; pp < 32; ++pp) { const int pr = pq * 32 + pp; float acc = 0.f;
            for (int q = 0; q < 128; ++q) acc += wsm[pr * 128 + q] * zvn[q * 128 + c];
            acc += p.gmlp_bs[g * 128 + pr];
            const size_t o = (size_t)(tok0 + pr) * 1024 + g * 128 + c;
            YA[o] = (bf16_t)f2bf(bf2f(ZU[o]) * acc); }
    }
}
__device__ __forceinline__ bf16x8 pack8(const float (&v)[8]) { u32x4 w; w.x = pk2(v[0], v[1]); w.y = pk2(v[2], v[3]); w.z = pk2(v[4], v[5]); w.w = pk2(v[6], v[7]); return __builtin_bit_cast(bf16x8, w); }
__device__ __forceinline__ void attn_wave_unit(const P& p, int b, int r, int j, int h, int lane) {
    const int fr = lane & 15, fq = lane >> 4;
    const bf16_t* Q = (const bf16_t*)(p.ws + WS_Q); const bf16_t* K = (const bf16_t*)(p.ws + WS_K); const bf16_t* VT = (const bf16_t*)(p.ws + WS_VT);
    const bf16_t* KC = (const bf16_t*)(p.ws + WS_KC); const bf16_t* VCT = (const bf16_t*)(p.ws + WS_VCT); const float* tab = (const float*)(p.ws + WS_ROPE);
    bf16_t* YB = (bf16_t*)(p.ws + WS_YB);
    const int qc = 16 * j + fr; const size_t tq = (size_t)b * SEQ + r * 64 + qc;
    const int r0 = min(max(r - 4, 0), 56), c0 = min(max(qc - 8, 0), 48), cs = min(max(16 * j - 8, 0), 32);
    bf16x8 qpl[2], qrt[2];
#pragma unroll
    for (int s = 0; s < 2; ++s) {
        const bf16_t* qb = Q + tq * 1024 + h * 64 + 32 * s;
        const bf16x8 me = *(const bf16x8*)(qb + 8 * fq), ot = *(const bf16x8*)(qb + 8 * (fq ^ 2));
        qpl[s] = me;
        const int pos = s ? qc : r; const float* tb = tab + (pos * 16 + 8 * (fq & 1)) * 2;
        float rot[8];
#pragma unroll
        for (int jj = 0; jj < 8; ++jj) { const float cv = tb[2 * jj], sv = tb[2 * jj + 1];
            const float xv = bf2f((unsigned)(unsigned short)me[jj]), ov = bf2f((unsigned)(unsigned short)ot[jj]);
            rot[jj] = (fq < 2) ? (xv * cv - ov * sv) : (xv * cv + ov * sv); }
        qrt[s] = pack8(rot);
    }
    const int sp0 = 8 * (fr >> 2) + (fr & 3);
    float sc[8][8];
#pragma unroll
    for (int st = 0; st < 8; ++st) { const int kr = r0 + st; const size_t tok0 = (size_t)b * SEQ + kr * 64 + cs;
#pragma unroll
        for (int t = 0; t < 2; ++t) { const bf16_t* kp = K + (tok0 + sp0 + 4 * t) * 1024 + h * 64 + 8 * fq;
            f32x4 d = __builtin_amdgcn_mfma_f32_16x16x32_bf16(*(const bf16x8*)kp, qrt[0], (f32x4){0.f, 0.f, 0.f, 0.f}, 0, 0, 0);
            d = __builtin_amdgcn_mfma_f32_16x16x32_bf16(*(const bf16x8*)(kp + 32), qrt[1], d, 0, 0, 0);
#pragma unroll
            for (int i = 0; i < 4; ++i) { const int kc = cs + 8 * fq + 4 * t + i; const bool valid = (kc >= c0) && (kc < c0 + 16);
                float bias = 0.f; if (valid) bias = p.na_rpb[(h * 15 + (kr - r + 7)) * 31 + (kc - qc + 15)];
                sc[st][4 * t + i] = valid ? (d[i] * 0.125f + bias) : -INFINITY; } } }
    float m = -INFINITY;
#pragma unroll
    for (int st = 0; st < 8; ++st)
#pragma unroll
        for (int e = 0; e < 8; ++e) m = fmaxf(m, sc[st][e]);
    m = fmaxf(m, __shfl_xor(m, 16)); m = fmaxf(m, __shfl_xor(m, 32));
    float l = 0.f; f32x4 o[4];
#pragma unroll
    for (int dt = 0; dt < 4; ++dt) o[dt] = (f32x4){0.f, 0.f, 0.f, 0.f};
#pragma unroll
    for (int st = 0; st < 8; ++st) { const int kr = r0 + st; const size_t tok0 = (size_t)b * SEQ + kr * 64 + cs;
        float pv[8];
#pragma unroll
        for (int e = 0; e < 8; ++e) { pv[e] = __expf(sc[st][e] - m); l += pv[e]; }
        const bf16x8 pf = pack8(pv);
#pragma unroll
        for (int dt = 0; dt < 4; ++dt) { const bf16x8 vf = *(const bf16x8*)(VT + (size_t)(h * 64 + 16 * dt + fr) * NTOK + tok0 + 8 * fq);
            o[dt] = __builtin_amdgcn_mfma_f32_16x16x32_bf16(vf, pf, o[dt], 0, 0, 0); } }
#pragma unroll
    for (int st = 0; st < 8; ++st) { const size_t tok0 = (size_t)b * CTXL + 32 * st;
#pragma unroll
        for (int t = 0; t < 2; ++t) { const bf16_t* kp = KC + (tok0 + sp0 + 4 * t) * 1024 + h * 64 + 8 * fq;
            f32x4 d = __builtin_amdgcn_mfma_f32_16x16x32_bf16(*(const bf16x8*)kp, qpl[0], (f32x4){0.f, 0.f, 0.f, 0.f}, 0, 0, 0);
            d = __builtin_amdgcn_mfma_f32_16x16x32_bf16(*(const bf16x8*)(kp + 32), qpl[1], d, 0, 0, 0);
#pragma unroll
            for (int i = 0; i < 4; ++i) sc[st][4 * t + i] = d[i] * 0.125f; } }
    float m2 = -INFINITY;
#pragma unroll
    for (int st = 0; st < 8; ++st)
#pragma unroll
        for (int e = 0; e < 8; ++e) m2 = fmaxf(m2, sc[st][e]);
    m2 = fmaxf(m2, __shfl_xor(m2, 16)); m2 = fmaxf(m2, __shfl_xor(m2, 32));
    const float mn = fmaxf(m, m2), al = __expf(m - mn);
    l *= al;
#pragma unroll
    for (int dt = 0; dt < 4; ++dt) o[dt] = o[dt] * al;
#pragma unroll
    for (int st = 0; st < 8; ++st) { const size_t tok0 = (size_t)b * CTXL + 32 * st;
        float pv[8];
#pragma unroll
        for (int e = 0; e < 8; ++e) { pv[e] = __expf(sc[st][e] - mn); l += pv[e]; }
        const bf16x8 pf = pack8(pv);
#pragma unroll
        for (int dt = 0; dt < 4; ++dt) { const bf16x8 vf = *(const bf16x8*)(VCT + (size_t)(h * 64 + 16 * dt + fr) * NCTX + tok0 + 8 * fq);
            o[dt] = __builtin_amdgcn_mfma_f32_16x16x32_bf16(vf, pf, o[dt], 0, 0, 0); } }
    l += __shfl_xor(l, 16); l += __shfl_xor(l, 32);
    const float inv = 1.0f / l;
#pragma unroll
    for (int dt = 0; dt < 4; ++dt) { u32x2 w; w.x = pk2(o[dt][0] * inv, o[dt][1] * inv); w.y = pk2(o[dt][2] * inv, o[dt][3] * inv);
        *(u32x2*)(YB + tq * 1024 + h * 64 + 16 * dt + 4 * fq) = w; }
}
__global__ void __launch_bounds__(512) k_attn(P p) {
    const int wave = threadIdx.x >> 6, lane = threadIdx.x & 63;
    for (int bu = blockIdx.x; bu < NB * 64 * 8; bu += gridDim.x) { const int hp = bu & 7, r = (bu >> 3) & 63, b = bu >> 9;
        attn_wave_unit(p, b, r, wave & 3, 2 * hp + (wave >> 2), lane); }
}
struct EpiMergeA { const bf16_t* G; bf16_t* INNER;
    __device__ __forceinline__ void operator()(int r, int n, float v) const { INNER[(size_t)r * 1024 + n] = (bf16_t)f2bf(bf2f(G[(size_t)r * 2048 + n]) * v); } };
struct EpiMergeB { const bf16_t* G; bf16_t* INNER;
    __device__ __forceinline__ void operator()(int r, int n, float v) const { const size_t o = (size_t)r * 1024 + n; INNER[o] = (bf16_t)f2bf(bf2f(INNER[o]) + bf2f(G[(size_t)r * 2048 + 1024 + n]) * v); } };
template <int WHICH> __global__ void __launch_bounds__(512) k_merge(P p) {
    const int wave = threadIdx.x >> 6, lane = threadIdx.x & 63; unsigned char* ws = p.ws;
    const int ntn = 1024 / 32, ntiles = (NTOK / 32) * ntn;
    if (WHICH == 0) { ARowDense ar{(const bf16_t*)(ws + WS_U), 1024}, br{(const bf16_t*)(ws + WS_WPA), 1024}; EpiMergeA e{(const bf16_t*)(ws + WS_G), (bf16_t*)(ws + WS_INNER)};
        for (int t = blockIdx.x * 8 + wave; t < ntiles; t += gridDim.x * 8) sgemm_wave_tile((t / ntn) * 32, (t % ntn) * 32, 1024, ar, br, e, lane);
    } else { ARowDense ar{(const bf16_t*)(ws + WS_YB), 1024}, br{(const bf16_t*)(ws + WS_WPB), 1024}; EpiMergeB e{(const bf16_t*)(ws + WS_G), (bf16_t*)(ws + WS_INNER)};
        for (int t = blockIdx.x * 8 + wave; t < ntiles; t += gridDim.x * 8) sgemm_wave_tile((t / ntn) * 32, (t % ntn) * 32, 1024, ar, br, e, lane); }
}
struct EpiMix { const float *x, *rowstat, *lng, *lnb, *mod, *b_out; float* out;
    __device__ __forceinline__ void operator()(int r, int n, float v) const {
        const int b = r >> 12; const float x0 = (x[(size_t)r * 1024 + n] - rowstat[2 * r]) * rowstat[2 * r + 1] * lng[n] + lnb[n];
        out[(size_t)r * 1024 + n] = ALPHA * x0 + mod[b * 6144 + 2048 + n] * (v + b_out[n]); } };
__global__ void __launch_bounds__(512) k_mix(P p) {
    const int wave = threadIdx.x >> 6, lane = threadIdx.x & 63; unsigned char* ws = p.ws;
    const int ntn = 1024 / 32, ntiles = (NTOK / 32) * ntn;
    ARowDense ar{(const bf16_t*)(ws + WS_INNER), 1024}, br{(const bf16_t*)(ws + WS_WOUT), 1024};
    EpiMix e{p.x, (const float*)(ws + WS_ROWSTAT), p.ln_x_g, p.ln_x_b, (const float*)(ws + WS_MOD), p.b_out, p.out};
    for (int t = blockIdx.x * 8 + wave; t < ntiles; t += gridDim.x * 8) sgemm_wave_tile((t / ntn) * 32, (t % ntn) * 32, 1024, ar, br, e, lane);
}

constexpr int RT_LDS_W = 0, RT_LDS_CNT = 131072, RT_LDS_BASE = RT_LDS_CNT + 128, RT_LDS_REC = RT_LDS_BASE + 128, RT_MAXIT = 32, RT_LDS_END = RT_LDS_REC + 8 * RT_MAXIT * 8 * 4;
__device__ __forceinline__ int rw_off(int prow, int ch) { return prow * 128 + ((ch ^ ((prow >> 1) & 7)) << 4); }
__device__ __forceinline__ void phase_router(const P& p, int bid, int nblk, unsigned char* lds) {
    const int tid = threadIdx.x, wave = tid >> 6, lane = tid & 63;
    int* cnt = (int*)(lds + RT_LDS_CNT); int* base = (int*)(lds + RT_LDS_BASE); int* rec = (int*)(lds + RT_LDS_REC) + wave * RT_MAXIT * 8;
    for (int k = tid; k < 1024; k += 512) { const int l = (k & 255) >> 2, i = k & 3, j = k >> 8, prow = l + 64 * (4 * j + i);
        const f32x4* src = (const f32x4*)(p.router_w + (size_t)k * 32);
#pragma unroll
        for (int ch = 0; ch < 8; ++ch) *(f32x4*)(lds + RT_LDS_W + rw_off(prow, ch)) = src[ch]; }
    if (tid < 32) cnt[tid] = 0;
    __syncthreads();
    const float* mod = (const float*)(p.ws + WS_MOD);
    int* TOPE = (int*)(p.ws + WS_TOPE); float* TOPG = (float*)(p.ws + WS_TOPG); int* SLOT = (int*)(p.ws + WS_SLOT);
    bf16_t* U2 = (bf16_t*)(p.ws + WS_U);
    const int erev = (int)(__builtin_bitreverse32((unsigned)(lane & 31)) >> 27);
    unsigned wb[8];
#pragma unroll
    for (int ch = 0; ch < 8; ++ch) wb[ch] = RT_LDS_W + lane * 128 + ((ch ^ ((lane >> 1) & 7)) << 4);
    int it = 0;
    for (int row = bid * 8 + wave; row < NTOK; row += nblk * 8, ++it) {
        const int b = row >> 12;
        f32x4* xr = (f32x4*)(p.out + (size_t)row * DM) + lane;
        f32x4 v[4]; float s = 0.f;
#pragma unroll
        for (int j = 0; j < 4; ++j) { v[j] = xr[64 * j]; s += (v[j].x + v[j].y) + (v[j].z + v[j].w); }
        const float mean = wave_sum(s) * (1.f / DM); float s2 = 0.f;
#pragma unroll
        for (int j = 0; j < 4; ++j) { v[j] = v[j] - mean; s2 += (v[j].x * v[j].x + v[j].y * v[j].y) + (v[j].z * v[j].z + v[j].w * v[j].w); }
        const float rstd = 1.f / sqrtf(wave_sum(s2) * (1.f / DM) + LN_EPS);
        float a[32];
#pragma unroll
        for (int e = 0; e < 32; ++e) a[e] = 0.f;
        u32x2* o8 = (u32x2*)(U2 + (size_t)row * DM) + lane;
#pragma unroll
        for (int j = 0; j < 4; ++j) { const int col = 4 * lane + 256 * j;
            const f32x4 gg = *(const f32x4*)(p.ln1_g + col), bb = *(const f32x4*)(p.ln1_b + col);
            const f32x4 shv = *(const f32x4*)(mod + b * 6144 + 3072 + col), scv = *(const f32x4*)(mod + b * 6144 + 4096 + col);
            const f32x4 x1 = (v[j] * rstd) * gg + bb; xr[64 * j] = x1;
            const f32x4 u = x1 * (1.0f + scv) + shv;
            u32x2 w; w.x = pk2(u.x, u.y); w.y = pk2(u.z, u.w); o8[64 * j] = w;
#pragma unroll
            for (int i = 0; i < 4; ++i) { const float uv = u[i];
#pragma unroll
                for (int ch = 0; ch < 8; ++ch) { const f32x4 w4 = *(const f32x4*)(lds + wb[ch] + (4 * j + i) * 8192);
                    a[4 * ch + 0] += uv * w4.x; a[4 * ch + 1] += uv * w4.y; a[4 * ch + 2] += uv * w4.z; a[4 * ch + 3] += uv * w4.w; } }
        }
#pragma unroll
        for (int st = 0; st < 5; ++st) { const int n = 16 >> st; const bool up = (lane >> st) & 1;
#pragma unroll
            for (int i = 0; i < n; ++i) { const float keep = up ? a[n + i] : a[i], send = up ? a[i] : a[n + i]; a[i] = keep + __shfl_xor(send, 1 << st); } }
        float logit = a[0] + __shfl_xor(a[0], 32);
        logit += p.router_b[erev];
        float cur = logit;
#define TOP_STEP(TV, TE) float TV; int TE; { const float mx = wave_max(cur); int cand = (cur == mx) ? erev : 64; \
            cand = min(cand, __shfl_xor(cand, 1)); cand = min(cand, __shfl_xor(cand, 2)); cand = min(cand, __shfl_xor(cand, 4)); \
            cand = min(cand, __shfl_xor(cand, 8)); cand = min(cand, __shfl_xor(cand, 16)); cand = min(cand, __shfl_xor(cand, 32)); \
            TV = mx; TE = cand; if (erev == cand) cur = -INFINITY; }
        TOP_STEP(tv0, te0) TOP_STEP(tv1, te1) TOP_STEP(tv2, te2) TOP_STEP(tv3, te3)
#undef TOP_STEP
        const float gk0 = 1.0f, gk1 = __expf(tv1 - tv0), gk2 = __expf(tv2 - tv0), gk3 = __expf(tv3 - tv0);
        const float ginv = 1.f / (gk0 + gk1 + gk2 + gk3);
        if (lane < 4) { const int e = lane == 0 ? te0 : lane == 1 ? te1 : lane == 2 ? te2 : te3; const float g = lane == 0 ? gk0 : lane == 1 ? gk1 : lane == 2 ? gk2 : gk3;
            const int pos = atomicAdd(&cnt[e], 1);
            TOPE[row * 4 + lane] = e; TOPG[row * 4 + lane] = g * ginv;
            if (it < RT_MAXIT) { rec[it * 8 + lane * 2] = e; rec[it * 8 + lane * 2 + 1] = pos; } }
    }
    __syncthreads();
    if (tid < 32) base[tid] = atomicAdd((int*)(p.ws + WS_CTL) + tid, cnt[tid]);
    __syncthreads();
    it = 0;
    for (int row = bid * 8 + wave; row < NTOK; row += nblk * 8, ++it)
        if (lane < 4 && it < RT_MAXIT) SLOT[row * 4 + lane] = base[rec[it * 8 + lane * 2]] + rec[it * 8 + lane * 2 + 1];
}
__device__ __forceinline__ void phase_dispatch(const P& p, int bid, int nblk, unsigned char* lds) {
    const int tid = threadIdx.x; int* eb = (int*)lds; int* tb = eb + 40; int* cn = tb + 40;
    if (tid < 32) cn[tid] = __hip_atomic_load((int*)(p.ws + WS_CTL) + tid, __ATOMIC_RELAXED, __HIP_MEMORY_SCOPE_AGENT);
    __syncthreads();
    if (tid == 0) { int s = 0, t = 0; for (int e = 0; e < 32; ++e) { eb[e] = s; tb[e] = t; s += cn[e]; t += (cn[e] + 255) >> 8; } eb[32] = s; tb[32] = t; }
    __syncthreads();
    int* TILES = (int*)(p.ws + WS_TILES);
    if (bid == 0) { if (tid < 32) { const int e = tid, n = cn[e]; for (int j = 0; j * 256 < n; ++j) { const int T = tb[e] + j; TILES[4 * T] = e; TILES[4 * T + 1] = eb[e] + 256 * j; TILES[4 * T + 2] = min(256, n - 256 * j); TILES[4 * T + 3] = 0; } }
        if (tid == 0) TILES[4 * MAXTILES] = tb[32]; }
    const int* TOPE = (const int*)(p.ws + WS_TOPE); int* SLOT = (int*)(p.ws + WS_SLOT); int* PERM = (int*)(p.ws + WS_PERM);
    for (int i = bid * 512 + tid; i < NASSIGN; i += nblk * 512) { const int slot = eb[TOPE[i]] + SLOT[i]; SLOT[i] = slot; PERM[slot] = i >> 2; }
}
__global__ void __launch_bounds__(512) k_moe1(P p) {
    const int wave = threadIdx.x >> 6, lane = threadIdx.x & 63, fr = lane & 15, fq = lane >> 4; unsigned char* ws = p.ws;
    const int* TILES = (const int*)(ws + WS_TILES); const int* PERM = (const int*)(ws + WS_PERM); const int ntiles = TILES[4 * MAXTILES];
    const bf16_t* U2 = (const bf16_t*)(ws + WS_U); bf16_t* ACT = (bf16_t*)(ws + WS_ACT);
    const int total = ntiles * 8 * 64;
    for (int u = blockIdx.x * 8 + wave; u < total; u += gridDim.x * 8) {
        const int T = u >> 9, rb = (u >> 6) & 7, cb = u & 63; const int e = TILES[4 * T], row0 = TILES[4 * T + 1], nrows = TILES[4 * T + 2];
        if (rb * 32 >= nrows) continue;
        const bf16_t* W = (const bf16_t*)(ws + WS_W1) + (size_t)e * 2048 * 1024;
        const int wrow = 256 * (cb >> 3) + 16 * (cb & 7) + fr;
        const bf16_t* bp0 = W + (size_t)wrow * 1024 + 8 * fq; const bf16_t* bp1 = bp0 + (size_t)128 * 1024;
        const bf16_t* ap[2];
#pragma unroll
        for (int a = 0; a < 2; ++a) { const int lr = min(rb * 32 + 16 * a + fr, nrows - 1); ap[a] = U2 + (size_t)PERM[row0 + lr] * 1024 + 8 * fq; }
        f32x4 acc[2][2];
#pragma unroll
        for (int a = 0; a < 2; ++a) { acc[a][0] = (f32x4){0.f, 0.f, 0.f, 0.f}; acc[a][1] = (f32x4){0.f, 0.f, 0.f, 0.f}; }
        for (int k0 = 0; k0 < 1024; k0 += 32) { const bf16x8 b0 = *(const bf16x8*)(bp0 + k0), b1 = *(const bf16x8*)(bp1 + k0);
#pragma unroll
            for (int a = 0; a < 2; ++a) { const bf16x8 af = *(const bf16x8*)(ap[a] + k0);
                acc[a][0] = __builtin_amdgcn_mfma_f32_16x16x32_bf16(af, b0, acc[a][0], 0, 0, 0); acc[a][1] = __builtin_amdgcn_mfma_f32_16x16x32_bf16(af, b1, acc[a][1], 0, 0, 0); } }
        const int oc = 16 * cb + fr; const float bg = p.exp_b1[e * 2048 + oc], bl = p.exp_b1[e * 2048 + 1024 + oc];
#pragma unroll
        for (int a = 0; a < 2; ++a)
#pragma unroll
            for (int i = 0; i < 4; ++i) { const int lr = rb * 32 + 16 * a + 4 * fq + i; if (lr < nrows) {
                const float zg = fminf(acc[a][0][i] + bg, 7.0f), zl = fminf(fmaxf(acc[a][1][i] + bl, -7.0f), 7.0f);
                const float act = zg * sigmoidf_(1.702f * zg) * (zl + 1.0f);
                ACT[(size_t)(row0 + lr) * 1024 + oc] = (bf16_t)f2bf(act); } }
    }
}
__global__ void __launch_bounds__(512) k_moe2(P p) {
    const int wave = threadIdx.x >> 6, lane = threadIdx.x & 63, fr = lane & 15, fq = lane >> 4; unsigned char* ws = p.ws;
    const int* TILES = (const int*)(ws + WS_TILES); const int ntiles = TILES[4 * MAXTILES];
    const bf16_t* ACT = (const bf16_t*)(ws + WS_ACT); bf16_t* YS = (bf16_t*)(ws + WS_YS);
    const int total = ntiles * 8 * 32;
    for (int u = blockIdx.x * 8 + wave; u < total; u += gridDim.x * 8) {
        const int T = u >> 8, rb = (u >> 5) & 7, cb = u & 31; const int e = TILES[4 * T], row0 = TILES[4 * T + 1], nrows = TILES[4 * T + 2];
        if (rb * 32 >= nrows) continue;
        const bf16_t* W = (const bf16_t*)(ws + WS_W2) + (size_t)e * 1024 * 1024;
        const bf16_t* ap[2]; const bf16_t* bp[2];
#pragma unroll
        for (int a = 0; a < 2; ++a) { const int lr = min(rb * 32 + 16 * a + fr, nrows - 1); ap[a] = ACT + (size_t)(row0 + lr) * 1024 + 8 * fq; bp[a] = W + (size_t)(cb * 32 + 16 * a + fr) * 1024 + 8 * fq; }
        f32x4 acc[2][2];
#pragma unroll
        for (int a = 0; a < 2; ++a) { acc[a][0] = (f32x4){0.f, 0.f, 0.f, 0.f}; acc[a][1] = (f32x4){0.f, 0.f, 0.f, 0.f}; }
        for (int k0 = 0; k0 < 1024; k0 += 32) { bf16x8 af[2], bfr[2];
#pragma unroll
            for (int a = 0; a < 2; ++a) { af[a] = *(const bf16x8*)(ap[a] + k0); bfr[a] = *(const bf16x8*)(bp[a] + k0); }
#pragma unroll
            for (int a = 0; a < 2; ++a)
#pragma unroll
                for (int b = 0; b < 2; ++b) acc[a][b] = __builtin_amdgcn_mfma_f32_16x16x32_bf16(af[a], bfr[b], acc[a][b], 0, 0, 0); }
#pragma unroll
        for (int a = 0; a < 2; ++a)
#pragma unroll
            for (int b = 0; b < 2; ++b) { const int oc = cb * 32 + 16 * b + fr; const float bias = p.exp_b2[e * 1024 + oc];
#pragma unroll
                for (int i = 0; i < 4; ++i) { const int lr = rb * 32 + 16 * a + 4 * fq + i; if (lr < nrows) YS[(size_t)(row0 + lr) * 1024 + oc] = (bf16_t)f2bf(acc[a][b][i] + bias); } }
    }
}
__device__ __forceinline__ void phase_final(const P& p, int bid, int nblk) {
    const int tid = threadIdx.x, wave = tid >> 6, lane = tid & 63;
    const float* mod = (const float*)(p.ws + WS_MOD); const int* SLOT = (const int*)(p.ws + WS_SLOT); const float* TOPG = (const float*)(p.ws + WS_TOPG);
    const bf16_t* YS = (const bf16_t*)(p.ws + WS_YS);
    for (int row = bid * 8 + wave; row < NTOK; row += nblk * 8) {
        const int b = row >> 12;
        int sl[4]; float gk[4];
#pragma unroll
        for (int k = 0; k < 4; ++k) { sl[k] = SLOT[row * 4 + k]; gk[k] = TOPG[row * 4 + k]; }
        f32x4* xr = (f32x4*)(p.out + (size_t)row * DM) + lane;
        f32x4 v[4]; float s = 0.f;
#pragma unroll
        for (int j = 0; j < 4; ++j) { const int col = 4 * lane + 256 * j; f32x4 ff = (f32x4){0.f, 0.f, 0.f, 0.f};
#pragma unroll
            for (int k = 0; k < 4; ++k) { const u32x2 w = *((const u32x2*)(YS + (size_t)sl[k] * 1024 + col));
                ff.x += gk[k] * bflo(w.x); ff.y += gk[k] * bfhi(w.x); ff.z += gk[k] * bflo(w.y); ff.w += gk[k] * bfhi(w.y); }
            const f32x4 g2 = *(const f32x4*)(mod + b * 6144 + 5120 + col);
            v[j] = xr[64 * j] * ALPHA + g2 * ff; s += (v[j].x + v[j].y) + (v[j].z + v[j].w); }
        const float mean = wave_sum(s) * (1.f / DM); float s2 = 0.f;
#pragma unroll
        for (int j = 0; j < 4; ++j) { v[j] = v[j] - mean; s2 += (v[j].x * v[j].x + v[j].y * v[j].y) + (v[j].z * v[j].z + v[j].w * v[j].w); }
        const float rstd = 1.f / sqrtf(wave_sum(s2) * (1.f / DM) + LN_EPS);
#pragma unroll
        for (int j = 0; j < 4; ++j) { const int col = 4 * lane + 256 * j; const f32x4 gg = *(const f32x4*)(p.ln2_g + col), bb = *(const f32x4*)(p.ln2_b + col);
            xr[64 * j] = (v[j] * rstd) * gg + bb; }
    }
}

__global__ void __launch_bounds__(512) k_prologue_a(P p) { extern __shared__ __attribute__((aligned(16))) unsigned char lds[]; phase_prologue_a(p, blockIdx.x, gridDim.x, lds); }
__global__ void __launch_bounds__(512) k_prologue_b(P p) { phase_prologue_b(p, blockIdx.x, gridDim.x); }
__global__ void __launch_bounds__(512) k_router(P p) { extern __shared__ __attribute__((aligned(16))) unsigned char lds[]; phase_router(p, blockIdx.x, gridDim.x, lds); }
__global__ void __launch_bounds__(512) k_dispatch(P p) { extern __shared__ __attribute__((aligned(16))) unsigned char lds[]; phase_dispatch(p, blockIdx.x, gridDim.x, lds); }
__global__ void __launch_bounds__(512) k_final(P p) { phase_final(p, blockIdx.x, gridDim.x); }

extern "C" void kernel_launch(void* const* d_in, const int* in_sizes, int n_in, void* d_out, int out_size, void* d_ws, size_t ws_size, hipStream_t stream) {
    static int ok = 0;
    if (ok == 0) {
        if (n_in != 31 || out_size != NTOK * DM || ws_size < WS_END) { fprintf(stderr, "kernel_launch: unexpected sizes n_in %d out %d ws %zu\n", n_in, out_size, ws_size); ok = -1; return; }
        hipFuncSetAttribute((const void*)k_prologue_a, hipFuncAttributeMaxDynamicSharedMemorySize, 147456);
        hipFuncSetAttribute((const void*)k_router, hipFuncAttributeMaxDynamicSharedMemorySize, 147456);
        hipFuncSetAttribute((const void*)k_dispatch, hipFuncAttributeMaxDynamicSharedMemorySize, 147456);
        hipFuncSetAttribute((const void*)k_gmlp, hipFuncAttributeMaxDynamicSharedMemorySize, 131072);
                ok = 1;
    }
    if (ok < 0) return;
    P p{};
    const float** pp = (const float**)&p;
    for (int i = 0; i < 31; ++i) pp[i] = (const float*)d_in[i];
    p.out = (float*)d_out; p.ws = (unsigned char*)d_ws; p.ph_lo = 0; p.ph_hi = 0;
    hipMemsetAsync((char*)d_ws + WS_CTL, 0, 1 * MiB, stream);
    hipLaunchKernelGGL(k_prologue_a, dim3(1024), dim3(512), 147456, stream, p);
    hipLaunchKernelGGL(k_prologue_b, dim3(1024), dim3(512), 0, stream, p);
    hipLaunchKernelGGL(k_proj, dim3(2048), dim3(512), 0, stream, p);
    hipLaunchKernelGGL(k_ctxkv, dim3(512), dim3(512), 0, stream, p);
    hipLaunchKernelGGL(k_rope, dim3(2048), dim3(512), 0, stream, p);
    hipLaunchKernelGGL(k_zstat, dim3(64), dim3(512), 0, stream, p);
    hipLaunchKernelGGL(k_gmlp, dim3(2048), dim3(512), 131072, stream, p);
    hipLaunchKernelGGL(k_attn, dim3(2048), dim3(512), 0, stream, p);
    hipLaunchKernelGGL(k_merge<0>, dim3(2048), dim3(512), 0, stream, p);
    hipLaunchKernelGGL(k_merge<1>, dim3(2048), dim3(512), 0, stream, p);
    hipLaunchKernelGGL(k_mix, dim3(2048), dim3(512), 0, stream, p);
    hipLaunchKernelGGL(k_router, dim3(256), dim3(512), 147456, stream, p);
    hipLaunchKernelGGL(k_dispatch, dim3(256), dim3(512), 147456, stream, p);
    hipLaunchKernelGGL(k_moe1, dim3(2048), dim3(512), 0, stream, p);
    hipLaunchKernelGGL(k_moe2, dim3(2048), dim3(512), 0, stream, p);
    hipLaunchKernelGGL(k_final, dim3(1024), dim3(512), 0, stream, p);
}
```

```cpp
#include <hip/hip_runtime.h>
#include <cstdio>
#include <cstdint>

typedef unsigned short bf16_t;
typedef short bf16x8 __attribute__((ext_vector_type(8)));
typedef float f32x4 __attribute__((ext_vector_type(4)));
typedef unsigned u32x4 __attribute__((ext_vector_type(4)));
typedef unsigned u32x2 __attribute__((ext_vector_type(2)));

constexpr int DM = 1024, NB = 8, SEQ = 4096, NTOK = NB * SEQ, CTXL = 256, NCTX = NB * CTXL, INW = 7168;
constexpr int NE = 32, TOPK = 4, FF = 1024, NASSIGN = NTOK * TOPK;
constexpr int NHEAD = 16, HD = 64, GW = 64;
constexpr float LN_EPS = 1e-5f;
constexpr float ALPHA = 1.189207115002721f;
constexpr int MAXTILES = NASSIGN / 256 + NE;

constexpr size_t MiB = 1u << 20;
constexpr size_t WS_CTL = 0;
constexpr size_t WS_MOD = 1 * MiB;
constexpr size_t WS_ROPE = 1 * MiB + 512 * 1024;
constexpr size_t WS_ROWSTAT = 2 * MiB;
constexpr size_t WS_ZSTAT = 2 * MiB + 512 * 1024;
constexpr size_t WS_TOPE = 3 * MiB;
constexpr size_t WS_TOPG = 4 * MiB;
constexpr size_t WS_SLOT = 5 * MiB;
constexpr size_t WS_PERM = 6 * MiB;
constexpr size_t WS_TILES = 7 * MiB;
constexpr size_t WS_WIN = 8 * MiB;
constexpr size_t WS_WPA = 22 * MiB, WS_WPB = 24 * MiB, WS_WOUT = 26 * MiB, WS_WSB = 28 * MiB;
constexpr size_t WS_KC = 30 * MiB;
constexpr size_t WS_VCT = 34 * MiB;
constexpr size_t WS_UC = 38 * MiB;
constexpr size_t WS_W1 = 48 * MiB;
constexpr size_t WS_W2 = 176 * MiB;
constexpr size_t WS_U = 240 * MiB;
constexpr size_t WS_ZU = 304 * MiB;
constexpr size_t WS_ZVT = 368 * MiB;
constexpr size_t WS_Q = 432 * MiB;
constexpr size_t WS_K = 496 * MiB;
constexpr size_t WS_VT = 560 * MiB;
constexpr size_t WS_G = 624 * MiB;
constexpr size_t WS_YB = 752 * MiB;
constexpr size_t WS_INNER = 816 * MiB;
constexpr size_t WS_ACT = WS_ZU;
constexpr size_t WS_YS = WS_G;
constexpr size_t WS_END = 880 * MiB;

struct P {
    const float *x, *c, *ctx, *c_ctx, *ln_x_g, *ln_x_b, *ln_ctx_g, *ln_ctx_b, *w_ada, *b_ada, *w_in, *b_in, *gmlp_ln_g, *gmlp_ln_b, *gmlp_ws, *gmlp_bs,
        *na_rpb, *w_pa, *w_pb, *w_out, *b_out, *ln1_g, *ln1_b, *ln2_g, *ln2_b, *router_w, *router_b, *exp_w1, *exp_b1, *exp_w2, *exp_b2;
    float* out; unsigned char* ws; int ph_lo, ph_hi;
};

__device__ __forceinline__ int tid_opaque() { int t = threadIdx.x; asm volatile("" : "+v"(t)); return t; }
__device__ __forceinline__ unsigned f2bf(float f) { unsigned u = __builtin_bit_cast(unsigned, f); return (u + 0x7fffu + ((u >> 16) & 1u)) >> 16; }
__device__ __forceinline__ unsigned pk2(float lo, float hi) { return f2bf(lo) | (f2bf(hi) << 16); }
__device__ __forceinline__ float bf2f(unsigned h) { return __builtin_bit_cast(float, (h & 0xffffu) << 16); }
__device__ __forceinline__ float bflo(unsigned w) { return __builtin_bit_cast(float, w << 16); }
__device__ __forceinline__ float bfhi(unsigned w) { return __builtin_bit_cast(float, w & 0xffff0000u); }
__device__ __forceinline__ float wave_sum(float v) {
#pragma unroll
    for (int o = 1; o < 64; o <<= 1) v += __shfl_xor(v, o);
    return v;
}
__device__ __forceinline__ float wave_max(float v) {
#pragma unroll
    for (int o = 1; o < 64; o <<= 1) v = fmaxf(v, __shfl_xor(v, o));
    return v;
}
__device__ __forceinline__ float gelu_exact(float v) { return 0.5f * v * (1.0f + erff(v * 0.70710678118654752f)); }
__device__ __forceinline__ float sigmoidf_(float v) { return 1.0f / (1.0f + __expf(-v)); }

__device__ __forceinline__ void mod_item(const P& p, int item, float* red  ) {
    const int tid = tid_opaque(), wave = tid >> 6, lane = tid & 63;
    const int col = item * 32 + (lane & 31), kpar = lane >> 5;
    float acc[9];
#pragma unroll
    for (int r = 0; r < 9; ++r) acc[r] = 0.f;
    for (int kk = 0; kk < 64; ++kk) {
        const int k = wave * 128 + kk * 2 + kpar;
        const float w = p.w_ada[(size_t)k * 6144 + col];
#pragma unroll
        for (int r = 0; r < 9; ++r) { const float cv = (r < 8) ? p.c[r * 1024 + k] : p.c_ctx[k]; const float s = cv / (1.0f + __expf(-cv)); acc[r] += s * w; }
    }
#pragma unroll
    for (int r = 0; r < 9; ++r) red[((wave * 2 + kpar) * 9 + r) * 32 + (lane & 31)] = acc[r];
    __syncthreads();
    if (tid < 288) {
        const int r = tid >> 5, cc = tid & 31; float s = 0.f;
#pragma unroll
        for (int q = 0; q < 16; ++q) s += red[(q * 9 + r) * 32 + cc];
        ((float*)(p.ws + WS_MOD))[r * 6144 + item * 32 + cc] = s + p.b_ada[item * 32 + cc];
    }
    __syncthreads();
}
__device__ __forceinline__ void transpose_item(const float* W, int K, int N, bf16_t* WT, int k0, int n0, int drow0, float* scr, int lane) {
#pragma unroll 8
    for (int i = 0; i < 32; ++i) { const int kk = 2 * i + (lane >> 5); scr[kk * 33 + (lane & 31)] = W[(size_t)(k0 + kk) * N + n0 + (lane & 31)]; }
    __builtin_amdgcn_wave_barrier();
    asm volatile("s_waitcnt lgkmcnt(0)" ::: "memory");
    const int c = lane & 7;
#pragma unroll
    for (int j = 0; j < 4; ++j) { const int n = (lane >> 3) + 8 * j; const float* s = scr + (8 * c) * 33 + n;
        u32x4 o; o.x = pk2(s[0 * 33], s[1 * 33]); o.y = pk2(s[2 * 33], s[3 * 33]); o.z = pk2(s[4 * 33], s[5 * 33]); o.w = pk2(s[6 * 33], s[7 * 33]);
        *(u32x4*)(WT + (size_t)(drow0 + n) * K + k0 + 8 * c) = o; }
    asm volatile("s_waitcnt lgkmcnt(0)" ::: "memory");
    __builtin_amdgcn_wave_barrier();
}
constexpr int IT_WIN = 16 * 224, IT_SQ = 16 * 32, IT_W1 = 32 * 16 * 64, IT_W2 = 32 * 16 * 32, IT_WS = 32;
constexpr int IT_TOTAL = IT_WIN + 3 * IT_SQ + IT_W1 + IT_W2 + IT_WS;
__device__ __forceinline__ void convert_item(const P& p, int it, float* scr, int lane) {
    unsigned char* ws = p.ws;
    if (it < IT_WIN) { const int kb = it / 224, nb = it % 224; transpose_item(p.w_in, 1024, INW, (bf16_t*)(ws + WS_WIN), kb * 64, nb * 32, nb * 32, scr, lane); return; } it -= IT_WIN;
    if (it < IT_SQ) { const int kb = it / 32, nb = it % 32; transpose_item(p.w_pa, 1024, 1024, (bf16_t*)(ws + WS_WPA), kb * 64, nb * 32, nb * 32, scr, lane); return; } it -= IT_SQ;
    if (it < IT_SQ) { const int kb = it / 32, nb = it % 32; transpose_item(p.w_pb, 1024, 1024, (bf16_t*)(ws + WS_WPB), kb * 64, nb * 32, nb * 32, scr, lane); return; } it -= IT_SQ;
    if (it < IT_SQ) { const int kb = it / 32, nb = it % 32; transpose_item(p.w_out, 1024, 1024, (bf16_t*)(ws + WS_WOUT), kb * 64, nb * 32, nb * 32, scr, lane); return; } it -= IT_SQ;
    if (it < IT_W1) { const int e = it / 1024, r = it % 1024, kb = r / 64, nb = r % 64, n0 = nb * 32;
        const int half = n0 >> 10, nn = n0 & 1023, drow0 = (nn >> 7) * 256 + half * 128 + (nn & 127);
        transpose_item(p.exp_w1 + (size_t)e * 1024 * 2048, 1024, 2048, (bf16_t*)(ws + WS_W1) + (size_t)e * 2048 * 1024, kb * 64, n0, drow0, scr, lane); return; } it -= IT_W1;
    if (it < IT_W2) { const int e = it / 512, r = it % 512, kb = r / 32, nb = r % 32;
        transpose_item(p.exp_w2 + (size_t)e * 1024 * 1024, 1024, 1024, (bf16_t*)(ws + WS_W2) + (size_t)e * 1024 * 1024, kb * 64, nb * 32, nb * 32, scr, lane); return; } it -= IT_W2;
    { bf16_t* o = (bf16_t*)(ws + WS_WSB); const float* s = p.gmlp_ws + it * 4096;
      for (int i = lane; i < 4096; i += 64) o[it * 4096 + i] = (bf16_t)f2bf(s[i]); }
}
__device__ __forceinline__ void phase_prologue_a(const P& p, int bid, int nblk, unsigned char* lds) {
    const int tid = tid_opaque(), wave = tid >> 6, lane = tid & 63;
    for (int item = bid; item < 192; item += nblk) mod_item(p, item, (float*)lds);
    if (bid == nblk - 1) {
        for (int i = tid; i < 1024; i += 512) { const int pos = i >> 4, fi = i & 15;
            const float inv = __builtin_amdgcn_exp2f(-(float)fi * (13.287712379549449f / 16.0f));
            const float ang = (float)pos * inv; const float rev = ang * 0.15915494309189535f;
            float* t = (float*)(p.ws + WS_ROPE); t[2 * i] = __builtin_amdgcn_cosf(rev); t[2 * i + 1] = __builtin_amdgcn_sinf(rev); }
    }
    __syncthreads();
    float* scr = (float*)lds + wave * (64 * 33 + 32);
    const int gw = bid * 8 + wave, ngw = nblk * 8;
    for (int it = gw; it < IT_TOTAL; it += ngw) convert_item(p, it, scr, lane);
}
__device__ __forceinline__ void ln_mod_row(const float* xrow, const float* g, const float* b, const float* sh, const float* sc, bf16_t* orow, float* stat, int lane) {
    const f32x4* xr = (const f32x4*)xrow + lane;
    f32x4 v[4]; float s = 0.f;
#pragma unroll
    for (int j = 0; j < 4; ++j) { v[j] = xr[64 * j]; s += (v[j].x + v[j].y) + (v[j].z + v[j].w); }
    const float mean = wave_sum(s) * (1.f / DM); float s2 = 0.f;
#pragma unroll
    for (int j = 0; j < 4; ++j) { v[j] = v[j] - mean; s2 += (v[j].x * v[j].x + v[j].y * v[j].y) + (v[j].z * v[j].z + v[j].w * v[j].w); }
    const float rstd = 1.f / sqrtf(wave_sum(s2) * (1.f / DM) + LN_EPS);
    if (stat && lane == 0) { stat[0] = mean; stat[1] = rstd; }
    u32x2* o8 = (u32x2*)orow + lane;
#pragma unroll
    for (int j = 0; j < 4; ++j) { const int col = 4 * lane + 256 * j;
        const f32x4 gg = *(const f32x4*)(g + col), bb = *(const f32x4*)(b + col), shv = *(const f32x4*)(sh + col), scv = *(const f32x4*)(sc + col);
        f32x4 y = (v[j] * rstd) * gg + bb; y = y * (1.0f + scv) + shv;
        u32x2 w; w.x = pk2(y.x, y.y); w.y = pk2(y.z, y.w); o8[64 * j] = w; }
}
__device__ __forceinline__ void phase_prologue_b(const P& p, int bid, int nblk) {
    const int tid = tid_opaque(), wave = tid >> 6, lane = tid & 63;
    const int gw = bid * 8 + wave, ngw = nblk * 8;
    const float* mod = (const float*)(p.ws + WS_MOD);
    for (int row = gw; row < NTOK + NCTX; row += ngw) {
        if (row < NTOK) { const int b = row >> 12;
            ln_mod_row(p.x + (size_t)row * DM, p.ln_x_g, p.ln_x_b, mod + b * 6144, mod + b * 6144 + 1024, (bf16_t*)(p.ws + WS_U) + (size_t)row * DM, (float*)(p.ws + WS_ROWSTAT) + 2 * row, lane);
        } else { const int r = row - NTOK;
            ln_mod_row(p.ctx + (size_t)r * DM, p.ln_ctx_g, p.ln_ctx_b, mod + 8 * 6144, mod + 8 * 6144 + 1024, (bf16_t*)(p.ws + WS_UC) + (size_t)r * DM, nullptr, lane); }
    }
}

template <class ARow, class BRow, class Epi>
__device__ __forceinline__ void sgemm_wave_tile(int r0, int n0, int K, const ARow& arow, const BRow& brow, const Epi& epi, int lane) {
    const int fr = lane & 15, fq = lane >> 4;
    f32x4 acc[2][2];
#pragma unroll
    for (int a = 0; a < 2; ++a)
#pragma unroll
        for (int b = 0; b < 2; ++b) acc[a][b] = (f32x4){0.f, 0.f, 0.f, 0.f};
    const bf16_t* ap[2]; const bf16_t* bp[2];
#pragma unroll
    for (int a = 0; a < 2; ++a) { ap[a] = arow(r0 + 16 * a + fr) + 8 * fq; bp[a] = brow(n0 + 16 * a + fr) + 8 * fq; }
    for (int k0 = 0; k0 < K; k0 += 32) {
        bf16x8 af[2], bfr[2];
#pragma unroll
        for (int a = 0; a < 2; ++a) { af[a] = *(const bf16x8*)(ap[a] + k0); bfr[a] = *(const bf16x8*)(bp[a] + k0); }
#pragma unroll
        for (int a = 0; a < 2; ++a)
#pragma unroll
            for (int b = 0; b < 2; ++b) acc[a][b] = __builtin_amdgcn_mfma_f32_16x16x32_bf16(af[a], bfr[b], acc[a][b], 0, 0, 0);
    }
#pragma unroll
    for (int a = 0; a < 2; ++a)
#pragma unroll
        for (int b = 0; b < 2; ++b)
#pragma unroll
            for (int i = 0; i < 4; ++i) epi(r0 + 16 * a + 4 * fq + i, n0 + 16 * b + fr, acc[a][b][i]);
}

struct ARowDense { const bf16_t* A; int lda; __device__ __forceinline__ const bf16_t* operator()(int r) const { return A + (size_t)r * lda; } };
struct EpiProj {
    const float* b_in; bf16_t *ZU, *ZVT, *Q, *K, *VT, *G;
    __device__ __forceinline__ void operator()(int r, int n, float v) const {
        v += b_in[n];
        if (n < 1024) ZU[(size_t)r * 1024 + n] = (bf16_t)f2bf(gelu_exact(v));
        else if (n < 2048) ZVT[(size_t)(n - 1024) * NTOK + r] = (bf16_t)f2bf(gelu_exact(v));
        else if (n < 3072) Q[(size_t)r * 1024 + (n - 2048)] = (bf16_t)f2bf(v);
        else if (n < 4096) K[(size_t)r * 1024 + (n - 3072)] = (bf16_t)f2bf(v);
        else if (n < 5120) VT[(size_t)(n - 4096) * NTOK + r] = (bf16_t)f2bf(v);
        else G[(size_t)r * 2048 + (n - 5120)] = (bf16_t)f2bf(sigmoidf_(v));
    }
};
__device__ __forceinline__ void phase_proj_s(const P& p, int bid, int nblk) {
    const int tid_ = tid_opaque(); const int wave = tid_ >> 6, lane = tid_ & 63; unsigned char* ws = p.ws;
    ARowDense ar{(const bf16_t*)(ws + WS_U), 1024}, br{(const bf16_t*)(ws + WS_WIN), 1024};
    EpiProj e{p.b_in, (bf16_t*)(ws + WS_ZU), (bf16_t*)(ws + WS_ZVT), (bf16_t*)(ws + WS_Q), (bf16_t*)(ws + WS_K), (bf16_t*)(ws + WS_VT), (bf16_t*)(ws + WS_G)};
    const int ntn = INW / 32, ntiles = (NTOK / 32) * ntn;
    for (int t = bid * 8 + wave; t < ntiles; t += nblk * 8) sgemm_wave_tile((t / ntn) * 32, (t % ntn) * 32, 1024, ar, br, e, lane);
}
struct EpiCtxKV {
    const float* b_in; bf16_t *KC, *VCT;
    __device__ __forceinline__ void operator()(int r, int n, float v) const {
        v += b_in[3072 + n];
        if (n < 1024) KC[(size_t)r * 1024 + n] = (bf16_t)f2bf(v); else VCT[(size_t)(n - 1024) * NCTX + r] = (bf16_t)f2bf(v);
    }
};
__device__ __forceinline__ void phase_ctxkv_s(const P& p, int bid, int nblk) {
    const int tid_ = tid_opaque(); const int wave = tid_ >> 6, lane = tid_ & 63; unsigned char* ws = p.ws;
    ARowDense ar{(const bf16_t*)(ws + WS_UC), 1024}, br{(const bf16_t*)(ws + WS_WIN) + (size_t)3072 * 1024, 1024};
    EpiCtxKV e{p.b_in, (bf16_t*)(ws + WS_KC), (bf16_t*)(ws + WS_VCT)};
    const int ntn = 2048 / 32, ntiles = (NCTX / 32) * ntn;
    for (int t = bid * 8 + wave; t < ntiles; t += nblk * 8) sgemm_wave_tile((t / ntn) * 32, (t % ntn) * 32, 1024, ar, br, e, lane);
}
__device__ __forceinline__ void phase_rope_s(const P& p, int bid, int nblk) {
    bf16_t* K = (bf16_t*)(p.ws + WS_K); const float* tab = (const float*)(p.ws + WS_ROPE);
    const size_t total = (size_t)NTOK * NHEAD * 32;
    const int tid_ = tid_opaque();
    for (size_t i = (size_t)bid * 512 + tid_; i < total; i += (size_t)nblk * 512) {
        const int pi = (int)(i & 31), h = (int)((i >> 5) & 15), t = (int)(i >> 9);
        const int pos = t & 4095, axis = pi >> 4, fi = pi & 15, ps = axis ? (pos & 63) : (pos >> 6);
        const float cs = tab[2 * (ps * 16 + fi)], sn = tab[2 * (ps * 16 + fi) + 1];
        bf16_t* base = K + (size_t)t * 1024 + h * 64 + axis * 32 + fi;
        const float x1 = bf2f(base[0]), x2 = bf2f(base[16]);
        base[0] = (bf16_t)f2bf(x1 * cs - x2 * sn); base[16] = (bf16_t)f2bf(x2 * cs + x1 * sn);
    }
}
__device__ __forceinline__ void phase_zstat_s(const P& p, int bid, int nblk) {
    const bf16_t* ZVT = (const bf16_t*)(p.ws + WS_ZVT); float* zs = (float*)(p.ws + WS_ZSTAT);
    const int tid_ = tid_opaque();
    for (int t = bid * 512 + tid_; t < NTOK; t += nblk * 512) {
        float s = 0.f, s2 = 0.f;
        for (int c = 0; c < 1024; ++c) { const float v = bf2f(ZVT[(size_t)c * NTOK + t]); s += v; s2 += v * v; }
        const float mean = s * (1.f / 1024.f); const float var = fmaxf(s2 * (1.f / 1024.f) - mean * mean, 0.f);
        zs[2 * t] = mean; zs[2 * t + 1] = 1.f / sqrtf(var + LN_EPS);
    }
}
__device__ __forceinline__ void phase_gmlp_s(const P& p, int bid, int nblk, unsigned char* lds) {
    float* zvn = (float*)lds;
    float* wsm = zvn + 128 * 128;
    const bf16_t* ZVT = (const bf16_t*)(p.ws + WS_ZVT); const bf16_t* ZU = (const bf16_t*)(p.ws + WS_ZU); const float* zs = (const float*)(p.ws + WS_ZSTAT);
    bf16_t* YA = (bf16_t*)(p.ws + WS_U);
    const int tid = tid_opaque();
    for (int item = bid; item < (NTOK / 128) * 8; item += nblk) {
        const int chunk = item >> 3, g = item & 7, tok0 = chunk * 128;
        __syncthreads();
        for (int i = tid; i < 128 * 128; i += 512) { const int c = i >> 7, q = i & 127; const int ch = g * 128 + c;
            const float v = bf2f(ZVT[(size_t)ch * NTOK + tok0 + q]);
            zvn[q * 128 + c] = (v - zs[2 * (tok0 + q)]) * zs[2 * (tok0 + q) + 1] * p.gmlp_ln_g[ch] + p.gmlp_ln_b[ch];
            wsm[i] = p.gmlp_ws[g * 16384 + i]; }
        __syncthreads();
        const int c = tid & 127, pq = tid >> 7;
        for (int pp = 0; pp < 32; ++pp) { const int pr = pq * 32 + pp; float acc = 0.f;
            for (int q = 0; q < 128; ++q) acc += wsm[pr * 128 + q] * zvn[q * 128 + c];
            acc += p.gmlp_bs[g * 128 + pr];
            const size_t o = (size_t)(tok0 + pr) * 1024 + g * 128 + c;
            YA[o] = (bf16_t)f2bf(bf2f(ZU[o]) * acc); }
    }
}
__device__ __forceinline__ bf16x8 pack8(const float (&v)[8]) { u32x4 w; w.x = pk2(v[0], v[1]); w.y = pk2(v[2], v[3]); w.z = pk2(v[4], v[5]); w.w = pk2(v[6], v[7]); return __builtin_bit_cast(bf16x8, w); }
__device__ __forceinline__ void attn_wave_unit(const P& p, int b, int r, int j, int h, int lane) {
    const int fr = lane & 15, fq = lane >> 4;
    const bf16_t* Q = (const bf16_t*)(p.ws + WS_Q); const bf16_t* K = (const bf16_t*)(p.ws + WS_K); const bf16_t* VT = (const bf16_t*)(p.ws + WS_VT);
    const bf16_t* KC = (const bf16_t*)(p.ws + WS_KC); const bf16_t* VCT = (const bf16_t*)(p.ws + WS_VCT); const float* tab = (const float*)(p.ws + WS_ROPE);
    bf16_t* YB = (bf16_t*)(p.ws + WS_YB);
    const int qc = 16 * j + fr; const size_t tq = (size_t)b * SEQ + r * 64 + qc;
    const int r0 = min(max(r - 4, 0), 56), c0 = min(max(qc - 8, 0), 48), cs = min(max(16 * j - 8, 0), 32);
    bf16x8 qpl[2], qrt[2];
#pragma unroll
    for (int s = 0; s < 2; ++s) {
        const bf16_t* qb = Q + tq * 1024 + h * 64 + 32 * s;
        const bf16x8 me = *(const bf16x8*)(qb + 8 * fq), ot = *(const bf16x8*)(qb + 8 * (fq ^ 2));
        qpl[s] = me;
        const int pos = s ? qc : r; const float* tb = tab + (pos * 16 + 8 * (fq & 1)) * 2;
        float rot[8];
#pragma unroll
        for (int jj = 0; jj < 8; ++jj) { const float cv = tb[2 * jj], sv = tb[2 * jj + 1];
            const float xv = bf2f((unsigned)(unsigned short)me[jj]), ov = bf2f((unsigned)(unsigned short)ot[jj]);
            rot[jj] = (fq < 2) ? (xv * cv - ov * sv) : (xv * cv + ov * sv); }
        qrt[s] = pack8(rot);
    }
    const int sp0 = 8 * (fr >> 2) + (fr & 3);
    float sc[8][8];
#pragma unroll
    for (int st = 0; st < 8; ++st) { const int kr = r0 + st; const size_t tok0 = (size_t)b * SEQ + kr * 64 + cs;
#pragma unroll
        for (int t = 0; t < 2; ++t) { const bf16_t* kp = K + (tok0 + sp0 + 4 * t) * 1024 + h * 64 + 8 * fq;
            f32x4 d = __builtin_amdgcn_mfma_f32_16x16x32_bf16(*(const bf16x8*)kp, qrt[0], (f32x4){0.f, 0.f, 0.f, 0.f}, 0, 0, 0);
            d = __builtin_amdgcn_mfma_f32_16x16x32_bf16(*(const bf16x8*)(kp + 32), qrt[1], d, 0, 0, 0);
#pragma unroll
            for (int i = 0; i < 4; ++i) { const int kc = cs + 8 * fq + 4 * t + i; const bool valid = (kc >= c0) && (kc < c0 + 16);
                float bias = 0.f; if (valid) bias = p.na_rpb[(h * 15 + (kr - r + 7)) * 31 + (kc - qc + 15)];
                sc[st][4 * t + i] = valid ? (d[i] * 0.125f + bias) : -INFINITY; } } }
    float m = -INFINITY;
#pragma unroll
    for (int st = 0; st < 8; ++st)
#pragma unroll
        for (int e = 0; e < 8; ++e) m = fmaxf(m, sc[st][e]);
    m = fmaxf(m, __shfl_xor(m, 16)); m = fmaxf(m, __shfl_xor(m, 32));
    float l = 0.f; f32x4 o[4];
#pragma unroll
    for (int dt = 0; dt < 4; ++dt) o[dt] = (f32x4){0.f, 0.f, 0.f, 0.f};
#pragma unroll
    for (int st = 0; st < 8; ++st) { const int kr = r0 + st; const size_t tok0 = (size_t)b * SEQ + kr * 64 + cs;
        float pv[8];
#pragma unroll
        for (int e = 0; e < 8; ++e) { pv[e] = __expf(sc[st][e] - m); l += pv[e]; }
        const bf16x8 pf = pack8(pv);
#pragma unroll
        for (int dt = 0; dt < 4; ++dt) { const bf16x8 vf = *(const bf16x8*)(VT + (size_t)(h * 64 + 16 * dt + fr) * NTOK + tok0 + 8 * fq);
            o[dt] = __builtin_amdgcn_mfma_f32_16x16x32_bf16(vf, pf, o[dt], 0, 0, 0); } }
#pragma unroll
    for (int st = 0; st < 8; ++st) { const size_t tok0 = (size_t)b * CTXL + 32 * st;
#pragma unroll
        for (int t = 0; t < 2; ++t) { const bf16_t* kp = KC + (tok0 + sp0 + 4 * t) * 1024 + h * 64 + 8 * fq;
            f32x4 d = __builtin_amdgcn_mfma_f32_16x16x32_bf16(*(const bf16x8*)kp, qpl[0], (f32x4){0.f, 0.f, 0.f, 0.f}, 0, 0, 0);
            d = __builtin_amdgcn_mfma_f32_16x16x32_bf16(*(const bf16x8*)(kp + 32), qpl[1], d, 0, 0, 0);
#pragma unroll
            for (int i = 0; i < 4; ++i) sc[st][4 * t + i] = d[i] * 0.125f; } }
    float m2 = -INFINITY;
#pragma unroll
    for (int st = 0; st < 8; ++st)
#pragma unroll
        for (int e = 0; e < 8; ++e) m2 = fmaxf(m2, sc[st][e]);
    m2 = fmaxf(m2, __shfl_xor(m2, 16)); m2 = fmaxf(m2, __shfl_xor(m2, 32));
    const float mn = fmaxf(m, m2), al = __expf(m - mn);
    l *= al;
#pragma unroll
    for (int dt = 0; dt < 4; ++dt) o[dt] = o[dt] * al;
#pragma unroll
    for (int st = 0; st < 8; ++st) { const size_t tok0 = (size_t)b * CTXL + 32 * st;
        float pv[8];
#pragma unroll
        for (int e = 0; e < 8; ++e) { pv[e] = __expf(sc[st][e] - mn); l += pv[e]; }
        const bf16x8 pf = pack8(pv);
#pragma unroll
        for (int dt = 0; dt < 4; ++dt) { const bf16x8 vf = *(const bf16x8*)(VCT + (size_t)(h * 64 + 16 * dt + fr) * NCTX + tok0 + 8 * fq);
            o[dt] = __builtin_amdgcn_mfma_f32_16x16x32_bf16(vf, pf, o[dt], 0, 0, 0); } }
    l += __shfl_xor(l, 16); l += __shfl_xor(l, 32);
    const float inv = 1.0f / l;
#pragma unroll
    for (int dt = 0; dt < 4; ++dt) { u32x2 w; w.x = pk2(o[dt][0] * inv, o[dt][1] * inv); w.y = pk2(o[dt][2] * inv, o[dt][3] * inv);
        *(u32x2*)(YB + tq * 1024 + h * 64 + 16 * dt + 4 * fq) = w; }
}
__device__ __forceinline__ void phase_attn_s(const P& p, int bid, int nblk) {
    const int tid_ = tid_opaque(); const int wave = tid_ >> 6, lane = tid_ & 63;
    for (int bu = bid; bu < NB * 64 * 8; bu += nblk) { const int hp = bu & 7, r = (bu >> 3) & 63, b = bu >> 9;
        attn_wave_unit(p, b, r, wave & 3, 2 * hp + (wave >> 2), lane); }
}
struct EpiMergeA { const bf16_t* G; bf16_t* INNER;
    __device__ __forceinline__ void operator()(int r, int n, float v) const { INNER[(size_t)r * 1024 + n] = (bf16_t)f2bf(bf2f(G[(size_t)r * 2048 + n]) * v); } };
struct EpiMergeB { const bf16_t* G; bf16_t* INNER;
    __device__ __forceinline__ void operator()(int r, int n, float v) const { const size_t o = (size_t)r * 1024 + n; INNER[o] = (bf16_t)f2bf(bf2f(INNER[o]) + bf2f(G[(size_t)r * 2048 + 1024 + n]) * v); } };
template <int WHICH> __device__ __forceinline__ void phase_merge_s(const P& p, int bid, int nblk) {
    const int tid_ = tid_opaque(); const int wave = tid_ >> 6, lane = tid_ & 63; unsigned char* ws = p.ws;
    const int ntn = 1024 / 32, ntiles = (NTOK / 32) * ntn;
    if (WHICH == 0) { ARowDense ar{(const bf16_t*)(ws + WS_U), 1024}, br{(const bf16_t*)(ws + WS_WPA), 1024}; EpiMergeA e{(const bf16_t*)(ws + WS_G), (bf16_t*)(ws + WS_INNER)};
        for (int t = bid * 8 + wave; t < ntiles; t += nblk * 8) sgemm_wave_tile((t / ntn) * 32, (t % ntn) * 32, 1024, ar, br, e, lane);
    } else { ARowDense ar{(const bf16_t*)(ws + WS_YB), 1024}, br{(const bf16_t*)(ws + WS_WPB), 1024}; EpiMergeB e{(const bf16_t*)(ws + WS_G), (bf16_t*)(ws + WS_INNER)};
        for (int t = bid * 8 + wave; t < ntiles; t += nblk * 8) sgemm_wave_tile((t / ntn) * 32, (t % ntn) * 32, 1024, ar, br, e, lane); }
}
struct EpiMix { const float *x, *rowstat, *lng, *lnb, *mod, *b_out; float* out;
    __device__ __forceinline__ void operator()(int r, int n, float v) const {
        const int b = r >> 12; const float x0 = (x[(size_t)r * 1024 + n] - rowstat[2 * r]) * rowstat[2 * r + 1] * lng[n] + lnb[n];
        out[(size_t)r * 1024 + n] = ALPHA * x0 + mod[b * 6144 + 2048 + n] * (v + b_out[n]); } };
__device__ __forceinline__ void phase_mix_s(const P& p, int bid, int nblk) {
    const int tid_ = tid_opaque(); const int wave = tid_ >> 6, lane = tid_ & 63; unsigned char* ws = p.ws;
    const int ntn = 1024 / 32, ntiles = (NTOK / 32) * ntn;
    ARowDense ar{(const bf16_t*)(ws + WS_INNER), 1024}, br{(const bf16_t*)(ws + WS_WOUT), 1024};
    EpiMix e{p.x, (const float*)(ws + WS_ROWSTAT), p.ln_x_g, p.ln_x_b, (const float*)(ws + WS_MOD), p.b_out, p.out};
    for (int t = bid * 8 + wave; t < ntiles; t += nblk * 8) sgemm_wave_tile((t / ntn) * 32, (t % ntn) * 32, 1024, ar, br, e, lane);
}

constexpr int RT_LDS_W = 0, RT_LDS_CNT = 131072, RT_LDS_BASE = RT_LDS_CNT + 128, RT_LDS_REC = RT_LDS_BASE + 128, RT_MAXIT = 32, RT_LDS_END = RT_LDS_REC + 8 * RT_MAXIT * 8 * 4;
__device__ __forceinline__ int rw_off(int prow, int ch) { return prow * 128 + ((ch ^ ((prow >> 1) & 7)) << 4); }
__device__ __forceinline__ void phase_router(const P& p, int bid, int nblk, unsigned char* lds) {
    const int tid = tid_opaque(), wave = tid >> 6, lane = tid & 63;
    int* cnt = (int*)(lds + RT_LDS_CNT); int* base = (int*)(lds + RT_LDS_BASE); int* rec = (int*)(lds + RT_LDS_REC) + wave * RT_MAXIT * 8;
    for (int k = tid; k < 1024; k += 512) { const int l = (k & 255) >> 2, i = k & 3, j = k >> 8, prow = l + 64 * (4 * j + i);
        const f32x4* src = (const f32x4*)(p.router_w + (size_t)k * 32);
#pragma unroll
        for (int ch = 0; ch < 8; ++ch) *(f32x4*)(lds + RT_LDS_W + rw_off(prow, ch)) = src[ch]; }
    if (tid < 32) cnt[tid] = 0;
    __syncthreads();
    const float* mod = (const float*)(p.ws + WS_MOD);
    int* TOPE = (int*)(p.ws + WS_TOPE); float* TOPG = (float*)(p.ws + WS_TOPG); int* SLOT = (int*)(p.ws + WS_SLOT);
    bf16_t* U2 = (bf16_t*)(p.ws + WS_U);
    const int erev = (int)(__builtin_bitreverse32((unsigned)(lane & 31)) >> 27);
    unsigned wb[8];
#pragma unroll
    for (int ch = 0; ch < 8; ++ch) wb[ch] = RT_LDS_W + lane * 128 + ((ch ^ ((lane >> 1) & 7)) << 4);
    int it = 0;
    for (int row = bid * 8 + wave; row < NTOK; row += nblk * 8, ++it) {
        const int b = row >> 12;
        f32x4* xr = (f32x4*)(p.out + (size_t)row * DM) + lane;
        f32x4 v[4]; float s = 0.f;
#pragma unroll
        for (int j = 0; j < 4; ++j) { v[j] = xr[64 * j]; s += (v[j].x + v[j].y) + (v[j].z + v[j].w); }
        const float mean = wave_sum(s) * (1.f / DM); float s2 = 0.f;
#pragma unroll
        for (int j = 0; j < 4; ++j) { v[j] = v[j] - mean; s2 += (v[j].x * v[j].x + v[j].y * v[j].y) + (v[j].z * v[j].z + v[j].w * v[j].w); }
        const float rstd = 1.f / sqrtf(wave_sum(s2) * (1.f / DM) + LN_EPS);
        float a[32];
#pragma unroll
        for (int e = 0; e < 32; ++e) a[e] = 0.f;
        u32x2* o8 = (u32x2*)(U2 + (size_t)row * DM) + lane;
        int lane_o = lane; asm volatile("" : "+v"(lane_o));
#pragma unroll
        for (int j = 0; j < 4; ++j) { const int col = 4 * lane_o + 256 * j;
            const f32x4 gg = *(const f32x4*)(p.ln1_g + col), bb = *(const f32x4*)(p.ln1_b + col);
            const f32x4 shv = *(const f32x4*)(mod + b * 6144 + 3072 + col), scv = *(const f32x4*)(mod + b * 6144 + 4096 + col);
            const f32x4 x1 = (v[j] * rstd) * gg + bb; xr[64 * j] = x1;
            const f32x4 u = x1 * (1.0f + scv) + shv;
            u32x2 w; w.x = pk2(u.x, u.y); w.y = pk2(u.z, u.w); o8[64 * j] = w;
#pragma unroll
            for (int i = 0; i < 4; ++i) { const float uv = u[i];
#pragma unroll
                for (int ch = 0; ch < 8; ++ch) { const f32x4 w4 = *(const f32x4*)(lds + wb[ch] + (4 * j + i) * 8192);
                    a[4 * ch + 0] += uv * w4.x; a[4 * ch + 1] += uv * w4.y; a[4 * ch + 2] += uv * w4.z; a[4 * ch + 3] += uv * w4.w; } }
        }
#pragma unroll
        for (int st = 0; st < 5; ++st) { const int n = 16 >> st; const bool up = (lane >> st) & 1;
#pragma unroll
            for (int i = 0; i < n; ++i) { const float keep = up ? a[n + i] : a[i], send = up ? a[i] : a[n + i]; a[i] = keep + __shfl_xor(send, 1 << st); } }
        float logit = a[0] + __shfl_xor(a[0], 32);
        logit += p.router_b[erev];
        float cur = logit;
#define TOP_STEP(TV, TE) float TV; int TE; { const float mx = wave_max(cur); int cand = (cur == mx) ? erev : 64; \
            cand = min(cand, __shfl_xor(cand, 1)); cand = min(cand, __shfl_xor(cand, 2)); cand = min(cand, __shfl_xor(cand, 4)); \
            cand = min(cand, __shfl_xor(cand, 8)); cand = min(cand, __shfl_xor(cand, 16)); cand = min(cand, __shfl_xor(cand, 32)); \
            TV = mx; TE = cand; if (erev == cand) cur = -INFINITY; }
        TOP_STEP(tv0, te0) TOP_STEP(tv1, te1) TOP_STEP(tv2, te2) TOP_STEP(tv3, te3)
#undef TOP_STEP
        const float gk0 = 1.0f, gk1 = __expf(tv1 - tv0), gk2 = __expf(tv2 - tv0), gk3 = __expf(tv3 - tv0);
        const float ginv = 1.f / (gk0 + gk1 + gk2 + gk3);
        if (lane < 4) { const int e = lane == 0 ? te0 : lane == 1 ? te1 : lane == 2 ? te2 : te3; const float g = lane == 0 ? gk0 : lane == 1 ? gk1 : lane == 2 ? gk2 : gk3;
            const int pos = atomicAdd(&cnt[e], 1);
            TOPE[row * 4 + lane] = e; TOPG[row * 4 + lane] = g * ginv;
            if (it < RT_MAXIT) { rec[it * 8 + lane * 2] = e; rec[it * 8 + lane * 2 + 1] = pos; } }
    }
    __syncthreads();
    if (tid < 32) base[tid] = atomicAdd((int*)(p.ws + WS_CTL) + tid, cnt[tid]);
    __syncthreads();
    it = 0;
    for (int row = bid * 8 + wave; row < NTOK; row += nblk * 8, ++it)
        if (lane < 4 && it < RT_MAXIT) SLOT[row * 4 + lane] = base[rec[it * 8 + lane * 2]] + rec[it * 8 + lane * 2 + 1];
}
__device__ __forceinline__ void phase_dispatch(const P& p, int bid, int nblk, unsigned char* lds) {
    const int tid = tid_opaque(); int* eb = (int*)lds; int* tb = eb + 40; int* cn = tb + 40;
    if (tid < 32) cn[tid] = __hip_atomic_load((int*)(p.ws + WS_CTL) + tid, __ATOMIC_RELAXED, __HIP_MEMORY_SCOPE_AGENT);
    __syncthreads();
    if (tid == 0) { int s = 0, t = 0; for (int e = 0; e < 32; ++e) { eb[e] = s; tb[e] = t; s += cn[e]; t += (cn[e] + 255) >> 8; } eb[32] = s; tb[32] = t; }
    __syncthreads();
    int* TILES = (int*)(p.ws + WS_TILES);
    if (bid == 0) { if (tid < 32) { const int e = tid, n = cn[e]; for (int j = 0; j * 256 < n; ++j) { const int T = tb[e] + j; TILES[4 * T] = e; TILES[4 * T + 1] = eb[e] + 256 * j; TILES[4 * T + 2] = min(256, n - 256 * j); TILES[4 * T + 3] = 0; } }
        if (tid == 0) TILES[4 * MAXTILES] = tb[32]; }
    const int* TOPE = (const int*)(p.ws + WS_TOPE); int* SLOT = (int*)(p.ws + WS_SLOT); int* PERM = (int*)(p.ws + WS_PERM);
    for (int i = bid * 512 + tid; i < NASSIGN; i += nblk * 512) { const int slot = eb[TOPE[i]] + SLOT[i]; SLOT[i] = slot; PERM[slot] = i >> 2; }
}
__device__ __forceinline__ void phase_moe1_s(const P& p, int bid, int nblk) {
    const int tid_ = tid_opaque(); const int wave = tid_ >> 6, lane = tid_ & 63, fr = lane & 15, fq = lane >> 4; unsigned char* ws = p.ws;
    const int* TILES = (const int*)(ws + WS_TILES); const int* PERM = (const int*)(ws + WS_PERM); const int ntiles = TILES[4 * MAXTILES];
    const bf16_t* U2 = (const bf16_t*)(ws + WS_U); bf16_t* ACT = (bf16_t*)(ws + WS_ACT);
    const int total = ntiles * 8 * 64;
    for (int u = bid * 8 + wave; u < total; u += nblk * 8) {
        const int T = u >> 9, rb = (u >> 6) & 7, cb = u & 63; const int e = TILES[4 * T], row0 = TILES[4 * T + 1], nrows = TILES[4 * T + 2];
        if (rb * 32 >= nrows) continue;
        const bf16_t* W = (const bf16_t*)(ws + WS_W1) + (size_t)e * 2048 * 1024;
        const int wrow = 256 * (cb >> 3) + 16 * (cb & 7) + fr;
        const bf16_t* bp0 = W + (size_t)wrow * 1024 + 8 * fq; const bf16_t* bp1 = bp0 + (size_t)128 * 1024;
        const bf16_t* ap[2];
#pragma unroll
        for (int a = 0; a < 2; ++a) { const int lr = min(rb * 32 + 16 * a + fr, nrows - 1); ap[a] = U2 + (size_t)PERM[row0 + lr] * 1024 + 8 * fq; }
        f32x4 acc[2][2];
#pragma unroll
        for (int a = 0; a < 2; ++a) { acc[a][0] = (f32x4){0.f, 0.f, 0.f, 0.f}; acc[a][1] = (f32x4){0.f, 0.f, 0.f, 0.f}; }
        for (int k0 = 0; k0 < 1024; k0 += 32) { const bf16x8 b0 = *(const bf16x8*)(bp0 + k0), b1 = *(const bf16x8*)(bp1 + k0);
#pragma unroll
            for (int a = 0; a < 2; ++a) { const bf16x8 af = *(const bf16x8*)(ap[a] + k0);
                acc[a][0] = __builtin_amdgcn_mfma_f32_16x16x32_bf16(af, b0, acc[a][0], 0, 0, 0); acc[a][1] = __builtin_amdgcn_mfma_f32_16x16x32_bf16(af, b1, acc[a][1], 0, 0, 0); } }
        const int oc = 16 * cb + fr; const float bg = p.exp_b1[e * 2048 + oc], bl = p.exp_b1[e * 2048 + 1024 + oc];
#pragma unroll
        for (int a = 0; a < 2; ++a)
#pragma unroll
            for (int i = 0; i < 4; ++i) { const int lr = rb * 32 + 16 * a + 4 * fq + i; if (lr < nrows) {
                const float zg = fminf(acc[a][0][i] + bg, 7.0f), zl = fminf(fmaxf(acc[a][1][i] + bl, -7.0f), 7.0f);
                const float act = zg * sigmoidf_(1.702f * zg) * (zl + 1.0f);
                ACT[(size_t)(row0 + lr) * 1024 + oc] = (bf16_t)f2bf(act); } }
    }
}
__device__ __forceinline__ void phase_moe2_s(const P& p, int bid, int nblk) {
    const int tid_ = tid_opaque(); const int wave = tid_ >> 6, lane = tid_ & 63, fr = lane & 15, fq = lane >> 4; unsigned char* ws = p.ws;
    const int* TILES = (const int*)(ws + WS_TILES); const int ntiles = TILES[4 * MAXTILES];
    const bf16_t* ACT = (const bf16_t*)(ws + WS_ACT); bf16_t* YS = (bf16_t*)(ws + WS_YS);
    const int total = ntiles * 8 * 32;
    for (int u = bid * 8 + wave; u < total; u += nblk * 8) {
        const int T = u >> 8, rb = (u >> 5) & 7, cb = u & 31; const int e = TILES[4 * T], row0 = TILES[4 * T + 1], nrows = TILES[4 * T + 2];
        if (rb * 32 >= nrows) continue;
        const bf16_t* W = (const bf16_t*)(ws + WS_W2) + (size_t)e * 1024 * 1024;
        const bf16_t* ap[2]; const bf16_t* bp[2];
#pragma unroll
        for (int a = 0; a < 2; ++a) { const int lr = min(rb * 32 + 16 * a + fr, nrows - 1); ap[a] = ACT + (size_t)(row0 + lr) * 1024 + 8 * fq; bp[a] = W + (size_t)(cb * 32 + 16 * a + fr) * 1024 + 8 * fq; }
        f32x4 acc[2][2];
#pragma unroll
        for (int a = 0; a < 2; ++a) { acc[a][0] = (f32x4){0.f, 0.f, 0.f, 0.f}; acc[a][1] = (f32x4){0.f, 0.f, 0.f, 0.f}; }
        for (int k0 = 0; k0 < 1024; k0 += 32) { bf16x8 af[2], bfr[2];
#pragma unroll
            for (int a = 0; a < 2; ++a) { af[a] = *(const bf16x8*)(ap[a] + k0); bfr[a] = *(const bf16x8*)(bp[a] + k0); }
#pragma unroll
            for (int a = 0; a < 2; ++a)
#pragma unroll
                for (int b = 0; b < 2; ++b) acc[a][b] = __builtin_amdgcn_mfma_f32_16x16x32_bf16(af[a], bfr[b], acc[a][b], 0, 0, 0); }
#pragma unroll
        for (int a = 0; a < 2; ++a)
#pragma unroll
            for (int b = 0; b < 2; ++b) { const int oc = cb * 32 + 16 * b + fr; const float bias = p.exp_b2[e * 1024 + oc];
#pragma unroll
                for (int i = 0; i < 4; ++i) { const int lr = rb * 32 + 16 * a + 4 * fq + i; if (lr < nrows) YS[(size_t)(row0 + lr) * 1024 + oc] = (bf16_t)f2bf(acc[a][b][i] + bias); } }
    }
}
__device__ __forceinline__ void phase_final(const P& p, int bid, int nblk) {
    const int tid = tid_opaque(), wave = tid >> 6, lane = tid & 63;
    const float* mod = (const float*)(p.ws + WS_MOD); const int* SLOT = (const int*)(p.ws + WS_SLOT); const float* TOPG = (const float*)(p.ws + WS_TOPG);
    const bf16_t* YS = (const bf16_t*)(p.ws + WS_YS);
    for (int row = bid * 8 + wave; row < NTOK; row += nblk * 8) {
        const int b = row >> 12;
        int sl[4]; float gk[4];
#pragma unroll
        for (int k = 0; k < 4; ++k) { sl[k] = SLOT[row * 4 + k]; gk[k] = TOPG[row * 4 + k]; }
        f32x4* xr = (f32x4*)(p.out + (size_t)row * DM) + lane;
        f32x4 v[4]; float s = 0.f;
#pragma unroll
        for (int j = 0; j < 4; ++j) { const int col = 4 * lane + 256 * j; f32x4 ff = (f32x4){0.f, 0.f, 0.f, 0.f};
#pragma unroll
            for (int k = 0; k < 4; ++k) { const u32x2 w = *((const u32x2*)(YS + (size_t)sl[k] * 1024 + col));
                ff.x += gk[k] * bflo(w.x); ff.y += gk[k] * bfhi(w.x); ff.z += gk[k] * bflo(w.y); ff.w += gk[k] * bfhi(w.y); }
            const f32x4 g2 = *(const f32x4*)(mod + b * 6144 + 5120 + col);
            v[j] = xr[64 * j] * ALPHA + g2 * ff; s += (v[j].x + v[j].y) + (v[j].z + v[j].w); }
        const float mean = wave_sum(s) * (1.f / DM); float s2 = 0.f;
#pragma unroll
        for (int j = 0; j < 4; ++j) { v[j] = v[j] - mean; s2 += (v[j].x * v[j].x + v[j].y * v[j].y) + (v[j].z * v[j].z + v[j].w * v[j].w); }
        const float rstd = 1.f / sqrtf(wave_sum(s2) * (1.f / DM) + LN_EPS);
#pragma unroll
        for (int j = 0; j < 4; ++j) { const int col = 4 * lane + 256 * j; const f32x4 gg = *(const f32x4*)(p.ln2_g + col), bb = *(const f32x4*)(p.ln2_b + col);
            xr[64 * j] = (v[j] * rstd) * gg + bb; }
    }
}

#include <hip/hip_cooperative_groups.h>
namespace cg = cooperative_groups;
constexpr int LDS_BYTES = 147456;
__global__ void __launch_bounds__(512, 2) mega(P p) {
    extern __shared__ __attribute__((aligned(16))) unsigned char lds[];
    const int bid = blockIdx.x, nblk = gridDim.x;
    phase_prologue_a(p, bid, nblk, lds); cg::this_grid().sync();
    phase_prologue_b(p, bid, nblk); cg::this_grid().sync();
    phase_proj_s(p, bid, nblk); phase_ctxkv_s(p, bid, nblk); cg::this_grid().sync();
    phase_rope_s(p, bid, nblk); phase_zstat_s(p, bid, nblk); cg::this_grid().sync();
    phase_gmlp_s(p, bid, nblk, lds); phase_attn_s(p, bid, nblk); cg::this_grid().sync();
    phase_merge_s<0>(p, bid, nblk); cg::this_grid().sync();
    phase_merge_s<1>(p, bid, nblk); cg::this_grid().sync();
    phase_mix_s(p, bid, nblk); cg::this_grid().sync();
    __syncthreads();
    phase_router(p, bid, nblk, lds); cg::this_grid().sync();
    phase_dispatch(p, bid, nblk, lds); cg::this_grid().sync();
    phase_moe1_s(p, bid, nblk); cg::this_grid().sync();
    phase_moe2_s(p, bid, nblk); cg::this_grid().sync();
    phase_final(p, bid, nblk);
}

extern "C" void kernel_launch(void* const* d_in, const int* in_sizes, int n_in, void* d_out, int out_size, void* d_ws, size_t ws_size, hipStream_t stream) {
    static int grid = 0;
    if (grid == 0) {
        if (n_in != 31 || out_size != NTOK * DM || ws_size < WS_END) { fprintf(stderr, "kernel_launch: unexpected sizes n_in %d out %d ws %zu\n", n_in, out_size, ws_size); grid = -1; return; }
        int dev = 0, cus = 0, per_cu = 0;
        if (hipGetDevice(&dev) != hipSuccess || hipDeviceGetAttribute(&cus, hipDeviceAttributeMultiprocessorCount, dev) != hipSuccess) { grid = -1; return; }
        if (hipFuncSetAttribute((const void*)mega, hipFuncAttributeMaxDynamicSharedMemorySize, LDS_BYTES) != hipSuccess) { fprintf(stderr, "kernel_launch: hipFuncSetAttribute failed\n"); grid = -1; return; }
        if (hipOccupancyMaxActiveBlocksPerMultiprocessor(&per_cu, (const void*)mega, 512, LDS_BYTES) != hipSuccess || per_cu < 1) { fprintf(stderr, "kernel_launch: occupancy query failed (%d)\n", per_cu); grid = -1; return; }
        grid = cus * 1;
    }
    if (grid < 0) return;
    P p{};
    const float** pp = (const float**)&p;
    for (int i = 0; i < 31; ++i) pp[i] = (const float*)d_in[i];
    p.out = (float*)d_out; p.ws = (unsigned char*)d_ws; p.ph_lo = 0; p.ph_hi = 0;
    if (hipMemsetAsync((char*)d_ws + WS_CTL, 0, 1 * MiB, stream) != hipSuccess) { fprintf(stderr, "kernel_launch: memset failed\n"); return; }
    void* args[] = {&p};
    hipError_t e = hipLaunchCooperativeKernel((const void*)mega, dim3(grid), dim3(512), args, LDS_BYTES, stream);
    if (e != hipSuccess) fprintf(stderr, "cooperative launch failed: %s (grid %d)\n", hipGetErrorString(e), grid);
}
```

```cpp
#include <hip/hip_runtime.h>
#include <cstdio>
#include <cstdint>

typedef unsigned short bf16_t;
typedef short bf16x8 __attribute__((ext_vector_type(8)));
typedef float f32x4 __attribute__((ext_vector_type(4)));
typedef unsigned u32x4 __attribute__((ext_vector_type(4)));
typedef unsigned u32x2 __attribute__((ext_vector_type(2)));

constexpr int DM = 1024, NB = 8, SEQ = 4096, NTOK = NB * SEQ, CTXL = 256, NCTX = NB * CTXL, INW = 7168;
constexpr int NE = 32, TOPK = 4, FF = 1024, NASSIGN = NTOK * TOPK;
constexpr int NHEAD = 16, HD = 64, GW = 64;
constexpr float LN_EPS = 1e-5f;
constexpr float ALPHA = 1.189207115002721f;
constexpr int MAXTILES = NASSIGN / 256 + NE;

constexpr size_t MiB = 1u << 20;
constexpr size_t WS_CTL = 0;
constexpr size_t WS_MOD = 1 * MiB;
constexpr size_t WS_ROPE = 1 * MiB + 512 * 1024;
constexpr size_t WS_ROWSTAT = 2 * MiB;
constexpr size_t WS_ZSTAT = 2 * MiB + 512 * 1024;
constexpr size_t WS_TOPE = 3 * MiB;
constexpr size_t WS_TOPG = 4 * MiB;
constexpr size_t WS_SLOT = 5 * MiB;
constexpr size_t WS_PERM = 6 * MiB;
constexpr size_t WS_TILES = 7 * MiB;
constexpr size_t WS_WIN = 8 * MiB;
constexpr size_t WS_WPA = 22 * MiB, WS_WPB = 24 * MiB, WS_WOUT = 26 * MiB, WS_WSB = 28 * MiB;
constexpr size_t WS_KC = 30 * MiB;
constexpr size_t WS_VCT = 34 * MiB;
constexpr size_t WS_UC = 38 * MiB;
constexpr size_t WS_W1 = 48 * MiB;
constexpr size_t WS_W2 = 176 * MiB;
constexpr size_t WS_U = 240 * MiB;
constexpr size_t WS_ZU = 304 * MiB;
constexpr size_t WS_ZVT = 368 * MiB;
constexpr size_t WS_Q = 432 * MiB;
constexpr size_t WS_K = 496 * MiB;
constexpr size_t WS_VT = 560 * MiB;
constexpr size_t WS_G = 624 * MiB;
constexpr size_t WS_YB = 752 * MiB;
constexpr size_t WS_INNER = 816 * MiB;
constexpr size_t WS_ACT = WS_ZU;
constexpr size_t WS_YS = WS_G;
constexpr size_t WS_END = 880 * MiB;

struct P {
    const float *x, *c, *ctx, *c_ctx, *ln_x_g, *ln_x_b, *ln_ctx_g, *ln_ctx_b, *w_ada, *b_ada, *w_in, *b_in, *gmlp_ln_g, *gmlp_ln_b, *gmlp_ws, *gmlp_bs,
        *na_rpb, *w_pa, *w_pb, *w_out, *b_out, *ln1_g, *ln1_b, *ln2_g, *ln2_b, *router_w, *router_b, *exp_w1, *exp_b1, *exp_w2, *exp_b2;
    float* out; unsigned char* ws; int ph_lo, ph_hi;
};

__device__ __forceinline__ int tid_opaque() { int t = threadIdx.x; asm volatile("" : "+v"(t)); return t; }
__device__ __forceinline__ unsigned f2bf(float f) { unsigned u = __builtin_bit_cast(unsigned, f); return (u + 0x7fffu + ((u >> 16) & 1u)) >> 16; }
__device__ __forceinline__ unsigned pk2(float lo, float hi) { return f2bf(lo) | (f2bf(hi) << 16); }
__device__ __forceinline__ float bf2f(unsigned h) { return __builtin_bit_cast(float, (h & 0xffffu) << 16); }
__device__ __forceinline__ float bflo(unsigned w) { return __builtin_bit_cast(float, w << 16); }
__device__ __forceinline__ float bfhi(unsigned w) { return __builtin_bit_cast(float, w & 0xffff0000u); }
__device__ __forceinline__ float wave_sum(float v) {
#pragma unroll
    for (int o = 1; o < 64; o <<= 1) v += __shfl_xor(v, o);
    return v;
}
__device__ __forceinline__ float wave_max(float v) {
#pragma unroll
    for (int o = 1; o < 64; o <<= 1) v = fmaxf(v, __shfl_xor(v, o));
    return v;
}
__device__ __forceinline__ float gelu_exact(float v) { return 0.5f * v * (1.0f + erff(v * 0.70710678118654752f)); }
__device__ __forceinline__ float sigmoidf_(float v) { return 1.0f / (1.0f + __expf(-v)); }

__device__ __forceinline__ void mod_item(const P& p, int item, float* red  ) {
    const int tid = tid_opaque(), wave = tid >> 6, lane = tid & 63;
    const int col = item * 32 + (lane & 31), kpar = lane >> 5;
    float acc[9];
#pragma unroll
    for (int r = 0; r < 9; ++r) acc[r] = 0.f;
    for (int kk = 0; kk < 64; ++kk) {
        const int k = wave * 128 + kk * 2 + kpar;
        const float w = p.w_ada[(size_t)k * 6144 + col];
#pragma unroll
        for (int r = 0; r < 9; ++r) { const float cv = (r < 8) ? p.c[r * 1024 + k] : p.c_ctx[k]; const float s = cv / (1.0f + __expf(-cv)); acc[r] += s * w; }
    }
#pragma unroll
    for (int r = 0; r < 9; ++r) red[((wave * 2 + kpar) * 9 + r) * 32 + (lane & 31)] = acc[r];
    __syncthreads();
    if (tid < 288) {
        const int r = tid >> 5, cc = tid & 31; float s = 0.f;
#pragma unroll
        for (int q = 0; q < 16; ++q) s += red[(q * 9 + r) * 32 + cc];
        ((float*)(p.ws + WS_MOD))[r * 6144 + item * 32 + cc] = s + p.b_ada[item * 32 + cc];
    }
    __syncthreads();
}
__device__ __forceinline__ void transpose_item(const float* W, int K, int N, bf16_t* WT, int k0, int n0, int drow0, float* scr, int lane) {
#pragma unroll 8
    for (int i = 0; i < 32; ++i) { const int kk = 2 * i + (lane >> 5); scr[kk * 33 + (lane & 31)] = W[(size_t)(k0 + kk) * N + n0 + (lane & 31)]; }
    __builtin_amdgcn_wave_barrier();
    asm volatile("s_waitcnt lgkmcnt(0)" ::: "memory");
    const int c = lane & 7;
#pragma unroll
    for (int j = 0; j < 4; ++j) { const int n = (lane >> 3) + 8 * j; const float* s = scr + (8 * c) * 33 + n;
        u32x4 o; o.x = pk2(s[0 * 33], s[1 * 33]); o.y = pk2(s[2 * 33], s[3 * 33]); o.z = pk2(s[4 * 33], s[5 * 33]); o.w = pk2(s[6 * 33], s[7 * 33]);
        *(u32x4*)(WT + (size_t)(drow0 + n) * K + k0 + 8 * c) = o; }
    asm volatile("s_waitcnt lgkmcnt(0)" ::: "memory");
    __builtin_amdgcn_wave_barrier();
}
constexpr int IT_WIN = 16 * 224, IT_SQ = 16 * 32, IT_W1 = 32 * 16 * 64, IT_W2 = 32 * 16 * 32, IT_WS = 32;
constexpr int IT_TOTAL = IT_WIN + 3 * IT_SQ + IT_W1 + IT_W2 + IT_WS;
__device__ __forceinline__ void convert_item(const P& p, int it, float* scr, int lane) {
    unsigned char* ws = p.ws;
    if (it < IT_WIN) { const int kb = it / 224, nb = it % 224; transpose_item(p.w_in, 1024, INW, (bf16_t*)(ws + WS_WIN), kb * 64, nb * 32, nb * 32, scr, lane); return; } it -= IT_WIN;
    if (it < IT_SQ) { const int kb = it / 32, nb = it % 32; transpose_item(p.w_pa, 1024, 1024, (bf16_t*)(ws + WS_WPA), kb * 64, nb * 32, nb * 32, scr, lane); return; } it -= IT_SQ;
    if (it < IT_SQ) { const int kb = it / 32, nb = it % 32; transpose_item(p.w_pb, 1024, 1024, (bf16_t*)(ws + WS_WPB), kb * 64, nb * 32, nb * 32, scr, lane); return; } it -= IT_SQ;
    if (it < IT_SQ) { const int kb = it / 32, nb = it % 32; transpose_item(p.w_out, 1024, 1024, (bf16_t*)(ws + WS_WOUT), kb * 64, nb * 32, nb * 32, scr, lane); return; } it -= IT_SQ;
    if (it < IT_W1) { const int e = it / 1024, r = it % 1024, kb = r / 64, nb = r % 64, n0 = nb * 32;
        const int half = n0 >> 10, nn = n0 & 1023, drow0 = (nn >> 7) * 256 + half * 128 + (nn & 127);
        transpose_item(p.exp_w1 + (size_t)e * 1024 * 2048, 1024, 2048, (bf16_t*)(ws + WS_W1) + (size_t)e * 2048 * 1024, kb * 64, n0, drow0, scr, lane); return; } it -= IT_W1;
    if (it < IT_W2) { const int e = it / 512, r = it % 512, kb = r / 32, nb = r % 32;
        transpose_item(p.exp_w2 + (size_t)e * 1024 * 1024, 1024, 1024, (bf16_t*)(ws + WS_W2) + (size_t)e * 1024 * 1024, kb * 64, nb * 32, nb * 32, scr, lane); return; } it -= IT_W2;
    { bf16_t* o = (bf16_t*)(ws + WS_WSB); const float* s = p.gmlp_ws + it * 4096;
      for (int i = lane; i < 4096; i += 64) o[it * 4096 + i] = (bf16_t)f2bf(s[i]); }
}
__device__ __forceinline__ void phase_prologue_a(const P& p, int bid, int nblk, unsigned char* lds) {
    const int tid = tid_opaque(), wave = tid >> 6, lane = tid & 63;
    for (int item = bid; item < 192; item += nblk) mod_item(p, item, (float*)lds);
    if (bid == nblk - 1) {
        for (int i = tid; i < 1024; i += 512) { const int pos = i >> 4, fi = i & 15;
            const float inv = __builtin_amdgcn_exp2f(-(float)fi * (13.287712379549449f / 16.0f));
            const float ang = (float)pos * inv; const float rev = ang * 0.15915494309189535f;
            float* t = (float*)(p.ws + WS_ROPE); t[2 * i] = __builtin_amdgcn_cosf(rev); t[2 * i + 1] = __builtin_amdgcn_sinf(rev); }
    }
    __syncthreads();
    float* scr = (float*)lds + wave * (64 * 33 + 32);
    const int gw = bid * 8 + wave, ngw = nblk * 8;
    for (int it = gw; it < IT_TOTAL; it += ngw) convert_item(p, it, scr, lane);
}
__device__ __forceinline__ void ln_mod_row(const float* xrow, const float* g, const float* b, const float* sh, const float* sc, bf16_t* orow, float* stat, int lane) {
    const f32x4* xr = (const f32x4*)xrow + lane;
    f32x4 v[4]; float s = 0.f;
#pragma unroll
    for (int j = 0; j < 4; ++j) { v[j] = xr[64 * j]; s += (v[j].x + v[j].y) + (v[j].z + v[j].w); }
    const float mean = wave_sum(s) * (1.f / DM); float s2 = 0.f;
#pragma unroll
    for (int j = 0; j < 4; ++j) { v[j] = v[j] - mean; s2 += (v[j].x * v[j].x + v[j].y * v[j].y) + (v[j].z * v[j].z + v[j].w * v[j].w); }
    const float rstd = 1.f / sqrtf(wave_sum(s2) * (1.f / DM) + LN_EPS);
    if (stat && lane == 0) { stat[0] = mean; stat[1] = rstd; }
    u32x2* o8 = (u32x2*)orow + lane;
#pragma unroll
    for (int j = 0; j < 4; ++j) { const int col = 4 * lane + 256 * j;
        const f32x4 gg = *(const f32x4*)(g + col), bb = *(const f32x4*)(b + col), shv = *(const f32x4*)(sh + col), scv = *(const f32x4*)(sc + col);
        f32x4 y = (v[j] * rstd) * gg + bb; y = y * (1.0f + scv) + shv;
        u32x2 w; w.x = pk2(y.x, y.y); w.y = pk2(y.z, y.w); o8[64 * j] = w; }
}
__device__ __forceinline__ void phase_prologue_b(const P& p, int bid, int nblk) {
    const int tid = tid_opaque(), wave = tid >> 6, lane = tid & 63;
    const int gw = bid * 8 + wave, ngw = nblk * 8;
    const float* mod = (const float*)(p.ws + WS_MOD);
    for (int row = gw; row < NTOK + NCTX; row += ngw) {
        if (row < NTOK) { const int b = row >> 12;
            ln_mod_row(p.x + (size_t)row * DM, p.ln_x_g, p.ln_x_b, mod + b * 6144, mod + b * 6144 + 1024, (bf16_t*)(p.ws + WS_U) + (size_t)row * DM, (float*)(p.ws + WS_ROWSTAT) + 2 * row, lane);
        } else { const int r = row - NTOK;
            ln_mod_row(p.ctx + (size_t)r * DM, p.ln_ctx_g, p.ln_ctx_b, mod + 8 * 6144, mod + 8 * 6144 + 1024, (bf16_t*)(p.ws + WS_UC) + (size_t)r * DM, nullptr, lane); }
    }
}

template <class ARow, class BRow, class Epi>
__device__ __forceinline__ void sgemm_wave_tile(int r0, int n0, int K, const ARow& arow, const BRow& brow, const Epi& epi, int lane) {
    const int fr = lane & 15, fq = lane >> 4;
    f32x4 acc[2][2];
#pragma unroll
    for (int a = 0; a < 2; ++a)
#pragma unroll
        for (int b = 0; b < 2; ++b) acc[a][b] = (f32x4){0.f, 0.f, 0.f, 0.f};
    const bf16_t* ap[2]; const bf16_t* bp[2];
#pragma unroll
    for (int a = 0; a < 2; ++a) { ap[a] = arow(r0 + 16 * a + fr) + 8 * fq; bp[a] = brow(n0 + 16 * a + fr) + 8 * fq; }
    for (int k0 = 0; k0 < K; k0 += 32) {
        bf16x8 af[2], bfr[2];
#pragma unroll
        for (int a = 0; a < 2; ++a) { af[a] = *(const bf16x8*)(ap[a] + k0); bfr[a] = *(const bf16x8*)(bp[a] + k0); }
#pragma unroll
        for (int a = 0; a < 2; ++a)
#pragma unroll
            for (int b = 0; b < 2; ++b) acc[a][b] = __builtin_amdgcn_mfma_f32_16x16x32_bf16(af[a], bfr[b], acc[a][b], 0, 0, 0);
    }
#pragma unroll
    for (int a = 0; a < 2; ++a)
#pragma unroll
        for (int b = 0; b < 2; ++b)
#pragma unroll
            for (int i = 0; i < 4; ++i) epi(r0 + 16 * a + 4 * fq + i, n0 + 16 * b + fr, acc[a][b][i]);
}

struct ARowDense { const bf16_t* A; int lda; __device__ __forceinline__ const bf16_t* operator()(int r) const { return A + (size_t)r * lda; } };
struct EpiProj {
    const float* b_in; bf16_t *ZU, *ZVT, *Q, *K, *VT, *G;
    __device__ __forceinline__ void operator()(int r, int n, float v) const {
        v += b_in[n];
        if (n < 1024) ZU[(size_t)r * 1024 + n] = (bf16_t)f2bf(gelu_exact(v));
        else if (n < 2048) ZVT[(size_t)(n - 1024) * NTOK + r] = (bf16_t)f2bf(gelu_exact(v));
        else if (n < 3072) Q[(size_t)r * 1024 + (n - 2048)] = (bf16_t)f2bf(v);
        else if (n < 4096) K[(size_t)r * 1024 + (n - 3072)] = (bf16_t)f2bf(v);
        else if (n < 5120) VT[(size_t)(n - 4096) * NTOK + r] = (bf16_t)f2bf(v);
        else G[(size_t)r * 2048 + (n - 5120)] = (bf16_t)f2bf(sigmoidf_(v));
    }
};
__device__ __forceinline__ void phase_proj_s(const P& p, int bid, int nblk) {
    const int tid_ = tid_opaque(); const int wave = tid_ >> 6, lane = tid_ & 63; unsigned char* ws = p.ws;
    ARowDense ar{(const bf16_t*)(ws + WS_U), 1024}, br{(const bf16_t*)(ws + WS_WIN), 1024};
    EpiProj e{p.b_in, (bf16_t*)(ws + WS_ZU), (bf16_t*)(ws + WS_ZVT), (bf16_t*)(ws + WS_Q), (bf16_t*)(ws + WS_K), (bf16_t*)(ws + WS_VT), (bf16_t*)(ws + WS_G)};
    const int ntn = INW / 32, ntiles = (NTOK / 32) * ntn;
    for (int t = bid * 8 + wave; t < ntiles; t += nblk * 8) sgemm_wave_tile((t / ntn) * 32, (t % ntn) * 32, 1024, ar, br, e, lane);
}
struct EpiCtxKV {
    const float* b_in; bf16_t *KC, *VCT;
    __device__ __forceinline__ void operator()(int r, int n, float v) const {
        v += b_in[3072 + n];
        if (n < 1024) KC[(size_t)r * 1024 + n] = (bf16_t)f2bf(v); else VCT[(size_t)(n - 1024) * NCTX + r] = (bf16_t)f2bf(v);
    }
};
__device__ __forceinline__ void phase_ctxkv_s(const P& p, int bid, int nblk) {
    const int tid_ = tid_opaque(); const int wave = tid_ >> 6, lane = tid_ & 63; unsigned char* ws = p.ws;
    ARowDense ar{(const bf16_t*)(ws + WS_UC), 1024}, br{(const bf16_t*)(ws + WS_WIN) + (size_t)3072 * 1024, 1024};
    EpiCtxKV e{p.b_in, (bf16_t*)(ws + WS_KC), (bf16_t*)(ws + WS_VCT)};
    const int ntn = 2048 / 32, ntiles = (NCTX / 32) * ntn;
    for (int t = bid * 8 + wave; t < ntiles; t += nblk * 8) sgemm_wave_tile((t / ntn) * 32, (t % ntn) * 32, 1024, ar, br, e, lane);
}
__device__ __forceinline__ void phase_rope_s(const P& p, int bid, int nblk) {
    bf16_t* K = (bf16_t*)(p.ws + WS_K); const float* tab = (const float*)(p.ws + WS_ROPE);
    const size_t total = (size_t)NTOK * NHEAD * 32;
    const int tid_ = tid_opaque();
    for (size_t i = (size_t)bid * 512 + tid_; i < total; i += (size_t)nblk * 512) {
        const int pi = (int)(i & 31), h = (int)((i >> 5) & 15), t = (int)(i >> 9);
        const int pos = t & 4095, axis = pi >> 4, fi = pi & 15, ps = axis ? (pos & 63) : (pos >> 6);
        const float cs = tab[2 * (ps * 16 + fi)], sn = tab[2 * (ps * 16 + fi) + 1];
        bf16_t* base = K + (size_t)t * 1024 + h * 64 + axis * 32 + fi;
        const float x1 = bf2f(base[0]), x2 = bf2f(base[16]);
        base[0] = (bf16_t)f2bf(x1 * cs - x2 * sn); base[16] = (bf16_t)f2bf(x2 * cs + x1 * sn);
    }
}
__device__ __forceinline__ void phase_zstat_s(const P& p, int bid, int nblk) {
    const bf16_t* ZVT = (const bf16_t*)(p.ws + WS_ZVT); float* zs = (float*)(p.ws + WS_ZSTAT);
    const int tid_ = tid_opaque();
    for (int t = bid * 512 + tid_; t < NTOK; t += nblk * 512) {
        float s = 0.f, s2 = 0.f;
        for (int c = 0; c < 1024; ++c) { const float v = bf2f(ZVT[(size_t)c * NTOK + t]); s += v; s2 += v * v; }
        const float mean = s * (1.f / 1024.f); const float var = fmaxf(s2 * (1.f / 1024.f) - mean * mean, 0.f);
        zs[2 * t] = mean; zs[2 * t + 1] = 1.f / sqrtf(var + LN_EPS);
    }
}
__device__ __forceinline__ void phase_gmlp_s(const P& p, int bid, int nblk, unsigned char* lds) {
    float* zvn = (float*)lds;
    float* wsm = zvn + 128 * 128;
    const bf16_t* ZVT = (const bf16_t*)(p.ws + WS_ZVT); const bf16_t* ZU = (const bf16_t*)(p.ws + WS_ZU); const float* zs = (const float*)(p.ws + WS_ZSTAT);
    bf16_t* YA = (bf16_t*)(p.ws + WS_U);
    const int tid = tid_opaque();
    for (int item = bid; item < (NTOK / 128) * 8; item += nblk) {
        const int chunk = item >> 3, g = item & 7, tok0 = chunk * 128;
        __syncthreads();
        for (int i = tid; i < 128 * 128; i += 512) { const int c = i >> 7, q = i & 127; const int ch = g * 128 + c;
            const float v = bf2f(ZVT[(size_t)ch * NTOK + tok0 + q]);
            zvn[q * 128 + c] = (v - zs[2 * (tok0 + q)]) * zs[2 * (tok0 + q) + 1] * p.gmlp_ln_g[ch] + p.gmlp_ln_b[ch];
            wsm[i] = p.gmlp_ws[g * 16384 + i]; }
        __syncthreads();
        const int c = tid & 127, pq = tid >> 7;
        for (int pp = 0; pp < 32; ++pp) { const int pr = pq * 32 + pp; float acc = 0.f;
            for (int q = 0; q < 128; ++q) acc += wsm[pr * 128 + q] * zvn[q * 128 + c];
            acc += p.gmlp_bs[g * 128 + pr];
            const size_t o = (size_t)(tok0 + pr) * 1024 + g * 128 + c;
            YA[o] = (bf16_t)f2bf(bf2f(ZU[o]) * acc); }
    }
}
__device__ __forceinline__ bf16x8 pack8(const float (&v)[8]) { u32x4 w; w.x = pk2(v[0], v[1]); w.y = pk2(v[2], v[3]); w.z = pk2(v[4], v[5]); w.w = pk2(v[6], v[7]); return __builtin_bit_cast(bf16x8, w); }
__device__ __forceinline__ void attn_wave_unit(const P& p, int b, int r, int j, int h, int lane) {
    const int fr = lane & 15, fq = lane >> 4;
    const bf16_t* Q = (const bf16_t*)(p.ws + WS_Q); const bf16_t* K = (const bf16_t*)(p.ws + WS_K); const bf16_t* VT = (const bf16_t*)(p.ws + WS_VT);
    const bf16_t* KC = (const bf16_t*)(p.ws + WS_KC); const bf16_t* VCT = (const bf16_t*)(p.ws + WS_VCT); const float* tab = (const float*)(p.ws + WS_ROPE);
    bf16_t* YB = (bf16_t*)(p.ws + WS_YB);
    const int qc = 16 * j + fr; const size_t tq = (size_t)b * SEQ + r * 64 + qc;
    const int r0 = min(max(r - 4, 0), 56), c0 = min(max(qc - 8, 0), 48), cs = min(max(16 * j - 8, 0), 32);
    bf16x8 qpl[2], qrt[2];
#pragma unroll
    for (int s = 0; s < 2; ++s) {
        const bf16_t* qb = Q + tq * 1024 + h * 64 + 32 * s;
        const bf16x8 me = *(const bf16x8*)(qb + 8 * fq), ot = *(const bf16x8*)(qb + 8 * (fq ^ 2));
        qpl[s] = me;
        const int pos = s ? qc : r; const float* tb = tab + (pos * 16 + 8 * (fq & 1)) * 2;
        float rot[8];
#pragma unroll
        for (int jj = 0; jj < 8; ++jj) { const float cv = tb[2 * jj], sv = tb[2 * jj + 1];
            const float xv = bf2f((unsigned)(unsigned short)me[jj]), ov = bf2f((unsigned)(unsigned short)ot[jj]);
            rot[jj] = (fq < 2) ? (xv * cv - ov * sv) : (xv * cv + ov * sv); }
        qrt[s] = pack8(rot);
    }
    const int sp0 = 8 * (fr >> 2) + (fr & 3);
    float sc[8][8];
#pragma unroll
    for (int st = 0; st < 8; ++st) { const int kr = r0 + st; const size_t tok0 = (size_t)b * SEQ + kr * 64 + cs;
#pragma unroll
        for (int t = 0; t < 2; ++t) { const bf16_t* kp = K + (tok0 + sp0 + 4 * t) * 1024 + h * 64 + 8 * fq;
            f32x4 d = __builtin_amdgcn_mfma_f32_16x16x32_bf16(*(const bf16x8*)kp, qrt[0], (f32x4){0.f, 0.f, 0.f, 0.f}, 0, 0, 0);
            d = __builtin_amdgcn_mfma_f32_16x16x32_bf16(*(const bf16x8*)(kp + 32), qrt[1], d, 0, 0, 0);
#pragma unroll
            for (int i = 0; i < 4; ++i) { const int kc = cs + 8 * fq + 4 * t + i; const bool valid = (kc >= c0) && (kc < c0 + 16);
                float bias = 0.f; if (valid) bias = p.na_rpb[(h * 15 + (kr - r + 7)) * 31 + (kc - qc + 15)];
                sc[st][4 * t + i] = valid ? (d[i] * 0.125f + bias) : -INFINITY; } } }
    float m = -INFINITY;
#pragma unroll
    for (int st = 0; st < 8; ++st)
#pragma unroll
        for (int e = 0; e < 8; ++e) m = fmaxf(m, sc[st][e]);
    m = fmaxf(m, __shfl_xor(m, 16)); m = fmaxf(m, __shfl_xor(m, 32));
    float l = 0.f; f32x4 o[4];
#pragma unroll
    for (int dt = 0; dt < 4; ++dt) o[dt] = (f32x4){0.f, 0.f, 0.f, 0.f};
#pragma unroll
    for (int st = 0; st < 8; ++st) { const int kr = r0 + st; const size_t tok0 = (size_t)b * SEQ + kr * 64 + cs;
        float pv[8];
#pragma unroll
        for (int e = 0; e < 8; ++e) { pv[e] = __expf(sc[st][e] - m); l += pv[e]; }
        const bf16x8 pf = pack8(pv);
#pragma unroll
        for (int dt = 0; dt < 4; ++dt) { const bf16x8 vf = *(const bf16x8*)(VT + (size_t)(h * 64 + 16 * dt + fr) * NTOK + tok0 + 8 * fq);
            o[dt] = __builtin_amdgcn_mfma_f32_16x16x32_bf16(vf, pf, o[dt], 0, 0, 0); } }
#pragma unroll
    for (int st = 0; st < 8; ++st) { const size_t tok0 = (size_t)b * CTXL + 32 * st;
#pragma unroll
        for (int t = 0; t < 2; ++t) { const bf16_t* kp = KC + (tok0 + sp0 + 4 * t) * 1024 + h * 64 + 8 * fq;
            f32x4 d = __builtin_amdgcn_mfma_f32_16x16x32_bf16(*(const bf16x8*)kp, qpl[0], (f32x4){0.f, 0.f, 0.f, 0.f}, 0, 0, 0);
            d = __builtin_amdgcn_mfma_f32_16x16x32_bf16(*(const bf16x8*)(kp + 32), qpl[1], d, 0, 0, 0);
#pragma unroll
            for (int i = 0; i < 4; ++i) sc[st][4 * t + i] = d[i] * 0.125f; } }
    float m2 = -INFINITY;
#pragma unroll
    for (int st = 0; st < 8; ++st)
#pragma unroll
        for (int e = 0; e < 8; ++e) m2 = fmaxf(m2, sc[st][e]);
    m2 = fmaxf(m2, __shfl_xor(m2, 16)); m2 = fmaxf(m2, __shfl_xor(m2, 32));
    const float mn = fmaxf(m, m2), al = __expf(m - mn);
    l *= al;
#pragma unroll
    for (int dt = 0; dt < 4; ++dt) o[dt] = o[dt] * al;
#pragma unroll
    for (int st = 0; st < 8; ++st) { const size_t tok0 = (size_t)b * CTXL + 32 * st;
        float pv[8];
#pragma unroll
        for (int e = 0; e < 8; ++e) { pv[e] = __expf(sc[st][e] - mn); l += pv[e]; }
        const bf16x8 pf = pack8(pv);
#pragma unroll
        for (int dt = 0; dt < 4; ++dt) { const bf16x8 vf = *(const bf16x8*)(VCT + (size_t)(h * 64 + 16 * dt + fr) * NCTX + tok0 + 8 * fq);
            o[dt] = __builtin_amdgcn_mfma_f32_16x16x32_bf16(vf, pf, o[dt], 0, 0, 0); } }
    l += __shfl_xor(l, 16); l += __shfl_xor(l, 32);
    const float inv = 1.0f / l;
#pragma unroll
    for (int dt = 0; dt < 4; ++dt) { u32x2 w; w.x = pk2(o[dt][0] * inv, o[dt][1] * inv); w.y = pk2(o[dt][2] * inv, o[dt][3] * inv);
        *(u32x2*)(YB + tq * 1024 + h * 64 + 16 * dt + 4 * fq) = w; }
}
__device__ __forceinline__ void phase_attn_s(const P& p, int bid, int nblk) {
    const int tid_ = tid_opaque(); const int wave = tid_ >> 6, lane = tid_ & 63;
    for (int bu = bid; bu < NB * 64 * 8; bu += nblk) { const int hp = bu & 7, r = (bu >> 3) & 63, b = bu >> 9;
        attn_wave_unit(p, b, r, wave & 3, 2 * hp + (wave >> 2), lane); }
}
struct EpiMergeA { const bf16_t* G; bf16_t* INNER;
    __device__ __forceinline__ void operator()(int r, int n, float v) const { INNER[(size_t)r * 1024 + n] = (bf16_t)f2bf(bf2f(G[(size_t)r * 2048 + n]) * v); } };
struct EpiMergeB { const bf16_t* G; bf16_t* INNER;
    __device__ __forceinline__ void operator()(int r, int n, float v) const { const size_t o = (size_t)r * 1024 + n; INNER[o] = (bf16_t)f2bf(bf2f(INNER[o]) + bf2f(G[(size_t)r * 2048 + 1024 + n]) * v); } };
template <int WHICH> __device__ __forceinline__ void phase_merge_s(const P& p, int bid, int nblk) {
    const int tid_ = tid_opaque(); const int wave = tid_ >> 6, lane = tid_ & 63; unsigned char* ws = p.ws;
    const int ntn = 1024 / 32, ntiles = (NTOK / 32) * ntn;
    if (WHICH == 0) { ARowDense ar{(const bf16_t*)(ws + WS_U), 1024}, br{(const bf16_t*)(ws + WS_WPA), 1024}; EpiMergeA e{(const bf16_t*)(ws + WS_G), (bf16_t*)(ws + WS_INNER)};
        for (int t = bid * 8 + wave; t < ntiles; t += nblk * 8) sgemm_wave_tile((t / ntn) * 32, (t % ntn) * 32, 1024, ar, br, e, lane);
    } else { ARowDense ar{(const bf16_t*)(ws + WS_YB), 1024}, br{(const bf16_t*)(ws + WS_WPB), 1024}; EpiMergeB e{(const bf16_t*)(ws + WS_G), (bf16_t*)(ws + WS_INNER)};
        for (int t = bid * 8 + wave; t < ntiles; t += nblk * 8) sgemm_wave_tile((t / ntn) * 32, (t % ntn) * 32, 1024, ar, br, e, lane); }
}
struct EpiMix { const float *x, *rowstat, *lng, *lnb, *mod, *b_out; float* out;
    __device__ __forceinline__ void operator()(int r, int n, float v) const {
        const int b = r >> 12; const float x0 = (x[(size_t)r * 1024 + n] - rowstat[2 * r]) * rowstat[2 * r + 1] * lng[n] + lnb[n];
        out[(size_t)r * 1024 + n] = ALPHA * x0 + mod[b * 6144 + 2048 + n] * (v + b_out[n]); } };
__device__ __forceinline__ void phase_mix_s(const P& p, int bid, int nblk) {
    const int tid_ = tid_opaque(); const int wave = tid_ >> 6, lane = tid_ & 63; unsigned char* ws = p.ws;
    const int ntn = 1024 / 32, ntiles = (NTOK / 32) * ntn;
    ARowDense ar{(const bf16_t*)(ws + WS_INNER), 1024}, br{(const bf16_t*)(ws + WS_WOUT), 1024};
    EpiMix e{p.x, (const float*)(ws + WS_ROWSTAT), p.ln_x_g, p.ln_x_b, (const float*)(ws + WS_MOD), p.b_out, p.out};
    for (int t = bid * 8 + wave; t < ntiles; t += nblk * 8) sgemm_wave_tile((t / ntn) * 32, (t % ntn) * 32, 1024, ar, br, e, lane);
}

constexpr int RT_LDS_W = 0, RT_LDS_CNT = 131072, RT_LDS_BASE = RT_LDS_CNT + 128, RT_LDS_REC = RT_LDS_BASE + 128, RT_MAXIT = 32, RT_LDS_END = RT_LDS_REC + 8 * RT_MAXIT * 8 * 4;
__device__ __forceinline__ int rw_off(int prow, int ch) { return prow * 128 + ((ch ^ ((prow >> 1) & 7)) << 4); }
__device__ __forceinline__ void phase_router(const P& p, int bid, int nblk, unsigned char* lds) {
    const int tid = tid_opaque(), wave = tid >> 6, lane = tid & 63;
    int* cnt = (int*)(lds + RT_LDS_CNT); int* base = (int*)(lds + RT_LDS_BASE); int* rec = (int*)(lds + RT_LDS_REC) + wave * RT_MAXIT * 8;
    for (int k = tid; k < 1024; k += 512) { const int l = (k & 255) >> 2, i = k & 3, j = k >> 8, prow = l + 64 * (4 * j + i);
        const f32x4* src = (const f32x4*)(p.router_w + (size_t)k * 32);
#pragma unroll
        for (int ch = 0; ch < 8; ++ch) *(f32x4*)(lds + RT_LDS_W + rw_off(prow, ch)) = src[ch]; }
    if (tid < 32) cnt[tid] = 0;
    __syncthreads();
    const float* mod = (const float*)(p.ws + WS_MOD);
    int* TOPE = (int*)(p.ws + WS_TOPE); float* TOPG = (float*)(p.ws + WS_TOPG); int* SLOT = (int*)(p.ws + WS_SLOT);
    bf16_t* U2 = (bf16_t*)(p.ws + WS_U);
    const int erev = (int)(__builtin_bitreverse32((unsigned)(lane & 31)) >> 27);
    unsigned wb[8];
#pragma unroll
    for (int ch = 0; ch < 8; ++ch) wb[ch] = RT_LDS_W + lane * 128 + ((ch ^ ((lane >> 1) & 7)) << 4);
    int it = 0;
    for (int row = bid * 8 + wave; row < NTOK; row += nblk * 8, ++it) {
        const int b = row >> 12;
        f32x4* xr = (f32x4*)(p.out + (size_t)row * DM) + lane;
        f32x4 v[4]; float s = 0.f;
#pragma unroll
        for (int j = 0; j < 4; ++j) { v[j] = xr[64 * j]; s += (v[j].x + v[j].y) + (v[j].z + v[j].w); }
        const float mean = wave_sum(s) * (1.f / DM); float s2 = 0.f;
#pragma unroll
        for (int j = 0; j < 4; ++j) { v[j] = v[j] - mean; s2 += (v[j].x * v[j].x + v[j].y * v[j].y) + (v[j].z * v[j].z + v[j].w * v[j].w); }
        const float rstd = 1.f / sqrtf(wave_sum(s2) * (1.f / DM) + LN_EPS);
        float a[32];
#pragma unroll
        for (int e = 0; e < 32; ++e) a[e] = 0.f;
        u32x2* o8 = (u32x2*)(U2 + (size_t)row * DM) + lane;
        int lane_o = lane; asm volatile("" : "+v"(lane_o));
#pragma unroll
        for (int j = 0; j < 4; ++j) { const int col = 4 * lane_o + 256 * j;
            const f32x4 gg = *(const f32x4*)(p.ln1_g + col), bb = *(const f32x4*)(p.ln1_b + col);
            const f32x4 shv = *(const f32x4*)(mod + b * 6144 + 3072 + col), scv = *(const f32x4*)(mod + b * 6144 + 4096 + col);
            const f32x4 x1 = (v[j] * rstd) * gg + bb; xr[64 * j] = x1;
            const f32x4 u = x1 * (1.0f + scv) + shv;
            u32x2 w; w.x = pk2(u.x, u.y); w.y = pk2(u.z, u.w); o8[64 * j] = w;
#pragma unroll
            for (int i = 0; i < 4; ++i) { const float uv = u[i];
#pragma unroll
                for (int ch = 0; ch < 8; ++ch) { const f32x4 w4 = *(const f32x4*)(lds + wb[ch] + (4 * j + i) * 8192);
                    a[4 * ch + 0] += uv * w4.x; a[4 * ch + 1] += uv * w4.y; a[4 * ch + 2] += uv * w4.z; a[4 * ch + 3] += uv * w4.w; } }
        }
#pragma unroll
        for (int st = 0; st < 5; ++st) { const int n = 16 >> st; const bool up = (lane >> st) & 1;
#pragma unroll
            for (int i = 0; i < n; ++i) { const float keep = up ? a[n + i] : a[i], send = up ? a[i] : a[n + i]; a[i] = keep + __shfl_xor(send, 1 << st); } }
        float logit = a[0] + __shfl_xor(a[0], 32);
        logit += p.router_b[erev];
        float cur = logit;
#define TOP_STEP(TV, TE) float TV; int TE; { const float mx = wave_max(cur); int cand = (cur == mx) ? erev : 64; \
            cand = min(cand, __shfl_xor(cand, 1)); cand = min(cand, __shfl_xor(cand, 2)); cand = min(cand, __shfl_xor(cand, 4)); \
            cand = min(cand, __shfl_xor(cand, 8)); cand = min(cand, __shfl_xor(cand, 16)); cand = min(cand, __shfl_xor(cand, 32)); \
            TV = mx; TE = cand; if (erev == cand) cur = -INFINITY; }
        TOP_STEP(tv0, te0) TOP_STEP(tv1, te1) TOP_STEP(tv2, te2) TOP_STEP(tv3, te3)
#undef TOP_STEP
        const float gk0 = 1.0f, gk1 = __expf(tv1 - tv0), gk2 = __expf(tv2 - tv0), gk3 = __expf(tv3 - tv0);
        const float ginv = 1.f / (gk0 + gk1 + gk2 + gk3);
        if (lane < 4) { const int e = lane == 0 ? te0 : lane == 1 ? te1 : lane == 2 ? te2 : te3; const float g = lane == 0 ? gk0 : lane == 1 ? gk1 : lane == 2 ? gk2 : gk3;
            const int pos = atomicAdd(&cnt[e], 1);
            TOPE[row * 4 + lane] = e; TOPG[row * 4 + lane] = g * ginv;
            if (it < RT_MAXIT) { rec[it * 8 + lane * 2] = e; rec[it * 8 + lane * 2 + 1] = pos; } }
    }
    __syncthreads();
    if (tid < 32) base[tid] = atomicAdd((int*)(p.ws + WS_CTL) + tid, cnt[tid]);
    __syncthreads();
    it = 0;
    for (int row = bid * 8 + wave; row < NTOK; row += nblk * 8, ++it)
        if (lane < 4 && it < RT_MAXIT) SLOT[row * 4 + lane] = base[rec[it * 8 + lane * 2]] + rec[it * 8 + lane * 2 + 1];
}
__device__ __forceinline__ void phase_dispatch(const P& p, int bid, int nblk, unsigned char* lds) {
    const int tid = tid_opaque(); int* eb = (int*)lds; int* tb = eb + 40; int* cn = tb + 40;
    if (tid < 32) cn[tid] = __hip_atomic_load((int*)(p.ws + WS_CTL) + tid, __ATOMIC_RELAXED, __HIP_MEMORY_SCOPE_AGENT);
    __syncthreads();
    if (tid == 0) { int s = 0, t = 0; for (int e = 0; e < 32; ++e) { eb[e] = s; tb[e] = t; s += cn[e]; t += (cn[e] + 255) >> 8; } eb[32] = s; tb[32] = t; }
    __syncthreads();
    int* TILES = (int*)(p.ws + WS_TILES);
    if (bid == 0) { if (tid < 32) { const int e = tid, n = cn[e]; for (int j = 0; j * 256 < n; ++j) { const int T = tb[e] + j; TILES[4 * T] = e; TILES[4 * T + 1] = eb[e] + 256 * j; TILES[4 * T + 2] = min(256, n - 256 * j); TILES[4 * T + 3] = 0; } }
        if (tid == 0) TILES[4 * MAXTILES] = tb[32]; }
    const int* TOPE = (const int*)(p.ws + WS_TOPE); int* SLOT = (int*)(p.ws + WS_SLOT); int* PERM = (int*)(p.ws + WS_PERM);
    for (int i = bid * 512 + tid; i < NASSIGN; i += nblk * 512) { const int slot = eb[TOPE[i]] + SLOT[i]; SLOT[i] = slot; PERM[slot] = i >> 2; }
}
__device__ __forceinline__ void phase_moe1_s(const P& p, int bid, int nblk) {
    const int tid_ = tid_opaque(); const int wave = tid_ >> 6, lane = tid_ & 63, fr = lane & 15, fq = lane >> 4; unsigned char* ws = p.ws;
    const int* TILES = (const int*)(ws + WS_TILES); const int* PERM = (const int*)(ws + WS_PERM); const int ntiles = TILES[4 * MAXTILES];
    const bf16_t* U2 = (const bf16_t*)(ws + WS_U); bf16_t* ACT = (bf16_t*)(ws + WS_ACT);
    const int total = ntiles * 8 * 64;
    for (int u = bid * 8 + wave; u < total; u += nblk * 8) {
        const int T = u >> 9, rb = (u >> 6) & 7, cb = u & 63; const int e = TILES[4 * T], row0 = TILES[4 * T + 1], nrows = TILES[4 * T + 2];
        if (rb * 32 >= nrows) continue;
        const bf16_t* W = (const bf16_t*)(ws + WS_W1) + (size_t)e * 2048 * 1024;
        const int wrow = 256 * (cb >> 3) + 16 * (cb & 7) + fr;
        const bf16_t* bp0 = W + (size_t)wrow * 1024 + 8 * fq; const bf16_t* bp1 = bp0 + (size_t)128 * 1024;
        const bf16_t* ap[2];
#pragma unroll
        for (int a = 0; a < 2; ++a) { const int lr = min(rb * 32 + 16 * a + fr, nrows - 1); ap[a] = U2 + (size_t)PERM[row0 + lr] * 1024 + 8 * fq; }
        f32x4 acc[2][2];
#pragma unroll
        for (int a = 0; a < 2; ++a) { acc[a][0] = (f32x4){0.f, 0.f, 0.f, 0.f}; acc[a][1] = (f32x4){0.f, 0.f, 0.f, 0.f}; }
        for (int k0 = 0; k0 < 1024; k0 += 32) { const bf16x8 b0 = *(const bf16x8*)(bp0 + k0), b1 = *(const bf16x8*)(bp1 + k0);
#pragma unroll
            for (int a = 0; a < 2; ++a) { const bf16x8 af = *(const bf16x8*)(ap[a] + k0);
                acc[a][0] = __builtin_amdgcn_mfma_f32_16x16x32_bf16(af, b0, acc[a][0], 0, 0, 0); acc[a][1] = __builtin_amdgcn_mfma_f32_16x16x32_bf16(af, b1, acc[a][1], 0, 0, 0); } }
        const int oc = 16 * cb + fr; const float bg = p.exp_b1[e * 2048 + oc], bl = p.exp_b1[e * 2048 + 1024 + oc];
#pragma unroll
        for (int a = 0; a < 2; ++a)
#pragma unroll
            for (int i = 0; i < 4; ++i) { const int lr = rb * 32 + 16 * a + 4 * fq + i; if (lr < nrows) {
                const float zg = fminf(acc[a][0][i] + bg, 7.0f), zl = fminf(fmaxf(acc[a][1][i] + bl, -7.0f), 7.0f);
                const float act = zg * sigmoidf_(1.702f * zg) * (zl + 1.0f);
                ACT[(size_t)(row0 + lr) * 1024 + oc] = (bf16_t)f2bf(act); } }
    }
}
__device__ __forceinline__ void phase_moe2_s(const P& p, int bid, int nblk) {
    const int tid_ = tid_opaque(); const int wave = tid_ >> 6, lane = tid_ & 63, fr = lane & 15, fq = lane >> 4; unsigned char* ws = p.ws;
    const int* TILES = (const int*)(ws + WS_TILES); const int ntiles = TILES[4 * MAXTILES];
    const bf16_t* ACT = (const bf16_t*)(ws + WS_ACT); bf16_t* YS = (bf16_t*)(ws + WS_YS);
    const int total = ntiles * 8 * 32;
    for (int u = bid * 8 + wave; u < total; u += nblk * 8) {
        const int T = u >> 8, rb = (u >> 5) & 7, cb = u & 31; const int e = TILES[4 * T], row0 = TILES[4 * T + 1], nrows = TILES[4 * T + 2];
        if (rb * 32 >= nrows) continue;
        const bf16_t* W = (const bf16_t*)(ws + WS_W2) + (size_t)e * 1024 * 1024;
        const bf16_t* ap[2]; const bf16_t* bp[2];
#pragma unroll
        for (int a = 0; a < 2; ++a) { const int lr = min(rb * 32 + 16 * a + fr, nrows - 1); ap[a] = ACT + (size_t)(row0 + lr) * 1024 + 8 * fq; bp[a] = W + (size_t)(cb * 32 + 16 * a + fr) * 1024 + 8 * fq; }
        f32x4 acc[2][2];
#pragma unroll
        for (int a = 0; a < 2; ++a) { acc[a][0] = (f32x4){0.f, 0.f, 0.f, 0.f}; acc[a][1] = (f32x4){0.f, 0.f, 0.f, 0.f}; }
        for (int k0 = 0; k0 < 1024; k0 += 32) { bf16x8 af[2], bfr[2];
#pragma unroll
            for (int a = 0; a < 2; ++a) { af[a] = *(const bf16x8*)(ap[a] + k0); bfr[a] = *(const bf16x8*)(bp[a] + k0); }
#pragma unroll
            for (int a = 0; a < 2; ++a)
#pragma unroll
                for (int b = 0; b < 2; ++b) acc[a][b] = __builtin_amdgcn_mfma_f32_16x16x32_bf16(af[a], bfr[b], acc[a][b], 0, 0, 0); }
#pragma unroll
        for (int a = 0; a < 2; ++a)
#pragma unroll
            for (int b = 0; b < 2; ++b) { const int oc = cb * 32 + 16 * b + fr; const float bias = p.exp_b2[e * 1024 + oc];
#pragma unroll
                for (int i = 0; i < 4; ++i) { const int lr = rb * 32 + 16 * a + 4 * fq + i; if (lr < nrows) YS[(size_t)(row0 + lr) * 1024 + oc] = (bf16_t)f2bf(acc[a][b][i] + bias); } }
    }
}
__device__ __forceinline__ void phase_final(const P& p, int bid, int nblk) {
    const int tid = tid_opaque(), wave = tid >> 6, lane = tid & 63;
    const float* mod = (const float*)(p.ws + WS_MOD); const int* SLOT = (const int*)(p.ws + WS_SLOT); const float* TOPG = (const float*)(p.ws + WS_TOPG);
    const bf16_t* YS = (const bf16_t*)(p.ws + WS_YS);
    for (int row = bid * 8 + wave; row < NTOK; row += nblk * 8) {
        const int b = row >> 12;
        int sl[4]; float gk[4];
#pragma unroll
        for (int k = 0; k < 4; ++k) { sl[k] = SLOT[row * 4 + k]; gk[k] = TOPG[row * 4 + k]; }
        f32x4* xr = (f32x4*)(p.out + (size_t)row * DM) + lane;
        f32x4 v[4]; float s = 0.f;
#pragma unroll
        for (int j = 0; j < 4; ++j) { const int col = 4 * lane + 256 * j; f32x4 ff = (f32x4){0.f, 0.f, 0.f, 0.f};
#pragma unroll
            for (int k = 0; k < 4; ++k) { const u32x2 w = *((const u32x2*)(YS + (size_t)sl[k] * 1024 + col));
                ff.x += gk[k] * bflo(w.x); ff.y += gk[k] * bfhi(w.x); ff.z += gk[k] * bflo(w.y); ff.w += gk[k] * bfhi(w.y); }
            const f32x4 g2 = *(const f32x4*)(mod + b * 6144 + 5120 + col);
            v[j] = xr[64 * j] * ALPHA + g2 * ff; s += (v[j].x + v[j].y) + (v[j].z + v[j].w); }
        const float mean = wave_sum(s) * (1.f / DM); float s2 = 0.f;
#pragma unroll
        for (int j = 0; j < 4; ++j) { v[j] = v[j] - mean; s2 += (v[j].x * v[j].x + v[j].y * v[j].y) + (v[j].z * v[j].z + v[j].w * v[j].w); }
        const float rstd = 1.f / sqrtf(wave_sum(s2) * (1.f / DM) + LN_EPS);
#pragma unroll
        for (int j = 0; j < 4; ++j) { const int col = 4 * lane + 256 * j; const f32x4 gg = *(const f32x4*)(p.ln2_g + col), bb = *(const f32x4*)(p.ln2_b + col);
            xr[64 * j] = (v[j] * rstd) * gg + bb; }
    }
}

namespace pg {
#define PG_LAS __attribute__((address_space(3)))
typedef float f32x2 __attribute__((ext_vector_type(2)));
constexpr int BM = 256, BK = 64, HALF = 128, HTB = HALF * BK * 2, STAGE_BYTES = 8 * HTB, KD = 1024, NT = KD / BK;
constexpr unsigned KSTEP = BK * 2, HSTEPB = HALF * KD * 2;
__host__ __device__ __forceinline__ int lds_byte(int r, int c) { const int st = (r >> 4) * 2 + (c >> 5), rr = r & 15, cc = c & 31, ob = rr * 64 + cc * 2; return st * 1024 + (ob ^ (((ob >> 9) & 1) << 5)); }
__host__ __device__ __forceinline__ void stage_rc(int b, int& R, int& C) { const int st = b / 1024, sb = b % 1024, swz = sb ^ (((sb >> 9) & 1) << 5); R = (st >> 1) * 16 + swz / 64; C = (st & 1) * 32 + (swz % 64) / 2; }
__host__ __device__ __forceinline__ int perm32(int rho) { const int n = rho >> 4, i = rho & 15; return 8 * (i >> 2) + 4 * n + (i & 3); }
struct Unit { int pm, pn, row0, nrows, e, kind; };
__device__ __forceinline__ void tilemap(int L, int nM, int nN, int& pm, int& pn) {
    int wgid = L; { const int nwg = nM * nN, q = nwg / 8, r = nwg % 8, xcd = wgid % 8, off = wgid / 8; wgid = (xcd < r ? xcd * (q + 1) : r * (q + 1) + (xcd - r) * q) + off; }
    const int nig = 8 * nN, gid = wgid / nig, fm = gid * 8, gsz = (nM - fm) < 8 ? (nM - fm) : 8;
    pm = fm + ((wgid % nig) % gsz); pn = (wgid % nig) / gsz;
}
__device__ __forceinline__ unsigned cvt_pk_bf16(float lo, float hi) { unsigned r; asm volatile("v_cvt_pk_bf16_f32 %0, %1, %2" : "=v"(r) : "v"(lo), "v"(hi)); return r; }
__device__ __forceinline__ f32x2 gelu_pk(f32x2 v) {
    const f32x2 av = __builtin_elementwise_abs(v), d = av * 0.2316418882f + 1.0f;
    f32x2 t; t.x = __builtin_amdgcn_rcpf(d.x); t.y = __builtin_amdgcn_rcpf(d.y);
    f32x2 q = t * 0.5307027145f + (-0.7265760135f); q = q * t + 0.7107068705f; q = q * t + (-0.142248368f); q = q * t + 0.127414796f; q = q * t;
    const f32x2 s = (v * v) * (-0.72134752044f);
    f32x2 e; e.x = __builtin_amdgcn_exp2f(s.x); e.y = __builtin_amdgcn_exp2f(s.y);
    const f32x2 m = v * (q * e), r = v - m;
    f32x2 o; o.x = v.x < 0.f ? m.x : r.x; o.y = v.y < 0.f ? m.y : r.y; return o;
}
__device__ __forceinline__ f32x4 gelu4(f32x4 v) { const f32x2 a = gelu_pk((f32x2){v[0], v[1]}), b = gelu_pk((f32x2){v[2], v[3]}); return (f32x4){a.x, a.y, b.x, b.y}; }
__device__ __forceinline__ f32x4 sigmoid4(f32x4 v) { f32x4 o;
#pragma unroll
    for (int i = 0; i < 4; ++i) o[i] = __builtin_amdgcn_rcpf(1.0f + __builtin_amdgcn_exp2f(-1.4426950408889634f * v[i]));
    return o; }
__device__ __forceinline__ u32x4 pack8v(f32x4 a, f32x4 b) { u32x4 w; w.x = cvt_pk_bf16(a[0], a[1]); w.y = cvt_pk_bf16(a[2], a[3]); w.z = cvt_pk_bf16(b[0], b[1]); w.w = cvt_pk_bf16(b[2], b[3]); return w; }

template <class Epi, class Sched, bool ALIGN_EPI>
__device__ __forceinline__ void gemm_phase(PG_LAS unsigned char* lds, const unsigned char* Abase, const Sched& S, const Epi& E) {
    const int tid = tid_opaque(), wid = __builtin_amdgcn_readfirstlane(tid >> 6), lane = tid & 63, wr = wid >> 2, wc = wid & 3, fr = lane & 15, fq = lane >> 4;
    int R[2], C[2]; unsigned voffB[2];
#pragma unroll
    for (int i = 0; i < 2; ++i) { stage_rc(tid * 16 + i * 8192, R[i], C[i]); const int Rb = Epi::PERM ? ((R[i] & ~31) + perm32(R[i] & 31)) : R[i]; voffB[i] = (unsigned)(Rb * KD + C[i]) * 2u; }
    const unsigned ldsw = (unsigned)wid * 1024u;
    const int aoff = lds_byte(wr * 64 + fr, fq * 8), boff = lds_byte(wc * 32 + fr, fq * 8);
#define PG_SA(b, h) (((b) * 2 + (h)) * HTB)
#define PG_SB(b, h) ((4 + (b) * 2 + (h)) * HTB)
#define PG_STAGE_A(bufoff, kbyte, vo) do { _Pragma("unroll") for (int _i = 0; _i < 2; ++_i) \
        __builtin_amdgcn_global_load_lds((const unsigned*)((const char*)Abase + (kbyte) + (vo)[_i]), (PG_LAS unsigned*)(lds + (bufoff) + ldsw + _i * 8192), 16, 0, 0); } while (0)
#define PG_STAGE_B(bufoff, gbase) do { _Pragma("unroll") for (int _i = 0; _i < 2; ++_i) \
        __builtin_amdgcn_global_load_lds((const unsigned*)((const char*)(gbase) + voffB[_i]), (PG_LAS unsigned*)(lds + (bufoff) + ldsw + _i * 8192), 16, 0, 0); } while (0)
#define PG_LDA(dst, b, h) do { _Pragma("unroll") for (int m = 0; m < 4; ++m) _Pragma("unroll") for (int k = 0; k < 2; ++k) dst[m][k] = *(const PG_LAS bf16x8*)(lds + PG_SA(b, h) + aoff + m * 2048 + k * 1024); } while (0)
#define PG_LDB(dst, b, h) do { _Pragma("unroll") for (int n = 0; n < 2; ++n) _Pragma("unroll") for (int k = 0; k < 2; ++k) dst[n][k] = *(const PG_LAS bf16x8*)(lds + PG_SB(b, h) + boff + n * 2048 + k * 1024); } while (0)
#define PG_MMA(ai, bj, At, Bt) do { __builtin_amdgcn_s_setprio(1); _Pragma("unroll") for (int m = 0; m < 4; ++m) _Pragma("unroll") for (int n = 0; n < 2; ++n) _Pragma("unroll") for (int k = 0; k < 2; ++k) \
        acc[ai][bj][m][n] = __builtin_amdgcn_mfma_f32_16x16x32_bf16(Bt[n][k], At[m][k], acc[ai][bj][m][n], 0, 0, 0); __builtin_amdgcn_s_setprio(0); } while (0)
#define PG_WAIT_V(n) asm volatile("s_waitcnt vmcnt(" #n ")" ::: "memory")
#define PG_WAIT_L(n) asm volatile("s_waitcnt lgkmcnt(" #n ")" ::: "memory")
#define PG_BAR __builtin_amdgcn_s_barrier()
#define PG_SCHED __builtin_amdgcn_sched_barrier(0)
    Unit cur, nxt; int ui = 0;
    if (!S.next(0, cur)) return;
    f32x4 acc[2][2][4][2];
#pragma unroll
    for (int a = 0; a < 2; ++a)
#pragma unroll
        for (int b = 0; b < 2; ++b)
#pragma unroll
            for (int m = 0; m < 4; ++m)
#pragma unroll
                for (int n = 0; n < 2; ++n) acc[a][b][m][n] = (f32x4){0.f, 0.f, 0.f, 0.f};
    bf16x8 At[4][2], B0[2][2], B1[2][2];
    unsigned ac[2][2], an[2][2];
    S.aoffs(cur, R, C, ac);
    const char* cB = S.bptr(cur);
    PG_STAGE_B(PG_SB(0, 0), cB); PG_STAGE_B(PG_SB(0, 1), cB + HSTEPB); PG_STAGE_A(PG_SA(0, 0), 0u, ac[0]); PG_STAGE_A(PG_SA(0, 1), 0u, ac[1]);
    if (wr == 1) PG_BAR;
    PG_WAIT_V(2); PG_BAR;
    PG_STAGE_B(PG_SB(1, 0), cB + KSTEP); PG_STAGE_A(PG_SA(1, 0), KSTEP, ac[0]); PG_STAGE_B(PG_SB(1, 1), cB + HSTEPB + KSTEP);
    PG_WAIT_V(6); PG_BAR;
    for (;;) {
        const bool has_next = S.next(ui + 1, nxt);
        const char* nB = cB;
        if (has_next) { S.aoffs(nxt, R, C, an); nB = S.bptr(nxt); }
        else {
#pragma unroll
            for (int h = 0; h < 2; ++h)
#pragma unroll
                for (int i = 0; i < 2; ++i) an[h][i] = ac[h][i]; }
        for (int t = 0; t < NT; t += 2) {
            const bool last = (t == NT - 2);
            const unsigned ka1 = (unsigned)(t + 1) * KSTEP;
            const unsigned ka2 = last ? 0u : (unsigned)(t + 2) * KSTEP;
            const char* b2 = last ? nB : cB + (size_t)(t + 2) * KSTEP; const char* b3 = b2 + KSTEP;
            unsigned a2o[2][2];
#pragma unroll
            for (int h = 0; h < 2; ++h)
#pragma unroll
                for (int i = 0; i < 2; ++i) a2o[h][i] = last ? an[h][i] : ac[h][i];
            PG_LDB(B0, 0, 0); PG_LDB(B1, 0, 1); PG_SCHED; PG_LDA(At, 0, 0); PG_STAGE_A(PG_SA(1, 1), ka1, ac[1]);
            PG_WAIT_V(8); PG_WAIT_L(0); PG_BAR; PG_MMA(0, 0, At, B0); PG_MMA(0, 1, At, B1); PG_BAR; PG_SCHED;
            PG_LDA(At, 0, 1); PG_STAGE_B(PG_SB(0, 0), b2); PG_STAGE_B(PG_SB(0, 1), b2 + HSTEPB); PG_STAGE_A(PG_SA(0, 0), ka2, a2o[0]);
            PG_WAIT_V(8); PG_WAIT_L(0); PG_BAR; PG_MMA(1, 0, At, B0); PG_MMA(1, 1, At, B1); PG_BAR; PG_SCHED;
            PG_LDB(B0, 1, 0); PG_LDB(B1, 1, 1); PG_SCHED; PG_LDA(At, 1, 0); PG_STAGE_A(PG_SA(0, 1), ka2, a2o[1]);
            PG_WAIT_V(8); PG_WAIT_L(0); PG_BAR; PG_MMA(0, 0, At, B0); PG_MMA(0, 1, At, B1); PG_BAR; PG_SCHED;
            PG_LDA(At, 1, 1); PG_STAGE_B(PG_SB(1, 0), b3); PG_STAGE_B(PG_SB(1, 1), b3 + HSTEPB); PG_STAGE_A(PG_SA(1, 0), ka2 + KSTEP, a2o[0]);
            PG_WAIT_V(8); PG_WAIT_L(0); PG_BAR; PG_MMA(1, 0, At, B0); PG_MMA(1, 1, At, B1); PG_BAR; PG_SCHED;
        }
        if constexpr (ALIGN_EPI) { if (wr == 0) PG_BAR; }
        E.run(acc, cur, wr, wc, fr, fq);
        if (!has_next) break;
        if (!E.carry(cur)) {
#pragma unroll
            for (int a = 0; a < 2; ++a)
#pragma unroll
                for (int b = 0; b < 2; ++b)
#pragma unroll
                    for (int m = 0; m < 4; ++m)
#pragma unroll
                        for (int n = 0; n < 2; ++n) acc[a][b][m][n] = (f32x4){0.f, 0.f, 0.f, 0.f}; }
        cur = nxt; cB = nB; ++ui;
#pragma unroll
        for (int h = 0; h < 2; ++h)
#pragma unroll
            for (int i = 0; i < 2; ++i) ac[h][i] = an[h][i];
        if constexpr (ALIGN_EPI) { if (wr == 1) PG_BAR; }
    }
    PG_WAIT_V(0);
    if constexpr (!ALIGN_EPI) { if (wr == 0) PG_BAR; }
    PG_BAR;
#undef PG_SA
#undef PG_SB
#undef PG_STAGE_A
#undef PG_STAGE_B
#undef PG_LDA
#undef PG_LDB
#undef PG_MMA
#undef PG_WAIT_V
#undef PG_WAIT_L
#undef PG_BAR
#undef PG_SCHED
}

struct SchedP1 {
    int G, c; const unsigned char* ws;
    __device__ __forceinline__ bool next(int i, Unit& u) const {
        const int L = i * G + c; if (L >= 3136) return false;
        u.row0 = 0; u.nrows = 256; u.e = 0;
        if (L < 2048) { u.kind = 0; tilemap(L, 128, 16, u.pm, u.pn); }
        else if (L < 3072) { u.kind = 1; tilemap(L - 2048, 8, 128, u.pm, u.pn); }
        else if (L < 3104) { u.kind = 2; const int l = L - 3072; u.pm = l >> 2; u.pn = l & 3; }
        else { u.kind = 3; const int l = L - 3104; u.pm = l >> 3; u.pn = l & 7; }
        return true; }
    __device__ __forceinline__ void aoffs(const Unit& u, const int (&R)[2], const int (&C)[2], unsigned (&o)[2][2]) const {
        size_t base; int row0;
        if (u.kind == 0) { base = WS_U; row0 = 256 * u.pm; }
        else if (u.kind == 1) { base = WS_WIN; row0 = u.pm < 4 ? 1024 + 256 * u.pm : 4096 + 256 * (u.pm - 4); }
        else if (u.kind == 2) { base = WS_UC; row0 = 256 * u.pm; }
        else { base = WS_WIN; row0 = 4096 + 256 * u.pm; }
#pragma unroll
        for (int h = 0; h < 2; ++h)
#pragma unroll
            for (int i = 0; i < 2; ++i) o[h][i] = (unsigned)(base + ((size_t)(row0 + 128 * h + R[i]) * 1024 + C[i]) * 2); }
    __device__ __forceinline__ const char* bptr(const Unit& u) const {
        if (u.kind == 0) { const int wrow = u.pn < 4 ? 256 * u.pn : (u.pn < 8 ? 2048 + 256 * (u.pn - 4) : 5120 + 256 * (u.pn - 8)); return (const char*)ws + WS_WIN + (size_t)wrow * 2048; }
        if (u.kind == 1) return (const char*)ws + WS_U + (size_t)u.pn * 256 * 2048;
        if (u.kind == 2) return (const char*)ws + WS_WIN + (size_t)(3072 + 256 * u.pn) * 2048;
        return (const char*)ws + WS_UC + (size_t)u.pn * 256 * 2048; }
};
struct EpiP1 {
    static constexpr bool PERM = true;
    unsigned char* ws; const float* b_in;
    __device__ __forceinline__ bool carry(const Unit&) const { return false; }
    __device__ __forceinline__ void run(f32x4 (&acc)[2][2][4][2], const Unit& u, int wr, int wc, int fr, int fq) const {
        bf16_t* dst; size_t ldc; int act, colbase, bcol; bool brow; int browbase, rowbase;
        if (u.kind == 0) { rowbase = 256 * u.pm; brow = false; browbase = 0;
            if (u.pn < 4) { dst = (bf16_t*)(ws + WS_ZU); ldc = 1024; act = 1; colbase = 256 * u.pn; bcol = 256 * u.pn; }
            else if (u.pn < 8) { dst = (bf16_t*)(ws + WS_Q); ldc = 1024; act = 0; colbase = 256 * (u.pn - 4); bcol = 2048 + 256 * (u.pn - 4); }
            else { dst = (bf16_t*)(ws + WS_G); ldc = 2048; act = 2; colbase = 256 * (u.pn - 8); bcol = 5120 + 256 * (u.pn - 8); } }
        else if (u.kind == 1) { brow = true; ldc = NTOK; colbase = 256 * u.pn; bcol = 0;
            if (u.pm < 4) { dst = (bf16_t*)(ws + WS_ZVT); act = 1; rowbase = 256 * u.pm; browbase = 1024; }
            else { dst = (bf16_t*)(ws + WS_VT); act = 0; rowbase = 256 * (u.pm - 4); browbase = 4096; } }
        else if (u.kind == 2) { dst = (bf16_t*)(ws + WS_KC); ldc = 1024; act = 0; rowbase = 256 * u.pm; colbase = 256 * u.pn; bcol = 3072 + 256 * u.pn; brow = false; browbase = 0; }
        else { dst = (bf16_t*)(ws + WS_VCT); ldc = NCTX; act = 0; rowbase = 256 * u.pm; colbase = 256 * u.pn; bcol = 0; brow = true; browbase = 4096; }
        const int lc = wc * 32 + 8 * fq;
        f32x4 bv[2][2];
#pragma unroll
        for (int bj = 0; bj < 2; ++bj)
#pragma unroll
            for (int n = 0; n < 2; ++n) bv[bj][n] = brow ? (f32x4){0.f, 0.f, 0.f, 0.f} : *(const f32x4*)(b_in + bcol + lc + bj * HALF + 4 * n);
#pragma unroll
        for (int ai = 0; ai < 2; ++ai)
#pragma unroll
            for (int m = 0; m < 4; ++m) { const int row = rowbase + ai * HALF + wr * 64 + m * 16 + fr;
                const float rb = brow ? b_in[browbase + row] : 0.f;
                bf16_t* rowp = dst + (size_t)row * ldc + colbase + lc;
#pragma unroll
                for (int bj = 0; bj < 2; ++bj) { f32x4 v0 = acc[ai][bj][m][0] + bv[bj][0] + rb, v1 = acc[ai][bj][m][1] + bv[bj][1] + rb;
                    if (act == 1) { v0 = gelu4(v0); v1 = gelu4(v1); } else if (act == 2) { v0 = sigmoid4(v0); v1 = sigmoid4(v1); }
                    *(u32x4*)(rowp + bj * HALF) = pack8v(v0, v1); } }
    }
};
struct SchedK {
    int G, c; const unsigned char* ws;
    __device__ __forceinline__ bool next(int i, Unit& u) const { const int L = i * G + c; if (L >= 512) return false; u.kind = 0; u.row0 = 0; u.nrows = 256; u.e = 0; tilemap(L, 128, 4, u.pm, u.pn); return true; }
    __device__ __forceinline__ void aoffs(const Unit& u, const int (&R)[2], const int (&C)[2], unsigned (&o)[2][2]) const {
#pragma unroll
        for (int h = 0; h < 2; ++h)
#pragma unroll
            for (int i = 0; i < 2; ++i) o[h][i] = (unsigned)(WS_U + ((size_t)(256 * u.pm + 128 * h + R[i]) * 1024 + C[i]) * 2); }
    __device__ __forceinline__ const char* bptr(const Unit& u) const { return (const char*)ws + WS_WIN + (size_t)(3072 + 256 * u.pn) * 2048; }
};
struct EpiRope {
    static constexpr bool PERM = false;
    unsigned char* ws; const float* b_in;
    __device__ __forceinline__ bool carry(const Unit&) const { return false; }
    __device__ __forceinline__ void run(f32x4 (&acc)[2][2][4][2], const Unit& u, int wr, int wc, int fr, int fq) const {
        bf16_t* K = (bf16_t*)(ws + WS_K); const float* tab = (const float*)(ws + WS_ROPE);
        const int lc = wc * 32 + 4 * fq, axis = wc & 1;
        f32x4 b0[2], b1[2];
#pragma unroll
        for (int bj = 0; bj < 2; ++bj) { b0[bj] = *(const f32x4*)(b_in + 3072 + 256 * u.pn + bj * HALF + lc); b1[bj] = *(const f32x4*)(b_in + 3072 + 256 * u.pn + bj * HALF + lc + 16); }
#pragma unroll
        for (int ai = 0; ai < 2; ++ai)
#pragma unroll
            for (int m = 0; m < 4; ++m) { const int tok = 256 * u.pm + ai * HALF + wr * 64 + m * 16 + fr;
                const int pos = axis ? (tok & 63) : ((tok >> 6) & 63);
                const f32x4 t0 = *(const f32x4*)(tab + (pos * 16 + 4 * fq) * 2), t1 = *(const f32x4*)(tab + (pos * 16 + 4 * fq) * 2 + 4);
                const f32x4 cs = (f32x4){t0[0], t0[2], t1[0], t1[2]}, sn = (f32x4){t0[1], t0[3], t1[1], t1[3]};
                bf16_t* rowp = K + (size_t)tok * 1024 + 256 * u.pn + lc;
#pragma unroll
                for (int bj = 0; bj < 2; ++bj) { const f32x4 v0 = acc[ai][bj][m][0] + b0[bj], v1 = acc[ai][bj][m][1] + b1[bj];
                    const f32x4 o0 = v0 * cs - v1 * sn, o1 = v1 * cs + v0 * sn;
                    u32x2 w0, w1; w0.x = cvt_pk_bf16(o0[0], o0[1]); w0.y = cvt_pk_bf16(o0[2], o0[3]); w1.x = cvt_pk_bf16(o1[0], o1[1]); w1.y = cvt_pk_bf16(o1[2], o1[3]);
                    *(u32x2*)(rowp + bj * HALF) = w0; *(u32x2*)(rowp + bj * HALF + 16) = w1; } }
    }
};
struct SchedMerge {
    int G, c; const unsigned char* ws;
    __device__ __forceinline__ bool next(int i, Unit& u) const { const int L = (i >> 1) * G + c; if (L >= 512) return false; u.kind = i & 1; u.row0 = 0; u.nrows = 256; u.e = 0; tilemap(L, 128, 4, u.pm, u.pn); return true; }
    __device__ __forceinline__ void aoffs(const Unit& u, const int (&R)[2], const int (&C)[2], unsigned (&o)[2][2]) const {
        const size_t base = u.kind ? WS_YB : WS_U;
#pragma unroll
        for (int h = 0; h < 2; ++h)
#pragma unroll
            for (int i = 0; i < 2; ++i) o[h][i] = (unsigned)(base + ((size_t)(256 * u.pm + 128 * h + R[i]) * 1024 + C[i]) * 2); }
    __device__ __forceinline__ const char* bptr(const Unit& u) const { return (const char*)ws + (u.kind ? WS_WPB : WS_WPA) + (size_t)u.pn * 256 * 2048; }
};
struct EpiMerge {
    static constexpr bool PERM = true;
    unsigned char* ws;
    __device__ __forceinline__ bool carry(const Unit& u) const { return u.kind == 0; }
    __device__ __forceinline__ void run(f32x4 (&acc)[2][2][4][2], const Unit& u, int wr, int wc, int fr, int fq) const {
        const bf16_t* Gt = (const bf16_t*)(ws + WS_G); bf16_t* INNER = (bf16_t*)(ws + WS_INNER);
        const int lc = 256 * u.pn + wc * 32 + 8 * fq;
#pragma unroll
        for (int ai = 0; ai < 2; ++ai)
#pragma unroll
            for (int m = 0; m < 4; ++m) { const size_t tok = (size_t)(256 * u.pm + ai * HALF + wr * 64 + m * 16 + fr);
#pragma unroll
                for (int bj = 0; bj < 2; ++bj) { const int col = lc + bj * HALF;
                    const u32x4 gbw = *(const u32x4*)(Gt + tok * 2048 + 1024 + col);
                    f32x4 gb0 = (f32x4){bflo(gbw.x), bfhi(gbw.x), bflo(gbw.y), bfhi(gbw.y)}, gb1 = (f32x4){bflo(gbw.z), bfhi(gbw.z), bflo(gbw.w), bfhi(gbw.w)};
                    if (u.kind == 0) { const u32x4 gaw = *(const u32x4*)(Gt + tok * 2048 + col);
                        const f32x4 ga0 = (f32x4){bflo(gaw.x), bfhi(gaw.x), bflo(gaw.y), bfhi(gaw.y)}, ga1 = (f32x4){bflo(gaw.z), bfhi(gaw.z), bflo(gaw.w), bfhi(gaw.w)};
#pragma unroll
                        for (int i = 0; i < 4; ++i) { acc[ai][bj][m][0][i] *= ga0[i] * __builtin_amdgcn_rcpf(fmaxf(gb0[i], 1e-30f)); acc[ai][bj][m][1][i] *= ga1[i] * __builtin_amdgcn_rcpf(fmaxf(gb1[i], 1e-30f)); }
                    } else { *(u32x4*)(INNER + tok * 1024 + col) = pack8v(acc[ai][bj][m][0] * gb0, acc[ai][bj][m][1] * gb1); } } }
    }
};
struct SchedMix {
    int G, c; const unsigned char* ws;
    __device__ __forceinline__ bool next(int i, Unit& u) const { const int L = i * G + c; if (L >= 512) return false; u.kind = 0; u.row0 = 0; u.nrows = 256; u.e = 0; tilemap(L, 128, 4, u.pm, u.pn); return true; }
    __device__ __forceinline__ void aoffs(const Unit& u, const int (&R)[2], const int (&C)[2], unsigned (&o)[2][2]) const {
#pragma unroll
        for (int h = 0; h < 2; ++h)
#pragma unroll
            for (int i = 0; i < 2; ++i) o[h][i] = (unsigned)(WS_INNER + ((size_t)(256 * u.pm + 128 * h + R[i]) * 1024 + C[i]) * 2); }
    __device__ __forceinline__ const char* bptr(const Unit& u) const { return (const char*)ws + WS_WOUT + (size_t)u.pn * 256 * 2048; }
};
struct EpiMix {
    static constexpr bool PERM = false;
    unsigned char* ws; const float *x, *lng, *lnb, *b_out; float* out;
    __device__ __forceinline__ bool carry(const Unit&) const { return false; }
    __device__ __forceinline__ void run(f32x4 (&acc)[2][2][4][2], const Unit& u, int wr, int wc, int fr, int fq) const {
        const float* rowstat = (const float*)(ws + WS_ROWSTAT); const float* mod = (const float*)(ws + WS_MOD) + ((256 * u.pm) >> 12) * 6144 + 2048;
        f32x2 st[2][4];
#pragma unroll
        for (int ai = 0; ai < 2; ++ai)
#pragma unroll
            for (int m = 0; m < 4; ++m) st[ai][m] = *(const f32x2*)(rowstat + 2 * (256 * u.pm + ai * HALF + wr * 64 + m * 16 + fr));
#pragma unroll
        for (int bj = 0; bj < 2; ++bj)
#pragma unroll
            for (int n = 0; n < 2; ++n) { const int col = 256 * u.pn + bj * HALF + wc * 32 + n * 16 + 4 * fq;
                const f32x4 lg = *(const f32x4*)(lng + col), lb = *(const f32x4*)(lnb + col), bo = *(const f32x4*)(b_out + col), g1 = *(const f32x4*)(mod + col);
#pragma unroll
                for (int ai = 0; ai < 2; ++ai)
#pragma unroll
                    for (int m = 0; m < 4; ++m) { const size_t off = (size_t)(256 * u.pm + ai * HALF + wr * 64 + m * 16 + fr) * 1024 + col;
                        const f32x4 xv = *(const f32x4*)(x + off);
                        const f32x4 x0 = (xv - st[ai][m].x) * st[ai][m].y * lg + lb;
                        *(f32x4*)(out + off) = x0 * ALPHA + g1 * (acc[ai][bj][m][n] + bo); }
                asm volatile("" ::: "memory"); }
    }
};
__device__ __forceinline__ int ld_u(const int* p) { return __builtin_amdgcn_readfirstlane(__hip_atomic_load(p, __ATOMIC_RELAXED, __HIP_MEMORY_SCOPE_AGENT)); }
template <int NPN  > struct SchedMoe {
    int G, c; const unsigned char* ws;
    __device__ __forceinline__ bool next(int i, Unit& u) const {
        const int* TILES = (const int*)(ws + WS_TILES);
        const int ntiles = ld_u(TILES + 4 * MAXTILES), tpx = (ntiles + 7) >> 3, x = c & 7, s = c >> 3;
        const int tiles_x = min(tpx, ntiles - x * tpx), ll = i * (G >> 3) + s;
        if (ll >= NPN * tiles_x) return false;
        const int T = x * tpx + ll / NPN; u.pn = ll % NPN; u.pm = T; u.kind = 0;
        u.e = ld_u(TILES + 4 * T); u.row0 = ld_u(TILES + 4 * T + 1); u.nrows = ld_u(TILES + 4 * T + 2); return true; }
    __device__ __forceinline__ void aoffs(const Unit& u, const int (&R)[2], const int (&C)[2], unsigned (&o)[2][2]) const {
        const int* PERM_ = (const int*)(ws + WS_PERM);
#pragma unroll
        for (int h = 0; h < 2; ++h)
#pragma unroll
            for (int i = 0; i < 2; ++i) { const int lr = min(128 * h + R[i], u.nrows - 1);
                if (NPN == 8) { const int tok = PERM_[u.row0 + lr]; o[h][i] = (unsigned)(WS_U + ((size_t)tok * 1024 + C[i]) * 2); }
                else o[h][i] = (unsigned)(WS_ACT + ((size_t)(u.row0 + lr) * 1024 + C[i]) * 2); } }
    __device__ __forceinline__ const char* bptr(const Unit& u) const {
        if (NPN == 8) return (const char*)ws + WS_W1 + ((size_t)u.e * 2048 + 256 * u.pn) * 2048;
        return (const char*)ws + WS_W2 + ((size_t)u.e * 1024 + 256 * u.pn) * 2048; }
};
struct EpiMoe1 {
    static constexpr bool PERM = true;
    unsigned char* ws; const float* b1;
    __device__ __forceinline__ bool carry(const Unit&) const { return false; }
    __device__ __forceinline__ void run(f32x4 (&acc)[2][2][4][2], const Unit& u, int wr, int wc, int fr, int fq) const {
        bf16_t* ACT = (bf16_t*)(ws + WS_ACT);
        const int col = 128 * u.pn + wc * 32 + 8 * fq;
        f32x4 bg[2], bl[2];
#pragma unroll
        for (int n = 0; n < 2; ++n) { bg[n] = *(const f32x4*)(b1 + u.e * 2048 + col + 4 * n); bl[n] = *(const f32x4*)(b1 + u.e * 2048 + 1024 + col + 4 * n); }
#pragma unroll
        for (int ai = 0; ai < 2; ++ai)
#pragma unroll
            for (int m = 0; m < 4; ++m) { const int lr = ai * HALF + wr * 64 + m * 16 + fr;
                f32x4 a[2];
#pragma unroll
                for (int n = 0; n < 2; ++n) { const f32x4 zgv = acc[ai][0][m][n] + bg[n], zlv = acc[ai][1][m][n] + bl[n];
#pragma unroll
                    for (int i = 0; i < 4; ++i) { const float zg = fminf(zgv[i], 7.0f), zl = fminf(fmaxf(zlv[i], -7.0f), 7.0f);
                        a[n][i] = zg * __builtin_amdgcn_rcpf(1.0f + __builtin_amdgcn_exp2f(-1.702f * 1.4426950408889634f * zg)) * (zl + 1.0f); } }
                if (lr < u.nrows) *(u32x4*)(ACT + (size_t)(u.row0 + lr) * 1024 + col) = pack8v(a[0], a[1]); }
    }
};
struct EpiMoe2 {
    static constexpr bool PERM = true;
    unsigned char* ws; const float* b2;
    __device__ __forceinline__ bool carry(const Unit&) const { return false; }
    __device__ __forceinline__ void run(f32x4 (&acc)[2][2][4][2], const Unit& u, int wr, int wc, int fr, int fq) const {
        bf16_t* YS = (bf16_t*)(ws + WS_YS);
        const int lc = 256 * u.pn + wc * 32 + 8 * fq;
        f32x4 bv[2][2];
#pragma unroll
        for (int bj = 0; bj < 2; ++bj)
#pragma unroll
            for (int n = 0; n < 2; ++n) bv[bj][n] = *(const f32x4*)(b2 + u.e * 1024 + lc + bj * HALF + 4 * n);
#pragma unroll
        for (int ai = 0; ai < 2; ++ai)
#pragma unroll
            for (int m = 0; m < 4; ++m) { const int lr = ai * HALF + wr * 64 + m * 16 + fr;
                if (lr < u.nrows) {
#pragma unroll
                    for (int bj = 0; bj < 2; ++bj) *(u32x4*)(YS + (size_t)(u.row0 + lr) * 1024 + lc + bj * HALF) = pack8v(acc[ai][bj][m][0] + bv[bj][0], acc[ai][bj][m][1] + bv[bj][1]); } }
    }
};
}
__device__ __forceinline__ void phase_merge_fast(const P& p, int bid, int nblk, unsigned char* lds) {
    pg::SchedMerge S{nblk, bid, p.ws}; pg::EpiMerge E{p.ws};
    pg::gemm_phase<pg::EpiMerge, pg::SchedMerge, true>((PG_LAS unsigned char*)lds, p.ws, S, E);
}
__device__ __forceinline__ void phase_mix_fast(const P& p, int bid, int nblk, unsigned char* lds) {
    pg::SchedMix S{nblk, bid, p.ws}; pg::EpiMix E{p.ws, p.x, p.ln_x_g, p.ln_x_b, p.b_out, p.out};
    pg::gemm_phase<pg::EpiMix, pg::SchedMix, true>((PG_LAS unsigned char*)lds, p.ws, S, E);
}
__device__ __forceinline__ void phase_moe1_fast(const P& p, int bid, int nblk, unsigned char* lds) {
    pg::SchedMoe<8> S{nblk, bid, p.ws}; pg::EpiMoe1 E{p.ws, p.exp_b1};
    pg::gemm_phase<pg::EpiMoe1, pg::SchedMoe<8>, true>((PG_LAS unsigned char*)lds, p.ws, S, E);
}
__device__ __forceinline__ void phase_moe2_fast(const P& p, int bid, int nblk, unsigned char* lds) {
    pg::SchedMoe<4> S{nblk, bid, p.ws}; pg::EpiMoe2 E{p.ws, p.exp_b2};
    pg::gemm_phase<pg::EpiMoe2, pg::SchedMoe<4>, true>((PG_LAS unsigned char*)lds, p.ws, S, E);
}
__device__ __forceinline__ void phase_proj_fast(const P& p, int bid, int nblk, unsigned char* lds) {
    { pg::SchedP1 S{nblk, bid, p.ws}; pg::EpiP1 E{p.ws, p.b_in};
      pg::gemm_phase<pg::EpiP1, pg::SchedP1, true>((PG_LAS unsigned char*)lds, p.ws, S, E); }
    { pg::SchedK S{nblk, bid, p.ws}; pg::EpiRope E{p.ws, p.b_in};
      pg::gemm_phase<pg::EpiRope, pg::SchedK, true>((PG_LAS unsigned char*)lds, p.ws, S, E); }
}

#include <hip/hip_cooperative_groups.h>
namespace cg = cooperative_groups;
constexpr int LDS_BYTES = 147456;
__global__ void __launch_bounds__(512, 2) mega(P p) {
    extern __shared__ __attribute__((aligned(16))) unsigned char lds[];
    const int bid = blockIdx.x, nblk = gridDim.x;
    phase_prologue_a(p, bid, nblk, lds); cg::this_grid().sync();
    phase_prologue_b(p, bid, nblk); cg::this_grid().sync();
    phase_proj_fast(p, bid, nblk, lds); cg::this_grid().sync();
    phase_zstat_s(p, bid, nblk); cg::this_grid().sync();
    phase_gmlp_s(p, bid, nblk, lds); phase_attn_s(p, bid, nblk); cg::this_grid().sync();
    phase_merge_fast(p, bid, nblk, lds); cg::this_grid().sync();
    phase_mix_fast(p, bid, nblk, lds); cg::this_grid().sync();
    __syncthreads();
    phase_router(p, bid, nblk, lds); cg::this_grid().sync();
    phase_dispatch(p, bid, nblk, lds); cg::this_grid().sync();
    phase_moe1_fast(p, bid, nblk, lds); cg::this_grid().sync();
    phase_moe2_fast(p, bid, nblk, lds); cg::this_grid().sync();
    phase_final(p, bid, nblk);
}

extern "C" void kernel_launch(void* const* d_in, const int* in_sizes, int n_in, void* d_out, int out_size, void* d_ws, size_t ws_size, hipStream_t stream) {
    static int grid = 0;
    if (grid == 0) {
        if (n_in != 31 || out_size != NTOK * DM || ws_size < WS_END) { fprintf(stderr, "kernel_launch: unexpected sizes n_in %d out %d ws %zu\n", n_in, out_size, ws_size); grid = -1; return; }
        int dev = 0, cus = 0, per_cu = 0;
        if (hipGetDevice(&dev) != hipSuccess || hipDeviceGetAttribute(&cus, hipDeviceAttributeMultiprocessorCount, dev) != hipSuccess) { grid = -1; return; }
        if (hipFuncSetAttribute((const void*)mega, hipFuncAttributeMaxDynamicSharedMemorySize, LDS_BYTES) != hipSuccess) { fprintf(stderr, "kernel_launch: hipFuncSetAttribute failed\n"); grid = -1; return; }
        if (hipOccupancyMaxActiveBlocksPerMultiprocessor(&per_cu, (const void*)mega, 512, LDS_BYTES) != hipSuccess || per_cu < 1) { fprintf(stderr, "kernel_launch: occupancy query failed (%d)\n", per_cu); grid = -1; return; }
        grid = cus * 1;
    }
    if (grid < 0) return;
    P p{};
    const float** pp = (const float**)&p;
    for (int i = 0; i < 31; ++i) pp[i] = (const float*)d_in[i];
    p.out = (float*)d_out; p.ws = (unsigned char*)d_ws; p.ph_lo = 0; p.ph_hi = 0;
    if (hipMemsetAsync((char*)d_ws + WS_CTL, 0, 1 * MiB, stream) != hipSuccess) { fprintf(stderr, "kernel_launch: memset failed\n"); return; }
    void* args[] = {&p};
    hipError_t e = hipLaunchCooperativeKernel((const void*)mega, dim3(grid), dim3(512), args, LDS_BYTES, stream);
    if (e != hipSuccess) fprintf(stderr, "cooperative launch failed: %s (grid %d)\n", hipGetErrorString(e), grid);
}
```

```cpp
#include <hip/hip_runtime.h>
#include <cstdio>
#include <cstdint>

typedef unsigned short bf16_t;
typedef short bf16x8 __attribute__((ext_vector_type(8)));
typedef float f32x4 __attribute__((ext_vector_type(4)));
typedef unsigned u32x4 __attribute__((ext_vector_type(4)));
typedef unsigned u32x2 __attribute__((ext_vector_type(2)));

constexpr int DM = 1024, NB = 8, SEQ = 4096, NTOK = NB * SEQ, CTXL = 256, NCTX = NB * CTXL, INW = 7168;
constexpr int NE = 32, TOPK = 4, FF = 1024, NASSIGN = NTOK * TOPK;
constexpr int NHEAD = 16, HD = 64, GW = 64;
constexpr float LN_EPS = 1e-5f;
constexpr float ALPHA = 1.189207115002721f;
constexpr int MAXTILES = NASSIGN / 256 + NE;

constexpr size_t MiB = 1u << 20;
constexpr size_t WS_CTL = 0;
constexpr size_t WS_MOD = 1 * MiB;
constexpr size_t WS_ROPE = 1 * MiB + 512 * 1024;
constexpr size_t WS_ROWSTAT = 2 * MiB;
constexpr size_t WS_ZSTAT = 2 * MiB + 512 * 1024;
constexpr size_t WS_TOPE = 3 * MiB;
constexpr size_t WS_TOPG = 4 * MiB;
constexpr size_t WS_SLOT = 5 * MiB;
constexpr size_t WS_PERM = 6 * MiB;
constexpr size_t WS_TILES = 7 * MiB;
constexpr size_t WS_WIN = 8 * MiB;
constexpr size_t WS_WPA = 22 * MiB, WS_WPB = 24 * MiB, WS_WOUT = 26 * MiB, WS_WSB = 28 * MiB;
constexpr size_t WS_KC = 30 * MiB;
constexpr size_t WS_VCT = 34 * MiB;
constexpr size_t WS_UC = 38 * MiB;
constexpr size_t WS_PERM2 = 42 * MiB;
constexpr size_t WS_W1 = 48 * MiB;
constexpr size_t WS_W2 = 176 * MiB;
constexpr size_t WS_U = 240 * MiB;
constexpr size_t WS_ZU = 304 * MiB;
constexpr size_t WS_ZVT = 368 * MiB;
constexpr size_t WS_Q = 432 * MiB;
constexpr size_t WS_K = 496 * MiB;
constexpr size_t WS_VT = 560 * MiB;
constexpr size_t WS_G = 624 * MiB;
constexpr size_t WS_YB = 752 * MiB;
constexpr size_t WS_INNER = 816 * MiB;
constexpr size_t WS_ACT = WS_ZU;
constexpr size_t WS_YS = WS_G;
constexpr size_t WS_END = 880 * MiB;

struct P {
    const float *x, *c, *ctx, *c_ctx, *ln_x_g, *ln_x_b, *ln_ctx_g, *ln_ctx_b, *w_ada, *b_ada, *w_in, *b_in, *gmlp_ln_g, *gmlp_ln_b, *gmlp_ws, *gmlp_bs,
        *na_rpb, *w_pa, *w_pb, *w_out, *b_out, *ln1_g, *ln1_b, *ln2_g, *ln2_b, *router_w, *router_b, *exp_w1, *exp_b1, *exp_w2, *exp_b2;
    float* out; unsigned char* ws; int ph_lo, ph_hi;
};

__device__ __forceinline__ int tid_opaque() { int t = threadIdx.x; asm volatile("" : "+v"(t)); return t; }
__device__ __forceinline__ unsigned f2bf(float f) { unsigned u = __builtin_bit_cast(unsigned, f); return (u + 0x7fffu + ((u >> 16) & 1u)) >> 16; }
__device__ __forceinline__ unsigned pk2(float lo, float hi) { return f2bf(lo) | (f2bf(hi) << 16); }
__device__ __forceinline__ float bf2f(unsigned h) { return __builtin_bit_cast(float, (h & 0xffffu) << 16); }
__device__ __forceinline__ float bflo(unsigned w) { return __builtin_bit_cast(float, w << 16); }
__device__ __forceinline__ float bfhi(unsigned w) { return __builtin_bit_cast(float, w & 0xffff0000u); }
__device__ __forceinline__ float wave_sum(float v) {
#pragma unroll
    for (int o = 1; o < 64; o <<= 1) v += __shfl_xor(v, o);
    return v;
}
__device__ __forceinline__ float wave_max(float v) {
#pragma unroll
    for (int o = 1; o < 64; o <<= 1) v = fmaxf(v, __shfl_xor(v, o));
    return v;
}
__device__ __forceinline__ float gelu_exact(float v) { return 0.5f * v * (1.0f + erff(v * 0.70710678118654752f)); }
__device__ __forceinline__ float sigmoidf_(float v) { return 1.0f / (1.0f + __expf(-v)); }

__device__ __forceinline__ void mod_item(const P& p, int item, float* red  ) {
    const int tid = tid_opaque(), wave = tid >> 6, lane = tid & 63;
    const int col = item * 32 + (lane & 31), kpar = lane >> 5;
    float acc[9];
#pragma unroll
    for (int r = 0; r < 9; ++r) acc[r] = 0.f;
    for (int kk = 0; kk < 64; ++kk) {
        const int k = wave * 128 + kk * 2 + kpar;
        const float w = p.w_ada[(size_t)k * 6144 + col];
#pragma unroll
        for (int r = 0; r < 9; ++r) { const float cv = (r < 8) ? p.c[r * 1024 + k] : p.c_ctx[k]; const float s = cv / (1.0f + __expf(-cv)); acc[r] += s * w; }
    }
#pragma unroll
    for (int r = 0; r < 9; ++r) red[((wave * 2 + kpar) * 9 + r) * 32 + (lane & 31)] = acc[r];
    __syncthreads();
    if (tid < 288) {
        const int r = tid >> 5, cc = tid & 31; float s = 0.f;
#pragma unroll
        for (int q = 0; q < 16; ++q) s += red[(q * 9 + r) * 32 + cc];
        ((float*)(p.ws + WS_MOD))[r * 6144 + item * 32 + cc] = s + p.b_ada[item * 32 + cc];
    }
    __syncthreads();
}
__device__ __forceinline__ void transpose_item(const float* W, int K, int N, bf16_t* WT, int k0, int n0, int drow0, float* scr, int lane) {
#pragma unroll 8
    for (int i = 0; i < 32; ++i) { const int kk = 2 * i + (lane >> 5); scr[kk * 33 + (lane & 31)] = W[(size_t)(k0 + kk) * N + n0 + (lane & 31)]; }
    __builtin_amdgcn_wave_barrier();
    asm volatile("s_waitcnt lgkmcnt(0)" ::: "memory");
    const int c = lane & 7;
#pragma unroll
    for (int j = 0; j < 4; ++j) { const int n = (lane >> 3) + 8 * j; const float* s = scr + (8 * c) * 33 + n;
        u32x4 o; o.x = pk2(s[0 * 33], s[1 * 33]); o.y = pk2(s[2 * 33], s[3 * 33]); o.z = pk2(s[4 * 33], s[5 * 33]); o.w = pk2(s[6 * 33], s[7 * 33]);
        *(u32x4*)(WT + (size_t)(drow0 + n) * K + k0 + 8 * c) = o; }
    asm volatile("s_waitcnt lgkmcnt(0)" ::: "memory");
    __builtin_amdgcn_wave_barrier();
}
constexpr int IT_WIN = 16 * 224, IT_SQ = 16 * 32, IT_W1 = 32 * 16 * 64, IT_W2 = 32 * 16 * 32, IT_WS = 32;
constexpr int IT_TOTAL = IT_WIN + 3 * IT_SQ + IT_W1 + IT_W2 + IT_WS;
__device__ __forceinline__ void convert_item(const P& p, int it, float* scr, int lane) {
    unsigned char* ws = p.ws;
    if (it < IT_WIN) { const int kb = it / 224, nb = it % 224; transpose_item(p.w_in, 1024, INW, (bf16_t*)(ws + WS_WIN), kb * 64, nb * 32, nb * 32, scr, lane); return; } it -= IT_WIN;
    if (it < IT_SQ) { const int kb = it / 32, nb = it % 32; transpose_item(p.w_pa, 1024, 1024, (bf16_t*)(ws + WS_WPA), kb * 64, nb * 32, nb * 32, scr, lane); return; } it -= IT_SQ;
    if (it < IT_SQ) { const int kb = it / 32, nb = it % 32; transpose_item(p.w_pb, 1024, 1024, (bf16_t*)(ws + WS_WPB), kb * 64, nb * 32, nb * 32, scr, lane); return; } it -= IT_SQ;
    if (it < IT_SQ) { const int kb = it / 32, nb = it % 32; transpose_item(p.w_out, 1024, 1024, (bf16_t*)(ws + WS_WOUT), kb * 64, nb * 32, nb * 32, scr, lane); return; } it -= IT_SQ;
    if (it < IT_W1) { const int e = it / 1024, r = it % 1024, kb = r / 64, nb = r % 64, n0 = nb * 32;
        const int half = n0 >> 10, nn = n0 & 1023, drow0 = (nn >> 7) * 256 + half * 128 + (nn & 127);
        transpose_item(p.exp_w1 + (size_t)e * 1024 * 2048, 1024, 2048, (bf16_t*)(ws + WS_W1) + (size_t)e * 2048 * 1024, kb * 64, n0, drow0, scr, lane); return; } it -= IT_W1;
    if (it < IT_W2) { const int e = it / 512, r = it % 512, kb = r / 32, nb = r % 32;
        transpose_item(p.exp_w2 + (size_t)e * 1024 * 1024, 1024, 1024, (bf16_t*)(ws + WS_W2) + (size_t)e * 1024 * 1024, kb * 64, nb * 32, nb * 32, scr, lane); return; } it -= IT_W2;
    { bf16_t* o = (bf16_t*)(ws + WS_WSB); const float* s = p.gmlp_ws + it * 4096;
      for (int i = lane; i < 4096; i += 64) o[it * 4096 + i] = (bf16_t)f2bf(s[i]); }
}
__device__ __forceinline__ void phase_prologue_a(const P& p, int bid, int nblk, unsigned char* lds) {
    const int tid = tid_opaque(), wave = tid >> 6, lane = tid & 63;
    for (int item = bid; item < 192; item += nblk) mod_item(p, item, (float*)lds);
    if (bid == nblk - 1) {
        for (int i = tid; i < 1024; i += 512) { const int pos = i >> 4, fi = i & 15;
            const float inv = __builtin_amdgcn_exp2f(-(float)fi * (13.287712379549449f / 16.0f));
            const float ang = (float)pos * inv; const float rev = ang * 0.15915494309189535f;
            float* t = (float*)(p.ws + WS_ROPE); t[2 * i] = __builtin_amdgcn_cosf(rev); t[2 * i + 1] = __builtin_amdgcn_sinf(rev); }
    }
    __syncthreads();
    float* scr = (float*)lds + wave * (64 * 33 + 32);
    const int gw = bid * 8 + wave, ngw = nblk * 8;
    for (int it = gw; it < IT_TOTAL; it += ngw) convert_item(p, it, scr, lane);
}
__device__ __forceinline__ void ln_mod_row(const float* xrow, const float* g, const float* b, const float* sh, const float* sc, bf16_t* orow, float* stat, int lane) {
    const f32x4* xr = (const f32x4*)xrow + lane;
    f32x4 v[4]; float s = 0.f;
#pragma unroll
    for (int j = 0; j < 4; ++j) { v[j] = xr[64 * j]; s += (v[j].x + v[j].y) + (v[j].z + v[j].w); }
    const float mean = wave_sum(s) * (1.f / DM); float s2 = 0.f;
#pragma unroll
    for (int j = 0; j < 4; ++j) { v[j] = v[j] - mean; s2 += (v[j].x * v[j].x + v[j].y * v[j].y) + (v[j].z * v[j].z + v[j].w * v[j].w); }
    const float rstd = 1.f / sqrtf(wave_sum(s2) * (1.f / DM) + LN_EPS);
    if (stat && lane == 0) { stat[0] = mean; stat[1] = rstd; }
    u32x2* o8 = (u32x2*)orow + lane;
#pragma unroll
    for (int j = 0; j < 4; ++j) { const int col = 4 * lane + 256 * j;
        const f32x4 gg = *(const f32x4*)(g + col), bb = *(const f32x4*)(b + col), shv = *(const f32x4*)(sh + col), scv = *(const f32x4*)(sc + col);
        f32x4 y = (v[j] * rstd) * gg + bb; y = y * (1.0f + scv) + shv;
        u32x2 w; w.x = pk2(y.x, y.y); w.y = pk2(y.z, y.w); o8[64 * j] = w; }
}
__device__ __forceinline__ void phase_prologue_b(const P& p, int bid, int nblk) {
    const int tid = tid_opaque(), wave = tid >> 6, lane = tid & 63;
    const int gw = bid * 8 + wave, ngw = nblk * 8;
    const float* mod = (const float*)(p.ws + WS_MOD);
    for (int row = gw; row < NTOK + NCTX; row += ngw) {
        if (row < NTOK) { const int b = row >> 12;
            ln_mod_row(p.x + (size_t)row * DM, p.ln_x_g, p.ln_x_b, mod + b * 6144, mod + b * 6144 + 1024, (bf16_t*)(p.ws + WS_U) + (size_t)row * DM, (float*)(p.ws + WS_ROWSTAT) + 2 * row, lane);
        } else { const int r = row - NTOK;
            ln_mod_row(p.ctx + (size_t)r * DM, p.ln_ctx_g, p.ln_ctx_b, mod + 8 * 6144, mod + 8 * 6144 + 1024, (bf16_t*)(p.ws + WS_UC) + (size_t)r * DM, nullptr, lane); }
    }
}

template <class ARow, class BRow, class Epi>
__device__ __forceinline__ void sgemm_wave_tile(int r0, int n0, int K, const ARow& arow, const BRow& brow, const Epi& epi, int lane) {
    const int fr = lane & 15, fq = lane >> 4;
    f32x4 acc[2][2];
#pragma unroll
    for (int a = 0; a < 2; ++a)
#pragma unroll
        for (int b = 0; b < 2; ++b) acc[a][b] = (f32x4){0.f, 0.f, 0.f, 0.f};
    const bf16_t* ap[2]; const bf16_t* bp[2];
#pragma unroll
    for (int a = 0; a < 2; ++a) { ap[a] = arow(r0 + 16 * a + fr) + 8 * fq; bp[a] = brow(n0 + 16 * a + fr) + 8 * fq; }
    for (int k0 = 0; k0 < K; k0 += 32) {
        bf16x8 af[2], bfr[2];
#pragma unroll
        for (int a = 0; a < 2; ++a) { af[a] = *(const bf16x8*)(ap[a] + k0); bfr[a] = *(const bf16x8*)(bp[a] + k0); }
#pragma unroll
        for (int a = 0; a < 2; ++a)
#pragma unroll
            for (int b = 0; b < 2; ++b) acc[a][b] = __builtin_amdgcn_mfma_f32_16x16x32_bf16(af[a], bfr[b], acc[a][b], 0, 0, 0);
    }
#pragma unroll
    for (int a = 0; a < 2; ++a)
#pragma unroll
        for (int b = 0; b < 2; ++b)
#pragma unroll
            for (int i = 0; i < 4; ++i) epi(r0 + 16 * a + 4 * fq + i, n0 + 16 * b + fr, acc[a][b][i]);
}

struct ARowDense { const bf16_t* A; int lda; __device__ __forceinline__ const bf16_t* operator()(int r) const { return A + (size_t)r * lda; } };
struct EpiProj {
    const float* b_in; bf16_t *ZU, *ZVT, *Q, *K, *VT, *G;
    __device__ __forceinline__ void operator()(int r, int n, float v) const {
        v += b_in[n];
        if (n < 1024) ZU[(size_t)r * 1024 + n] = (bf16_t)f2bf(gelu_exact(v));
        else if (n < 2048) ZVT[(size_t)(n - 1024) * NTOK + r] = (bf16_t)f2bf(gelu_exact(v));
        else if (n < 3072) Q[(size_t)r * 1024 + (n - 2048)] = (bf16_t)f2bf(v);
        else if (n < 4096) K[(size_t)r * 1024 + (n - 3072)] = (bf16_t)f2bf(v);
        else if (n < 5120) VT[(size_t)(n - 4096) * NTOK + r] = (bf16_t)f2bf(v);
        else G[(size_t)r * 2048 + (n - 5120)] = (bf16_t)f2bf(sigmoidf_(v));
    }
};
__device__ __forceinline__ void phase_proj_s(const P& p, int bid, int nblk) {
    const int tid_ = tid_opaque(); const int wave = tid_ >> 6, lane = tid_ & 63; unsigned char* ws = p.ws;
    ARowDense ar{(const bf16_t*)(ws + WS_U), 1024}, br{(const bf16_t*)(ws + WS_WIN), 1024};
    EpiProj e{p.b_in, (bf16_t*)(ws + WS_ZU), (bf16_t*)(ws + WS_ZVT), (bf16_t*)(ws + WS_Q), (bf16_t*)(ws + WS_K), (bf16_t*)(ws + WS_VT), (bf16_t*)(ws + WS_G)};
    const int ntn = INW / 32, ntiles = (NTOK / 32) * ntn;
    for (int t = bid * 8 + wave; t < ntiles; t += nblk * 8) sgemm_wave_tile((t / ntn) * 32, (t % ntn) * 32, 1024, ar, br, e, lane);
}
struct EpiCtxKV {
    const float* b_in; bf16_t *KC, *VCT;
    __device__ __forceinline__ void operator()(int r, int n, float v) const {
        v += b_in[3072 + n];
        if (n < 1024) KC[(size_t)r * 1024 + n] = (bf16_t)f2bf(v); else VCT[(size_t)(n - 1024) * NCTX + r] = (bf16_t)f2bf(v);
    }
};
__device__ __forceinline__ void phase_ctxkv_s(const P& p, int bid, int nblk) {
    const int tid_ = tid_opaque(); const int wave = tid_ >> 6, lane = tid_ & 63; unsigned char* ws = p.ws;
    ARowDense ar{(const bf16_t*)(ws + WS_UC), 1024}, br{(const bf16_t*)(ws + WS_WIN) + (size_t)3072 * 1024, 1024};
    EpiCtxKV e{p.b_in, (bf16_t*)(ws + WS_KC), (bf16_t*)(ws + WS_VCT)};
    const int ntn = 2048 / 32, ntiles = (NCTX / 32) * ntn;
    for (int t = bid * 8 + wave; t < ntiles; t += nblk * 8) sgemm_wave_tile((t / ntn) * 32, (t % ntn) * 32, 1024, ar, br, e, lane);
}
__device__ __forceinline__ void phase_rope_s(const P& p, int bid, int nblk) {
    bf16_t* K = (bf16_t*)(p.ws + WS_K); const float* tab = (const float*)(p.ws + WS_ROPE);
    const size_t total = (size_t)NTOK * NHEAD * 32;
    const int tid_ = tid_opaque();
    for (size_t i = (size_t)bid * 512 + tid_; i < total; i += (size_t)nblk * 512) {
        const int pi = (int)(i & 31), h = (int)((i >> 5) & 15), t = (int)(i >> 9);
        const int pos = t & 4095, axis = pi >> 4, fi = pi & 15, ps = axis ? (pos & 63) : (pos >> 6);
        const float cs = tab[2 * (ps * 16 + fi)], sn = tab[2 * (ps * 16 + fi) + 1];
        bf16_t* base = K + (size_t)t * 1024 + h * 64 + axis * 32 + fi;
        const float x1 = bf2f(base[0]), x2 = bf2f(base[16]);
        base[0] = (bf16_t)f2bf(x1 * cs - x2 * sn); base[16] = (bf16_t)f2bf(x2 * cs + x1 * sn);
    }
}
__device__ __forceinline__ void phase_zstat_s(const P& p, int bid, int nblk) {
    const bf16_t* ZVT = (const bf16_t*)(p.ws + WS_ZVT); float* zs = (float*)(p.ws + WS_ZSTAT);
    const int tid_ = tid_opaque();
    for (int t = bid * 512 + tid_; t < NTOK; t += nblk * 512) {
        float s = 0.f, s2 = 0.f;
        for (int c = 0; c < 1024; ++c) { const float v = bf2f(ZVT[(size_t)c * NTOK + t]); s += v; s2 += v * v; }
        const float mean = s * (1.f / 1024.f); const float var = fmaxf(s2 * (1.f / 1024.f) - mean * mean, 0.f);
        zs[2 * t] = mean; zs[2 * t + 1] = 1.f / sqrtf(var + LN_EPS);
    }
}
__device__ __forceinline__ void phase_gmlp_s(const P& p, int bid, int nblk, unsigned char* lds) {
    float* zvn = (float*)lds;
    float* wsm = zvn + 128 * 128;
    const bf16_t* ZVT = (const bf16_t*)(p.ws + WS_ZVT); const bf16_t* ZU = (const bf16_t*)(p.ws + WS_ZU); const float* zs = (const float*)(p.ws + WS_ZSTAT);
    bf16_t* YA = (bf16_t*)(p.ws + WS_U);
    const int tid = tid_opaque();
    for (int item = bid; item < (NTOK / 128) * 8; item += nblk) {
        const int chunk = item >> 3, g = item & 7, tok0 = chunk * 128;
        __syncthreads();
        for (int i = tid; i < 128 * 128; i += 512) { const int c = i >> 7, q = i & 127; const int ch = g * 128 + c;
            const float v = bf2f(ZVT[(size_t)ch * NTOK + tok0 + q]);
            zvn[q * 128 + c] = (v - zs[2 * (tok0 + q)]) * zs[2 * (tok0 + q) + 1] * p.gmlp_ln_g[ch] + p.gmlp_ln_b[ch];
            wsm[i] = p.gmlp_ws[g * 16384 + i]; }
        __syncthreads();
        const int c = tid & 127, pq = tid >> 7;
        for (int pp = 0; pp < 32; ++pp) { const int pr = pq * 32 + pp; float acc = 0.f;
            for (int q = 0; q < 128; ++q) acc += wsm[pr * 128 + q] * zvn[q * 128 + c];
            acc += p.gmlp_bs[g * 128 + pr];
            const size_t o = (size_t)(tok0 + pr) * 1024 + g * 128 + c;
            YA[o] = (bf16_t)f2bf(bf2f(ZU[o]) * acc); }
    }
}
__device__ __forceinline__ bf16x8 pack8(const float (&v)[8]) { u32x4 w; w.x = pk2(v[0], v[1]); w.y = pk2(v[2], v[3]); w.z = pk2(v[4], v[5]); w.w = pk2(v[6], v[7]); return __builtin_bit_cast(bf16x8, w); }
__device__ __forceinline__ void phase_gmlp_fast(const P& p, int bid, int nblk, unsigned char* lds) {
    const int tid = tid_opaque(), g = tid >> 6, lane = tid & 63, fr = lane & 15, fq = lane >> 4;
    float* part = (float*)lds;
    float* stat = part + 8 * 128 * 2;
    const bf16_t* ZVT = (const bf16_t*)(p.ws + WS_ZVT); const bf16_t* ZU = (const bf16_t*)(p.ws + WS_ZU); const bf16_t* WSB = (const bf16_t*)(p.ws + WS_WSB);
    bf16_t* YA = (bf16_t*)(p.ws + WS_U);
    for (int chunk = bid; chunk < NTOK / 128; chunk += nblk) {
        const int tok0 = chunk * 128;
        __syncthreads();
        { float s1[8], s2[8];
#pragma unroll
          for (int jj = 0; jj < 8; ++jj) { s1[jj] = 0.f; s2[jj] = 0.f; }
          const bf16_t* zp = ZVT + (size_t)(128 * g + fq) * NTOK + tok0 + 8 * fr;
#pragma unroll 8
          for (int it = 0; it < 32; ++it) { const bf16x8 v = *(const bf16x8*)(zp + (size_t)(4 * it) * NTOK);
#pragma unroll
              for (int jj = 0; jj < 8; ++jj) { const float f = bf2f((unsigned)(unsigned short)v[jj]); s1[jj] += f; s2[jj] += f * f; } }
#pragma unroll
          for (int jj = 0; jj < 8; ++jj) { s1[jj] += __shfl_xor(s1[jj], 16); s1[jj] += __shfl_xor(s1[jj], 32); s2[jj] += __shfl_xor(s2[jj], 16); s2[jj] += __shfl_xor(s2[jj], 32); }
          if (fq == 0) {
#pragma unroll
              for (int jj = 0; jj < 8; ++jj) { part[(g * 128 + 8 * fr + jj) * 2] = s1[jj]; part[(g * 128 + 8 * fr + jj) * 2 + 1] = s2[jj]; } } }
        __syncthreads();
        if (tid < 128) { float a = 0.f, b = 0.f;
#pragma unroll
            for (int w = 0; w < 8; ++w) { a += part[(w * 128 + tid) * 2]; b += part[(w * 128 + tid) * 2 + 1]; }
            const float mean = a * (1.f / 1024.f), var = fmaxf(b * (1.f / 1024.f) - mean * mean, 0.f);
            stat[2 * tid] = mean; stat[2 * tid + 1] = 1.f / sqrtf(var + LN_EPS); }
        __syncthreads();
#pragma unroll 1
        for (int ph = 0; ph < 2; ++ph) {
            bf16x8 wf[4][4]; float t1[4], t2[4], bsv[4];
#pragma unroll
            for (int pt = 0; pt < 4; ++pt) { const int pp = 64 * ph + 16 * pt + fr; float t1a = 0.f, t2a = 0.f;
                const float* stat_o = stat + 16 * fq; asm volatile("" : "+v"(stat_o));
#pragma unroll
                for (int ks = 0; ks < 4; ++ks) { const bf16x8 w = *(const bf16x8*)(WSB + ((size_t)g * 128 + pp) * 128 + 32 * ks + 8 * fq);
                    float wv[8];
#pragma unroll
                    for (int jj = 0; jj < 8; ++jj) { const float w0 = bf2f((unsigned)(unsigned short)w[jj]); t2a += w0; wv[jj] = w0 * stat_o[2 * (32 * ks + jj) + 1]; }
                    const bf16x8 wp = pack8(wv); wf[pt][ks] = wp;
#pragma unroll
                    for (int jj = 0; jj < 8; ++jj) t1a += bf2f((unsigned)(unsigned short)wp[jj]) * stat_o[2 * (32 * ks + jj)]; }
                t1a += __shfl_xor(t1a, 16); t1a += __shfl_xor(t1a, 32); t2a += __shfl_xor(t2a, 16); t2a += __shfl_xor(t2a, 32);
                t1[pt] = t1a; t2[pt] = t2a; bsv[pt] = p.gmlp_bs[g * 128 + pp]; }
#pragma unroll 1
            for (int ct = 0; ct < 8; ++ct) {
                bf16x8 af[4];
                const bf16_t* zp = ZVT + (size_t)(128 * g + 16 * ct + fr) * NTOK + tok0 + 8 * fq;
#pragma unroll
                for (int ks = 0; ks < 4; ++ks) af[ks] = *(const bf16x8*)(zp + 32 * ks);
                f32x4 acc[4];
#pragma unroll
                for (int pt = 0; pt < 4; ++pt) { acc[pt] = (f32x4){0.f, 0.f, 0.f, 0.f};
#pragma unroll
                    for (int ks = 0; ks < 4; ++ks) acc[pt] = __builtin_amdgcn_mfma_f32_16x16x32_bf16(af[ks], wf[pt][ks], acc[pt], 0, 0, 0); }
                const int c = 128 * g + 16 * ct + 4 * fq;
                const f32x4 gc = *(const f32x4*)(p.gmlp_ln_g + c), bc = *(const f32x4*)(p.gmlp_ln_b + c);
#pragma unroll
                for (int pt = 0; pt < 4; ++pt) { const size_t off = (size_t)(tok0 + 64 * ph + 16 * pt + fr) * 1024 + c;
                    const u32x2 zu = *(const u32x2*)(ZU + off);
                    const f32x4 s = gc * (acc[pt] - t1[pt]) + bc * t2[pt] + bsv[pt];
                    u32x2 w; w.x = pk2(bflo(zu.x) * s[0], bfhi(zu.x) * s[1]); w.y = pk2(bflo(zu.y) * s[2], bfhi(zu.y) * s[3]);
                    *(u32x2*)(YA + off) = w; }
            }
        }
    }
}
constexpr int RPB_LDS_FLOATS = 16 * 15 * 64;
__device__ __forceinline__ void attn_stage_rpb(const P& p, float* tbl, int tid) {
    for (int idx = tid; idx < RPB_LDS_FLOATS; idx += 512) { const int h = idx / 960, rem = idx % 960, dr = rem >> 6, cc = rem & 63;
        tbl[idx] = (cc >= 16 && cc < 47) ? p.na_rpb[(h * 15 + dr) * 31 + cc - 16] : 0.f; }
}
__device__ __forceinline__ void attn_wave_unit(const P& p, const float* tbl, int b, int r, int j, int h, int lane) {
    const int fr = lane & 15, fq = lane >> 4;
    const bf16_t* Q = (const bf16_t*)(p.ws + WS_Q); const bf16_t* K = (const bf16_t*)(p.ws + WS_K); const bf16_t* VT = (const bf16_t*)(p.ws + WS_VT);
    const bf16_t* KC = (const bf16_t*)(p.ws + WS_KC); const bf16_t* VCT = (const bf16_t*)(p.ws + WS_VCT); const float* tab = (const float*)(p.ws + WS_ROPE);
    bf16_t* YB = (bf16_t*)(p.ws + WS_YB);
    const int qc = 16 * j + fr; const size_t tq = (size_t)b * SEQ + r * 64 + qc;
    const int r0 = min(max(r - 4, 0), 56), c0 = min(max(qc - 8, 0), 48), cs = min(max(16 * j - 8, 0), 32);
    const int sp0 = 8 * (fr >> 2) + (fr & 3);
    const bf16_t* klat = K + ((size_t)b * SEQ + r0 * 64 + cs + sp0) * 1024 + h * 64 + 8 * fq;
    const bf16_t* kctx = KC + ((size_t)b * CTXL + sp0) * 1024 + h * 64 + 8 * fq;
    const bf16_t* vlat = VT + (size_t)(h * 64 + fr) * NTOK + (size_t)b * SEQ + r0 * 64 + cs + 8 * fq;
    const bf16_t* vctx = VCT + (size_t)(h * 64 + fr) * NCTX + (size_t)b * CTXL + 8 * fq;
    bf16x8 kf[2][2][2];
#define LOADK(base, rowstride, buf, st_) do { _Pragma("unroll") for (int t = 0; t < 2; ++t) { \
        const bf16_t* kp_ = (base) + (size_t)(st_) * (rowstride) * 1024 + t * 4 * 1024; kf[buf][t][0] = *(const bf16x8*)kp_; kf[buf][t][1] = *(const bf16x8*)(kp_ + 32); } } while (0)
    LOADK(klat, 64, 0, 0); LOADK(klat, 64, 1, 1);
    bf16x8 qpl[2], qrt[2];
#pragma unroll
    for (int s = 0; s < 2; ++s) {
        const bf16_t* qb = Q + tq * 1024 + h * 64 + 32 * s;
        const bf16x8 me = *(const bf16x8*)(qb + 8 * fq), ot = *(const bf16x8*)(qb + 8 * (fq ^ 2));
        qpl[s] = me;
        const int pos = s ? qc : r; const float* tb = tab + (pos * 16 + 8 * (fq & 1)) * 2;
        float rot[8];
#pragma unroll
        for (int jj = 0; jj < 8; ++jj) { const float cv = tb[2 * jj], sv = tb[2 * jj + 1];
            const float xv = bf2f((unsigned)(unsigned short)me[jj]), ov = bf2f((unsigned)(unsigned short)ot[jj]);
            rot[jj] = (fq < 2) ? (xv * cv - ov * sv) : (xv * cv + ov * sv); }
        qrt[s] = pack8(rot);
    }
    float sc[8][8];
    const float* brow0 = tbl + (h * 15 + (r0 - r + 7)) * 64 + (cs + 8 * fq - qc + 31);
#pragma unroll
    for (int st = 0; st < 8; ++st) {
#pragma unroll
        for (int t = 0; t < 2; ++t) {
            f32x4 d = __builtin_amdgcn_mfma_f32_16x16x32_bf16(kf[st & 1][t][0], qrt[0], (f32x4){0.f, 0.f, 0.f, 0.f}, 0, 0, 0);
            d = __builtin_amdgcn_mfma_f32_16x16x32_bf16(kf[st & 1][t][1], qrt[1], d, 0, 0, 0);
#pragma unroll
            for (int i = 0; i < 4; ++i) { const int kc = cs + 8 * fq + 4 * t + i; const bool valid = (kc >= c0) && (kc < c0 + 16);
                sc[st][4 * t + i] = valid ? (d[i] * 0.125f + brow0[st * 64 + 4 * t + i]) : -INFINITY; } }
        if (st + 2 < 8) LOADK(klat, 64, st & 1, st + 2);
    }
    bf16x8 vf[2][4];
#define LOADV(base, colstride, ld, buf, st_) do { _Pragma("unroll") for (int dt = 0; dt < 4; ++dt) \
        vf[buf][dt] = *(const bf16x8*)((base) + (size_t)dt * 16 * (ld) + (st_) * (colstride)); } while (0)
    LOADV(vlat, 64, NTOK, 0, 0); LOADV(vlat, 64, NTOK, 1, 1);
    float m = -INFINITY;
#pragma unroll
    for (int st = 0; st < 8; ++st)
#pragma unroll
        for (int e = 0; e < 8; ++e) m = fmaxf(m, sc[st][e]);
    m = fmaxf(m, __shfl_xor(m, 16)); m = fmaxf(m, __shfl_xor(m, 32));
    float l = 0.f; f32x4 o[4];
#pragma unroll
    for (int dt = 0; dt < 4; ++dt) o[dt] = (f32x4){0.f, 0.f, 0.f, 0.f};
    const float ml2 = m * 1.4426950408889634f;
#pragma unroll
    for (int st = 0; st < 8; ++st) {
        float pv[8];
#pragma unroll
        for (int e = 0; e < 8; ++e) { pv[e] = __builtin_amdgcn_exp2f(sc[st][e] * 1.4426950408889634f - ml2); l += pv[e]; }
        const bf16x8 pf = pack8(pv);
#pragma unroll
        for (int dt = 0; dt < 4; ++dt) o[dt] = __builtin_amdgcn_mfma_f32_16x16x32_bf16(vf[st & 1][dt], pf, o[dt], 0, 0, 0);
        if (st + 2 < 8) LOADV(vlat, 64, NTOK, st & 1, st + 2);
    }
    LOADK(kctx, 32, 0, 0); LOADK(kctx, 32, 1, 1);
#pragma unroll
    for (int st = 0; st < 8; ++st) {
#pragma unroll
        for (int t = 0; t < 2; ++t) {
            f32x4 d = __builtin_amdgcn_mfma_f32_16x16x32_bf16(kf[st & 1][t][0], qpl[0], (f32x4){0.f, 0.f, 0.f, 0.f}, 0, 0, 0);
            d = __builtin_amdgcn_mfma_f32_16x16x32_bf16(kf[st & 1][t][1], qpl[1], d, 0, 0, 0);
#pragma unroll
            for (int i = 0; i < 4; ++i) sc[st][4 * t + i] = d[i] * 0.125f; }
        if (st + 2 < 8) LOADK(kctx, 32, st & 1, st + 2);
    }
    LOADV(vctx, 32, NCTX, 0, 0); LOADV(vctx, 32, NCTX, 1, 1);
    float m2 = -INFINITY;
#pragma unroll
    for (int st = 0; st < 8; ++st)
#pragma unroll
        for (int e = 0; e < 8; ++e) m2 = fmaxf(m2, sc[st][e]);
    m2 = fmaxf(m2, __shfl_xor(m2, 16)); m2 = fmaxf(m2, __shfl_xor(m2, 32));
    const float mn = fmaxf(m, m2), al = __builtin_amdgcn_exp2f((m - mn) * 1.4426950408889634f), mnl2 = mn * 1.4426950408889634f;
    l *= al;
#pragma unroll
    for (int dt = 0; dt < 4; ++dt) o[dt] = o[dt] * al;
#pragma unroll
    for (int st = 0; st < 8; ++st) {
        float pv[8];
#pragma unroll
        for (int e = 0; e < 8; ++e) { pv[e] = __builtin_amdgcn_exp2f(sc[st][e] * 1.4426950408889634f - mnl2); l += pv[e]; }
        const bf16x8 pf = pack8(pv);
#pragma unroll
        for (int dt = 0; dt < 4; ++dt) o[dt] = __builtin_amdgcn_mfma_f32_16x16x32_bf16(vf[st & 1][dt], pf, o[dt], 0, 0, 0);
        if (st + 2 < 8) LOADV(vctx, 32, NCTX, st & 1, st + 2);
    }
#undef LOADK
#undef LOADV
    l += __shfl_xor(l, 16); l += __shfl_xor(l, 32);
    const float inv = 1.0f / l;
#pragma unroll
    for (int dt = 0; dt < 4; ++dt) { u32x2 w; w.x = pk2(o[dt][0] * inv, o[dt][1] * inv); w.y = pk2(o[dt][2] * inv, o[dt][3] * inv);
        *(u32x2*)(YB + tq * 1024 + h * 64 + 16 * dt + 4 * fq) = w; }
}
__device__ __forceinline__ void phase_attn_s(const P& p, int bid, int nblk, unsigned char* lds) {
    const int tid_ = tid_opaque(); const int wave = tid_ >> 6, lane = tid_ & 63;
    float* tbl = (float*)lds;
    __syncthreads();
    attn_stage_rpb(p, tbl, tid_);
    __syncthreads();
    for (int bu = bid; bu < NB * 64 * 8; bu += nblk) { const int hp = bu & 7, r = (bu >> 3) & 63, b = bu >> 9;
        attn_wave_unit(p, tbl, b, r, wave & 3, 2 * hp + (wave >> 2), lane); }
}
struct EpiMergeA { const bf16_t* G; bf16_t* INNER;
    __device__ __forceinline__ void operator()(int r, int n, float v) const { INNER[(size_t)r * 1024 + n] = (bf16_t)f2bf(bf2f(G[(size_t)r * 2048 + n]) * v); } };
struct EpiMergeB { const bf16_t* G; bf16_t* INNER;
    __device__ __forceinline__ void operator()(int r, int n, float v) const { const size_t o = (size_t)r * 1024 + n; INNER[o] = (bf16_t)f2bf(bf2f(INNER[o]) + bf2f(G[(size_t)r * 2048 + 1024 + n]) * v); } };
template <int WHICH> __device__ __forceinline__ void phase_merge_s(const P& p, int bid, int nblk) {
    const int tid_ = tid_opaque(); const int wave = tid_ >> 6, lane = tid_ & 63; unsigned char* ws = p.ws;
    const int ntn = 1024 / 32, ntiles = (NTOK / 32) * ntn;
    if (WHICH == 0) { ARowDense ar{(const bf16_t*)(ws + WS_U), 1024}, br{(const bf16_t*)(ws + WS_WPA), 1024}; EpiMergeA e{(const bf16_t*)(ws + WS_G), (bf16_t*)(ws + WS_INNER)};
        for (int t = bid * 8 + wave; t < ntiles; t += nblk * 8) sgemm_wave_tile((t / ntn) * 32, (t % ntn) * 32, 1024, ar, br, e, lane);
    } else { ARowDense ar{(const bf16_t*)(ws + WS_YB), 1024}, br{(const bf16_t*)(ws + WS_WPB), 1024}; EpiMergeB e{(const bf16_t*)(ws + WS_G), (bf16_t*)(ws + WS_INNER)};
        for (int t = bid * 8 + wave; t < ntiles; t += nblk * 8) sgemm_wave_tile((t / ntn) * 32, (t % ntn) * 32, 1024, ar, br, e, lane); }
}
struct EpiMix { const float *x, *rowstat, *lng, *lnb, *mod, *b_out; float* out;
    __device__ __forceinline__ void operator()(int r, int n, float v) const {
        const int b = r >> 12; const float x0 = (x[(size_t)r * 1024 + n] - rowstat[2 * r]) * rowstat[2 * r + 1] * lng[n] + lnb[n];
        out[(size_t)r * 1024 + n] = ALPHA * x0 + mod[b * 6144 + 2048 + n] * (v + b_out[n]); } };
__device__ __forceinline__ void phase_mix_s(const P& p, int bid, int nblk) {
    const int tid_ = tid_opaque(); const int wave = tid_ >> 6, lane = tid_ & 63; unsigned char* ws = p.ws;
    const int ntn = 1024 / 32, ntiles = (NTOK / 32) * ntn;
    ARowDense ar{(const bf16_t*)(ws + WS_INNER), 1024}, br{(const bf16_t*)(ws + WS_WOUT), 1024};
    EpiMix e{p.x, (const float*)(ws + WS_ROWSTAT), p.ln_x_g, p.ln_x_b, (const float*)(ws + WS_MOD), p.b_out, p.out};
    for (int t = bid * 8 + wave; t < ntiles; t += nblk * 8) sgemm_wave_tile((t / ntn) * 32, (t % ntn) * 32, 1024, ar, br, e, lane);
}

constexpr int RT_LDS_W = 0, RT_LDS_CNT = 131072, RT_LDS_BASE = RT_LDS_CNT + 128, RT_LDS_REC = RT_LDS_BASE + 128, RT_MAXIT = 32, RT_LDS_END = RT_LDS_REC + 8 * RT_MAXIT * 8 * 4;
__device__ __forceinline__ int rw_off(int prow, int ch) { return prow * 128 + ((ch ^ ((prow >> 1) & 7)) << 4); }
__device__ __forceinline__ void phase_router(const P& p, int bid, int nblk, unsigned char* lds) {
    const int tid = tid_opaque(), wave = tid >> 6, lane = tid & 63;
    int* cnt = (int*)(lds + RT_LDS_CNT); int* base = (int*)(lds + RT_LDS_BASE); int* rec = (int*)(lds + RT_LDS_REC) + wave * RT_MAXIT * 8;
    for (int k = tid; k < 1024; k += 512) { const int l = (k & 255) >> 2, i = k & 3, j = k >> 8, prow = l + 64 * (4 * j + i);
        const f32x4* src = (const f32x4*)(p.router_w + (size_t)k * 32);
#pragma unroll
        for (int ch = 0; ch < 8; ++ch) *(f32x4*)(lds + RT_LDS_W + rw_off(prow, ch)) = src[ch]; }
    if (tid < 32) cnt[tid] = 0;
    __syncthreads();
    const float* mod = (const float*)(p.ws + WS_MOD);
    int* TOPE = (int*)(p.ws + WS_TOPE); float* TOPG = (float*)(p.ws + WS_TOPG); int* SLOT = (int*)(p.ws + WS_SLOT);
    bf16_t* U2 = (bf16_t*)(p.ws + WS_U);
    const int erev = (int)(__builtin_bitreverse32((unsigned)(lane & 31)) >> 27);
    unsigned wb[8];
#pragma unroll
    for (int ch = 0; ch < 8; ++ch) wb[ch] = RT_LDS_W + lane * 128 + ((ch ^ ((lane >> 1) & 7)) << 4);
    int it = 0;
    for (int row = bid * 8 + wave; row < NTOK; row += nblk * 8, ++it) {
        const int b = row >> 12;
        f32x4* xr = (f32x4*)(p.out + (size_t)row * DM) + lane;
        f32x4 v[4]; float s = 0.f;
#pragma unroll
        for (int j = 0; j < 4; ++j) { v[j] = xr[64 * j]; s += (v[j].x + v[j].y) + (v[j].z + v[j].w); }
        const float mean = wave_sum(s) * (1.f / DM); float s2 = 0.f;
#pragma unroll
        for (int j = 0; j < 4; ++j) { v[j] = v[j] - mean; s2 += (v[j].x * v[j].x + v[j].y * v[j].y) + (v[j].z * v[j].z + v[j].w * v[j].w); }
        const float rstd = 1.f / sqrtf(wave_sum(s2) * (1.f / DM) + LN_EPS);
        float a[32];
#pragma unroll
        for (int e = 0; e < 32; ++e) a[e] = 0.f;
        u32x2* o8 = (u32x2*)(U2 + (size_t)row * DM) + lane;
        int lane_o = lane; asm volatile("" : "+v"(lane_o));
#pragma unroll
        for (int j = 0; j < 4; ++j) { const int col = 4 * lane_o + 256 * j;
            const f32x4 gg = *(const f32x4*)(p.ln1_g + col), bb = *(const f32x4*)(p.ln1_b + col);
            const f32x4 shv = *(const f32x4*)(mod + b * 6144 + 3072 + col), scv = *(const f32x4*)(mod + b * 6144 + 4096 + col);
            const f32x4 x1 = (v[j] * rstd) * gg + bb; xr[64 * j] = x1;
            const f32x4 u = x1 * (1.0f + scv) + shv;
            u32x2 w; w.x = pk2(u.x, u.y); w.y = pk2(u.z, u.w); o8[64 * j] = w;
#pragma unroll
            for (int i = 0; i < 4; ++i) { const float uv = u[i];
#pragma unroll
                for (int ch = 0; ch < 8; ++ch) { const f32x4 w4 = *(const f32x4*)(lds + wb[ch] + (4 * j + i) * 8192);
                    a[4 * ch + 0] += uv * w4.x; a[4 * ch + 1] += uv * w4.y; a[4 * ch + 2] += uv * w4.z; a[4 * ch + 3] += uv * w4.w; } }
        }
#pragma unroll
        for (int st = 0; st < 5; ++st) { const int n = 16 >> st; const bool up = (lane >> st) & 1;
#pragma unroll
            for (int i = 0; i < n; ++i) { const float keep = up ? a[n + i] : a[i], send = up ? a[i] : a[n + i]; a[i] = keep + __shfl_xor(send, 1 << st); } }
        float logit = a[0] + __shfl_xor(a[0], 32);
        logit += p.router_b[erev];
        float cur = logit;
#define TOP_STEP(TV, TE) float TV; int TE; { const float mx = wave_max(cur); int cand = (cur == mx) ? erev : 64; \
            cand = min(cand, __shfl_xor(cand, 1)); cand = min(cand, __shfl_xor(cand, 2)); cand = min(cand, __shfl_xor(cand, 4)); \
            cand = min(cand, __shfl_xor(cand, 8)); cand = min(cand, __shfl_xor(cand, 16)); cand = min(cand, __shfl_xor(cand, 32)); \
            TV = mx; TE = cand; if (erev == cand) cur = -INFINITY; }
        TOP_STEP(tv0, te0) TOP_STEP(tv1, te1) TOP_STEP(tv2, te2) TOP_STEP(tv3, te3)
#undef TOP_STEP
        const float gk0 = 1.0f, gk1 = __expf(tv1 - tv0), gk2 = __expf(tv2 - tv0), gk3 = __expf(tv3 - tv0);
        const float ginv = 1.f / (gk0 + gk1 + gk2 + gk3);
        if (lane < 4) { const int e = lane == 0 ? te0 : lane == 1 ? te1 : lane == 2 ? te2 : te3; const float g = lane == 0 ? gk0 : lane == 1 ? gk1 : lane == 2 ? gk2 : gk3;
            const int pos = atomicAdd(&cnt[e], 1);
            TOPE[row * 4 + lane] = e; TOPG[row * 4 + lane] = g * ginv;
            if (it < RT_MAXIT) { rec[it * 8 + lane * 2] = e; rec[it * 8 + lane * 2 + 1] = pos; } }
    }
    __syncthreads();
    if (tid < 32) base[tid] = atomicAdd((int*)(p.ws + WS_CTL) + tid, cnt[tid]);
    __syncthreads();
    it = 0;
    int* PERM2 = (int*)(p.ws + WS_PERM2);
    for (int row = bid * 8 + wave; row < NTOK; row += nblk * 8, ++it)
        if (lane < 4 && it < RT_MAXIT) { const int e = rec[it * 8 + lane * 2], pos = base[e] + rec[it * 8 + lane * 2 + 1]; SLOT[row * 4 + lane] = pos; PERM2[(size_t)e * NTOK + pos] = row; }
}
constexpr int MT_LDS = 131072 + 1024;
__device__ __forceinline__ void moe_tables(const P& p, unsigned char* lds) {
    const int tid = tid_opaque(); int* cn = (int*)(lds + MT_LDS); int* eb = cn + 32; int* tb = eb + 33;
    __syncthreads();
    if (tid < 32) cn[tid] = __hip_atomic_load((int*)(p.ws + WS_CTL) + tid, __ATOMIC_RELAXED, __HIP_MEMORY_SCOPE_AGENT);
    __syncthreads();
    if (tid == 0) { int s = 0, t = 0; for (int e = 0; e < 32; ++e) { eb[e] = s; tb[e] = t; s += cn[e]; t += (cn[e] + 255) >> 8; } eb[32] = s; tb[32] = t; }
    __syncthreads();
}
__device__ __forceinline__ void phase_final(const P& p, int bid, int nblk, unsigned char* lds) {
    moe_tables(p, lds); const int* eb = (const int*)(lds + MT_LDS) + 32; const int* TOPE = (const int*)(p.ws + WS_TOPE);
    const int tid = tid_opaque(), wave = tid >> 6, lane = tid & 63;
    const float* mod = (const float*)(p.ws + WS_MOD); const int* SLOT = (const int*)(p.ws + WS_SLOT); const float* TOPG = (const float*)(p.ws + WS_TOPG);
    const bf16_t* YS = (const bf16_t*)(p.ws + WS_YS);
    for (int row = bid * 8 + wave; row < NTOK; row += nblk * 8) {
        const int b = row >> 12;
        int sl[4]; float gk[4];
#pragma unroll
        for (int k = 0; k < 4; ++k) { sl[k] = eb[TOPE[row * 4 + k]] + SLOT[row * 4 + k]; gk[k] = TOPG[row * 4 + k]; }
        f32x4* xr = (f32x4*)(p.out + (size_t)row * DM) + lane;
        f32x4 v[4]; float s = 0.f;
#pragma unroll
        for (int j = 0; j < 4; ++j) { const int col = 4 * lane + 256 * j; f32x4 ff = (f32x4){0.f, 0.f, 0.f, 0.f};
#pragma unroll
            for (int k = 0; k < 4; ++k) { const u32x2 w = *((const u32x2*)(YS + (size_t)sl[k] * 1024 + col));
                ff.x += gk[k] * bflo(w.x); ff.y += gk[k] * bfhi(w.x); ff.z += gk[k] * bflo(w.y); ff.w += gk[k] * bfhi(w.y); }
            const f32x4 g2 = *(const f32x4*)(mod + b * 6144 + 5120 + col);
            v[j] = xr[64 * j] * ALPHA + g2 * ff; s += (v[j].x + v[j].y) + (v[j].z + v[j].w); }
        const float mean = wave_sum(s) * (1.f / DM); float s2 = 0.f;
#pragma unroll
        for (int j = 0; j < 4; ++j) { v[j] = v[j] - mean; s2 += (v[j].x * v[j].x + v[j].y * v[j].y) + (v[j].z * v[j].z + v[j].w * v[j].w); }
        const float rstd = 1.f / sqrtf(wave_sum(s2) * (1.f / DM) + LN_EPS);
#pragma unroll
        for (int j = 0; j < 4; ++j) { const int col = 4 * lane + 256 * j; const f32x4 gg = *(const f32x4*)(p.ln2_g + col), bb = *(const f32x4*)(p.ln2_b + col);
            xr[64 * j] = (v[j] * rstd) * gg + bb; }
    }
}

namespace pg {
#define PG_LAS __attribute__((address_space(3)))
typedef float f32x2 __attribute__((ext_vector_type(2)));
constexpr int BM = 256, BK = 64, HALF = 128, HTB = HALF * BK * 2, STAGE_BYTES = 8 * HTB, KD = 1024, NT = KD / BK;
constexpr unsigned KSTEP = BK * 2, HSTEPB = HALF * KD * 2;
__host__ __device__ __forceinline__ int lds_byte(int r, int c) { const int st = (r >> 4) * 2 + (c >> 5), rr = r & 15, cc = c & 31, ob = rr * 64 + cc * 2; return st * 1024 + (ob ^ (((ob >> 9) & 1) << 5)); }
__host__ __device__ __forceinline__ void stage_rc(int b, int& R, int& C) { const int st = b / 1024, sb = b % 1024, swz = sb ^ (((sb >> 9) & 1) << 5); R = (st >> 1) * 16 + swz / 64; C = (st & 1) * 32 + (swz % 64) / 2; }
__host__ __device__ __forceinline__ int perm32(int rho) { const int n = rho >> 4, i = rho & 15; return 8 * (i >> 2) + 4 * n + (i & 3); }
struct Unit { int pm, pn, row0, nrows, e, kind; };
__device__ __forceinline__ void tilemap(int L, int nM, int nN, int& pm, int& pn) {
    int wgid = L; { const int nwg = nM * nN, q = nwg / 8, r = nwg % 8, xcd = wgid % 8, off = wgid / 8; wgid = (xcd < r ? xcd * (q + 1) : r * (q + 1) + (xcd - r) * q) + off; }
    const int nig = 8 * nN, gid = wgid / nig, fm = gid * 8, gsz = (nM - fm) < 8 ? (nM - fm) : 8;
    pm = fm + ((wgid % nig) % gsz); pn = (wgid % nig) / gsz;
}
__device__ __forceinline__ unsigned cvt_pk_bf16(float lo, float hi) { unsigned r; asm volatile("v_cvt_pk_bf16_f32 %0, %1, %2" : "=v"(r) : "v"(lo), "v"(hi)); return r; }
__device__ __forceinline__ f32x2 gelu_pk(f32x2 v) {
    const f32x2 av = __builtin_elementwise_abs(v), d = av * 0.2316418882f + 1.0f;
    f32x2 t; t.x = __builtin_amdgcn_rcpf(d.x); t.y = __builtin_amdgcn_rcpf(d.y);
    f32x2 q = t * 0.5307027145f + (-0.7265760135f); q = q * t + 0.7107068705f; q = q * t + (-0.142248368f); q = q * t + 0.127414796f; q = q * t;
    const f32x2 s = (v * v) * (-0.72134752044f);
    f32x2 e; e.x = __builtin_amdgcn_exp2f(s.x); e.y = __builtin_amdgcn_exp2f(s.y);
    const f32x2 m = v * (q * e), r = v - m;
    f32x2 o; o.x = v.x < 0.f ? m.x : r.x; o.y = v.y < 0.f ? m.y : r.y; return o;
}
__device__ __forceinline__ f32x4 gelu4(f32x4 v) { const f32x2 a = gelu_pk((f32x2){v[0], v[1]}), b = gelu_pk((f32x2){v[2], v[3]}); return (f32x4){a.x, a.y, b.x, b.y}; }
__device__ __forceinline__ f32x4 sigmoid4(f32x4 v) { f32x4 o;
#pragma unroll
    for (int i = 0; i < 4; ++i) o[i] = __builtin_amdgcn_rcpf(1.0f + __builtin_amdgcn_exp2f(-1.4426950408889634f * v[i]));
    return o; }
__device__ __forceinline__ u32x4 pack8v(f32x4 a, f32x4 b) { u32x4 w; w.x = cvt_pk_bf16(a[0], a[1]); w.y = cvt_pk_bf16(a[2], a[3]); w.z = cvt_pk_bf16(b[0], b[1]); w.w = cvt_pk_bf16(b[2], b[3]); return w; }

template <class Epi, class Sched, bool ALIGN_EPI>
__device__ __forceinline__ void gemm_phase(PG_LAS unsigned char* lds, const unsigned char* Abase, const Sched& S, const Epi& E) {
    const int tid = tid_opaque(), wid = __builtin_amdgcn_readfirstlane(tid >> 6), lane = tid & 63, wr = wid >> 2, wc = wid & 3, fr = lane & 15, fq = lane >> 4;
    int R[2], C[2]; unsigned voffB[2];
#pragma unroll
    for (int i = 0; i < 2; ++i) { stage_rc(tid * 16 + i * 8192, R[i], C[i]); const int Rb = Epi::PERM ? ((R[i] & ~31) + perm32(R[i] & 31)) : R[i]; voffB[i] = (unsigned)(Rb * KD + C[i]) * 2u; }
    const unsigned ldsw = (unsigned)wid * 1024u;
    const int aoff = lds_byte(wr * 64 + fr, fq * 8), boff = lds_byte(wc * 32 + fr, fq * 8);
#define PG_SA(b, h) (((b) * 2 + (h)) * HTB)
#define PG_SB(b, h) ((4 + (b) * 2 + (h)) * HTB)
#define PG_STAGE_A(bufoff, kbyte, vo) do { _Pragma("unroll") for (int _i = 0; _i < 2; ++_i) \
        __builtin_amdgcn_global_load_lds((const unsigned*)((const char*)Abase + (kbyte) + (vo)[_i]), (PG_LAS unsigned*)(lds + (bufoff) + ldsw + _i * 8192), 16, 0, 0); } while (0)
#define PG_STAGE_B(bufoff, gbase) do { _Pragma("unroll") for (int _i = 0; _i < 2; ++_i) \
        __builtin_amdgcn_global_load_lds((const unsigned*)((const char*)(gbase) + voffB[_i]), (PG_LAS unsigned*)(lds + (bufoff) + ldsw + _i * 8192), 16, 0, 0); } while (0)
#define PG_LDA(dst, b, h) do { _Pragma("unroll") for (int m = 0; m < 4; ++m) _Pragma("unroll") for (int k = 0; k < 2; ++k) dst[m][k] = *(const PG_LAS bf16x8*)(lds + PG_SA(b, h) + aoff + m * 2048 + k * 1024); } while (0)
#define PG_LDB(dst, b, h) do { _Pragma("unroll") for (int n = 0; n < 2; ++n) _Pragma("unroll") for (int k = 0; k < 2; ++k) dst[n][k] = *(const PG_LAS bf16x8*)(lds + PG_SB(b, h) + boff + n * 2048 + k * 1024); } while (0)
#define PG_MMA(ai, bj, At, Bt) do { __builtin_amdgcn_s_setprio(1); _Pragma("unroll") for (int m = 0; m < 4; ++m) _Pragma("unroll") for (int n = 0; n < 2; ++n) _Pragma("unroll") for (int k = 0; k < 2; ++k) \
        acc[ai][bj][m][n] = __builtin_amdgcn_mfma_f32_16x16x32_bf16(Bt[n][k], At[m][k], acc[ai][bj][m][n], 0, 0, 0); __builtin_amdgcn_s_setprio(0); } while (0)
#define PG_WAIT_V(n) asm volatile("s_waitcnt vmcnt(" #n ")" ::: "memory")
#define PG_WAIT_L(n) asm volatile("s_waitcnt lgkmcnt(" #n ")" ::: "memory")
#define PG_BAR __builtin_amdgcn_s_barrier()
#define PG_SCHED __builtin_amdgcn_sched_barrier(0)
    Unit cur, nxt; int ui = 0;
    if (!S.next(0, cur)) return;
    f32x4 acc[2][2][4][2];
#pragma unroll
    for (int a = 0; a < 2; ++a)
#pragma unroll
        for (int b = 0; b < 2; ++b)
#pragma unroll
            for (int m = 0; m < 4; ++m)
#pragma unroll
                for (int n = 0; n < 2; ++n) acc[a][b][m][n] = (f32x4){0.f, 0.f, 0.f, 0.f};
    bf16x8 At[4][2], B0[2][2], B1[2][2];
    unsigned ac[2][2], an[2][2];
    S.aoffs(cur, R, C, ac);
    const char* cB = S.bptr(cur);
    PG_STAGE_B(PG_SB(0, 0), cB); PG_STAGE_B(PG_SB(0, 1), cB + HSTEPB); PG_STAGE_A(PG_SA(0, 0), 0u, ac[0]); PG_STAGE_A(PG_SA(0, 1), 0u, ac[1]);
    if (wr == 1) PG_BAR;
    PG_WAIT_V(2); PG_BAR;
    PG_STAGE_B(PG_SB(1, 0), cB + KSTEP); PG_STAGE_A(PG_SA(1, 0), KSTEP, ac[0]); PG_STAGE_B(PG_SB(1, 1), cB + HSTEPB + KSTEP);
    PG_WAIT_V(6); PG_BAR;
    for (;;) {
        const bool has_next = S.next(ui + 1, nxt);
        const char* nB = cB;
        if (has_next) { S.aoffs(nxt, R, C, an); nB = S.bptr(nxt); }
        else {
#pragma unroll
            for (int h = 0; h < 2; ++h)
#pragma unroll
                for (int i = 0; i < 2; ++i) an[h][i] = ac[h][i]; }
        for (int t = 0; t < NT; t += 2) {
            const bool last = (t == NT - 2);
            const unsigned ka1 = (unsigned)(t + 1) * KSTEP;
            const unsigned ka2 = last ? 0u : (unsigned)(t + 2) * KSTEP;
            const char* b2 = last ? nB : cB + (size_t)(t + 2) * KSTEP; const char* b3 = b2 + KSTEP;
            unsigned a2o[2][2];
#pragma unroll
            for (int h = 0; h < 2; ++h)
#pragma unroll
                for (int i = 0; i < 2; ++i) a2o[h][i] = last ? an[h][i] : ac[h][i];
            PG_LDB(B0, 0, 0); PG_LDB(B1, 0, 1); PG_SCHED; PG_LDA(At, 0, 0); PG_STAGE_A(PG_SA(1, 1), ka1, ac[1]);
            PG_WAIT_V(8); PG_WAIT_L(0); PG_BAR; PG_MMA(0, 0, At, B0); PG_MMA(0, 1, At, B1); PG_BAR; PG_SCHED;
            PG_LDA(At, 0, 1); PG_STAGE_B(PG_SB(0, 0), b2); PG_STAGE_B(PG_SB(0, 1), b2 + HSTEPB); PG_STAGE_A(PG_SA(0, 0), ka2, a2o[0]);
            PG_WAIT_V(8); PG_WAIT_L(0); PG_BAR; PG_MMA(1, 0, At, B0); PG_MMA(1, 1, At, B1); PG_BAR; PG_SCHED;
            PG_LDB(B0, 1, 0); PG_LDB(B1, 1, 1); PG_SCHED; PG_LDA(At, 1, 0); PG_STAGE_A(PG_SA(0, 1), ka2, a2o[1]);
            PG_WAIT_V(8); PG_WAIT_L(0); PG_BAR; PG_MMA(0, 0, At, B0); PG_MMA(0, 1, At, B1); PG_BAR; PG_SCHED;
            PG_LDA(At, 1, 1); PG_STAGE_B(PG_SB(1, 0), b3); PG_STAGE_B(PG_SB(1, 1), b3 + HSTEPB); PG_STAGE_A(PG_SA(1, 0), ka2 + KSTEP, a2o[0]);
            PG_WAIT_V(8); PG_WAIT_L(0); PG_BAR; PG_MMA(1, 0, At, B0); PG_MMA(1, 1, At, B1); PG_BAR; PG_SCHED;
        }
        if constexpr (ALIGN_EPI) { if (wr == 0) PG_BAR; }
        E.run(acc, cur, wr, wc, fr, fq);
        if (!has_next) break;
        if (!E.carry(cur)) {
#pragma unroll
            for (int a = 0; a < 2; ++a)
#pragma unroll
                for (int b = 0; b < 2; ++b)
#pragma unroll
                    for (int m = 0; m < 4; ++m)
#pragma unroll
                        for (int n = 0; n < 2; ++n) acc[a][b][m][n] = (f32x4){0.f, 0.f, 0.f, 0.f}; }
        cur = nxt; cB = nB; ++ui;
#pragma unroll
        for (int h = 0; h < 2; ++h)
#pragma unroll
            for (int i = 0; i < 2; ++i) ac[h][i] = an[h][i];
        if constexpr (ALIGN_EPI) { if (wr == 1) PG_BAR; }
    }
    PG_WAIT_V(0);
    if constexpr (!ALIGN_EPI) { if (wr == 0) PG_BAR; }
    PG_BAR;
#undef PG_SA
#undef PG_SB
#undef PG_STAGE_A
#undef PG_STAGE_B
#undef PG_LDA
#undef PG_LDB
#undef PG_MMA
#undef PG_WAIT_V
#undef PG_WAIT_L
#undef PG_BAR
#undef PG_SCHED
}

struct SchedP1 {
    int G, c; const unsigned char* ws;
    __device__ __forceinline__ bool next(int i, Unit& u) const {
        const int L = i * G + c; if (L >= 3136) return false;
        u.row0 = 0; u.nrows = 256; u.e = 0;
        if (L < 2048) { u.kind = 0; tilemap(L, 128, 16, u.pm, u.pn); }
        else if (L < 3072) { u.kind = 1; tilemap(L - 2048, 8, 128, u.pm, u.pn); }
        else if (L < 3104) { u.kind = 2; const int l = L - 3072; u.pm = l >> 2; u.pn = l & 3; }
        else { u.kind = 3; const int l = L - 3104; u.pm = l >> 3; u.pn = l & 7; }
        return true; }
    __device__ __forceinline__ void aoffs(const Unit& u, const int (&R)[2], const int (&C)[2], unsigned (&o)[2][2]) const {
        size_t base; int row0;
        if (u.kind == 0) { base = WS_U; row0 = 256 * u.pm; }
        else if (u.kind == 1) { base = WS_WIN; row0 = u.pm < 4 ? 1024 + 256 * u.pm : 4096 + 256 * (u.pm - 4); }
        else if (u.kind == 2) { base = WS_UC; row0 = 256 * u.pm; }
        else { base = WS_WIN; row0 = 4096 + 256 * u.pm; }
#pragma unroll
        for (int h = 0; h < 2; ++h)
#pragma unroll
            for (int i = 0; i < 2; ++i) o[h][i] = (unsigned)(base + ((size_t)(row0 + 128 * h + R[i]) * 1024 + C[i]) * 2); }
    __device__ __forceinline__ const char* bptr(const Unit& u) const {
        if (u.kind == 0) { const int wrow = u.pn < 4 ? 256 * u.pn : (u.pn < 8 ? 2048 + 256 * (u.pn - 4) : 5120 + 256 * (u.pn - 8)); return (const char*)ws + WS_WIN + (size_t)wrow * 2048; }
        if (u.kind == 1) return (const char*)ws + WS_U + (size_t)u.pn * 256 * 2048;
        if (u.kind == 2) return (const char*)ws + WS_WIN + (size_t)(3072 + 256 * u.pn) * 2048;
        return (const char*)ws + WS_UC + (size_t)u.pn * 256 * 2048; }
};
struct EpiP1 {
    static constexpr bool PERM = true;
    unsigned char* ws; const float* b_in;
    __device__ __forceinline__ bool carry(const Unit&) const { return false; }
    __device__ __forceinline__ void run(f32x4 (&acc)[2][2][4][2], const Unit& u, int wr, int wc, int fr, int fq) const {
        bf16_t* dst; size_t ldc; int act, colbase, bcol; bool brow; int browbase, rowbase;
        if (u.kind == 0) { rowbase = 256 * u.pm; brow = false; browbase = 0;
            if (u.pn < 4) { dst = (bf16_t*)(ws + WS_ZU); ldc = 1024; act = 1; colbase = 256 * u.pn; bcol = 256 * u.pn; }
            else if (u.pn < 8) { dst = (bf16_t*)(ws + WS_Q); ldc = 1024; act = 0; colbase = 256 * (u.pn - 4); bcol = 2048 + 256 * (u.pn - 4); }
            else { dst = (bf16_t*)(ws + WS_G); ldc = 2048; act = 2; colbase = 256 * (u.pn - 8); bcol = 5120 + 256 * (u.pn - 8); } }
        else if (u.kind == 1) { brow = true; ldc = NTOK; colbase = 256 * u.pn; bcol = 0;
            if (u.pm < 4) { dst = (bf16_t*)(ws + WS_ZVT); act = 1; rowbase = 256 * u.pm; browbase = 1024; }
            else { dst = (bf16_t*)(ws + WS_VT); act = 0; rowbase = 256 * (u.pm - 4); browbase = 4096; } }
        else if (u.kind == 2) { dst = (bf16_t*)(ws + WS_KC); ldc = 1024; act = 0; rowbase = 256 * u.pm; colbase = 256 * u.pn; bcol = 3072 + 256 * u.pn; brow = false; browbase = 0; }
        else { dst = (bf16_t*)(ws + WS_VCT); ldc = NCTX; act = 0; rowbase = 256 * u.pm; colbase = 256 * u.pn; bcol = 0; brow = true; browbase = 4096; }
        const int lc = wc * 32 + 8 * fq;
        f32x4 bv[2][2];
#pragma unroll
        for (int bj = 0; bj < 2; ++bj)
#pragma unroll
            for (int n = 0; n < 2; ++n) bv[bj][n] = brow ? (f32x4){0.f, 0.f, 0.f, 0.f} : *(const f32x4*)(b_in + bcol + lc + bj * HALF + 4 * n);
#pragma unroll
        for (int ai = 0; ai < 2; ++ai)
#pragma unroll
            for (int m = 0; m < 4; ++m) { const int row = rowbase + ai * HALF + wr * 64 + m * 16 + fr;
                const float rb = brow ? b_in[browbase + row] : 0.f;
                bf16_t* rowp = dst + (size_t)row * ldc + colbase + lc;
#pragma unroll
                for (int bj = 0; bj < 2; ++bj) { f32x4 v0 = acc[ai][bj][m][0] + bv[bj][0] + rb, v1 = acc[ai][bj][m][1] + bv[bj][1] + rb;
                    if (act == 1) { v0 = gelu4(v0); v1 = gelu4(v1); } else if (act == 2) { v0 = sigmoid4(v0); v1 = sigmoid4(v1); }
                    *(u32x4*)(rowp + bj * HALF) = pack8v(v0, v1); } }
    }
};
struct SchedK {
    int G, c; const unsigned char* ws;
    __device__ __forceinline__ bool next(int i, Unit& u) const { const int L = i * G + c; if (L >= 512) return false; u.kind = 0; u.row0 = 0; u.nrows = 256; u.e = 0; tilemap(L, 128, 4, u.pm, u.pn); return true; }
    __device__ __forceinline__ void aoffs(const Unit& u, const int (&R)[2], const int (&C)[2], unsigned (&o)[2][2]) const {
#pragma unroll
        for (int h = 0; h < 2; ++h)
#pragma unroll
            for (int i = 0; i < 2; ++i) o[h][i] = (unsigned)(WS_U + ((size_t)(256 * u.pm + 128 * h + R[i]) * 1024 + C[i]) * 2); }
    __device__ __forceinline__ const char* bptr(const Unit& u) const { return (const char*)ws + WS_WIN + (size_t)(3072 + 256 * u.pn) * 2048; }
};
struct EpiRope {
    static constexpr bool PERM = false;
    unsigned char* ws; const float* b_in;
    __device__ __forceinline__ bool carry(const Unit&) const { return false; }
    __device__ __forceinline__ void run(f32x4 (&acc)[2][2][4][2], const Unit& u, int wr, int wc, int fr, int fq) const {
        bf16_t* K = (bf16_t*)(ws + WS_K); const float* tab = (const float*)(ws + WS_ROPE);
        const int lc = wc * 32 + 4 * fq, axis = wc & 1;
        f32x4 b0[2], b1[2];
#pragma unroll
        for (int bj = 0; bj < 2; ++bj) { b0[bj] = *(const f32x4*)(b_in + 3072 + 256 * u.pn + bj * HALF + lc); b1[bj] = *(const f32x4*)(b_in + 3072 + 256 * u.pn + bj * HALF + lc + 16); }
#pragma unroll
        for (int ai = 0; ai < 2; ++ai)
#pragma unroll
            for (int m = 0; m < 4; ++m) { const int tok = 256 * u.pm + ai * HALF + wr * 64 + m * 16 + fr;
                const int pos = axis ? (tok & 63) : ((tok >> 6) & 63);
                const f32x4 t0 = *(const f32x4*)(tab + (pos * 16 + 4 * fq) * 2), t1 = *(const f32x4*)(tab + (pos * 16 + 4 * fq) * 2 + 4);
                const f32x4 cs = (f32x4){t0[0], t0[2], t1[0], t1[2]}, sn = (f32x4){t0[1], t0[3], t1[1], t1[3]};
                bf16_t* rowp = K + (size_t)tok * 1024 + 256 * u.pn + lc;
#pragma unroll
                for (int bj = 0; bj < 2; ++bj) { const f32x4 v0 = acc[ai][bj][m][0] + b0[bj], v1 = acc[ai][bj][m][1] + b1[bj];
                    const f32x4 o0 = v0 * cs - v1 * sn, o1 = v1 * cs + v0 * sn;
                    u32x2 w0, w1; w0.x = cvt_pk_bf16(o0[0], o0[1]); w0.y = cvt_pk_bf16(o0[2], o0[3]); w1.x = cvt_pk_bf16(o1[0], o1[1]); w1.y = cvt_pk_bf16(o1[2], o1[3]);
                    *(u32x2*)(rowp + bj * HALF) = w0; *(u32x2*)(rowp + bj * HALF + 16) = w1; } }
    }
};
struct SchedMerge {
    int G, c; const unsigned char* ws;
    __device__ __forceinline__ bool next(int i, Unit& u) const { const int L = (i >> 1) * G + c; if (L >= 512) return false; u.kind = i & 1; u.row0 = 0; u.nrows = 256; u.e = 0; tilemap(L, 128, 4, u.pm, u.pn); return true; }
    __device__ __forceinline__ void aoffs(const Unit& u, const int (&R)[2], const int (&C)[2], unsigned (&o)[2][2]) const {
        const size_t base = u.kind ? WS_YB : WS_U;
#pragma unroll
        for (int h = 0; h < 2; ++h)
#pragma unroll
            for (int i = 0; i < 2; ++i) o[h][i] = (unsigned)(base + ((size_t)(256 * u.pm + 128 * h + R[i]) * 1024 + C[i]) * 2); }
    __device__ __forceinline__ const char* bptr(const Unit& u) const { return (const char*)ws + (u.kind ? WS_WPB : WS_WPA) + (size_t)u.pn * 256 * 2048; }
};
struct EpiMerge {
    static constexpr bool PERM = true;
    unsigned char* ws;
    __device__ __forceinline__ bool carry(const Unit& u) const { return u.kind == 0; }
    __device__ __forceinline__ void run(f32x4 (&acc)[2][2][4][2], const Unit& u, int wr, int wc, int fr, int fq) const {
        const bf16_t* Gt = (const bf16_t*)(ws + WS_G); bf16_t* INNER = (bf16_t*)(ws + WS_INNER);
        const int lc = 256 * u.pn + wc * 32 + 8 * fq;
#pragma unroll
        for (int ai = 0; ai < 2; ++ai)
#pragma unroll
            for (int m = 0; m < 4; ++m) { const size_t tok = (size_t)(256 * u.pm + ai * HALF + wr * 64 + m * 16 + fr);
#pragma unroll
                for (int bj = 0; bj < 2; ++bj) { const int col = lc + bj * HALF;
                    const u32x4 gbw = *(const u32x4*)(Gt + tok * 2048 + 1024 + col);
                    f32x4 gb0 = (f32x4){bflo(gbw.x), bfhi(gbw.x), bflo(gbw.y), bfhi(gbw.y)}, gb1 = (f32x4){bflo(gbw.z), bfhi(gbw.z), bflo(gbw.w), bfhi(gbw.w)};
                    if (u.kind == 0) { const u32x4 gaw = *(const u32x4*)(Gt + tok * 2048 + col);
                        const f32x4 ga0 = (f32x4){bflo(gaw.x), bfhi(gaw.x), bflo(gaw.y), bfhi(gaw.y)}, ga1 = (f32x4){bflo(gaw.z), bfhi(gaw.z), bflo(gaw.w), bfhi(gaw.w)};
#pragma unroll
                        for (int i = 0; i < 4; ++i) { acc[ai][bj][m][0][i] *= ga0[i] * __builtin_amdgcn_rcpf(fmaxf(gb0[i], 1e-30f)); acc[ai][bj][m][1][i] *= ga1[i] * __builtin_amdgcn_rcpf(fmaxf(gb1[i], 1e-30f)); }
                    } else { *(u32x4*)(INNER + tok * 1024 + col) = pack8v(acc[ai][bj][m][0] * gb0, acc[ai][bj][m][1] * gb1); } } }
    }
};
struct SchedMix {
    int G, c; const unsigned char* ws;
    __device__ __forceinline__ bool next(int i, Unit& u) const { const int L = i * G + c; if (L >= 512) return false; u.kind = 0; u.row0 = 0; u.nrows = 256; u.e = 0; tilemap(L, 128, 4, u.pm, u.pn); return true; }
    __device__ __forceinline__ void aoffs(const Unit& u, const int (&R)[2], const int (&C)[2], unsigned (&o)[2][2]) const {
#pragma unroll
        for (int h = 0; h < 2; ++h)
#pragma unroll
            for (int i = 0; i < 2; ++i) o[h][i] = (unsigned)(WS_INNER + ((size_t)(256 * u.pm + 128 * h + R[i]) * 1024 + C[i]) * 2); }
    __device__ __forceinline__ const char* bptr(const Unit& u) const { return (const char*)ws + WS_WOUT + (size_t)u.pn * 256 * 2048; }
};
struct EpiMix {
    static constexpr bool PERM = false;
    unsigned char* ws; const float *x, *lng, *lnb, *b_out; float* out;
    __device__ __forceinline__ bool carry(const Unit&) const { return false; }
    __device__ __forceinline__ void run(f32x4 (&acc)[2][2][4][2], const Unit& u, int wr, int wc, int fr, int fq) const {
        const float* rowstat = (const float*)(ws + WS_ROWSTAT); const float* mod = (const float*)(ws + WS_MOD) + ((256 * u.pm) >> 12) * 6144 + 2048;
        f32x2 st[2][4];
#pragma unroll
        for (int ai = 0; ai < 2; ++ai)
#pragma unroll
            for (int m = 0; m < 4; ++m) st[ai][m] = *(const f32x2*)(rowstat + 2 * (256 * u.pm + ai * HALF + wr * 64 + m * 16 + fr));
#pragma unroll
        for (int bj = 0; bj < 2; ++bj)
#pragma unroll
            for (int n = 0; n < 2; ++n) { const int col = 256 * u.pn + bj * HALF + wc * 32 + n * 16 + 4 * fq;
                const f32x4 lg = *(const f32x4*)(lng + col), lb = *(const f32x4*)(lnb + col), bo = *(const f32x4*)(b_out + col), g1 = *(const f32x4*)(mod + col);
#pragma unroll
                for (int ai = 0; ai < 2; ++ai)
#pragma unroll
                    for (int m = 0; m < 4; ++m) { const size_t off = (size_t)(256 * u.pm + ai * HALF + wr * 64 + m * 16 + fr) * 1024 + col;
                        const f32x4 xv = *(const f32x4*)(x + off);
                        const f32x4 x0 = (xv - st[ai][m].x) * st[ai][m].y * lg + lb;
                        *(f32x4*)(out + off) = x0 * ALPHA + g1 * (acc[ai][bj][m][n] + bo); }
                asm volatile("" ::: "memory"); }
    }
};
__device__ __forceinline__ int ld_u(const int* p) { return __builtin_amdgcn_readfirstlane(__hip_atomic_load(p, __ATOMIC_RELAXED, __HIP_MEMORY_SCOPE_AGENT)); }
template <int NPN  > struct SchedMoe {
    int G, c; const unsigned char* ws; const int* tabs;
    __device__ __forceinline__ bool next(int i, Unit& u) const {
        const int* cn = tabs; const int* eb = tabs + 32; const int* tb = tabs + 65;
        const int ntiles = tb[32], tpx = (ntiles + 7) >> 3, x = c & 7, s = c >> 3;
        const int tiles_x = min(tpx, ntiles - x * tpx), ll = i * (G >> 3) + s;
        if (ll >= NPN * tiles_x) return false;
        const int T = x * tpx + ll / NPN; u.pn = ll % NPN; u.kind = 0;
        int e = 0;
#pragma unroll 1
        for (int k = 16; k >= 1; k >>= 1) if (tb[e + k] <= T) e += k;
        const int jt = T - tb[e];
        u.e = __builtin_amdgcn_readfirstlane(e); u.pm = __builtin_amdgcn_readfirstlane(jt);
        u.row0 = __builtin_amdgcn_readfirstlane(eb[e] + 256 * jt); u.nrows = __builtin_amdgcn_readfirstlane(min(256, cn[e] - 256 * jt)); return true; }
    __device__ __forceinline__ void aoffs(const Unit& u, const int (&R)[2], const int (&C)[2], unsigned (&o)[2][2]) const {
        const int* PERM2 = (const int*)(ws + WS_PERM2) + (size_t)u.e * NTOK + 256 * u.pm;
#pragma unroll
        for (int h = 0; h < 2; ++h)
#pragma unroll
            for (int i = 0; i < 2; ++i) { const int lr = min(128 * h + R[i], u.nrows - 1);
                if (NPN == 8) { const int tok = PERM2[lr]; o[h][i] = (unsigned)(WS_U + ((size_t)tok * 1024 + C[i]) * 2); }
                else o[h][i] = (unsigned)(WS_ACT + ((size_t)(u.row0 + lr) * 1024 + C[i]) * 2); } }
    __device__ __forceinline__ const char* bptr(const Unit& u) const {
        if (NPN == 8) return (const char*)ws + WS_W1 + ((size_t)u.e * 2048 + 256 * u.pn) * 2048;
        return (const char*)ws + WS_W2 + ((size_t)u.e * 1024 + 256 * u.pn) * 2048; }
};
struct EpiMoe1 {
    static constexpr bool PERM = true;
    unsigned char* ws; const float* b1;
    __device__ __forceinline__ bool carry(const Unit&) const { return false; }
    __device__ __forceinline__ void run(f32x4 (&acc)[2][2][4][2], const Unit& u, int wr, int wc, int fr, int fq) const {
        bf16_t* ACT = (bf16_t*)(ws + WS_ACT);
        const int col = 128 * u.pn + wc * 32 + 8 * fq;
        f32x4 bg[2], bl[2];
#pragma unroll
        for (int n = 0; n < 2; ++n) { bg[n] = *(const f32x4*)(b1 + u.e * 2048 + col + 4 * n); bl[n] = *(const f32x4*)(b1 + u.e * 2048 + 1024 + col + 4 * n); }
#pragma unroll
        for (int ai = 0; ai < 2; ++ai)
#pragma unroll
            for (int m = 0; m < 4; ++m) { const int lr = ai * HALF + wr * 64 + m * 16 + fr;
                f32x4 a[2];
#pragma unroll
                for (int n = 0; n < 2; ++n) { const f32x4 zgv = acc[ai][0][m][n] + bg[n], zlv = acc[ai][1][m][n] + bl[n];
#pragma unroll
                    for (int i = 0; i < 4; ++i) { const float zg = fminf(zgv[i], 7.0f), zl = fminf(fmaxf(zlv[i], -7.0f), 7.0f);
                        a[n][i] = zg * __builtin_amdgcn_rcpf(1.0f + __builtin_amdgcn_exp2f(-1.702f * 1.4426950408889634f * zg)) * (zl + 1.0f); } }
                if (lr < u.nrows) *(u32x4*)(ACT + (size_t)(u.row0 + lr) * 1024 + col) = pack8v(a[0], a[1]); }
    }
};
struct EpiMoe2 {
    static constexpr bool PERM = true;
    unsigned char* ws; const float* b2;
    __device__ __forceinline__ bool carry(const Unit&) const { return false; }
    __device__ __forceinline__ void run(f32x4 (&acc)[2][2][4][2], const Unit& u, int wr, int wc, int fr, int fq) const {
        bf16_t* YS = (bf16_t*)(ws + WS_YS);
        const int lc = 256 * u.pn + wc * 32 + 8 * fq;
        f32x4 bv[2][2];
#pragma unroll
        for (int bj = 0; bj < 2; ++bj)
#pragma unroll
            for (int n = 0; n < 2; ++n) bv[bj][n] = *(const f32x4*)(b2 + u.e * 1024 + lc + bj * HALF + 4 * n);
#pragma unroll
        for (int ai = 0; ai < 2; ++ai)
#pragma unroll
            for (int m = 0; m < 4; ++m) { const int lr = ai * HALF + wr * 64 + m * 16 + fr;
                if (lr < u.nrows) {
#pragma unroll
                    for (int bj = 0; bj < 2; ++bj) *(u32x4*)(YS + (size_t)(u.row0 + lr) * 1024 + lc + bj * HALF) = pack8v(acc[ai][bj][m][0] + bv[bj][0], acc[ai][bj][m][1] + bv[bj][1]); } }
    }
};
}
__device__ __forceinline__ void phase_merge_fast(const P& p, int bid, int nblk, unsigned char* lds) {
    pg::SchedMerge S{nblk, bid, p.ws}; pg::EpiMerge E{p.ws};
    pg::gemm_phase<pg::EpiMerge, pg::SchedMerge, true>((PG_LAS unsigned char*)lds, p.ws, S, E);
}
__device__ __forceinline__ void phase_mix_fast(const P& p, int bid, int nblk, unsigned char* lds) {
    pg::SchedMix S{nblk, bid, p.ws}; pg::EpiMix E{p.ws, p.x, p.ln_x_g, p.ln_x_b, p.b_out, p.out};
    pg::gemm_phase<pg::EpiMix, pg::SchedMix, true>((PG_LAS unsigned char*)lds, p.ws, S, E);
}
__device__ __forceinline__ void phase_moe1_fast(const P& p, int bid, int nblk, unsigned char* lds) {
    moe_tables(p, lds); pg::SchedMoe<8> S{nblk, bid, p.ws, (const int*)(lds + MT_LDS)}; pg::EpiMoe1 E{p.ws, p.exp_b1};
    pg::gemm_phase<pg::EpiMoe1, pg::SchedMoe<8>, true>((PG_LAS unsigned char*)lds, p.ws, S, E);
}
__device__ __forceinline__ void phase_moe2_fast(const P& p, int bid, int nblk, unsigned char* lds) {
    moe_tables(p, lds); pg::SchedMoe<4> S{nblk, bid, p.ws, (const int*)(lds + MT_LDS)}; pg::EpiMoe2 E{p.ws, p.exp_b2};
    pg::gemm_phase<pg::EpiMoe2, pg::SchedMoe<4>, true>((PG_LAS unsigned char*)lds, p.ws, S, E);
}
__device__ __forceinline__ void phase_proj_fast(const P& p, int bid, int nblk, unsigned char* lds) {
    { pg::SchedP1 S{nblk, bid, p.ws}; pg::EpiP1 E{p.ws, p.b_in};
      pg::gemm_phase<pg::EpiP1, pg::SchedP1, true>((PG_LAS unsigned char*)lds, p.ws, S, E); }
    { pg::SchedK S{nblk, bid, p.ws}; pg::EpiRope E{p.ws, p.b_in};
      pg::gemm_phase<pg::EpiRope, pg::SchedK, true>((PG_LAS unsigned char*)lds, p.ws, S, E); }
}

#define LAS __attribute__((address_space(3)))
#define XB_TMO      128
#define XB_XCNT(j)  (256  + 64 * (j))
#define XB_XSUB(j)  (1280 + 64 * (j))
#define XB_XGEN(j)  (2304 + 64 * (j))
#define XB_TOP      3328
#define XB_TOPGEN   3392
#define XCD_BAR_WORDS 3456
#define XB_SPIN_CAP (1u << 22)
__device__ __forceinline__ unsigned xb_ld(unsigned* p)              { return __hip_atomic_load(p, __ATOMIC_RELAXED, __HIP_MEMORY_SCOPE_AGENT); }
__device__ __forceinline__ unsigned xb_add(unsigned* p, unsigned v) { return __hip_atomic_fetch_add(p, v, __ATOMIC_RELAXED, __HIP_MEMORY_SCOPE_AGENT); }
__device__ __forceinline__ unsigned xb_xcc_id() { return (unsigned)__builtin_amdgcn_s_getreg((3 << 11) | 20) & 0xFu; }
#define XB_SPIN(cond, bar) do { unsigned _sp = 0; while (cond) { __builtin_amdgcn_s_sleep(1); \
    if ((++_sp & 255u) == 0u) { if (xb_ld(&(bar)[XB_TMO])) break; if (_sp > XB_SPIN_CAP) { atomicAdd(&(bar)[XB_TMO], 1u); break; } } } } while (0)
struct XcdBarrier { unsigned* bar; unsigned x; volatile LAS unsigned* st; };
__device__ __forceinline__ XcdBarrier xcd_barrier_post(unsigned* bar, volatile LAS unsigned* st) {
    XcdBarrier b; b.bar = bar; b.x = xb_xcc_id(); b.st = st;
    if (threadIdx.x == 0) (void)xb_add(&bar[XB_XCNT(b.x)], 1u);
    return b;
}
__device__ __forceinline__ void xcd_barrier_complete(unsigned* bar, unsigned x, unsigned& nloc, unsigned& nx) {
    const unsigned G = gridDim.x * gridDim.y * gridDim.z;
    unsigned sum, cnt, mine, sp = 0u;
    for (;;) {
        sum = 0u; cnt = 0u; mine = 0u;
#pragma unroll
        for (unsigned j = 0; j < 16; ++j) { const unsigned c = xb_ld(&bar[XB_XCNT(j)]); sum += c; cnt += (c > 0u) ? 1u : 0u; mine = (j == x) ? c : mine; }
        if (sum == G) break;
        __builtin_amdgcn_s_sleep(1);
        if ((++sp & 255u) == 0u) { if (xb_ld(&bar[XB_TMO])) break; if (sp > XB_SPIN_CAP) { atomicAdd(&bar[XB_TMO], 1u); break; } }
    }
    nloc = mine > 0u ? mine : 1u; nx = cnt > 0u ? cnt : 1u;
}
__device__ __forceinline__ void xcd_barrier(const XcdBarrier& b) {
    asm volatile("s_waitcnt vmcnt(0)" ::: "memory");
    __syncthreads();
    if (threadIdx.x == 0) {
        unsigned* bar = b.bar;
        __builtin_amdgcn_s_waitcnt(0);
        unsigned nloc = b.st[0], nx = b.st[1];
        if (nloc == 0u) { xcd_barrier_complete(bar, b.x, nloc, nx); b.st[0] = nloc; b.st[1] = nx; }
        const unsigned old = xb_add(&bar[XB_XSUB(b.x)], 1u);
        const unsigned gen = old / nloc;
        if (old + 1u == (gen + 1u) * nloc) {
            __builtin_amdgcn_fence(__ATOMIC_RELEASE, "agent");
            asm volatile("s_waitcnt vmcnt(0)" ::: "memory");
            const unsigned og = xb_add(&bar[XB_TOP], 1u);
            const unsigned tg = og / nx;
            if (og + 1u == (tg + 1u) * nx) xb_add(&bar[XB_TOPGEN], 1u);
            else XB_SPIN(xb_ld(&bar[XB_TOPGEN]) == tg, bar);
            __builtin_amdgcn_fence(__ATOMIC_ACQUIRE, "agent");
            xb_add(&bar[XB_XGEN(b.x)], 1u);
            asm volatile("s_waitcnt vmcnt(0)" ::: "memory");
        } else {
            XB_SPIN(xb_ld(&bar[XB_XGEN(b.x)]) == gen, bar);
            __builtin_amdgcn_fence(__ATOMIC_ACQUIRE, "agent");
            asm volatile("s_waitcnt vmcnt(0)" ::: "memory");
        }
    }
    __syncthreads();
}
#include <hip/hip_cooperative_groups.h>
namespace cg = cooperative_groups;
constexpr int LDS_BYTES = 147456;
constexpr int XB_LDS = LDS_BYTES - 64;
constexpr int CW_BAR = 4096;
constexpr int REP_PA = 1, REP_PB = 1, REP_P1 = 1, REP_GMLP = 1, REP_ATTN = 1, REP_MERGE = 1, REP_MIX = 1, REP_MOE1 = 1, REP_MOE2 = 1;
__global__ void __launch_bounds__(512, 2) mega(P p) {
    extern __shared__ __attribute__((aligned(16))) unsigned char lds[];
    const int bid = blockIdx.x, nblk = gridDim.x;
    if (threadIdx.x < 16) ((volatile LAS unsigned*)((LAS unsigned char*)lds + XB_LDS))[threadIdx.x] = 0u;
    __syncthreads();
    const XcdBarrier bar = xcd_barrier_post((unsigned*)(p.ws + WS_CTL) + CW_BAR, (volatile LAS unsigned*)((LAS unsigned char*)lds + XB_LDS));
#define GRID_BAR() xcd_barrier(bar)
#define REP(n) _Pragma("unroll 1") for (int rep_ = 0; rep_ < (n); ++rep_)
    REP(REP_PA) { __syncthreads(); phase_prologue_a(p, bid, nblk, lds); } cg::this_grid().sync();
    REP(REP_PB) phase_prologue_b(p, bid, nblk); GRID_BAR();
    REP(REP_P1) phase_proj_fast(p, bid, nblk, lds); GRID_BAR();
    REP(REP_GMLP) phase_gmlp_fast(p, bid, nblk, lds); REP(REP_ATTN) phase_attn_s(p, bid, nblk, lds); GRID_BAR();
    REP(REP_MERGE) phase_merge_fast(p, bid, nblk, lds); GRID_BAR();
    REP(REP_MIX) phase_mix_fast(p, bid, nblk, lds); GRID_BAR();
    phase_router(p, bid, nblk, lds); GRID_BAR();
    REP(REP_MOE1) phase_moe1_fast(p, bid, nblk, lds); GRID_BAR();
    REP(REP_MOE2) phase_moe2_fast(p, bid, nblk, lds); GRID_BAR();
#undef REP
    phase_final(p, bid, nblk, lds);
}

extern "C" void kernel_launch(void* const* d_in, const int* in_sizes, int n_in, void* d_out, int out_size, void* d_ws, size_t ws_size, hipStream_t stream) {
    static int grid = 0;
    if (grid == 0) {
        if (n_in != 31 || out_size != NTOK * DM || ws_size < WS_END) { fprintf(stderr, "kernel_launch: unexpected sizes n_in %d out %d ws %zu\n", n_in, out_size, ws_size); grid = -1; return; }
        int dev = 0, cus = 0, per_cu = 0;
        if (hipGetDevice(&dev) != hipSuccess || hipDeviceGetAttribute(&cus, hipDeviceAttributeMultiprocessorCount, dev) != hipSuccess) { grid = -1; return; }
        if (hipFuncSetAttribute((const void*)mega, hipFuncAttributeMaxDynamicSharedMemorySize, LDS_BYTES) != hipSuccess) { fprintf(stderr, "kernel_launch: hipFuncSetAttribute failed\n"); grid = -1; return; }
        if (hipOccupancyMaxActiveBlocksPerMultiprocessor(&per_cu, (const void*)mega, 512, LDS_BYTES) != hipSuccess || per_cu < 1) { fprintf(stderr, "kernel_launch: occupancy query failed (%d)\n", per_cu); grid = -1; return; }
        grid = cus * 1;
    }
    if (grid < 0) return;
    P p{};
    const float** pp = (const float**)&p;
    for (int i = 0; i < 31; ++i) pp[i] = (const float*)d_in[i];
    p.out = (float*)d_out; p.ws = (unsigned char*)d_ws; p.ph_lo = 0; p.ph_hi = 0;
    if (hipMemsetAsync((char*)d_ws + WS_CTL, 0, 1 * MiB, stream) != hipSuccess) { fprintf(stderr, "kernel_launch: memset failed\n"); return; }
    void* args[] = {&p};
    hipError_t e = hipLaunchCooperativeKernel((const void*)mega, dim3(grid), dim3(512), args, LDS_BYTES, stream);
    if (e != hipSuccess) fprintf(stderr, "cooperative launch failed: %s (grid %d)\n", hipGetErrorString(e), grid);
}
```

```cpp
#include <hip/hip_runtime.h>
#include <cstdio>
#include <cstdint>

typedef unsigned short bf16_t;
typedef short bf16x8 __attribute__((ext_vector_type(8)));
typedef float f32x4 __attribute__((ext_vector_type(4)));
typedef unsigned u32x4 __attribute__((ext_vector_type(4)));
typedef unsigned u32x2 __attribute__((ext_vector_type(2)));

constexpr int DM = 1024, NB = 8, SEQ = 4096, NTOK = NB * SEQ, CTXL = 256, NCTX = NB * CTXL, INW = 7168;
constexpr int NE = 32, TOPK = 4, FF = 1024, NASSIGN = NTOK * TOPK;
constexpr int NHEAD = 16, HD = 64, GW = 64;
constexpr float LN_EPS = 1e-5f;
constexpr float ALPHA = 1.189207115002721f;
constexpr int MAXTILES = NASSIGN / 256 + NE;

constexpr size_t MiB = 1u << 20;
constexpr size_t WS_CTL = 0;
constexpr size_t WS_MOD = 1 * MiB;
constexpr size_t WS_ROPE = 1 * MiB + 512 * 1024;
constexpr size_t WS_ROWSTAT = 2 * MiB;
constexpr size_t WS_ZSTAT = 2 * MiB + 512 * 1024;
constexpr size_t WS_TOPE = 3 * MiB;
constexpr size_t WS_TOPG = 4 * MiB;
constexpr size_t WS_SLOT = 5 * MiB;
constexpr size_t WS_PERM = 6 * MiB;
constexpr size_t WS_TILES = 7 * MiB;
constexpr size_t WS_WIN = 8 * MiB;
constexpr size_t WS_WPA = 22 * MiB, WS_WPB = 24 * MiB, WS_WOUT = 26 * MiB, WS_WSB = 28 * MiB;
constexpr size_t WS_KC = 30 * MiB;
constexpr size_t WS_VCT = 34 * MiB;
constexpr size_t WS_UC = 38 * MiB;
constexpr size_t WS_PERM2 = 42 * MiB;
constexpr size_t WS_W1 = 48 * MiB;
constexpr size_t WS_W2 = 176 * MiB;
constexpr size_t WS_U = 240 * MiB;
constexpr size_t WS_ZU = 304 * MiB;
constexpr size_t WS_ZVT = 368 * MiB;
constexpr size_t WS_Q = 432 * MiB;
constexpr size_t WS_K = 496 * MiB;
constexpr size_t WS_VT = 560 * MiB;
constexpr size_t WS_G = 624 * MiB;
constexpr size_t WS_YB = 752 * MiB;
constexpr size_t WS_INNER = 816 * MiB;
constexpr size_t WS_ACT = WS_ZU;
constexpr size_t WS_YS = WS_G;
constexpr size_t WS_END = 880 * MiB;

struct P {
    const float *x, *c, *ctx, *c_ctx, *ln_x_g, *ln_x_b, *ln_ctx_g, *ln_ctx_b, *w_ada, *b_ada, *w_in, *b_in, *gmlp_ln_g, *gmlp_ln_b, *gmlp_ws, *gmlp_bs,
        *na_rpb, *w_pa, *w_pb, *w_out, *b_out, *ln1_g, *ln1_b, *ln2_g, *ln2_b, *router_w, *router_b, *exp_w1, *exp_b1, *exp_w2, *exp_b2;
    float* out; unsigned char* ws; int ph_lo, ph_hi;
};

__device__ __forceinline__ int tid_opaque() { int t = threadIdx.x; asm volatile("" : "+v"(t)); return t; }
__device__ __forceinline__ unsigned f2bf(float f) { unsigned u = __builtin_bit_cast(unsigned, f); return (u + 0x7fffu + ((u >> 16) & 1u)) >> 16; }
__device__ __forceinline__ unsigned pk2(float lo, float hi) { return f2bf(lo) | (f2bf(hi) << 16); }
__device__ __forceinline__ float bf2f(unsigned h) { return __builtin_bit_cast(float, (h & 0xffffu) << 16); }
__device__ __forceinline__ float bflo(unsigned w) { return __builtin_bit_cast(float, w << 16); }
__device__ __forceinline__ float bfhi(unsigned w) { return __builtin_bit_cast(float, w & 0xffff0000u); }
__device__ __forceinline__ float wave_sum(float v) {
#pragma unroll
    for (int o = 1; o < 64; o <<= 1) v += __shfl_xor(v, o);
    return v;
}
__device__ __forceinline__ float wave_max(float v) {
#pragma unroll
    for (int o = 1; o < 64; o <<= 1) v = fmaxf(v, __shfl_xor(v, o));
    return v;
}
__device__ __forceinline__ float gelu_exact(float v) { return 0.5f * v * (1.0f + erff(v * 0.70710678118654752f)); }
__device__ __forceinline__ float sigmoidf_(float v) { return 1.0f / (1.0f + __expf(-v)); }

__device__ __forceinline__ void mod_item(const P& p, int item, float* red  ) {
    const int tid = tid_opaque(), wave = tid >> 6, lane = tid & 63;
    const int col = item * 32 + (lane & 31), kpar = lane >> 5;
    float acc[9];
#pragma unroll
    for (int r = 0; r < 9; ++r) acc[r] = 0.f;
    for (int kk = 0; kk < 64; ++kk) {
        const int k = wave * 128 + kk * 2 + kpar;
        const float w = p.w_ada[(size_t)k * 6144 + col];
#pragma unroll
        for (int r = 0; r < 9; ++r) { const float cv = (r < 8) ? p.c[r * 1024 + k] : p.c_ctx[k]; const float s = cv / (1.0f + __expf(-cv)); acc[r] += s * w; }
    }
#pragma unroll
    for (int r = 0; r < 9; ++r) red[((wave * 2 + kpar) * 9 + r) * 32 + (lane & 31)] = acc[r];
    __syncthreads();
    if (tid < 288) {
        const int r = tid >> 5, cc = tid & 31; float s = 0.f;
#pragma unroll
        for (int q = 0; q < 16; ++q) s += red[(q * 9 + r) * 32 + cc];
        ((float*)(p.ws + WS_MOD))[r * 6144 + item * 32 + cc] = s + p.b_ada[item * 32 + cc];
    }
    __syncthreads();
}
__device__ __forceinline__ void transpose_item(const float* W, int K, int N, bf16_t* WT, int k0, int n0, int drow0, float* scr, int lane) {
#pragma unroll 8
    for (int i = 0; i < 32; ++i) { const int kk = 2 * i + (lane >> 5); scr[kk * 33 + (lane & 31)] = W[(size_t)(k0 + kk) * N + n0 + (lane & 31)]; }
    __builtin_amdgcn_wave_barrier();
    asm volatile("s_waitcnt lgkmcnt(0)" ::: "memory");
    const int c = lane & 7;
#pragma unroll
    for (int j = 0; j < 4; ++j) { const int n = (lane >> 3) + 8 * j; const float* s = scr + (8 * c) * 33 + n;
        u32x4 o; o.x = pk2(s[0 * 33], s[1 * 33]); o.y = pk2(s[2 * 33], s[3 * 33]); o.z = pk2(s[4 * 33], s[5 * 33]); o.w = pk2(s[6 * 33], s[7 * 33]);
        *(u32x4*)(WT + (size_t)(drow0 + n) * K + k0 + 8 * c) = o; }
    asm volatile("s_waitcnt lgkmcnt(0)" ::: "memory");
    __builtin_amdgcn_wave_barrier();
}
constexpr int IT_WIN = 16 * 224, IT_SQ = 16 * 32, IT_W1 = 32 * 16 * 64, IT_W2 = 32 * 16 * 32, IT_WS = 32;
constexpr int IT_TOTAL = IT_WIN + 3 * IT_SQ + IT_W1 + IT_W2 + IT_WS;
__device__ __forceinline__ void convert_item(const P& p, int it, float* scr, int lane) {
    unsigned char* ws = p.ws;
    if (it < IT_WIN) { const int kb = it / 224, nb = it % 224; transpose_item(p.w_in, 1024, INW, (bf16_t*)(ws + WS_WIN), kb * 64, nb * 32, nb * 32, scr, lane); return; } it -= IT_WIN;
    if (it < IT_SQ) { const int kb = it / 32, nb = it % 32; transpose_item(p.w_pa, 1024, 1024, (bf16_t*)(ws + WS_WPA), kb * 64, nb * 32, nb * 32, scr, lane); return; } it -= IT_SQ;
    if (it < IT_SQ) { const int kb = it / 32, nb = it % 32; transpose_item(p.w_pb, 1024, 1024, (bf16_t*)(ws + WS_WPB), kb * 64, nb * 32, nb * 32, scr, lane); return; } it -= IT_SQ;
    if (it < IT_SQ) { const int kb = it / 32, nb = it % 32; transpose_item(p.w_out, 1024, 1024, (bf16_t*)(ws + WS_WOUT), kb * 64, nb * 32, nb * 32, scr, lane); return; } it -= IT_SQ;
    if (it < IT_W1) { const int e = it / 1024, r = it % 1024, kb = r / 64, nb = r % 64, n0 = nb * 32;
        const int half = n0 >> 10, nn = n0 & 1023, drow0 = (nn >> 7) * 256 + half * 128 + (nn & 127);
        transpose_item(p.exp_w1 + (size_t)e * 1024 * 2048, 1024, 2048, (bf16_t*)(ws + WS_W1) + (size_t)e * 2048 * 1024, kb * 64, n0, drow0, scr, lane); return; } it -= IT_W1;
    if (it < IT_W2) { const int e = it / 512, r = it % 512, kb = r / 32, nb = r % 32;
        transpose_item(p.exp_w2 + (size_t)e * 1024 * 1024, 1024, 1024, (bf16_t*)(ws + WS_W2) + (size_t)e * 1024 * 1024, kb * 64, nb * 32, nb * 32, scr, lane); return; } it -= IT_W2;
    { bf16_t* o = (bf16_t*)(ws + WS_WSB); const float* s = p.gmlp_ws + it * 4096;
      for (int i = lane; i < 4096; i += 64) o[it * 4096 + i] = (bf16_t)f2bf(s[i]); }
}
__device__ __forceinline__ void phase_prologue_a(const P& p, int bid, int nblk, unsigned char* lds) {
    const int tid = tid_opaque(), wave = tid >> 6, lane = tid & 63;
    for (int item = bid; item < 192; item += nblk) mod_item(p, item, (float*)lds);
    if (bid == nblk - 1) {
        for (int i = tid; i < 1024; i += 512) { const int pos = i >> 4, fi = i & 15;
            const float inv = __builtin_amdgcn_exp2f(-(float)fi * (13.287712379549449f / 16.0f));
            const float ang = (float)pos * inv; const float rev = ang * 0.15915494309189535f;
            float* t = (float*)(p.ws + WS_ROPE); t[2 * i] = __builtin_amdgcn_cosf(rev); t[2 * i + 1] = __builtin_amdgcn_sinf(rev); }
    }
    __syncthreads();
    float* scr = (float*)lds + wave * (64 * 33 + 32);
    const int gw = bid * 8 + wave, ngw = nblk * 8;
    for (int it = gw; it < IT_TOTAL; it += ngw) convert_item(p, it, scr, lane);
}
__device__ __forceinline__ void ln_mod_row(const float* xrow, const float* g, const float* b, const float* sh, const float* sc, bf16_t* orow, float* stat, int lane) {
    const f32x4* xr = (const f32x4*)xrow + lane;
    f32x4 v[4]; float s = 0.f;
#pragma unroll
    for (int j = 0; j < 4; ++j) { v[j] = xr[64 * j]; s += (v[j].x + v[j].y) + (v[j].z + v[j].w); }
    const float mean = wave_sum(s) * (1.f / DM); float s2 = 0.f;
#pragma unroll
    for (int j = 0; j < 4; ++j) { v[j] = v[j] - mean; s2 += (v[j].x * v[j].x + v[j].y * v[j].y) + (v[j].z * v[j].z + v[j].w * v[j].w); }
    const float rstd = 1.f / sqrtf(wave_sum(s2) * (1.f / DM) + LN_EPS);
    if (stat && lane == 0) { stat[0] = mean; stat[1] = rstd; }
    u32x2* o8 = (u32x2*)orow + lane;
#pragma unroll
    for (int j = 0; j < 4; ++j) { const int col = 4 * lane + 256 * j;
        const f32x4 gg = *(const f32x4*)(g + col), bb = *(const f32x4*)(b + col), shv = *(const f32x4*)(sh + col), scv = *(const f32x4*)(sc + col);
        f32x4 y = (v[j] * rstd) * gg + bb; y = y * (1.0f + scv) + shv;
        u32x2 w; w.x = pk2(y.x, y.y); w.y = pk2(y.z, y.w); o8[64 * j] = w; }
}
__device__ __forceinline__ void phase_prologue_b(const P& p, int bid, int nblk) {
    const int tid = tid_opaque(), wave = tid >> 6, lane = tid & 63;
    const int gw = bid * 8 + wave, ngw = nblk * 8;
    const float* mod = (const float*)(p.ws + WS_MOD);
    for (int row = gw; row < NTOK + NCTX; row += ngw) {
        if (row < NTOK) { const int b = row >> 12;
            ln_mod_row(p.x + (size_t)row * DM, p.ln_x_g, p.ln_x_b, mod + b * 6144, mod + b * 6144 + 1024, (bf16_t*)(p.ws + WS_U) + (size_t)row * DM, (float*)(p.ws + WS_ROWSTAT) + 2 * row, lane);
        } else { const int r = row - NTOK;
            ln_mod_row(p.ctx + (size_t)r * DM, p.ln_ctx_g, p.ln_ctx_b, mod + 8 * 6144, mod + 8 * 6144 + 1024, (bf16_t*)(p.ws + WS_UC) + (size_t)r * DM, nullptr, lane); }
    }
}

template <class ARow, class BRow, class Epi>
__device__ __forceinline__ void sgemm_wave_tile(int r0, int n0, int K, const ARow& arow, const BRow& brow, const Epi& epi, int lane) {
    const int fr = lane & 15, fq = lane >> 4;
    f32x4 acc[2][2];
#pragma unroll
    for (int a = 0; a < 2; ++a)
#pragma unroll
        for (int b = 0; b < 2; ++b) acc[a][b] = (f32x4){0.f, 0.f, 0.f, 0.f};
    const bf16_t* ap[2]; const bf16_t* bp[2];
#pragma unroll
    for (int a = 0; a < 2; ++a) { ap[a] = arow(r0 + 16 * a + fr) + 8 * fq; bp[a] = brow(n0 + 16 * a + fr) + 8 * fq; }
    for (int k0 = 0; k0 < K; k0 += 32) {
        bf16x8 af[2], bfr[2];
#pragma unroll
        for (int a = 0; a < 2; ++a) { af[a] = *(const bf16x8*)(ap[a] + k0); bfr[a] = *(const bf16x8*)(bp[a] + k0); }
#pragma unroll
        for (int a = 0; a < 2; ++a)
#pragma unroll
            for (int b = 0; b < 2; ++b) acc[a][b] = __builtin_amdgcn_mfma_f32_16x16x32_bf16(af[a], bfr[b], acc[a][b], 0, 0, 0);
    }
#pragma unroll
    for (int a = 0; a < 2; ++a)
#pragma unroll
        for (int b = 0; b < 2; ++b)
#pragma unroll
            for (int i = 0; i < 4; ++i) epi(r0 + 16 * a + 4 * fq + i, n0 + 16 * b + fr, acc[a][b][i]);
}

struct ARowDense { const bf16_t* A; int lda; __device__ __forceinline__ const bf16_t* operator()(int r) const { return A + (size_t)r * lda; } };
struct EpiProj {
    const float* b_in; bf16_t *ZU, *ZVT, *Q, *K, *VT, *G;
    __device__ __forceinline__ void operator()(int r, int n, float v) const {
        v += b_in[n];
        if (n < 1024) ZU[(size_t)r * 1024 + n] = (bf16_t)f2bf(gelu_exact(v));
        else if (n < 2048) ZVT[(size_t)(n - 1024) * NTOK + r] = (bf16_t)f2bf(gelu_exact(v));
        else if (n < 3072) Q[(size_t)r * 1024 + (n - 2048)] = (bf16_t)f2bf(v);
        else if (n < 4096) K[(size_t)r * 1024 + (n - 3072)] = (bf16_t)f2bf(v);
        else if (n < 5120) VT[(size_t)(n - 4096) * NTOK + r] = (bf16_t)f2bf(v);
        else G[(size_t)r * 2048 + (n - 5120)] = (bf16_t)f2bf(sigmoidf_(v));
    }
};
__device__ __forceinline__ void phase_proj_s(const P& p, int bid, int nblk) {
    const int tid_ = tid_opaque(); const int wave = tid_ >> 6, lane = tid_ & 63; unsigned char* ws = p.ws;
    ARowDense ar{(const bf16_t*)(ws + WS_U), 1024}, br{(const bf16_t*)(ws + WS_WIN), 1024};
    EpiProj e{p.b_in, (bf16_t*)(ws + WS_ZU), (bf16_t*)(ws + WS_ZVT), (bf16_t*)(ws + WS_Q), (bf16_t*)(ws + WS_K), (bf16_t*)(ws + WS_VT), (bf16_t*)(ws + WS_G)};
    const int ntn = INW / 32, ntiles = (NTOK / 32) * ntn;
    for (int t = bid * 8 + wave; t < ntiles; t += nblk * 8) sgemm_wave_tile((t / ntn) * 32, (t % ntn) * 32, 1024, ar, br, e, lane);
}
struct EpiCtxKV {
    const float* b_in; bf16_t *KC, *VCT;
    __device__ __forceinline__ void operator()(int r, int n, float v) const {
        v += b_in[3072 + n];
        if (n < 1024) KC[(size_t)r * 1024 + n] = (bf16_t)f2bf(v); else VCT[(size_t)(n - 1024) * NCTX + r] = (bf16_t)f2bf(v);
    }
};
__device__ __forceinline__ void phase_ctxkv_s(const P& p, int bid, int nblk) {
    const int tid_ = tid_opaque(); const int wave = tid_ >> 6, lane = tid_ & 63; unsigned char* ws = p.ws;
    ARowDense ar{(const bf16_t*)(ws + WS_UC), 1024}, br{(const bf16_t*)(ws + WS_WIN) + (size_t)3072 * 1024, 1024};
    EpiCtxKV e{p.b_in, (bf16_t*)(ws + WS_KC), (bf16_t*)(ws + WS_VCT)};
    const int ntn = 2048 / 32, ntiles = (NCTX / 32) * ntn;
    for (int t = bid * 8 + wave; t < ntiles; t += nblk * 8) sgemm_wave_tile((t / ntn) * 32, (t % ntn) * 32, 1024, ar, br, e, lane);
}
__device__ __forceinline__ void phase_rope_s(const P& p, int bid, int nblk) {
    bf16_t* K = (bf16_t*)(p.ws + WS_K); const float* tab = (const float*)(p.ws + WS_ROPE);
    const size_t total = (size_t)NTOK * NHEAD * 32;
    const int tid_ = tid_opaque();
    for (size_t i = (size_t)bid * 512 + tid_; i < total; i += (size_t)nblk * 512) {
        const int pi = (int)(i & 31), h = (int)((i >> 5) & 15), t = (int)(i >> 9);
        const int pos = t & 4095, axis = pi >> 4, fi = pi & 15, ps = axis ? (pos & 63) : (pos >> 6);
        const float cs = tab[2 * (ps * 16 + fi)], sn = tab[2 * (ps * 16 + fi) + 1];
        bf16_t* base = K + (size_t)t * 1024 + h * 64 + axis * 32 + fi;
        const float x1 = bf2f(base[0]), x2 = bf2f(base[16]);
        base[0] = (bf16_t)f2bf(x1 * cs - x2 * sn); base[16] = (bf16_t)f2bf(x2 * cs + x1 * sn);
    }
}
__device__ __forceinline__ void phase_zstat_s(const P& p, int bid, int nblk) {
    const bf16_t* ZVT = (const bf16_t*)(p.ws + WS_ZVT); float* zs = (float*)(p.ws + WS_ZSTAT);
    const int tid_ = tid_opaque();
    for (int t = bid * 512 + tid_; t < NTOK; t += nblk * 512) {
        float s = 0.f, s2 = 0.f;
        for (int c = 0; c < 1024; ++c) { const float v = bf2f(ZVT[(size_t)c * NTOK + t]); s += v; s2 += v * v; }
        const float mean = s * (1.f / 1024.f); const float var = fmaxf(s2 * (1.f / 1024.f) - mean * mean, 0.f);
        zs[2 * t] = mean; zs[2 * t + 1] = 1.f / sqrtf(var + LN_EPS);
    }
}
__device__ __forceinline__ void phase_gmlp_s(const P& p, int bid, int nblk, unsigned char* lds) {
    float* zvn = (float*)lds;
    float* wsm = zvn + 128 * 128;
    const bf16_t* ZVT = (const bf16_t*)(p.ws + WS_ZVT); const bf16_t* ZU = (const bf16_t*)(p.ws + WS_ZU); const float* zs = (const float*)(p.ws + WS_ZSTAT);
    bf16_t* YA = (bf16_t*)(p.ws + WS_U);
    const int tid = tid_opaque();
    for (int item = bid; item < (NTOK / 128) * 8; item += nblk) {
        const int chunk = item >> 3, g = item & 7, tok0 = chunk * 128;
        __syncthreads();
        for (int i = tid; i < 128 * 128; i += 512) { const int c = i >> 7, q = i & 127; const int ch = g * 128 + c;
            const float v = bf2f(ZVT[(size_t)ch * NTOK + tok0 + q]);
            zvn[q * 128 + c] = (v - zs[2 * (tok0 + q)]) * zs[2 * (tok0 + q) + 1] * p.gmlp_ln_g[ch] + p.gmlp_ln_b[ch];
            wsm[i] = p.gmlp_ws[g * 16384 + i]; }
        __syncthreads();
        const int c = tid & 127, pq = tid >> 7;
        for (int pp = 0; pp < 32; ++pp) { const int pr = pq * 32 + pp; float acc = 0.f;
            for (int q = 0; q < 128; ++q) acc += wsm[pr * 128 + q] * zvn[q * 128 + c];
            acc += p.gmlp_bs[g * 128 + pr];
            const size_t o = (size_t)(tok0 + pr) * 1024 + g * 128 + c;
            YA[o] = (bf16_t)f2bf(bf2f(ZU[o]) * acc); }
    }
}
__device__ __forceinline__ bf16x8 pack8(const float (&v)[8]) { u32x4 w; w.x = pk2(v[0], v[1]); w.y = pk2(v[2], v[3]); w.z = pk2(v[4], v[5]); w.w = pk2(v[6], v[7]); return __builtin_bit_cast(bf16x8, w); }
__device__ __forceinline__ void phase_gmlp_fast(const P& p, int bid, int nblk, unsigned char* lds) {
    const int tid = tid_opaque(), g = tid >> 6, lane = tid & 63, fr = lane & 15, fq = lane >> 4;
    float* part = (float*)lds;
    float* stat = part + 8 * 128 * 2;
    const bf16_t* ZVT = (const bf16_t*)(p.ws + WS_ZVT); const bf16_t* ZU = (const bf16_t*)(p.ws + WS_ZU); const bf16_t* WSB = (const bf16_t*)(p.ws + WS_WSB);
    bf16_t* YA = (bf16_t*)(p.ws + WS_U);
    for (int chunk = bid; chunk < NTOK / 128; chunk += nblk) {
        const int tok0 = chunk * 128;
        __syncthreads();
        { float s1[8], s2[8];
#pragma unroll
          for (int jj = 0; jj < 8; ++jj) { s1[jj] = 0.f; s2[jj] = 0.f; }
          const bf16_t* zp = ZVT + (((size_t)(tok0 >> 3) + fr) * 1024 + 128 * g + fq) * 8;
#pragma unroll 8
          for (int it = 0; it < 32; ++it) { const bf16x8 v = *(const bf16x8*)(zp + (4 * it) * 8);
#pragma unroll
              for (int jj = 0; jj < 8; ++jj) { const float f = bf2f((unsigned)(unsigned short)v[jj]); s1[jj] += f; s2[jj] += f * f; } }
#pragma unroll
          for (int jj = 0; jj < 8; ++jj) { s1[jj] += __shfl_xor(s1[jj], 16); s1[jj] += __shfl_xor(s1[jj], 32); s2[jj] += __shfl_xor(s2[jj], 16); s2[jj] += __shfl_xor(s2[jj], 32); }
          if (fq == 0) {
#pragma unroll
              for (int jj = 0; jj < 8; ++jj) { part[(g * 128 + 8 * fr + jj) * 2] = s1[jj]; part[(g * 128 + 8 * fr + jj) * 2 + 1] = s2[jj]; } } }
        __syncthreads();
        if (tid < 128) { float a = 0.f, b = 0.f;
#pragma unroll
            for (int w = 0; w < 8; ++w) { a += part[(w * 128 + tid) * 2]; b += part[(w * 128 + tid) * 2 + 1]; }
            const float mean = a * (1.f / 1024.f), var = fmaxf(b * (1.f / 1024.f) - mean * mean, 0.f);
            stat[2 * tid] = mean; stat[2 * tid + 1] = 1.f / sqrtf(var + LN_EPS); }
        __syncthreads();
#pragma unroll 1
        for (int ph = 0; ph < 2; ++ph) {
            bf16x8 wf[4][4]; float t1[4], t2[4], bsv[4];
#pragma unroll
            for (int pt = 0; pt < 4; ++pt) { const int pp = 64 * ph + 16 * pt + fr; float t1a = 0.f, t2a = 0.f;
                const float* stat_o = stat + 16 * fq; asm volatile("" : "+v"(stat_o));
#pragma unroll
                for (int ks = 0; ks < 4; ++ks) { const bf16x8 w = *(const bf16x8*)(WSB + ((size_t)g * 128 + pp) * 128 + 32 * ks + 8 * fq);
                    float wv[8];
#pragma unroll
                    for (int jj = 0; jj < 8; ++jj) { const float w0 = bf2f((unsigned)(unsigned short)w[jj]); t2a += w0; wv[jj] = w0 * stat_o[2 * (32 * ks + jj) + 1]; }
                    const bf16x8 wp = pack8(wv); wf[pt][ks] = wp;
#pragma unroll
                    for (int jj = 0; jj < 8; ++jj) t1a += bf2f((unsigned)(unsigned short)wp[jj]) * stat_o[2 * (32 * ks + jj)]; }
                t1a += __shfl_xor(t1a, 16); t1a += __shfl_xor(t1a, 32); t2a += __shfl_xor(t2a, 16); t2a += __shfl_xor(t2a, 32);
                t1[pt] = t1a; t2[pt] = t2a; bsv[pt] = p.gmlp_bs[g * 128 + pp]; }
#pragma unroll 1
            for (int ct = 0; ct < 8; ++ct) {
                bf16x8 af[4];
                const bf16_t* zp = ZVT + (((size_t)(tok0 >> 3) + fq) * 1024 + 128 * g + 16 * ct + fr) * 8;
#pragma unroll
                for (int ks = 0; ks < 4; ++ks) af[ks] = *(const bf16x8*)(zp + (size_t)ks * 4 * 1024 * 8);
                f32x4 acc[4];
#pragma unroll
                for (int pt = 0; pt < 4; ++pt) { acc[pt] = (f32x4){0.f, 0.f, 0.f, 0.f};
#pragma unroll
                    for (int ks = 0; ks < 4; ++ks) acc[pt] = __builtin_amdgcn_mfma_f32_16x16x32_bf16(af[ks], wf[pt][ks], acc[pt], 0, 0, 0); }
                const int c = 128 * g + 16 * ct + 4 * fq;
                const f32x4 gc = *(const f32x4*)(p.gmlp_ln_g + c), bc = *(const f32x4*)(p.gmlp_ln_b + c);
#pragma unroll
                for (int pt = 0; pt < 4; ++pt) { const size_t off = (size_t)(tok0 + 64 * ph + 16 * pt + fr) * 1024 + c;
                    const u32x2 zu = *(const u32x2*)(ZU + off);
                    const f32x4 s = gc * (acc[pt] - t1[pt]) + bc * t2[pt] + bsv[pt];
                    u32x2 w; w.x = pk2(bflo(zu.x) * s[0], bfhi(zu.x) * s[1]); w.y = pk2(bflo(zu.y) * s[2], bfhi(zu.y) * s[3]);
                    *(u32x2*)(YA + off) = w; }
            }
        }
    }
}
constexpr int RPB_LDS_FLOATS = 16 * 15 * 64;
__device__ __forceinline__ void attn_stage_rpb(const P& p, float* tbl, int tid) {
    for (int idx = tid; idx < RPB_LDS_FLOATS; idx += 512) { const int h = idx / 960, rem = idx % 960, dr = rem >> 6, cc = rem & 63;
        tbl[idx] = (cc >= 16 && cc < 47) ? p.na_rpb[(h * 15 + dr) * 31 + cc - 16] : 0.f; }
}
__device__ __forceinline__ void attn_wave_unit(const P& p, const float* tbl, int b, int r, int j, int h, int lane) {
    const int fr = lane & 15, fq = lane >> 4;
    const bf16_t* Q = (const bf16_t*)(p.ws + WS_Q); const bf16_t* K = (const bf16_t*)(p.ws + WS_K); const bf16_t* VT = (const bf16_t*)(p.ws + WS_VT);
    const bf16_t* KC = (const bf16_t*)(p.ws + WS_KC); const bf16_t* VCT = (const bf16_t*)(p.ws + WS_VCT); const float* tab = (const float*)(p.ws + WS_ROPE);
    bf16_t* YB = (bf16_t*)(p.ws + WS_YB);
    const int qc = 16 * j + fr; const size_t tq = (size_t)b * SEQ + r * 64 + qc; const size_t bh = (size_t)b * 16 + h;
    const int r0 = min(max(r - 4, 0), 56), c0 = min(max(qc - 8, 0), 48), cs = min(max(16 * j - 8, 0), 32);
    const int sp0 = 8 * (fr >> 2) + (fr & 3);
    const bf16_t* klat = K + (bh * 4096 + r0 * 64 + cs + sp0) * 64 + 8 * fq;
    const bf16_t* kctx = KC + (bh * 256 + sp0) * 64 + 8 * fq;
    const bf16_t* vlat = VT + ((bh * 512 + ((r0 * 64 + cs) >> 3) + fq) * 64 + fr) * 8;
    const bf16_t* vctx = VCT + ((bh * 32 + fq) * 64 + fr) * 8;
    bf16x8 kf[2][2][2];
#define LOADK(base, rowstride, buf, st_) do { _Pragma("unroll") for (int t = 0; t < 2; ++t) { \
        const bf16_t* kp_ = (base) + (size_t)(st_) * (rowstride) * 64 + t * 4 * 64; kf[buf][t][0] = *(const bf16x8*)kp_; kf[buf][t][1] = *(const bf16x8*)(kp_ + 32); } } while (0)
    LOADK(klat, 64, 0, 0); LOADK(klat, 64, 1, 1);
    bf16x8 qpl[2], qrt[2];
#pragma unroll
    for (int s = 0; s < 2; ++s) {
        const bf16_t* qb = Q + (bh * 4096 + r * 64 + qc) * 64 + 32 * s;
        const bf16x8 me = *(const bf16x8*)(qb + 8 * fq), ot = *(const bf16x8*)(qb + 8 * (fq ^ 2));
        qpl[s] = me;
        const int pos = s ? qc : r; const float* tb = tab + (pos * 16 + 8 * (fq & 1)) * 2;
        float rot[8];
#pragma unroll
        for (int jj = 0; jj < 8; ++jj) { const float cv = tb[2 * jj], sv = tb[2 * jj + 1];
            const float xv = bf2f((unsigned)(unsigned short)me[jj]), ov = bf2f((unsigned)(unsigned short)ot[jj]);
            rot[jj] = (fq < 2) ? (xv * cv - ov * sv) : (xv * cv + ov * sv); }
        qrt[s] = pack8(rot);
    }
    float sc[8][8];
    const float* brow0 = tbl + (h * 15 + (r0 - r + 7)) * 64 + (cs + 8 * fq - qc + 31);
#pragma unroll
    for (int st = 0; st < 8; ++st) {
        const float* brow = brow0 + st * 64; asm volatile("" : "+v"(brow));
#pragma unroll
        for (int t = 0; t < 2; ++t) {
            f32x4 d = __builtin_amdgcn_mfma_f32_16x16x32_bf16(kf[st & 1][t][0], qrt[0], (f32x4){0.f, 0.f, 0.f, 0.f}, 0, 0, 0);
            d = __builtin_amdgcn_mfma_f32_16x16x32_bf16(kf[st & 1][t][1], qrt[1], d, 0, 0, 0);
#pragma unroll
            for (int i = 0; i < 4; ++i) { const int kc = cs + 8 * fq + 4 * t + i; const bool valid = (kc >= c0) && (kc < c0 + 16);
                const float bias = brow[4 * t + i];
                sc[st][4 * t + i] = valid ? (d[i] * 0.125f + bias) : -INFINITY; } }
        if (st + 2 < 8) LOADK(klat, 64, st & 1, st + 2);
    }
    bf16x8 vf[2][4];
#define LOADV(base, colstride, ld, buf, st_) do { _Pragma("unroll") for (int dt = 0; dt < 4; ++dt) \
        vf[buf][dt] = *(const bf16x8*)((base) + dt * 128 + (st_) * ((colstride) / 8) * 512); } while (0)
    LOADV(vlat, 64, NTOK, 0, 0); LOADV(vlat, 64, NTOK, 1, 1);
    float m = -INFINITY;
#pragma unroll
    for (int st = 0; st < 8; ++st)
#pragma unroll
        for (int e = 0; e < 8; ++e) m = fmaxf(m, sc[st][e]);
    m = fmaxf(m, __shfl_xor(m, 16)); m = fmaxf(m, __shfl_xor(m, 32));
    float l = 0.f; f32x4 o[4];
#pragma unroll
    for (int dt = 0; dt < 4; ++dt) o[dt] = (f32x4){0.f, 0.f, 0.f, 0.f};
    const float ml2 = m * 1.4426950408889634f;
#pragma unroll
    for (int st = 0; st < 8; ++st) {
        float pv[8];
#pragma unroll
        for (int e = 0; e < 8; ++e) { pv[e] = __builtin_amdgcn_exp2f(sc[st][e] * 1.4426950408889634f - ml2); l += pv[e]; }
        const bf16x8 pf = pack8(pv);
#pragma unroll
        for (int dt = 0; dt < 4; ++dt) o[dt] = __builtin_amdgcn_mfma_f32_16x16x32_bf16(vf[st & 1][dt], pf, o[dt], 0, 0, 0);
        if (st + 2 < 8) LOADV(vlat, 64, NTOK, st & 1, st + 2);
    }
    LOADK(kctx, 32, 0, 0); LOADK(kctx, 32, 1, 1);
#pragma unroll
    for (int st = 0; st < 8; ++st) {
#pragma unroll
        for (int t = 0; t < 2; ++t) {
            f32x4 d = __builtin_amdgcn_mfma_f32_16x16x32_bf16(kf[st & 1][t][0], qpl[0], (f32x4){0.f, 0.f, 0.f, 0.f}, 0, 0, 0);
            d = __builtin_amdgcn_mfma_f32_16x16x32_bf16(kf[st & 1][t][1], qpl[1], d, 0, 0, 0);
#pragma unroll
            for (int i = 0; i < 4; ++i) sc[st][4 * t + i] = d[i] * 0.125f; }
        if (st + 2 < 8) LOADK(kctx, 32, st & 1, st + 2);
    }
    LOADV(vctx, 32, NCTX, 0, 0); LOADV(vctx, 32, NCTX, 1, 1);
    float m2 = -INFINITY;
#pragma unroll
    for (int st = 0; st < 8; ++st)
#pragma unroll
        for (int e = 0; e < 8; ++e) m2 = fmaxf(m2, sc[st][e]);
    m2 = fmaxf(m2, __shfl_xor(m2, 16)); m2 = fmaxf(m2, __shfl_xor(m2, 32));
    const float mn = fmaxf(m, m2), al = __builtin_amdgcn_exp2f((m - mn) * 1.4426950408889634f), mnl2 = mn * 1.4426950408889634f;
    l *= al;
#pragma unroll
    for (int dt = 0; dt < 4; ++dt) o[dt] = o[dt] * al;
#pragma unroll
    for (int st = 0; st < 8; ++st) {
        float pv[8];
#pragma unroll
        for (int e = 0; e < 8; ++e) { pv[e] = __builtin_amdgcn_exp2f(sc[st][e] * 1.4426950408889634f - mnl2); l += pv[e]; }
        const bf16x8 pf = pack8(pv);
#pragma unroll
        for (int dt = 0; dt < 4; ++dt) o[dt] = __builtin_amdgcn_mfma_f32_16x16x32_bf16(vf[st & 1][dt], pf, o[dt], 0, 0, 0);
        if (st + 2 < 8) LOADV(vctx, 32, NCTX, st & 1, st + 2);
    }
#undef LOADK
#undef LOADV
    l += __shfl_xor(l, 16); l += __shfl_xor(l, 32);
    const float inv = 1.0f / l;
#pragma unroll
    for (int dt = 0; dt < 4; ++dt) { u32x2 w; w.x = pk2(o[dt][0] * inv, o[dt][1] * inv); w.y = pk2(o[dt][2] * inv, o[dt][3] * inv);
        *(u32x2*)(YB + tq * 1024 + h * 64 + 16 * dt + 4 * fq) = w; }
}
__device__ __forceinline__ void phase_attn_s(const P& p, int bid, int nblk, unsigned char* lds) {
    const int tid_ = tid_opaque(); const int wave = tid_ >> 6, lane = tid_ & 63;
    float* tbl = (float*)lds;
    __syncthreads();
    attn_stage_rpb(p, tbl, tid_);
    __syncthreads();
    for (int bu = bid; bu < NB * 64 * 8; bu += nblk) { const int hp = bu & 7, r = (bu >> 3) & 63, b = bu >> 9;
        int lane_o = lane; asm volatile("" : "+v"(lane_o));
        attn_wave_unit(p, tbl, b, r, wave & 3, 2 * hp + (wave >> 2), lane_o); }
}
struct EpiMergeA { const bf16_t* G; bf16_t* INNER;
    __device__ __forceinline__ void operator()(int r, int n, float v) const { INNER[(size_t)r * 1024 + n] = (bf16_t)f2bf(bf2f(G[(size_t)r * 2048 + n]) * v); } };
struct EpiMergeB { const bf16_t* G; bf16_t* INNER;
    __device__ __forceinline__ void operator()(int r, int n, float v) const { const size_t o = (size_t)r * 1024 + n; INNER[o] = (bf16_t)f2bf(bf2f(INNER[o]) + bf2f(G[(size_t)r * 2048 + 1024 + n]) * v); } };
template <int WHICH> __device__ __forceinline__ void phase_merge_s(const P& p, int bid, int nblk) {
    const int tid_ = tid_opaque(); const int wave = tid_ >> 6, lane = tid_ & 63; unsigned char* ws = p.ws;
    const int ntn = 1024 / 32, ntiles = (NTOK / 32) * ntn;
    if (WHICH == 0) { ARowDense ar{(const bf16_t*)(ws + WS_U), 1024}, br{(const bf16_t*)(ws + WS_WPA), 1024}; EpiMergeA e{(const bf16_t*)(ws + WS_G), (bf16_t*)(ws + WS_INNER)};
        for (int t = bid * 8 + wave; t < ntiles; t += nblk * 8) sgemm_wave_tile((t / ntn) * 32, (t % ntn) * 32, 1024, ar, br, e, lane);
    } else { ARowDense ar{(const bf16_t*)(ws + WS_YB), 1024}, br{(const bf16_t*)(ws + WS_WPB), 1024}; EpiMergeB e{(const bf16_t*)(ws + WS_G), (bf16_t*)(ws + WS_INNER)};
        for (int t = bid * 8 + wave; t < ntiles; t += nblk * 8) sgemm_wave_tile((t / ntn) * 32, (t % ntn) * 32, 1024, ar, br, e, lane); }
}
struct EpiMix { const float *x, *rowstat, *lng, *lnb, *mod, *b_out; float* out;
    __device__ __forceinline__ void operator()(int r, int n, float v) const {
        const int b = r >> 12; const float x0 = (x[(size_t)r * 1024 + n] - rowstat[2 * r]) * rowstat[2 * r + 1] * lng[n] + lnb[n];
        out[(size_t)r * 1024 + n] = ALPHA * x0 + mod[b * 6144 + 2048 + n] * (v + b_out[n]); } };
__device__ __forceinline__ void phase_mix_s(const P& p, int bid, int nblk) {
    const int tid_ = tid_opaque(); const int wave = tid_ >> 6, lane = tid_ & 63; unsigned char* ws = p.ws;
    const int ntn = 1024 / 32, ntiles = (NTOK / 32) * ntn;
    ARowDense ar{(const bf16_t*)(ws + WS_INNER), 1024}, br{(const bf16_t*)(ws + WS_WOUT), 1024};
    EpiMix e{p.x, (const float*)(ws + WS_ROWSTAT), p.ln_x_g, p.ln_x_b, (const float*)(ws + WS_MOD), p.b_out, p.out};
    for (int t = bid * 8 + wave; t < ntiles; t += nblk * 8) sgemm_wave_tile((t / ntn) * 32, (t % ntn) * 32, 1024, ar, br, e, lane);
}

constexpr int RT_LDS_W = 0, RT_LDS_CNT = 131072, RT_LDS_BASE = RT_LDS_CNT + 128, RT_LDS_REC = RT_LDS_BASE + 128, RT_MAXIT = 32, RT_LDS_END = RT_LDS_REC + 8 * RT_MAXIT * 8 * 4;
__device__ __forceinline__ int rw_off(int prow, int ch) { return prow * 128 + ((ch ^ ((prow >> 1) & 7)) << 4); }
__device__ __forceinline__ void phase_router(const P& p, int bid, int nblk, unsigned char* lds) {
    const int tid = tid_opaque(), wave = tid >> 6, lane = tid & 63;
    int* cnt = (int*)(lds + RT_LDS_CNT); int* base = (int*)(lds + RT_LDS_BASE); int* rec = (int*)(lds + RT_LDS_REC) + wave * RT_MAXIT * 8;
    for (int k = tid; k < 1024; k += 512) { const int l = (k & 255) >> 2, i = k & 3, j = k >> 8, prow = l + 64 * (4 * j + i);
        const f32x4* src = (const f32x4*)(p.router_w + (size_t)k * 32);
#pragma unroll
        for (int ch = 0; ch < 8; ++ch) *(f32x4*)(lds + RT_LDS_W + rw_off(prow, ch)) = src[ch]; }
    if (tid < 32) cnt[tid] = 0;
    __syncthreads();
    const float* mod = (const float*)(p.ws + WS_MOD);
    int* TOPE = (int*)(p.ws + WS_TOPE); float* TOPG = (float*)(p.ws + WS_TOPG); int* SLOT = (int*)(p.ws + WS_SLOT);
    bf16_t* U2 = (bf16_t*)(p.ws + WS_U);
    const int erev = 16 * ((lane >> 4) & 1) + (int)(__builtin_bitreverse32((unsigned)(lane & 15)) >> 28);
    unsigned wb[8];
#pragma unroll
    for (int ch = 0; ch < 8; ++ch) wb[ch] = RT_LDS_W + lane * 128 + ((ch ^ ((lane >> 1) & 7)) << 4);
    int it = 0;
    for (int row = bid * 8 + wave; row < NTOK; row += nblk * 8, ++it) {
        const int b = row >> 12;
        f32x4* xr = (f32x4*)(p.out + (size_t)row * DM) + lane;
        f32x4 v[4]; float s = 0.f;
#pragma unroll
        for (int j = 0; j < 4; ++j) { v[j] = xr[64 * j]; s += (v[j].x + v[j].y) + (v[j].z + v[j].w); }
        const float mean = wave_sum(s) * (1.f / DM); float s2 = 0.f;
#pragma unroll
        for (int j = 0; j < 4; ++j) { v[j] = v[j] - mean; s2 += (v[j].x * v[j].x + v[j].y * v[j].y) + (v[j].z * v[j].z + v[j].w * v[j].w); }
        const float rstd = 1.f / sqrtf(wave_sum(s2) * (1.f / DM) + LN_EPS);
        u32x2* o8 = (u32x2*)(U2 + (size_t)row * DM) + lane;
        int lane_o = lane; asm volatile("" : "+v"(lane_o));
        f32x4 u[4];
#pragma unroll
        for (int j = 0; j < 4; ++j) { const int col = 4 * lane_o + 256 * j;
            const f32x4 gg = *(const f32x4*)(p.ln1_g + col), bb = *(const f32x4*)(p.ln1_b + col);
            const f32x4 shv = *(const f32x4*)(mod + b * 6144 + 3072 + col), scv = *(const f32x4*)(mod + b * 6144 + 4096 + col);
            const f32x4 x1 = (v[j] * rstd) * gg + bb; xr[64 * j] = x1;
            u[j] = x1 * (1.0f + scv) + shv;
            u32x2 w; w.x = pk2(u[j].x, u[j].y); w.y = pk2(u[j].z, u[j].w); o8[64 * j] = w; }
        float lg2[2];
#pragma unroll
        for (int hf = 0; hf < 2; ++hf) {
            float a[16];
#pragma unroll
            for (int e = 0; e < 16; ++e) a[e] = 0.f;
#pragma unroll
            for (int j = 0; j < 4; ++j)
#pragma unroll
                for (int i = 0; i < 4; ++i) { const float uv = u[j][i];
#pragma unroll
                    for (int ch = 0; ch < 4; ++ch) { const f32x4 w4 = *(const f32x4*)(lds + wb[4 * hf + ch] + (4 * j + i) * 8192);
                        a[4 * ch + 0] += uv * w4.x; a[4 * ch + 1] += uv * w4.y; a[4 * ch + 2] += uv * w4.z; a[4 * ch + 3] += uv * w4.w; } }
#pragma unroll
            for (int st = 0; st < 4; ++st) { const int n = 8 >> st; const bool up = (lane >> st) & 1;
#pragma unroll
                for (int i = 0; i < n; ++i) { float lo = a[i], hi = a[n + i]; asm volatile("" : "+v"(lo), "+v"(hi));
                    const float keep = up ? hi : lo, send = up ? lo : hi; a[i] = keep + __shfl_xor(send, 1 << st); } }
            float r = a[0]; r += __shfl_xor(r, 16); r += __shfl_xor(r, 32); lg2[hf] = r;
        }
        float logit = ((lane >> 4) & 1) ? lg2[1] : lg2[0];
        logit += p.router_b[erev];
        float cur = logit;
#define TOP_STEP(TV, TE) float TV; int TE; { const float mx = wave_max(cur); int cand = (cur == mx) ? erev : 64; \
            cand = min(cand, __shfl_xor(cand, 1)); cand = min(cand, __shfl_xor(cand, 2)); cand = min(cand, __shfl_xor(cand, 4)); \
            cand = min(cand, __shfl_xor(cand, 8)); cand = min(cand, __shfl_xor(cand, 16)); cand = min(cand, __shfl_xor(cand, 32)); \
            TV = mx; TE = cand; if (erev == cand) cur = -INFINITY; }
        TOP_STEP(tv0, te0) TOP_STEP(tv1, te1) TOP_STEP(tv2, te2) TOP_STEP(tv3, te3)
#undef TOP_STEP
        const float gk0 = 1.0f, gk1 = __expf(tv1 - tv0), gk2 = __expf(tv2 - tv0), gk3 = __expf(tv3 - tv0);
        const float ginv = 1.f / (gk0 + gk1 + gk2 + gk3);
        if (lane < 4) { const int e = lane == 0 ? te0 : lane == 1 ? te1 : lane == 2 ? te2 : te3; const float g = lane == 0 ? gk0 : lane == 1 ? gk1 : lane == 2 ? gk2 : gk3;
            const int pos = atomicAdd(&cnt[e], 1);
            TOPE[row * 4 + lane] = e; TOPG[row * 4 + lane] = g * ginv;
            if (it < RT_MAXIT) { rec[it * 8 + lane * 2] = e; rec[it * 8 + lane * 2 + 1] = pos; } }
    }
    __syncthreads();
    if (tid < 32) base[tid] = atomicAdd((int*)(p.ws + WS_CTL) + tid, cnt[tid]);
    __syncthreads();
    it = 0;
    int* PERM2 = (int*)(p.ws + WS_PERM2);
    for (int row = bid * 8 + wave; row < NTOK; row += nblk * 8, ++it)
        if (lane < 4 && it < RT_MAXIT) { const int e = rec[it * 8 + lane * 2], pos = base[e] + rec[it * 8 + lane * 2 + 1]; SLOT[row * 4 + lane] = pos; PERM2[(size_t)e * NTOK + pos] = row; }
}
constexpr int MT_LDS = 131072 + 1024;
__device__ __forceinline__ void moe_tables(const P& p, unsigned char* lds) {
    const int tid = tid_opaque(); int* cn = (int*)(lds + MT_LDS); int* eb = cn + 32; int* tb = eb + 33;
    __syncthreads();
    if (tid < 32) cn[tid] = __hip_atomic_load((int*)(p.ws + WS_CTL) + tid, __ATOMIC_RELAXED, __HIP_MEMORY_SCOPE_AGENT);
    __syncthreads();
    if (tid == 0) { int s = 0, t = 0; for (int e = 0; e < 32; ++e) { eb[e] = s; tb[e] = t; s += cn[e]; t += (cn[e] + 255) >> 8; } eb[32] = s; tb[32] = t; }
    __syncthreads();
}
struct FinIdx { int e[4]; int pos[4]; float g[4]; };
struct FinData { u32x4 ys[2][4]; f32x4 x[2][2]; };
__device__ __forceinline__ void fin_load_idx(const P& p, int row, FinIdx& r) {
    const u32x4 ev = *(const u32x4*)((const int*)(p.ws + WS_TOPE) + row * 4), pv = *(const u32x4*)((const int*)(p.ws + WS_SLOT) + row * 4); const f32x4 gv = *(const f32x4*)((const float*)(p.ws + WS_TOPG) + row * 4);
#pragma unroll
    for (int k = 0; k < 4; ++k) { r.e[k] = (int)ev[k]; r.pos[k] = (int)pv[k]; r.g[k] = gv[k]; }
}
__device__ __forceinline__ void fin_load_data(const P& p, const int* eb, int row, const FinIdx& ix, FinData& d, int lane) {
    const bf16_t* YS = (const bf16_t*)(p.ws + WS_YS);
#pragma unroll
    for (int k = 0; k < 4; ++k) { const size_t slot = (size_t)(eb[ix.e[k]] + ix.pos[k]);
#pragma unroll
        for (int j = 0; j < 2; ++j) d.ys[j][k] = *(const u32x4*)(YS + slot * 1024 + 8 * lane + 512 * j); }
#pragma unroll
    for (int j = 0; j < 2; ++j) { const f32x4* xr = (const f32x4*)(p.out + (size_t)row * DM + 8 * lane + 512 * j); d.x[j][0] = xr[0]; d.x[j][1] = xr[1]; }
}
__device__ __forceinline__ void phase_final(const P& p, int bid, int nblk, unsigned char* lds) {
    moe_tables(p, lds); const int* eb = (const int*)(lds + MT_LDS) + 32;
    const int tid = tid_opaque(), wave = tid >> 6, lane = tid & 63;
    const float* mod = (const float*)(p.ws + WS_MOD);
    const int stride = nblk * 8;
    int row = bid * 8 + wave; if (row >= NTOK) return;
    FinIdx ic, in; FinData dc, dn;
    fin_load_idx(p, row, ic); fin_load_data(p, eb, row, ic, dc, lane);
    int row_n = row + stride; if (row_n < NTOK) fin_load_idx(p, row_n, in);
#pragma unroll 1
    for (;;) {
        if (row_n < NTOK) fin_load_data(p, eb, row_n, in, dn, lane);
        const int row_nn = row_n + stride; FinIdx inn; if (row_nn < NTOK) fin_load_idx(p, row_nn, inn);
        const int b = row >> 12;
        f32x4 v[2][2]; float s = 0.f;
#pragma unroll
        for (int j = 0; j < 2; ++j) { const int col = 8 * lane + 512 * j; f32x4 f0 = (f32x4){0.f, 0.f, 0.f, 0.f}, f1 = f0;
#pragma unroll
            for (int k = 0; k < 4; ++k) { const u32x4 w = dc.ys[j][k]; const float g = ic.g[k];
                f0.x += g * bflo(w.x); f0.y += g * bfhi(w.x); f0.z += g * bflo(w.y); f0.w += g * bfhi(w.y); f1.x += g * bflo(w.z); f1.y += g * bfhi(w.z); f1.z += g * bflo(w.w); f1.w += g * bfhi(w.w); }
            const f32x4 g20 = *(const f32x4*)(mod + b * 6144 + 5120 + col), g21 = *(const f32x4*)(mod + b * 6144 + 5120 + col + 4);
            v[j][0] = dc.x[j][0] * ALPHA + g20 * f0; v[j][1] = dc.x[j][1] * ALPHA + g21 * f1;
            s += ((v[j][0].x + v[j][0].y) + (v[j][0].z + v[j][0].w)) + ((v[j][1].x + v[j][1].y) + (v[j][1].z + v[j][1].w)); }
        const float mean = wave_sum(s) * (1.f / DM); float s2 = 0.f;
#pragma unroll
        for (int j = 0; j < 2; ++j)
#pragma unroll
            for (int q = 0; q < 2; ++q) { v[j][q] = v[j][q] - mean; s2 += (v[j][q].x * v[j][q].x + v[j][q].y * v[j][q].y) + (v[j][q].z * v[j][q].z + v[j][q].w * v[j][q].w); }
        const float rstd = 1.f / sqrtf(wave_sum(s2) * (1.f / DM) + LN_EPS);
#pragma unroll
        for (int j = 0; j < 2; ++j) { const int col = 8 * lane + 512 * j; f32x4* xo = (f32x4*)(p.out + (size_t)row * DM + col);
#pragma unroll
            for (int q = 0; q < 2; ++q) { const f32x4 gg = *(const f32x4*)(p.ln2_g + col + 4 * q), bb = *(const f32x4*)(p.ln2_b + col + 4 * q); xo[q] = (v[j][q] * rstd) * gg + bb; } }
        if (row_n >= NTOK) break;
        row = row_n; row_n = row_nn; ic = in; in = inn; dc = dn;
    }
}

namespace pg {
#define PG_LAS __attribute__((address_space(3)))
typedef float f32x2 __attribute__((ext_vector_type(2)));
constexpr int BM = 256, BK = 64, HALF = 128, HTB = HALF * BK * 2, STAGE_BYTES = 8 * HTB, KD = 1024, NT = KD / BK;
constexpr unsigned KSTEP = BK * 2, HSTEPB = HALF * KD * 2;
__host__ __device__ __forceinline__ int lds_byte(int r, int c) { const int st = (r >> 4) * 2 + (c >> 5), rr = r & 15, cc = c & 31, ob = rr * 64 + cc * 2; return st * 1024 + (ob ^ (((ob >> 9) & 1) << 5)); }
__host__ __device__ __forceinline__ void stage_rc(int b, int& R, int& C) { const int st = b / 1024, sb = b % 1024, swz = sb ^ (((sb >> 9) & 1) << 5); R = (st >> 1) * 16 + swz / 64; C = (st & 1) * 32 + (swz % 64) / 2; }
__host__ __device__ __forceinline__ int perm32(int rho) { const int n = rho >> 4, i = rho & 15; return 8 * (i >> 2) + 4 * n + (i & 3); }
struct Unit { int pm, pn, row0, nrows, e, kind; };
__device__ __forceinline__ void tilemap(int L, int nM, int nN, int& pm, int& pn) {
    int wgid = L; { const int nwg = nM * nN, q = nwg / 8, r = nwg % 8, xcd = wgid % 8, off = wgid / 8; wgid = (xcd < r ? xcd * (q + 1) : r * (q + 1) + (xcd - r) * q) + off; }
    const int nig = 8 * nN, gid = wgid / nig, fm = gid * 8, gsz = (nM - fm) < 8 ? (nM - fm) : 8;
    pm = fm + ((wgid % nig) % gsz); pn = (wgid % nig) / gsz;
}
__device__ __forceinline__ unsigned cvt_pk_bf16(float lo, float hi) { unsigned r; asm volatile("v_cvt_pk_bf16_f32 %0, %1, %2" : "=v"(r) : "v"(lo), "v"(hi)); return r; }
__device__ __forceinline__ f32x2 gelu_pk(f32x2 v) {
    const f32x2 av = __builtin_elementwise_abs(v), d = av * 0.2316418882f + 1.0f;
    f32x2 t; t.x = __builtin_amdgcn_rcpf(d.x); t.y = __builtin_amdgcn_rcpf(d.y);
    f32x2 q = t * 0.5307027145f + (-0.7265760135f); q = q * t + 0.7107068705f; q = q * t + (-0.142248368f); q = q * t + 0.127414796f; q = q * t;
    const f32x2 s = (v * v) * (-0.72134752044f);
    f32x2 e; e.x = __builtin_amdgcn_exp2f(s.x); e.y = __builtin_amdgcn_exp2f(s.y);
    const f32x2 m = v * (q * e), r = v - m;
    f32x2 o; o.x = v.x < 0.f ? m.x : r.x; o.y = v.y < 0.f ? m.y : r.y; return o;
}
__device__ __forceinline__ f32x4 gelu4(f32x4 v) { const f32x2 a = gelu_pk((f32x2){v[0], v[1]}), b = gelu_pk((f32x2){v[2], v[3]}); return (f32x4){a.x, a.y, b.x, b.y}; }
__device__ __forceinline__ f32x4 sigmoid4(f32x4 v) { f32x4 o;
#pragma unroll
    for (int i = 0; i < 4; ++i) o[i] = __builtin_amdgcn_rcpf(1.0f + __builtin_amdgcn_exp2f(-1.4426950408889634f * v[i]));
    return o; }
__device__ __forceinline__ u32x4 pack8v(f32x4 a, f32x4 b) { u32x4 w; w.x = cvt_pk_bf16(a[0], a[1]); w.y = cvt_pk_bf16(a[2], a[3]); w.z = cvt_pk_bf16(b[0], b[1]); w.w = cvt_pk_bf16(b[2], b[3]); return w; }

template <class Epi, class Sched, bool ALIGN_EPI>
__device__ __forceinline__ void gemm_phase(PG_LAS unsigned char* lds, const unsigned char* Abase, const Sched& S, const Epi& E) {
    const int tid = tid_opaque(), wid = __builtin_amdgcn_readfirstlane(tid >> 6), lane = tid & 63, wr = wid >> 2, wc = wid & 3, fr = lane & 15, fq = lane >> 4;
    int R[2], C[2]; unsigned voffB[2];
#pragma unroll
    for (int i = 0; i < 2; ++i) { stage_rc(tid * 16 + i * 8192, R[i], C[i]); const int Rb = Epi::PERM ? ((R[i] & ~31) + perm32(R[i] & 31)) : R[i]; voffB[i] = (unsigned)(Rb * KD + C[i]) * 2u; }
    const unsigned ldsw = (unsigned)wid * 1024u;
    const int aoff = lds_byte(wr * 64 + fr, fq * 8), boff = lds_byte(wc * 32 + fr, fq * 8);
#define PG_SA(b, h) (((b) * 2 + (h)) * HTB)
#define PG_SB(b, h) ((4 + (b) * 2 + (h)) * HTB)
#define PG_STAGE_A(bufoff, kbyte, vo) do { _Pragma("unroll") for (int _i = 0; _i < 2; ++_i) \
        __builtin_amdgcn_global_load_lds((const unsigned*)((const char*)Abase + (kbyte) + (vo)[_i]), (PG_LAS unsigned*)(lds + (bufoff) + ldsw + _i * 8192), 16, 0, 0); } while (0)
#define PG_STAGE_B(bufoff, gbase) do { _Pragma("unroll") for (int _i = 0; _i < 2; ++_i) \
        __builtin_amdgcn_global_load_lds((const unsigned*)((const char*)(gbase) + voffB[_i]), (PG_LAS unsigned*)(lds + (bufoff) + ldsw + _i * 8192), 16, 0, 0); } while (0)
#define PG_LDA(dst, b, h) do { _Pragma("unroll") for (int m = 0; m < 4; ++m) _Pragma("unroll") for (int k = 0; k < 2; ++k) dst[m][k] = *(const PG_LAS bf16x8*)(lds + PG_SA(b, h) + aoff + m * 2048 + k * 1024); } while (0)
#define PG_LDB(dst, b, h) do { _Pragma("unroll") for (int n = 0; n < 2; ++n) _Pragma("unroll") for (int k = 0; k < 2; ++k) dst[n][k] = *(const PG_LAS bf16x8*)(lds + PG_SB(b, h) + boff + n * 2048 + k * 1024); } while (0)
#define PG_MMA(ai, bj, At, Bt) do { __builtin_amdgcn_s_setprio(1); _Pragma("unroll") for (int m = 0; m < 4; ++m) _Pragma("unroll") for (int n = 0; n < 2; ++n) _Pragma("unroll") for (int k = 0; k < 2; ++k) \
        acc[ai][bj][m][n] = __builtin_amdgcn_mfma_f32_16x16x32_bf16(Bt[n][k], At[m][k], acc[ai][bj][m][n], 0, 0, 0); __builtin_amdgcn_s_setprio(0); } while (0)
#define PG_WAIT_V(n) asm volatile("s_waitcnt vmcnt(" #n ")" ::: "memory")
#define PG_WAIT_L(n) asm volatile("s_waitcnt lgkmcnt(" #n ")" ::: "memory")
#define PG_BAR __builtin_amdgcn_s_barrier()
#define PG_SCHED __builtin_amdgcn_sched_barrier(0)
    Unit cur, nxt; int ui = 0;
    if (!S.next(0, cur)) return;
    f32x4 acc[2][2][4][2];
#pragma unroll
    for (int a = 0; a < 2; ++a)
#pragma unroll
        for (int b = 0; b < 2; ++b)
#pragma unroll
            for (int m = 0; m < 4; ++m)
#pragma unroll
                for (int n = 0; n < 2; ++n) acc[a][b][m][n] = (f32x4){0.f, 0.f, 0.f, 0.f};
    bf16x8 At[4][2], B0[2][2], B1[2][2];
    unsigned ac[2][2], an[2][2];
    S.aoffs(cur, R, C, ac);
    const char* cB = S.bptr(cur);
    PG_STAGE_B(PG_SB(0, 0), cB); PG_STAGE_B(PG_SB(0, 1), cB + HSTEPB); PG_STAGE_A(PG_SA(0, 0), 0u, ac[0]); PG_STAGE_A(PG_SA(0, 1), 0u, ac[1]);
    if (wr == 1) PG_BAR;
    PG_WAIT_V(2); PG_BAR;
    PG_STAGE_B(PG_SB(1, 0), cB + KSTEP); PG_STAGE_A(PG_SA(1, 0), KSTEP, ac[0]); PG_STAGE_B(PG_SB(1, 1), cB + HSTEPB + KSTEP);
    PG_WAIT_V(6); PG_BAR;
    for (;;) {
        const bool has_next = S.next(ui + 1, nxt);
        const char* nB = cB;
        if (has_next) { S.aoffs(nxt, R, C, an); nB = S.bptr(nxt); }
        else {
#pragma unroll
            for (int h = 0; h < 2; ++h)
#pragma unroll
                for (int i = 0; i < 2; ++i) an[h][i] = ac[h][i]; }
        for (int t = 0; t < NT; t += 2) {
            const bool last = (t == NT - 2);
            const unsigned ka1 = (unsigned)(t + 1) * KSTEP;
            const unsigned ka2 = last ? 0u : (unsigned)(t + 2) * KSTEP;
            const char* b2 = last ? nB : cB + (size_t)(t + 2) * KSTEP; const char* b3 = b2 + KSTEP;
            unsigned a2o[2][2];
#pragma unroll
            for (int h = 0; h < 2; ++h)
#pragma unroll
                for (int i = 0; i < 2; ++i) a2o[h][i] = last ? an[h][i] : ac[h][i];
            PG_LDB(B0, 0, 0); PG_LDB(B1, 0, 1); PG_SCHED; PG_LDA(At, 0, 0); PG_STAGE_A(PG_SA(1, 1), ka1, ac[1]);
            PG_WAIT_V(8); PG_WAIT_L(0); PG_BAR; PG_MMA(0, 0, At, B0); PG_MMA(0, 1, At, B1); PG_BAR; PG_SCHED;
            PG_LDA(At, 0, 1); PG_STAGE_B(PG_SB(0, 0), b2); PG_STAGE_B(PG_SB(0, 1), b2 + HSTEPB); PG_STAGE_A(PG_SA(0, 0), ka2, a2o[0]);
            PG_WAIT_V(8); PG_WAIT_L(0); PG_BAR; PG_MMA(1, 0, At, B0); PG_MMA(1, 1, At, B1); PG_BAR; PG_SCHED;
            PG_LDB(B0, 1, 0); PG_LDB(B1, 1, 1); PG_SCHED; PG_LDA(At, 1, 0); PG_STAGE_A(PG_SA(0, 1), ka2, a2o[1]);
            PG_WAIT_V(8); PG_WAIT_L(0); PG_BAR; PG_MMA(0, 0, At, B0); PG_MMA(0, 1, At, B1); PG_BAR; PG_SCHED;
            PG_LDA(At, 1, 1); PG_STAGE_B(PG_SB(1, 0), b3); PG_STAGE_B(PG_SB(1, 1), b3 + HSTEPB); PG_STAGE_A(PG_SA(1, 0), ka2 + KSTEP, a2o[0]);
            PG_WAIT_V(8); PG_WAIT_L(0); PG_BAR; PG_MMA(1, 0, At, B0); PG_MMA(1, 1, At, B1); PG_BAR; PG_SCHED;
        }
        if constexpr (ALIGN_EPI) { if (wr == 0) PG_BAR; }
        E.run(acc, cur, wr, wc, fr, fq);
        if (!has_next) break;
        if (!E.carry(cur)) {
#pragma unroll
            for (int a = 0; a < 2; ++a)
#pragma unroll
                for (int b = 0; b < 2; ++b)
#pragma unroll
                    for (int m = 0; m < 4; ++m)
#pragma unroll
                        for (int n = 0; n < 2; ++n) acc[a][b][m][n] = (f32x4){0.f, 0.f, 0.f, 0.f}; }
        cur = nxt; cB = nB; ++ui;
#pragma unroll
        for (int h = 0; h < 2; ++h)
#pragma unroll
            for (int i = 0; i < 2; ++i) ac[h][i] = an[h][i];
        if constexpr (ALIGN_EPI) { if (wr == 1) PG_BAR; }
    }
    PG_WAIT_V(0);
    if constexpr (!ALIGN_EPI) { if (wr == 0) PG_BAR; }
    PG_BAR;
#undef PG_SA
#undef PG_SB
#undef PG_STAGE_A
#undef PG_STAGE_B
#undef PG_LDA
#undef PG_LDB
#undef PG_MMA
#undef PG_WAIT_V
#undef PG_WAIT_L
#undef PG_BAR
#undef PG_SCHED
}

struct SchedP1 {
    int G, c; const unsigned char* ws;
    __device__ __forceinline__ bool next(int i, Unit& u) const {
        const int L = i * G + c; if (L >= 3136) return false;
        u.row0 = 0; u.nrows = 256; u.e = 0;
        if (L < 2048) { u.kind = 0; tilemap(L, 128, 16, u.pm, u.pn); }
        else if (L < 3072) { u.kind = 1; tilemap(L - 2048, 8, 128, u.pm, u.pn); }
        else if (L < 3104) { u.kind = 2; const int l = L - 3072; u.pm = l >> 2; u.pn = l & 3; }
        else { u.kind = 3; const int l = L - 3104; u.pm = l >> 3; u.pn = l & 7; }
        return true; }
    __device__ __forceinline__ void aoffs(const Unit& u, const int (&R)[2], const int (&C)[2], unsigned (&o)[2][2]) const {
        size_t base; int row0;
        if (u.kind == 0) { base = WS_U; row0 = 256 * u.pm; }
        else if (u.kind == 1) { base = WS_WIN; row0 = u.pm < 4 ? 1024 + 256 * u.pm : 4096 + 256 * (u.pm - 4); }
        else if (u.kind == 2) { base = WS_UC; row0 = 256 * u.pm; }
        else { base = WS_WIN; row0 = 4096 + 256 * u.pm; }
#pragma unroll
        for (int h = 0; h < 2; ++h)
#pragma unroll
            for (int i = 0; i < 2; ++i) o[h][i] = (unsigned)(base + ((size_t)(row0 + 128 * h + R[i]) * 1024 + C[i]) * 2); }
    __device__ __forceinline__ const char* bptr(const Unit& u) const {
        if (u.kind == 0) { const int wrow = u.pn < 4 ? 256 * u.pn : (u.pn < 8 ? 2048 + 256 * (u.pn - 4) : 5120 + 256 * (u.pn - 8)); return (const char*)ws + WS_WIN + (size_t)wrow * 2048; }
        if (u.kind == 1) return (const char*)ws + WS_U + (size_t)u.pn * 256 * 2048;
        if (u.kind == 2) return (const char*)ws + WS_WIN + (size_t)(3072 + 256 * u.pn) * 2048;
        return (const char*)ws + WS_UC + (size_t)u.pn * 256 * 2048; }
};
struct EpiP1 {
    static constexpr bool PERM = true;
    unsigned char* ws; const float* b_in;
    __device__ __forceinline__ bool carry(const Unit&) const { return false; }
    __device__ __forceinline__ void run(f32x4 (&acc)[2][2][4][2], const Unit& u, int wr, int wc, int fr, int fq) const {
        const int lc = wc * 32 + 8 * fq, kind = u.kind, pm = u.pm, pn = u.pn;
        const bool brow = (kind == 1) || (kind == 3);
        int act, bcol, browbase, RA, RB, CA, CB; size_t base;
        if (kind == 0) { browbase = 0;
            if (pn < 4) { act = 1; bcol = 256 * pn; base = WS_ZU / 2 + (size_t)256 * pm * 1024 + 256 * pn; RA = 65536; RB = 1024; CA = 64; CB = 1; }
            else if (pn < 8) { act = 0; bcol = 2048 + 256 * (pn - 4); const int tok0 = 256 * pm;
                base = WS_Q / 2 + ((size_t)((tok0 >> 12) * 16 + 4 * (pn - 4)) * 4096 + (tok0 & 4095)) * 64; RA = 4096; RB = 64; CA = 4096 * 64; CB = 1; }
            else { act = 2; bcol = 5120 + 256 * (pn - 8); base = WS_G / 2 + (size_t)256 * pm * 2048 + 256 * (pn - 8); RA = 131072; RB = 2048; CA = 64; CB = 1; } }
        else if (kind == 1) { bcol = 0; const int tk0 = 256 * pn;
            if (pm < 4) { act = 1; browbase = 1024 + 256 * pm; base = WS_ZVT / 2 + (size_t)(tk0 >> 3) * 8192 + 256 * pm * 8; RA = 512; RB = 8; CA = 65536; CB = 1024; }
            else { act = 0; browbase = 4096 + 256 * (pm - 4); base = WS_VT / 2 + ((size_t)((tk0 >> 12) * 16 + 4 * (pm - 4)) * 512 + ((tk0 & 4095) >> 3)) * 512; RA = 512 * 512; RB = 8; CA = 4096; CB = 64; } }
        else if (kind == 2) { act = 0; bcol = 3072 + 256 * pn; browbase = 0; base = WS_KC / 2 + (size_t)(pm * 16 + 4 * pn) * 256 * 64; RA = 4096; RB = 64; CA = 16384; CB = 1; }
        else { act = 0; bcol = 0; browbase = 4096 + 256 * pm; base = WS_VCT / 2 + (size_t)(pn * 16 + 4 * pm) * 32 * 512; RA = 32 * 512; RB = 8; CA = 4096; CB = 64; }
        bf16_t* dbase = (bf16_t*)ws + base;
        f32x4 bv[2][2];
#pragma unroll
        for (int bj = 0; bj < 2; ++bj)
#pragma unroll
            for (int n = 0; n < 2; ++n) bv[bj][n] = brow ? (f32x4){0.f, 0.f, 0.f, 0.f} : *(const f32x4*)(b_in + bcol + lc + bj * HALF + 4 * n);
        const int colterm0 = (wc >> 1) * CA + ((wc & 1) * 32 + 8 * fq) * CB;
#pragma unroll
        for (int ai = 0; ai < 2; ++ai)
#pragma unroll
            for (int m = 0; m < 4; ++m) { const int row = ai * HALF + wr * 64 + m * 16 + fr;
                const float rb = brow ? b_in[browbase + row] : 0.f;
                const int rowterm = (2 * ai + wr) * RA + (16 * m + fr) * RB;
#pragma unroll
                for (int bj = 0; bj < 2; ++bj) {
                    f32x4 v0 = acc[ai][bj][m][0] + bv[bj][0] + rb, v1 = acc[ai][bj][m][1] + bv[bj][1] + rb;
                    if (act == 1) { v0 = gelu4(v0); v1 = gelu4(v1); } else if (act == 2) { v0 = sigmoid4(v0); v1 = sigmoid4(v1); }
                    *(u32x4*)(dbase + rowterm + colterm0 + 2 * bj * CA) = pack8v(v0, v1); } }
    }
};
struct SchedK {
    int G, c; const unsigned char* ws;
    __device__ __forceinline__ bool next(int i, Unit& u) const { const int L = i * G + c; if (L >= 512) return false; u.kind = 0; u.row0 = 0; u.nrows = 256; u.e = 0; tilemap(L, 128, 4, u.pm, u.pn); return true; }
    __device__ __forceinline__ void aoffs(const Unit& u, const int (&R)[2], const int (&C)[2], unsigned (&o)[2][2]) const {
#pragma unroll
        for (int h = 0; h < 2; ++h)
#pragma unroll
            for (int i = 0; i < 2; ++i) o[h][i] = (unsigned)(WS_U + ((size_t)(256 * u.pm + 128 * h + R[i]) * 1024 + C[i]) * 2); }
    __device__ __forceinline__ const char* bptr(const Unit& u) const { return (const char*)ws + WS_WIN + (size_t)(3072 + 256 * u.pn) * 2048; }
};
struct EpiRope {
    static constexpr bool PERM = false;
    unsigned char* ws; const float* b_in;
    __device__ __forceinline__ bool carry(const Unit&) const { return false; }
    __device__ __forceinline__ void run(f32x4 (&acc)[2][2][4][2], const Unit& u, int wr, int wc, int fr, int fq) const {
        bf16_t* K = (bf16_t*)(ws + WS_K); const float* tab = (const float*)(ws + WS_ROPE);
        const int lc = wc * 32 + 4 * fq, axis = wc & 1;
        f32x4 b0[2], b1[2];
#pragma unroll
        for (int bj = 0; bj < 2; ++bj) { b0[bj] = *(const f32x4*)(b_in + 3072 + 256 * u.pn + bj * HALF + lc); b1[bj] = *(const f32x4*)(b_in + 3072 + 256 * u.pn + bj * HALF + lc + 16); }
#pragma unroll
        for (int ai = 0; ai < 2; ++ai)
#pragma unroll
            for (int m = 0; m < 4; ++m) { const int tok = 256 * u.pm + ai * HALF + wr * 64 + m * 16 + fr;
                const int pos = axis ? (tok & 63) : ((tok >> 6) & 63);
                const f32x4 t0 = *(const f32x4*)(tab + (pos * 16 + 4 * fq) * 2), t1 = *(const f32x4*)(tab + (pos * 16 + 4 * fq) * 2 + 4);
                const f32x4 cs = (f32x4){t0[0], t0[2], t1[0], t1[2]}, sn = (f32x4){t0[1], t0[3], t1[1], t1[3]};
                const int cc0 = 256 * u.pn + lc;
                bf16_t* rowp = K + ((size_t)((tok >> 12) * 16) * 4096 + (tok & 4095)) * 64;
#pragma unroll
                for (int bj = 0; bj < 2; ++bj) { const f32x4 v0 = acc[ai][bj][m][0] + b0[bj], v1 = acc[ai][bj][m][1] + b1[bj];
                    const f32x4 o0 = v0 * cs - v1 * sn, o1 = v1 * cs + v0 * sn;
                    u32x2 w0, w1; w0.x = cvt_pk_bf16(o0[0], o0[1]); w0.y = cvt_pk_bf16(o0[2], o0[3]); w1.x = cvt_pk_bf16(o1[0], o1[1]); w1.y = cvt_pk_bf16(o1[2], o1[3]);
                    const int cc = cc0 + bj * HALF; bf16_t* dp = rowp + (size_t)(cc >> 6) * 4096 * 64 + (cc & 63);
                    *(u32x2*)dp = w0; *(u32x2*)(dp + 16) = w1; } }
    }
};
struct SchedMerge {
    int G, c; const unsigned char* ws;
    __device__ __forceinline__ bool next(int i, Unit& u) const { const int L = (i >> 1) * G + c; if (L >= 512) return false; u.kind = i & 1; u.row0 = 0; u.nrows = 256; u.e = 0; tilemap(L, 128, 4, u.pm, u.pn); return true; }
    __device__ __forceinline__ void aoffs(const Unit& u, const int (&R)[2], const int (&C)[2], unsigned (&o)[2][2]) const {
        const size_t base = u.kind ? WS_YB : WS_U;
#pragma unroll
        for (int h = 0; h < 2; ++h)
#pragma unroll
            for (int i = 0; i < 2; ++i) o[h][i] = (unsigned)(base + ((size_t)(256 * u.pm + 128 * h + R[i]) * 1024 + C[i]) * 2); }
    __device__ __forceinline__ const char* bptr(const Unit& u) const { return (const char*)ws + (u.kind ? WS_WPB : WS_WPA) + (size_t)u.pn * 256 * 2048; }
};
struct EpiMerge {
    static constexpr bool PERM = true;
    unsigned char* ws;
    __device__ __forceinline__ bool carry(const Unit& u) const { return u.kind == 0; }
    __device__ __forceinline__ void run(f32x4 (&acc)[2][2][4][2], const Unit& u, int wr, int wc, int fr, int fq) const {
        const bf16_t* Gt = (const bf16_t*)(ws + WS_G); bf16_t* INNER = (bf16_t*)(ws + WS_INNER);
        const int lc = 256 * u.pn + wc * 32 + 8 * fq;
#pragma unroll
        for (int ai = 0; ai < 2; ++ai)
#pragma unroll
            for (int m = 0; m < 4; ++m) { const size_t tok = (size_t)(256 * u.pm + ai * HALF + wr * 64 + m * 16 + fr);
#pragma unroll
                for (int bj = 0; bj < 2; ++bj) { const int col = lc + bj * HALF;
                    const u32x4 gbw = *(const u32x4*)(Gt + tok * 2048 + 1024 + col);
                    f32x4 gb0 = (f32x4){bflo(gbw.x), bfhi(gbw.x), bflo(gbw.y), bfhi(gbw.y)}, gb1 = (f32x4){bflo(gbw.z), bfhi(gbw.z), bflo(gbw.w), bfhi(gbw.w)};
                    if (u.kind == 0) { const u32x4 gaw = *(const u32x4*)(Gt + tok * 2048 + col);
                        const f32x4 ga0 = (f32x4){bflo(gaw.x), bfhi(gaw.x), bflo(gaw.y), bfhi(gaw.y)}, ga1 = (f32x4){bflo(gaw.z), bfhi(gaw.z), bflo(gaw.w), bfhi(gaw.w)};
#pragma unroll
                        for (int i = 0; i < 4; ++i) { acc[ai][bj][m][0][i] *= ga0[i] * __builtin_amdgcn_rcpf(fmaxf(gb0[i], 1e-30f)); acc[ai][bj][m][1][i] *= ga1[i] * __builtin_amdgcn_rcpf(fmaxf(gb1[i], 1e-30f)); }
                    } else { *(u32x4*)(INNER + tok * 1024 + col) = pack8v(acc[ai][bj][m][0] * gb0, acc[ai][bj][m][1] * gb1); } } }
    }
};
struct SchedMix {
    int G, c; const unsigned char* ws;
    __device__ __forceinline__ bool next(int i, Unit& u) const { const int L = i * G + c; if (L >= 512) return false; u.kind = 0; u.row0 = 0; u.nrows = 256; u.e = 0; tilemap(L, 128, 4, u.pm, u.pn); return true; }
    __device__ __forceinline__ void aoffs(const Unit& u, const int (&R)[2], const int (&C)[2], unsigned (&o)[2][2]) const {
#pragma unroll
        for (int h = 0; h < 2; ++h)
#pragma unroll
            for (int i = 0; i < 2; ++i) o[h][i] = (unsigned)(WS_INNER + ((size_t)(256 * u.pm + 128 * h + R[i]) * 1024 + C[i]) * 2); }
    __device__ __forceinline__ const char* bptr(const Unit& u) const { return (const char*)ws + WS_WOUT + (size_t)u.pn * 256 * 2048; }
};
struct EpiMix {
    static constexpr bool PERM = false;
    unsigned char* ws; const float *x, *lng, *lnb, *b_out; float* out;
    __device__ __forceinline__ bool carry(const Unit&) const { return false; }
    __device__ __forceinline__ void run(f32x4 (&acc)[2][2][4][2], const Unit& u, int wr, int wc, int fr, int fq) const {
        const float* rowstat = (const float*)(ws + WS_ROWSTAT); const float* mod = (const float*)(ws + WS_MOD) + ((256 * u.pm) >> 12) * 6144 + 2048;
        f32x2 st[2][4];
#pragma unroll
        for (int ai = 0; ai < 2; ++ai)
#pragma unroll
            for (int m = 0; m < 4; ++m) st[ai][m] = *(const f32x2*)(rowstat + 2 * (256 * u.pm + ai * HALF + wr * 64 + m * 16 + fr));
#pragma unroll
        for (int bj = 0; bj < 2; ++bj)
#pragma unroll
            for (int n = 0; n < 2; ++n) { const int col = 256 * u.pn + bj * HALF + wc * 32 + n * 16 + 4 * fq;
                const f32x4 lg = *(const f32x4*)(lng + col), lb = *(const f32x4*)(lnb + col), bo = *(const f32x4*)(b_out + col), g1 = *(const f32x4*)(mod + col);
#pragma unroll
                for (int ai = 0; ai < 2; ++ai)
#pragma unroll
                    for (int m = 0; m < 4; ++m) { const size_t off = (size_t)(256 * u.pm + ai * HALF + wr * 64 + m * 16 + fr) * 1024 + col;
                        const f32x4 xv = *(const f32x4*)(x + off);
                        const f32x4 x0 = (xv - st[ai][m].x) * st[ai][m].y * lg + lb;
                        *(f32x4*)(out + off) = x0 * ALPHA + g1 * (acc[ai][bj][m][n] + bo); }
                asm volatile("" ::: "memory"); }
    }
};
__device__ __forceinline__ int ld_u(const int* p) { return __builtin_amdgcn_readfirstlane(__hip_atomic_load(p, __ATOMIC_RELAXED, __HIP_MEMORY_SCOPE_AGENT)); }
template <int NPN  > struct SchedMoe {
    int G, c; const unsigned char* ws; const int* tabs;
    __device__ __forceinline__ bool next(int i, Unit& u) const {
        const int* cn = tabs; const int* eb = tabs + 32; const int* tb = tabs + 65;
        const int ntiles = tb[32], tpx = (ntiles + 7) >> 3, x = c & 7, s = c >> 3;
        const int tiles_x = min(tpx, ntiles - x * tpx), ll = i * (G >> 3) + s;
        if (ll >= NPN * tiles_x) return false;
        const int T = x * tpx + ll / NPN; u.pn = ll % NPN; u.kind = 0;
        int e = 0;
#pragma unroll 1
        for (int k = 16; k >= 1; k >>= 1) if (tb[e + k] <= T) e += k;
        const int jt = T - tb[e];
        u.e = __builtin_amdgcn_readfirstlane(e); u.pm = __builtin_amdgcn_readfirstlane(jt);
        u.row0 = __builtin_amdgcn_readfirstlane(eb[e] + 256 * jt); u.nrows = __builtin_amdgcn_readfirstlane(min(256, cn[e] - 256 * jt)); return true; }
    __device__ __forceinline__ void aoffs(const Unit& u, const int (&R)[2], const int (&C)[2], unsigned (&o)[2][2]) const {
        const int* PERM2 = (const int*)(ws + WS_PERM2) + (size_t)u.e * NTOK + 256 * u.pm;
#pragma unroll
        for (int h = 0; h < 2; ++h)
#pragma unroll
            for (int i = 0; i < 2; ++i) { const int lr = min(128 * h + R[i], u.nrows - 1);
                if (NPN == 8) { const int tok = PERM2[lr]; o[h][i] = (unsigned)(WS_U + ((size_t)tok * 1024 + C[i]) * 2); }
                else o[h][i] = (unsigned)(WS_ACT + ((size_t)(u.row0 + lr) * 1024 + C[i]) * 2); } }
    __device__ __forceinline__ const char* bptr(const Unit& u) const {
        if (NPN == 8) return (const char*)ws + WS_W1 + ((size_t)u.e * 2048 + 256 * u.pn) * 2048;
        return (const char*)ws + WS_W2 + ((size_t)u.e * 1024 + 256 * u.pn) * 2048; }
};
struct EpiMoe1 {
    static constexpr bool PERM = true;
    unsigned char* ws; const float* b1;
    __device__ __forceinline__ bool carry(const Unit&) const { return false; }
    __device__ __forceinline__ void run(f32x4 (&acc)[2][2][4][2], const Unit& u, int wr, int wc, int fr, int fq) const {
        bf16_t* ACT = (bf16_t*)(ws + WS_ACT);
        const int col = 128 * u.pn + wc * 32 + 8 * fq;
        f32x4 bg[2], bl[2];
#pragma unroll
        for (int n = 0; n < 2; ++n) { bg[n] = *(const f32x4*)(b1 + u.e * 2048 + col + 4 * n); bl[n] = *(const f32x4*)(b1 + u.e * 2048 + 1024 + col + 4 * n); }
#pragma unroll
        for (int ai = 0; ai < 2; ++ai)
#pragma unroll
            for (int m = 0; m < 4; ++m) { const int lr = ai * HALF + wr * 64 + m * 16 + fr;
                f32x4 a[2];
#pragma unroll
                for (int n = 0; n < 2; ++n) { const f32x4 zgv = acc[ai][0][m][n] + bg[n], zlv = acc[ai][1][m][n] + bl[n];
#pragma unroll
                    for (int i = 0; i < 4; ++i) { const float zg = fminf(zgv[i], 7.0f), zl = fminf(fmaxf(zlv[i], -7.0f), 7.0f);
                        a[n][i] = zg * __builtin_amdgcn_rcpf(1.0f + __builtin_amdgcn_exp2f(-1.702f * 1.4426950408889634f * zg)) * (zl + 1.0f); } }
                if (lr < u.nrows) *(u32x4*)(ACT + (size_t)(u.row0 + lr) * 1024 + col) = pack8v(a[0], a[1]); }
    }
};
struct EpiMoe2 {
    static constexpr bool PERM = true;
    unsigned char* ws; const float* b2;
    __device__ __forceinline__ bool carry(const Unit&) const { return false; }
    __device__ __forceinline__ void run(f32x4 (&acc)[2][2][4][2], const Unit& u, int wr, int wc, int fr, int fq) const {
        bf16_t* YS = (bf16_t*)(ws + WS_YS);
        const int lc = 256 * u.pn + wc * 32 + 8 * fq;
        f32x4 bv[2][2];
#pragma unroll
        for (int bj = 0; bj < 2; ++bj)
#pragma unroll
            for (int n = 0; n < 2; ++n) bv[bj][n] = *(const f32x4*)(b2 + u.e * 1024 + lc + bj * HALF + 4 * n);
#pragma unroll
        for (int ai = 0; ai < 2; ++ai)
#pragma unroll
            for (int m = 0; m < 4; ++m) { const int lr = ai * HALF + wr * 64 + m * 16 + fr;
                if (lr < u.nrows) {
#pragma unroll
                    for (int bj = 0; bj < 2; ++bj) *(u32x4*)(YS + (size_t)(u.row0 + lr) * 1024 + lc + bj * HALF) = pack8v(acc[ai][bj][m][0] + bv[bj][0], acc[ai][bj][m][1] + bv[bj][1]); } }
    }
};
}
__device__ __forceinline__ void phase_merge_fast(const P& p, int bid, int nblk, unsigned char* lds) {
    pg::SchedMerge S{nblk, bid, p.ws}; pg::EpiMerge E{p.ws};
    pg::gemm_phase<pg::EpiMerge, pg::SchedMerge, true>((PG_LAS unsigned char*)lds, p.ws, S, E);
}
__device__ __forceinline__ void phase_mix_fast(const P& p, int bid, int nblk, unsigned char* lds) {
    pg::SchedMix S{nblk, bid, p.ws}; pg::EpiMix E{p.ws, p.x, p.ln_x_g, p.ln_x_b, p.b_out, p.out};
    pg::gemm_phase<pg::EpiMix, pg::SchedMix, true>((PG_LAS unsigned char*)lds, p.ws, S, E);
}
__device__ __forceinline__ void phase_moe1_fast(const P& p, int bid, int nblk, unsigned char* lds) {
    moe_tables(p, lds); pg::SchedMoe<8> S{nblk, bid, p.ws, (const int*)(lds + MT_LDS)}; pg::EpiMoe1 E{p.ws, p.exp_b1};
    pg::gemm_phase<pg::EpiMoe1, pg::SchedMoe<8>, true>((PG_LAS unsigned char*)lds, p.ws, S, E);
}
__device__ __forceinline__ void phase_moe2_fast(const P& p, int bid, int nblk, unsigned char* lds) {
    moe_tables(p, lds); pg::SchedMoe<4> S{nblk, bid, p.ws, (const int*)(lds + MT_LDS)}; pg::EpiMoe2 E{p.ws, p.exp_b2};
    pg::gemm_phase<pg::EpiMoe2, pg::SchedMoe<4>, true>((PG_LAS unsigned char*)lds, p.ws, S, E);
}
__device__ __forceinline__ void phase_proj_fast(const P& p, int bid, int nblk, unsigned char* lds) {
    { pg::SchedP1 S{nblk, bid, p.ws}; pg::EpiP1 E{p.ws, p.b_in};
      pg::gemm_phase<pg::EpiP1, pg::SchedP1, true>((PG_LAS unsigned char*)lds, p.ws, S, E); }
    { pg::SchedK S{nblk, bid, p.ws}; pg::EpiRope E{p.ws, p.b_in};
      pg::gemm_phase<pg::EpiRope, pg::SchedK, true>((PG_LAS unsigned char*)lds, p.ws, S, E); }
}

#define LAS __attribute__((address_space(3)))
#define XB_TMO      128
#define XB_XCNT(j)  (256  + 64 * (j))
#define XB_XSUB(j)  (1280 + 64 * (j))
#define XB_XGEN(j)  (2304 + 64 * (j))
#define XB_TOP      3328
#define XB_TOPGEN   3392
#define XCD_BAR_WORDS 3456
#define XB_SPIN_CAP (1u << 22)
__device__ __forceinline__ unsigned xb_ld(unsigned* p)              { return __hip_atomic_load(p, __ATOMIC_RELAXED, __HIP_MEMORY_SCOPE_AGENT); }
__device__ __forceinline__ unsigned xb_add(unsigned* p, unsigned v) { return __hip_atomic_fetch_add(p, v, __ATOMIC_RELAXED, __HIP_MEMORY_SCOPE_AGENT); }
__device__ __forceinline__ unsigned xb_xcc_id() { return (unsigned)__builtin_amdgcn_s_getreg((3 << 11) | 20) & 0xFu; }
#define XB_SPIN(cond, bar) do { unsigned _sp = 0; while (cond) { __builtin_amdgcn_s_sleep(1); \
    if ((++_sp & 255u) == 0u) { if (xb_ld(&(bar)[XB_TMO])) break; if (_sp > XB_SPIN_CAP) { atomicAdd(&(bar)[XB_TMO], 1u); break; } } } } while (0)
struct XcdBarrier { unsigned* bar; unsigned x; volatile LAS unsigned* st; };
__device__ __forceinline__ XcdBarrier xcd_barrier_post(unsigned* bar, volatile LAS unsigned* st) {
    XcdBarrier b; b.bar = bar; b.x = xb_xcc_id(); b.st = st;
    if (threadIdx.x == 0) (void)xb_add(&bar[XB_XCNT(b.x)], 1u);
    return b;
}
__device__ __forceinline__ void xcd_barrier_complete(unsigned* bar, unsigned x, unsigned& nloc, unsigned& nx) {
    const unsigned G = gridDim.x * gridDim.y * gridDim.z;
    unsigned sum, cnt, mine, sp = 0u;
    for (;;) {
        sum = 0u; cnt = 0u; mine = 0u;
#pragma unroll
        for (unsigned j = 0; j < 16; ++j) { const unsigned c = xb_ld(&bar[XB_XCNT(j)]); sum += c; cnt += (c > 0u) ? 1u : 0u; mine = (j == x) ? c : mine; }
        if (sum == G) break;
        __builtin_amdgcn_s_sleep(1);
        if ((++sp & 255u) == 0u) { if (xb_ld(&bar[XB_TMO])) break; if (sp > XB_SPIN_CAP) { atomicAdd(&bar[XB_TMO], 1u); break; } }
    }
    nloc = mine > 0u ? mine : 1u; nx = cnt > 0u ? cnt : 1u;
}
__device__ __forceinline__ void xcd_barrier(const XcdBarrier& b) {
    asm volatile("s_waitcnt vmcnt(0)" ::: "memory");
    __syncthreads();
    if (threadIdx.x == 0) {
        unsigned* bar = b.bar;
        __builtin_amdgcn_s_waitcnt(0);
        unsigned nloc = b.st[0], nx = b.st[1];
        if (nloc == 0u) { xcd_barrier_complete(bar, b.x, nloc, nx); b.st[0] = nloc; b.st[1] = nx; }
        const unsigned old = xb_add(&bar[XB_XSUB(b.x)], 1u);
        const unsigned gen = old / nloc;
        if (old + 1u == (gen + 1u) * nloc) {
            __builtin_amdgcn_fence(__ATOMIC_RELEASE, "agent");
            asm volatile("s_waitcnt vmcnt(0)" ::: "memory");
            const unsigned og = xb_add(&bar[XB_TOP], 1u);
            const unsigned tg = og / nx;
            if (og + 1u == (tg + 1u) * nx) xb_add(&bar[XB_TOPGEN], 1u);
            else XB_SPIN(xb_ld(&bar[XB_TOPGEN]) == tg, bar);
            __builtin_amdgcn_fence(__ATOMIC_ACQUIRE, "agent");
            xb_add(&bar[XB_XGEN(b.x)], 1u);
            asm volatile("s_waitcnt vmcnt(0)" ::: "memory");
        } else {
            XB_SPIN(xb_ld(&bar[XB_XGEN(b.x)]) == gen, bar);
            __builtin_amdgcn_fence(__ATOMIC_ACQUIRE, "agent");
            asm volatile("s_waitcnt vmcnt(0)" ::: "memory");
        }
    }
    __syncthreads();
}
#include <hip/hip_cooperative_groups.h>
namespace cg = cooperative_groups;
constexpr int LDS_BYTES = 147456;
constexpr int XB_LDS = LDS_BYTES - 64;
constexpr int CW_BAR = 4096;
constexpr int REP_PA = 1, REP_PB = 1, REP_P1 = 1, REP_GMLP = 1, REP_ATTN = 1, REP_MERGE = 1, REP_MIX = 1, REP_MOE1 = 1, REP_MOE2 = 1, REP_BAR = 0;
__global__ void __launch_bounds__(512, 2) mega(P p) {
    extern __shared__ __attribute__((aligned(16))) unsigned char lds[];
    const int bid = blockIdx.x, nblk = gridDim.x;
    if (threadIdx.x < 16) ((volatile LAS unsigned*)((LAS unsigned char*)lds + XB_LDS))[threadIdx.x] = 0u;
    __syncthreads();
    const XcdBarrier bar = xcd_barrier_post((unsigned*)(p.ws + WS_CTL) + CW_BAR, (volatile LAS unsigned*)((LAS unsigned char*)lds + XB_LDS));
#define GRID_BAR() xcd_barrier(bar)
#define REP(n) _Pragma("unroll 1") for (int rep_ = 0; rep_ < (n); ++rep_)
    REP(REP_PA) { __syncthreads(); phase_prologue_a(p, bid, nblk, lds); } GRID_BAR();
    REP(REP_PB) phase_prologue_b(p, bid, nblk); GRID_BAR();
    REP(REP_P1) phase_proj_fast(p, bid, nblk, lds); GRID_BAR();
    REP(REP_GMLP) phase_gmlp_fast(p, bid, nblk, lds); REP(REP_ATTN) phase_attn_s(p, bid, nblk, lds); GRID_BAR();
    REP(REP_MERGE) phase_merge_fast(p, bid, nblk, lds); GRID_BAR();
    REP(REP_MIX) phase_mix_fast(p, bid, nblk, lds); GRID_BAR();
    phase_router(p, bid, nblk, lds); GRID_BAR();
    REP(REP_BAR) GRID_BAR();
    REP(REP_MOE1) phase_moe1_fast(p, bid, nblk, lds); GRID_BAR();
    REP(REP_MOE2) phase_moe2_fast(p, bid, nblk, lds); GRID_BAR();
#undef REP
    phase_final(p, bid, nblk, lds);
}

extern "C" void kernel_launch(void* const* d_in, const int* in_sizes, int n_in, void* d_out, int out_size, void* d_ws, size_t ws_size, hipStream_t stream) {
    static int grid = 0;
    if (grid == 0) {
        if (n_in != 31 || out_size != NTOK * DM || ws_size < WS_END) { fprintf(stderr, "kernel_launch: unexpected sizes n_in %d out %d ws %zu\n", n_in, out_size, ws_size); grid = -1; return; }
        int dev = 0, cus = 0, per_cu = 0;
        if (hipGetDevice(&dev) != hipSuccess || hipDeviceGetAttribute(&cus, hipDeviceAttributeMultiprocessorCount, dev) != hipSuccess) { grid = -1; return; }
        if (hipFuncSetAttribute((const void*)mega, hipFuncAttributeMaxDynamicSharedMemorySize, LDS_BYTES) != hipSuccess) { fprintf(stderr, "kernel_launch: hipFuncSetAttribute failed\n"); grid = -1; return; }
        if (hipOccupancyMaxActiveBlocksPerMultiprocessor(&per_cu, (const void*)mega, 512, LDS_BYTES) != hipSuccess || per_cu < 1) { fprintf(stderr, "kernel_launch: occupancy query failed (%d)\n", per_cu); grid = -1; return; }
        grid = cus * 1;
    }
    if (grid < 0) return;
    P p{};
    const float** pp = (const float**)&p;
    for (int i = 0; i < 31; ++i) pp[i] = (const float*)d_in[i];
    p.out = (float*)d_out; p.ws = (unsigned char*)d_ws; p.ph_lo = 0; p.ph_hi = 0;
    if (hipMemsetAsync((char*)d_ws + WS_CTL, 0, 1 * MiB, stream) != hipSuccess) { fprintf(stderr, "kernel_launch: memset failed\n"); return; }
    hipLaunchKernelGGL(mega, dim3(grid), dim3(512), LDS_BYTES, stream, p);
    const hipError_t e = hipPeekAtLastError();
    if (e != hipSuccess) fprintf(stderr, "launch failed: %s (grid %d)\n", hipGetErrorString(e), grid);
}
```

```cpp
#include <hip/hip_runtime.h>
#include <cstdio>
#include <cstdint>

typedef unsigned short bf16_t;
typedef short bf16x8 __attribute__((ext_vector_type(8)));
typedef float f32x4 __attribute__((ext_vector_type(4)));
typedef unsigned u32x4 __attribute__((ext_vector_type(4)));
typedef unsigned u32x2 __attribute__((ext_vector_type(2)));

constexpr int DM = 1024, NB = 8, SEQ = 4096, NTOK = NB * SEQ, CTXL = 256, NCTX = NB * CTXL, INW = 7168;
constexpr int NE = 32, TOPK = 4, FF = 1024, NASSIGN = NTOK * TOPK;
constexpr int NHEAD = 16, HD = 64, GW = 64;
constexpr float LN_EPS = 1e-5f;
constexpr float ALPHA = 1.189207115002721f;
constexpr int MAXTILES = NASSIGN / 256 + NE;

constexpr size_t MiB = 1u << 20;
constexpr size_t WS_CTL = 0;
constexpr size_t WS_MOD = 1 * MiB;
constexpr size_t WS_ROPE = 1 * MiB + 512 * 1024;
constexpr size_t WS_ROWSTAT = 2 * MiB;
constexpr size_t WS_ZSTAT = 2 * MiB + 512 * 1024;
constexpr size_t WS_TOPE = 3 * MiB;
constexpr size_t WS_TOPG = 4 * MiB;
constexpr size_t WS_SLOT = 5 * MiB;
constexpr size_t WS_PERM = 6 * MiB;
constexpr size_t WS_TILES = 7 * MiB;
constexpr size_t WS_WIN = 8 * MiB;
constexpr size_t WS_WPA = 22 * MiB, WS_WPB = 24 * MiB, WS_WOUT = 26 * MiB, WS_WSB = 28 * MiB;
constexpr size_t WS_KC = 30 * MiB;
constexpr size_t WS_VCT = 34 * MiB;
constexpr size_t WS_UC = 38 * MiB;
constexpr size_t WS_PERM2 = 42 * MiB;
constexpr size_t WS_W1 = 48 * MiB;
constexpr size_t WS_W2 = 176 * MiB;
constexpr size_t WS_U = 240 * MiB;
constexpr size_t WS_ZU = 304 * MiB;
constexpr size_t WS_ZVT = 368 * MiB;
constexpr size_t WS_Q = 432 * MiB;
constexpr size_t WS_K = 496 * MiB;
constexpr size_t WS_VT = 560 * MiB;
constexpr size_t WS_G = 624 * MiB;
constexpr size_t WS_YB = 752 * MiB;
constexpr size_t WS_INNER = 816 * MiB;
constexpr size_t WS_ACT = WS_ZU;
constexpr size_t WS_YS = WS_G;
constexpr size_t WS_END = 880 * MiB;

struct P {
    const float *x, *c, *ctx, *c_ctx, *ln_x_g, *ln_x_b, *ln_ctx_g, *ln_ctx_b, *w_ada, *b_ada, *w_in, *b_in, *gmlp_ln_g, *gmlp_ln_b, *gmlp_ws, *gmlp_bs,
        *na_rpb, *w_pa, *w_pb, *w_out, *b_out, *ln1_g, *ln1_b, *ln2_g, *ln2_b, *router_w, *router_b, *exp_w1, *exp_b1, *exp_w2, *exp_b2;
    float* out; unsigned char* ws; int ph_lo, ph_hi;
};

__device__ __forceinline__ int tid_opaque() { int t = threadIdx.x; asm volatile("" : "+v"(t)); return t; }
typedef float f32x2_ __attribute__((ext_vector_type(2))); typedef __bf16 bf16x2_ __attribute__((ext_vector_type(2)));
__device__ __forceinline__ unsigned pk2(float lo, float hi) { const f32x2_ v = {lo, hi}; return __builtin_bit_cast(unsigned, __builtin_convertvector(v, bf16x2_)); }
__device__ __forceinline__ unsigned f2bf(float f) { return pk2(f, 0.f) & 0xffffu; }
__device__ __forceinline__ float bf2f(unsigned h) { return __builtin_bit_cast(float, (h & 0xffffu) << 16); }
__device__ __forceinline__ float bflo(unsigned w) { return __builtin_bit_cast(float, w << 16); }
__device__ __forceinline__ float bfhi(unsigned w) { return __builtin_bit_cast(float, w & 0xffff0000u); }
__device__ __forceinline__ float wave_sum(float v) {
#pragma unroll
    for (int o = 1; o < 64; o <<= 1) v += __shfl_xor(v, o);
    return v;
}
__device__ __forceinline__ float wave_max(float v) {
#pragma unroll
    for (int o = 1; o < 64; o <<= 1) v = fmaxf(v, __shfl_xor(v, o));
    return v;
}
__device__ __forceinline__ float gelu_exact(float v) { return 0.5f * v * (1.0f + erff(v * 0.70710678118654752f)); }
__device__ __forceinline__ float sigmoidf_(float v) { return 1.0f / (1.0f + __expf(-v)); }

__device__ __forceinline__ void mod_item(const P& p, int item, float* red  ) {
    const int tid = tid_opaque(), wave = tid >> 6, lane = tid & 63;
    const int col = item * 32 + (lane & 31), kpar = lane >> 5;
    float acc[9];
#pragma unroll
    for (int r = 0; r < 9; ++r) acc[r] = 0.f;
    for (int kk = 0; kk < 64; ++kk) {
        const int k = wave * 128 + kk * 2 + kpar;
        const float w = p.w_ada[(size_t)k * 6144 + col];
#pragma unroll
        for (int r = 0; r < 9; ++r) { const float cv = (r < 8) ? p.c[r * 1024 + k] : p.c_ctx[k]; const float s = cv / (1.0f + __expf(-cv)); acc[r] += s * w; }
    }
#pragma unroll
    for (int r = 0; r < 9; ++r) red[((wave * 2 + kpar) * 9 + r) * 32 + (lane & 31)] = acc[r];
    __syncthreads();
    if (tid < 288) {
        const int r = tid >> 5, cc = tid & 31; float s = 0.f;
#pragma unroll
        for (int q = 0; q < 16; ++q) s += red[(q * 9 + r) * 32 + cc];
        ((float*)(p.ws + WS_MOD))[r * 6144 + item * 32 + cc] = s + p.b_ada[item * 32 + cc];
    }
    __syncthreads();
}
__device__ __forceinline__ void transpose_item(const float* W, int K, int N, bf16_t* WT, int k0, int n0, int drow0, float* scr, int lane) {
    const int lr = lane >> 3, lc4 = (lane & 7) * 4;
    f32x4 v[8];
#pragma unroll
    for (int i = 0; i < 8; ++i) v[i] = *(const f32x4*)(W + (size_t)(k0 + 8 * i + lr) * N + n0 + lc4);
#pragma unroll
    for (int i = 0; i < 8; ++i) { float* d = scr + (8 * i + lr) * 33 + lc4; d[0] = v[i].x; d[1] = v[i].y; d[2] = v[i].z; d[3] = v[i].w; }
    __builtin_amdgcn_wave_barrier();
    asm volatile("s_waitcnt lgkmcnt(0)" ::: "memory");
    const int c = lane & 7;
#pragma unroll
    for (int j = 0; j < 4; ++j) { const int n = (lane >> 3) + 8 * j; const float* s = scr + (8 * c) * 33 + n;
        u32x4 o; o.x = pk2(s[0 * 33], s[1 * 33]); o.y = pk2(s[2 * 33], s[3 * 33]); o.z = pk2(s[4 * 33], s[5 * 33]); o.w = pk2(s[6 * 33], s[7 * 33]);
        *(u32x4*)(WT + (size_t)(drow0 + n) * K + k0 + 8 * c) = o; }
    asm volatile("s_waitcnt lgkmcnt(0)" ::: "memory");
    __builtin_amdgcn_wave_barrier();
}
constexpr int IT_WIN = 16 * 224, IT_SQ = 16 * 32, IT_W1 = 32 * 16 * 64, IT_W2 = 32 * 16 * 32, IT_WS = 32;
constexpr int IT_TOTAL = IT_WIN + 3 * IT_SQ + IT_W1 + IT_W2 + IT_WS;
__device__ __forceinline__ void convert_item(const P& p, int it, float* scr, int lane) {
    unsigned char* ws = p.ws;
    if (it < IT_WIN) { const int kb = it / 224, nb = it % 224; transpose_item(p.w_in, 1024, INW, (bf16_t*)(ws + WS_WIN), kb * 64, nb * 32, nb * 32, scr, lane); return; } it -= IT_WIN;
    if (it < IT_SQ) { const int kb = it / 32, nb = it % 32; transpose_item(p.w_pa, 1024, 1024, (bf16_t*)(ws + WS_WPA), kb * 64, nb * 32, nb * 32, scr, lane); return; } it -= IT_SQ;
    if (it < IT_SQ) { const int kb = it / 32, nb = it % 32; transpose_item(p.w_pb, 1024, 1024, (bf16_t*)(ws + WS_WPB), kb * 64, nb * 32, nb * 32, scr, lane); return; } it -= IT_SQ;
    if (it < IT_SQ) { const int kb = it / 32, nb = it % 32; transpose_item(p.w_out, 1024, 1024, (bf16_t*)(ws + WS_WOUT), kb * 64, nb * 32, nb * 32, scr, lane); return; } it -= IT_SQ;
    if (it < IT_W1) { const int e = it / 1024, r = it % 1024, kb = r / 64, nb = r % 64, n0 = nb * 32;
        const int half = n0 >> 10, nn = n0 & 1023, drow0 = (nn >> 7) * 256 + half * 128 + (nn & 127);
        transpose_item(p.exp_w1 + (size_t)e * 1024 * 2048, 1024, 2048, (bf16_t*)(ws + WS_W1) + (size_t)e * 2048 * 1024, kb * 64, n0, drow0, scr, lane); return; } it -= IT_W1;
    if (it < IT_W2) { const int e = it / 512, r = it % 512, kb = r / 32, nb = r % 32;
        transpose_item(p.exp_w2 + (size_t)e * 1024 * 1024, 1024, 1024, (bf16_t*)(ws + WS_W2) + (size_t)e * 1024 * 1024, kb * 64, nb * 32, nb * 32, scr, lane); return; } it -= IT_W2;
    { bf16_t* o = (bf16_t*)(ws + WS_WSB); const float* s = p.gmlp_ws + it * 4096;
      for (int i = lane; i < 4096; i += 64) o[it * 4096 + i] = (bf16_t)f2bf(s[i]); }
}
__device__ __forceinline__ void phase_prologue_a(const P& p, int bid, int nblk, unsigned char* lds) {
    const int tid = tid_opaque(), wave = tid >> 6, lane = tid & 63;
    for (int item = bid; item < 192; item += nblk) mod_item(p, item, (float*)lds);
    if (bid == nblk - 1) {
        for (int i = tid; i < 1024; i += 512) { const int pos = i >> 4, fi = i & 15;
            const float inv = __builtin_amdgcn_exp2f(-(float)fi * (13.287712379549449f / 16.0f));
            const float ang = (float)pos * inv; const float rev = ang * 0.15915494309189535f;
            float* t = (float*)(p.ws + WS_ROPE); t[2 * i] = __builtin_amdgcn_cosf(rev); t[2 * i + 1] = __builtin_amdgcn_sinf(rev); }
    }
    __syncthreads();
    float* scr = (float*)lds + wave * (64 * 33 + 32);
    const int gw = bid * 8 + wave, ngw = nblk * 8;
    for (int it = gw; it < IT_TOTAL; it += ngw) convert_item(p, it, scr, lane);
}
__device__ __forceinline__ void ln_mod_row(const float* xrow, const float* g, const float* b, const float* sh, const float* sc, bf16_t* orow, float* stat, int lane) {
    const f32x4* xr = (const f32x4*)xrow + lane;
    f32x4 v[4]; float s = 0.f;
#pragma unroll
    for (int j = 0; j < 4; ++j) { v[j] = xr[64 * j]; s += (v[j].x + v[j].y) + (v[j].z + v[j].w); }
    const float mean = wave_sum(s) * (1.f / DM); float s2 = 0.f;
#pragma unroll
    for (int j = 0; j < 4; ++j) { v[j] = v[j] - mean; s2 += (v[j].x * v[j].x + v[j].y * v[j].y) + (v[j].z * v[j].z + v[j].w * v[j].w); }
    const float rstd = 1.f / sqrtf(wave_sum(s2) * (1.f / DM) + LN_EPS);
    if (stat && lane == 0) { stat[0] = mean; stat[1] = rstd; }
    u32x2* o8 = (u32x2*)orow + lane;
#pragma unroll
    for (int j = 0; j < 4; ++j) { const int col = 4 * lane + 256 * j;
        const f32x4 gg = *(const f32x4*)(g + col), bb = *(const f32x4*)(b + col), shv = *(const f32x4*)(sh + col), scv = *(const f32x4*)(sc + col);
        f32x4 y = (v[j] * rstd) * gg + bb; y = y * (1.0f + scv) + shv;
        u32x2 w; w.x = pk2(y.x, y.y); w.y = pk2(y.z, y.w); o8[64 * j] = w; }
}
__device__ __forceinline__ void phase_prologue_b(const P& p, int bid, int nblk) {
    const int tid = tid_opaque(), wave = tid >> 6, lane = tid & 63;
    const int gw = bid * 8 + wave, ngw = nblk * 8;
    const float* mod = (const float*)(p.ws + WS_MOD);
    for (int row = gw; row < NTOK + NCTX; row += ngw) {
        if (row < NTOK) { const int b = row >> 12;
            ln_mod_row(p.x + (size_t)row * DM, p.ln_x_g, p.ln_x_b, mod + b * 6144, mod + b * 6144 + 1024, (bf16_t*)(p.ws + WS_U) + (size_t)row * DM, (float*)(p.ws + WS_ROWSTAT) + 2 * row, lane);
        } else { const int r = row - NTOK;
            ln_mod_row(p.ctx + (size_t)r * DM, p.ln_ctx_g, p.ln_ctx_b, mod + 8 * 6144, mod + 8 * 6144 + 1024, (bf16_t*)(p.ws + WS_UC) + (size_t)r * DM, nullptr, lane); }
    }
}

template <class ARow, class BRow, class Epi>
__device__ __forceinline__ void sgemm_wave_tile(int r0, int n0, int K, const ARow& arow, const BRow& brow, const Epi& epi, int lane) {
    const int fr = lane & 15, fq = lane >> 4;
    f32x4 acc[2][2];
#pragma unroll
    for (int a = 0; a < 2; ++a)
#pragma unroll
        for (int b = 0; b < 2; ++b) acc[a][b] = (f32x4){0.f, 0.f, 0.f, 0.f};
    const bf16_t* ap[2]; const bf16_t* bp[2];
#pragma unroll
    for (int a = 0; a < 2; ++a) { ap[a] = arow(r0 + 16 * a + fr) + 8 * fq; bp[a] = brow(n0 + 16 * a + fr) + 8 * fq; }
    for (int k0 = 0; k0 < K; k0 += 32) {
        bf16x8 af[2], bfr[2];
#pragma unroll
        for (int a = 0; a < 2; ++a) { af[a] = *(const bf16x8*)(ap[a] + k0); bfr[a] = *(const bf16x8*)(bp[a] + k0); }
#pragma unroll
        for (int a = 0; a < 2; ++a)
#pragma unroll
            for (int b = 0; b < 2; ++b) acc[a][b] = __builtin_amdgcn_mfma_f32_16x16x32_bf16(af[a], bfr[b], acc[a][b], 0, 0, 0);
    }
#pragma unroll
    for (int a = 0; a < 2; ++a)
#pragma unroll
        for (int b = 0; b < 2; ++b)
#pragma unroll
            for (int i = 0; i < 4; ++i) epi(r0 + 16 * a + 4 * fq + i, n0 + 16 * b + fr, acc[a][b][i]);
}

struct ARowDense { const bf16_t* A; int lda; __device__ __forceinline__ const bf16_t* operator()(int r) const { return A + (size_t)r * lda; } };
struct EpiProj {
    const float* b_in; bf16_t *ZU, *ZVT, *Q, *K, *VT, *G;
    __device__ __forceinline__ void operator()(int r, int n, float v) const {
        v += b_in[n];
        if (n < 1024) ZU[(size_t)r * 1024 + n] = (bf16_t)f2bf(gelu_exact(v));
        else if (n < 2048) ZVT[(size_t)(n - 1024) * NTOK + r] = (bf16_t)f2bf(gelu_exact(v));
        else if (n < 3072) Q[(size_t)r * 1024 + (n - 2048)] = (bf16_t)f2bf(v);
        else if (n < 4096) K[(size_t)r * 1024 + (n - 3072)] = (bf16_t)f2bf(v);
        else if (n < 5120) VT[(size_t)(n - 4096) * NTOK + r] = (bf16_t)f2bf(v);
        else G[(size_t)r * 2048 + (n - 5120)] = (bf16_t)f2bf(sigmoidf_(v));
    }
};
__device__ __forceinline__ void phase_proj_s(const P& p, int bid, int nblk) {
    const int tid_ = tid_opaque(); const int wave = tid_ >> 6, lane = tid_ & 63; unsigned char* ws = p.ws;
    ARowDense ar{(const bf16_t*)(ws + WS_U), 1024}, br{(const bf16_t*)(ws + WS_WIN), 1024};
    EpiProj e{p.b_in, (bf16_t*)(ws + WS_ZU), (bf16_t*)(ws + WS_ZVT), (bf16_t*)(ws + WS_Q), (bf16_t*)(ws + WS_K), (bf16_t*)(ws + WS_VT), (bf16_t*)(ws + WS_G)};
    const int ntn = INW / 32, ntiles = (NTOK / 32) * ntn;
    for (int t = bid * 8 + wave; t < ntiles; t += nblk * 8) sgemm_wave_tile((t / ntn) * 32, (t % ntn) * 32, 1024, ar, br, e, lane);
}
struct EpiCtxKV {
    const float* b_in; bf16_t *KC, *VCT;
    __device__ __forceinline__ void operator()(int r, int n, float v) const {
        v += b_in[3072 + n];
        if (n < 1024) KC[(size_t)r * 1024 + n] = (bf16_t)f2bf(v); else VCT[(size_t)(n - 1024) * NCTX + r] = (bf16_t)f2bf(v);
    }
};
__device__ __forceinline__ void phase_ctxkv_s(const P& p, int bid, int nblk) {
    const int tid_ = tid_opaque(); const int wave = tid_ >> 6, lane = tid_ & 63; unsigned char* ws = p.ws;
    ARowDense ar{(const bf16_t*)(ws + WS_UC), 1024}, br{(const bf16_t*)(ws + WS_WIN) + (size_t)3072 * 1024, 1024};
    EpiCtxKV e{p.b_in, (bf16_t*)(ws + WS_KC), (bf16_t*)(ws + WS_VCT)};
    const int ntn = 2048 / 32, ntiles = (NCTX / 32) * ntn;
    for (int t = bid * 8 + wave; t < ntiles; t += nblk * 8) sgemm_wave_tile((t / ntn) * 32, (t % ntn) * 32, 1024, ar, br, e, lane);
}
__device__ __forceinline__ void phase_rope_s(const P& p, int bid, int nblk) {
    bf16_t* K = (bf16_t*)(p.ws + WS_K); const float* tab = (const float*)(p.ws + WS_ROPE);
    const size_t total = (size_t)NTOK * NHEAD * 32;
    const int tid_ = tid_opaque();
    for (size_t i = (size_t)bid * 512 + tid_; i < total; i += (size_t)nblk * 512) {
        const int pi = (int)(i & 31), h = (int)((i >> 5) & 15), t = (int)(i >> 9);
        const int pos = t & 4095, axis = pi >> 4, fi = pi & 15, ps = axis ? (pos & 63) : (pos >> 6);
        const float cs = tab[2 * (ps * 16 + fi)], sn = tab[2 * (ps * 16 + fi) + 1];
        bf16_t* base = K + (size_t)t * 1024 + h * 64 + axis * 32 + fi;
        const float x1 = bf2f(base[0]), x2 = bf2f(base[16]);
        base[0] = (bf16_t)f2bf(x1 * cs - x2 * sn); base[16] = (bf16_t)f2bf(x2 * cs + x1 * sn);
    }
}
__device__ __forceinline__ void phase_zstat_s(const P& p, int bid, int nblk) {
    const bf16_t* ZVT = (const bf16_t*)(p.ws + WS_ZVT); float* zs = (float*)(p.ws + WS_ZSTAT);
    const int tid_ = tid_opaque();
    for (int t = bid * 512 + tid_; t < NTOK; t += nblk * 512) {
        float s = 0.f, s2 = 0.f;
        for (int c = 0; c < 1024; ++c) { const float v = bf2f(ZVT[(size_t)c * NTOK + t]); s += v; s2 += v * v; }
        const float mean = s * (1.f / 1024.f); const float var = fmaxf(s2 * (1.f / 1024.f) - mean * mean, 0.f);
        zs[2 * t] = mean; zs[2 * t + 1] = 1.f / sqrtf(var + LN_EPS);
    }
}
__device__ __forceinline__ void phase_gmlp_s(const P& p, int bid, int nblk, unsigned char* lds) {
    float* zvn = (float*)lds;
    float* wsm = zvn + 128 * 128;
    const bf16_t* ZVT = (const bf16_t*)(p.ws + WS_ZVT); const bf16_t* ZU = (const bf16_t*)(p.ws + WS_ZU); const float* zs = (const float*)(p.ws + WS_ZSTAT);
    bf16_t* YA = (bf16_t*)(p.ws + WS_U);
    const int tid = tid_opaque();
    for (int item = bid; item < (NTOK / 128) * 8; item += nblk) {
        const int chunk = item >> 3, g = item & 7, tok0 = chunk * 128;
        __syncthreads();
        for (int i = tid; i < 128 * 128; i += 512) { const int c = i >> 7, q = i & 127; const int ch = g * 128 + c;
            const float v = bf2f(ZVT[(size_t)ch * NTOK + tok0 + q]);
            zvn[q * 128 + c] = (v - zs[2 * (tok0 + q)]) * zs[2 * (tok0 + q) + 1] * p.gmlp_ln_g[ch] + p.gmlp_ln_b[ch];
            wsm[i] = p.gmlp_ws[g * 16384 + i]; }
        __syncthreads();
        const int c = tid & 127, pq = tid >> 7;
        for (int pp = 0; pp < 32; ++pp) { const int pr = pq * 32 + pp; float acc = 0.f;
            for (int q = 0; q < 128; ++q) acc += wsm[pr * 128 + q] * zvn[q * 128 + c];
            acc += p.gmlp_bs[g * 128 + pr];
            const size_t o = (size_t)(tok0 + pr) * 1024 + g * 128 + c;
            YA[o] = (bf16_t)f2bf(bf2f(ZU[o]) * acc); }
    }
}
__device__ __forceinline__ bf16x8 pack8(const float (&v)[8]) { u32x4 w; w.x = pk2(v[0], v[1]); w.y = pk2(v[2], v[3]); w.z = pk2(v[4], v[5]); w.w = pk2(v[6], v[7]); return __builtin_bit_cast(bf16x8, w); }
__device__ __forceinline__ void phase_gmlp_fast(const P& p, int bid, int nblk, unsigned char* lds) {
    const int tid = tid_opaque(), g = tid >> 6, lane = tid & 63, fr = lane & 15, fq = lane >> 4;
    float* part = (float*)lds;
    float* stat = part + 8 * 128 * 2;
    const bf16_t* ZVT = (const bf16_t*)(p.ws + WS_ZVT); const bf16_t* ZU = (const bf16_t*)(p.ws + WS_ZU); const bf16_t* WSB = (const bf16_t*)(p.ws + WS_WSB);
    bf16_t* YA = (bf16_t*)(p.ws + WS_U);
    for (int chunk = bid; chunk < NTOK / 128; chunk += nblk) {
        const int tok0 = chunk * 128;
        __syncthreads();
        { float s1[8], s2[8];
#pragma unroll
          for (int jj = 0; jj < 8; ++jj) { s1[jj] = 0.f; s2[jj] = 0.f; }
          const bf16_t* zp = ZVT + (((size_t)(tok0 >> 3) + fr) * 1024 + 128 * g + fq) * 8;
#pragma unroll 8
          for (int it = 0; it < 32; ++it) { const bf16x8 v = *(const bf16x8*)(zp + (4 * it) * 8);
#pragma unroll
              for (int jj = 0; jj < 8; ++jj) { const float f = bf2f((unsigned)(unsigned short)v[jj]); s1[jj] += f; s2[jj] += f * f; } }
#pragma unroll
          for (int jj = 0; jj < 8; ++jj) { s1[jj] += __shfl_xor(s1[jj], 16); s1[jj] += __shfl_xor(s1[jj], 32); s2[jj] += __shfl_xor(s2[jj], 16); s2[jj] += __shfl_xor(s2[jj], 32); }
          if (fq == 0) {
#pragma unroll
              for (int jj = 0; jj < 8; ++jj) { part[(g * 128 + 8 * fr + jj) * 2] = s1[jj]; part[(g * 128 + 8 * fr + jj) * 2 + 1] = s2[jj]; } } }
        __syncthreads();
        if (tid < 128) { float a = 0.f, b = 0.f;
#pragma unroll
            for (int w = 0; w < 8; ++w) { a += part[(w * 128 + tid) * 2]; b += part[(w * 128 + tid) * 2 + 1]; }
            const float mean = a * (1.f / 1024.f), var = fmaxf(b * (1.f / 1024.f) - mean * mean, 0.f);
            stat[2 * tid] = mean; stat[2 * tid + 1] = 1.f / sqrtf(var + LN_EPS); }
        __syncthreads();
#pragma unroll 1
        for (int ph = 0; ph < 2; ++ph) {
            bf16x8 wf[4][4]; float t1[4], t2[4], bsv[4];
#pragma unroll
            for (int pt = 0; pt < 4; ++pt) { const int pp = 64 * ph + 16 * pt + fr; float t1a = 0.f, t2a = 0.f;
                const float* stat_o = stat + 16 * fq; asm volatile("" : "+v"(stat_o));
#pragma unroll
                for (int ks = 0; ks < 4; ++ks) { const bf16x8 w = *(const bf16x8*)(WSB + ((size_t)g * 128 + pp) * 128 + 32 * ks + 8 * fq);
                    float wv[8];
#pragma unroll
                    for (int jj = 0; jj < 8; ++jj) { const float w0 = bf2f((unsigned)(unsigned short)w[jj]); t2a += w0; wv[jj] = w0 * stat_o[2 * (32 * ks + jj) + 1]; }
                    const bf16x8 wp = pack8(wv); wf[pt][ks] = wp;
#pragma unroll
                    for (int jj = 0; jj < 8; ++jj) t1a += bf2f((unsigned)(unsigned short)wp[jj]) * stat_o[2 * (32 * ks + jj)]; }
                t1a += __shfl_xor(t1a, 16); t1a += __shfl_xor(t1a, 32); t2a += __shfl_xor(t2a, 16); t2a += __shfl_xor(t2a, 32);
                t1[pt] = t1a; t2[pt] = t2a; bsv[pt] = p.gmlp_bs[g * 128 + pp]; }
#pragma unroll 1
            for (int ct = 0; ct < 8; ++ct) {
                bf16x8 af[4];
                const bf16_t* zp = ZVT + (((size_t)(tok0 >> 3) + fq) * 1024 + 128 * g + 16 * ct + fr) * 8;
#pragma unroll
                for (int ks = 0; ks < 4; ++ks) af[ks] = *(const bf16x8*)(zp + (size_t)ks * 4 * 1024 * 8);
                f32x4 acc[4];
#pragma unroll
                for (int pt = 0; pt < 4; ++pt) { acc[pt] = (f32x4){0.f, 0.f, 0.f, 0.f};
#pragma unroll
                    for (int ks = 0; ks < 4; ++ks) acc[pt] = __builtin_amdgcn_mfma_f32_16x16x32_bf16(af[ks], wf[pt][ks], acc[pt], 0, 0, 0); }
                const int c = 128 * g + 16 * ct + 4 * fq;
                const f32x4 gc = *(const f32x4*)(p.gmlp_ln_g + c), bc = *(const f32x4*)(p.gmlp_ln_b + c);
#pragma unroll
                for (int pt = 0; pt < 4; ++pt) { const size_t off = (size_t)(tok0 + 64 * ph + 16 * pt + fr) * 1024 + c;
                    const u32x2 zu = *(const u32x2*)(ZU + off);
                    const f32x4 s = gc * (acc[pt] - t1[pt]) + bc * t2[pt] + bsv[pt];
                    u32x2 w; w.x = pk2(bflo(zu.x) * s[0], bfhi(zu.x) * s[1]); w.y = pk2(bflo(zu.y) * s[2], bfhi(zu.y) * s[3]);
                    *(u32x2*)(YA + off) = w; }
            }
        }
    }
}
constexpr int AT_LDS_RPB = 0, AT_LDS_KC = 4096, AT_LDS_VC = AT_LDS_KC + 32768, AT_LDS_END = AT_LDS_VC + 32768;
typedef __attribute__((address_space(3))) const unsigned char* lds_cp;
__device__ __forceinline__ void attn_stage(const P& p, unsigned char* lds, int b, int h, int tid) {
    float* tbl = (float*)(lds + AT_LDS_RPB);
    for (int idx = tid; idx < 15 * 64; idx += 512) { const int dr = idx >> 6, cc = idx & 63; tbl[idx] = (cc >= 16 && cc < 47) ? p.na_rpb[(h * 15 + dr) * 31 + cc - 16] : 0.f; }
    const size_t bh = (size_t)b * 16 + h;
    const u32x4* kc = (const u32x4*)((const bf16_t*)(p.ws + WS_KC) + bh * 256 * 64); const u32x4* vc = (const u32x4*)((const bf16_t*)(p.ws + WS_VCT) + bh * 32 * 512);
#pragma unroll
    for (int i = 0; i < 4; ++i) { const int q = tid + 512 * i, key = q >> 3, c = q & 7; const int fk = ((key >> 1) & 1) | (((key >> 3) & 1) << 1) | (((key >> 4) & 1) << 2);
        *(u32x4*)(lds + AT_LDS_KC + key * 128 + ((c ^ fk) << 4)) = kc[q]; *(u32x4*)(lds + AT_LDS_VC + q * 16) = vc[q]; }
}
__device__ __forceinline__ void attn_wave_unit(const P& p, unsigned char* lds, int b, int r, int j, int h, int lane) {
    const int fr = lane & 15, fq = lane >> 4;
    const bf16_t* Q = (const bf16_t*)(p.ws + WS_Q); const bf16_t* K = (const bf16_t*)(p.ws + WS_K); const bf16_t* VT = (const bf16_t*)(p.ws + WS_VT);
    const float* tab = (const float*)(p.ws + WS_ROPE); const float* tbl = (const float*)(lds + AT_LDS_RPB);
    bf16_t* YB = (bf16_t*)(p.ws + WS_YB);
    const int qc = 16 * j + fr; const size_t tq = (size_t)b * SEQ + r * 64 + qc; const size_t bh = (size_t)b * 16 + h;
    const int r0 = min(max(r - 4, 0), 56), c0 = min(max(qc - 8, 0), 48), cs = min(max(16 * j - 8, 0), 32);
    const int sp0 = 8 * (fr >> 2) + (fr & 3);
    const bf16_t* klat = K + (bh * 4096 + r0 * 64 + cs + sp0) * 64 + 8 * fq;
    const bf16_t* vlat = VT + ((bh * 512 + ((r0 * 64 + cs) >> 3) + fq) * 64 + fr) * 8;
    const int fk = ((fr >> 1) & 1) | (((fr >> 2) & 1) << 1) | (((fr >> 3) & 1) << 2);
    const lds_cp kcl = (lds_cp)lds + AT_LDS_KC + sp0 * 128;
    const int kco0 = (fq ^ fk) << 4, kco1 = ((fq + 4) ^ fk) << 4;
    const lds_cp vcl = (lds_cp)lds + AT_LDS_VC + (fq * 64 + fr) * 16;
    bf16x8 kf[2][2][2];
#define LOADK(buf, st_) do { _Pragma("unroll") for (int t = 0; t < 2; ++t) { \
        const bf16_t* kp_ = klat + (size_t)(st_) * 64 * 64 + t * 4 * 64; kf[buf][t][0] = *(const bf16x8*)kp_; kf[buf][t][1] = *(const bf16x8*)(kp_ + 32); } } while (0)
#define LOADKC(buf, st_) do { _Pragma("unroll") for (int t = 0; t < 2; ++t) { \
        const lds_cp kp_ = kcl + (32 * (st_) + 4 * t) * 128; kf[buf][t][0] = *(const __attribute__((address_space(3))) bf16x8*)(kp_ + kco0); kf[buf][t][1] = *(const __attribute__((address_space(3))) bf16x8*)(kp_ + kco1); } } while (0)
    LOADK(0, 0); LOADK(1, 1);
    bf16x8 qpl[2], qrt[2];
#pragma unroll
    for (int s = 0; s < 2; ++s) {
        const bf16_t* qb = Q + (bh * 4096 + r * 64 + qc) * 64 + 32 * s;
        const bf16x8 me = *(const bf16x8*)(qb + 8 * fq), ot = *(const bf16x8*)(qb + 8 * (fq ^ 2));
        qpl[s] = me;
        const int pos = s ? qc : r; const float* tb = tab + (pos * 16 + 8 * (fq & 1)) * 2;
        float rot[8];
#pragma unroll
        for (int jj = 0; jj < 8; ++jj) { const float cv = tb[2 * jj], sv = tb[2 * jj + 1];
            const float xv = bf2f((unsigned)(unsigned short)me[jj]), ov = bf2f((unsigned)(unsigned short)ot[jj]);
            rot[jj] = (fq < 2) ? (xv * cv - ov * sv) : (xv * cv + ov * sv); }
        qrt[s] = pack8(rot);
    }
    float sc[8][8];
    const float* brow0 = tbl + (r0 - r + 7) * 64 + (cs + 8 * fq - qc + 31);
#pragma unroll
    for (int st = 0; st < 8; ++st) {
        const float* brow = brow0 + st * 64; asm volatile("" : "+v"(brow));
#pragma unroll
        for (int t = 0; t < 2; ++t) {
            f32x4 d = __builtin_amdgcn_mfma_f32_16x16x32_bf16(kf[st & 1][t][0], qrt[0], (f32x4){0.f, 0.f, 0.f, 0.f}, 0, 0, 0);
            d = __builtin_amdgcn_mfma_f32_16x16x32_bf16(kf[st & 1][t][1], qrt[1], d, 0, 0, 0);
#pragma unroll
            for (int i = 0; i < 4; ++i) { const int kc = cs + 8 * fq + 4 * t + i; const bool valid = (kc >= c0) && (kc < c0 + 16);
                const float bias = brow[4 * t + i];
                sc[st][4 * t + i] = valid ? (d[i] * 0.125f + bias) : -INFINITY; } }
        if (st + 2 < 8) LOADK(st & 1, st + 2);
    }
    bf16x8 vf[2][4];
#define LOADV(buf, st_) do { _Pragma("unroll") for (int dt = 0; dt < 4; ++dt) vf[buf][dt] = *(const bf16x8*)(vlat + dt * 128 + (st_) * 8 * 512); } while (0)
#define LOADVC(buf, st_) do { _Pragma("unroll") for (int dt = 0; dt < 4; ++dt) vf[buf][dt] = *(const __attribute__((address_space(3))) bf16x8*)(vcl + (st_) * 4096 + dt * 256); } while (0)
    LOADV(0, 0); LOADV(1, 1);
    float m = -INFINITY;
#pragma unroll
    for (int st = 0; st < 8; ++st)
#pragma unroll
        for (int e = 0; e < 8; ++e) m = fmaxf(m, sc[st][e]);
    m = fmaxf(m, __shfl_xor(m, 16)); m = fmaxf(m, __shfl_xor(m, 32));
    float l = 0.f; f32x4 o[4];
#pragma unroll
    for (int dt = 0; dt < 4; ++dt) o[dt] = (f32x4){0.f, 0.f, 0.f, 0.f};
    const float ml2 = m * 1.4426950408889634f;
#pragma unroll
    for (int st = 0; st < 8; ++st) {
        float pv[8];
#pragma unroll
        for (int e = 0; e < 8; ++e) { pv[e] = __builtin_amdgcn_exp2f(sc[st][e] * 1.4426950408889634f - ml2); l += pv[e]; }
        const bf16x8 pf = pack8(pv);
#pragma unroll
        for (int dt = 0; dt < 4; ++dt) o[dt] = __builtin_amdgcn_mfma_f32_16x16x32_bf16(vf[st & 1][dt], pf, o[dt], 0, 0, 0);
        if (st + 2 < 8) LOADV(st & 1, st + 2);
    }
    LOADKC(0, 0);
#pragma unroll
    for (int st = 0; st < 8; ++st) {
        if (st + 1 < 8) LOADKC((st + 1) & 1, st + 1);
#pragma unroll
        for (int t = 0; t < 2; ++t) {
            f32x4 d = __builtin_amdgcn_mfma_f32_16x16x32_bf16(kf[st & 1][t][0], qpl[0], (f32x4){0.f, 0.f, 0.f, 0.f}, 0, 0, 0);
            d = __builtin_amdgcn_mfma_f32_16x16x32_bf16(kf[st & 1][t][1], qpl[1], d, 0, 0, 0);
#pragma unroll
            for (int i = 0; i < 4; ++i) sc[st][4 * t + i] = d[i] * 0.125f; }
    }
    float m2 = -INFINITY;
#pragma unroll
    for (int st = 0; st < 8; ++st)
#pragma unroll
        for (int e = 0; e < 8; ++e) m2 = fmaxf(m2, sc[st][e]);
    m2 = fmaxf(m2, __shfl_xor(m2, 16)); m2 = fmaxf(m2, __shfl_xor(m2, 32));
    const float mn = fmaxf(m, m2), al = __builtin_amdgcn_exp2f((m - mn) * 1.4426950408889634f), mnl2 = mn * 1.4426950408889634f;
    l *= al;
#pragma unroll
    for (int dt = 0; dt < 4; ++dt) o[dt] = o[dt] * al;
    LOADVC(0, 0);
#pragma unroll
    for (int st = 0; st < 8; ++st) {
        if (st + 1 < 8) LOADVC((st + 1) & 1, st + 1);
        float pv[8];
#pragma unroll
        for (int e = 0; e < 8; ++e) { pv[e] = __builtin_amdgcn_exp2f(sc[st][e] * 1.4426950408889634f - mnl2); l += pv[e]; }
        const bf16x8 pf = pack8(pv);
#pragma unroll
        for (int dt = 0; dt < 4; ++dt) o[dt] = __builtin_amdgcn_mfma_f32_16x16x32_bf16(vf[st & 1][dt], pf, o[dt], 0, 0, 0);
    }
#undef LOADK
#undef LOADKC
#undef LOADV
#undef LOADVC
    l += __shfl_xor(l, 16); l += __shfl_xor(l, 32);
    const float inv = 1.0f / l;
#pragma unroll
    for (int dt = 0; dt < 4; ++dt) { u32x2 w; w.x = pk2(o[dt][0] * inv, o[dt][1] * inv); w.y = pk2(o[dt][2] * inv, o[dt][3] * inv);
        *(u32x2*)(YB + tq * 1024 + h * 64 + 16 * dt + 4 * fq) = w; }
}
__device__ __forceinline__ void phase_attn_s(const P& p, int bid, int nblk, unsigned char* lds) {
    const int tid_ = tid_opaque(); const int wave = tid_ >> 6, lane = tid_ & 63;
    for (int vb = bid; vb < 256; vb += nblk) { const int half = vb & 1, h = (vb >> 1) & 15, b = vb >> 5;
        __syncthreads();
        attn_stage(p, lds, b, h, tid_);
        __syncthreads();
#pragma unroll 1
        for (int it = 0; it < 16; ++it) { int lane_o = lane; asm volatile("" : "+v"(lane_o));
            attn_wave_unit(p, lds, b, 32 * half + 2 * it + (wave >> 2), wave & 3, h, lane_o); }
    }
}
struct EpiMergeA { const bf16_t* G; bf16_t* INNER;
    __device__ __forceinline__ void operator()(int r, int n, float v) const { INNER[(size_t)r * 1024 + n] = (bf16_t)f2bf(bf2f(G[(size_t)r * 2048 + n]) * v); } };
struct EpiMergeB { const bf16_t* G; bf16_t* INNER;
    __device__ __forceinline__ void operator()(int r, int n, float v) const { const size_t o = (size_t)r * 1024 + n; INNER[o] = (bf16_t)f2bf(bf2f(INNER[o]) + bf2f(G[(size_t)r * 2048 + 1024 + n]) * v); } };
template <int WHICH> __device__ __forceinline__ void phase_merge_s(const P& p, int bid, int nblk) {
    const int tid_ = tid_opaque(); const int wave = tid_ >> 6, lane = tid_ & 63; unsigned char* ws = p.ws;
    const int ntn = 1024 / 32, ntiles = (NTOK / 32) * ntn;
    if (WHICH == 0) { ARowDense ar{(const bf16_t*)(ws + WS_U), 1024}, br{(const bf16_t*)(ws + WS_WPA), 1024}; EpiMergeA e{(const bf16_t*)(ws + WS_G), (bf16_t*)(ws + WS_INNER)};
        for (int t = bid * 8 + wave; t < ntiles; t += nblk * 8) sgemm_wave_tile((t / ntn) * 32, (t % ntn) * 32, 1024, ar, br, e, lane);
    } else { ARowDense ar{(const bf16_t*)(ws + WS_YB), 1024}, br{(const bf16_t*)(ws + WS_WPB), 1024}; EpiMergeB e{(const bf16_t*)(ws + WS_G), (bf16_t*)(ws + WS_INNER)};
        for (int t = bid * 8 + wave; t < ntiles; t += nblk * 8) sgemm_wave_tile((t / ntn) * 32, (t % ntn) * 32, 1024, ar, br, e, lane); }
}
struct EpiMix { const float *x, *rowstat, *lng, *lnb, *mod, *b_out; float* out;
    __device__ __forceinline__ void operator()(int r, int n, float v) const {
        const int b = r >> 12; const float x0 = (x[(size_t)r * 1024 + n] - rowstat[2 * r]) * rowstat[2 * r + 1] * lng[n] + lnb[n];
        out[(size_t)r * 1024 + n] = ALPHA * x0 + mod[b * 6144 + 2048 + n] * (v + b_out[n]); } };
__device__ __forceinline__ void phase_mix_s(const P& p, int bid, int nblk) {
    const int tid_ = tid_opaque(); const int wave = tid_ >> 6, lane = tid_ & 63; unsigned char* ws = p.ws;
    const int ntn = 1024 / 32, ntiles = (NTOK / 32) * ntn;
    ARowDense ar{(const bf16_t*)(ws + WS_INNER), 1024}, br{(const bf16_t*)(ws + WS_WOUT), 1024};
    EpiMix e{p.x, (const float*)(ws + WS_ROWSTAT), p.ln_x_g, p.ln_x_b, (const float*)(ws + WS_MOD), p.b_out, p.out};
    for (int t = bid * 8 + wave; t < ntiles; t += nblk * 8) sgemm_wave_tile((t / ntn) * 32, (t % ntn) * 32, 1024, ar, br, e, lane);
}

constexpr int RT_LDS_W = 0, RT_LDS_CNT = 131072, RT_LDS_BASE = RT_LDS_CNT + 128, RT_LDS_REC = RT_LDS_BASE + 128, RT_MAXIT = 32, RT_LDS_END = RT_LDS_REC + 8 * RT_MAXIT * 8 * 4;
__device__ __forceinline__ int rw_off(int prow, int ch) { return prow * 128 + ((ch ^ ((prow >> 1) & 7)) << 4); }
__device__ __forceinline__ void phase_router(const P& p, int bid, int nblk, unsigned char* lds) {
    const int tid = tid_opaque(), wave = tid >> 6, lane = tid & 63;
    int* cnt = (int*)(lds + RT_LDS_CNT); int* base = (int*)(lds + RT_LDS_BASE); int* rec = (int*)(lds + RT_LDS_REC) + wave * RT_MAXIT * 8;
    for (int k = tid; k < 1024; k += 512) { const int l = (k & 255) >> 2, i = k & 3, j = k >> 8, prow = l + 64 * (4 * j + i);
        const f32x4* src = (const f32x4*)(p.router_w + (size_t)k * 32);
#pragma unroll
        for (int ch = 0; ch < 8; ++ch) *(f32x4*)(lds + RT_LDS_W + rw_off(prow, ch)) = src[ch]; }
    if (tid < 32) cnt[tid] = 0;
    __syncthreads();
    const float* mod = (const float*)(p.ws + WS_MOD);
    int* TOPE = (int*)(p.ws + WS_TOPE); float* TOPG = (float*)(p.ws + WS_TOPG); int* SLOT = (int*)(p.ws + WS_SLOT);
    bf16_t* U2 = (bf16_t*)(p.ws + WS_U);
    const int erev = 16 * ((lane >> 4) & 1) + (int)(__builtin_bitreverse32((unsigned)(lane & 15)) >> 28);
    unsigned wb[8];
#pragma unroll
    for (int ch = 0; ch < 8; ++ch) wb[ch] = RT_LDS_W + lane * 128 + ((ch ^ ((lane >> 1) & 7)) << 4);
    int it = 0;
    for (int row = bid * 8 + wave; row < NTOK; row += nblk * 8, ++it) {
        const int b = row >> 12;
        f32x4* xr = (f32x4*)(p.out + (size_t)row * DM) + lane;
        f32x4 v[4]; float s = 0.f;
#pragma unroll
        for (int j = 0; j < 4; ++j) { v[j] = xr[64 * j]; s += (v[j].x + v[j].y) + (v[j].z + v[j].w); }
        const float mean = wave_sum(s) * (1.f / DM); float s2 = 0.f;
#pragma unroll
        for (int j = 0; j < 4; ++j) { v[j] = v[j] - mean; s2 += (v[j].x * v[j].x + v[j].y * v[j].y) + (v[j].z * v[j].z + v[j].w * v[j].w); }
        const float rstd = 1.f / sqrtf(wave_sum(s2) * (1.f / DM) + LN_EPS);
        u32x2* o8 = (u32x2*)(U2 + (size_t)row * DM) + lane;
        int lane_o = lane; asm volatile("" : "+v"(lane_o));
        f32x4 u[4];
#pragma unroll
        for (int j = 0; j < 4; ++j) { const int col = 4 * lane_o + 256 * j;
            const f32x4 gg = *(const f32x4*)(p.ln1_g + col), bb = *(const f32x4*)(p.ln1_b + col);
            const f32x4 shv = *(const f32x4*)(mod + b * 6144 + 3072 + col), scv = *(const f32x4*)(mod + b * 6144 + 4096 + col);
            const f32x4 x1 = (v[j] * rstd) * gg + bb; xr[64 * j] = x1;
            u[j] = x1 * (1.0f + scv) + shv;
            u32x2 w; w.x = pk2(u[j].x, u[j].y); w.y = pk2(u[j].z, u[j].w); o8[64 * j] = w; }
        float lg2[2];
#pragma unroll
        for (int hf = 0; hf < 2; ++hf) {
            float a[16];
#pragma unroll
            for (int e = 0; e < 16; ++e) a[e] = 0.f;
#pragma unroll
            for (int j = 0; j < 4; ++j)
#pragma unroll
                for (int i = 0; i < 4; ++i) { const float uv = u[j][i];
#pragma unroll
                    for (int ch = 0; ch < 4; ++ch) { const f32x4 w4 = *(const f32x4*)(lds + wb[4 * hf + ch] + (4 * j + i) * 8192);
                        a[4 * ch + 0] += uv * w4.x; a[4 * ch + 1] += uv * w4.y; a[4 * ch + 2] += uv * w4.z; a[4 * ch + 3] += uv * w4.w; } }
#pragma unroll
            for (int st = 0; st < 4; ++st) { const int n = 8 >> st; const bool up = (lane >> st) & 1;
#pragma unroll
                for (int i = 0; i < n; ++i) { float lo = a[i], hi = a[n + i]; asm volatile("" : "+v"(lo), "+v"(hi));
                    const float keep = up ? hi : lo, send = up ? lo : hi; a[i] = keep + __shfl_xor(send, 1 << st); } }
            float r = a[0]; r += __shfl_xor(r, 16); r += __shfl_xor(r, 32); lg2[hf] = r;
        }
        float logit = ((lane >> 4) & 1) ? lg2[1] : lg2[0];
        logit += p.router_b[erev];
        float cur = logit;
#define TOP_STEP(TV, TE) float TV; int TE; { const float mx = wave_max(cur); int cand = (cur == mx) ? erev : 64; \
            cand = min(cand, __shfl_xor(cand, 1)); cand = min(cand, __shfl_xor(cand, 2)); cand = min(cand, __shfl_xor(cand, 4)); \
            cand = min(cand, __shfl_xor(cand, 8)); cand = min(cand, __shfl_xor(cand, 16)); cand = min(cand, __shfl_xor(cand, 32)); \
            TV = mx; TE = cand; if (erev == cand) cur = -INFINITY; }
        TOP_STEP(tv0, te0) TOP_STEP(tv1, te1) TOP_STEP(tv2, te2) TOP_STEP(tv3, te3)
#undef TOP_STEP
        const float gk0 = 1.0f, gk1 = __expf(tv1 - tv0), gk2 = __expf(tv2 - tv0), gk3 = __expf(tv3 - tv0);
        const float ginv = 1.f / (gk0 + gk1 + gk2 + gk3);
        if (lane < 4) { const int e = lane == 0 ? te0 : lane == 1 ? te1 : lane == 2 ? te2 : te3; const float g = lane == 0 ? gk0 : lane == 1 ? gk1 : lane == 2 ? gk2 : gk3;
            const int pos = atomicAdd(&cnt[e], 1);
            TOPE[row * 4 + lane] = e; TOPG[row * 4 + lane] = g * ginv;
            if (it < RT_MAXIT) { rec[it * 8 + lane * 2] = e; rec[it * 8 + lane * 2 + 1] = pos; } }
    }
    __syncthreads();
    if (tid < 32) base[tid] = atomicAdd((int*)(p.ws + WS_CTL) + tid, cnt[tid]);
    __syncthreads();
    it = 0;
    int* PERM2 = (int*)(p.ws + WS_PERM2);
    for (int row = bid * 8 + wave; row < NTOK; row += nblk * 8, ++it)
        if (lane < 4 && it < RT_MAXIT) { const int e = rec[it * 8 + lane * 2], pos = base[e] + rec[it * 8 + lane * 2 + 1]; SLOT[row * 4 + lane] = pos; PERM2[(size_t)e * NTOK + pos] = row; }
}
constexpr int MT_LDS = 131072 + 1024;
__device__ __forceinline__ void moe_tables(const P& p, unsigned char* lds) {
    const int tid = tid_opaque(); int* cn = (int*)(lds + MT_LDS); int* eb = cn + 32; int* tb = eb + 33;
    __syncthreads();
    if (tid < 32) cn[tid] = __hip_atomic_load((int*)(p.ws + WS_CTL) + tid, __ATOMIC_RELAXED, __HIP_MEMORY_SCOPE_AGENT);
    __syncthreads();
    if (tid == 0) { int s = 0, t = 0; for (int e = 0; e < 32; ++e) { eb[e] = s; tb[e] = t; s += cn[e]; t += (cn[e] + 255) >> 8; } eb[32] = s; tb[32] = t; }
    __syncthreads();
}
struct FinIdx { int e[4]; int pos[4]; float g[4]; };
struct FinData { u32x4 ys[2][4]; f32x4 x[2][2]; };
__device__ __forceinline__ void fin_load_idx(const P& p, int row, FinIdx& r) {
    const u32x4 ev = *(const u32x4*)((const int*)(p.ws + WS_TOPE) + row * 4), pv = *(const u32x4*)((const int*)(p.ws + WS_SLOT) + row * 4); const f32x4 gv = *(const f32x4*)((const float*)(p.ws + WS_TOPG) + row * 4);
#pragma unroll
    for (int k = 0; k < 4; ++k) { r.e[k] = (int)ev[k]; r.pos[k] = (int)pv[k]; r.g[k] = gv[k]; }
}
__device__ __forceinline__ void fin_load_data(const P& p, const int* eb, int row, const FinIdx& ix, FinData& d, int lane) {
    const bf16_t* YS = (const bf16_t*)(p.ws + WS_YS);
#pragma unroll
    for (int k = 0; k < 4; ++k) { const size_t slot = (size_t)(eb[ix.e[k]] + ix.pos[k]);
#pragma unroll
        for (int j = 0; j < 2; ++j) d.ys[j][k] = *(const u32x4*)(YS + slot * 1024 + 8 * lane + 512 * j); }
#pragma unroll
    for (int j = 0; j < 2; ++j) { const f32x4* xr = (const f32x4*)(p.out + (size_t)row * DM + 8 * lane + 512 * j); d.x[j][0] = xr[0]; d.x[j][1] = xr[1]; }
}
__device__ __forceinline__ void phase_final(const P& p, int bid, int nblk, unsigned char* lds) {
    moe_tables(p, lds); const int* eb = (const int*)(lds + MT_LDS) + 32;
    const int tid = tid_opaque(), wave = tid >> 6, lane = tid & 63;
    const float* mod = (const float*)(p.ws + WS_MOD);
    const int stride = nblk * 8;
    int row = bid * 8 + wave; if (row >= NTOK) return;
    FinIdx ic, in; FinData dc, dn;
    fin_load_idx(p, row, ic); fin_load_data(p, eb, row, ic, dc, lane);
    int row_n = row + stride; if (row_n < NTOK) fin_load_idx(p, row_n, in);
#pragma unroll 1
    for (;;) {
        if (row_n < NTOK) fin_load_data(p, eb, row_n, in, dn, lane);
        const int row_nn = row_n + stride; FinIdx inn; if (row_nn < NTOK) fin_load_idx(p, row_nn, inn);
        const int b = row >> 12;
        f32x4 v[2][2]; float s = 0.f;
#pragma unroll
        for (int j = 0; j < 2; ++j) { const int col = 8 * lane + 512 * j; f32x4 f0 = (f32x4){0.f, 0.f, 0.f, 0.f}, f1 = f0;
#pragma unroll
            for (int k = 0; k < 4; ++k) { const u32x4 w = dc.ys[j][k]; const float g = ic.g[k];
                f0.x += g * bflo(w.x); f0.y += g * bfhi(w.x); f0.z += g * bflo(w.y); f0.w += g * bfhi(w.y); f1.x += g * bflo(w.z); f1.y += g * bfhi(w.z); f1.z += g * bflo(w.w); f1.w += g * bfhi(w.w); }
            const f32x4 g20 = *(const f32x4*)(mod + b * 6144 + 5120 + col), g21 = *(const f32x4*)(mod + b * 6144 + 5120 + col + 4);
            v[j][0] = dc.x[j][0] * ALPHA + g20 * f0; v[j][1] = dc.x[j][1] * ALPHA + g21 * f1;
            s += ((v[j][0].x + v[j][0].y) + (v[j][0].z + v[j][0].w)) + ((v[j][1].x + v[j][1].y) + (v[j][1].z + v[j][1].w)); }
        const float mean = wave_sum(s) * (1.f / DM); float s2 = 0.f;
#pragma unroll
        for (int j = 0; j < 2; ++j)
#pragma unroll
            for (int q = 0; q < 2; ++q) { v[j][q] = v[j][q] - mean; s2 += (v[j][q].x * v[j][q].x + v[j][q].y * v[j][q].y) + (v[j][q].z * v[j][q].z + v[j][q].w * v[j][q].w); }
        const float rstd = 1.f / sqrtf(wave_sum(s2) * (1.f / DM) + LN_EPS);
#pragma unroll
        for (int j = 0; j < 2; ++j) { const int col = 8 * lane + 512 * j; f32x4* xo = (f32x4*)(p.out + (size_t)row * DM + col);
#pragma unroll
            for (int q = 0; q < 2; ++q) { const f32x4 gg = *(const f32x4*)(p.ln2_g + col + 4 * q), bb = *(const f32x4*)(p.ln2_b + col + 4 * q); xo[q] = (v[j][q] * rstd) * gg + bb; } }
        if (row_n >= NTOK) break;
        row = row_n; row_n = row_nn; ic = in; in = inn; dc = dn;
    }
}

namespace pg {
#define PG_LAS __attribute__((address_space(3)))
typedef float f32x2 __attribute__((ext_vector_type(2)));
constexpr int BM = 256, BK = 64, HALF = 128, HTB = HALF * BK * 2, STAGE_BYTES = 8 * HTB, KD = 1024, NT = KD / BK;
constexpr unsigned KSTEP = BK * 2, HSTEPB = HALF * KD * 2;
__host__ __device__ __forceinline__ int lds_byte(int r, int c) { const int st = (r >> 4) * 2 + (c >> 5), rr = r & 15, cc = c & 31, ob = rr * 64 + cc * 2; return st * 1024 + (ob ^ (((ob >> 9) & 1) << 5)); }
__host__ __device__ __forceinline__ void stage_rc(int b, int& R, int& C) { const int st = b / 1024, sb = b % 1024, swz = sb ^ (((sb >> 9) & 1) << 5); R = (st >> 1) * 16 + swz / 64; C = (st & 1) * 32 + (swz % 64) / 2; }
__host__ __device__ __forceinline__ int perm32(int rho) { const int n = rho >> 4, i = rho & 15; return 8 * (i >> 2) + 4 * n + (i & 3); }
struct Unit { int pm, pn, row0, nrows, e, kind; };
__device__ __forceinline__ void tilemap(int L, int nM, int nN, int& pm, int& pn) {
    int wgid = L; { const int nwg = nM * nN, q = nwg / 8, r = nwg % 8, xcd = wgid % 8, off = wgid / 8; wgid = (xcd < r ? xcd * (q + 1) : r * (q + 1) + (xcd - r) * q) + off; }
    const int nig = 8 * nN, gid = wgid / nig, fm = gid * 8, gsz = (nM - fm) < 8 ? (nM - fm) : 8;
    pm = fm + ((wgid % nig) % gsz); pn = (wgid % nig) / gsz;
}
__device__ __forceinline__ unsigned cvt_pk_bf16(float lo, float hi) { unsigned r; asm volatile("v_cvt_pk_bf16_f32 %0, %1, %2" : "=v"(r) : "v"(lo), "v"(hi)); return r; }
__device__ __forceinline__ f32x2 gelu_pk(f32x2 v) {
    const f32x2 av = __builtin_elementwise_abs(v), d = av * 0.2316418882f + 1.0f;
    f32x2 t; t.x = __builtin_amdgcn_rcpf(d.x); t.y = __builtin_amdgcn_rcpf(d.y);
    f32x2 q = t * 0.5307027145f + (-0.7265760135f); q = q * t + 0.7107068705f; q = q * t + (-0.142248368f); q = q * t + 0.127414796f; q = q * t;
    const f32x2 s = (v * v) * (-0.72134752044f);
    f32x2 e; e.x = __builtin_amdgcn_exp2f(s.x); e.y = __builtin_amdgcn_exp2f(s.y);
    const f32x2 m = v * (q * e), r = v - m;
    f32x2 o; o.x = v.x < 0.f ? m.x : r.x; o.y = v.y < 0.f ? m.y : r.y; return o;
}
__device__ __forceinline__ f32x4 gelu4(f32x4 v) { const f32x2 a = gelu_pk((f32x2){v[0], v[1]}), b = gelu_pk((f32x2){v[2], v[3]}); return (f32x4){a.x, a.y, b.x, b.y}; }
__device__ __forceinline__ f32x4 sigmoid4(f32x4 v) { f32x4 o;
#pragma unroll
    for (int i = 0; i < 4; ++i) o[i] = __builtin_amdgcn_rcpf(1.0f + __builtin_amdgcn_exp2f(-1.4426950408889634f * v[i]));
    return o; }
__device__ __forceinline__ u32x4 pack8v(f32x4 a, f32x4 b) { u32x4 w; w.x = cvt_pk_bf16(a[0], a[1]); w.y = cvt_pk_bf16(a[2], a[3]); w.z = cvt_pk_bf16(b[0], b[1]); w.w = cvt_pk_bf16(b[2], b[3]); return w; }

template <class Epi, class Sched, bool ALIGN_EPI>
__device__ __forceinline__ void gemm_phase(PG_LAS unsigned char* lds, const unsigned char* Abase, const Sched& S, const Epi& E) {
    const int tid = tid_opaque(), wid = __builtin_amdgcn_readfirstlane(tid >> 6), lane = tid & 63, wr = wid >> 2, wc = wid & 3, fr = lane & 15, fq = lane >> 4;
    int R[2], C[2]; unsigned voffB[2];
#pragma unroll
    for (int i = 0; i < 2; ++i) { stage_rc(tid * 16 + i * 8192, R[i], C[i]); const int Rb = Epi::PERM ? ((R[i] & ~31) + perm32(R[i] & 31)) : R[i]; voffB[i] = (unsigned)(Rb * KD + C[i]) * 2u; }
    const unsigned ldsw = (unsigned)wid * 1024u;
    const int aoff = lds_byte(wr * 64 + fr, fq * 8), boff = lds_byte(wc * 32 + fr, fq * 8);
#define PG_SA(b, h) (((b) * 2 + (h)) * HTB)
#define PG_SB(b, h) ((4 + (b) * 2 + (h)) * HTB)
#define PG_STAGE_A(bufoff, kbyte, vo) do { _Pragma("unroll") for (int _i = 0; _i < 2; ++_i) \
        __builtin_amdgcn_global_load_lds((const unsigned*)((const char*)Abase + (kbyte) + (vo)[_i]), (PG_LAS unsigned*)(lds + (bufoff) + ldsw + _i * 8192), 16, 0, 0); } while (0)
#define PG_STAGE_B(bufoff, gbase) do { _Pragma("unroll") for (int _i = 0; _i < 2; ++_i) \
        __builtin_amdgcn_global_load_lds((const unsigned*)((const char*)(gbase) + voffB[_i]), (PG_LAS unsigned*)(lds + (bufoff) + ldsw + _i * 8192), 16, 0, 0); } while (0)
#define PG_LDA(dst, b, h) do { _Pragma("unroll") for (int m = 0; m < 4; ++m) _Pragma("unroll") for (int k = 0; k < 2; ++k) dst[m][k] = *(const PG_LAS bf16x8*)(lds + PG_SA(b, h) + aoff + m * 2048 + k * 1024); } while (0)
#define PG_LDB(dst, b, h) do { _Pragma("unroll") for (int n = 0; n < 2; ++n) _Pragma("unroll") for (int k = 0; k < 2; ++k) dst[n][k] = *(const PG_LAS bf16x8*)(lds + PG_SB(b, h) + boff + n * 2048 + k * 1024); } while (0)
#define PG_MMA(ai, bj, At, Bt) do { __builtin_amdgcn_s_setprio(1); _Pragma("unroll") for (int m = 0; m < 4; ++m) _Pragma("unroll") for (int n = 0; n < 2; ++n) _Pragma("unroll") for (int k = 0; k < 2; ++k) \
        acc[ai][bj][m][n] = __builtin_amdgcn_mfma_f32_16x16x32_bf16(Bt[n][k], At[m][k], acc[ai][bj][m][n], 0, 0, 0); __builtin_amdgcn_s_setprio(0); } while (0)
#define PG_WAIT_V(n) asm volatile("s_waitcnt vmcnt(" #n ")" ::: "memory")
#define PG_WAIT_L(n) asm volatile("s_waitcnt lgkmcnt(" #n ")" ::: "memory")
#define PG_BAR __builtin_amdgcn_s_barrier()
#define PG_SCHED __builtin_amdgcn_sched_barrier(0)
    Unit cur, nxt; int ui = 0;
    if (!S.next(0, cur)) return;
    f32x4 acc[2][2][4][2];
#pragma unroll
    for (int a = 0; a < 2; ++a)
#pragma unroll
        for (int b = 0; b < 2; ++b)
#pragma unroll
            for (int m = 0; m < 4; ++m)
#pragma unroll
                for (int n = 0; n < 2; ++n) acc[a][b][m][n] = (f32x4){0.f, 0.f, 0.f, 0.f};
    bf16x8 At[4][2], B0[2][2], B1[2][2];
    unsigned ac[2][2], an[2][2];
    S.aoffs(cur, R, C, ac);
    const char* cB = S.bptr(cur);
    PG_STAGE_B(PG_SB(0, 0), cB); PG_STAGE_B(PG_SB(0, 1), cB + HSTEPB); PG_STAGE_A(PG_SA(0, 0), 0u, ac[0]); PG_STAGE_A(PG_SA(0, 1), 0u, ac[1]);
    if (wr == 1) PG_BAR;
    PG_WAIT_V(2); PG_BAR;
    PG_STAGE_B(PG_SB(1, 0), cB + KSTEP); PG_STAGE_A(PG_SA(1, 0), KSTEP, ac[0]); PG_STAGE_B(PG_SB(1, 1), cB + HSTEPB + KSTEP);
    PG_WAIT_V(6); PG_BAR;
    for (;;) {
        const bool has_next = S.next(ui + 1, nxt);
        const char* nB = cB;
        if (has_next) { S.aoffs(nxt, R, C, an); nB = S.bptr(nxt); }
        else {
#pragma unroll
            for (int h = 0; h < 2; ++h)
#pragma unroll
                for (int i = 0; i < 2; ++i) an[h][i] = ac[h][i]; }
        for (int t = 0; t < NT; t += 2) {
            const bool last = (t == NT - 2);
            const unsigned ka1 = (unsigned)(t + 1) * KSTEP;
            const unsigned ka2 = last ? 0u : (unsigned)(t + 2) * KSTEP;
            const char* b2 = last ? nB : cB + (size_t)(t + 2) * KSTEP; const char* b3 = b2 + KSTEP;
            unsigned a2o[2][2];
#pragma unroll
            for (int h = 0; h < 2; ++h)
#pragma unroll
                for (int i = 0; i < 2; ++i) a2o[h][i] = last ? an[h][i] : ac[h][i];
            PG_LDB(B0, 0, 0); PG_LDB(B1, 0, 1); PG_SCHED; PG_LDA(At, 0, 0); PG_STAGE_A(PG_SA(1, 1), ka1, ac[1]);
            PG_WAIT_V(8); PG_WAIT_L(0); PG_BAR; PG_MMA(0, 0, At, B0); PG_MMA(0, 1, At, B1); PG_BAR; PG_SCHED;
            PG_LDA(At, 0, 1); PG_STAGE_B(PG_SB(0, 0), b2); PG_STAGE_B(PG_SB(0, 1), b2 + HSTEPB); PG_STAGE_A(PG_SA(0, 0), ka2, a2o[0]);
            PG_WAIT_V(8); PG_WAIT_L(0); PG_BAR; PG_MMA(1, 0, At, B0); PG_MMA(1, 1, At, B1); PG_BAR; PG_SCHED;
            PG_LDB(B0, 1, 0); PG_LDB(B1, 1, 1); PG_SCHED; PG_LDA(At, 1, 0); PG_STAGE_A(PG_SA(0, 1), ka2, a2o[1]);
            PG_WAIT_V(8); PG_WAIT_L(0); PG_BAR; PG_MMA(0, 0, At, B0); PG_MMA(0, 1, At, B1); PG_BAR; PG_SCHED;
            PG_LDA(At, 1, 1); PG_STAGE_B(PG_SB(1, 0), b3); PG_STAGE_B(PG_SB(1, 1), b3 + HSTEPB); PG_STAGE_A(PG_SA(1, 0), ka2 + KSTEP, a2o[0]);
            PG_WAIT_V(8); PG_WAIT_L(0); PG_BAR; PG_MMA(1, 0, At, B0); PG_MMA(1, 1, At, B1); PG_BAR; PG_SCHED;
        }
        if constexpr (ALIGN_EPI) { if (wr == 0) PG_BAR; }
        E.run(acc, cur, wr, wc, fr, fq);
        if (!has_next) break;
        if (!E.carry(cur)) {
#pragma unroll
            for (int a = 0; a < 2; ++a)
#pragma unroll
                for (int b = 0; b < 2; ++b)
#pragma unroll
                    for (int m = 0; m < 4; ++m)
#pragma unroll
                        for (int n = 0; n < 2; ++n) acc[a][b][m][n] = (f32x4){0.f, 0.f, 0.f, 0.f}; }
        cur = nxt; cB = nB; ++ui;
#pragma unroll
        for (int h = 0; h < 2; ++h)
#pragma unroll
            for (int i = 0; i < 2; ++i) ac[h][i] = an[h][i];
        if constexpr (ALIGN_EPI) { if (wr == 1) PG_BAR; }
    }
    PG_WAIT_V(0);
    if constexpr (!ALIGN_EPI) { if (wr == 0) PG_BAR; }
    PG_BAR;
#undef PG_SA
#undef PG_SB
#undef PG_STAGE_A
#undef PG_STAGE_B
#undef PG_LDA
#undef PG_LDB
#undef PG_MMA
#undef PG_WAIT_V
#undef PG_WAIT_L
#undef PG_BAR
#undef PG_SCHED
}

struct SchedP1 {
    int G, c; const unsigned char* ws;
    __device__ __forceinline__ bool next(int i, Unit& u) const {
        const int L = i * G + c; if (L >= 3136) return false;
        u.row0 = 0; u.nrows = 256; u.e = 0;
        if (L < 2048) { u.kind = 0; tilemap(L, 128, 16, u.pm, u.pn); }
        else if (L < 3072) { u.kind = 1; tilemap(L - 2048, 8, 128, u.pm, u.pn); }
        else if (L < 3104) { u.kind = 2; const int l = L - 3072; u.pm = l >> 2; u.pn = l & 3; }
        else { u.kind = 3; const int l = L - 3104; u.pm = l >> 3; u.pn = l & 7; }
        return true; }
    __device__ __forceinline__ void aoffs(const Unit& u, const int (&R)[2], const int (&C)[2], unsigned (&o)[2][2]) const {
        size_t base; int row0;
        if (u.kind == 0) { base = WS_U; row0 = 256 * u.pm; }
        else if (u.kind == 1) { base = WS_WIN; row0 = u.pm < 4 ? 1024 + 256 * u.pm : 4096 + 256 * (u.pm - 4); }
        else if (u.kind == 2) { base = WS_UC; row0 = 256 * u.pm; }
        else { base = WS_WIN; row0 = 4096 + 256 * u.pm; }
#pragma unroll
        for (int h = 0; h < 2; ++h)
#pragma unroll
            for (int i = 0; i < 2; ++i) o[h][i] = (unsigned)(base + ((size_t)(row0 + 128 * h + R[i]) * 1024 + C[i]) * 2); }
    __device__ __forceinline__ const char* bptr(const Unit& u) const {
        if (u.kind == 0) { const int wrow = u.pn < 4 ? 256 * u.pn : (u.pn < 8 ? 2048 + 256 * (u.pn - 4) : 5120 + 256 * (u.pn - 8)); return (const char*)ws + WS_WIN + (size_t)wrow * 2048; }
        if (u.kind == 1) return (const char*)ws + WS_U + (size_t)u.pn * 256 * 2048;
        if (u.kind == 2) return (const char*)ws + WS_WIN + (size_t)(3072 + 256 * u.pn) * 2048;
        return (const char*)ws + WS_UC + (size_t)u.pn * 256 * 2048; }
};
struct EpiP1 {
    static constexpr bool PERM = true;
    unsigned char* ws; const float* b_in;
    __device__ __forceinline__ bool carry(const Unit&) const { return false; }
    __device__ __forceinline__ void run(f32x4 (&acc)[2][2][4][2], const Unit& u, int wr, int wc, int fr, int fq) const {
        const int lc = wc * 32 + 8 * fq, kind = u.kind, pm = u.pm, pn = u.pn;
        const bool brow = (kind == 1) || (kind == 3);
        int act, bcol, browbase, RA, RB, CA, CB; size_t base;
        if (kind == 0) { browbase = 0;
            if (pn < 4) { act = 1; bcol = 256 * pn; base = WS_ZU / 2 + (size_t)256 * pm * 1024 + 256 * pn; RA = 65536; RB = 1024; CA = 64; CB = 1; }
            else if (pn < 8) { act = 0; bcol = 2048 + 256 * (pn - 4); const int tok0 = 256 * pm;
                base = WS_Q / 2 + ((size_t)((tok0 >> 12) * 16 + 4 * (pn - 4)) * 4096 + (tok0 & 4095)) * 64; RA = 4096; RB = 64; CA = 4096 * 64; CB = 1; }
            else { act = 2; bcol = 5120 + 256 * (pn - 8); base = WS_G / 2 + (size_t)256 * pm * 2048 + 256 * (pn - 8); RA = 131072; RB = 2048; CA = 64; CB = 1; } }
        else if (kind == 1) { bcol = 0; const int tk0 = 256 * pn;
            if (pm < 4) { act = 1; browbase = 1024 + 256 * pm; base = WS_ZVT / 2 + (size_t)(tk0 >> 3) * 8192 + 256 * pm * 8; RA = 512; RB = 8; CA = 65536; CB = 1024; }
            else { act = 0; browbase = 4096 + 256 * (pm - 4); base = WS_VT / 2 + ((size_t)((tk0 >> 12) * 16 + 4 * (pm - 4)) * 512 + ((tk0 & 4095) >> 3)) * 512; RA = 512 * 512; RB = 8; CA = 4096; CB = 64; } }
        else if (kind == 2) { act = 0; bcol = 3072 + 256 * pn; browbase = 0; base = WS_KC / 2 + (size_t)(pm * 16 + 4 * pn) * 256 * 64; RA = 4096; RB = 64; CA = 16384; CB = 1; }
        else { act = 0; bcol = 0; browbase = 4096 + 256 * pm; base = WS_VCT / 2 + (size_t)(pn * 16 + 4 * pm) * 32 * 512; RA = 32 * 512; RB = 8; CA = 4096; CB = 64; }
        bf16_t* dbase = (bf16_t*)ws + base;
        f32x4 bv[2][2];
#pragma unroll
        for (int bj = 0; bj < 2; ++bj)
#pragma unroll
            for (int n = 0; n < 2; ++n) bv[bj][n] = brow ? (f32x4){0.f, 0.f, 0.f, 0.f} : *(const f32x4*)(b_in + bcol + lc + bj * HALF + 4 * n);
        const int colterm0 = (wc >> 1) * CA + ((wc & 1) * 32 + 8 * fq) * CB;
#pragma unroll
        for (int ai = 0; ai < 2; ++ai)
#pragma unroll
            for (int m = 0; m < 4; ++m) { const int row = ai * HALF + wr * 64 + m * 16 + fr;
                const float rb = brow ? b_in[browbase + row] : 0.f;
                const int rowterm = (2 * ai + wr) * RA + (16 * m + fr) * RB;
#pragma unroll
                for (int bj = 0; bj < 2; ++bj) {
                    f32x4 v0 = acc[ai][bj][m][0] + bv[bj][0] + rb, v1 = acc[ai][bj][m][1] + bv[bj][1] + rb;
                    if (act == 1) { v0 = gelu4(v0); v1 = gelu4(v1); } else if (act == 2) { v0 = sigmoid4(v0); v1 = sigmoid4(v1); }
                    *(u32x4*)(dbase + rowterm + colterm0 + 2 * bj * CA) = pack8v(v0, v1); } }
    }
};
struct SchedK {
    int G, c; const unsigned char* ws;
    __device__ __forceinline__ bool next(int i, Unit& u) const { const int L = i * G + c; if (L >= 512) return false; u.kind = 0; u.row0 = 0; u.nrows = 256; u.e = 0; tilemap(L, 128, 4, u.pm, u.pn); return true; }
    __device__ __forceinline__ void aoffs(const Unit& u, const int (&R)[2], const int (&C)[2], unsigned (&o)[2][2]) const {
#pragma unroll
        for (int h = 0; h < 2; ++h)
#pragma unroll
            for (int i = 0; i < 2; ++i) o[h][i] = (unsigned)(WS_U + ((size_t)(256 * u.pm + 128 * h + R[i]) * 1024 + C[i]) * 2); }
    __device__ __forceinline__ const char* bptr(const Unit& u) const { return (const char*)ws + WS_WIN + (size_t)(3072 + 256 * u.pn) * 2048; }
};
struct EpiRope {
    static constexpr bool PERM = false;
    unsigned char* ws; const float* b_in;
    __device__ __forceinline__ bool carry(const Unit&) const { return false; }
    __device__ __forceinline__ void run(f32x4 (&acc)[2][2][4][2], const Unit& u, int wr, int wc, int fr, int fq) const {
        bf16_t* K = (bf16_t*)(ws + WS_K); const float* tab = (const float*)(ws + WS_ROPE);
        const int lc = wc * 32 + 4 * fq, axis = wc & 1;
        f32x4 b0[2], b1[2];
#pragma unroll
        for (int bj = 0; bj < 2; ++bj) { b0[bj] = *(const f32x4*)(b_in + 3072 + 256 * u.pn + bj * HALF + lc); b1[bj] = *(const f32x4*)(b_in + 3072 + 256 * u.pn + bj * HALF + lc + 16); }
#pragma unroll
        for (int ai = 0; ai < 2; ++ai)
#pragma unroll
            for (int m = 0; m < 4; ++m) { const int tok = 256 * u.pm + ai * HALF + wr * 64 + m * 16 + fr;
                const int pos = axis ? (tok & 63) : ((tok >> 6) & 63);
                const f32x4 t0 = *(const f32x4*)(tab + (pos * 16 + 4 * fq) * 2), t1 = *(const f32x4*)(tab + (pos * 16 + 4 * fq) * 2 + 4);
                const f32x4 cs = (f32x4){t0[0], t0[2], t1[0], t1[2]}, sn = (f32x4){t0[1], t0[3], t1[1], t1[3]};
                const int cc0 = 256 * u.pn + lc;
                bf16_t* rowp = K + ((size_t)((tok >> 12) * 16) * 4096 + (tok & 4095)) * 64;
#pragma unroll
                for (int bj = 0; bj < 2; ++bj) { const f32x4 v0 = acc[ai][bj][m][0] + b0[bj], v1 = acc[ai][bj][m][1] + b1[bj];
                    const f32x4 o0 = v0 * cs - v1 * sn, o1 = v1 * cs + v0 * sn;
                    u32x2 w0, w1; w0.x = cvt_pk_bf16(o0[0], o0[1]); w0.y = cvt_pk_bf16(o0[2], o0[3]); w1.x = cvt_pk_bf16(o1[0], o1[1]); w1.y = cvt_pk_bf16(o1[2], o1[3]);
                    const int cc = cc0 + bj * HALF; bf16_t* dp = rowp + (size_t)(cc >> 6) * 4096 * 64 + (cc & 63);
                    *(u32x2*)dp = w0; *(u32x2*)(dp + 16) = w1; } }
    }
};
struct SchedMerge {
    int G, c; const unsigned char* ws;
    __device__ __forceinline__ bool next(int i, Unit& u) const { const int L = (i >> 1) * G + c; if (L >= 512) return false; u.kind = i & 1; u.row0 = 0; u.nrows = 256; u.e = 0; tilemap(L, 128, 4, u.pm, u.pn); return true; }
    __device__ __forceinline__ void aoffs(const Unit& u, const int (&R)[2], const int (&C)[2], unsigned (&o)[2][2]) const {
        const size_t base = u.kind ? WS_YB : WS_U;
#pragma unroll
        for (int h = 0; h < 2; ++h)
#pragma unroll
            for (int i = 0; i < 2; ++i) o[h][i] = (unsigned)(base + ((size_t)(256 * u.pm + 128 * h + R[i]) * 1024 + C[i]) * 2); }
    __device__ __forceinline__ const char* bptr(const Unit& u) const { return (const char*)ws + (u.kind ? WS_WPB : WS_WPA) + (size_t)u.pn * 256 * 2048; }
};
struct EpiMerge {
    static constexpr bool PERM = true;
    unsigned char* ws;
    __device__ __forceinline__ bool carry(const Unit& u) const { return u.kind == 0; }
    __device__ __forceinline__ void run(f32x4 (&acc)[2][2][4][2], const Unit& u, int wr, int wc, int fr, int fq) const {
        const bf16_t* Gt = (const bf16_t*)(ws + WS_G); bf16_t* INNER = (bf16_t*)(ws + WS_INNER);
        const int lc = 256 * u.pn + wc * 32 + 8 * fq;
#pragma unroll
        for (int ai = 0; ai < 2; ++ai)
#pragma unroll
            for (int m = 0; m < 4; ++m) { const size_t tok = (size_t)(256 * u.pm + ai * HALF + wr * 64 + m * 16 + fr);
#pragma unroll
                for (int bj = 0; bj < 2; ++bj) { const int col = lc + bj * HALF;
                    const u32x4 gbw = *(const u32x4*)(Gt + tok * 2048 + 1024 + col);
                    f32x4 gb0 = (f32x4){bflo(gbw.x), bfhi(gbw.x), bflo(gbw.y), bfhi(gbw.y)}, gb1 = (f32x4){bflo(gbw.z), bfhi(gbw.z), bflo(gbw.w), bfhi(gbw.w)};
                    if (u.kind == 0) { const u32x4 gaw = *(const u32x4*)(Gt + tok * 2048 + col);
                        const f32x4 ga0 = (f32x4){bflo(gaw.x), bfhi(gaw.x), bflo(gaw.y), bfhi(gaw.y)}, ga1 = (f32x4){bflo(gaw.z), bfhi(gaw.z), bflo(gaw.w), bfhi(gaw.w)};
#pragma unroll
                        for (int i = 0; i < 4; ++i) { acc[ai][bj][m][0][i] *= ga0[i] * __builtin_amdgcn_rcpf(fmaxf(gb0[i], 1e-30f)); acc[ai][bj][m][1][i] *= ga1[i] * __builtin_amdgcn_rcpf(fmaxf(gb1[i], 1e-30f)); }
                    } else { *(u32x4*)(INNER + tok * 1024 + col) = pack8v(acc[ai][bj][m][0] * gb0, acc[ai][bj][m][1] * gb1); } } }
    }
};
struct SchedMix {
    int G, c; const unsigned char* ws;
    __device__ __forceinline__ bool next(int i, Unit& u) const { const int L = i * G + c; if (L >= 512) return false; u.kind = 0; u.row0 = 0; u.nrows = 256; u.e = 0; tilemap(L, 128, 4, u.pm, u.pn); return true; }
    __device__ __forceinline__ void aoffs(const Unit& u, const int (&R)[2], const int (&C)[2], unsigned (&o)[2][2]) const {
#pragma unroll
        for (int h = 0; h < 2; ++h)
#pragma unroll
            for (int i = 0; i < 2; ++i) o[h][i] = (unsigned)(WS_INNER + ((size_t)(256 * u.pm + 128 * h + R[i]) * 1024 + C[i]) * 2); }
    __device__ __forceinline__ const char* bptr(const Unit& u) const { return (const char*)ws + WS_WOUT + (size_t)u.pn * 256 * 2048; }
};
struct EpiMix {
    static constexpr bool PERM = false;
    unsigned char* ws; const float *x, *lng, *lnb, *b_out; float* out;
    __device__ __forceinline__ bool carry(const Unit&) const { return false; }
    __device__ __forceinline__ void run(f32x4 (&acc)[2][2][4][2], const Unit& u, int wr, int wc, int fr, int fq) const {
        const float* rowstat = (const float*)(ws + WS_ROWSTAT); const float* mod = (const float*)(ws + WS_MOD) + ((256 * u.pm) >> 12) * 6144 + 2048;
        f32x2 st[2][4];
#pragma unroll
        for (int ai = 0; ai < 2; ++ai)
#pragma unroll
            for (int m = 0; m < 4; ++m) st[ai][m] = *(const f32x2*)(rowstat + 2 * (256 * u.pm + ai * HALF + wr * 64 + m * 16 + fr));
#pragma unroll
        for (int bj = 0; bj < 2; ++bj)
#pragma unroll
            for (int n = 0; n < 2; ++n) { const int col = 256 * u.pn + bj * HALF + wc * 32 + n * 16 + 4 * fq;
                const f32x4 lg = *(const f32x4*)(lng + col), lb = *(const f32x4*)(lnb + col), bo = *(const f32x4*)(b_out + col), g1 = *(const f32x4*)(mod + col);
#pragma unroll
                for (int ai = 0; ai < 2; ++ai)
#pragma unroll
                    for (int m = 0; m < 4; ++m) { const size_t off = (size_t)(256 * u.pm + ai * HALF + wr * 64 + m * 16 + fr) * 1024 + col;
                        const f32x4 xv = *(const f32x4*)(x + off);
                        const f32x4 x0 = (xv - st[ai][m].x) * st[ai][m].y * lg + lb;
                        *(f32x4*)(out + off) = x0 * ALPHA + g1 * (acc[ai][bj][m][n] + bo); }
                asm volatile("" ::: "memory"); }
    }
};
__device__ __forceinline__ int ld_u(const int* p) { return __builtin_amdgcn_readfirstlane(__hip_atomic_load(p, __ATOMIC_RELAXED, __HIP_MEMORY_SCOPE_AGENT)); }
template <int NPN  > struct SchedMoe {
    int G, c; const unsigned char* ws; const int* tabs;
    __device__ __forceinline__ bool next(int i, Unit& u) const {
        const int* cn = tabs; const int* eb = tabs + 32; const int* tb = tabs + 65;
        const int ntiles = tb[32], tpx = (ntiles + 7) >> 3, x = c & 7, s = c >> 3;
        const int tiles_x = min(tpx, ntiles - x * tpx), ll = i * (G >> 3) + s;
        if (ll >= NPN * tiles_x) return false;
        const int T = x * tpx + ll / NPN; u.pn = ll % NPN; u.kind = 0;
        int e = 0;
#pragma unroll 1
        for (int k = 16; k >= 1; k >>= 1) if (tb[e + k] <= T) e += k;
        const int jt = T - tb[e];
        u.e = __builtin_amdgcn_readfirstlane(e); u.pm = __builtin_amdgcn_readfirstlane(jt);
        u.row0 = __builtin_amdgcn_readfirstlane(eb[e] + 256 * jt); u.nrows = __builtin_amdgcn_readfirstlane(min(256, cn[e] - 256 * jt)); return true; }
    __device__ __forceinline__ void aoffs(const Unit& u, const int (&R)[2], const int (&C)[2], unsigned (&o)[2][2]) const {
        const int* PERM2 = (const int*)(ws + WS_PERM2) + (size_t)u.e * NTOK + 256 * u.pm;
#pragma unroll
        for (int h = 0; h < 2; ++h)
#pragma unroll
            for (int i = 0; i < 2; ++i) { const int lr = min(128 * h + R[i], u.nrows - 1);
                if (NPN == 8) { const int tok = PERM2[lr]; o[h][i] = (unsigned)(WS_U + ((size_t)tok * 1024 + C[i]) * 2); }
                else o[h][i] = (unsigned)(WS_ACT + ((size_t)(u.row0 + lr) * 1024 + C[i]) * 2); } }
    __device__ __forceinline__ const char* bptr(const Unit& u) const {
        if (NPN == 8) return (const char*)ws + WS_W1 + ((size_t)u.e * 2048 + 256 * u.pn) * 2048;
        return (const char*)ws + WS_W2 + ((size_t)u.e * 1024 + 256 * u.pn) * 2048; }
};
struct EpiMoe1 {
    static constexpr bool PERM = true;
    unsigned char* ws; const float* b1;
    __device__ __forceinline__ bool carry(const Unit&) const { return false; }
    __device__ __forceinline__ void run(f32x4 (&acc)[2][2][4][2], const Unit& u, int wr, int wc, int fr, int fq) const {
        bf16_t* ACT = (bf16_t*)(ws + WS_ACT);
        const int col = 128 * u.pn + wc * 32 + 8 * fq;
        f32x4 bg[2], bl[2];
#pragma unroll
        for (int n = 0; n < 2; ++n) { bg[n] = *(const f32x4*)(b1 + u.e * 2048 + col + 4 * n); bl[n] = *(const f32x4*)(b1 + u.e * 2048 + 1024 + col + 4 * n); }
#pragma unroll
        for (int ai = 0; ai < 2; ++ai)
#pragma unroll
            for (int m = 0; m < 4; ++m) { const int lr = ai * HALF + wr * 64 + m * 16 + fr;
                f32x4 a[2];
#pragma unroll
                for (int n = 0; n < 2; ++n) { const f32x4 zgv = acc[ai][0][m][n] + bg[n], zlv = acc[ai][1][m][n] + bl[n];
#pragma unroll
                    for (int i = 0; i < 4; ++i) { const float zg = fminf(zgv[i], 7.0f), zl = fminf(fmaxf(zlv[i], -7.0f), 7.0f);
                        a[n][i] = zg * __builtin_amdgcn_rcpf(1.0f + __builtin_amdgcn_exp2f(-1.702f * 1.4426950408889634f * zg)) * (zl + 1.0f); } }
                if (lr < u.nrows) *(u32x4*)(ACT + (size_t)(u.row0 + lr) * 1024 + col) = pack8v(a[0], a[1]); }
    }
};
struct EpiMoe2 {
    static constexpr bool PERM = true;
    unsigned char* ws; const float* b2;
    __device__ __forceinline__ bool carry(const Unit&) const { return false; }
    __device__ __forceinline__ void run(f32x4 (&acc)[2][2][4][2], const Unit& u, int wr, int wc, int fr, int fq) const {
        bf16_t* YS = (bf16_t*)(ws + WS_YS);
        const int lc = 256 * u.pn + wc * 32 + 8 * fq;
        f32x4 bv[2][2];
#pragma unroll
        for (int bj = 0; bj < 2; ++bj)
#pragma unroll
            for (int n = 0; n < 2; ++n) bv[bj][n] = *(const f32x4*)(b2 + u.e * 1024 + lc + bj * HALF + 4 * n);
#pragma unroll
        for (int ai = 0; ai < 2; ++ai)
#pragma unroll
            for (int m = 0; m < 4; ++m) { const int lr = ai * HALF + wr * 64 + m * 16 + fr;
                if (lr < u.nrows) {
#pragma unroll
                    for (int bj = 0; bj < 2; ++bj) *(u32x4*)(YS + (size_t)(u.row0 + lr) * 1024 + lc + bj * HALF) = pack8v(acc[ai][bj][m][0] + bv[bj][0], acc[ai][bj][m][1] + bv[bj][1]); } }
    }
};
}
__device__ __forceinline__ void phase_merge_fast(const P& p, int bid, int nblk, unsigned char* lds) {
    pg::SchedMerge S{nblk, bid, p.ws}; pg::EpiMerge E{p.ws};
    pg::gemm_phase<pg::EpiMerge, pg::SchedMerge, true>((PG_LAS unsigned char*)lds, p.ws, S, E);
}
__device__ __forceinline__ void phase_mix_fast(const P& p, int bid, int nblk, unsigned char* lds) {
    pg::SchedMix S{nblk, bid, p.ws}; pg::EpiMix E{p.ws, p.x, p.ln_x_g, p.ln_x_b, p.b_out, p.out};
    pg::gemm_phase<pg::EpiMix, pg::SchedMix, true>((PG_LAS unsigned char*)lds, p.ws, S, E);
}
__device__ __forceinline__ void phase_moe1_fast(const P& p, int bid, int nblk, unsigned char* lds) {
    moe_tables(p, lds); pg::SchedMoe<8> S{nblk, bid, p.ws, (const int*)(lds + MT_LDS)}; pg::EpiMoe1 E{p.ws, p.exp_b1};
    pg::gemm_phase<pg::EpiMoe1, pg::SchedMoe<8>, true>((PG_LAS unsigned char*)lds, p.ws, S, E);
}
__device__ __forceinline__ void phase_moe2_fast(const P& p, int bid, int nblk, unsigned char* lds) {
    moe_tables(p, lds); pg::SchedMoe<4> S{nblk, bid, p.ws, (const int*)(lds + MT_LDS)}; pg::EpiMoe2 E{p.ws, p.exp_b2};
    pg::gemm_phase<pg::EpiMoe2, pg::SchedMoe<4>, true>((PG_LAS unsigned char*)lds, p.ws, S, E);
}
__device__ __forceinline__ void phase_proj_fast(const P& p, int bid, int nblk, unsigned char* lds) {
    { pg::SchedP1 S{nblk, bid, p.ws}; pg::EpiP1 E{p.ws, p.b_in};
      pg::gemm_phase<pg::EpiP1, pg::SchedP1, true>((PG_LAS unsigned char*)lds, p.ws, S, E); }
    { pg::SchedK S{nblk, bid, p.ws}; pg::EpiRope E{p.ws, p.b_in};
      pg::gemm_phase<pg::EpiRope, pg::SchedK, true>((PG_LAS unsigned char*)lds, p.ws, S, E); }
}

#define LAS __attribute__((address_space(3)))
#define XB_TMO      128
#define XB_XCNT(j)  (256  + 64 * (j))
#define XB_XSUB(j)  (1280 + 64 * (j))
#define XB_XGEN(j)  (2304 + 64 * (j))
#define XB_TOP      3328
#define XB_TOPGEN   3392
#define XCD_BAR_WORDS 3456
#define XB_SPIN_CAP (1u << 22)
__device__ __forceinline__ unsigned xb_ld(unsigned* p)              { return __hip_atomic_load(p, __ATOMIC_RELAXED, __HIP_MEMORY_SCOPE_AGENT); }
__device__ __forceinline__ unsigned xb_add(unsigned* p, unsigned v) { return __hip_atomic_fetch_add(p, v, __ATOMIC_RELAXED, __HIP_MEMORY_SCOPE_AGENT); }
__device__ __forceinline__ unsigned xb_xcc_id() { return (unsigned)__builtin_amdgcn_s_getreg((3 << 11) | 20) & 0xFu; }
#define XB_SPIN(cond, bar) do { unsigned _sp = 0; while (cond) { __builtin_amdgcn_s_sleep(1); \
    if ((++_sp & 255u) == 0u) { if (xb_ld(&(bar)[XB_TMO])) break; if (_sp > XB_SPIN_CAP) { atomicAdd(&(bar)[XB_TMO], 1u); break; } } } } while (0)
struct XcdBarrier { unsigned* bar; unsigned x; volatile LAS unsigned* st; };
__device__ __forceinline__ XcdBarrier xcd_barrier_post(unsigned* bar, volatile LAS unsigned* st) {
    XcdBarrier b; b.bar = bar; b.x = xb_xcc_id(); b.st = st;
    if (threadIdx.x == 0) (void)xb_add(&bar[XB_XCNT(b.x)], 1u);
    return b;
}
__device__ __forceinline__ void xcd_barrier_complete(unsigned* bar, unsigned x, unsigned& nloc, unsigned& nx) {
    const unsigned G = gridDim.x * gridDim.y * gridDim.z;
    unsigned sum, cnt, mine, sp = 0u;
    for (;;) {
        sum = 0u; cnt = 0u; mine = 0u;
#pragma unroll
        for (unsigned j = 0; j < 16; ++j) { const unsigned c = xb_ld(&bar[XB_XCNT(j)]); sum += c; cnt += (c > 0u) ? 1u : 0u; mine = (j == x) ? c : mine; }
        if (sum == G) break;
        __builtin_amdgcn_s_sleep(1);
        if ((++sp & 255u) == 0u) { if (xb_ld(&bar[XB_TMO])) break; if (sp > XB_SPIN_CAP) { atomicAdd(&bar[XB_TMO], 1u); break; } }
    }
    nloc = mine > 0u ? mine : 1u; nx = cnt > 0u ? cnt : 1u;
}
__device__ __forceinline__ void xcd_barrier(const XcdBarrier& b) {
    asm volatile("s_waitcnt vmcnt(0)" ::: "memory");
    __syncthreads();
    if (threadIdx.x == 0) {
        unsigned* bar = b.bar;
        __builtin_amdgcn_s_waitcnt(0);
        unsigned nloc = b.st[0], nx = b.st[1];
        if (nloc == 0u) { xcd_barrier_complete(bar, b.x, nloc, nx); b.st[0] = nloc; b.st[1] = nx; }
        const unsigned old = xb_add(&bar[XB_XSUB(b.x)], 1u);
        const unsigned gen = old / nloc;
        if (old + 1u == (gen + 1u) * nloc) {
            __builtin_amdgcn_fence(__ATOMIC_RELEASE, "agent");
            asm volatile("s_waitcnt vmcnt(0)" ::: "memory");
            const unsigned og = xb_add(&bar[XB_TOP], 1u);
            const unsigned tg = og / nx;
            if (og + 1u == (tg + 1u) * nx) xb_add(&bar[XB_TOPGEN], 1u);
            else XB_SPIN(xb_ld(&bar[XB_TOPGEN]) == tg, bar);
            __builtin_amdgcn_fence(__ATOMIC_ACQUIRE, "agent");
            xb_add(&bar[XB_XGEN(b.x)], 1u);
            asm volatile("s_waitcnt vmcnt(0)" ::: "memory");
        } else {
            XB_SPIN(xb_ld(&bar[XB_XGEN(b.x)]) == gen, bar);
            __builtin_amdgcn_fence(__ATOMIC_ACQUIRE, "agent");
            asm volatile("s_waitcnt vmcnt(0)" ::: "memory");
        }
    }
    __syncthreads();
}
#include <hip/hip_cooperative_groups.h>
namespace cg = cooperative_groups;
constexpr int LDS_BYTES = 147456;
constexpr int XB_LDS = LDS_BYTES - 64;
constexpr int CW_BAR = 4096;
constexpr int REP_PA = 1, REP_PB = 1, REP_P1 = 1, REP_GMLP = 1, REP_ATTN = 1, REP_MERGE = 1, REP_MIX = 1, REP_MOE1 = 1, REP_MOE2 = 1, REP_BAR = 0;
__global__ void __launch_bounds__(512, 2) mega(P p) {
    extern __shared__ __attribute__((aligned(16))) unsigned char lds[];
    const int bid = blockIdx.x, nblk = gridDim.x;
    if (threadIdx.x < 16) ((volatile LAS unsigned*)((LAS unsigned char*)lds + XB_LDS))[threadIdx.x] = 0u;
    __syncthreads();
    const XcdBarrier bar = xcd_barrier_post((unsigned*)(p.ws + WS_CTL) + CW_BAR, (volatile LAS unsigned*)((LAS unsigned char*)lds + XB_LDS));
#define GRID_BAR() xcd_barrier(bar)
#define REP(n) _Pragma("unroll 1") for (int rep_ = 0; rep_ < (n); ++rep_)
    REP(REP_PA) { __syncthreads(); phase_prologue_a(p, bid, nblk, lds); } GRID_BAR();
    REP(REP_PB) phase_prologue_b(p, bid, nblk); GRID_BAR();
    REP(REP_P1) phase_proj_fast(p, bid, nblk, lds); GRID_BAR();
    REP(REP_GMLP) phase_gmlp_fast(p, bid, nblk, lds); REP(REP_ATTN) phase_attn_s(p, bid, nblk, lds); GRID_BAR();
    REP(REP_MERGE) phase_merge_fast(p, bid, nblk, lds); GRID_BAR();
    REP(REP_MIX) phase_mix_fast(p, bid, nblk, lds); GRID_BAR();
    phase_router(p, bid, nblk, lds); GRID_BAR();
    REP(REP_BAR) GRID_BAR();
    REP(REP_MOE1) phase_moe1_fast(p, bid, nblk, lds); GRID_BAR();
    REP(REP_MOE2) phase_moe2_fast(p, bid, nblk, lds); GRID_BAR();
#undef REP
    phase_final(p, bid, nblk, lds);
}

extern "C" void kernel_launch(void* const* d_in, const int* in_sizes, int n_in, void* d_out, int out_size, void* d_ws, size_t ws_size, hipStream_t stream) {
    static int grid = 0;
    if (grid == 0) {
        if (n_in != 31 || out_size != NTOK * DM || ws_size < WS_END) { fprintf(stderr, "kernel_launch: unexpected sizes n_in %d out %d ws %zu\n", n_in, out_size, ws_size); grid = -1; return; }
        int dev = 0, cus = 0, per_cu = 0;
        if (hipGetDevice(&dev) != hipSuccess || hipDeviceGetAttribute(&cus, hipDeviceAttributeMultiprocessorCount, dev) != hipSuccess) { grid = -1; return; }
        if (hipFuncSetAttribute((const void*)mega, hipFuncAttributeMaxDynamicSharedMemorySize, LDS_BYTES) != hipSuccess) { fprintf(stderr, "kernel_launch: hipFuncSetAttribute failed\n"); grid = -1; return; }
        if (hipOccupancyMaxActiveBlocksPerMultiprocessor(&per_cu, (const void*)mega, 512, LDS_BYTES) != hipSuccess || per_cu < 1) { fprintf(stderr, "kernel_launch: occupancy query failed (%d)\n", per_cu); grid = -1; return; }
        grid = cus * 1;
    }
    if (grid < 0) return;
    P p{};
    const float** pp = (const float**)&p;
    for (int i = 0; i < 31; ++i) pp[i] = (const float*)d_in[i];
    p.out = (float*)d_out; p.ws = (unsigned char*)d_ws; p.ph_lo = 0; p.ph_hi = 0;
    if (hipMemsetAsync((char*)d_ws + WS_CTL, 0, 1 * MiB, stream) != hipSuccess) { fprintf(stderr, "kernel_launch: memset failed\n"); return; }
    hipLaunchKernelGGL(mega, dim3(grid), dim3(512), LDS_BYTES, stream, p);
    const hipError_t e = hipPeekAtLastError();
    if (e != hipSuccess) fprintf(stderr, "launch failed: %s (grid %d)\n", hipGetErrorString(e), grid);
}
```

```cpp
#include <hip/hip_runtime.h>
#include <cstdio>
#include <cstdint>

typedef unsigned short bf16_t;
typedef short bf16x8 __attribute__((ext_vector_type(8)));
typedef float f32x4 __attribute__((ext_vector_type(4)));
typedef unsigned u32x4 __attribute__((ext_vector_type(4)));
typedef unsigned u32x2 __attribute__((ext_vector_type(2)));

constexpr int DM = 1024, NB = 8, SEQ = 4096, NTOK = NB * SEQ, CTXL = 256, NCTX = NB * CTXL, INW = 7168;
constexpr int NE = 32, TOPK = 4, FF = 1024, NASSIGN = NTOK * TOPK;
constexpr int NHEAD = 16, HD = 64, GW = 64;
constexpr float LN_EPS = 1e-5f;
constexpr float ALPHA = 1.189207115002721f;
constexpr int MAXTILES = NASSIGN / 256 + NE;

constexpr size_t MiB = 1u << 20;
constexpr size_t WS_CTL = 0;
constexpr size_t WS_MOD = 1 * MiB;
constexpr size_t WS_ROPE = 1 * MiB + 512 * 1024;
constexpr size_t WS_ROWSTAT = 2 * MiB;
constexpr size_t WS_ZSTAT = 2 * MiB + 512 * 1024;
constexpr size_t WS_TOPE = 3 * MiB;
constexpr size_t WS_TOPG = 4 * MiB;
constexpr size_t WS_SLOT = 5 * MiB;
constexpr size_t WS_PERM = 6 * MiB;
constexpr size_t WS_TILES = 7 * MiB;
constexpr size_t WS_WIN = 8 * MiB;
constexpr size_t WS_WPA = 22 * MiB, WS_WPB = 24 * MiB, WS_WOUT = 26 * MiB, WS_WSB = 28 * MiB;
constexpr size_t WS_KC = 30 * MiB;
constexpr size_t WS_VCT = 34 * MiB;
constexpr size_t WS_UC = 38 * MiB;
constexpr size_t WS_PERM2 = 42 * MiB;
constexpr size_t WS_W1 = 48 * MiB;
constexpr size_t WS_W2 = 176 * MiB;
constexpr size_t WS_U = 240 * MiB;
constexpr size_t WS_ZU = 304 * MiB;
constexpr size_t WS_ZVT = 368 * MiB;
constexpr size_t WS_Q = 432 * MiB;
constexpr size_t WS_K = 496 * MiB;
constexpr size_t WS_VT = 560 * MiB;
constexpr size_t WS_G = 624 * MiB;
constexpr size_t WS_YB = 752 * MiB;
constexpr size_t WS_INNER = 816 * MiB;
constexpr size_t WS_ACT = WS_ZU;
constexpr size_t WS_YS = WS_G;
constexpr size_t WS_X1PRE = WS_YB;
constexpr size_t WS_X1 = WS_VT;
constexpr size_t WS_END = 880 * MiB;

struct P {
    const float *x, *c, *ctx, *c_ctx, *ln_x_g, *ln_x_b, *ln_ctx_g, *ln_ctx_b, *w_ada, *b_ada, *w_in, *b_in, *gmlp_ln_g, *gmlp_ln_b, *gmlp_ws, *gmlp_bs,
        *na_rpb, *w_pa, *w_pb, *w_out, *b_out, *ln1_g, *ln1_b, *ln2_g, *ln2_b, *router_w, *router_b, *exp_w1, *exp_b1, *exp_w2, *exp_b2;
    float* out; unsigned char* ws; int ph_lo, ph_hi;
};

__device__ __forceinline__ int tid_opaque() { int t = threadIdx.x; asm volatile("" : "+v"(t)); return t; }
typedef float f32x2_ __attribute__((ext_vector_type(2))); typedef __bf16 bf16x2_ __attribute__((ext_vector_type(2)));
__device__ __forceinline__ unsigned pk2(float lo, float hi) { const f32x2_ v = {lo, hi}; return __builtin_bit_cast(unsigned, __builtin_convertvector(v, bf16x2_)); }
__device__ __forceinline__ unsigned f2bf(float f) { return pk2(f, 0.f) & 0xffffu; }
__device__ __forceinline__ float bf2f(unsigned h) { return __builtin_bit_cast(float, (h & 0xffffu) << 16); }
__device__ __forceinline__ float bflo(unsigned w) { return __builtin_bit_cast(float, w << 16); }
__device__ __forceinline__ float bfhi(unsigned w) { return __builtin_bit_cast(float, w & 0xffff0000u); }
__device__ __forceinline__ float wave_sum(float v) {
#pragma unroll
    for (int o = 1; o < 64; o <<= 1) v += __shfl_xor(v, o);
    return v;
}
__device__ __forceinline__ float wave_max(float v) {
#pragma unroll
    for (int o = 1; o < 64; o <<= 1) v = fmaxf(v, __shfl_xor(v, o));
    return v;
}
__device__ __forceinline__ float gelu_exact(float v) { return 0.5f * v * (1.0f + erff(v * 0.70710678118654752f)); }
__device__ __forceinline__ float sigmoidf_(float v) { return 1.0f / (1.0f + __expf(-v)); }

__device__ __forceinline__ void mod_item(const P& p, int item, float* red  ) {
    const int tid = tid_opaque(), wave = tid >> 6, lane = tid & 63;
    const int col = item * 32 + (lane & 31), kpar = lane >> 5;
    float acc[9];
#pragma unroll
    for (int r = 0; r < 9; ++r) acc[r] = 0.f;
    for (int kk = 0; kk < 64; ++kk) {
        const int k = wave * 128 + kk * 2 + kpar;
        const float w = p.w_ada[(size_t)k * 6144 + col];
#pragma unroll
        for (int r = 0; r < 9; ++r) { const float cv = (r < 8) ? p.c[r * 1024 + k] : p.c_ctx[k]; const float s = cv / (1.0f + __expf(-cv)); acc[r] += s * w; }
    }
#pragma unroll
    for (int r = 0; r < 9; ++r) red[((wave * 2 + kpar) * 9 + r) * 32 + (lane & 31)] = acc[r];
    __syncthreads();
    if (tid < 288) {
        const int r = tid >> 5, cc = tid & 31; float s = 0.f;
#pragma unroll
        for (int q = 0; q < 16; ++q) s += red[(q * 9 + r) * 32 + cc];
        ((float*)(p.ws + WS_MOD))[r * 6144 + item * 32 + cc] = s + p.b_ada[item * 32 + cc];
    }
    __syncthreads();
}
__device__ __forceinline__ void transpose_item(const float* W, int K, int N, bf16_t* WT, int k0, int n0, int drow0, float* scr, int lane) {
    const int lr = lane >> 3, lc4 = (lane & 7) * 4;
    f32x4 v[8];
#pragma unroll
    for (int i = 0; i < 8; ++i) v[i] = *(const f32x4*)(W + (size_t)(k0 + 8 * i + lr) * N + n0 + lc4);
#pragma unroll
    for (int i = 0; i < 8; ++i) { float* d = scr + (8 * i + lr) * 33 + lc4; d[0] = v[i].x; d[1] = v[i].y; d[2] = v[i].z; d[3] = v[i].w; }
    __builtin_amdgcn_wave_barrier();
    asm volatile("s_waitcnt lgkmcnt(0)" ::: "memory");
    const int c = lane & 7;
#pragma unroll
    for (int j = 0; j < 4; ++j) { const int n = (lane >> 3) + 8 * j; const float* s = scr + (8 * c) * 33 + n;
        u32x4 o; o.x = pk2(s[0 * 33], s[1 * 33]); o.y = pk2(s[2 * 33], s[3 * 33]); o.z = pk2(s[4 * 33], s[5 * 33]); o.w = pk2(s[6 * 33], s[7 * 33]);
        *(u32x4*)(WT + (size_t)(drow0 + n) * K + k0 + 8 * c) = o; }
    asm volatile("s_waitcnt lgkmcnt(0)" ::: "memory");
    __builtin_amdgcn_wave_barrier();
}
constexpr int IT_WIN = 16 * 224, IT_SQ = 16 * 32, IT_W1 = 32 * 16 * 64, IT_W2 = 32 * 16 * 32, IT_WS = 32;
constexpr int IT_TOTAL = IT_WIN + 3 * IT_SQ + IT_W1 + IT_W2 + IT_WS, IT_EXP0 = IT_WIN + 3 * IT_SQ;
__device__ __forceinline__ void convert_item(const P& p, int it, float* scr, int lane) {
    unsigned char* ws = p.ws;
    if (it < IT_WIN) { const int kb = it / 224, nb = it % 224; transpose_item(p.w_in, 1024, INW, (bf16_t*)(ws + WS_WIN), kb * 64, nb * 32, nb * 32, scr, lane); return; } it -= IT_WIN;
    if (it < IT_SQ) { const int kb = it / 32, nb = it % 32; transpose_item(p.w_pa, 1024, 1024, (bf16_t*)(ws + WS_WPA), kb * 64, nb * 32, nb * 32, scr, lane); return; } it -= IT_SQ;
    if (it < IT_SQ) { const int kb = it / 32, nb = it % 32; transpose_item(p.w_pb, 1024, 1024, (bf16_t*)(ws + WS_WPB), kb * 64, nb * 32, nb * 32, scr, lane); return; } it -= IT_SQ;
    if (it < IT_SQ) { const int kb = it / 32, nb = it % 32; transpose_item(p.w_out, 1024, 1024, (bf16_t*)(ws + WS_WOUT), kb * 64, nb * 32, nb * 32, scr, lane); return; } it -= IT_SQ;
    if (it < IT_W1) { const int e = it / 1024, r = it % 1024, kb = r / 64, nb = r % 64, n0 = nb * 32;
        const int half = n0 >> 10, nn = n0 & 1023, drow0 = (nn >> 7) * 256 + half * 128 + (nn & 127);
        transpose_item(p.exp_w1 + (size_t)e * 1024 * 2048, 1024, 2048, (bf16_t*)(ws + WS_W1) + (size_t)e * 2048 * 1024, kb * 64, n0, drow0, scr, lane); return; } it -= IT_W1;
    if (it < IT_W2) { const int e = it / 512, r = it % 512, kb = r / 32, nb = r % 32;
        transpose_item(p.exp_w2 + (size_t)e * 1024 * 1024, 1024, 1024, (bf16_t*)(ws + WS_W2) + (size_t)e * 1024 * 1024, kb * 64, nb * 32, nb * 32, scr, lane); return; } it -= IT_W2;
    { bf16_t* o = (bf16_t*)(ws + WS_WSB); const float* s = p.gmlp_ws + it * 4096;
      for (int i = lane; i < 4096; i += 64) o[it * 4096 + i] = (bf16_t)f2bf(s[i]); }
}
__device__ __forceinline__ void phase_prologue_a(const P& p, int bid, int nblk, unsigned char* lds) {
    const int tid = tid_opaque(), wave = tid >> 6, lane = tid & 63;
    for (int item = bid; item < 192; item += nblk) mod_item(p, item, (float*)lds);
    if (bid == nblk - 1) {
        for (int i = tid; i < 1024; i += 512) { const int pos = i >> 4, fi = i & 15;
            const float inv = __builtin_amdgcn_exp2f(-(float)fi * (13.287712379549449f / 16.0f));
            const float ang = (float)pos * inv; const float rev = ang * 0.15915494309189535f;
            float* t = (float*)(p.ws + WS_ROPE); t[2 * i] = __builtin_amdgcn_cosf(rev); t[2 * i + 1] = __builtin_amdgcn_sinf(rev); }
    }
    __syncthreads();
    float* scr = (float*)lds + wave * (64 * 33 + 32);
    const int gw = bid * 8 + wave, ngw = nblk * 8;
    for (int it = gw; it < IT_TOTAL - (IT_W1 + IT_W2); it += ngw) convert_item(p, it < IT_EXP0 ? it : it + (IT_W1 + IT_W2), scr, lane);
}
__device__ __forceinline__ void ln_mod_row(const float* xrow, const float* g, const float* b, const float* sh, const float* sc, bf16_t* orow, float* stat, int lane) {
    const f32x4* xr = (const f32x4*)xrow + lane;
    f32x4 v[4]; float s = 0.f;
#pragma unroll
    for (int j = 0; j < 4; ++j) { v[j] = xr[64 * j]; s += (v[j].x + v[j].y) + (v[j].z + v[j].w); }
    const float mean = wave_sum(s) * (1.f / DM); float s2 = 0.f;
#pragma unroll
    for (int j = 0; j < 4; ++j) { v[j] = v[j] - mean; s2 += (v[j].x * v[j].x + v[j].y * v[j].y) + (v[j].z * v[j].z + v[j].w * v[j].w); }
    const float rstd = 1.f / sqrtf(wave_sum(s2) * (1.f / DM) + LN_EPS);
    if (stat && lane == 0) { stat[0] = mean; stat[1] = rstd; }
    u32x2* o8 = (u32x2*)orow + lane;
#pragma unroll
    for (int j = 0; j < 4; ++j) { const int col = 4 * lane + 256 * j;
        const f32x4 gg = *(const f32x4*)(g + col), bb = *(const f32x4*)(b + col), shv = *(const f32x4*)(sh + col), scv = *(const f32x4*)(sc + col);
        f32x4 y = (v[j] * rstd) * gg + bb; y = y * (1.0f + scv) + shv;
        u32x2 w; w.x = pk2(y.x, y.y); w.y = pk2(y.z, y.w); o8[64 * j] = w; }
}
__device__ __forceinline__ void phase_prologue_b(const P& p, int bid, int nblk) {
    const int tid = tid_opaque(), wave = tid >> 6, lane = tid & 63;
    const int gw = bid * 8 + wave, ngw = nblk * 8;
    const float* mod = (const float*)(p.ws + WS_MOD);
    for (int row = gw; row < NTOK + NCTX; row += ngw) {
        if (row < NTOK) { const int b = row >> 12;
            ln_mod_row(p.x + (size_t)row * DM, p.ln_x_g, p.ln_x_b, mod + b * 6144, mod + b * 6144 + 1024, (bf16_t*)(p.ws + WS_U) + (size_t)row * DM, (float*)(p.ws + WS_ROWSTAT) + 2 * row, lane);
        } else { const int r = row - NTOK;
            ln_mod_row(p.ctx + (size_t)r * DM, p.ln_ctx_g, p.ln_ctx_b, mod + 8 * 6144, mod + 8 * 6144 + 1024, (bf16_t*)(p.ws + WS_UC) + (size_t)r * DM, nullptr, lane); }
    }
}

template <class ARow, class BRow, class Epi>
__device__ __forceinline__ void sgemm_wave_tile(int r0, int n0, int K, const ARow& arow, const BRow& brow, const Epi& epi, int lane) {
    const int fr = lane & 15, fq = lane >> 4;
    f32x4 acc[2][2];
#pragma unroll
    for (int a = 0; a < 2; ++a)
#pragma unroll
        for (int b = 0; b < 2; ++b) acc[a][b] = (f32x4){0.f, 0.f, 0.f, 0.f};
    const bf16_t* ap[2]; const bf16_t* bp[2];
#pragma unroll
    for (int a = 0; a < 2; ++a) { ap[a] = arow(r0 + 16 * a + fr) + 8 * fq; bp[a] = brow(n0 + 16 * a + fr) + 8 * fq; }
    for (int k0 = 0; k0 < K; k0 += 32) {
        bf16x8 af[2], bfr[2];
#pragma unroll
        for (int a = 0; a < 2; ++a) { af[a] = *(const bf16x8*)(ap[a] + k0); bfr[a] = *(const bf16x8*)(bp[a] + k0); }
#pragma unroll
        for (int a = 0; a < 2; ++a)
#pragma unroll
            for (int b = 0; b < 2; ++b) acc[a][b] = __builtin_amdgcn_mfma_f32_16x16x32_bf16(af[a], bfr[b], acc[a][b], 0, 0, 0);
    }
#pragma unroll
    for (int a = 0; a < 2; ++a)
#pragma unroll
        for (int b = 0; b < 2; ++b)
#pragma unroll
            for (int i = 0; i < 4; ++i) epi(r0 + 16 * a + 4 * fq + i, n0 + 16 * b + fr, acc[a][b][i]);
}

struct ARowDense { const bf16_t* A; int lda; __device__ __forceinline__ const bf16_t* operator()(int r) const { return A + (size_t)r * lda; } };
struct EpiProj {
    const float* b_in; bf16_t *ZU, *ZVT, *Q, *K, *VT, *G;
    __device__ __forceinline__ void operator()(int r, int n, float v) const {
        v += b_in[n];
        if (n < 1024) ZU[(size_t)r * 1024 + n] = (bf16_t)f2bf(gelu_exact(v));
        else if (n < 2048) ZVT[(size_t)(n - 1024) * NTOK + r] = (bf16_t)f2bf(gelu_exact(v));
        else if (n < 3072) Q[(size_t)r * 1024 + (n - 2048)] = (bf16_t)f2bf(v);
        else if (n < 4096) K[(size_t)r * 1024 + (n - 3072)] = (bf16_t)f2bf(v);
        else if (n < 5120) VT[(size_t)(n - 4096) * NTOK + r] = (bf16_t)f2bf(v);
        else G[(size_t)r * 2048 + (n - 5120)] = (bf16_t)f2bf(sigmoidf_(v));
    }
};
__device__ __forceinline__ void phase_proj_s(const P& p, int bid, int nblk) {
    const int tid_ = tid_opaque(); const int wave = tid_ >> 6, lane = tid_ & 63; unsigned char* ws = p.ws;
    ARowDense ar{(const bf16_t*)(ws + WS_U), 1024}, br{(const bf16_t*)(ws + WS_WIN), 1024};
    EpiProj e{p.b_in, (bf16_t*)(ws + WS_ZU), (bf16_t*)(ws + WS_ZVT), (bf16_t*)(ws + WS_Q), (bf16_t*)(ws + WS_K), (bf16_t*)(ws + WS_VT), (bf16_t*)(ws + WS_G)};
    const int ntn = INW / 32, ntiles = (NTOK / 32) * ntn;
    for (int t = bid * 8 + wave; t < ntiles; t += nblk * 8) sgemm_wave_tile((t / ntn) * 32, (t % ntn) * 32, 1024, ar, br, e, lane);
}
struct EpiCtxKV {
    const float* b_in; bf16_t *KC, *VCT;
    __device__ __forceinline__ void operator()(int r, int n, float v) const {
        v += b_in[3072 + n];
        if (n < 1024) KC[(size_t)r * 1024 + n] = (bf16_t)f2bf(v); else VCT[(size_t)(n - 1024) * NCTX + r] = (bf16_t)f2bf(v);
    }
};
__device__ __forceinline__ void phase_ctxkv_s(const P& p, int bid, int nblk) {
    const int tid_ = tid_opaque(); const int wave = tid_ >> 6, lane = tid_ & 63; unsigned char* ws = p.ws;
    ARowDense ar{(const bf16_t*)(ws + WS_UC), 1024}, br{(const bf16_t*)(ws + WS_WIN) + (size_t)3072 * 1024, 1024};
    EpiCtxKV e{p.b_in, (bf16_t*)(ws + WS_KC), (bf16_t*)(ws + WS_VCT)};
    const int ntn = 2048 / 32, ntiles = (NCTX / 32) * ntn;
    for (int t = bid * 8 + wave; t < ntiles; t += nblk * 8) sgemm_wave_tile((t / ntn) * 32, (t % ntn) * 32, 1024, ar, br, e, lane);
}
__device__ __forceinline__ void phase_rope_s(const P& p, int bid, int nblk) {
    bf16_t* K = (bf16_t*)(p.ws + WS_K); const float* tab = (const float*)(p.ws + WS_ROPE);
    const size_t total = (size_t)NTOK * NHEAD * 32;
    const int tid_ = tid_opaque();
    for (size_t i = (size_t)bid * 512 + tid_; i < total; i += (size_t)nblk * 512) {
        const int pi = (int)(i & 31), h = (int)((i >> 5) & 15), t = (int)(i >> 9);
        const int pos = t & 4095, axis = pi >> 4, fi = pi & 15, ps = axis ? (pos & 63) : (pos >> 6);
        const float cs = tab[2 * (ps * 16 + fi)], sn = tab[2 * (ps * 16 + fi) + 1];
        bf16_t* base = K + (size_t)t * 1024 + h * 64 + axis * 32 + fi;
        const float x1 = bf2f(base[0]), x2 = bf2f(base[16]);
        base[0] = (bf16_t)f2bf(x1 * cs - x2 * sn); base[16] = (bf16_t)f2bf(x2 * cs + x1 * sn);
    }
}
__device__ __forceinline__ void phase_zstat_s(const P& p, int bid, int nblk) {
    const bf16_t* ZVT = (const bf16_t*)(p.ws + WS_ZVT); float* zs = (float*)(p.ws + WS_ZSTAT);
    const int tid_ = tid_opaque();
    for (int t = bid * 512 + tid_; t < NTOK; t += nblk * 512) {
        float s = 0.f, s2 = 0.f;
        for (int c = 0; c < 1024; ++c) { const float v = bf2f(ZVT[(size_t)c * NTOK + t]); s += v; s2 += v * v; }
        const float mean = s * (1.f / 1024.f); const float var = fmaxf(s2 * (1.f / 1024.f) - mean * mean, 0.f);
        zs[2 * t] = mean; zs[2 * t + 1] = 1.f / sqrtf(var + LN_EPS);
    }
}
__device__ __forceinline__ void phase_gmlp_s(const P& p, int bid, int nblk, unsigned char* lds) {
    float* zvn = (float*)lds;
    float* wsm = zvn + 128 * 128;
    const bf16_t* ZVT = (const bf16_t*)(p.ws + WS_ZVT); const bf16_t* ZU = (const bf16_t*)(p.ws + WS_ZU); const float* zs = (const float*)(p.ws + WS_ZSTAT);
    bf16_t* YA = (bf16_t*)(p.ws + WS_U);
    const int tid = tid_opaque();
    for (int item = bid; item < (NTOK / 128) * 8; item += nblk) {
        const int chunk = item >> 3, g = item & 7, tok0 = chunk * 128;
        __syncthreads();
        for (int i = tid; i < 128 * 128; i += 512) { const int c = i >> 7, q = i & 127; const int ch = g * 128 + c;
            const float v = bf2f(ZVT[(size_t)ch * NTOK + tok0 + q]);
            zvn[q * 128 + c] = (v - zs[2 * (tok0 + q)]) * zs[2 * (tok0 + q) + 1] * p.gmlp_ln_g[ch] + p.gmlp_ln_b[ch];
            wsm[i] = p.gmlp_ws[g * 16384 + i]; }
        __syncthreads();
        const int c = tid & 127, pq = tid >> 7;
        for (int pp = 0; pp < 32; ++pp) { const int pr = pq * 32 + pp; float acc = 0.f;
            for (int q = 0; q < 128; ++q) acc += wsm[pr * 128 + q] * zvn[q * 128 + c];
            acc += p.gmlp_bs[g * 128 + pr];
            const size_t o = (size_t)(tok0 + pr) * 1024 + g * 128 + c;
            YA[o] = (bf16_t)f2bf(bf2f(ZU[o]) * acc); }
    }
}
__device__ __forceinline__ bf16x8 pack8(const float (&v)[8]) { u32x4 w; w.x = pk2(v[0], v[1]); w.y = pk2(v[2], v[3]); w.z = pk2(v[4], v[5]); w.w = pk2(v[6], v[7]); return __builtin_bit_cast(bf16x8, w); }
__device__ __forceinline__ void phase_gmlp_fast(const P& p, int bid, int nblk, unsigned char* lds) {
    const int tid = tid_opaque(), g = tid >> 6, lane = tid & 63, fr = lane & 15, fq = lane >> 4;
    float* part = (float*)lds;
    float* stat = part + 8 * 128 * 2;
    const bf16_t* ZVT = (const bf16_t*)(p.ws + WS_ZVT); const bf16_t* ZU = (const bf16_t*)(p.ws + WS_ZU); const bf16_t* WSB = (const bf16_t*)(p.ws + WS_WSB);
    bf16_t* YA = (bf16_t*)(p.ws + WS_U);
    for (int chunk = bid; chunk < NTOK / 128; chunk += nblk) {
        const int tok0 = chunk * 128;
        __syncthreads();
        { float s1[8], s2[8];
#pragma unroll
          for (int jj = 0; jj < 8; ++jj) { s1[jj] = 0.f; s2[jj] = 0.f; }
          const bf16_t* zp = ZVT + (((size_t)(tok0 >> 3) + fr) * 1024 + 128 * g + fq) * 8;
#pragma unroll 8
          for (int it = 0; it < 32; ++it) { const bf16x8 v = *(const bf16x8*)(zp + (4 * it) * 8);
#pragma unroll
              for (int jj = 0; jj < 8; ++jj) { const float f = bf2f((unsigned)(unsigned short)v[jj]); s1[jj] += f; s2[jj] += f * f; } }
#pragma unroll
          for (int jj = 0; jj < 8; ++jj) { s1[jj] += __shfl_xor(s1[jj], 16); s1[jj] += __shfl_xor(s1[jj], 32); s2[jj] += __shfl_xor(s2[jj], 16); s2[jj] += __shfl_xor(s2[jj], 32); }
          if (fq == 0) {
#pragma unroll
              for (int jj = 0; jj < 8; ++jj) { part[(g * 128 + 8 * fr + jj) * 2] = s1[jj]; part[(g * 128 + 8 * fr + jj) * 2 + 1] = s2[jj]; } } }
        __syncthreads();
        if (tid < 128) { float a = 0.f, b = 0.f;
#pragma unroll
            for (int w = 0; w < 8; ++w) { a += part[(w * 128 + tid) * 2]; b += part[(w * 128 + tid) * 2 + 1]; }
            const float mean = a * (1.f / 1024.f), var = fmaxf(b * (1.f / 1024.f) - mean * mean, 0.f);
            stat[2 * tid] = mean; stat[2 * tid + 1] = 1.f / sqrtf(var + LN_EPS); }
        __syncthreads();
#pragma unroll 1
        for (int ph = 0; ph < 2; ++ph) {
            bf16x8 wf[4][4]; float t1[4], t2[4], bsv[4];
#pragma unroll
            for (int pt = 0; pt < 4; ++pt) { const int pp = 64 * ph + 16 * pt + fr; float t1a = 0.f, t2a = 0.f;
                const __attribute__((address_space(3))) float* stat3 = (const __attribute__((address_space(3))) float*)((const __attribute__((address_space(3))) unsigned char*)lds + 8 * 128 * 2 * 4);
                int so = 16 * fq; asm volatile("" : "+v"(so));
#pragma unroll
                for (int ks = 0; ks < 4; ++ks) { const bf16x8 w = *(const bf16x8*)(WSB + ((size_t)g * 128 + pp) * 128 + 32 * ks + 8 * fq);
                    float wv[8];
#pragma unroll
                    for (int jj = 0; jj < 8; ++jj) { const float w0 = bf2f((unsigned)(unsigned short)w[jj]); t2a += w0; wv[jj] = w0 * stat3[so + 2 * (32 * ks + jj) + 1]; }
                    const bf16x8 wp = pack8(wv); wf[pt][ks] = wp;
#pragma unroll
                    for (int jj = 0; jj < 8; ++jj) t1a += bf2f((unsigned)(unsigned short)wp[jj]) * stat3[so + 2 * (32 * ks + jj)]; }
                t1a += __shfl_xor(t1a, 16); t1a += __shfl_xor(t1a, 32); t2a += __shfl_xor(t2a, 16); t2a += __shfl_xor(t2a, 32);
                t1[pt] = t1a; t2[pt] = t2a; bsv[pt] = p.gmlp_bs[g * 128 + pp]; }
#pragma unroll 1
            for (int ct = 0; ct < 8; ++ct) {
                bf16x8 af[4];
                const bf16_t* zp = ZVT + (((size_t)(tok0 >> 3) + fq) * 1024 + 128 * g + 16 * ct + fr) * 8;
#pragma unroll
                for (int ks = 0; ks < 4; ++ks) af[ks] = *(const bf16x8*)(zp + (size_t)ks * 4 * 1024 * 8);
                f32x4 acc[4];
#pragma unroll
                for (int pt = 0; pt < 4; ++pt) { acc[pt] = (f32x4){0.f, 0.f, 0.f, 0.f};
#pragma unroll
                    for (int ks = 0; ks < 4; ++ks) acc[pt] = __builtin_amdgcn_mfma_f32_16x16x32_bf16(af[ks], wf[pt][ks], acc[pt], 0, 0, 0); }
                const int c = 128 * g + 16 * ct + 4 * fq;
                const f32x4 gc = *(const f32x4*)(p.gmlp_ln_g + c), bc = *(const f32x4*)(p.gmlp_ln_b + c);
#pragma unroll
                for (int pt = 0; pt < 4; ++pt) { const size_t off = (size_t)(tok0 + 64 * ph + 16 * pt + fr) * 1024 + c;
                    const u32x2 zu = *(const u32x2*)(ZU + off);
                    const f32x4 s = gc * (acc[pt] - t1[pt]) + bc * t2[pt] + bsv[pt];
                    u32x2 w; w.x = pk2(bflo(zu.x) * s[0], bfhi(zu.x) * s[1]); w.y = pk2(bflo(zu.y) * s[2], bfhi(zu.y) * s[3]);
                    *(u32x2*)(YA + off) = w; }
            }
        }
    }
}
constexpr int AT_LDS_RPB = 0, AT_LDS_KC = 4096, AT_LDS_VC = AT_LDS_KC + 32768, AT_LDS_END = AT_LDS_VC + 32768;
typedef __attribute__((address_space(3))) const unsigned char* lds_cp;
__device__ __forceinline__ void attn_stage(const P& p, unsigned char* lds, int b, int h, int tid) {
    float* tbl = (float*)(lds + AT_LDS_RPB);
    for (int idx = tid; idx < 15 * 64; idx += 512) { const int dr = idx >> 6, cc = idx & 63; tbl[idx] = (cc >= 16 && cc < 47) ? p.na_rpb[(h * 15 + dr) * 31 + cc - 16] : 0.f; }
    const size_t bh = (size_t)b * 16 + h;
    const u32x4* kc = (const u32x4*)((const bf16_t*)(p.ws + WS_KC) + bh * 256 * 64); const u32x4* vc = (const u32x4*)((const bf16_t*)(p.ws + WS_VCT) + bh * 32 * 512);
#pragma unroll
    for (int i = 0; i < 4; ++i) { const int q = tid + 512 * i, key = q >> 3, c = q & 7; const int fk = ((key >> 1) & 1) | (((key >> 3) & 1) << 1) | (((key >> 4) & 1) << 2);
        *(u32x4*)(lds + AT_LDS_KC + key * 128 + ((c ^ fk) << 4)) = kc[q]; *(u32x4*)(lds + AT_LDS_VC + q * 16) = vc[q]; }
}
__device__ __forceinline__ void attn_wave_unit(const P& p, unsigned char* lds, int b, int r, int j, int h, int lane) {
    const int fr = lane & 15, fq = lane >> 4;
    const bf16_t* Q = (const bf16_t*)(p.ws + WS_Q); const bf16_t* K = (const bf16_t*)(p.ws + WS_K); const bf16_t* VT = (const bf16_t*)(p.ws + WS_VT);
    const float* tab = (const float*)(p.ws + WS_ROPE);
    bf16_t* YB = (bf16_t*)(p.ws + WS_YB);
    const int qc = 16 * j + fr; const size_t tq = (size_t)b * SEQ + r * 64 + qc; const size_t bh = (size_t)b * 16 + h;
    const int r0 = min(max(r - 4, 0), 56), c0 = min(max(qc - 8, 0), 48), cs = min(max(16 * j - 8, 0), 32);
    const int sp0 = 8 * (fr >> 2) + (fr & 3);
    const bf16_t* klat = K + (bh * 4096 + r0 * 64 + cs + sp0) * 64 + 8 * fq;
    const bf16_t* vlat = VT + ((bh * 512 + ((r0 * 64 + cs) >> 3) + fq) * 64 + fr) * 8;
    const int fk = ((fr >> 1) & 1) | (((fr >> 2) & 1) << 1) | (((fr >> 3) & 1) << 2);
    const lds_cp kcl = (lds_cp)lds + AT_LDS_KC + sp0 * 128;
    const int kco0 = (fq ^ fk) << 4, kco1 = ((fq + 4) ^ fk) << 4;
    const lds_cp vcl = (lds_cp)lds + AT_LDS_VC + (fq * 64 + fr) * 16;
    bf16x8 kf[2][2][2];
#define LOADK(buf, st_) do { _Pragma("unroll") for (int t = 0; t < 2; ++t) { \
        const bf16_t* kp_ = klat + (size_t)(st_) * 64 * 64 + t * 4 * 64; kf[buf][t][0] = *(const bf16x8*)kp_; kf[buf][t][1] = *(const bf16x8*)(kp_ + 32); } } while (0)
#define LOADKC(buf, st_) do { _Pragma("unroll") for (int t = 0; t < 2; ++t) { \
        const lds_cp kp_ = kcl + (32 * (st_) + 4 * t) * 128; kf[buf][t][0] = *(const __attribute__((address_space(3))) bf16x8*)(kp_ + kco0); kf[buf][t][1] = *(const __attribute__((address_space(3))) bf16x8*)(kp_ + kco1); } } while (0)
    LOADK(0, 0); LOADK(1, 1);
    bf16x8 qpl[2], qrt[2];
#pragma unroll
    for (int s = 0; s < 2; ++s) {
        const bf16_t* qb = Q + (bh * 4096 + r * 64 + qc) * 64 + 32 * s;
        const bf16x8 me = *(const bf16x8*)(qb + 8 * fq), ot = *(const bf16x8*)(qb + 8 * (fq ^ 2));
        qpl[s] = me;
        const int pos = s ? qc : r; const float* tb = tab + (pos * 16 + 8 * (fq & 1)) * 2;
        float rot[8];
#pragma unroll
        for (int jj = 0; jj < 8; ++jj) { const float cv = tb[2 * jj], sv = tb[2 * jj + 1];
            const float xv = bf2f((unsigned)(unsigned short)me[jj]), ov = bf2f((unsigned)(unsigned short)ot[jj]);
            rot[jj] = (fq < 2) ? (xv * cv - ov * sv) : (xv * cv + ov * sv); }
        qrt[s] = pack8(rot);
    }
    float sc[8][8];
    const __attribute__((address_space(3))) float* tbl3 = (const __attribute__((address_space(3))) float*)((lds_cp)lds + AT_LDS_RPB);
    const int boff0 = (r0 - r + 7) * 64 + (cs + 8 * fq - qc + 31);
#pragma unroll
    for (int st = 0; st < 8; ++st) {
        int boff = boff0 + st * 64; asm volatile("" : "+v"(boff));
#pragma unroll
        for (int t = 0; t < 2; ++t) {
            f32x4 d = __builtin_amdgcn_mfma_f32_16x16x32_bf16(kf[st & 1][t][0], qrt[0], (f32x4){0.f, 0.f, 0.f, 0.f}, 0, 0, 0);
            d = __builtin_amdgcn_mfma_f32_16x16x32_bf16(kf[st & 1][t][1], qrt[1], d, 0, 0, 0);
#pragma unroll
            for (int i = 0; i < 4; ++i) { const int kc = cs + 8 * fq + 4 * t + i; const bool valid = (kc >= c0) && (kc < c0 + 16);
                const float bias = tbl3[boff + 4 * t + i];
                sc[st][4 * t + i] = valid ? (d[i] * 0.125f + bias) : -INFINITY; } }
        if (st + 2 < 8) LOADK(st & 1, st + 2);
    }
    bf16x8 vf[2][4];
#define LOADV(buf, st_) do { _Pragma("unroll") for (int dt = 0; dt < 4; ++dt) vf[buf][dt] = *(const bf16x8*)(vlat + dt * 128 + (st_) * 8 * 512); } while (0)
#define LOADVC(buf, st_) do { _Pragma("unroll") for (int dt = 0; dt < 4; ++dt) vf[buf][dt] = *(const __attribute__((address_space(3))) bf16x8*)(vcl + (st_) * 4096 + dt * 256); } while (0)
    LOADV(0, 0); LOADV(1, 1);
    float m = -INFINITY;
#pragma unroll
    for (int st = 0; st < 8; ++st)
#pragma unroll
        for (int e = 0; e < 8; ++e) m = fmaxf(m, sc[st][e]);
    m = fmaxf(m, __shfl_xor(m, 16)); m = fmaxf(m, __shfl_xor(m, 32));
    float l = 0.f; f32x4 o[4];
#pragma unroll
    for (int dt = 0; dt < 4; ++dt) o[dt] = (f32x4){0.f, 0.f, 0.f, 0.f};
    const float ml2 = m * 1.4426950408889634f;
#pragma unroll
    for (int st = 0; st < 8; ++st) {
        float pv[8];
#pragma unroll
        for (int e = 0; e < 8; ++e) { pv[e] = __builtin_amdgcn_exp2f(sc[st][e] * 1.4426950408889634f - ml2); l += pv[e]; }
        const bf16x8 pf = pack8(pv);
#pragma unroll
        for (int dt = 0; dt < 4; ++dt) o[dt] = __builtin_amdgcn_mfma_f32_16x16x32_bf16(vf[st & 1][dt], pf, o[dt], 0, 0, 0);
        if (st + 2 < 8) LOADV(st & 1, st + 2);
    }
    LOADKC(0, 0);
#pragma unroll
    for (int st = 0; st < 8; ++st) {
        if (st + 1 < 8) LOADKC((st + 1) & 1, st + 1);
#pragma unroll
        for (int t = 0; t < 2; ++t) {
            f32x4 d = __builtin_amdgcn_mfma_f32_16x16x32_bf16(kf[st & 1][t][0], qpl[0], (f32x4){0.f, 0.f, 0.f, 0.f}, 0, 0, 0);
            d = __builtin_amdgcn_mfma_f32_16x16x32_bf16(kf[st & 1][t][1], qpl[1], d, 0, 0, 0);
#pragma unroll
            for (int i = 0; i < 4; ++i) sc[st][4 * t + i] = d[i] * 0.125f; }
    }
    float m2 = -INFINITY;
#pragma unroll
    for (int st = 0; st < 8; ++st)
#pragma unroll
        for (int e = 0; e < 8; ++e) m2 = fmaxf(m2, sc[st][e]);
    m2 = fmaxf(m2, __shfl_xor(m2, 16)); m2 = fmaxf(m2, __shfl_xor(m2, 32));
    const float mn = fmaxf(m, m2), al = __builtin_amdgcn_exp2f((m - mn) * 1.4426950408889634f), mnl2 = mn * 1.4426950408889634f;
    l *= al;
#pragma unroll
    for (int dt = 0; dt < 4; ++dt) o[dt] = o[dt] * al;
    LOADVC(0, 0);
#pragma unroll
    for (int st = 0; st < 8; ++st) {
        if (st + 1 < 8) LOADVC((st + 1) & 1, st + 1);
        float pv[8];
#pragma unroll
        for (int e = 0; e < 8; ++e) { pv[e] = __builtin_amdgcn_exp2f(sc[st][e] * 1.4426950408889634f - mnl2); l += pv[e]; }
        const bf16x8 pf = pack8(pv);
#pragma unroll
        for (int dt = 0; dt < 4; ++dt) o[dt] = __builtin_amdgcn_mfma_f32_16x16x32_bf16(vf[st & 1][dt], pf, o[dt], 0, 0, 0);
    }
#undef LOADK
#undef LOADKC
#undef LOADV
#undef LOADVC
    l += __shfl_xor(l, 16); l += __shfl_xor(l, 32);
    const float inv = 1.0f / l;
#pragma unroll
    for (int dt = 0; dt < 4; ++dt) { u32x2 w; w.x = pk2(o[dt][0] * inv, o[dt][1] * inv); w.y = pk2(o[dt][2] * inv, o[dt][3] * inv);
        *(u32x2*)(YB + tq * 1024 + h * 64 + 16 * dt + 4 * fq) = w; }
}
__device__ __forceinline__ void phase_attn_s(const P& p, int bid, int nblk, unsigned char* lds) {
    const int tid_ = tid_opaque(); const int wave = tid_ >> 6, lane = tid_ & 63;
    float* cscr = (float*)(lds + AT_LDS_END) + wave * (64 * 33 + 32);
    for (int vb = bid; vb < 256; vb += nblk) { const int half = vb & 1, h = (vb >> 1) & 15, b = vb >> 5;
        __syncthreads();
        attn_stage(p, lds, b, h, tid_);
        __syncthreads();
#pragma unroll 1
        for (int it = 0; it < 16; ++it) { int lane_o = lane; asm volatile("" : "+v"(lane_o));
            attn_wave_unit(p, lds, b, 32 * half + 2 * it + (wave >> 2), wave & 3, h, lane_o);
            const int gw = vb * 8 + wave;
            for (int k = it; k * 2048 + gw < IT_W1 + IT_W2; k += 16) convert_item(p, IT_EXP0 + k * 2048 + gw, cscr, lane_o); }
    }
}
struct EpiMergeA { const bf16_t* G; bf16_t* INNER;
    __device__ __forceinline__ void operator()(int r, int n, float v) const { INNER[(size_t)r * 1024 + n] = (bf16_t)f2bf(bf2f(G[(size_t)r * 2048 + n]) * v); } };
struct EpiMergeB { const bf16_t* G; bf16_t* INNER;
    __device__ __forceinline__ void operator()(int r, int n, float v) const { const size_t o = (size_t)r * 1024 + n; INNER[o] = (bf16_t)f2bf(bf2f(INNER[o]) + bf2f(G[(size_t)r * 2048 + 1024 + n]) * v); } };
template <int WHICH> __device__ __forceinline__ void phase_merge_s(const P& p, int bid, int nblk) {
    const int tid_ = tid_opaque(); const int wave = tid_ >> 6, lane = tid_ & 63; unsigned char* ws = p.ws;
    const int ntn = 1024 / 32, ntiles = (NTOK / 32) * ntn;
    if (WHICH == 0) { ARowDense ar{(const bf16_t*)(ws + WS_U), 1024}, br{(const bf16_t*)(ws + WS_WPA), 1024}; EpiMergeA e{(const bf16_t*)(ws + WS_G), (bf16_t*)(ws + WS_INNER)};
        for (int t = bid * 8 + wave; t < ntiles; t += nblk * 8) sgemm_wave_tile((t / ntn) * 32, (t % ntn) * 32, 1024, ar, br, e, lane);
    } else { ARowDense ar{(const bf16_t*)(ws + WS_YB), 1024}, br{(const bf16_t*)(ws + WS_WPB), 1024}; EpiMergeB e{(const bf16_t*)(ws + WS_G), (bf16_t*)(ws + WS_INNER)};
        for (int t = bid * 8 + wave; t < ntiles; t += nblk * 8) sgemm_wave_tile((t / ntn) * 32, (t % ntn) * 32, 1024, ar, br, e, lane); }
}
struct EpiMix { const float *x, *rowstat, *lng, *lnb, *mod, *b_out; float* out;
    __device__ __forceinline__ void operator()(int r, int n, float v) const {
        const int b = r >> 12; const float x0 = (x[(size_t)r * 1024 + n] - rowstat[2 * r]) * rowstat[2 * r + 1] * lng[n] + lnb[n];
        out[(size_t)r * 1024 + n] = ALPHA * x0 + mod[b * 6144 + 2048 + n] * (v + b_out[n]); } };
__device__ __forceinline__ void phase_mix_s(const P& p, int bid, int nblk) {
    const int tid_ = tid_opaque(); const int wave = tid_ >> 6, lane = tid_ & 63; unsigned char* ws = p.ws;
    const int ntn = 1024 / 32, ntiles = (NTOK / 32) * ntn;
    ARowDense ar{(const bf16_t*)(ws + WS_INNER), 1024}, br{(const bf16_t*)(ws + WS_WOUT), 1024};
    EpiMix e{p.x, (const float*)(ws + WS_ROWSTAT), p.ln_x_g, p.ln_x_b, (const float*)(ws + WS_MOD), p.b_out, p.out};
    for (int t = bid * 8 + wave; t < ntiles; t += nblk * 8) sgemm_wave_tile((t / ntn) * 32, (t % ntn) * 32, 1024, ar, br, e, lane);
}

constexpr int RT_LDS_W = 0, RT_LDS_CNT = 131072, RT_LDS_BASE = RT_LDS_CNT + 128, RT_LDS_REC = RT_LDS_BASE + 128, RT_MAXIT = 32, RT_LDS_END = RT_LDS_REC + 8 * RT_MAXIT * 8 * 4;
__device__ __forceinline__ int rw_off(int prow, int ch) { return prow * 128 + ((ch ^ ((prow >> 1) & 7)) << 4); }
__device__ __forceinline__ void phase_router(const P& p, int bid, int nblk, unsigned char* lds) {
    const int tid = tid_opaque(), wave = tid >> 6, lane = tid & 63;
    int* cnt = (int*)(lds + RT_LDS_CNT); int* base = (int*)(lds + RT_LDS_BASE); int* rec = (int*)(lds + RT_LDS_REC) + wave * RT_MAXIT * 8;
    for (int k = tid; k < 1024; k += 512) { const int l = (k & 255) >> 2, i = k & 3, j = k >> 8, prow = l + 64 * (4 * j + i);
        const f32x4* src = (const f32x4*)(p.router_w + (size_t)k * 32);
#pragma unroll
        for (int ch = 0; ch < 8; ++ch) *(f32x4*)(lds + RT_LDS_W + rw_off(prow, ch)) = src[ch]; }
    if (tid < 32) cnt[tid] = 0;
    __syncthreads();
    const float* mod = (const float*)(p.ws + WS_MOD);
    int* TOPE = (int*)(p.ws + WS_TOPE); float* TOPG = (float*)(p.ws + WS_TOPG); int* SLOT = (int*)(p.ws + WS_SLOT);
    bf16_t* U2 = (bf16_t*)(p.ws + WS_U);
    const int erev = 16 * ((lane >> 4) & 1) + (int)(__builtin_bitreverse32((unsigned)(lane & 15)) >> 28);
    unsigned wb[8];
#pragma unroll
    for (int ch = 0; ch < 8; ++ch) wb[ch] = RT_LDS_W + lane * 128 + ((ch ^ ((lane >> 1) & 7)) << 4);
    int it = 0;
    for (int row = bid * 8 + wave; row < NTOK; row += nblk * 8, ++it) {
        const int b = row >> 12;
        const u32x2* xin = (const u32x2*)((const bf16_t*)(p.ws + WS_X1PRE) + (size_t)row * DM) + lane; u32x2* xr = (u32x2*)((bf16_t*)(p.ws + WS_X1) + (size_t)row * DM) + lane;
        f32x4 v[4]; float s = 0.f;
#pragma unroll
        for (int j = 0; j < 4; ++j) { const u32x2 w = xin[64 * j]; v[j] = (f32x4){bflo(w.x), bfhi(w.x), bflo(w.y), bfhi(w.y)}; s += (v[j].x + v[j].y) + (v[j].z + v[j].w); }
        const float mean = wave_sum(s) * (1.f / DM); float s2 = 0.f;
#pragma unroll
        for (int j = 0; j < 4; ++j) { v[j] = v[j] - mean; s2 += (v[j].x * v[j].x + v[j].y * v[j].y) + (v[j].z * v[j].z + v[j].w * v[j].w); }
        const float rstd = 1.f / sqrtf(wave_sum(s2) * (1.f / DM) + LN_EPS);
        u32x2* o8 = (u32x2*)(U2 + (size_t)row * DM) + lane;
        int lane_o = lane; asm volatile("" : "+v"(lane_o));
        f32x4 u[4];
#pragma unroll
        for (int j = 0; j < 4; ++j) { const int col = 4 * lane_o + 256 * j;
            const f32x4 gg = *(const f32x4*)(p.ln1_g + col), bb = *(const f32x4*)(p.ln1_b + col);
            const f32x4 shv = *(const f32x4*)(mod + b * 6144 + 3072 + col), scv = *(const f32x4*)(mod + b * 6144 + 4096 + col);
            const f32x4 x1 = (v[j] * rstd) * gg + bb; { u32x2 w; w.x = pk2(x1.x, x1.y); w.y = pk2(x1.z, x1.w); xr[64 * j] = w; }
            u[j] = x1 * (1.0f + scv) + shv;
            u32x2 w; w.x = pk2(u[j].x, u[j].y); w.y = pk2(u[j].z, u[j].w); o8[64 * j] = w; }
        float lg2[2];
#pragma unroll
        for (int hf = 0; hf < 2; ++hf) {
            float a[16];
#pragma unroll
            for (int e = 0; e < 16; ++e) a[e] = 0.f;
#pragma unroll
            for (int j = 0; j < 4; ++j)
#pragma unroll
                for (int i = 0; i < 4; ++i) { const float uv = u[j][i];
#pragma unroll
                    for (int ch = 0; ch < 4; ++ch) { const f32x4 w4 = *(const f32x4*)(lds + wb[4 * hf + ch] + (4 * j + i) * 8192);
                        a[4 * ch + 0] += uv * w4.x; a[4 * ch + 1] += uv * w4.y; a[4 * ch + 2] += uv * w4.z; a[4 * ch + 3] += uv * w4.w; } }
#pragma unroll
            for (int st = 0; st < 4; ++st) { const int n = 8 >> st; const bool up = (lane >> st) & 1;
#pragma unroll
                for (int i = 0; i < n; ++i) { float lo = a[i], hi = a[n + i]; asm volatile("" : "+v"(lo), "+v"(hi));
                    const float keep = up ? hi : lo, send = up ? lo : hi; a[i] = keep + __shfl_xor(send, 1 << st); } }
            float r = a[0]; r += __shfl_xor(r, 16); r += __shfl_xor(r, 32); lg2[hf] = r;
        }
        float logit = ((lane >> 4) & 1) ? lg2[1] : lg2[0];
        logit += p.router_b[erev];
        float cur = logit;
#define TOP_STEP(TV, TE) float TV; int TE; { const float mx = wave_max(cur); int cand = (cur == mx) ? erev : 64; \
            cand = min(cand, __shfl_xor(cand, 1)); cand = min(cand, __shfl_xor(cand, 2)); cand = min(cand, __shfl_xor(cand, 4)); \
            cand = min(cand, __shfl_xor(cand, 8)); cand = min(cand, __shfl_xor(cand, 16)); cand = min(cand, __shfl_xor(cand, 32)); \
            TV = mx; TE = cand; if (erev == cand) cur = -INFINITY; }
        TOP_STEP(tv0, te0) TOP_STEP(tv1, te1) TOP_STEP(tv2, te2) TOP_STEP(tv3, te3)
#undef TOP_STEP
        const float gk0 = 1.0f, gk1 = __expf(tv1 - tv0), gk2 = __expf(tv2 - tv0), gk3 = __expf(tv3 - tv0);
        const float ginv = 1.f / (gk0 + gk1 + gk2 + gk3);
        if (lane < 4) { const int e = lane == 0 ? te0 : lane == 1 ? te1 : lane == 2 ? te2 : te3; const float g = lane == 0 ? gk0 : lane == 1 ? gk1 : lane == 2 ? gk2 : gk3;
            const int pos = atomicAdd(&cnt[e], 1);
            TOPE[row * 4 + lane] = e; TOPG[row * 4 + lane] = g * ginv;
            if (it < RT_MAXIT) { rec[it * 8 + lane * 2] = e; rec[it * 8 + lane * 2 + 1] = pos; } }
    }
    __syncthreads();
    if (tid < 32) base[tid] = atomicAdd((int*)(p.ws + WS_CTL) + tid, cnt[tid]);
    __syncthreads();
    it = 0;
    int* PERM2 = (int*)(p.ws + WS_PERM2);
    for (int row = bid * 8 + wave; row < NTOK; row += nblk * 8, ++it)
        if (lane < 4 && it < RT_MAXIT) { const int e = rec[it * 8 + lane * 2], pos = base[e] + rec[it * 8 + lane * 2 + 1]; SLOT[row * 4 + lane] = pos; PERM2[(size_t)e * NTOK + pos] = row; }
}
constexpr int MT_LDS = 131072 + 1024;
__device__ __forceinline__ void moe_tables(const P& p, unsigned char* lds) {
    const int tid = tid_opaque(); int* cn = (int*)(lds + MT_LDS); int* eb = cn + 32; int* tb = eb + 33;
    __syncthreads();
    if (tid < 32) cn[tid] = __hip_atomic_load((int*)(p.ws + WS_CTL) + tid, __ATOMIC_RELAXED, __HIP_MEMORY_SCOPE_AGENT);
    __syncthreads();
    if (tid == 0) { int s = 0, t = 0; for (int e = 0; e < 32; ++e) { eb[e] = s; tb[e] = t; s += cn[e]; t += (cn[e] + 255) >> 8; } eb[32] = s; tb[32] = t; }
    __syncthreads();
}
struct FinIdx { int e[4]; int pos[4]; float g[4]; };
struct FinData { u32x4 ys[2][4]; u32x4 x[2]; };
__device__ __forceinline__ void fin_load_idx(const P& p, int row, FinIdx& r) {
    const u32x4 ev = *(const u32x4*)((const int*)(p.ws + WS_TOPE) + row * 4), pv = *(const u32x4*)((const int*)(p.ws + WS_SLOT) + row * 4); const f32x4 gv = *(const f32x4*)((const float*)(p.ws + WS_TOPG) + row * 4);
#pragma unroll
    for (int k = 0; k < 4; ++k) { r.e[k] = (int)ev[k]; r.pos[k] = (int)pv[k]; r.g[k] = gv[k]; }
}
__device__ __forceinline__ void fin_load_data(const P& p, const int* eb, int row, const FinIdx& ix, FinData& d, int lane) {
    const bf16_t* YS = (const bf16_t*)(p.ws + WS_YS);
#pragma unroll
    for (int k = 0; k < 4; ++k) { const size_t slot = (size_t)(eb[ix.e[k]] + ix.pos[k]);
#pragma unroll
        for (int j = 0; j < 2; ++j) d.ys[j][k] = *(const u32x4*)(YS + slot * 1024 + 8 * lane + 512 * j); }
#pragma unroll
    for (int j = 0; j < 2; ++j) d.x[j] = *(const u32x4*)((const bf16_t*)(p.ws + WS_X1) + (size_t)row * DM + 8 * lane + 512 * j);
}
__device__ __forceinline__ void phase_final(const P& p, int bid, int nblk, unsigned char* lds) {
    moe_tables(p, lds); const int* eb = (const int*)(lds + MT_LDS) + 32;
    const int tid = tid_opaque(), wave = tid >> 6, lane = tid & 63;
    const float* mod = (const float*)(p.ws + WS_MOD);
    const int stride = nblk * 8;
    int row = bid * 8 + wave; if (row >= NTOK) return;
    FinIdx ic, in; FinData dc, dn;
    fin_load_idx(p, row, ic); fin_load_data(p, eb, row, ic, dc, lane);
    int row_n = row + stride; if (row_n < NTOK) fin_load_idx(p, row_n, in);
#pragma unroll 1
    for (;;) {
        if (row_n < NTOK) fin_load_data(p, eb, row_n, in, dn, lane);
        const int row_nn = row_n + stride; FinIdx inn; if (row_nn < NTOK) fin_load_idx(p, row_nn, inn);
        const int b = row >> 12;
        f32x4 v[2][2]; float s = 0.f;
#pragma unroll
        for (int j = 0; j < 2; ++j) { const int col = 8 * lane + 512 * j; f32x4 f0 = (f32x4){0.f, 0.f, 0.f, 0.f}, f1 = f0;
#pragma unroll
            for (int k = 0; k < 4; ++k) { const u32x4 w = dc.ys[j][k]; const float g = ic.g[k];
                f0.x += g * bflo(w.x); f0.y += g * bfhi(w.x); f0.z += g * bflo(w.y); f0.w += g * bfhi(w.y); f1.x += g * bflo(w.z); f1.y += g * bfhi(w.z); f1.z += g * bflo(w.w); f1.w += g * bfhi(w.w); }
            const f32x4 g20 = *(const f32x4*)(mod + b * 6144 + 5120 + col), g21 = *(const f32x4*)(mod + b * 6144 + 5120 + col + 4);
            const u32x4 xw = dc.x[j]; const f32x4 xa = (f32x4){bflo(xw.x), bfhi(xw.x), bflo(xw.y), bfhi(xw.y)}, xb = (f32x4){bflo(xw.z), bfhi(xw.z), bflo(xw.w), bfhi(xw.w)};
            v[j][0] = xa * ALPHA + g20 * f0; v[j][1] = xb * ALPHA + g21 * f1;
            s += ((v[j][0].x + v[j][0].y) + (v[j][0].z + v[j][0].w)) + ((v[j][1].x + v[j][1].y) + (v[j][1].z + v[j][1].w)); }
        const float mean = wave_sum(s) * (1.f / DM); float s2 = 0.f;
#pragma unroll
        for (int j = 0; j < 2; ++j)
#pragma unroll
            for (int q = 0; q < 2; ++q) { v[j][q] = v[j][q] - mean; s2 += (v[j][q].x * v[j][q].x + v[j][q].y * v[j][q].y) + (v[j][q].z * v[j][q].z + v[j][q].w * v[j][q].w); }
        const float rstd = 1.f / sqrtf(wave_sum(s2) * (1.f / DM) + LN_EPS);
#pragma unroll
        for (int j = 0; j < 2; ++j) { const int col = 8 * lane + 512 * j; f32x4* xo = (f32x4*)(p.out + (size_t)row * DM + col);
#pragma unroll
            for (int q = 0; q < 2; ++q) { const f32x4 gg = *(const f32x4*)(p.ln2_g + col + 4 * q), bb = *(const f32x4*)(p.ln2_b + col + 4 * q); xo[q] = (v[j][q] * rstd) * gg + bb; } }
        if (row_n >= NTOK) break;
        row = row_n; row_n = row_nn; ic = in; in = inn; dc = dn;
    }
}

namespace pg {
#define PG_LAS __attribute__((address_space(3)))
typedef float f32x2 __attribute__((ext_vector_type(2)));
constexpr int BM = 256, BK = 64, HALF = 128, HTB = HALF * BK * 2, STAGE_BYTES = 8 * HTB, KD = 1024, NT = KD / BK;
constexpr unsigned KSTEP = BK * 2, HSTEPB = HALF * KD * 2;
__host__ __device__ __forceinline__ int lds_byte(int r, int c) { const int st = (r >> 4) * 2 + (c >> 5), rr = r & 15, cc = c & 31, ob = rr * 64 + cc * 2; return st * 1024 + (ob ^ (((ob >> 9) & 1) << 5)); }
__host__ __device__ __forceinline__ void stage_rc(int b, int& R, int& C) { const int st = b / 1024, sb = b % 1024, swz = sb ^ (((sb >> 9) & 1) << 5); R = (st >> 1) * 16 + swz / 64; C = (st & 1) * 32 + (swz % 64) / 2; }
__host__ __device__ __forceinline__ int perm32(int rho) { const int n = rho >> 4, i = rho & 15; return 8 * (i >> 2) + 4 * n + (i & 3); }
struct Unit { int pm, pn, row0, nrows, e, kind; };
__device__ __forceinline__ void tilemap(int L, int nM, int nN, int& pm, int& pn) {
    int wgid = L; { const int nwg = nM * nN, q = nwg / 8, r = nwg % 8, xcd = wgid % 8, off = wgid / 8; wgid = (xcd < r ? xcd * (q + 1) : r * (q + 1) + (xcd - r) * q) + off; }
    const int nig = 8 * nN, gid = wgid / nig, fm = gid * 8, gsz = (nM - fm) < 8 ? (nM - fm) : 8;
    pm = fm + ((wgid % nig) % gsz); pn = (wgid % nig) / gsz;
}
__device__ __forceinline__ unsigned cvt_pk_bf16(float lo, float hi) { unsigned r; asm volatile("v_cvt_pk_bf16_f32 %0, %1, %2" : "=v"(r) : "v"(lo), "v"(hi)); return r; }
__device__ __forceinline__ f32x2 gelu_pk(f32x2 v) {
    const f32x2 av = __builtin_elementwise_abs(v), d = av * 0.2316418882f + 1.0f;
    f32x2 t; t.x = __builtin_amdgcn_rcpf(d.x); t.y = __builtin_amdgcn_rcpf(d.y);
    f32x2 q = t * 0.5307027145f + (-0.7265760135f); q = q * t + 0.7107068705f; q = q * t + (-0.142248368f); q = q * t + 0.127414796f; q = q * t;
    const f32x2 s = (v * v) * (-0.72134752044f);
    f32x2 e; e.x = __builtin_amdgcn_exp2f(s.x); e.y = __builtin_amdgcn_exp2f(s.y);
    const f32x2 m = v * (q * e), r = v - m;
    f32x2 o; o.x = v.x < 0.f ? m.x : r.x; o.y = v.y < 0.f ? m.y : r.y; return o;
}
__device__ __forceinline__ f32x4 gelu4(f32x4 v) { const f32x2 a = gelu_pk((f32x2){v[0], v[1]}), b = gelu_pk((f32x2){v[2], v[3]}); return (f32x4){a.x, a.y, b.x, b.y}; }
__device__ __forceinline__ f32x4 sigmoid4(f32x4 v) { f32x4 o;
#pragma unroll
    for (int i = 0; i < 4; ++i) o[i] = __builtin_amdgcn_rcpf(1.0f + __builtin_amdgcn_exp2f(-1.4426950408889634f * v[i]));
    return o; }
__device__ __forceinline__ u32x4 pack8v(f32x4 a, f32x4 b) { u32x4 w; w.x = cvt_pk_bf16(a[0], a[1]); w.y = cvt_pk_bf16(a[2], a[3]); w.z = cvt_pk_bf16(b[0], b[1]); w.w = cvt_pk_bf16(b[2], b[3]); return w; }

template <class Epi, class Sched, bool ALIGN_EPI>
__device__ __forceinline__ void gemm_phase(PG_LAS unsigned char* lds, const unsigned char* Abase, const Sched& S, const Epi& E) {
    const int tid = tid_opaque(), wid = __builtin_amdgcn_readfirstlane(tid >> 6), lane = tid & 63, wr = wid >> 2, wc = wid & 3, fr = lane & 15, fq = lane >> 4;
    int R[2], C[2]; unsigned voffB[2];
#pragma unroll
    for (int i = 0; i < 2; ++i) { stage_rc(tid * 16 + i * 8192, R[i], C[i]); const int Rb = Epi::PERM ? ((R[i] & ~31) + perm32(R[i] & 31)) : R[i]; voffB[i] = (unsigned)(Rb * KD + C[i]) * 2u; }
    const unsigned ldsw = (unsigned)wid * 1024u;
    const int aoff = lds_byte(wr * 64 + fr, fq * 8), boff = lds_byte(wc * 32 + fr, fq * 8);
#define PG_SA(b, h) (((b) * 2 + (h)) * HTB)
#define PG_SB(b, h) ((4 + (b) * 2 + (h)) * HTB)
#define PG_STAGE_A(bufoff, kbyte, vo) do { _Pragma("unroll") for (int _i = 0; _i < 2; ++_i) \
        __builtin_amdgcn_global_load_lds((const unsigned*)((const char*)Abase + (kbyte) + (vo)[_i]), (PG_LAS unsigned*)(lds + (bufoff) + ldsw + _i * 8192), 16, 0, 0); } while (0)
#define PG_STAGE_B(bufoff, gbase) do { _Pragma("unroll") for (int _i = 0; _i < 2; ++_i) \
        __builtin_amdgcn_global_load_lds((const unsigned*)((const char*)(gbase) + voffB[_i]), (PG_LAS unsigned*)(lds + (bufoff) + ldsw + _i * 8192), 16, 0, 0); } while (0)
#define PG_LDA(dst, b, h) do { _Pragma("unroll") for (int m = 0; m < 4; ++m) _Pragma("unroll") for (int k = 0; k < 2; ++k) dst[m][k] = *(const PG_LAS bf16x8*)(lds + PG_SA(b, h) + aoff + m * 2048 + k * 1024); } while (0)
#define PG_LDB(dst, b, h) do { _Pragma("unroll") for (int n = 0; n < 2; ++n) _Pragma("unroll") for (int k = 0; k < 2; ++k) dst[n][k] = *(const PG_LAS bf16x8*)(lds + PG_SB(b, h) + boff + n * 2048 + k * 1024); } while (0)
#define PG_MMA(ai, bj, At, Bt) do { __builtin_amdgcn_s_setprio(1); _Pragma("unroll") for (int m = 0; m < 4; ++m) _Pragma("unroll") for (int n = 0; n < 2; ++n) _Pragma("unroll") for (int k = 0; k < 2; ++k) \
        acc[ai][bj][m][n] = __builtin_amdgcn_mfma_f32_16x16x32_bf16(Bt[n][k], At[m][k], acc[ai][bj][m][n], 0, 0, 0); __builtin_amdgcn_s_setprio(0); } while (0)
#define PG_WAIT_V(n) asm volatile("s_waitcnt vmcnt(" #n ")" ::: "memory")
#define PG_WAIT_L(n) asm volatile("s_waitcnt lgkmcnt(" #n ")" ::: "memory")
#define PG_BAR __builtin_amdgcn_s_barrier()
#define PG_SCHED __builtin_amdgcn_sched_barrier(0)
    Unit cur, nxt; int ui = 0;
    if (!S.next(0, cur)) return;
    f32x4 acc[2][2][4][2];
#pragma unroll
    for (int a = 0; a < 2; ++a)
#pragma unroll
        for (int b = 0; b < 2; ++b)
#pragma unroll
            for (int m = 0; m < 4; ++m)
#pragma unroll
                for (int n = 0; n < 2; ++n) acc[a][b][m][n] = (f32x4){0.f, 0.f, 0.f, 0.f};
    bf16x8 At[4][2], B0[2][2], B1[2][2];
    unsigned ac[2][2], an[2][2];
    S.aoffs(cur, R, C, ac);
    const char* cB = S.bptr(cur);
    PG_STAGE_B(PG_SB(0, 0), cB); PG_STAGE_B(PG_SB(0, 1), cB + HSTEPB); PG_STAGE_A(PG_SA(0, 0), 0u, ac[0]); PG_STAGE_A(PG_SA(0, 1), 0u, ac[1]);
    if (wr == 1) PG_BAR;
    PG_WAIT_V(2); PG_BAR;
    PG_STAGE_B(PG_SB(1, 0), cB + KSTEP); PG_STAGE_A(PG_SA(1, 0), KSTEP, ac[0]); PG_STAGE_B(PG_SB(1, 1), cB + HSTEPB + KSTEP);
    PG_WAIT_V(6); PG_BAR;
    for (;;) {
        const bool has_next = S.next(ui + 1, nxt);
        const char* nB = cB;
        if (has_next) { S.aoffs(nxt, R, C, an); nB = S.bptr(nxt); }
        else {
#pragma unroll
            for (int h = 0; h < 2; ++h)
#pragma unroll
                for (int i = 0; i < 2; ++i) an[h][i] = ac[h][i]; }
        for (int t = 0; t < NT; t += 2) {
            const bool last = (t == NT - 2);
            const unsigned ka1 = (unsigned)(t + 1) * KSTEP;
            const unsigned ka2 = last ? 0u : (unsigned)(t + 2) * KSTEP;
            const char* b2 = last ? nB : cB + (size_t)(t + 2) * KSTEP; const char* b3 = b2 + KSTEP;
            unsigned a2o[2][2];
#pragma unroll
            for (int h = 0; h < 2; ++h)
#pragma unroll
                for (int i = 0; i < 2; ++i) a2o[h][i] = last ? an[h][i] : ac[h][i];
            PG_LDB(B0, 0, 0); PG_LDB(B1, 0, 1); PG_SCHED; PG_LDA(At, 0, 0); PG_STAGE_A(PG_SA(1, 1), ka1, ac[1]);
            PG_WAIT_V(8); PG_WAIT_L(0); PG_BAR; PG_MMA(0, 0, At, B0); PG_MMA(0, 1, At, B1); PG_BAR; PG_SCHED;
            PG_LDA(At, 0, 1); PG_STAGE_B(PG_SB(0, 0), b2); PG_STAGE_B(PG_SB(0, 1), b2 + HSTEPB); PG_STAGE_A(PG_SA(0, 0), ka2, a2o[0]);
            PG_WAIT_V(8); PG_WAIT_L(0); PG_BAR; PG_MMA(1, 0, At, B0); PG_MMA(1, 1, At, B1); PG_BAR; PG_SCHED;
            PG_LDB(B0, 1, 0); PG_LDB(B1, 1, 1); PG_SCHED; PG_LDA(At, 1, 0); PG_STAGE_A(PG_SA(0, 1), ka2, a2o[1]);
            PG_WAIT_V(8); PG_WAIT_L(0); PG_BAR; PG_MMA(0, 0, At, B0); PG_MMA(0, 1, At, B1); PG_BAR; PG_SCHED;
            PG_LDA(At, 1, 1); PG_STAGE_B(PG_SB(1, 0), b3); PG_STAGE_B(PG_SB(1, 1), b3 + HSTEPB); PG_STAGE_A(PG_SA(1, 0), ka2 + KSTEP, a2o[0]);
            PG_WAIT_V(8); PG_WAIT_L(0); PG_BAR; PG_MMA(1, 0, At, B0); PG_MMA(1, 1, At, B1); PG_BAR; PG_SCHED;
        }
        if constexpr (ALIGN_EPI) { if (wr == 0) PG_BAR; }
        E.run(acc, cur, wr, wc, fr, fq);
        if (!has_next) break;
        if (!E.carry(cur)) {
#pragma unroll
            for (int a = 0; a < 2; ++a)
#pragma unroll
                for (int b = 0; b < 2; ++b)
#pragma unroll
                    for (int m = 0; m < 4; ++m)
#pragma unroll
                        for (int n = 0; n < 2; ++n) acc[a][b][m][n] = (f32x4){0.f, 0.f, 0.f, 0.f}; }
        cur = nxt; cB = nB; ++ui;
#pragma unroll
        for (int h = 0; h < 2; ++h)
#pragma unroll
            for (int i = 0; i < 2; ++i) ac[h][i] = an[h][i];
        if constexpr (ALIGN_EPI) { if (wr == 1) PG_BAR; }
    }
    PG_WAIT_V(0);
    if constexpr (!ALIGN_EPI) { if (wr == 0) PG_BAR; }
    PG_BAR;
#undef PG_SA
#undef PG_SB
#undef PG_STAGE_A
#undef PG_STAGE_B
#undef PG_LDA
#undef PG_LDB
#undef PG_MMA
#undef PG_WAIT_V
#undef PG_WAIT_L
#undef PG_BAR
#undef PG_SCHED
}

struct SchedP1 {
    int G, c; const unsigned char* ws;
    __device__ __forceinline__ bool next(int i, Unit& u) const {
        const int L = i * G + c; if (L >= 3136) return false;
        u.row0 = 0; u.nrows = 256; u.e = 0;
        if (L < 2048) { u.kind = 0; tilemap(L, 128, 16, u.pm, u.pn); }
        else if (L < 3072) { u.kind = 1; tilemap(L - 2048, 8, 128, u.pm, u.pn); }
        else if (L < 3104) { u.kind = 2; const int l = L - 3072; u.pm = l >> 2; u.pn = l & 3; }
        else { u.kind = 3; const int l = L - 3104; u.pm = l >> 3; u.pn = l & 7; }
        return true; }
    __device__ __forceinline__ void aoffs(const Unit& u, const int (&R)[2], const int (&C)[2], unsigned (&o)[2][2]) const {
        size_t base; int row0;
        if (u.kind == 0) { base = WS_U; row0 = 256 * u.pm; }
        else if (u.kind == 1) { base = WS_WIN; row0 = u.pm < 4 ? 1024 + 256 * u.pm : 4096 + 256 * (u.pm - 4); }
        else if (u.kind == 2) { base = WS_UC; row0 = 256 * u.pm; }
        else { base = WS_WIN; row0 = 4096 + 256 * u.pm; }
#pragma unroll
        for (int h = 0; h < 2; ++h)
#pragma unroll
            for (int i = 0; i < 2; ++i) o[h][i] = (unsigned)(base + ((size_t)(row0 + 128 * h + R[i]) * 1024 + C[i]) * 2); }
    __device__ __forceinline__ const char* bptr(const Unit& u) const {
        if (u.kind == 0) { const int wrow = u.pn < 4 ? 256 * u.pn : (u.pn < 8 ? 2048 + 256 * (u.pn - 4) : 5120 + 256 * (u.pn - 8)); return (const char*)ws + WS_WIN + (size_t)wrow * 2048; }
        if (u.kind == 1) return (const char*)ws + WS_U + (size_t)u.pn * 256 * 2048;
        if (u.kind == 2) return (const char*)ws + WS_WIN + (size_t)(3072 + 256 * u.pn) * 2048;
        return (const char*)ws + WS_UC + (size_t)u.pn * 256 * 2048; }
};
struct EpiP1 {
    static constexpr bool PERM = true;
    unsigned char* ws; const float* b_in;
    __device__ __forceinline__ bool carry(const Unit&) const { return false; }
    __device__ __forceinline__ void run(f32x4 (&acc)[2][2][4][2], const Unit& u, int wr, int wc, int fr, int fq) const {
        const int lc = wc * 32 + 8 * fq, kind = u.kind, pm = u.pm, pn = u.pn;
        const bool brow = (kind == 1) || (kind == 3);
        int act, bcol, browbase, RA, RB, CA, CB; size_t base;
        if (kind == 0) { browbase = 0;
            if (pn < 4) { act = 1; bcol = 256 * pn; base = WS_ZU / 2 + (size_t)256 * pm * 1024 + 256 * pn; RA = 65536; RB = 1024; CA = 64; CB = 1; }
            else if (pn < 8) { act = 0; bcol = 2048 + 256 * (pn - 4); const int tok0 = 256 * pm;
                base = WS_Q / 2 + ((size_t)((tok0 >> 12) * 16 + 4 * (pn - 4)) * 4096 + (tok0 & 4095)) * 64; RA = 4096; RB = 64; CA = 4096 * 64; CB = 1; }
            else { act = 2; bcol = 5120 + 256 * (pn - 8); base = WS_G / 2 + (size_t)256 * pm * 2048 + 256 * (pn - 8); RA = 131072; RB = 2048; CA = 64; CB = 1; } }
        else if (kind == 1) { bcol = 0; const int tk0 = 256 * pn;
            if (pm < 4) { act = 1; browbase = 1024 + 256 * pm; base = WS_ZVT / 2 + (size_t)(tk0 >> 3) * 8192 + 256 * pm * 8; RA = 512; RB = 8; CA = 65536; CB = 1024; }
            else { act = 0; browbase = 4096 + 256 * (pm - 4); base = WS_VT / 2 + ((size_t)((tk0 >> 12) * 16 + 4 * (pm - 4)) * 512 + ((tk0 & 4095) >> 3)) * 512; RA = 512 * 512; RB = 8; CA = 4096; CB = 64; } }
        else if (kind == 2) { act = 0; bcol = 3072 + 256 * pn; browbase = 0; base = WS_KC / 2 + (size_t)(pm * 16 + 4 * pn) * 256 * 64; RA = 4096; RB = 64; CA = 16384; CB = 1; }
        else { act = 0; bcol = 0; browbase = 4096 + 256 * pm; base = WS_VCT / 2 + (size_t)(pn * 16 + 4 * pm) * 32 * 512; RA = 32 * 512; RB = 8; CA = 4096; CB = 64; }
        bf16_t* dbase = (bf16_t*)ws + base;
        f32x4 bv[2][2];
#pragma unroll
        for (int bj = 0; bj < 2; ++bj)
#pragma unroll
            for (int n = 0; n < 2; ++n) bv[bj][n] = brow ? (f32x4){0.f, 0.f, 0.f, 0.f} : *(const f32x4*)(b_in + bcol + lc + bj * HALF + 4 * n);
        const int colterm0 = (wc >> 1) * CA + ((wc & 1) * 32 + 8 * fq) * CB;
#pragma unroll
        for (int ai = 0; ai < 2; ++ai)
#pragma unroll
            for (int m = 0; m < 4; ++m) { const int row = ai * HALF + wr * 64 + m * 16 + fr;
                const float rb = brow ? b_in[browbase + row] : 0.f;
                const int rowterm = (2 * ai + wr) * RA + (16 * m + fr) * RB;
#pragma unroll
                for (int bj = 0; bj < 2; ++bj) {
                    f32x4 v0 = acc[ai][bj][m][0] + bv[bj][0] + rb, v1 = acc[ai][bj][m][1] + bv[bj][1] + rb;
                    if (act == 1) { v0 = gelu4(v0); v1 = gelu4(v1); } else if (act == 2) { v0 = sigmoid4(v0); v1 = sigmoid4(v1); }
                    *(u32x4*)(dbase + rowterm + colterm0 + 2 * bj * CA) = pack8v(v0, v1); } }
    }
};
struct SchedK {
    int G, c; const unsigned char* ws;
    __device__ __forceinline__ bool next(int i, Unit& u) const { const int L = i * G + c; if (L >= 512) return false; u.kind = 0; u.row0 = 0; u.nrows = 256; u.e = 0; tilemap(L, 128, 4, u.pm, u.pn); return true; }
    __device__ __forceinline__ void aoffs(const Unit& u, const int (&R)[2], const int (&C)[2], unsigned (&o)[2][2]) const {
#pragma unroll
        for (int h = 0; h < 2; ++h)
#pragma unroll
            for (int i = 0; i < 2; ++i) o[h][i] = (unsigned)(WS_U + ((size_t)(256 * u.pm + 128 * h + R[i]) * 1024 + C[i]) * 2); }
    __device__ __forceinline__ const char* bptr(const Unit& u) const { return (const char*)ws + WS_WIN + (size_t)(3072 + 256 * u.pn) * 2048; }
};
struct EpiRope {
    static constexpr bool PERM = false;
    unsigned char* ws; const float* b_in;
    __device__ __forceinline__ bool carry(const Unit&) const { return false; }
    __device__ __forceinline__ void run(f32x4 (&acc)[2][2][4][2], const Unit& u, int wr, int wc, int fr, int fq) const {
        bf16_t* K = (bf16_t*)(ws + WS_K); const float* tab = (const float*)(ws + WS_ROPE);
        const int lc = wc * 32 + 4 * fq, axis = wc & 1;
        f32x4 b0[2], b1[2];
#pragma unroll
        for (int bj = 0; bj < 2; ++bj) { b0[bj] = *(const f32x4*)(b_in + 3072 + 256 * u.pn + bj * HALF + lc); b1[bj] = *(const f32x4*)(b_in + 3072 + 256 * u.pn + bj * HALF + lc + 16); }
#pragma unroll
        for (int ai = 0; ai < 2; ++ai)
#pragma unroll
            for (int m = 0; m < 4; ++m) { const int tok = 256 * u.pm + ai * HALF + wr * 64 + m * 16 + fr;
                const int pos = axis ? (tok & 63) : ((tok >> 6) & 63);
                const f32x4 t0 = *(const f32x4*)(tab + (pos * 16 + 4 * fq) * 2), t1 = *(const f32x4*)(tab + (pos * 16 + 4 * fq) * 2 + 4);
                const f32x4 cs = (f32x4){t0[0], t0[2], t1[0], t1[2]}, sn = (f32x4){t0[1], t0[3], t1[1], t1[3]};
                const int cc0 = 256 * u.pn + lc;
                bf16_t* rowp = K + ((size_t)((tok >> 12) * 16) * 4096 + (tok & 4095)) * 64;
#pragma unroll
                for (int bj = 0; bj < 2; ++bj) { const f32x4 v0 = acc[ai][bj][m][0] + b0[bj], v1 = acc[ai][bj][m][1] + b1[bj];
                    const f32x4 o0 = v0 * cs - v1 * sn, o1 = v1 * cs + v0 * sn;
                    u32x2 w0, w1; w0.x = cvt_pk_bf16(o0[0], o0[1]); w0.y = cvt_pk_bf16(o0[2], o0[3]); w1.x = cvt_pk_bf16(o1[0], o1[1]); w1.y = cvt_pk_bf16(o1[2], o1[3]);
                    const int cc = cc0 + bj * HALF; bf16_t* dp = rowp + (size_t)(cc >> 6) * 4096 * 64 + (cc & 63);
                    *(u32x2*)dp = w0; *(u32x2*)(dp + 16) = w1; } }
    }
};
struct SchedMerge {
    int G, c; const unsigned char* ws;
    __device__ __forceinline__ bool next(int i, Unit& u) const { const int L = (i >> 1) * G + c; if (L >= 512) return false; u.kind = i & 1; u.row0 = 0; u.nrows = 256; u.e = 0; tilemap(L, 128, 4, u.pm, u.pn); return true; }
    __device__ __forceinline__ void aoffs(const Unit& u, const int (&R)[2], const int (&C)[2], unsigned (&o)[2][2]) const {
        const size_t base = u.kind ? WS_YB : WS_U;
#pragma unroll
        for (int h = 0; h < 2; ++h)
#pragma unroll
            for (int i = 0; i < 2; ++i) o[h][i] = (unsigned)(base + ((size_t)(256 * u.pm + 128 * h + R[i]) * 1024 + C[i]) * 2); }
    __device__ __forceinline__ const char* bptr(const Unit& u) const { return (const char*)ws + (u.kind ? WS_WPB : WS_WPA) + (size_t)u.pn * 256 * 2048; }
};
struct EpiMerge {
    static constexpr bool PERM = true;
    unsigned char* ws;
    __device__ __forceinline__ bool carry(const Unit& u) const { return u.kind == 0; }
    __device__ __forceinline__ void run(f32x4 (&acc)[2][2][4][2], const Unit& u, int wr, int wc, int fr, int fq) const {
        const bf16_t* Gt = (const bf16_t*)(ws + WS_G); bf16_t* INNER = (bf16_t*)(ws + WS_INNER);
        const int lc = 256 * u.pn + wc * 32 + 8 * fq;
#pragma unroll
        for (int ai = 0; ai < 2; ++ai)
#pragma unroll
            for (int m = 0; m < 4; ++m) { const size_t tok = (size_t)(256 * u.pm + ai * HALF + wr * 64 + m * 16 + fr);
#pragma unroll
                for (int bj = 0; bj < 2; ++bj) { const int col = lc + bj * HALF;
                    const u32x4 gbw = *(const u32x4*)(Gt + tok * 2048 + 1024 + col);
                    f32x4 gb0 = (f32x4){bflo(gbw.x), bfhi(gbw.x), bflo(gbw.y), bfhi(gbw.y)}, gb1 = (f32x4){bflo(gbw.z), bfhi(gbw.z), bflo(gbw.w), bfhi(gbw.w)};
                    if (u.kind == 0) { const u32x4 gaw = *(const u32x4*)(Gt + tok * 2048 + col);
                        const f32x4 ga0 = (f32x4){bflo(gaw.x), bfhi(gaw.x), bflo(gaw.y), bfhi(gaw.y)}, ga1 = (f32x4){bflo(gaw.z), bfhi(gaw.z), bflo(gaw.w), bfhi(gaw.w)};
#pragma unroll
                        for (int i = 0; i < 4; ++i) { acc[ai][bj][m][0][i] *= ga0[i] * __builtin_amdgcn_rcpf(fmaxf(gb0[i], 1e-30f)); acc[ai][bj][m][1][i] *= ga1[i] * __builtin_amdgcn_rcpf(fmaxf(gb1[i], 1e-30f)); }
                    } else { *(u32x4*)(INNER + tok * 1024 + col) = pack8v(acc[ai][bj][m][0] * gb0, acc[ai][bj][m][1] * gb1); } } }
    }
};
struct SchedMix {
    int G, c; const unsigned char* ws;
    __device__ __forceinline__ bool next(int i, Unit& u) const { const int L = i * G + c; if (L >= 512) return false; u.kind = 0; u.row0 = 0; u.nrows = 256; u.e = 0; tilemap(L, 128, 4, u.pm, u.pn); return true; }
    __device__ __forceinline__ void aoffs(const Unit& u, const int (&R)[2], const int (&C)[2], unsigned (&o)[2][2]) const {
#pragma unroll
        for (int h = 0; h < 2; ++h)
#pragma unroll
            for (int i = 0; i < 2; ++i) o[h][i] = (unsigned)(WS_INNER + ((size_t)(256 * u.pm + 128 * h + R[i]) * 1024 + C[i]) * 2); }
    __device__ __forceinline__ const char* bptr(const Unit& u) const { return (const char*)ws + WS_WOUT + (size_t)u.pn * 256 * 2048; }
};
struct EpiMix {
    static constexpr bool PERM = false;
    unsigned char* ws; const float *x, *lng, *lnb, *b_out; float* out;
    __device__ __forceinline__ bool carry(const Unit&) const { return false; }
    __device__ __forceinline__ void run(f32x4 (&acc)[2][2][4][2], const Unit& u, int wr, int wc, int fr, int fq) const {
        const float* rowstat = (const float*)(ws + WS_ROWSTAT); const float* mod = (const float*)(ws + WS_MOD) + ((256 * u.pm) >> 12) * 6144 + 2048;
        f32x2 st[2][4];
#pragma unroll
        for (int ai = 0; ai < 2; ++ai)
#pragma unroll
            for (int m = 0; m < 4; ++m) st[ai][m] = *(const f32x2*)(rowstat + 2 * (256 * u.pm + ai * HALF + wr * 64 + m * 16 + fr));
#pragma unroll
        for (int bj = 0; bj < 2; ++bj)
#pragma unroll
            for (int n = 0; n < 2; ++n) { const int col = 256 * u.pn + bj * HALF + wc * 32 + n * 16 + 4 * fq;
                const f32x4 lg = *(const f32x4*)(lng + col), lb = *(const f32x4*)(lnb + col), bo = *(const f32x4*)(b_out + col), g1 = *(const f32x4*)(mod + col);
#pragma unroll
                for (int ai = 0; ai < 2; ++ai)
#pragma unroll
                    for (int m = 0; m < 4; ++m) { const size_t off = (size_t)(256 * u.pm + ai * HALF + wr * 64 + m * 16 + fr) * 1024 + col;
                        const f32x4 xv = *(const f32x4*)(x + off);
                        const f32x4 x0 = (xv - st[ai][m].x) * st[ai][m].y * lg + lb;
                        const f32x4 r = x0 * ALPHA + g1 * (acc[ai][bj][m][n] + bo); u32x2 w; w.x = cvt_pk_bf16(r[0], r[1]); w.y = cvt_pk_bf16(r[2], r[3]);
                        *(u32x2*)((bf16_t*)(ws + WS_X1PRE) + off) = w; }
                asm volatile("" ::: "memory"); }
    }
};
__device__ __forceinline__ int ld_u(const int* p) { return __builtin_amdgcn_readfirstlane(__hip_atomic_load(p, __ATOMIC_RELAXED, __HIP_MEMORY_SCOPE_AGENT)); }
template <int NPN  > struct SchedMoe {
    int G, c; const unsigned char* ws; const int* tabs;
    __device__ __forceinline__ bool next(int i, Unit& u) const {
        const int* cn = tabs; const int* eb = tabs + 32; const int* tb = tabs + 65;
        const int ntiles = tb[32], tpx = (ntiles + 7) >> 3, x = c & 7, s = c >> 3;
        const int tiles_x = min(tpx, ntiles - x * tpx), ll = i * (G >> 3) + s;
        if (ll >= NPN * tiles_x) return false;
        const int T = x * tpx + ll / NPN; u.pn = ll % NPN; u.kind = 0;
        int e = 0;
#pragma unroll 1
        for (int k = 16; k >= 1; k >>= 1) if (tb[e + k] <= T) e += k;
        const int jt = T - tb[e];
        u.e = __builtin_amdgcn_readfirstlane(e); u.pm = __builtin_amdgcn_readfirstlane(jt);
        u.row0 = __builtin_amdgcn_readfirstlane(eb[e] + 256 * jt); u.nrows = __builtin_amdgcn_readfirstlane(min(256, cn[e] - 256 * jt)); return true; }
    __device__ __forceinline__ void aoffs(const Unit& u, const int (&R)[2], const int (&C)[2], unsigned (&o)[2][2]) const {
        const int* PERM2 = (const int*)(ws + WS_PERM2) + (size_t)u.e * NTOK + 256 * u.pm;
#pragma unroll
        for (int h = 0; h < 2; ++h)
#pragma unroll
            for (int i = 0; i < 2; ++i) { const int lr = min(128 * h + R[i], u.nrows - 1);
                if (NPN == 8) { const int tok = PERM2[lr]; o[h][i] = (unsigned)(WS_U + ((size_t)tok * 1024 + C[i]) * 2); }
                else o[h][i] = (unsigned)(WS_ACT + ((size_t)(u.row0 + lr) * 1024 + C[i]) * 2); } }
    __device__ __forceinline__ const char* bptr(const Unit& u) const {
        if (NPN == 8) return (const char*)ws + WS_W1 + ((size_t)u.e * 2048 + 256 * u.pn) * 2048;
        return (const char*)ws + WS_W2 + ((size_t)u.e * 1024 + 256 * u.pn) * 2048; }
};
struct EpiMoe1 {
    static constexpr bool PERM = true;
    unsigned char* ws; const float* b1;
    __device__ __forceinline__ bool carry(const Unit&) const { return false; }
    __device__ __forceinline__ void run(f32x4 (&acc)[2][2][4][2], const Unit& u, int wr, int wc, int fr, int fq) const {
        bf16_t* ACT = (bf16_t*)(ws + WS_ACT);
        const int col = 128 * u.pn + wc * 32 + 8 * fq;
        f32x4 bg[2], bl[2];
#pragma unroll
        for (int n = 0; n < 2; ++n) { bg[n] = *(const f32x4*)(b1 + u.e * 2048 + col + 4 * n); bl[n] = *(const f32x4*)(b1 + u.e * 2048 + 1024 + col + 4 * n); }
#pragma unroll
        for (int ai = 0; ai < 2; ++ai)
#pragma unroll
            for (int m = 0; m < 4; ++m) { const int lr = ai * HALF + wr * 64 + m * 16 + fr;
                f32x4 a[2];
#pragma unroll
                for (int n = 0; n < 2; ++n) { const f32x4 zgv = acc[ai][0][m][n] + bg[n], zlv = acc[ai][1][m][n] + bl[n];
#pragma unroll
                    for (int i = 0; i < 4; ++i) { const float zg = fminf(zgv[i], 7.0f), zl = fminf(fmaxf(zlv[i], -7.0f), 7.0f);
                        a[n][i] = zg * __builtin_amdgcn_rcpf(1.0f + __builtin_amdgcn_exp2f(-1.702f * 1.4426950408889634f * zg)) * (zl + 1.0f); } }
                if (lr < u.nrows) *(u32x4*)(ACT + (size_t)(u.row0 + lr) * 1024 + col) = pack8v(a[0], a[1]); }
    }
};
struct EpiMoe2 {
    static constexpr bool PERM = true;
    unsigned char* ws; const float* b2;
    __device__ __forceinline__ bool carry(const Unit&) const { return false; }
    __device__ __forceinline__ void run(f32x4 (&acc)[2][2][4][2], const Unit& u, int wr, int wc, int fr, int fq) const {
        bf16_t* YS = (bf16_t*)(ws + WS_YS);
        const int lc = 256 * u.pn + wc * 32 + 8 * fq;
        f32x4 bv[2][2];
#pragma unroll
        for (int bj = 0; bj < 2; ++bj)
#pragma unroll
            for (int n = 0; n < 2; ++n) bv[bj][n] = *(const f32x4*)(b2 + u.e * 1024 + lc + bj * HALF + 4 * n);
#pragma unroll
        for (int ai = 0; ai < 2; ++ai)
#pragma unroll
            for (int m = 0; m < 4; ++m) { const int lr = ai * HALF + wr * 64 + m * 16 + fr;
                if (lr < u.nrows) {
#pragma unroll
                    for (int bj = 0; bj < 2; ++bj) *(u32x4*)(YS + (size_t)(u.row0 + lr) * 1024 + lc + bj * HALF) = pack8v(acc[ai][bj][m][0] + bv[bj][0], acc[ai][bj][m][1] + bv[bj][1]); } }
    }
};
}
__device__ __forceinline__ void phase_merge_fast(const P& p, int bid, int nblk, unsigned char* lds) {
    pg::SchedMerge S{nblk, bid, p.ws}; pg::EpiMerge E{p.ws};
    pg::gemm_phase<pg::EpiMerge, pg::SchedMerge, true>((PG_LAS unsigned char*)lds, p.ws, S, E);
}
__device__ __forceinline__ void phase_mix_fast(const P& p, int bid, int nblk, unsigned char* lds) {
    pg::SchedMix S{nblk, bid, p.ws}; pg::EpiMix E{p.ws, p.x, p.ln_x_g, p.ln_x_b, p.b_out, p.out};
    pg::gemm_phase<pg::EpiMix, pg::SchedMix, true>((PG_LAS unsigned char*)lds, p.ws, S, E);
}
__device__ __forceinline__ void phase_moe1_fast(const P& p, int bid, int nblk, unsigned char* lds) {
    moe_tables(p, lds); pg::SchedMoe<8> S{nblk, bid, p.ws, (const int*)(lds + MT_LDS)}; pg::EpiMoe1 E{p.ws, p.exp_b1};
    pg::gemm_phase<pg::EpiMoe1, pg::SchedMoe<8>, true>((PG_LAS unsigned char*)lds, p.ws, S, E);
}
__device__ __forceinline__ void phase_moe2_fast(const P& p, int bid, int nblk, unsigned char* lds) {
    moe_tables(p, lds); pg::SchedMoe<4> S{nblk, bid, p.ws, (const int*)(lds + MT_LDS)}; pg::EpiMoe2 E{p.ws, p.exp_b2};
    pg::gemm_phase<pg::EpiMoe2, pg::SchedMoe<4>, true>((PG_LAS unsigned char*)lds, p.ws, S, E);
}
__device__ __forceinline__ void phase_proj_fast(const P& p, int bid, int nblk, unsigned char* lds) {
    { pg::SchedP1 S{nblk, bid, p.ws}; pg::EpiP1 E{p.ws, p.b_in};
      pg::gemm_phase<pg::EpiP1, pg::SchedP1, true>((PG_LAS unsigned char*)lds, p.ws, S, E); }
    { pg::SchedK S{nblk, bid, p.ws}; pg::EpiRope E{p.ws, p.b_in};
      pg::gemm_phase<pg::EpiRope, pg::SchedK, true>((PG_LAS unsigned char*)lds, p.ws, S, E); }
}

#define LAS __attribute__((address_space(3)))
#define XB_TMO      128
#define XB_XCNT(j)  (256  + 64 * (j))
#define XB_XSUB(j)  (1280 + 64 * (j))
#define XB_XGEN(j)  (2304 + 64 * (j))
#define XB_TOP      3328
#define XB_TOPGEN   3392
#define XCD_BAR_WORDS 3456
#define XB_SPIN_CAP (1u << 22)
__device__ __forceinline__ unsigned xb_ld(unsigned* p)              { return __hip_atomic_load(p, __ATOMIC_RELAXED, __HIP_MEMORY_SCOPE_AGENT); }
__device__ __forceinline__ unsigned xb_add(unsigned* p, unsigned v) { return __hip_atomic_fetch_add(p, v, __ATOMIC_RELAXED, __HIP_MEMORY_SCOPE_AGENT); }
__device__ __forceinline__ unsigned xb_xcc_id() { return (unsigned)__builtin_amdgcn_s_getreg((3 << 11) | 20) & 0xFu; }
#define XB_SPIN(cond, bar) do { unsigned _sp = 0; while (cond) { __builtin_amdgcn_s_sleep(1); \
    if ((++_sp & 255u) == 0u) { if (xb_ld(&(bar)[XB_TMO])) break; if (_sp > XB_SPIN_CAP) { atomicAdd(&(bar)[XB_TMO], 1u); break; } } } } while (0)
struct XcdBarrier { unsigned* bar; unsigned x; volatile LAS unsigned* st; };
__device__ __forceinline__ XcdBarrier xcd_barrier_post(unsigned* bar, volatile LAS unsigned* st) {
    XcdBarrier b; b.bar = bar; b.x = xb_xcc_id(); b.st = st;
    if (threadIdx.x == 0) (void)xb_add(&bar[XB_XCNT(b.x)], 1u);
    return b;
}
__device__ __forceinline__ void xcd_barrier_complete(unsigned* bar, unsigned x, unsigned& nloc, unsigned& nx) {
    const unsigned G = gridDim.x * gridDim.y * gridDim.z;
    unsigned sum, cnt, mine, sp = 0u;
    for (;;) {
        sum = 0u; cnt = 0u; mine = 0u;
#pragma unroll
        for (unsigned j = 0; j < 16; ++j) { const unsigned c = xb_ld(&bar[XB_XCNT(j)]); sum += c; cnt += (c > 0u) ? 1u : 0u; mine = (j == x) ? c : mine; }
        if (sum == G) break;
        __builtin_amdgcn_s_sleep(1);
        if ((++sp & 255u) == 0u) { if (xb_ld(&bar[XB_TMO])) break; if (sp > XB_SPIN_CAP) { atomicAdd(&bar[XB_TMO], 1u); break; } }
    }
    nloc = mine > 0u ? mine : 1u; nx = cnt > 0u ? cnt : 1u;
}
__device__ __forceinline__ void xcd_barrier(const XcdBarrier& b) {
    asm volatile("s_waitcnt vmcnt(0)" ::: "memory");
    __syncthreads();
    if (threadIdx.x == 0) {
        unsigned* bar = b.bar;
        __builtin_amdgcn_s_waitcnt(0);
        unsigned nloc = b.st[0], nx = b.st[1];
        if (nloc == 0u) { xcd_barrier_complete(bar, b.x, nloc, nx); b.st[0] = nloc; b.st[1] = nx; }
        const unsigned old = xb_add(&bar[XB_XSUB(b.x)], 1u);
        const unsigned gen = old / nloc;
        if (old + 1u == (gen + 1u) * nloc) {
            __builtin_amdgcn_fence(__ATOMIC_RELEASE, "agent");
            asm volatile("s_waitcnt vmcnt(0)" ::: "memory");
            const unsigned og = xb_add(&bar[XB_TOP], 1u);
            const unsigned tg = og / nx;
            if (og + 1u == (tg + 1u) * nx) xb_add(&bar[XB_TOPGEN], 1u);
            else XB_SPIN(xb_ld(&bar[XB_TOPGEN]) == tg, bar);
            __builtin_amdgcn_fence(__ATOMIC_ACQUIRE, "agent");
            xb_add(&bar[XB_XGEN(b.x)], 1u);
            asm volatile("s_waitcnt vmcnt(0)" ::: "memory");
        } else {
            XB_SPIN(xb_ld(&bar[XB_XGEN(b.x)]) == gen, bar);
            __builtin_amdgcn_fence(__ATOMIC_ACQUIRE, "agent");
            asm volatile("s_waitcnt vmcnt(0)" ::: "memory");
        }
    }
    __syncthreads();
}
#include <hip/hip_cooperative_groups.h>
namespace cg = cooperative_groups;
constexpr int LDS_BYTES = 147456;
constexpr int XB_LDS = LDS_BYTES - 64;
constexpr int CW_BAR = 4096;
constexpr int REP_PA = 1, REP_PB = 1, REP_P1 = 1, REP_GMLP = 1, REP_ATTN = 1, REP_MERGE = 1, REP_MIX = 1, REP_MOE1 = 1, REP_MOE2 = 1, REP_BAR = 0;
__global__ void __launch_bounds__(512, 2) mega(P p) {
    extern __shared__ __attribute__((aligned(16))) unsigned char lds[];
    const int bid = blockIdx.x, nblk = gridDim.x;
    if (threadIdx.x < 16) ((volatile LAS unsigned*)((LAS unsigned char*)lds + XB_LDS))[threadIdx.x] = 0u;
    __syncthreads();
    const XcdBarrier bar = xcd_barrier_post((unsigned*)(p.ws + WS_CTL) + CW_BAR, (volatile LAS unsigned*)((LAS unsigned char*)lds + XB_LDS));
#define GRID_BAR() xcd_barrier(bar)
#define REP(n) _Pragma("unroll 1") for (int rep_ = 0; rep_ < (n); ++rep_)
    REP(REP_PA) { __syncthreads(); phase_prologue_a(p, bid, nblk, lds); } GRID_BAR();
    REP(REP_PB) phase_prologue_b(p, bid, nblk); GRID_BAR();
    REP(REP_P1) phase_proj_fast(p, bid, nblk, lds); GRID_BAR();
    REP(REP_GMLP) phase_gmlp_fast(p, bid, nblk, lds); REP(REP_ATTN) phase_attn_s(p, bid, nblk, lds); GRID_BAR();
    REP(REP_MERGE) phase_merge_fast(p, bid, nblk, lds); GRID_BAR();
    REP(REP_MIX) phase_mix_fast(p, bid, nblk, lds); GRID_BAR();
    phase_router(p, bid, nblk, lds); GRID_BAR();
    REP(REP_BAR) GRID_BAR();
    REP(REP_MOE1) phase_moe1_fast(p, bid, nblk, lds); GRID_BAR();
    REP(REP_MOE2) phase_moe2_fast(p, bid, nblk, lds); GRID_BAR();
#undef REP
    phase_final(p, bid, nblk, lds);
}

extern "C" void kernel_launch(void* const* d_in, const int* in_sizes, int n_in, void* d_out, int out_size, void* d_ws, size_t ws_size, hipStream_t stream) {
    static int grid = 0;
    if (grid == 0) {
        if (n_in != 31 || out_size != NTOK * DM || ws_size < WS_END) { fprintf(stderr, "kernel_launch: unexpected sizes n_in %d out %d ws %zu\n", n_in, out_size, ws_size); grid = -1; return; }
        int dev = 0, cus = 0, per_cu = 0;
        if (hipGetDevice(&dev) != hipSuccess || hipDeviceGetAttribute(&cus, hipDeviceAttributeMultiprocessorCount, dev) != hipSuccess) { grid = -1; return; }
        if (hipFuncSetAttribute((const void*)mega, hipFuncAttributeMaxDynamicSharedMemorySize, LDS_BYTES) != hipSuccess) { fprintf(stderr, "kernel_launch: hipFuncSetAttribute failed\n"); grid = -1; return; }
        if (hipOccupancyMaxActiveBlocksPerMultiprocessor(&per_cu, (const void*)mega, 512, LDS_BYTES) != hipSuccess || per_cu < 1) { fprintf(stderr, "kernel_launch: occupancy query failed (%d)\n", per_cu); grid = -1; return; }
        grid = cus * 1;
    }
    if (grid < 0) return;
    P p{};
    const float** pp = (const float**)&p;
    for (int i = 0; i < 31; ++i) pp[i] = (const float*)d_in[i];
    p.out = (float*)d_out; p.ws = (unsigned char*)d_ws; p.ph_lo = 0; p.ph_hi = 0;
    if (hipMemsetAsync((char*)d_ws + WS_CTL, 0, 1 * MiB, stream) != hipSuccess) { fprintf(stderr, "kernel_launch: memset failed\n"); return; }
    hipLaunchKernelGGL(mega, dim3(grid), dim3(512), LDS_BYTES, stream, p);
    const hipError_t e = hipPeekAtLastError();
    if (e != hipSuccess) fprintf(stderr, "launch failed: %s (grid %d)\n", hipGetErrorString(e), grid);
}
```

```cpp
#include <hip/hip_runtime.h>
#include <cstdio>
#include <cstdint>

typedef unsigned short bf16_t;
typedef short bf16x8 __attribute__((ext_vector_type(8)));
typedef float f32x4 __attribute__((ext_vector_type(4)));
typedef unsigned u32x4 __attribute__((ext_vector_type(4)));
typedef unsigned u32x2 __attribute__((ext_vector_type(2)));

constexpr int DM = 1024, NB = 8, SEQ = 4096, NTOK = NB * SEQ, CTXL = 256, NCTX = NB * CTXL, INW = 7168;
constexpr int NE = 32, TOPK = 4, FF = 1024, NASSIGN = NTOK * TOPK;
constexpr int NHEAD = 16, HD = 64, GW = 64;
constexpr float LN_EPS = 1e-5f;
constexpr float ALPHA = 1.189207115002721f;
constexpr int MAXTILES = NASSIGN / 256 + NE;

constexpr size_t MiB = 1u << 20;
constexpr size_t WS_CTL = 0;
constexpr size_t WS_MOD = 1 * MiB;
constexpr size_t WS_ROPE = 1 * MiB + 512 * 1024;
constexpr size_t WS_ROWSTAT = 2 * MiB;
constexpr size_t WS_ZSTAT = 2 * MiB + 512 * 1024;
constexpr size_t WS_TOPE = 3 * MiB;
constexpr size_t WS_TOPG = 4 * MiB;
constexpr size_t WS_SLOT = 5 * MiB;
constexpr size_t WS_PERM = 6 * MiB;
constexpr size_t WS_TILES = 7 * MiB;
constexpr size_t WS_WIN = 8 * MiB;
constexpr size_t WS_WPA = 22 * MiB, WS_WPB = 24 * MiB, WS_WOUT = 26 * MiB, WS_WSB = 28 * MiB;
constexpr size_t WS_KC = 30 * MiB;
constexpr size_t WS_VCT = 34 * MiB;
constexpr size_t WS_UC = 38 * MiB;
constexpr size_t WS_PERM2 = 42 * MiB;
constexpr size_t WS_W1 = 48 * MiB;
constexpr size_t WS_W2 = 176 * MiB;
constexpr size_t WS_U = 240 * MiB;
constexpr size_t WS_ZU = 304 * MiB;
constexpr size_t WS_ZVT = 368 * MiB;
constexpr size_t WS_Q = 432 * MiB;
constexpr size_t WS_K = 496 * MiB;
constexpr size_t WS_VT = 560 * MiB;
constexpr size_t WS_G = 624 * MiB;
constexpr size_t WS_YB = 752 * MiB;
constexpr size_t WS_INNER = 816 * MiB;
constexpr size_t WS_ACT = WS_ZU;
constexpr size_t WS_YS = WS_G;
constexpr size_t WS_X1PRE = WS_YB;
constexpr size_t WS_X1 = WS_VT;
constexpr size_t WS_END = 880 * MiB;

struct P {
    const float *x, *c, *ctx, *c_ctx, *ln_x_g, *ln_x_b, *ln_ctx_g, *ln_ctx_b, *w_ada, *b_ada, *w_in, *b_in, *gmlp_ln_g, *gmlp_ln_b, *gmlp_ws, *gmlp_bs,
        *na_rpb, *w_pa, *w_pb, *w_out, *b_out, *ln1_g, *ln1_b, *ln2_g, *ln2_b, *router_w, *router_b, *exp_w1, *exp_b1, *exp_w2, *exp_b2;
    float* out; unsigned char* ws; int ph_lo, ph_hi;
};

__device__ __forceinline__ int tid_opaque() { int t = threadIdx.x; asm volatile("" : "+v"(t)); return t; }
typedef float f32x2_ __attribute__((ext_vector_type(2))); typedef __bf16 bf16x2_ __attribute__((ext_vector_type(2)));
__device__ __forceinline__ unsigned pk2(float lo, float hi) { const f32x2_ v = {lo, hi}; return __builtin_bit_cast(unsigned, __builtin_convertvector(v, bf16x2_)); }
__device__ __forceinline__ unsigned f2bf(float f) { return pk2(f, 0.f) & 0xffffu; }
__device__ __forceinline__ float bf2f(unsigned h) { return __builtin_bit_cast(float, (h & 0xffffu) << 16); }
__device__ __forceinline__ float bflo(unsigned w) { return __builtin_bit_cast(float, w << 16); }
__device__ __forceinline__ float bfhi(unsigned w) { return __builtin_bit_cast(float, w & 0xffff0000u); }
__device__ __forceinline__ u32x2 pack8_f8(f32x4 a, f32x4 b) {
    int w0 = 0, w1 = 0;
    w0 = __builtin_amdgcn_cvt_pk_fp8_f32(a[0], a[1], w0, false); w0 = __builtin_amdgcn_cvt_pk_fp8_f32(a[2], a[3], w0, true);
    w1 = __builtin_amdgcn_cvt_pk_fp8_f32(b[0], b[1], w1, false); w1 = __builtin_amdgcn_cvt_pk_fp8_f32(b[2], b[3], w1, true);
    u32x2 r; r.x = (unsigned)w0; r.y = (unsigned)w1; return r;
}
typedef float f32x2u __attribute__((ext_vector_type(2)));
__device__ __forceinline__ f32x4 unpack4_f8(unsigned w) { const f32x2u lo = __builtin_amdgcn_cvt_pk_f32_fp8((int)w, false), hi = __builtin_amdgcn_cvt_pk_f32_fp8((int)w, true); return (f32x4){lo.x, lo.y, hi.x, hi.y}; }
constexpr float YS_F8_SCALE = 16.0f;
__device__ __forceinline__ float wave_sum(float v) {
#pragma unroll
    for (int o = 1; o < 64; o <<= 1) v += __shfl_xor(v, o);
    return v;
}
__device__ __forceinline__ float wave_max(float v) {
#pragma unroll
    for (int o = 1; o < 64; o <<= 1) v = fmaxf(v, __shfl_xor(v, o));
    return v;
}
__device__ __forceinline__ float gelu_exact(float v) { return 0.5f * v * (1.0f + erff(v * 0.70710678118654752f)); }
__device__ __forceinline__ float sigmoidf_(float v) { return 1.0f / (1.0f + __expf(-v)); }

__device__ __forceinline__ void mod_item(const P& p, int item, float* red  ) {
    const int tid = tid_opaque(), wave = tid >> 6, lane = tid & 63;
    const int col = item * 32 + (lane & 31), kpar = lane >> 5;
    float acc[9];
#pragma unroll
    for (int r = 0; r < 9; ++r) acc[r] = 0.f;
    for (int kk = 0; kk < 64; ++kk) {
        const int k = wave * 128 + kk * 2 + kpar;
        const float w = p.w_ada[(size_t)k * 6144 + col];
#pragma unroll
        for (int r = 0; r < 9; ++r) { const float cv = (r < 8) ? p.c[r * 1024 + k] : p.c_ctx[k]; const float s = cv / (1.0f + __expf(-cv)); acc[r] += s * w; }
    }
#pragma unroll
    for (int r = 0; r < 9; ++r) red[((wave * 2 + kpar) * 9 + r) * 32 + (lane & 31)] = acc[r];
    __syncthreads();
    if (tid < 288) {
        const int r = tid >> 5, cc = tid & 31; float s = 0.f;
#pragma unroll
        for (int q = 0; q < 16; ++q) s += red[(q * 9 + r) * 32 + cc];
        ((float*)(p.ws + WS_MOD))[r * 6144 + item * 32 + cc] = s + p.b_ada[item * 32 + cc];
    }
    __syncthreads();
}
__device__ __forceinline__ void transpose_item(const float* W, int K, int N, bf16_t* WT, int k0, int n0, int drow0, float* scr, int lane) {
    const int lr = lane >> 3, lc4 = (lane & 7) * 4;
    f32x4 v[8];
#pragma unroll
    for (int i = 0; i < 8; ++i) v[i] = *(const f32x4*)(W + (size_t)(k0 + 8 * i + lr) * N + n0 + lc4);
#pragma unroll
    for (int i = 0; i < 8; ++i) { float* d = scr + (8 * i + lr) * 33 + lc4; d[0] = v[i].x; d[1] = v[i].y; d[2] = v[i].z; d[3] = v[i].w; }
    __builtin_amdgcn_wave_barrier();
    asm volatile("s_waitcnt lgkmcnt(0)" ::: "memory");
    const int c = lane & 7;
#pragma unroll
    for (int j = 0; j < 4; ++j) { const int n = (lane >> 3) + 8 * j; const float* s = scr + (8 * c) * 33 + n;
        u32x4 o; o.x = pk2(s[0 * 33], s[1 * 33]); o.y = pk2(s[2 * 33], s[3 * 33]); o.z = pk2(s[4 * 33], s[5 * 33]); o.w = pk2(s[6 * 33], s[7 * 33]);
        *(u32x4*)(WT + (size_t)(drow0 + n) * K + k0 + 8 * c) = o; }
    asm volatile("s_waitcnt lgkmcnt(0)" ::: "memory");
    __builtin_amdgcn_wave_barrier();
}
constexpr int IT_WIN = 16 * 224, IT_SQ = 16 * 32, IT_W1 = 32 * 16 * 64, IT_W2 = 32 * 16 * 32, IT_WS = 32;
constexpr int IT_TOTAL = IT_WIN + 3 * IT_SQ + IT_W1 + IT_W2 + IT_WS, IT_EXP0 = IT_WIN + 3 * IT_SQ;
__device__ __forceinline__ void convert_item(const P& p, int it, float* scr, int lane) {
    unsigned char* ws = p.ws;
    if (it < IT_WIN) { const int kb = it / 224, nb = it % 224; transpose_item(p.w_in, 1024, INW, (bf16_t*)(ws + WS_WIN), kb * 64, nb * 32, nb * 32, scr, lane); return; } it -= IT_WIN;
    if (it < IT_SQ) { const int kb = it / 32, nb = it % 32; transpose_item(p.w_pa, 1024, 1024, (bf16_t*)(ws + WS_WPA), kb * 64, nb * 32, nb * 32, scr, lane); return; } it -= IT_SQ;
    if (it < IT_SQ) { const int kb = it / 32, nb = it % 32; transpose_item(p.w_pb, 1024, 1024, (bf16_t*)(ws + WS_WPB), kb * 64, nb * 32, nb * 32, scr, lane); return; } it -= IT_SQ;
    if (it < IT_SQ) { const int kb = it / 32, nb = it % 32; transpose_item(p.w_out, 1024, 1024, (bf16_t*)(ws + WS_WOUT), kb * 64, nb * 32, nb * 32, scr, lane); return; } it -= IT_SQ;
    if (it < IT_W1) { const int e = it / 1024, r = it % 1024, kb = r / 64, nb = r % 64, n0 = nb * 32;
        const int half = n0 >> 10, nn = n0 & 1023, drow0 = (nn >> 7) * 256 + half * 128 + (nn & 127);
        transpose_item(p.exp_w1 + (size_t)e * 1024 * 2048, 1024, 2048, (bf16_t*)(ws + WS_W1) + (size_t)e * 2048 * 1024, kb * 64, n0, drow0, scr, lane); return; } it -= IT_W1;
    if (it < IT_W2) { const int e = it / 512, r = it % 512, kb = r / 32, nb = r % 32;
        transpose_item(p.exp_w2 + (size_t)e * 1024 * 1024, 1024, 1024, (bf16_t*)(ws + WS_W2) + (size_t)e * 1024 * 1024, kb * 64, nb * 32, nb * 32, scr, lane); return; } it -= IT_W2;
    { bf16_t* o = (bf16_t*)(ws + WS_WSB); const float* s = p.gmlp_ws + it * 4096;
      for (int i = lane; i < 4096; i += 64) o[it * 4096 + i] = (bf16_t)f2bf(s[i]); }
}
__device__ __forceinline__ void phase_prologue_a(const P& p, int bid, int nblk, unsigned char* lds) {
    const int tid = tid_opaque(), wave = tid >> 6, lane = tid & 63;
    for (int item = bid; item < 192; item += nblk) mod_item(p, item, (float*)lds);
    if (bid == nblk - 1) {
        for (int i = tid; i < 1024; i += 512) { const int pos = i >> 4, fi = i & 15;
            const float inv = __builtin_amdgcn_exp2f(-(float)fi * (13.287712379549449f / 16.0f));
            const float ang = (float)pos * inv; const float rev = ang * 0.15915494309189535f;
            float* t = (float*)(p.ws + WS_ROPE); t[2 * i] = __builtin_amdgcn_cosf(rev); t[2 * i + 1] = __builtin_amdgcn_sinf(rev); }
    }
    __syncthreads();
    float* scr = (float*)lds + wave * (64 * 33 + 32);
    const int gw = bid * 8 + wave, ngw = nblk * 8;
    for (int it = gw; it < IT_TOTAL - (IT_W1 + IT_W2); it += ngw) convert_item(p, it < IT_EXP0 ? it : it + (IT_W1 + IT_W2), scr, lane);
}
__device__ __forceinline__ void ln_mod_row(const float* xrow, const float* g, const float* b, const float* sh, const float* sc, bf16_t* orow, float* stat, int lane) {
    const f32x4* xr = (const f32x4*)xrow + lane;
    f32x4 v[4]; float s = 0.f;
#pragma unroll
    for (int j = 0; j < 4; ++j) { v[j] = xr[64 * j]; s += (v[j].x + v[j].y) + (v[j].z + v[j].w); }
    const float mean = wave_sum(s) * (1.f / DM); float s2 = 0.f;
#pragma unroll
    for (int j = 0; j < 4; ++j) { v[j] = v[j] - mean; s2 += (v[j].x * v[j].x + v[j].y * v[j].y) + (v[j].z * v[j].z + v[j].w * v[j].w); }
    const float rstd = 1.f / sqrtf(wave_sum(s2) * (1.f / DM) + LN_EPS);
    if (stat && lane == 0) { stat[0] = mean; stat[1] = rstd; }
    u32x2* o8 = (u32x2*)orow + lane;
#pragma unroll
    for (int j = 0; j < 4; ++j) { const int col = 4 * lane + 256 * j;
        const f32x4 gg = *(const f32x4*)(g + col), bb = *(const f32x4*)(b + col), shv = *(const f32x4*)(sh + col), scv = *(const f32x4*)(sc + col);
        f32x4 y = (v[j] * rstd) * gg + bb; y = y * (1.0f + scv) + shv;
        u32x2 w; w.x = pk2(y.x, y.y); w.y = pk2(y.z, y.w); o8[64 * j] = w; }
}
__device__ __forceinline__ void phase_prologue_b(const P& p, int bid, int nblk) {
    const int tid = tid_opaque(), wave = tid >> 6, lane = tid & 63;
    const int gw = bid * 8 + wave, ngw = nblk * 8;
    const float* mod = (const float*)(p.ws + WS_MOD);
    for (int row = gw; row < NTOK + NCTX; row += ngw) {
        if (row < NTOK) { const int b = row >> 12;
            ln_mod_row(p.x + (size_t)row * DM, p.ln_x_g, p.ln_x_b, mod + b * 6144, mod + b * 6144 + 1024, (bf16_t*)(p.ws + WS_U) + (size_t)row * DM, (float*)(p.ws + WS_ROWSTAT) + 2 * row, lane);
        } else { const int r = row - NTOK;
            ln_mod_row(p.ctx + (size_t)r * DM, p.ln_ctx_g, p.ln_ctx_b, mod + 8 * 6144, mod + 8 * 6144 + 1024, (bf16_t*)(p.ws + WS_UC) + (size_t)r * DM, nullptr, lane); }
    }
}

template <class ARow, class BRow, class Epi>
__device__ __forceinline__ void sgemm_wave_tile(int r0, int n0, int K, const ARow& arow, const BRow& brow, const Epi& epi, int lane) {
    const int fr = lane & 15, fq = lane >> 4;
    f32x4 acc[2][2];
#pragma unroll
    for (int a = 0; a < 2; ++a)
#pragma unroll
        for (int b = 0; b < 2; ++b) acc[a][b] = (f32x4){0.f, 0.f, 0.f, 0.f};
    const bf16_t* ap[2]; const bf16_t* bp[2];
#pragma unroll
    for (int a = 0; a < 2; ++a) { ap[a] = arow(r0 + 16 * a + fr) + 8 * fq; bp[a] = brow(n0 + 16 * a + fr) + 8 * fq; }
    for (int k0 = 0; k0 < K; k0 += 32) {
        bf16x8 af[2], bfr[2];
#pragma unroll
        for (int a = 0; a < 2; ++a) { af[a] = *(const bf16x8*)(ap[a] + k0); bfr[a] = *(const bf16x8*)(bp[a] + k0); }
#pragma unroll
        for (int a = 0; a < 2; ++a)
#pragma unroll
            for (int b = 0; b < 2; ++b) acc[a][b] = __builtin_amdgcn_mfma_f32_16x16x32_bf16(af[a], bfr[b], acc[a][b], 0, 0, 0);
    }
#pragma unroll
    for (int a = 0; a < 2; ++a)
#pragma unroll
        for (int b = 0; b < 2; ++b)
#pragma unroll
            for (int i = 0; i < 4; ++i) epi(r0 + 16 * a + 4 * fq + i, n0 + 16 * b + fr, acc[a][b][i]);
}

struct ARowDense { const bf16_t* A; int lda; __device__ __forceinline__ const bf16_t* operator()(int r) const { return A + (size_t)r * lda; } };
struct EpiProj {
    const float* b_in; bf16_t *ZU, *ZVT, *Q, *K, *VT, *G;
    __device__ __forceinline__ void operator()(int r, int n, float v) const {
        v += b_in[n];
        if (n < 1024) ZU[(size_t)r * 1024 + n] = (bf16_t)f2bf(gelu_exact(v));
        else if (n < 2048) ZVT[(size_t)(n - 1024) * NTOK + r] = (bf16_t)f2bf(gelu_exact(v));
        else if (n < 3072) Q[(size_t)r * 1024 + (n - 2048)] = (bf16_t)f2bf(v);
        else if (n < 4096) K[(size_t)r * 1024 + (n - 3072)] = (bf16_t)f2bf(v);
        else if (n < 5120) VT[(size_t)(n - 4096) * NTOK + r] = (bf16_t)f2bf(v);
        else G[(size_t)r * 2048 + (n - 5120)] = (bf16_t)f2bf(sigmoidf_(v));
    }
};
__device__ __forceinline__ void phase_proj_s(const P& p, int bid, int nblk) {
    const int tid_ = tid_opaque(); const int wave = tid_ >> 6, lane = tid_ & 63; unsigned char* ws = p.ws;
    ARowDense ar{(const bf16_t*)(ws + WS_U), 1024}, br{(const bf16_t*)(ws + WS_WIN), 1024};
    EpiProj e{p.b_in, (bf16_t*)(ws + WS_ZU), (bf16_t*)(ws + WS_ZVT), (bf16_t*)(ws + WS_Q), (bf16_t*)(ws + WS_K), (bf16_t*)(ws + WS_VT), (bf16_t*)(ws + WS_G)};
    const int ntn = INW / 32, ntiles = (NTOK / 32) * ntn;
    for (int t = bid * 8 + wave; t < ntiles; t += nblk * 8) sgemm_wave_tile((t / ntn) * 32, (t % ntn) * 32, 1024, ar, br, e, lane);
}
struct EpiCtxKV {
    const float* b_in; bf16_t *KC, *VCT;
    __device__ __forceinline__ void operator()(int r, int n, float v) const {
        v += b_in[3072 + n];
        if (n < 1024) KC[(size_t)r * 1024 + n] = (bf16_t)f2bf(v); else VCT[(size_t)(n - 1024) * NCTX + r] = (bf16_t)f2bf(v);
    }
};
__device__ __forceinline__ void phase_ctxkv_s(const P& p, int bid, int nblk) {
    const int tid_ = tid_opaque(); const int wave = tid_ >> 6, lane = tid_ & 63; unsigned char* ws = p.ws;
    ARowDense ar{(const bf16_t*)(ws + WS_UC), 1024}, br{(const bf16_t*)(ws + WS_WIN) + (size_t)3072 * 1024, 1024};
    EpiCtxKV e{p.b_in, (bf16_t*)(ws + WS_KC), (bf16_t*)(ws + WS_VCT)};
    const int ntn = 2048 / 32, ntiles = (NCTX / 32) * ntn;
    for (int t = bid * 8 + wave; t < ntiles; t += nblk * 8) sgemm_wave_tile((t / ntn) * 32, (t % ntn) * 32, 1024, ar, br, e, lane);
}
__device__ __forceinline__ void phase_rope_s(const P& p, int bid, int nblk) {
    bf16_t* K = (bf16_t*)(p.ws + WS_K); const float* tab = (const float*)(p.ws + WS_ROPE);
    const size_t total = (size_t)NTOK * NHEAD * 32;
    const int tid_ = tid_opaque();
    for (size_t i = (size_t)bid * 512 + tid_; i < total; i += (size_t)nblk * 512) {
        const int pi = (int)(i & 31), h = (int)((i >> 5) & 15), t = (int)(i >> 9);
        const int pos = t & 4095, axis = pi >> 4, fi = pi & 15, ps = axis ? (pos & 63) : (pos >> 6);
        const float cs = tab[2 * (ps * 16 + fi)], sn = tab[2 * (ps * 16 + fi) + 1];
        bf16_t* base = K + (size_t)t * 1024 + h * 64 + axis * 32 + fi;
        const float x1 = bf2f(base[0]), x2 = bf2f(base[16]);
        base[0] = (bf16_t)f2bf(x1 * cs - x2 * sn); base[16] = (bf16_t)f2bf(x2 * cs + x1 * sn);
    }
}
__device__ __forceinline__ void phase_zstat_s(const P& p, int bid, int nblk) {
    const bf16_t* ZVT = (const bf16_t*)(p.ws + WS_ZVT); float* zs = (float*)(p.ws + WS_ZSTAT);
    const int tid_ = tid_opaque();
    for (int t = bid * 512 + tid_; t < NTOK; t += nblk * 512) {
        float s = 0.f, s2 = 0.f;
        for (int c = 0; c < 1024; ++c) { const float v = bf2f(ZVT[(size_t)c * NTOK + t]); s += v; s2 += v * v; }
        const float mean = s * (1.f / 1024.f); const float var = fmaxf(s2 * (1.f / 1024.f) - mean * mean, 0.f);
        zs[2 * t] = mean; zs[2 * t + 1] = 1.f / sqrtf(var + LN_EPS);
    }
}
__device__ __forceinline__ void phase_gmlp_s(const P& p, int bid, int nblk, unsigned char* lds) {
    float* zvn = (float*)lds;
    float* wsm = zvn + 128 * 128;
    const bf16_t* ZVT = (const bf16_t*)(p.ws + WS_ZVT); const bf16_t* ZU = (const bf16_t*)(p.ws + WS_ZU); const float* zs = (const float*)(p.ws + WS_ZSTAT);
    bf16_t* YA = (bf16_t*)(p.ws + WS_U);
    const int tid = tid_opaque();
    for (int item = bid; item < (NTOK / 128) * 8; item += nblk) {
        const int chunk = item >> 3, g = item & 7, tok0 = chunk * 128;
        __syncthreads();
        for (int i = tid; i < 128 * 128; i += 512) { const int c = i >> 7, q = i & 127; const int ch = g * 128 + c;
            const float v = bf2f(ZVT[(size_t)ch * NTOK + tok0 + q]);
            zvn[q * 128 + c] = (v - zs[2 * (tok0 + q)]) * zs[2 * (tok0 + q) + 1] * p.gmlp_ln_g[ch] + p.gmlp_ln_b[ch];
            wsm[i] = p.gmlp_ws[g * 16384 + i]; }
        __syncthreads();
        const int c = tid & 127, pq = tid >> 7;
        for (int pp = 0; pp < 32; ++pp) { const int pr = pq * 32 + pp; float acc = 0.f;
            for (int q = 0; q < 128; ++q) acc += wsm[pr * 128 + q] * zvn[q * 128 + c];
            acc += p.gmlp_bs[g * 128 + pr];
            const size_t o = (size_t)(tok0 + pr) * 1024 + g * 128 + c;
            YA[o] = (bf16_t)f2bf(bf2f(ZU[o]) * acc); }
    }
}
__device__ __forceinline__ bf16x8 pack8(const float (&v)[8]) { u32x4 w; w.x = pk2(v[0], v[1]); w.y = pk2(v[2], v[3]); w.z = pk2(v[4], v[5]); w.w = pk2(v[6], v[7]); return __builtin_bit_cast(bf16x8, w); }
__device__ __forceinline__ void phase_gmlp_fast(const P& p, int bid, int nblk, unsigned char* lds) {
    const int tid = tid_opaque(), g = tid >> 6, lane = tid & 63, fr = lane & 15, fq = lane >> 4;
    float* part = (float*)lds;
    float* stat = part + 8 * 128 * 2;
    const bf16_t* ZVT = (const bf16_t*)(p.ws + WS_ZVT); const bf16_t* ZU = (const bf16_t*)(p.ws + WS_ZU); const bf16_t* WSB = (const bf16_t*)(p.ws + WS_WSB);
    bf16_t* YA = (bf16_t*)(p.ws + WS_U);
    for (int chunk = bid; chunk < NTOK / 128; chunk += nblk) {
        const int tok0 = chunk * 128;
        __syncthreads();
        { float s1[8], s2[8];
#pragma unroll
          for (int jj = 0; jj < 8; ++jj) { s1[jj] = 0.f; s2[jj] = 0.f; }
          const bf16_t* zp = ZVT + (((size_t)(tok0 >> 3) + fr) * 1024 + 128 * g + fq) * 8;
#pragma unroll 8
          for (int it = 0; it < 32; ++it) { const bf16x8 v = *(const bf16x8*)(zp + (4 * it) * 8);
#pragma unroll
              for (int jj = 0; jj < 8; ++jj) { const float f = bf2f((unsigned)(unsigned short)v[jj]); s1[jj] += f; s2[jj] += f * f; } }
#pragma unroll
          for (int jj = 0; jj < 8; ++jj) { s1[jj] += __shfl_xor(s1[jj], 16); s1[jj] += __shfl_xor(s1[jj], 32); s2[jj] += __shfl_xor(s2[jj], 16); s2[jj] += __shfl_xor(s2[jj], 32); }
          if (fq == 0) {
#pragma unroll
              for (int jj = 0; jj < 8; ++jj) { part[(g * 128 + 8 * fr + jj) * 2] = s1[jj]; part[(g * 128 + 8 * fr + jj) * 2 + 1] = s2[jj]; } } }
        __syncthreads();
        if (tid < 128) { float a = 0.f, b = 0.f;
#pragma unroll
            for (int w = 0; w < 8; ++w) { a += part[(w * 128 + tid) * 2]; b += part[(w * 128 + tid) * 2 + 1]; }
            const float mean = a * (1.f / 1024.f), var = fmaxf(b * (1.f / 1024.f) - mean * mean, 0.f);
            stat[2 * tid] = mean; stat[2 * tid + 1] = 1.f / sqrtf(var + LN_EPS); }
        __syncthreads();
#pragma unroll 1
        for (int ph = 0; ph < 2; ++ph) {
            bf16x8 wf[4][4]; float t1[4], t2[4], bsv[4];
#pragma unroll
            for (int pt = 0; pt < 4; ++pt) { const int pp = 64 * ph + 16 * pt + fr; float t1a = 0.f, t2a = 0.f;
                const __attribute__((address_space(3))) float* stat3 = (const __attribute__((address_space(3))) float*)((const __attribute__((address_space(3))) unsigned char*)lds + 8 * 128 * 2 * 4);
                int so = 16 * fq; asm volatile("" : "+v"(so));
#pragma unroll
                for (int ks = 0; ks < 4; ++ks) { const bf16x8 w = *(const bf16x8*)(WSB + ((size_t)g * 128 + pp) * 128 + 32 * ks + 8 * fq);
                    float wv[8];
#pragma unroll
                    for (int jj = 0; jj < 8; ++jj) { const float w0 = bf2f((unsigned)(unsigned short)w[jj]); t2a += w0; wv[jj] = w0 * stat3[so + 2 * (32 * ks + jj) + 1]; }
                    const bf16x8 wp = pack8(wv); wf[pt][ks] = wp;
#pragma unroll
                    for (int jj = 0; jj < 8; ++jj) t1a += bf2f((unsigned)(unsigned short)wp[jj]) * stat3[so + 2 * (32 * ks + jj)]; }
                t1a += __shfl_xor(t1a, 16); t1a += __shfl_xor(t1a, 32); t2a += __shfl_xor(t2a, 16); t2a += __shfl_xor(t2a, 32);
                t1[pt] = t1a; t2[pt] = t2a; bsv[pt] = p.gmlp_bs[g * 128 + pp]; }
            bf16x8 afn[4];
            { const bf16_t* zp = ZVT + (((size_t)(tok0 >> 3) + fq) * 1024 + 128 * g + fr) * 8;
#pragma unroll
              for (int ks = 0; ks < 4; ++ks) afn[ks] = *(const bf16x8*)(zp + (size_t)ks * 4 * 1024 * 8); }
#pragma unroll 1
            for (int ct = 0; ct < 8; ++ct) {
                bf16x8 af[4];
#pragma unroll
                for (int ks = 0; ks < 4; ++ks) af[ks] = afn[ks];
                if (ct + 1 < 8) { const bf16_t* zp = ZVT + (((size_t)(tok0 >> 3) + fq) * 1024 + 128 * g + 16 * (ct + 1) + fr) * 8;
#pragma unroll
                    for (int ks = 0; ks < 4; ++ks) afn[ks] = *(const bf16x8*)(zp + (size_t)ks * 4 * 1024 * 8); }
                const int c = 128 * g + 16 * ct + 4 * fq;
                u32x2 zuv[4];
#pragma unroll
                for (int pt = 0; pt < 4; ++pt) zuv[pt] = *(const u32x2*)(ZU + (size_t)(tok0 + 64 * ph + 16 * pt + fr) * 1024 + c);
                f32x4 acc[4];
#pragma unroll
                for (int pt = 0; pt < 4; ++pt) { acc[pt] = (f32x4){0.f, 0.f, 0.f, 0.f};
#pragma unroll
                    for (int ks = 0; ks < 4; ++ks) acc[pt] = __builtin_amdgcn_mfma_f32_16x16x32_bf16(af[ks], wf[pt][ks], acc[pt], 0, 0, 0); }
                const f32x4 gc = *(const f32x4*)(p.gmlp_ln_g + c), bc = *(const f32x4*)(p.gmlp_ln_b + c);
#pragma unroll
                for (int pt = 0; pt < 4; ++pt) { const size_t off = (size_t)(tok0 + 64 * ph + 16 * pt + fr) * 1024 + c;
                    const u32x2 zu = zuv[pt];
                    const f32x4 s = gc * (acc[pt] - t1[pt]) + bc * t2[pt] + bsv[pt];
                    u32x2 w; w.x = pk2(bflo(zu.x) * s[0], bfhi(zu.x) * s[1]); w.y = pk2(bflo(zu.y) * s[2], bfhi(zu.y) * s[3]);
                    *(u32x2*)(YA + off) = w; }
            }
        }
    }
}
constexpr int AT_LDS_RPB = 0, AT_LDS_KC = 4096, AT_LDS_VC = AT_LDS_KC + 32768, AT_LDS_END = AT_LDS_VC + 32768;
typedef __attribute__((address_space(3))) const unsigned char* lds_cp;
__device__ __forceinline__ void attn_stage(const P& p, unsigned char* lds, int b, int h, int tid) {
    float* tbl = (float*)(lds + AT_LDS_RPB);
    for (int idx = tid; idx < 15 * 64; idx += 512) { const int dr = idx >> 6, cc = idx & 63; tbl[idx] = (cc >= 16 && cc < 47) ? p.na_rpb[(h * 15 + dr) * 31 + cc - 16] : 0.f; }
    const size_t bh = (size_t)b * 16 + h;
    const u32x4* kc = (const u32x4*)((const bf16_t*)(p.ws + WS_KC) + bh * 256 * 64); const u32x4* vc = (const u32x4*)((const bf16_t*)(p.ws + WS_VCT) + bh * 32 * 512);
#pragma unroll
    for (int i = 0; i < 4; ++i) { const int q = tid + 512 * i, key = q >> 3, c = q & 7; const int fk = ((key >> 1) & 1) | (((key >> 3) & 1) << 1) | (((key >> 4) & 1) << 2);
        *(u32x4*)(lds + AT_LDS_KC + key * 128 + ((c ^ fk) << 4)) = kc[q]; *(u32x4*)(lds + AT_LDS_VC + q * 16) = vc[q]; }
}
__device__ __forceinline__ void attn_wave_unit(const P& p, unsigned char* lds, int b, int r, int j, int h, int lane) {
    const int fr = lane & 15, fq = lane >> 4;
    const bf16_t* Q = (const bf16_t*)(p.ws + WS_Q); const bf16_t* K = (const bf16_t*)(p.ws + WS_K); const bf16_t* VT = (const bf16_t*)(p.ws + WS_VT);
    const float* tab = (const float*)(p.ws + WS_ROPE);
    bf16_t* YB = (bf16_t*)(p.ws + WS_YB);
    const int qc = 16 * j + fr; const size_t tq = (size_t)b * SEQ + r * 64 + qc; const size_t bh = (size_t)b * 16 + h;
    const int r0 = min(max(r - 4, 0), 56), c0 = min(max(qc - 8, 0), 48), cs = min(max(16 * j - 8, 0), 32);
    const int sp0 = 8 * (fr >> 2) + (fr & 3);
    const bf16_t* klat = K + (bh * 4096 + r0 * 64 + cs + sp0) * 64 + 8 * fq;
    const bf16_t* vlat = VT + ((bh * 512 + ((r0 * 64 + cs) >> 3) + fq) * 64 + fr) * 8;
    const int fk = ((fr >> 1) & 1) | (((fr >> 2) & 1) << 1) | (((fr >> 3) & 1) << 2);
    const lds_cp kcl = (lds_cp)lds + AT_LDS_KC + sp0 * 128;
    const int kco0 = (fq ^ fk) << 4, kco1 = ((fq + 4) ^ fk) << 4;
    const lds_cp vcl = (lds_cp)lds + AT_LDS_VC + (fq * 64 + fr) * 16;
    bf16x8 kf[2][2][2];
#define LOADK(buf, st_) do { _Pragma("unroll") for (int t = 0; t < 2; ++t) { \
        const bf16_t* kp_ = klat + (size_t)(st_) * 64 * 64 + t * 4 * 64; kf[buf][t][0] = *(const bf16x8*)kp_; kf[buf][t][1] = *(const bf16x8*)(kp_ + 32); } } while (0)
#define LOADKC(buf, st_) do { _Pragma("unroll") for (int t = 0; t < 2; ++t) { \
        const lds_cp kp_ = kcl + (32 * (st_) + 4 * t) * 128; kf[buf][t][0] = *(const __attribute__((address_space(3))) bf16x8*)(kp_ + kco0); kf[buf][t][1] = *(const __attribute__((address_space(3))) bf16x8*)(kp_ + kco1); } } while (0)
    LOADK(0, 0); LOADK(1, 1);
    bf16x8 qpl[2], qrt[2];
#pragma unroll
    for (int s = 0; s < 2; ++s) {
        const bf16_t* qb = Q + (bh * 4096 + r * 64 + qc) * 64 + 32 * s;
        const bf16x8 me = *(const bf16x8*)(qb + 8 * fq), ot = *(const bf16x8*)(qb + 8 * (fq ^ 2));
        qpl[s] = me;
        const int pos = s ? qc : r; const float* tb = tab + (pos * 16 + 8 * (fq & 1)) * 2;
        float rot[8];
#pragma unroll
        for (int jj = 0; jj < 8; ++jj) { const float cv = tb[2 * jj], sv = tb[2 * jj + 1];
            const float xv = bf2f((unsigned)(unsigned short)me[jj]), ov = bf2f((unsigned)(unsigned short)ot[jj]);
            rot[jj] = (fq < 2) ? (xv * cv - ov * sv) : (xv * cv + ov * sv); }
        qrt[s] = pack8(rot);
    }
    float sc[8][8];
    const __attribute__((address_space(3))) float* tbl3 = (const __attribute__((address_space(3))) float*)((lds_cp)lds + AT_LDS_RPB);
    const int boff0 = (r0 - r + 7) * 64 + (cs + 8 * fq - qc + 31);
#pragma unroll
    for (int st = 0; st < 8; ++st) {
        int boff = boff0 + st * 64; asm volatile("" : "+v"(boff));
#pragma unroll
        for (int t = 0; t < 2; ++t) {
            f32x4 d = __builtin_amdgcn_mfma_f32_16x16x32_bf16(kf[st & 1][t][0], qrt[0], (f32x4){0.f, 0.f, 0.f, 0.f}, 0, 0, 0);
            d = __builtin_amdgcn_mfma_f32_16x16x32_bf16(kf[st & 1][t][1], qrt[1], d, 0, 0, 0);
#pragma unroll
            for (int i = 0; i < 4; ++i) { const int kc = cs + 8 * fq + 4 * t + i; const bool valid = (kc >= c0) && (kc < c0 + 16);
                const float bias = tbl3[boff + 4 * t + i];
                sc[st][4 * t + i] = valid ? (d[i] * 0.125f + bias) : -INFINITY; } }
        if (st + 2 < 8) LOADK(st & 1, st + 2);
    }
    bf16x8 vf[2][4];
#define LOADV(buf, st_) do { _Pragma("unroll") for (int dt = 0; dt < 4; ++dt) vf[buf][dt] = *(const bf16x8*)(vlat + dt * 128 + (st_) * 8 * 512); } while (0)
#define LOADVC(buf, st_) do { _Pragma("unroll") for (int dt = 0; dt < 4; ++dt) vf[buf][dt] = *(const __attribute__((address_space(3))) bf16x8*)(vcl + (st_) * 4096 + dt * 256); } while (0)
    LOADV(0, 0); LOADV(1, 1);
    float m = -INFINITY;
#pragma unroll
    for (int st = 0; st < 8; ++st)
#pragma unroll
        for (int e = 0; e < 8; ++e) m = fmaxf(m, sc[st][e]);
    m = fmaxf(m, __shfl_xor(m, 16)); m = fmaxf(m, __shfl_xor(m, 32));
    float l = 0.f; f32x4 o[4];
#pragma unroll
    for (int dt = 0; dt < 4; ++dt) o[dt] = (f32x4){0.f, 0.f, 0.f, 0.f};
    const float ml2 = m * 1.4426950408889634f;
#pragma unroll
    for (int st = 0; st < 8; ++st) {
        float pv[8];
#pragma unroll
        for (int e = 0; e < 8; ++e) { pv[e] = __builtin_amdgcn_exp2f(sc[st][e] * 1.4426950408889634f - ml2); l += pv[e]; }
        const bf16x8 pf = pack8(pv);
#pragma unroll
        for (int dt = 0; dt < 4; ++dt) o[dt] = __builtin_amdgcn_mfma_f32_16x16x32_bf16(vf[st & 1][dt], pf, o[dt], 0, 0, 0);
        if (st + 2 < 8) LOADV(st & 1, st + 2);
    }
    LOADKC(0, 0);
#pragma unroll
    for (int st = 0; st < 8; ++st) {
        if (st + 1 < 8) LOADKC((st + 1) & 1, st + 1);
#pragma unroll
        for (int t = 0; t < 2; ++t) {
            f32x4 d = __builtin_amdgcn_mfma_f32_16x16x32_bf16(kf[st & 1][t][0], qpl[0], (f32x4){0.f, 0.f, 0.f, 0.f}, 0, 0, 0);
            d = __builtin_amdgcn_mfma_f32_16x16x32_bf16(kf[st & 1][t][1], qpl[1], d, 0, 0, 0);
#pragma unroll
            for (int i = 0; i < 4; ++i) sc[st][4 * t + i] = d[i] * 0.125f; }
    }
    float m2 = -INFINITY;
#pragma unroll
    for (int st = 0; st < 8; ++st)
#pragma unroll
        for (int e = 0; e < 8; ++e) m2 = fmaxf(m2, sc[st][e]);
    m2 = fmaxf(m2, __shfl_xor(m2, 16)); m2 = fmaxf(m2, __shfl_xor(m2, 32));
    const float mn = fmaxf(m, m2), al = __builtin_amdgcn_exp2f((m - mn) * 1.4426950408889634f), mnl2 = mn * 1.4426950408889634f;
    l *= al;
#pragma unroll
    for (int dt = 0; dt < 4; ++dt) o[dt] = o[dt] * al;
    LOADVC(0, 0);
#pragma unroll
    for (int st = 0; st < 8; ++st) {
        if (st + 1 < 8) LOADVC((st + 1) & 1, st + 1);
        float pv[8];
#pragma unroll
        for (int e = 0; e < 8; ++e) { pv[e] = __builtin_amdgcn_exp2f(sc[st][e] * 1.4426950408889634f - mnl2); l += pv[e]; }
        const bf16x8 pf = pack8(pv);
#pragma unroll
        for (int dt = 0; dt < 4; ++dt) o[dt] = __builtin_amdgcn_mfma_f32_16x16x32_bf16(vf[st & 1][dt], pf, o[dt], 0, 0, 0);
    }
#undef LOADK
#undef LOADKC
#undef LOADV
#undef LOADVC
    l += __shfl_xor(l, 16); l += __shfl_xor(l, 32);
    const float inv = 1.0f / l;
#pragma unroll
    for (int dt = 0; dt < 4; ++dt) { u32x2 w; w.x = pk2(o[dt][0] * inv, o[dt][1] * inv); w.y = pk2(o[dt][2] * inv, o[dt][3] * inv);
        *(u32x2*)(YB + tq * 1024 + h * 64 + 16 * dt + 4 * fq) = w; }
}
__device__ __forceinline__ void phase_attn_s(const P& p, int bid, int nblk, unsigned char* lds) {
    const int tid_ = tid_opaque(); const int wave = tid_ >> 6, lane = tid_ & 63;
    float* cscr = (float*)(lds + AT_LDS_END) + wave * (64 * 33 + 32);
    for (int vb = bid; vb < 256; vb += nblk) { const int half = vb & 1, h = (vb >> 1) & 15, b = vb >> 5;
        __syncthreads();
        attn_stage(p, lds, b, h, tid_);
        __syncthreads();
#pragma unroll 1
        for (int it = 0; it < 16; ++it) { int lane_o = lane; asm volatile("" : "+v"(lane_o));
            attn_wave_unit(p, lds, b, 32 * half + 2 * it + (wave >> 2), wave & 3, h, lane_o);
            const int gw = vb * 8 + wave;
            for (int k = it; k * 2048 + gw < IT_W1 + IT_W2; k += 16) convert_item(p, IT_EXP0 + k * 2048 + gw, cscr, lane_o); }
    }
}
struct EpiMergeA { const bf16_t* G; bf16_t* INNER;
    __device__ __forceinline__ void operator()(int r, int n, float v) const { INNER[(size_t)r * 1024 + n] = (bf16_t)f2bf(bf2f(G[(size_t)r * 2048 + n]) * v); } };
struct EpiMergeB { const bf16_t* G; bf16_t* INNER;
    __device__ __forceinline__ void operator()(int r, int n, float v) const { const size_t o = (size_t)r * 1024 + n; INNER[o] = (bf16_t)f2bf(bf2f(INNER[o]) + bf2f(G[(size_t)r * 2048 + 1024 + n]) * v); } };
template <int WHICH> __device__ __forceinline__ void phase_merge_s(const P& p, int bid, int nblk) {
    const int tid_ = tid_opaque(); const int wave = tid_ >> 6, lane = tid_ & 63; unsigned char* ws = p.ws;
    const int ntn = 1024 / 32, ntiles = (NTOK / 32) * ntn;
    if (WHICH == 0) { ARowDense ar{(const bf16_t*)(ws + WS_U), 1024}, br{(const bf16_t*)(ws + WS_WPA), 1024}; EpiMergeA e{(const bf16_t*)(ws + WS_G), (bf16_t*)(ws + WS_INNER)};
        for (int t = bid * 8 + wave; t < ntiles; t += nblk * 8) sgemm_wave_tile((t / ntn) * 32, (t % ntn) * 32, 1024, ar, br, e, lane);
    } else { ARowDense ar{(const bf16_t*)(ws + WS_YB), 1024}, br{(const bf16_t*)(ws + WS_WPB), 1024}; EpiMergeB e{(const bf16_t*)(ws + WS_G), (bf16_t*)(ws + WS_INNER)};
        for (int t = bid * 8 + wave; t < ntiles; t += nblk * 8) sgemm_wave_tile((t / ntn) * 32, (t % ntn) * 32, 1024, ar, br, e, lane); }
}
struct EpiMix { const float *x, *rowstat, *lng, *lnb, *mod, *b_out; float* out;
    __device__ __forceinline__ void operator()(int r, int n, float v) const {
        const int b = r >> 12; const float x0 = (x[(size_t)r * 1024 + n] - rowstat[2 * r]) * rowstat[2 * r + 1] * lng[n] + lnb[n];
        out[(size_t)r * 1024 + n] = ALPHA * x0 + mod[b * 6144 + 2048 + n] * (v + b_out[n]); } };
__device__ __forceinline__ void phase_mix_s(const P& p, int bid, int nblk) {
    const int tid_ = tid_opaque(); const int wave = tid_ >> 6, lane = tid_ & 63; unsigned char* ws = p.ws;
    const int ntn = 1024 / 32, ntiles = (NTOK / 32) * ntn;
    ARowDense ar{(const bf16_t*)(ws + WS_INNER), 1024}, br{(const bf16_t*)(ws + WS_WOUT), 1024};
    EpiMix e{p.x, (const float*)(ws + WS_ROWSTAT), p.ln_x_g, p.ln_x_b, (const float*)(ws + WS_MOD), p.b_out, p.out};
    for (int t = bid * 8 + wave; t < ntiles; t += nblk * 8) sgemm_wave_tile((t / ntn) * 32, (t % ntn) * 32, 1024, ar, br, e, lane);
}

constexpr int RT_LDS_W = 0, RT_LDS_CNT = 131072, RT_LDS_BASE = RT_LDS_CNT + 128, RT_LDS_REC = RT_LDS_BASE + 128, RT_MAXIT = 32, RT_LDS_END = RT_LDS_REC + 8 * RT_MAXIT * 8 * 4;
__device__ __forceinline__ int rw_off(int prow, int ch) { return prow * 128 + ((ch ^ ((prow >> 1) & 7)) << 4); }
__device__ __forceinline__ void phase_router(const P& p, int bid, int nblk, unsigned char* lds) {
    const int tid = tid_opaque(), wave = tid >> 6, lane = tid & 63;
    int* cnt = (int*)(lds + RT_LDS_CNT); int* base = (int*)(lds + RT_LDS_BASE); int* rec = (int*)(lds + RT_LDS_REC) + wave * RT_MAXIT * 8;
    for (int k = tid; k < 1024; k += 512) { const int l = (k & 255) >> 2, i = k & 3, j = k >> 8, prow = l + 64 * (4 * j + i);
        const f32x4* src = (const f32x4*)(p.router_w + (size_t)k * 32);
#pragma unroll
        for (int ch = 0; ch < 8; ++ch) *(f32x4*)(lds + RT_LDS_W + rw_off(prow, ch)) = src[ch]; }
    if (tid < 32) cnt[tid] = 0;
    __syncthreads();
    const float* mod = (const float*)(p.ws + WS_MOD);
    int* TOPE = (int*)(p.ws + WS_TOPE); float* TOPG = (float*)(p.ws + WS_TOPG); int* SLOT = (int*)(p.ws + WS_SLOT);
    bf16_t* U2 = (bf16_t*)(p.ws + WS_U);
    const int erev = 16 * ((lane >> 4) & 1) + (int)(__builtin_bitreverse32((unsigned)(lane & 15)) >> 28);
    unsigned wb[8];
#pragma unroll
    for (int ch = 0; ch < 8; ++ch) wb[ch] = RT_LDS_W + lane * 128 + ((ch ^ ((lane >> 1) & 7)) << 4);
    int it = 0;
    u32x2 pre[4];
    { const int row0 = bid * 8 + wave; if (row0 < NTOK) { const u32x2* xin0 = (const u32x2*)((const bf16_t*)(p.ws + WS_X1PRE) + (size_t)row0 * DM) + lane;
#pragma unroll
        for (int j = 0; j < 4; ++j) pre[j] = xin0[64 * j]; } }
    for (int row = bid * 8 + wave; row < NTOK; row += nblk * 8, ++it) {
        const int b = row >> 12;
        u32x2* xr = (u32x2*)((bf16_t*)(p.ws + WS_X1) + (size_t)row * DM) + lane;
        f32x4 v[4]; float s = 0.f;
#pragma unroll
        for (int j = 0; j < 4; ++j) { const u32x2 w = pre[j]; v[j] = (f32x4){bflo(w.x), bfhi(w.x), bflo(w.y), bfhi(w.y)}; s += (v[j].x + v[j].y) + (v[j].z + v[j].w); }
        { const int rown = row + nblk * 8; if (rown < NTOK) { const u32x2* xinn = (const u32x2*)((const bf16_t*)(p.ws + WS_X1PRE) + (size_t)rown * DM) + lane;
#pragma unroll
            for (int j = 0; j < 4; ++j) pre[j] = xinn[64 * j]; } }
        const float mean = wave_sum(s) * (1.f / DM); float s2 = 0.f;
#pragma unroll
        for (int j = 0; j < 4; ++j) { v[j] = v[j] - mean; s2 += (v[j].x * v[j].x + v[j].y * v[j].y) + (v[j].z * v[j].z + v[j].w * v[j].w); }
        const float rstd = 1.f / sqrtf(wave_sum(s2) * (1.f / DM) + LN_EPS);
        u32x2* o8 = (u32x2*)(U2 + (size_t)row * DM) + lane;
        int lane_o = lane; asm volatile("" : "+v"(lane_o));
        f32x4 u[4];
#pragma unroll
        for (int j = 0; j < 4; ++j) { const int col = 4 * lane_o + 256 * j;
            const f32x4 gg = *(const f32x4*)(p.ln1_g + col), bb = *(const f32x4*)(p.ln1_b + col);
            const f32x4 shv = *(const f32x4*)(mod + b * 6144 + 3072 + col), scv = *(const f32x4*)(mod + b * 6144 + 4096 + col);
            const f32x4 x1 = (v[j] * rstd) * gg + bb; { u32x2 w; w.x = pk2(x1.x, x1.y); w.y = pk2(x1.z, x1.w); xr[64 * j] = w; }
            u[j] = x1 * (1.0f + scv) + shv;
            u32x2 w; w.x = pk2(u[j].x, u[j].y); w.y = pk2(u[j].z, u[j].w); o8[64 * j] = w; }
        float lg2[2];
#pragma unroll
        for (int hf = 0; hf < 2; ++hf) {
            float a[16];
#pragma unroll
            for (int e = 0; e < 16; ++e) a[e] = 0.f;
#pragma unroll
            for (int j = 0; j < 4; ++j)
#pragma unroll
                for (int i = 0; i < 4; ++i) { const float uv = u[j][i];
#pragma unroll
                    for (int ch = 0; ch < 4; ++ch) { const f32x4 w4 = *(const f32x4*)(lds + wb[4 * hf + ch] + (4 * j + i) * 8192);
                        a[4 * ch + 0] += uv * w4.x; a[4 * ch + 1] += uv * w4.y; a[4 * ch + 2] += uv * w4.z; a[4 * ch + 3] += uv * w4.w; } }
#pragma unroll
            for (int st = 0; st < 4; ++st) { const int n = 8 >> st; const bool up = (lane >> st) & 1;
#pragma unroll
                for (int i = 0; i < n; ++i) { float lo = a[i], hi = a[n + i]; asm volatile("" : "+v"(lo), "+v"(hi));
                    const float keep = up ? hi : lo, send = up ? lo : hi; a[i] = keep + __shfl_xor(send, 1 << st); } }
            float r = a[0]; r += __shfl_xor(r, 16); r += __shfl_xor(r, 32); lg2[hf] = r;
        }
        float logit = ((lane >> 4) & 1) ? lg2[1] : lg2[0];
        logit += p.router_b[erev];
        float cur = logit;
#define TOP_STEP(TV, TE) float TV; int TE; { const float mx = wave_max(cur); int cand = (cur == mx) ? erev : 64; \
            cand = min(cand, __shfl_xor(cand, 1)); cand = min(cand, __shfl_xor(cand, 2)); cand = min(cand, __shfl_xor(cand, 4)); \
            cand = min(cand, __shfl_xor(cand, 8)); cand = min(cand, __shfl_xor(cand, 16)); cand = min(cand, __shfl_xor(cand, 32)); \
            TV = mx; TE = cand; if (erev == cand) cur = -INFINITY; }
        TOP_STEP(tv0, te0) TOP_STEP(tv1, te1) TOP_STEP(tv2, te2) TOP_STEP(tv3, te3)
#undef TOP_STEP
        const float gk0 = 1.0f, gk1 = __expf(tv1 - tv0), gk2 = __expf(tv2 - tv0), gk3 = __expf(tv3 - tv0);
        const float ginv = 1.f / (gk0 + gk1 + gk2 + gk3);
        if (lane < 4) { const int e = lane == 0 ? te0 : lane == 1 ? te1 : lane == 2 ? te2 : te3; const float g = lane == 0 ? gk0 : lane == 1 ? gk1 : lane == 2 ? gk2 : gk3;
            const int pos = atomicAdd(&cnt[e], 1);
            TOPE[row * 4 + lane] = e; TOPG[row * 4 + lane] = g * ginv;
            if (it < RT_MAXIT) { rec[it * 8 + lane * 2] = e; rec[it * 8 + lane * 2 + 1] = pos; } }
    }
    __syncthreads();
    if (tid < 32) base[tid] = atomicAdd((int*)(p.ws + WS_CTL) + tid, cnt[tid]);
    __syncthreads();
    it = 0;
    int* PERM2 = (int*)(p.ws + WS_PERM2);
    for (int row = bid * 8 + wave; row < NTOK; row += nblk * 8, ++it)
        if (lane < 4 && it < RT_MAXIT) { const int e = rec[it * 8 + lane * 2], pos = base[e] + rec[it * 8 + lane * 2 + 1]; SLOT[row * 4 + lane] = pos; PERM2[(size_t)e * NTOK + pos] = row; }
}
constexpr int MT_LDS = 131072 + 1024;
__device__ __forceinline__ void moe_tables(const P& p, unsigned char* lds) {
    const int tid = tid_opaque(); int* cn = (int*)(lds + MT_LDS); int* eb = cn + 32; int* tb = eb + 33;
    __syncthreads();
    if (tid < 32) cn[tid] = __hip_atomic_load((int*)(p.ws + WS_CTL) + tid, __ATOMIC_RELAXED, __HIP_MEMORY_SCOPE_AGENT);
    __syncthreads();
    if (tid == 0) { int s = 0, t = 0; for (int e = 0; e < 32; ++e) { eb[e] = s; tb[e] = t; s += cn[e]; t += (cn[e] + 255) >> 8; } eb[32] = s; tb[32] = t; }
    __syncthreads();
}
struct FinIdx { int e[4]; int pos[4]; float g[4]; };
struct FinData { u32x4 ys[4]; u32x4 x[2]; };
__device__ __forceinline__ void fin_load_idx(const P& p, int row, FinIdx& r) {
    const u32x4 ev = *(const u32x4*)((const int*)(p.ws + WS_TOPE) + row * 4), pv = *(const u32x4*)((const int*)(p.ws + WS_SLOT) + row * 4); const f32x4 gv = *(const f32x4*)((const float*)(p.ws + WS_TOPG) + row * 4);
#pragma unroll
    for (int k = 0; k < 4; ++k) { r.e[k] = (int)ev[k]; r.pos[k] = (int)pv[k]; r.g[k] = gv[k] * (1.0f / YS_F8_SCALE); }
}
__device__ __forceinline__ void fin_load_data(const P& p, const int* eb, int row, const FinIdx& ix, FinData& d, int lane) {
    const unsigned char* YS = p.ws + WS_YS;
#pragma unroll
    for (int k = 0; k < 4; ++k) { const size_t slot = (size_t)(eb[ix.e[k]] + ix.pos[k]); d.ys[k] = *(const u32x4*)(YS + slot * 1024 + 16 * lane); }
    const u32x4* xr = (const u32x4*)((const bf16_t*)(p.ws + WS_X1) + (size_t)row * DM + 16 * lane); d.x[0] = xr[0]; d.x[1] = xr[1];
}
__device__ __forceinline__ void phase_final(const P& p, int bid, int nblk, unsigned char* lds) {
    moe_tables(p, lds); const int* eb = (const int*)(lds + MT_LDS) + 32;
    const int tid = tid_opaque(), wave = tid >> 6, lane = tid & 63;
    const float* mod = (const float*)(p.ws + WS_MOD);
    const int stride = nblk * 8;
    int row = bid * 8 + wave; if (row >= NTOK) return;
    FinIdx ic, in; FinData dc, dn;
    fin_load_idx(p, row, ic); fin_load_data(p, eb, row, ic, dc, lane);
    int row_n = row + stride; if (row_n < NTOK) fin_load_idx(p, row_n, in);
#pragma unroll 1
    for (;;) {
        if (row_n < NTOK) fin_load_data(p, eb, row_n, in, dn, lane);
        const int row_nn = row_n + stride; FinIdx inn; if (row_nn < NTOK) fin_load_idx(p, row_nn, inn);
        const int b = row >> 12, col = 16 * lane;
        f32x4 v[4]; float s = 0.f;
#pragma unroll
        for (int q = 0; q < 4; ++q) v[q] = (f32x4){0.f, 0.f, 0.f, 0.f};
#pragma unroll
        for (int k = 0; k < 4; ++k) { const u32x4 w = dc.ys[k]; const float g = ic.g[k];
            v[0] += unpack4_f8(w.x) * g; v[1] += unpack4_f8(w.y) * g; v[2] += unpack4_f8(w.z) * g; v[3] += unpack4_f8(w.w) * g; }
#pragma unroll
        for (int q = 0; q < 4; ++q) { const u32x4 xw = dc.x[q >> 1]; const unsigned w0 = (q & 1) ? xw.z : xw.x, w1 = (q & 1) ? xw.w : xw.y;
            const f32x4 xa = (f32x4){bflo(w0), bfhi(w0), bflo(w1), bfhi(w1)}; const f32x4 g2 = *(const f32x4*)(mod + b * 6144 + 5120 + col + 4 * q);
            v[q] = xa * ALPHA + g2 * v[q]; s += (v[q].x + v[q].y) + (v[q].z + v[q].w); }
        const float mean = wave_sum(s) * (1.f / DM); float s2 = 0.f;
#pragma unroll
        for (int q = 0; q < 4; ++q) { v[q] = v[q] - mean; s2 += (v[q].x * v[q].x + v[q].y * v[q].y) + (v[q].z * v[q].z + v[q].w * v[q].w); }
        const float rstd = 1.f / sqrtf(wave_sum(s2) * (1.f / DM) + LN_EPS);
        f32x4* xo = (f32x4*)(p.out + (size_t)row * DM + col);
#pragma unroll
        for (int q = 0; q < 4; ++q) { const f32x4 gg = *(const f32x4*)(p.ln2_g + col + 4 * q), bb = *(const f32x4*)(p.ln2_b + col + 4 * q); xo[q] = (v[q] * rstd) * gg + bb; }
        if (row_n >= NTOK) break;
        row = row_n; row_n = row_nn; ic = in; in = inn; dc = dn;
    }
}

namespace pg {
#define PG_LAS __attribute__((address_space(3)))
typedef float f32x2 __attribute__((ext_vector_type(2)));
constexpr int BM = 256, BK = 64, HALF = 128, HTB = HALF * BK * 2, STAGE_BYTES = 8 * HTB, KD = 1024, NT = KD / BK;
constexpr unsigned KSTEP = BK * 2, HSTEPB = HALF * KD * 2;
__host__ __device__ __forceinline__ int lds_byte(int r, int c) { const int st = (r >> 4) * 2 + (c >> 5), rr = r & 15, cc = c & 31, ob = rr * 64 + cc * 2; return st * 1024 + (ob ^ (((ob >> 9) & 1) << 5)); }
__host__ __device__ __forceinline__ void stage_rc(int b, int& R, int& C) { const int st = b / 1024, sb = b % 1024, swz = sb ^ (((sb >> 9) & 1) << 5); R = (st >> 1) * 16 + swz / 64; C = (st & 1) * 32 + (swz % 64) / 2; }
__host__ __device__ __forceinline__ int perm32(int rho) { const int n = rho >> 4, i = rho & 15; return 8 * (i >> 2) + 4 * n + (i & 3); }
struct Unit { int pm, pn, row0, nrows, e, kind; };
__device__ __forceinline__ void tilemap(int L, int nM, int nN, int& pm, int& pn) {
    int wgid = L; { const int nwg = nM * nN, q = nwg / 8, r = nwg % 8, xcd = wgid % 8, off = wgid / 8; wgid = (xcd < r ? xcd * (q + 1) : r * (q + 1) + (xcd - r) * q) + off; }
    const int nig = 8 * nN, gid = wgid / nig, fm = gid * 8, gsz = (nM - fm) < 8 ? (nM - fm) : 8;
    pm = fm + ((wgid % nig) % gsz); pn = (wgid % nig) / gsz;
}
__device__ __forceinline__ unsigned cvt_pk_bf16(float lo, float hi) { unsigned r; asm volatile("v_cvt_pk_bf16_f32 %0, %1, %2" : "=v"(r) : "v"(lo), "v"(hi)); return r; }
__device__ __forceinline__ f32x2 gelu_pk(f32x2 v) {
    const f32x2 av = __builtin_elementwise_abs(v), d = av * 0.2316418882f + 1.0f;
    f32x2 t; t.x = __builtin_amdgcn_rcpf(d.x); t.y = __builtin_amdgcn_rcpf(d.y);
    f32x2 q = t * 0.5307027145f + (-0.7265760135f); q = q * t + 0.7107068705f; q = q * t + (-0.142248368f); q = q * t + 0.127414796f; q = q * t;
    const f32x2 s = (v * v) * (-0.72134752044f);
    f32x2 e; e.x = __builtin_amdgcn_exp2f(s.x); e.y = __builtin_amdgcn_exp2f(s.y);
    const f32x2 m = v * (q * e), r = v - m;
    f32x2 o; o.x = v.x < 0.f ? m.x : r.x; o.y = v.y < 0.f ? m.y : r.y; return o;
}
__device__ __forceinline__ f32x4 gelu4(f32x4 v) { const f32x2 a = gelu_pk((f32x2){v[0], v[1]}), b = gelu_pk((f32x2){v[2], v[3]}); return (f32x4){a.x, a.y, b.x, b.y}; }
__device__ __forceinline__ f32x4 sigmoid4(f32x4 v) { f32x4 o;
#pragma unroll
    for (int i = 0; i < 4; ++i) o[i] = __builtin_amdgcn_rcpf(1.0f + __builtin_amdgcn_exp2f(-1.4426950408889634f * v[i]));
    return o; }
__device__ __forceinline__ u32x4 pack8v(f32x4 a, f32x4 b) { u32x4 w; w.x = cvt_pk_bf16(a[0], a[1]); w.y = cvt_pk_bf16(a[2], a[3]); w.z = cvt_pk_bf16(b[0], b[1]); w.w = cvt_pk_bf16(b[2], b[3]); return w; }

template <class Epi, class Sched, bool ALIGN_EPI>
__device__ __forceinline__ void gemm_phase(PG_LAS unsigned char* lds, const unsigned char* Abase, const Sched& S, const Epi& E) {
    const int tid = tid_opaque(), wid = __builtin_amdgcn_readfirstlane(tid >> 6), lane = tid & 63, wr = wid >> 2, wc = wid & 3, fr = lane & 15, fq = lane >> 4;
    int R[2], C[2]; unsigned voffB[2];
#pragma unroll
    for (int i = 0; i < 2; ++i) { stage_rc(tid * 16 + i * 8192, R[i], C[i]);
        const int rho = R[i] & 31, Rb = Epi::PERM == 0 ? R[i] : (Epi::PERM == 1 ? ((R[i] & ~31) + perm32(rho)) : ((R[i] >> 5) * 64 + 16 * ((rho & 15) >> 2) + 4 * (rho >> 4) + (rho & 3)));
        voffB[i] = (unsigned)(Rb * KD + C[i]) * 2u; }
    constexpr unsigned HSB = Epi::PERM == 2 ? 8u * KD * 2u : HSTEPB;
    const unsigned ldsw = (unsigned)wid * 1024u;
    const int aoff = lds_byte(wr * 64 + fr, fq * 8), boff = lds_byte(wc * 32 + fr, fq * 8);
#define PG_SA(b, h) (((b) * 2 + (h)) * HTB)
#define PG_SB(b, h) ((4 + (b) * 2 + (h)) * HTB)
#define PG_STAGE_A(bufoff, kbyte, vo) do { _Pragma("unroll") for (int _i = 0; _i < 2; ++_i) \
        __builtin_amdgcn_global_load_lds((const unsigned*)((const char*)Abase + (kbyte) + (vo)[_i]), (PG_LAS unsigned*)(lds + (bufoff) + ldsw + _i * 8192), 16, 0, 0); } while (0)
#define PG_STAGE_B(bufoff, gbase) do { _Pragma("unroll") for (int _i = 0; _i < 2; ++_i) \
        __builtin_amdgcn_global_load_lds((const unsigned*)((const char*)(gbase) + voffB[_i]), (PG_LAS unsigned*)(lds + (bufoff) + ldsw + _i * 8192), 16, 0, 0); } while (0)
#define PG_LDA(dst, b, h) do { _Pragma("unroll") for (int m = 0; m < 4; ++m) _Pragma("unroll") for (int k = 0; k < 2; ++k) dst[m][k] = *(const PG_LAS bf16x8*)(lds + PG_SA(b, h) + aoff + m * 2048 + k * 1024); } while (0)
#define PG_LDB(dst, b, h) do { _Pragma("unroll") for (int n = 0; n < 2; ++n) _Pragma("unroll") for (int k = 0; k < 2; ++k) dst[n][k] = *(const PG_LAS bf16x8*)(lds + PG_SB(b, h) + boff + n * 2048 + k * 1024); } while (0)
#define PG_MMA(ai, bj, At, Bt) do { __builtin_amdgcn_s_setprio(1); _Pragma("unroll") for (int m = 0; m < 4; ++m) _Pragma("unroll") for (int n = 0; n < 2; ++n) _Pragma("unroll") for (int k = 0; k < 2; ++k) \
        acc[ai][bj][m][n] = __builtin_amdgcn_mfma_f32_16x16x32_bf16(Bt[n][k], At[m][k], acc[ai][bj][m][n], 0, 0, 0); __builtin_amdgcn_s_setprio(0); } while (0)
#define PG_WAIT_V(n) asm volatile("s_waitcnt vmcnt(" #n ")" ::: "memory")
#define PG_WAIT_L(n) asm volatile("s_waitcnt lgkmcnt(" #n ")" ::: "memory")
#define PG_BAR __builtin_amdgcn_s_barrier()
#define PG_SCHED __builtin_amdgcn_sched_barrier(0)
    Unit cur, nxt; int ui = 0;
    if (!S.next(0, cur)) return;
    f32x4 acc[2][2][4][2];
#pragma unroll
    for (int a = 0; a < 2; ++a)
#pragma unroll
        for (int b = 0; b < 2; ++b)
#pragma unroll
            for (int m = 0; m < 4; ++m)
#pragma unroll
                for (int n = 0; n < 2; ++n) acc[a][b][m][n] = (f32x4){0.f, 0.f, 0.f, 0.f};
    bf16x8 At[4][2], B0[2][2], B1[2][2];
    unsigned ac[2][2], an[2][2];
    S.aoffs(cur, R, C, ac);
    const char* cB = S.bptr(cur);
    PG_STAGE_B(PG_SB(0, 0), cB); PG_STAGE_B(PG_SB(0, 1), cB + HSB); PG_STAGE_A(PG_SA(0, 0), 0u, ac[0]); PG_STAGE_A(PG_SA(0, 1), 0u, ac[1]);
    if (wr == 1) PG_BAR;
    PG_WAIT_V(2); PG_BAR;
    PG_STAGE_B(PG_SB(1, 0), cB + KSTEP); PG_STAGE_A(PG_SA(1, 0), KSTEP, ac[0]); PG_STAGE_B(PG_SB(1, 1), cB + HSB + KSTEP);
    PG_WAIT_V(6); PG_BAR;
    for (;;) {
        const bool has_next = S.next(ui + 1, nxt);
        const char* nB = cB;
        if (has_next) { S.aoffs(nxt, R, C, an); nB = S.bptr(nxt); }
        else {
#pragma unroll
            for (int h = 0; h < 2; ++h)
#pragma unroll
                for (int i = 0; i < 2; ++i) an[h][i] = ac[h][i]; }
        for (int t = 0; t < NT; t += 2) {
            const bool last = (t == NT - 2);
            const unsigned ka1 = (unsigned)(t + 1) * KSTEP;
            const unsigned ka2 = last ? 0u : (unsigned)(t + 2) * KSTEP;
            const char* b2 = last ? nB : cB + (size_t)(t + 2) * KSTEP; const char* b3 = b2 + KSTEP;
            unsigned a2o[2][2];
#pragma unroll
            for (int h = 0; h < 2; ++h)
#pragma unroll
                for (int i = 0; i < 2; ++i) a2o[h][i] = last ? an[h][i] : ac[h][i];
            PG_LDB(B0, 0, 0); PG_LDB(B1, 0, 1); PG_SCHED; PG_LDA(At, 0, 0); PG_STAGE_A(PG_SA(1, 1), ka1, ac[1]);
            PG_WAIT_V(8); PG_WAIT_L(0); PG_BAR; PG_MMA(0, 0, At, B0); PG_MMA(0, 1, At, B1); PG_BAR; PG_SCHED;
            PG_LDA(At, 0, 1); PG_STAGE_B(PG_SB(0, 0), b2); PG_STAGE_B(PG_SB(0, 1), b2 + HSB); PG_STAGE_A(PG_SA(0, 0), ka2, a2o[0]);
            PG_WAIT_V(8); PG_WAIT_L(0); PG_BAR; PG_MMA(1, 0, At, B0); PG_MMA(1, 1, At, B1); PG_BAR; PG_SCHED;
            PG_LDB(B0, 1, 0); PG_LDB(B1, 1, 1); PG_SCHED; PG_LDA(At, 1, 0); PG_STAGE_A(PG_SA(0, 1), ka2, a2o[1]);
            PG_WAIT_V(8); PG_WAIT_L(0); PG_BAR; PG_MMA(0, 0, At, B0); PG_MMA(0, 1, At, B1); PG_BAR; PG_SCHED;
            PG_LDA(At, 1, 1); PG_STAGE_B(PG_SB(1, 0), b3); PG_STAGE_B(PG_SB(1, 1), b3 + HSB); PG_STAGE_A(PG_SA(1, 0), ka2 + KSTEP, a2o[0]);
            PG_WAIT_V(8); PG_WAIT_L(0); PG_BAR; PG_MMA(1, 0, At, B0); PG_MMA(1, 1, At, B1); PG_BAR; PG_SCHED;
        }
        if constexpr (ALIGN_EPI) { if (wr == 0) PG_BAR; }
        E.run(acc, cur, wr, wc, fr, fq);
        if (!has_next) break;
        if (!E.carry(cur)) {
#pragma unroll
            for (int a = 0; a < 2; ++a)
#pragma unroll
                for (int b = 0; b < 2; ++b)
#pragma unroll
                    for (int m = 0; m < 4; ++m)
#pragma unroll
                        for (int n = 0; n < 2; ++n) acc[a][b][m][n] = (f32x4){0.f, 0.f, 0.f, 0.f}; }
        cur = nxt; cB = nB; ++ui;
#pragma unroll
        for (int h = 0; h < 2; ++h)
#pragma unroll
            for (int i = 0; i < 2; ++i) ac[h][i] = an[h][i];
        if constexpr (ALIGN_EPI) { if (wr == 1) PG_BAR; }
    }
    PG_WAIT_V(0);
    if constexpr (!ALIGN_EPI) { if (wr == 0) PG_BAR; }
    PG_BAR;
#undef PG_SA
#undef PG_SB
#undef PG_STAGE_A
#undef PG_STAGE_B
#undef PG_LDA
#undef PG_LDB
#undef PG_MMA
#undef PG_WAIT_V
#undef PG_WAIT_L
#undef PG_BAR
#undef PG_SCHED
}

struct SchedP1 {
    int G, c; const unsigned char* ws;
    __device__ __forceinline__ bool next(int i, Unit& u) const {
        const int L = i * G + c; if (L >= 3136) return false;
        u.row0 = 0; u.nrows = 256; u.e = 0;
        if (L < 2048) { u.kind = 0; tilemap(L, 128, 16, u.pm, u.pn); }
        else if (L < 3072) { u.kind = 1; tilemap(L - 2048, 8, 128, u.pm, u.pn); }
        else if (L < 3104) { u.kind = 2; const int l = L - 3072; u.pm = l >> 2; u.pn = l & 3; }
        else { u.kind = 3; const int l = L - 3104; u.pm = l >> 3; u.pn = l & 7; }
        return true; }
    __device__ __forceinline__ void aoffs(const Unit& u, const int (&R)[2], const int (&C)[2], unsigned (&o)[2][2]) const {
        size_t base; int row0;
        if (u.kind == 0) { base = WS_U; row0 = 256 * u.pm; }
        else if (u.kind == 1) { base = WS_WIN; row0 = u.pm < 4 ? 1024 + 256 * u.pm : 4096 + 256 * (u.pm - 4); }
        else if (u.kind == 2) { base = WS_UC; row0 = 256 * u.pm; }
        else { base = WS_WIN; row0 = 4096 + 256 * u.pm; }
#pragma unroll
        for (int h = 0; h < 2; ++h)
#pragma unroll
            for (int i = 0; i < 2; ++i) o[h][i] = (unsigned)(base + ((size_t)(row0 + 128 * h + R[i]) * 1024 + C[i]) * 2); }
    __device__ __forceinline__ const char* bptr(const Unit& u) const {
        if (u.kind == 0) { const int wrow = u.pn < 4 ? 256 * u.pn : (u.pn < 8 ? 2048 + 256 * (u.pn - 4) : 5120 + 256 * (u.pn - 8)); return (const char*)ws + WS_WIN + (size_t)wrow * 2048; }
        if (u.kind == 1) return (const char*)ws + WS_U + (size_t)u.pn * 256 * 2048;
        if (u.kind == 2) return (const char*)ws + WS_WIN + (size_t)(3072 + 256 * u.pn) * 2048;
        return (const char*)ws + WS_UC + (size_t)u.pn * 256 * 2048; }
};
struct EpiP1 {
    static constexpr int PERM = 1;
    unsigned char* ws; const float* b_in;
    __device__ __forceinline__ bool carry(const Unit&) const { return false; }
    __device__ __forceinline__ void run(f32x4 (&acc)[2][2][4][2], const Unit& u, int wr, int wc, int fr, int fq) const {
        const int lc = wc * 32 + 8 * fq, kind = u.kind, pm = u.pm, pn = u.pn;
        const bool brow = (kind == 1) || (kind == 3);
        int act, bcol, browbase, RA, RB, CA, CB; size_t base;
        if (kind == 0) { browbase = 0;
            if (pn < 4) { act = 1; bcol = 256 * pn; base = WS_ZU / 2 + (size_t)256 * pm * 1024 + 256 * pn; RA = 65536; RB = 1024; CA = 64; CB = 1; }
            else if (pn < 8) { act = 0; bcol = 2048 + 256 * (pn - 4); const int tok0 = 256 * pm;
                base = WS_Q / 2 + ((size_t)((tok0 >> 12) * 16 + 4 * (pn - 4)) * 4096 + (tok0 & 4095)) * 64; RA = 4096; RB = 64; CA = 4096 * 64; CB = 1; }
            else { act = 2; bcol = 5120 + 256 * (pn - 8); base = WS_G / 2 + (size_t)256 * pm * 2048 + 256 * (pn - 8); RA = 131072; RB = 2048; CA = 64; CB = 1; } }
        else if (kind == 1) { bcol = 0; const int tk0 = 256 * pn;
            if (pm < 4) { act = 1; browbase = 1024 + 256 * pm; base = WS_ZVT / 2 + (size_t)(tk0 >> 3) * 8192 + 256 * pm * 8; RA = 512; RB = 8; CA = 65536; CB = 1024; }
            else { act = 0; browbase = 4096 + 256 * (pm - 4); base = WS_VT / 2 + ((size_t)((tk0 >> 12) * 16 + 4 * (pm - 4)) * 512 + ((tk0 & 4095) >> 3)) * 512; RA = 512 * 512; RB = 8; CA = 4096; CB = 64; } }
        else if (kind == 2) { act = 0; bcol = 3072 + 256 * pn; browbase = 0; base = WS_KC / 2 + (size_t)(pm * 16 + 4 * pn) * 256 * 64; RA = 4096; RB = 64; CA = 16384; CB = 1; }
        else { act = 0; bcol = 0; browbase = 4096 + 256 * pm; base = WS_VCT / 2 + (size_t)(pn * 16 + 4 * pm) * 32 * 512; RA = 32 * 512; RB = 8; CA = 4096; CB = 64; }
        bf16_t* dbase = (bf16_t*)ws + base;
        f32x4 bv[2][2];
#pragma unroll
        for (int bj = 0; bj < 2; ++bj)
#pragma unroll
            for (int n = 0; n < 2; ++n) bv[bj][n] = brow ? (f32x4){0.f, 0.f, 0.f, 0.f} : *(const f32x4*)(b_in + bcol + lc + bj * HALF + 4 * n);
        const int colterm0 = (wc >> 1) * CA + ((wc & 1) * 32 + 8 * fq) * CB;
#pragma unroll
        for (int ai = 0; ai < 2; ++ai)
#pragma unroll
            for (int m = 0; m < 4; ++m) { const int row = ai * HALF + wr * 64 + m * 16 + fr;
                const float rb = brow ? b_in[browbase + row] : 0.f;
                const int rowterm = (2 * ai + wr) * RA + (16 * m + fr) * RB;
#pragma unroll
                for (int bj = 0; bj < 2; ++bj) {
                    f32x4 v0 = acc[ai][bj][m][0] + bv[bj][0] + rb, v1 = acc[ai][bj][m][1] + bv[bj][1] + rb;
                    if (act == 1) { v0 = gelu4(v0); v1 = gelu4(v1); } else if (act == 2) { v0 = sigmoid4(v0); v1 = sigmoid4(v1); }
                    *(u32x4*)(dbase + rowterm + colterm0 + 2 * bj * CA) = pack8v(v0, v1); } }
    }
};
struct SchedK {
    int G, c; const unsigned char* ws;
    __device__ __forceinline__ bool next(int i, Unit& u) const { const int L = i * G + c; if (L >= 512) return false; u.kind = 0; u.row0 = 0; u.nrows = 256; u.e = 0; tilemap(L, 128, 4, u.pm, u.pn); return true; }
    __device__ __forceinline__ void aoffs(const Unit& u, const int (&R)[2], const int (&C)[2], unsigned (&o)[2][2]) const {
#pragma unroll
        for (int h = 0; h < 2; ++h)
#pragma unroll
            for (int i = 0; i < 2; ++i) o[h][i] = (unsigned)(WS_U + ((size_t)(256 * u.pm + 128 * h + R[i]) * 1024 + C[i]) * 2); }
    __device__ __forceinline__ const char* bptr(const Unit& u) const { return (const char*)ws + WS_WIN + (size_t)(3072 + 256 * u.pn) * 2048; }
};
struct EpiRope {
    static constexpr int PERM = 0;
    unsigned char* ws; const float* b_in;
    __device__ __forceinline__ bool carry(const Unit&) const { return false; }
    __device__ __forceinline__ void run(f32x4 (&acc)[2][2][4][2], const Unit& u, int wr, int wc, int fr, int fq) const {
        bf16_t* K = (bf16_t*)(ws + WS_K); const float* tab = (const float*)(ws + WS_ROPE);
        const int lc = wc * 32 + 4 * fq, axis = wc & 1;
        f32x4 b0[2], b1[2];
#pragma unroll
        for (int bj = 0; bj < 2; ++bj) { b0[bj] = *(const f32x4*)(b_in + 3072 + 256 * u.pn + bj * HALF + lc); b1[bj] = *(const f32x4*)(b_in + 3072 + 256 * u.pn + bj * HALF + lc + 16); }
#pragma unroll
        for (int ai = 0; ai < 2; ++ai)
#pragma unroll
            for (int m = 0; m < 4; ++m) { const int tok = 256 * u.pm + ai * HALF + wr * 64 + m * 16 + fr;
                const int pos = axis ? (tok & 63) : ((tok >> 6) & 63);
                const f32x4 t0 = *(const f32x4*)(tab + (pos * 16 + 4 * fq) * 2), t1 = *(const f32x4*)(tab + (pos * 16 + 4 * fq) * 2 + 4);
                const f32x4 cs = (f32x4){t0[0], t0[2], t1[0], t1[2]}, sn = (f32x4){t0[1], t0[3], t1[1], t1[3]};
                const int cc0 = 256 * u.pn + lc;
                bf16_t* rowp = K + ((size_t)((tok >> 12) * 16) * 4096 + (tok & 4095)) * 64;
#pragma unroll
                for (int bj = 0; bj < 2; ++bj) { const f32x4 v0 = acc[ai][bj][m][0] + b0[bj], v1 = acc[ai][bj][m][1] + b1[bj];
                    const f32x4 o0 = v0 * cs - v1 * sn, o1 = v1 * cs + v0 * sn;
                    u32x2 w0, w1; w0.x = cvt_pk_bf16(o0[0], o0[1]); w0.y = cvt_pk_bf16(o0[2], o0[3]); w1.x = cvt_pk_bf16(o1[0], o1[1]); w1.y = cvt_pk_bf16(o1[2], o1[3]);
                    const int cc = cc0 + bj * HALF; bf16_t* dp = rowp + (size_t)(cc >> 6) * 4096 * 64 + (cc & 63);
                    *(u32x2*)dp = w0; *(u32x2*)(dp + 16) = w1; } }
    }
};
struct SchedMerge {
    int G, c; const unsigned char* ws;
    __device__ __forceinline__ bool next(int i, Unit& u) const { const int L = (i >> 1) * G + c; if (L >= 512) return false; u.kind = i & 1; u.row0 = 0; u.nrows = 256; u.e = 0; tilemap(L, 128, 4, u.pm, u.pn); return true; }
    __device__ __forceinline__ void aoffs(const Unit& u, const int (&R)[2], const int (&C)[2], unsigned (&o)[2][2]) const {
        const size_t base = u.kind ? WS_YB : WS_U;
#pragma unroll
        for (int h = 0; h < 2; ++h)
#pragma unroll
            for (int i = 0; i < 2; ++i) o[h][i] = (unsigned)(base + ((size_t)(256 * u.pm + 128 * h + R[i]) * 1024 + C[i]) * 2); }
    __device__ __forceinline__ const char* bptr(const Unit& u) const { return (const char*)ws + (u.kind ? WS_WPB : WS_WPA) + (size_t)u.pn * 256 * 2048; }
};
struct EpiMerge {
    static constexpr int PERM = 1;
    unsigned char* ws;
    __device__ __forceinline__ bool carry(const Unit& u) const { return u.kind == 0; }
    __device__ __forceinline__ void run(f32x4 (&acc)[2][2][4][2], const Unit& u, int wr, int wc, int fr, int fq) const {
        const bf16_t* Gt = (const bf16_t*)(ws + WS_G); bf16_t* INNER = (bf16_t*)(ws + WS_INNER);
        const int lc = 256 * u.pn + wc * 32 + 8 * fq;
#pragma unroll
        for (int ai = 0; ai < 2; ++ai)
#pragma unroll
            for (int m = 0; m < 4; ++m) { const size_t tok = (size_t)(256 * u.pm + ai * HALF + wr * 64 + m * 16 + fr);
#pragma unroll
                for (int bj = 0; bj < 2; ++bj) { const int col = lc + bj * HALF;
                    const u32x4 gbw = *(const u32x4*)(Gt + tok * 2048 + 1024 + col);
                    f32x4 gb0 = (f32x4){bflo(gbw.x), bfhi(gbw.x), bflo(gbw.y), bfhi(gbw.y)}, gb1 = (f32x4){bflo(gbw.z), bfhi(gbw.z), bflo(gbw.w), bfhi(gbw.w)};
                    if (u.kind == 0) { const u32x4 gaw = *(const u32x4*)(Gt + tok * 2048 + col);
                        const f32x4 ga0 = (f32x4){bflo(gaw.x), bfhi(gaw.x), bflo(gaw.y), bfhi(gaw.y)}, ga1 = (f32x4){bflo(gaw.z), bfhi(gaw.z), bflo(gaw.w), bfhi(gaw.w)};
#pragma unroll
                        for (int i = 0; i < 4; ++i) { acc[ai][bj][m][0][i] *= ga0[i] * __builtin_amdgcn_rcpf(fmaxf(gb0[i], 1e-30f)); acc[ai][bj][m][1][i] *= ga1[i] * __builtin_amdgcn_rcpf(fmaxf(gb1[i], 1e-30f)); }
                    } else { *(u32x4*)(INNER + tok * 1024 + col) = pack8v(acc[ai][bj][m][0] * gb0, acc[ai][bj][m][1] * gb1); } } }
    }
};
struct SchedMix {
    int G, c; const unsigned char* ws;
    __device__ __forceinline__ bool next(int i, Unit& u) const { const int L = i * G + c; if (L >= 512) return false; u.kind = 0; u.row0 = 0; u.nrows = 256; u.e = 0; tilemap(L, 128, 4, u.pm, u.pn); return true; }
    __device__ __forceinline__ void aoffs(const Unit& u, const int (&R)[2], const int (&C)[2], unsigned (&o)[2][2]) const {
#pragma unroll
        for (int h = 0; h < 2; ++h)
#pragma unroll
            for (int i = 0; i < 2; ++i) o[h][i] = (unsigned)(WS_INNER + ((size_t)(256 * u.pm + 128 * h + R[i]) * 1024 + C[i]) * 2); }
    __device__ __forceinline__ const char* bptr(const Unit& u) const { return (const char*)ws + WS_WOUT + (size_t)u.pn * 256 * 2048; }
};
struct EpiMix {
    static constexpr int PERM = 0;
    unsigned char* ws; const float *x, *lng, *lnb, *b_out; float* out;
    __device__ __forceinline__ bool carry(const Unit&) const { return false; }
    __device__ __forceinline__ void run(f32x4 (&acc)[2][2][4][2], const Unit& u, int wr, int wc, int fr, int fq) const {
        const float* rowstat = (const float*)(ws + WS_ROWSTAT); const float* mod = (const float*)(ws + WS_MOD) + ((256 * u.pm) >> 12) * 6144 + 2048;
        f32x2 st[2][4];
#pragma unroll
        for (int ai = 0; ai < 2; ++ai)
#pragma unroll
            for (int m = 0; m < 4; ++m) st[ai][m] = *(const f32x2*)(rowstat + 2 * (256 * u.pm + ai * HALF + wr * 64 + m * 16 + fr));
#pragma unroll
        for (int bj = 0; bj < 2; ++bj)
#pragma unroll
            for (int n = 0; n < 2; ++n) { const int col = 256 * u.pn + bj * HALF + wc * 32 + n * 16 + 4 * fq;
                const f32x4 lg = *(const f32x4*)(lng + col), lb = *(const f32x4*)(lnb + col), bo = *(const f32x4*)(b_out + col), g1 = *(const f32x4*)(mod + col);
#pragma unroll
                for (int ai = 0; ai < 2; ++ai)
#pragma unroll
                    for (int m = 0; m < 4; ++m) { const size_t off = (size_t)(256 * u.pm + ai * HALF + wr * 64 + m * 16 + fr) * 1024 + col;
                        const f32x4 xv = *(const f32x4*)(x + off);
                        const f32x4 x0 = (xv - st[ai][m].x) * st[ai][m].y * lg + lb;
                        const f32x4 r = x0 * ALPHA + g1 * (acc[ai][bj][m][n] + bo); u32x2 w; w.x = cvt_pk_bf16(r[0], r[1]); w.y = cvt_pk_bf16(r[2], r[3]);
                        *(u32x2*)((bf16_t*)(ws + WS_X1PRE) + off) = w; }
                asm volatile("" ::: "memory"); }
    }
};
__device__ __forceinline__ int ld_u(const int* p) { return __builtin_amdgcn_readfirstlane(__hip_atomic_load(p, __ATOMIC_RELAXED, __HIP_MEMORY_SCOPE_AGENT)); }
template <int NPN  > struct SchedMoe {
    int G, c; const unsigned char* ws; const int* tabs;
    __device__ __forceinline__ bool next(int i, Unit& u) const {
        const int* cn = tabs; const int* eb = tabs + 32; const int* tb = tabs + 65;
        const int ntiles = tb[32], tpx = (ntiles + 7) >> 3, x = c & 7, s = c >> 3;
        const int tiles_x = min(tpx, ntiles - x * tpx), ll = i * (G >> 3) + s;
        if (ll >= NPN * tiles_x) return false;
        const int T = x * tpx + ll / NPN; u.pn = ll % NPN; u.kind = 0;
        int e = 0;
#pragma unroll 1
        for (int k = 16; k >= 1; k >>= 1) if (tb[e + k] <= T) e += k;
        const int jt = T - tb[e];
        u.e = __builtin_amdgcn_readfirstlane(e); u.pm = __builtin_amdgcn_readfirstlane(jt);
        u.row0 = __builtin_amdgcn_readfirstlane(eb[e] + 256 * jt); u.nrows = __builtin_amdgcn_readfirstlane(min(256, cn[e] - 256 * jt)); return true; }
    __device__ __forceinline__ void aoffs(const Unit& u, const int (&R)[2], const int (&C)[2], unsigned (&o)[2][2]) const {
        const int* PERM2 = (const int*)(ws + WS_PERM2) + (size_t)u.e * NTOK + 256 * u.pm;
#pragma unroll
        for (int h = 0; h < 2; ++h)
#pragma unroll
            for (int i = 0; i < 2; ++i) { const int lr = min(128 * h + R[i], u.nrows - 1);
                if (NPN == 8) { const int tok = PERM2[lr]; o[h][i] = (unsigned)(WS_U + ((size_t)tok * 1024 + C[i]) * 2); }
                else o[h][i] = (unsigned)(WS_ACT + ((size_t)(u.row0 + lr) * 1024 + C[i]) * 2); } }
    __device__ __forceinline__ const char* bptr(const Unit& u) const {
        if (NPN == 8) return (const char*)ws + WS_W1 + ((size_t)u.e * 2048 + 256 * u.pn) * 2048;
        return (const char*)ws + WS_W2 + ((size_t)u.e * 1024 + 256 * u.pn) * 2048; }
};
struct EpiMoe1 {
    static constexpr int PERM = 1;
    unsigned char* ws; const float* b1;
    __device__ __forceinline__ bool carry(const Unit&) const { return false; }
    __device__ __forceinline__ void run(f32x4 (&acc)[2][2][4][2], const Unit& u, int wr, int wc, int fr, int fq) const {
        bf16_t* ACT = (bf16_t*)(ws + WS_ACT);
        const int col = 128 * u.pn + wc * 32 + 8 * fq;
        f32x4 bg[2], bl[2];
#pragma unroll
        for (int n = 0; n < 2; ++n) { bg[n] = *(const f32x4*)(b1 + u.e * 2048 + col + 4 * n); bl[n] = *(const f32x4*)(b1 + u.e * 2048 + 1024 + col + 4 * n); }
#pragma unroll
        for (int ai = 0; ai < 2; ++ai)
#pragma unroll
            for (int m = 0; m < 4; ++m) { const int lr = ai * HALF + wr * 64 + m * 16 + fr;
                f32x4 a[2];
#pragma unroll
                for (int n = 0; n < 2; ++n) { const f32x4 zgv = acc[ai][0][m][n] + bg[n], zlv = acc[ai][1][m][n] + bl[n];
#pragma unroll
                    for (int i = 0; i < 4; ++i) { const float zg = fminf(zgv[i], 7.0f), zl = fminf(fmaxf(zlv[i], -7.0f), 7.0f);
                        a[n][i] = zg * __builtin_amdgcn_rcpf(1.0f + __builtin_amdgcn_exp2f(-1.702f * 1.4426950408889634f * zg)) * (zl + 1.0f); } }
                if (lr < u.nrows) *(u32x4*)(ACT + (size_t)(u.row0 + lr) * 1024 + col) = pack8v(a[0], a[1]); }
    }
};
struct EpiMoe2 {
    static constexpr int PERM = 2;
    unsigned char* ws; const float* b2;
    __device__ __forceinline__ bool carry(const Unit&) const { return false; }
    __device__ __forceinline__ void run(f32x4 (&acc)[2][2][4][2], const Unit& u, int wr, int wc, int fr, int fq) const {
        unsigned char* YS = ws + WS_YS;
        const int lc = 256 * u.pn + wc * 64 + 16 * fq;
        f32x4 bv[2][2];
#pragma unroll
        for (int bj = 0; bj < 2; ++bj)
#pragma unroll
            for (int n = 0; n < 2; ++n) bv[bj][n] = *(const f32x4*)(b2 + u.e * 1024 + lc + 8 * bj + 4 * n);
#pragma unroll
        for (int ai = 0; ai < 2; ++ai)
#pragma unroll
            for (int m = 0; m < 4; ++m) { const int lr = ai * HALF + wr * 64 + m * 16 + fr;
                if (lr < u.nrows) { const u32x2 lo = pack8_f8((acc[ai][0][m][0] + bv[0][0]) * YS_F8_SCALE, (acc[ai][0][m][1] + bv[0][1]) * YS_F8_SCALE), hi = pack8_f8((acc[ai][1][m][0] + bv[1][0]) * YS_F8_SCALE, (acc[ai][1][m][1] + bv[1][1]) * YS_F8_SCALE);
                    u32x4 w; w.x = lo.x; w.y = lo.y; w.z = hi.x; w.w = hi.y; *(u32x4*)(YS + (size_t)(u.row0 + lr) * 1024 + lc) = w; } }
    }
};
}
__device__ __forceinline__ void phase_merge_fast(const P& p, int bid, int nblk, unsigned char* lds) {
    pg::SchedMerge S{nblk, bid, p.ws}; pg::EpiMerge E{p.ws};
    pg::gemm_phase<pg::EpiMerge, pg::SchedMerge, true>((PG_LAS unsigned char*)lds, p.ws, S, E);
}
__device__ __forceinline__ void phase_mix_fast(const P& p, int bid, int nblk, unsigned char* lds) {
    pg::SchedMix S{nblk, bid, p.ws}; pg::EpiMix E{p.ws, p.x, p.ln_x_g, p.ln_x_b, p.b_out, p.out};
    pg::gemm_phase<pg::EpiMix, pg::SchedMix, true>((PG_LAS unsigned char*)lds, p.ws, S, E);
}
__device__ __forceinline__ void phase_moe1_fast(const P& p, int bid, int nblk, unsigned char* lds) {
    moe_tables(p, lds); pg::SchedMoe<8> S{nblk, bid, p.ws, (const int*)(lds + MT_LDS)}; pg::EpiMoe1 E{p.ws, p.exp_b1};
    pg::gemm_phase<pg::EpiMoe1, pg::SchedMoe<8>, true>((PG_LAS unsigned char*)lds, p.ws, S, E);
}
__device__ __forceinline__ void phase_moe2_fast(const P& p, int bid, int nblk, unsigned char* lds) {
    moe_tables(p, lds); pg::SchedMoe<4> S{nblk, bid, p.ws, (const int*)(lds + MT_LDS)}; pg::EpiMoe2 E{p.ws, p.exp_b2};
    pg::gemm_phase<pg::EpiMoe2, pg::SchedMoe<4>, true>((PG_LAS unsigned char*)lds, p.ws, S, E);
}
__device__ __forceinline__ void phase_proj_fast(const P& p, int bid, int nblk, unsigned char* lds) {
    { pg::SchedP1 S{nblk, bid, p.ws}; pg::EpiP1 E{p.ws, p.b_in};
      pg::gemm_phase<pg::EpiP1, pg::SchedP1, true>((PG_LAS unsigned char*)lds, p.ws, S, E); }
    { pg::SchedK S{nblk, bid, p.ws}; pg::EpiRope E{p.ws, p.b_in};
      pg::gemm_phase<pg::EpiRope, pg::SchedK, true>((PG_LAS unsigned char*)lds, p.ws, S, E); }
}

#define LAS __attribute__((address_space(3)))
#define XB_TMO      128
#define XB_XCNT(j)  (256  + 64 * (j))
#define XB_XSUB(j)  (1280 + 64 * (j))
#define XB_XGEN(j)  (2304 + 64 * (j))
#define XB_TOP      3328
#define XB_TOPGEN   3392
#define XCD_BAR_WORDS 3456
#define XB_SPIN_CAP (1u << 22)
__device__ __forceinline__ unsigned xb_ld(unsigned* p)              { return __hip_atomic_load(p, __ATOMIC_RELAXED, __HIP_MEMORY_SCOPE_AGENT); }
__device__ __forceinline__ unsigned xb_add(unsigned* p, unsigned v) { return __hip_atomic_fetch_add(p, v, __ATOMIC_RELAXED, __HIP_MEMORY_SCOPE_AGENT); }
__device__ __forceinline__ unsigned xb_xcc_id() { return (unsigned)__builtin_amdgcn_s_getreg((3 << 11) | 20) & 0xFu; }
#define XB_SPIN(cond, bar) do { unsigned _sp = 0; while (cond) { __builtin_amdgcn_s_sleep(1); \
    if ((++_sp & 255u) == 0u) { if (xb_ld(&(bar)[XB_TMO])) break; if (_sp > XB_SPIN_CAP) { atomicAdd(&(bar)[XB_TMO], 1u); break; } } } } while (0)
struct XcdBarrier { unsigned* bar; unsigned x; volatile LAS unsigned* st; };
__device__ __forceinline__ XcdBarrier xcd_barrier_post(unsigned* bar, volatile LAS unsigned* st) {
    XcdBarrier b; b.bar = bar; b.x = xb_xcc_id(); b.st = st;
    if (threadIdx.x == 0) (void)xb_add(&bar[XB_XCNT(b.x)], 1u);
    return b;
}
__device__ __forceinline__ void xcd_barrier_complete(unsigned* bar, unsigned x, unsigned& nloc, unsigned& nx) {
    const unsigned G = gridDim.x * gridDim.y * gridDim.z;
    unsigned sum, cnt, mine, sp = 0u;
    for (;;) {
        sum = 0u; cnt = 0u; mine = 0u;
#pragma unroll
        for (unsigned j = 0; j < 16; ++j) { const unsigned c = xb_ld(&bar[XB_XCNT(j)]); sum += c; cnt += (c > 0u) ? 1u : 0u; mine = (j == x) ? c : mine; }
        if (sum == G) break;
        __builtin_amdgcn_s_sleep(1);
        if ((++sp & 255u) == 0u) { if (xb_ld(&bar[XB_TMO])) break; if (sp > XB_SPIN_CAP) { atomicAdd(&bar[XB_TMO], 1u); break; } }
    }
    nloc = mine > 0u ? mine : 1u; nx = cnt > 0u ? cnt : 1u;
}
__device__ __forceinline__ void xcd_barrier(const XcdBarrier& b) {
    asm volatile("s_waitcnt vmcnt(0)" ::: "memory");
    __syncthreads();
    if (threadIdx.x == 0) {
        unsigned* bar = b.bar;
        __builtin_amdgcn_s_waitcnt(0);
        unsigned nloc = b.st[0], nx = b.st[1];
        if (nloc == 0u) { xcd_barrier_complete(bar, b.x, nloc, nx); b.st[0] = nloc; b.st[1] = nx; }
        const unsigned old = xb_add(&bar[XB_XSUB(b.x)], 1u);
        const unsigned gen = old / nloc;
        if (old + 1u == (gen + 1u) * nloc) {
            __builtin_amdgcn_fence(__ATOMIC_RELEASE, "agent");
            asm volatile("s_waitcnt vmcnt(0)" ::: "memory");
            const unsigned og = xb_add(&bar[XB_TOP], 1u);
            const unsigned tg = og / nx;
            if (og + 1u == (tg + 1u) * nx) xb_add(&bar[XB_TOPGEN], 1u);
            else XB_SPIN(xb_ld(&bar[XB_TOPGEN]) == tg, bar);
            __builtin_amdgcn_fence(__ATOMIC_ACQUIRE, "agent");
            xb_add(&bar[XB_XGEN(b.x)], 1u);
            asm volatile("s_waitcnt vmcnt(0)" ::: "memory");
        } else {
            XB_SPIN(xb_ld(&bar[XB_XGEN(b.x)]) == gen, bar);
            __builtin_amdgcn_fence(__ATOMIC_ACQUIRE, "agent");
            asm volatile("s_waitcnt vmcnt(0)" ::: "memory");
        }
    }
    __syncthreads();
}
#include <hip/hip_cooperative_groups.h>
namespace cg = cooperative_groups;
constexpr int LDS_BYTES = 147456;
constexpr int XB_LDS = LDS_BYTES - 64;
constexpr int CW_BAR = 4096;
constexpr int REP_PA = 1, REP_PB = 1, REP_P1 = 1, REP_GMLP = 1, REP_ATTN = 1, REP_MERGE = 1, REP_MIX = 1, REP_MOE1 = 1, REP_MOE2 = 1, REP_BAR = 0;
__global__ void __launch_bounds__(512, 2) mega(P p) {
    extern __shared__ __attribute__((aligned(16))) unsigned char lds[];
    const int bid = blockIdx.x, nblk = gridDim.x;
    if (threadIdx.x < 16) ((volatile LAS unsigned*)((LAS unsigned char*)lds + XB_LDS))[threadIdx.x] = 0u;
    __syncthreads();
    const XcdBarrier bar = xcd_barrier_post((unsigned*)(p.ws + WS_CTL) + CW_BAR, (volatile LAS unsigned*)((LAS unsigned char*)lds + XB_LDS));
#define GRID_BAR() xcd_barrier(bar)
#define REP(n) _Pragma("unroll 1") for (int rep_ = 0; rep_ < (n); ++rep_)
    REP(REP_PA) { __syncthreads(); phase_prologue_a(p, bid, nblk, lds); } GRID_BAR();
    REP(REP_PB) phase_prologue_b(p, bid, nblk); GRID_BAR();
    REP(REP_P1) phase_proj_fast(p, bid, nblk, lds); GRID_BAR();
    REP(REP_GMLP) phase_gmlp_fast(p, bid, nblk, lds); REP(REP_ATTN) phase_attn_s(p, bid, nblk, lds); GRID_BAR();
    REP(REP_MERGE) phase_merge_fast(p, bid, nblk, lds); GRID_BAR();
    REP(REP_MIX) phase_mix_fast(p, bid, nblk, lds); GRID_BAR();
    phase_router(p, bid, nblk, lds); GRID_BAR();
    REP(REP_BAR) GRID_BAR();
    REP(REP_MOE1) phase_moe1_fast(p, bid, nblk, lds); GRID_BAR();
    REP(REP_MOE2) phase_moe2_fast(p, bid, nblk, lds); GRID_BAR();
#undef REP
    phase_final(p, bid, nblk, lds);
}

extern "C" void kernel_launch(void* const* d_in, const int* in_sizes, int n_in, void* d_out, int out_size, void* d_ws, size_t ws_size, hipStream_t stream) {
    static int grid = 0;
    if (grid == 0) {
        if (n_in != 31 || out_size != NTOK * DM || ws_size < WS_END) { fprintf(stderr, "kernel_launch: unexpected sizes n_in %d out %d ws %zu\n", n_in, out_size, ws_size); grid = -1; return; }
        int dev = 0, cus = 0, per_cu = 0;
        if (hipGetDevice(&dev) != hipSuccess || hipDeviceGetAttribute(&cus, hipDeviceAttributeMultiprocessorCount, dev) != hipSuccess) { grid = -1; return; }
        if (hipFuncSetAttribute((const void*)mega, hipFuncAttributeMaxDynamicSharedMemorySize, LDS_BYTES) != hipSuccess) { fprintf(stderr, "kernel_launch: hipFuncSetAttribute failed\n"); grid = -1; return; }
        if (hipOccupancyMaxActiveBlocksPerMultiprocessor(&per_cu, (const void*)mega, 512, LDS_BYTES) != hipSuccess || per_cu < 1) { fprintf(stderr, "kernel_launch: occupancy query failed (%d)\n", per_cu); grid = -1; return; }
        grid = cus * 1;
    }
    if (grid < 0) return;
    P p{};
    const float** pp = (const float**)&p;
    for (int i = 0; i < 31; ++i) pp[i] = (const float*)d_in[i];
    p.out = (float*)d_out; p.ws = (unsigned char*)d_ws; p.ph_lo = 0; p.ph_hi = 0;
    if (hipMemsetAsync((char*)d_ws + WS_CTL, 0, 1 * MiB, stream) != hipSuccess) { fprintf(stderr, "kernel_launch: memset failed\n"); return; }
    hipLaunchKernelGGL(mega, dim3(grid), dim3(512), LDS_BYTES, stream, p);
    const hipError_t e = hipPeekAtLastError();
    if (e != hipSuccess) fprintf(stderr, "launch failed: %s (grid %d)\n", hipGetErrorString(e), grid);
}
```

```cpp
#include <hip/hip_runtime.h>
#include <cstdio>
#include <cstdint>

typedef unsigned short bf16_t;
typedef short bf16x8 __attribute__((ext_vector_type(8)));
typedef float f32x4 __attribute__((ext_vector_type(4)));
typedef unsigned u32x4 __attribute__((ext_vector_type(4)));
typedef unsigned u32x2 __attribute__((ext_vector_type(2)));

constexpr int DM = 1024, NB = 8, SEQ = 4096, NTOK = NB * SEQ, CTXL = 256, NCTX = NB * CTXL, INW = 7168;
constexpr int NE = 32, TOPK = 4, FF = 1024, NASSIGN = NTOK * TOPK;
constexpr int NHEAD = 16, HD = 64, GW = 64;
constexpr float LN_EPS = 1e-5f;
constexpr float ALPHA = 1.189207115002721f;
constexpr int MAXTILES = NASSIGN / 256 + NE;

constexpr size_t MiB = 1u << 20;
constexpr size_t WS_CTL = 0;
constexpr size_t WS_MOD = 1 * MiB;
constexpr size_t WS_ROPE = 1 * MiB + 512 * 1024;
constexpr size_t WS_ROWSTAT = 2 * MiB;
constexpr size_t WS_ZSTAT = 2 * MiB + 512 * 1024;
constexpr size_t WS_TOPE = 3 * MiB;
constexpr size_t WS_TOPG = 4 * MiB;
constexpr size_t WS_SLOT = 5 * MiB;
constexpr size_t WS_PERM = 6 * MiB;
constexpr size_t WS_TILES = 7 * MiB;
constexpr size_t WS_WIN = 8 * MiB;
constexpr size_t WS_WPA = 22 * MiB, WS_WPB = 24 * MiB, WS_WOUT = 26 * MiB, WS_WSB = 28 * MiB;
constexpr size_t WS_KC = 30 * MiB;
constexpr size_t WS_VCT = 34 * MiB;
constexpr size_t WS_UC = 38 * MiB;
constexpr size_t WS_PERM2 = 42 * MiB;
constexpr size_t WS_W1 = 48 * MiB;
constexpr size_t WS_W2 = 176 * MiB;
constexpr size_t WS_U = 240 * MiB;
constexpr size_t WS_ZU = 304 * MiB;
constexpr size_t WS_ZVT = 368 * MiB;
constexpr size_t WS_Q = 432 * MiB;
constexpr size_t WS_K = 496 * MiB;
constexpr size_t WS_VT = 560 * MiB;
constexpr size_t WS_G = 624 * MiB;
constexpr size_t WS_YB = 752 * MiB;
constexpr size_t WS_INNER = 816 * MiB;
constexpr size_t WS_ACT = WS_ZU;
constexpr size_t WS_YS = WS_G;
constexpr size_t WS_X1PRE = WS_YB;
constexpr size_t WS_X1 = WS_VT;
constexpr size_t WS_END = 880 * MiB;

struct P {
    const float *x, *c, *ctx, *c_ctx, *ln_x_g, *ln_x_b, *ln_ctx_g, *ln_ctx_b, *w_ada, *b_ada, *w_in, *b_in, *gmlp_ln_g, *gmlp_ln_b, *gmlp_ws, *gmlp_bs,
        *na_rpb, *w_pa, *w_pb, *w_out, *b_out, *ln1_g, *ln1_b, *ln2_g, *ln2_b, *router_w, *router_b, *exp_w1, *exp_b1, *exp_w2, *exp_b2;
    float* out; unsigned char* ws; int ph_lo, ph_hi;
};

__device__ __forceinline__ int tid_opaque() { int t = threadIdx.x; asm volatile("" : "+v"(t)); return t; }
typedef float f32x2_ __attribute__((ext_vector_type(2))); typedef __bf16 bf16x2_ __attribute__((ext_vector_type(2)));
__device__ __forceinline__ unsigned pk2(float lo, float hi) { const f32x2_ v = {lo, hi}; return __builtin_bit_cast(unsigned, __builtin_convertvector(v, bf16x2_)); }
__device__ __forceinline__ unsigned f2bf(float f) { return pk2(f, 0.f) & 0xffffu; }
__device__ __forceinline__ float bf2f(unsigned h) { return __builtin_bit_cast(float, (h & 0xffffu) << 16); }
__device__ __forceinline__ float bflo(unsigned w) { return __builtin_bit_cast(float, w << 16); }
__device__ __forceinline__ float bfhi(unsigned w) { return __builtin_bit_cast(float, w & 0xffff0000u); }
__device__ __forceinline__ u32x2 pack8_f8(f32x4 a, f32x4 b) {
    int w0 = 0, w1 = 0;
    w0 = __builtin_amdgcn_cvt_pk_fp8_f32(a[0], a[1], w0, false); w0 = __builtin_amdgcn_cvt_pk_fp8_f32(a[2], a[3], w0, true);
    w1 = __builtin_amdgcn_cvt_pk_fp8_f32(b[0], b[1], w1, false); w1 = __builtin_amdgcn_cvt_pk_fp8_f32(b[2], b[3], w1, true);
    u32x2 r; r.x = (unsigned)w0; r.y = (unsigned)w1; return r;
}
typedef float f32x2u __attribute__((ext_vector_type(2)));
__device__ __forceinline__ f32x4 unpack4_f8(unsigned w) { const f32x2u lo = __builtin_amdgcn_cvt_pk_f32_fp8((int)w, false), hi = __builtin_amdgcn_cvt_pk_f32_fp8((int)w, true); return (f32x4){lo.x, lo.y, hi.x, hi.y}; }
constexpr float YS_F8_SCALE = 16.0f;
__device__ __forceinline__ float wave_sum(float v) {
#pragma unroll
    for (int o = 1; o < 64; o <<= 1) v += __shfl_xor(v, o);
    return v;
}
__device__ __forceinline__ float wave_max(float v) {
#pragma unroll
    for (int o = 1; o < 64; o <<= 1) v = fmaxf(v, __shfl_xor(v, o));
    return v;
}
__device__ __forceinline__ float gelu_exact(float v) { return 0.5f * v * (1.0f + erff(v * 0.70710678118654752f)); }
__device__ __forceinline__ float sigmoidf_(float v) { return 1.0f / (1.0f + __expf(-v)); }

__device__ __forceinline__ void mod_item(const P& p, int item, float* red  ) {
    const int tid = tid_opaque(), wave = tid >> 6, lane = tid & 63;
    const int col = item * 32 + (lane & 31), kpar = lane >> 5;
    float acc[9];
#pragma unroll
    for (int r = 0; r < 9; ++r) acc[r] = 0.f;
    for (int kk = 0; kk < 64; ++kk) {
        const int k = wave * 128 + kk * 2 + kpar;
        const float w = p.w_ada[(size_t)k * 6144 + col];
#pragma unroll
        for (int r = 0; r < 9; ++r) { const float cv = (r < 8) ? p.c[r * 1024 + k] : p.c_ctx[k]; const float s = cv / (1.0f + __expf(-cv)); acc[r] += s * w; }
    }
#pragma unroll
    for (int r = 0; r < 9; ++r) red[((wave * 2 + kpar) * 9 + r) * 32 + (lane & 31)] = acc[r];
    __syncthreads();
    if (tid < 288) {
        const int r = tid >> 5, cc = tid & 31; float s = 0.f;
#pragma unroll
        for (int q = 0; q < 16; ++q) s += red[(q * 9 + r) * 32 + cc];
        ((float*)(p.ws + WS_MOD))[r * 6144 + item * 32 + cc] = s + p.b_ada[item * 32 + cc];
    }
    __syncthreads();
}
__device__ __forceinline__ void transpose_item(const float* W, int K, int N, bf16_t* WT, int k0, int n0, int drow0, float* scr, int lane) {
    const int lr = lane >> 3, lc4 = (lane & 7) * 4;
    f32x4 v[8];
#pragma unroll
    for (int i = 0; i < 8; ++i) v[i] = *(const f32x4*)(W + (size_t)(k0 + 8 * i + lr) * N + n0 + lc4);
#pragma unroll
    for (int i = 0; i < 8; ++i) { float* d = scr + (8 * i + lr) * 33 + lc4; d[0] = v[i].x; d[1] = v[i].y; d[2] = v[i].z; d[3] = v[i].w; }
    __builtin_amdgcn_wave_barrier();
    asm volatile("s_waitcnt lgkmcnt(0)" ::: "memory");
    const int c = lane & 7;
#pragma unroll
    for (int j = 0; j < 4; ++j) { const int n = (lane >> 3) + 8 * j; const float* s = scr + (8 * c) * 33 + n;
        u32x4 o; o.x = pk2(s[0 * 33], s[1 * 33]); o.y = pk2(s[2 * 33], s[3 * 33]); o.z = pk2(s[4 * 33], s[5 * 33]); o.w = pk2(s[6 * 33], s[7 * 33]);
        *(u32x4*)(WT + (size_t)(drow0 + n) * K + k0 + 8 * c) = o; }
    asm volatile("s_waitcnt lgkmcnt(0)" ::: "memory");
    __builtin_amdgcn_wave_barrier();
}
__device__ __forceinline__ void transpose_item_f8(const float* W, int K, int N, unsigned char* WT, int k0, int n0, int drow0, float scale, float* scr, int lane) {
    const int lr = lane >> 3, lc4 = (lane & 7) * 4;
    f32x4 v[8];
#pragma unroll
    for (int i = 0; i < 8; ++i) v[i] = *(const f32x4*)(W + (size_t)(k0 + 8 * i + lr) * N + n0 + lc4);
#pragma unroll
    for (int i = 0; i < 8; ++i) { float* d = scr + (8 * i + lr) * 33 + lc4; d[0] = v[i].x * scale; d[1] = v[i].y * scale; d[2] = v[i].z * scale; d[3] = v[i].w * scale; }
    __builtin_amdgcn_wave_barrier();
    asm volatile("s_waitcnt lgkmcnt(0)" ::: "memory");
    const int c = lane & 7;
#pragma unroll
    for (int j = 0; j < 4; ++j) { const int n = (lane >> 3) + 8 * j; const float* s = scr + (8 * c) * 33 + n;
        *(u32x2*)(WT + (size_t)(drow0 + n) * K + k0 + 8 * c) = pack8_f8((f32x4){s[0 * 33], s[1 * 33], s[2 * 33], s[3 * 33]}, (f32x4){s[4 * 33], s[5 * 33], s[6 * 33], s[7 * 33]}); }
    asm volatile("s_waitcnt lgkmcnt(0)" ::: "memory");
    __builtin_amdgcn_wave_barrier();
}
constexpr float W_F8_SCALE = 256.0f, ACT_F8_SCALE = 4.0f;
constexpr int IT_WIN = 16 * 224, IT_SQ = 16 * 32, IT_W1 = 32 * 16 * 64, IT_W2 = 32 * 16 * 32, IT_WS = 32;
constexpr int IT_TOTAL = IT_WIN + 3 * IT_SQ + IT_W1 + IT_W2 + IT_WS, IT_EXP0 = IT_WIN + 3 * IT_SQ;
__device__ __forceinline__ void convert_item(const P& p, int it, float* scr, int lane) {
    unsigned char* ws = p.ws;
    if (it < IT_WIN) { const int kb = it / 224, nb = it % 224; transpose_item(p.w_in, 1024, INW, (bf16_t*)(ws + WS_WIN), kb * 64, nb * 32, nb * 32, scr, lane); return; } it -= IT_WIN;
    if (it < IT_SQ) { const int kb = it / 32, nb = it % 32; transpose_item(p.w_pa, 1024, 1024, (bf16_t*)(ws + WS_WPA), kb * 64, nb * 32, nb * 32, scr, lane); return; } it -= IT_SQ;
    if (it < IT_SQ) { const int kb = it / 32, nb = it % 32; transpose_item(p.w_pb, 1024, 1024, (bf16_t*)(ws + WS_WPB), kb * 64, nb * 32, nb * 32, scr, lane); return; } it -= IT_SQ;
    if (it < IT_SQ) { const int kb = it / 32, nb = it % 32; transpose_item(p.w_out, 1024, 1024, (bf16_t*)(ws + WS_WOUT), kb * 64, nb * 32, nb * 32, scr, lane); return; } it -= IT_SQ;
    if (it < IT_W1) { const int e = it / 1024, r = it % 1024, kb = r / 64, nb = r % 64, n0 = nb * 32;
        const int half = n0 >> 10, nn = n0 & 1023, drow0 = (nn >> 7) * 256 + half * 128 + (nn & 127);
        transpose_item_f8(p.exp_w1 + (size_t)e * 1024 * 2048, 1024, 2048, ws + WS_W1 + (size_t)e * 2048 * 1024, kb * 64, n0, drow0, W_F8_SCALE, scr, lane); return; } it -= IT_W1;
    if (it < IT_W2) { const int e = it / 512, r = it % 512, kb = r / 32, nb = r % 32;
        transpose_item_f8(p.exp_w2 + (size_t)e * 1024 * 1024, 1024, 1024, ws + WS_W2 + (size_t)e * 1024 * 1024, kb * 64, nb * 32, nb * 32, W_F8_SCALE, scr, lane); return; } it -= IT_W2;
    { bf16_t* o = (bf16_t*)(ws + WS_WSB); const float* s = p.gmlp_ws + it * 4096;
      for (int i = lane; i < 4096; i += 64) o[it * 4096 + i] = (bf16_t)f2bf(s[i]); }
}
__device__ __forceinline__ void phase_prologue_a(const P& p, int bid, int nblk, unsigned char* lds) {
    const int tid = tid_opaque(), wave = tid >> 6, lane = tid & 63;
    for (int item = bid; item < 192; item += nblk) mod_item(p, item, (float*)lds);
    if (bid == nblk - 1) {
        for (int i = tid; i < 1024; i += 512) { const int pos = i >> 4, fi = i & 15;
            const float inv = __builtin_amdgcn_exp2f(-(float)fi * (13.287712379549449f / 16.0f));
            const float ang = (float)pos * inv; const float rev = ang * 0.15915494309189535f;
            float* t = (float*)(p.ws + WS_ROPE); t[2 * i] = __builtin_amdgcn_cosf(rev); t[2 * i + 1] = __builtin_amdgcn_sinf(rev); }
    }
    __syncthreads();
    float* scr = (float*)lds + wave * (64 * 33 + 32);
    const int gw = bid * 8 + wave, ngw = nblk * 8;
    for (int it = gw; it < IT_TOTAL - (IT_W1 + IT_W2); it += ngw) convert_item(p, it < IT_EXP0 ? it : it + (IT_W1 + IT_W2), scr, lane);
}
__device__ __forceinline__ void ln_mod_row(const float* xrow, const float* g, const float* b, const float* sh, const float* sc, bf16_t* orow, float* stat, int lane) {
    const f32x4* xr = (const f32x4*)xrow + lane;
    f32x4 v[4]; float s = 0.f;
#pragma unroll
    for (int j = 0; j < 4; ++j) { v[j] = xr[64 * j]; s += (v[j].x + v[j].y) + (v[j].z + v[j].w); }
    const float mean = wave_sum(s) * (1.f / DM); float s2 = 0.f;
#pragma unroll
    for (int j = 0; j < 4; ++j) { v[j] = v[j] - mean; s2 += (v[j].x * v[j].x + v[j].y * v[j].y) + (v[j].z * v[j].z + v[j].w * v[j].w); }
    const float rstd = 1.f / sqrtf(wave_sum(s2) * (1.f / DM) + LN_EPS);
    if (stat && lane == 0) { stat[0] = mean; stat[1] = rstd; }
    u32x2* o8 = (u32x2*)orow + lane;
#pragma unroll
    for (int j = 0; j < 4; ++j) { const int col = 4 * lane + 256 * j;
        const f32x4 gg = *(const f32x4*)(g + col), bb = *(const f32x4*)(b + col), shv = *(const f32x4*)(sh + col), scv = *(const f32x4*)(sc + col);
        f32x4 y = (v[j] * rstd) * gg + bb; y = y * (1.0f + scv) + shv;
        u32x2 w; w.x = pk2(y.x, y.y); w.y = pk2(y.z, y.w); o8[64 * j] = w; }
}
__device__ __forceinline__ void phase_prologue_b(const P& p, int bid, int nblk) {
    const int tid = tid_opaque(), wave = tid >> 6, lane = tid & 63;
    const int gw = bid * 8 + wave, ngw = nblk * 8;
    const float* mod = (const float*)(p.ws + WS_MOD);
    for (int row = gw; row < NTOK + NCTX; row += ngw) {
        if (row < NTOK) { const int b = row >> 12;
            ln_mod_row(p.x + (size_t)row * DM, p.ln_x_g, p.ln_x_b, mod + b * 6144, mod + b * 6144 + 1024, (bf16_t*)(p.ws + WS_U) + (size_t)row * DM, (float*)(p.ws + WS_ROWSTAT) + 2 * row, lane);
        } else { const int r = row - NTOK;
            ln_mod_row(p.ctx + (size_t)r * DM, p.ln_ctx_g, p.ln_ctx_b, mod + 8 * 6144, mod + 8 * 6144 + 1024, (bf16_t*)(p.ws + WS_UC) + (size_t)r * DM, nullptr, lane); }
    }
}

template <class ARow, class BRow, class Epi>
__device__ __forceinline__ void sgemm_wave_tile(int r0, int n0, int K, const ARow& arow, const BRow& brow, const Epi& epi, int lane) {
    const int fr = lane & 15, fq = lane >> 4;
    f32x4 acc[2][2];
#pragma unroll
    for (int a = 0; a < 2; ++a)
#pragma unroll
        for (int b = 0; b < 2; ++b) acc[a][b] = (f32x4){0.f, 0.f, 0.f, 0.f};
    const bf16_t* ap[2]; const bf16_t* bp[2];
#pragma unroll
    for (int a = 0; a < 2; ++a) { ap[a] = arow(r0 + 16 * a + fr) + 8 * fq; bp[a] = brow(n0 + 16 * a + fr) + 8 * fq; }
    for (int k0 = 0; k0 < K; k0 += 32) {
        bf16x8 af[2], bfr[2];
#pragma unroll
        for (int a = 0; a < 2; ++a) { af[a] = *(const bf16x8*)(ap[a] + k0); bfr[a] = *(const bf16x8*)(bp[a] + k0); }
#pragma unroll
        for (int a = 0; a < 2; ++a)
#pragma unroll
            for (int b = 0; b < 2; ++b) acc[a][b] = __builtin_amdgcn_mfma_f32_16x16x32_bf16(af[a], bfr[b], acc[a][b], 0, 0, 0);
    }
#pragma unroll
    for (int a = 0; a < 2; ++a)
#pragma unroll
        for (int b = 0; b < 2; ++b)
#pragma unroll
            for (int i = 0; i < 4; ++i) epi(r0 + 16 * a + 4 * fq + i, n0 + 16 * b + fr, acc[a][b][i]);
}

struct ARowDense { const bf16_t* A; int lda; __device__ __forceinline__ const bf16_t* operator()(int r) const { return A + (size_t)r * lda; } };
struct EpiProj {
    const float* b_in; bf16_t *ZU, *ZVT, *Q, *K, *VT, *G;
    __device__ __forceinline__ void operator()(int r, int n, float v) const {
        v += b_in[n];
        if (n < 1024) ZU[(size_t)r * 1024 + n] = (bf16_t)f2bf(gelu_exact(v));
        else if (n < 2048) ZVT[(size_t)(n - 1024) * NTOK + r] = (bf16_t)f2bf(gelu_exact(v));
        else if (n < 3072) Q[(size_t)r * 1024 + (n - 2048)] = (bf16_t)f2bf(v);
        else if (n < 4096) K[(size_t)r * 1024 + (n - 3072)] = (bf16_t)f2bf(v);
        else if (n < 5120) VT[(size_t)(n - 4096) * NTOK + r] = (bf16_t)f2bf(v);
        else G[(size_t)r * 2048 + (n - 5120)] = (bf16_t)f2bf(sigmoidf_(v));
    }
};
__device__ __forceinline__ void phase_proj_s(const P& p, int bid, int nblk) {
    const int tid_ = tid_opaque(); const int wave = tid_ >> 6, lane = tid_ & 63; unsigned char* ws = p.ws;
    ARowDense ar{(const bf16_t*)(ws + WS_U), 1024}, br{(const bf16_t*)(ws + WS_WIN), 1024};
    EpiProj e{p.b_in, (bf16_t*)(ws + WS_ZU), (bf16_t*)(ws + WS_ZVT), (bf16_t*)(ws + WS_Q), (bf16_t*)(ws + WS_K), (bf16_t*)(ws + WS_VT), (bf16_t*)(ws + WS_G)};
    const int ntn = INW / 32, ntiles = (NTOK / 32) * ntn;
    for (int t = bid * 8 + wave; t < ntiles; t += nblk * 8) sgemm_wave_tile((t / ntn) * 32, (t % ntn) * 32, 1024, ar, br, e, lane);
}
struct EpiCtxKV {
    const float* b_in; bf16_t *KC, *VCT;
    __device__ __forceinline__ void operator()(int r, int n, float v) const {
        v += b_in[3072 + n];
        if (n < 1024) KC[(size_t)r * 1024 + n] = (bf16_t)f2bf(v); else VCT[(size_t)(n - 1024) * NCTX + r] = (bf16_t)f2bf(v);
    }
};
__device__ __forceinline__ void phase_ctxkv_s(const P& p, int bid, int nblk) {
    const int tid_ = tid_opaque(); const int wave = tid_ >> 6, lane = tid_ & 63; unsigned char* ws = p.ws;
    ARowDense ar{(const bf16_t*)(ws + WS_UC), 1024}, br{(const bf16_t*)(ws + WS_WIN) + (size_t)3072 * 1024, 1024};
    EpiCtxKV e{p.b_in, (bf16_t*)(ws + WS_KC), (bf16_t*)(ws + WS_VCT)};
    const int ntn = 2048 / 32, ntiles = (NCTX / 32) * ntn;
    for (int t = bid * 8 + wave; t < ntiles; t += nblk * 8) sgemm_wave_tile((t / ntn) * 32, (t % ntn) * 32, 1024, ar, br, e, lane);
}
__device__ __forceinline__ void phase_rope_s(const P& p, int bid, int nblk) {
    bf16_t* K = (bf16_t*)(p.ws + WS_K); const float* tab = (const float*)(p.ws + WS_ROPE);
    const size_t total = (size_t)NTOK * NHEAD * 32;
    const int tid_ = tid_opaque();
    for (size_t i = (size_t)bid * 512 + tid_; i < total; i += (size_t)nblk * 512) {
        const int pi = (int)(i & 31), h = (int)((i >> 5) & 15), t = (int)(i >> 9);
        const int pos = t & 4095, axis = pi >> 4, fi = pi & 15, ps = axis ? (pos & 63) : (pos >> 6);
        const float cs = tab[2 * (ps * 16 + fi)], sn = tab[2 * (ps * 16 + fi) + 1];
        bf16_t* base = K + (size_t)t * 1024 + h * 64 + axis * 32 + fi;
        const float x1 = bf2f(base[0]), x2 = bf2f(base[16]);
        base[0] = (bf16_t)f2bf(x1 * cs - x2 * sn); base[16] = (bf16_t)f2bf(x2 * cs + x1 * sn);
    }
}
__device__ __forceinline__ void phase_zstat_s(const P& p, int bid, int nblk) {
    const bf16_t* ZVT = (const bf16_t*)(p.ws + WS_ZVT); float* zs = (float*)(p.ws + WS_ZSTAT);
    const int tid_ = tid_opaque();
    for (int t = bid * 512 + tid_; t < NTOK; t += nblk * 512) {
        float s = 0.f, s2 = 0.f;
        for (int c = 0; c < 1024; ++c) { const float v = bf2f(ZVT[(size_t)c * NTOK + t]); s += v; s2 += v * v; }
        const float mean = s * (1.f / 1024.f); const float var = fmaxf(s2 * (1.f / 1024.f) - mean * mean, 0.f);
        zs[2 * t] = mean; zs[2 * t + 1] = 1.f / sqrtf(var + LN_EPS);
    }
}
__device__ __forceinline__ void phase_gmlp_s(const P& p, int bid, int nblk, unsigned char* lds) {
    float* zvn = (float*)lds;
    float* wsm = zvn + 128 * 128;
    const bf16_t* ZVT = (const bf16_t*)(p.ws + WS_ZVT); const bf16_t* ZU = (const bf16_t*)(p.ws + WS_ZU); const float* zs = (const float*)(p.ws + WS_ZSTAT);
    bf16_t* YA = (bf16_t*)(p.ws + WS_U);
    const int tid = tid_opaque();
    for (int item = bid; item < (NTOK / 128) * 8; item += nblk) {
        const int chunk = item >> 3, g = item & 7, tok0 = chunk * 128;
        __syncthreads();
        for (int i = tid; i < 128 * 128; i += 512) { const int c = i >> 7, q = i & 127; const int ch = g * 128 + c;
            const float v = bf2f(ZVT[(size_t)ch * NTOK + tok0 + q]);
            zvn[q * 128 + c] = (v - zs[2 * (tok0 + q)]) * zs[2 * (tok0 + q) + 1] * p.gmlp_ln_g[ch] + p.gmlp_ln_b[ch];
            wsm[i] = p.gmlp_ws[g * 16384 + i]; }
        __syncthreads();
        const int c = tid & 127, pq = tid >> 7;
        for (int pp = 0; pp < 32; ++pp) { const int pr = pq * 32 + pp; float acc = 0.f;
            for (int q = 0; q < 128; ++q) acc += wsm[pr * 128 + q] * zvn[q * 128 + c];
            acc += p.gmlp_bs[g * 128 + pr];
            const size_t o = (size_t)(tok0 + pr) * 1024 + g * 128 + c;
            YA[o] = (bf16_t)f2bf(bf2f(ZU[o]) * acc); }
    }
}
__device__ __forceinline__ bf16x8 pack8(const float (&v)[8]) { u32x4 w; w.x = pk2(v[0], v[1]); w.y = pk2(v[2], v[3]); w.z = pk2(v[4], v[5]); w.w = pk2(v[6], v[7]); return __builtin_bit_cast(bf16x8, w); }
__device__ __forceinline__ void phase_gmlp_fast(const P& p, int bid, int nblk, unsigned char* lds) {
    const int tid = tid_opaque(), g = tid >> 6, lane = tid & 63, fr = lane & 15, fq = lane >> 4;
    float* part = (float*)lds;
    float* stat = part + 8 * 128 * 2;
    const bf16_t* ZVT = (const bf16_t*)(p.ws + WS_ZVT); const bf16_t* ZU = (const bf16_t*)(p.ws + WS_ZU); const bf16_t* WSB = (const bf16_t*)(p.ws + WS_WSB);
    bf16_t* YA = (bf16_t*)(p.ws + WS_U);
    for (int chunk = bid; chunk < NTOK / 128; chunk += nblk) {
        const int tok0 = chunk * 128;
        __syncthreads();
        { float s1[8], s2[8];
#pragma unroll
          for (int jj = 0; jj < 8; ++jj) { s1[jj] = 0.f; s2[jj] = 0.f; }
          const bf16_t* zp = ZVT + (((size_t)(tok0 >> 3) + fr) * 1024 + 128 * g + fq) * 8;
#pragma unroll 8
          for (int it = 0; it < 32; ++it) { const bf16x8 v = *(const bf16x8*)(zp + (4 * it) * 8);
#pragma unroll
              for (int jj = 0; jj < 8; ++jj) { const float f = bf2f((unsigned)(unsigned short)v[jj]); s1[jj] += f; s2[jj] += f * f; } }
#pragma unroll
          for (int jj = 0; jj < 8; ++jj) { s1[jj] += __shfl_xor(s1[jj], 16); s1[jj] += __shfl_xor(s1[jj], 32); s2[jj] += __shfl_xor(s2[jj], 16); s2[jj] += __shfl_xor(s2[jj], 32); }
          if (fq == 0) {
#pragma unroll
              for (int jj = 0; jj < 8; ++jj) { part[(g * 128 + 8 * fr + jj) * 2] = s1[jj]; part[(g * 128 + 8 * fr + jj) * 2 + 1] = s2[jj]; } } }
        __syncthreads();
        if (tid < 128) { float a = 0.f, b = 0.f;
#pragma unroll
            for (int w = 0; w < 8; ++w) { a += part[(w * 128 + tid) * 2]; b += part[(w * 128 + tid) * 2 + 1]; }
            const float mean = a * (1.f / 1024.f), var = fmaxf(b * (1.f / 1024.f) - mean * mean, 0.f);
            stat[2 * tid] = mean; stat[2 * tid + 1] = 1.f / sqrtf(var + LN_EPS); }
        __syncthreads();
#pragma unroll 1
        for (int ph = 0; ph < 2; ++ph) {
            bf16x8 wf[4][4]; float t1[4], t2[4], bsv[4];
#pragma unroll
            for (int pt = 0; pt < 4; ++pt) { const int pp = 64 * ph + 16 * pt + fr; float t1a = 0.f, t2a = 0.f;
                const __attribute__((address_space(3))) float* stat3 = (const __attribute__((address_space(3))) float*)((const __attribute__((address_space(3))) unsigned char*)lds + 8 * 128 * 2 * 4);
                int so = 16 * fq; asm volatile("" : "+v"(so));
#pragma unroll
                for (int ks = 0; ks < 4; ++ks) { const bf16x8 w = *(const bf16x8*)(WSB + ((size_t)g * 128 + pp) * 128 + 32 * ks + 8 * fq);
                    float wv[8];
#pragma unroll
                    for (int jj = 0; jj < 8; ++jj) { const float w0 = bf2f((unsigned)(unsigned short)w[jj]); t2a += w0; wv[jj] = w0 * stat3[so + 2 * (32 * ks + jj) + 1]; }
                    const bf16x8 wp = pack8(wv); wf[pt][ks] = wp;
#pragma unroll
                    for (int jj = 0; jj < 8; ++jj) t1a += bf2f((unsigned)(unsigned short)wp[jj]) * stat3[so + 2 * (32 * ks + jj)]; }
                t1a += __shfl_xor(t1a, 16); t1a += __shfl_xor(t1a, 32); t2a += __shfl_xor(t2a, 16); t2a += __shfl_xor(t2a, 32);
                t1[pt] = t1a; t2[pt] = t2a; bsv[pt] = p.gmlp_bs[g * 128 + pp]; }
            bf16x8 afn[4];
            { const bf16_t* zp = ZVT + (((size_t)(tok0 >> 3) + fq) * 1024 + 128 * g + fr) * 8;
#pragma unroll
              for (int ks = 0; ks < 4; ++ks) afn[ks] = *(const bf16x8*)(zp + (size_t)ks * 4 * 1024 * 8); }
#pragma unroll 1
            for (int ct = 0; ct < 8; ++ct) {
                bf16x8 af[4];
#pragma unroll
                for (int ks = 0; ks < 4; ++ks) af[ks] = afn[ks];
                if (ct + 1 < 8) { const bf16_t* zp = ZVT + (((size_t)(tok0 >> 3) + fq) * 1024 + 128 * g + 16 * (ct + 1) + fr) * 8;
#pragma unroll
                    for (int ks = 0; ks < 4; ++ks) afn[ks] = *(const bf16x8*)(zp + (size_t)ks * 4 * 1024 * 8); }
                const int c = 128 * g + 16 * ct + 4 * fq;
                u32x2 zuv[4];
#pragma unroll
                for (int pt = 0; pt < 4; ++pt) zuv[pt] = *(const u32x2*)(ZU + (size_t)(tok0 + 64 * ph + 16 * pt + fr) * 1024 + c);
                f32x4 acc[4];
#pragma unroll
                for (int pt = 0; pt < 4; ++pt) { acc[pt] = (f32x4){0.f, 0.f, 0.f, 0.f};
#pragma unroll
                    for (int ks = 0; ks < 4; ++ks) acc[pt] = __builtin_amdgcn_mfma_f32_16x16x32_bf16(af[ks], wf[pt][ks], acc[pt], 0, 0, 0); }
                const f32x4 gc = *(const f32x4*)(p.gmlp_ln_g + c), bc = *(const f32x4*)(p.gmlp_ln_b + c);
#pragma unroll
                for (int pt = 0; pt < 4; ++pt) { const size_t off = (size_t)(tok0 + 64 * ph + 16 * pt + fr) * 1024 + c;
                    const u32x2 zu = zuv[pt];
                    const f32x4 s = gc * (acc[pt] - t1[pt]) + bc * t2[pt] + bsv[pt];
                    u32x2 w; w.x = pk2(bflo(zu.x) * s[0], bfhi(zu.x) * s[1]); w.y = pk2(bflo(zu.y) * s[2], bfhi(zu.y) * s[3]);
                    *(u32x2*)(YA + off) = w; }
            }
        }
    }
}
constexpr int AT_LDS_RPB = 0, AT_LDS_KC = 4096, AT_LDS_VC = AT_LDS_KC + 32768, AT_LDS_END = AT_LDS_VC + 32768;
typedef __attribute__((address_space(3))) const unsigned char* lds_cp;
__device__ __forceinline__ void attn_stage(const P& p, unsigned char* lds, int b, int h, int tid) {
    float* tbl = (float*)(lds + AT_LDS_RPB);
    for (int idx = tid; idx < 15 * 64; idx += 512) { const int dr = idx >> 6, cc = idx & 63; tbl[idx] = (cc >= 16 && cc < 47) ? p.na_rpb[(h * 15 + dr) * 31 + cc - 16] : 0.f; }
    const size_t bh = (size_t)b * 16 + h;
    const u32x4* kc = (const u32x4*)((const bf16_t*)(p.ws + WS_KC) + bh * 256 * 64); const u32x4* vc = (const u32x4*)((const bf16_t*)(p.ws + WS_VCT) + bh * 32 * 512);
#pragma unroll
    for (int i = 0; i < 4; ++i) { const int q = tid + 512 * i, key = q >> 3, c = q & 7; const int fk = ((key >> 1) & 1) | (((key >> 3) & 1) << 1) | (((key >> 4) & 1) << 2);
        *(u32x4*)(lds + AT_LDS_KC + key * 128 + ((c ^ fk) << 4)) = kc[q]; *(u32x4*)(lds + AT_LDS_VC + q * 16) = vc[q]; }
}
__device__ __forceinline__ void attn_wave_unit(const P& p, unsigned char* lds, int b, int r, int j, int h, int lane) {
    const int fr = lane & 15, fq = lane >> 4;
    const bf16_t* Q = (const bf16_t*)(p.ws + WS_Q); const bf16_t* K = (const bf16_t*)(p.ws + WS_K); const bf16_t* VT = (const bf16_t*)(p.ws + WS_VT);
    const float* tab = (const float*)(p.ws + WS_ROPE);
    bf16_t* YB = (bf16_t*)(p.ws + WS_YB);
    const int qc = 16 * j + fr; const size_t tq = (size_t)b * SEQ + r * 64 + qc; const size_t bh = (size_t)b * 16 + h;
    const int r0 = min(max(r - 4, 0), 56), c0 = min(max(qc - 8, 0), 48), cs = min(max(16 * j - 8, 0), 32);
    const int sp0 = 8 * (fr >> 2) + (fr & 3);
    const bf16_t* klat = K + (bh * 4096 + r0 * 64 + cs + sp0) * 64 + 8 * fq;
    const bf16_t* vlat = VT + ((bh * 512 + ((r0 * 64 + cs) >> 3) + fq) * 64 + fr) * 8;
    const int fk = ((fr >> 1) & 1) | (((fr >> 2) & 1) << 1) | (((fr >> 3) & 1) << 2);
    const lds_cp kcl = (lds_cp)lds + AT_LDS_KC + sp0 * 128;
    const int kco0 = (fq ^ fk) << 4, kco1 = ((fq + 4) ^ fk) << 4;
    const lds_cp vcl = (lds_cp)lds + AT_LDS_VC + (fq * 64 + fr) * 16;
    bf16x8 kf[2][2][2];
#define LOADK(buf, st_) do { _Pragma("unroll") for (int t = 0; t < 2; ++t) { \
        const bf16_t* kp_ = klat + (size_t)(st_) * 64 * 64 + t * 4 * 64; kf[buf][t][0] = *(const bf16x8*)kp_; kf[buf][t][1] = *(const bf16x8*)(kp_ + 32); } } while (0)
#define LOADKC(buf, st_) do { _Pragma("unroll") for (int t = 0; t < 2; ++t) { \
        const lds_cp kp_ = kcl + (32 * (st_) + 4 * t) * 128; kf[buf][t][0] = *(const __attribute__((address_space(3))) bf16x8*)(kp_ + kco0); kf[buf][t][1] = *(const __attribute__((address_space(3))) bf16x8*)(kp_ + kco1); } } while (0)
    LOADK(0, 0); LOADK(1, 1);
    bf16x8 qpl[2], qrt[2];
#pragma unroll
    for (int s = 0; s < 2; ++s) {
        const bf16_t* qb = Q + (bh * 4096 + r * 64 + qc) * 64 + 32 * s;
        const bf16x8 me = *(const bf16x8*)(qb + 8 * fq), ot = *(const bf16x8*)(qb + 8 * (fq ^ 2));
        qpl[s] = me;
        const int pos = s ? qc : r; const float* tb = tab + (pos * 16 + 8 * (fq & 1)) * 2;
        float rot[8];
#pragma unroll
        for (int jj = 0; jj < 8; ++jj) { const float cv = tb[2 * jj], sv = tb[2 * jj + 1];
            const float xv = bf2f((unsigned)(unsigned short)me[jj]), ov = bf2f((unsigned)(unsigned short)ot[jj]);
            rot[jj] = (fq < 2) ? (xv * cv - ov * sv) : (xv * cv + ov * sv); }
        qrt[s] = pack8(rot);
    }
    float sc[8][8];
    const __attribute__((address_space(3))) float* tbl3 = (const __attribute__((address_space(3))) float*)((lds_cp)lds + AT_LDS_RPB);
    const int boff0 = (r0 - r + 7) * 64 + (cs + 8 * fq - qc + 31);
#pragma unroll
    for (int st = 0; st < 8; ++st) {
        int boff = boff0 + st * 64; asm volatile("" : "+v"(boff));
#pragma unroll
        for (int t = 0; t < 2; ++t) {
            f32x4 d = __builtin_amdgcn_mfma_f32_16x16x32_bf16(kf[st & 1][t][0], qrt[0], (f32x4){0.f, 0.f, 0.f, 0.f}, 0, 0, 0);
            d = __builtin_amdgcn_mfma_f32_16x16x32_bf16(kf[st & 1][t][1], qrt[1], d, 0, 0, 0);
#pragma unroll
            for (int i = 0; i < 4; ++i) { const int kc = cs + 8 * fq + 4 * t + i; const bool valid = (kc >= c0) && (kc < c0 + 16);
                const float bias = tbl3[boff + 4 * t + i];
                sc[st][4 * t + i] = valid ? (d[i] * 0.125f + bias) : -INFINITY; } }
        if (st + 2 < 8) LOADK(st & 1, st + 2);
    }
    bf16x8 vf[2][4];
#define LOADV(buf, st_) do { _Pragma("unroll") for (int dt = 0; dt < 4; ++dt) vf[buf][dt] = *(const bf16x8*)(vlat + dt * 128 + (st_) * 8 * 512); } while (0)
#define LOADVC(buf, st_) do { _Pragma("unroll") for (int dt = 0; dt < 4; ++dt) vf[buf][dt] = *(const __attribute__((address_space(3))) bf16x8*)(vcl + (st_) * 4096 + dt * 256); } while (0)
    LOADV(0, 0); LOADV(1, 1);
    float m = -INFINITY;
#pragma unroll
    for (int st = 0; st < 8; ++st)
#pragma unroll
        for (int e = 0; e < 8; ++e) m = fmaxf(m, sc[st][e]);
    m = fmaxf(m, __shfl_xor(m, 16)); m = fmaxf(m, __shfl_xor(m, 32));
    float l = 0.f; f32x4 o[4];
#pragma unroll
    for (int dt = 0; dt < 4; ++dt) o[dt] = (f32x4){0.f, 0.f, 0.f, 0.f};
    const float ml2 = m * 1.4426950408889634f;
#pragma unroll
    for (int st = 0; st < 8; ++st) {
        float pv[8];
#pragma unroll
        for (int e = 0; e < 8; ++e) { pv[e] = __builtin_amdgcn_exp2f(sc[st][e] * 1.4426950408889634f - ml2); l += pv[e]; }
        const bf16x8 pf = pack8(pv);
#pragma unroll
        for (int dt = 0; dt < 4; ++dt) o[dt] = __builtin_amdgcn_mfma_f32_16x16x32_bf16(vf[st & 1][dt], pf, o[dt], 0, 0, 0);
        if (st + 2 < 8) LOADV(st & 1, st + 2);
    }
    LOADKC(0, 0);
#pragma unroll
    for (int st = 0; st < 8; ++st) {
        if (st + 1 < 8) LOADKC((st + 1) & 1, st + 1);
#pragma unroll
        for (int t = 0; t < 2; ++t) {
            f32x4 d = __builtin_amdgcn_mfma_f32_16x16x32_bf16(kf[st & 1][t][0], qpl[0], (f32x4){0.f, 0.f, 0.f, 0.f}, 0, 0, 0);
            d = __builtin_amdgcn_mfma_f32_16x16x32_bf16(kf[st & 1][t][1], qpl[1], d, 0, 0, 0);
#pragma unroll
            for (int i = 0; i < 4; ++i) sc[st][4 * t + i] = d[i] * 0.125f; }
    }
    float m2 = -INFINITY;
#pragma unroll
    for (int st = 0; st < 8; ++st)
#pragma unroll
        for (int e = 0; e < 8; ++e) m2 = fmaxf(m2, sc[st][e]);
    m2 = fmaxf(m2, __shfl_xor(m2, 16)); m2 = fmaxf(m2, __shfl_xor(m2, 32));
    const float mn = fmaxf(m, m2), al = __builtin_amdgcn_exp2f((m - mn) * 1.4426950408889634f), mnl2 = mn * 1.4426950408889634f;
    l *= al;
#pragma unroll
    for (int dt = 0; dt < 4; ++dt) o[dt] = o[dt] * al;
    LOADVC(0, 0);
#pragma unroll
    for (int st = 0; st < 8; ++st) {
        if (st + 1 < 8) LOADVC((st + 1) & 1, st + 1);
        float pv[8];
#pragma unroll
        for (int e = 0; e < 8; ++e) { pv[e] = __builtin_amdgcn_exp2f(sc[st][e] * 1.4426950408889634f - mnl2); l += pv[e]; }
        const bf16x8 pf = pack8(pv);
#pragma unroll
        for (int dt = 0; dt < 4; ++dt) o[dt] = __builtin_amdgcn_mfma_f32_16x16x32_bf16(vf[st & 1][dt], pf, o[dt], 0, 0, 0);
    }
#undef LOADK
#undef LOADKC
#undef LOADV
#undef LOADVC
    l += __shfl_xor(l, 16); l += __shfl_xor(l, 32);
    const float inv = 1.0f / l;
#pragma unroll
    for (int dt = 0; dt < 4; ++dt) { u32x2 w; w.x = pk2(o[dt][0] * inv, o[dt][1] * inv); w.y = pk2(o[dt][2] * inv, o[dt][3] * inv);
        *(u32x2*)(YB + tq * 1024 + h * 64 + 16 * dt + 4 * fq) = w; }
}
__device__ __forceinline__ void phase_attn_s(const P& p, int bid, int nblk, unsigned char* lds) {
    const int tid_ = tid_opaque(); const int wave = tid_ >> 6, lane = tid_ & 63;
    float* cscr = (float*)(lds + AT_LDS_END) + wave * (64 * 33 + 32);
    for (int vb = bid; vb < 256; vb += nblk) { const int half = vb & 1, h = (vb >> 1) & 15, b = vb >> 5;
        __syncthreads();
        attn_stage(p, lds, b, h, tid_);
        __syncthreads();
#pragma unroll 1
        for (int it = 0; it < 16; ++it) { int lane_o = lane; asm volatile("" : "+v"(lane_o));
            attn_wave_unit(p, lds, b, 32 * half + 2 * it + (wave >> 2), wave & 3, h, lane_o);
            const int gw = vb * 8 + wave;
            for (int k = it; k * 2048 + gw < IT_W1 + IT_W2; k += 16) convert_item(p, IT_EXP0 + k * 2048 + gw, cscr, lane_o); }
    }
}
struct EpiMergeA { const bf16_t* G; bf16_t* INNER;
    __device__ __forceinline__ void operator()(int r, int n, float v) const { INNER[(size_t)r * 1024 + n] = (bf16_t)f2bf(bf2f(G[(size_t)r * 2048 + n]) * v); } };
struct EpiMergeB { const bf16_t* G; bf16_t* INNER;
    __device__ __forceinline__ void operator()(int r, int n, float v) const { const size_t o = (size_t)r * 1024 + n; INNER[o] = (bf16_t)f2bf(bf2f(INNER[o]) + bf2f(G[(size_t)r * 2048 + 1024 + n]) * v); } };
template <int WHICH> __device__ __forceinline__ void phase_merge_s(const P& p, int bid, int nblk) {
    const int tid_ = tid_opaque(); const int wave = tid_ >> 6, lane = tid_ & 63; unsigned char* ws = p.ws;
    const int ntn = 1024 / 32, ntiles = (NTOK / 32) * ntn;
    if (WHICH == 0) { ARowDense ar{(const bf16_t*)(ws + WS_U), 1024}, br{(const bf16_t*)(ws + WS_WPA), 1024}; EpiMergeA e{(const bf16_t*)(ws + WS_G), (bf16_t*)(ws + WS_INNER)};
        for (int t = bid * 8 + wave; t < ntiles; t += nblk * 8) sgemm_wave_tile((t / ntn) * 32, (t % ntn) * 32, 1024, ar, br, e, lane);
    } else { ARowDense ar{(const bf16_t*)(ws + WS_YB), 1024}, br{(const bf16_t*)(ws + WS_WPB), 1024}; EpiMergeB e{(const bf16_t*)(ws + WS_G), (bf16_t*)(ws + WS_INNER)};
        for (int t = bid * 8 + wave; t < ntiles; t += nblk * 8) sgemm_wave_tile((t / ntn) * 32, (t % ntn) * 32, 1024, ar, br, e, lane); }
}
struct EpiMix { const float *x, *rowstat, *lng, *lnb, *mod, *b_out; float* out;
    __device__ __forceinline__ void operator()(int r, int n, float v) const {
        const int b = r >> 12; const float x0 = (x[(size_t)r * 1024 + n] - rowstat[2 * r]) * rowstat[2 * r + 1] * lng[n] + lnb[n];
        out[(size_t)r * 1024 + n] = ALPHA * x0 + mod[b * 6144 + 2048 + n] * (v + b_out[n]); } };
__device__ __forceinline__ void phase_mix_s(const P& p, int bid, int nblk) {
    const int tid_ = tid_opaque(); const int wave = tid_ >> 6, lane = tid_ & 63; unsigned char* ws = p.ws;
    const int ntn = 1024 / 32, ntiles = (NTOK / 32) * ntn;
    ARowDense ar{(const bf16_t*)(ws + WS_INNER), 1024}, br{(const bf16_t*)(ws + WS_WOUT), 1024};
    EpiMix e{p.x, (const float*)(ws + WS_ROWSTAT), p.ln_x_g, p.ln_x_b, (const float*)(ws + WS_MOD), p.b_out, p.out};
    for (int t = bid * 8 + wave; t < ntiles; t += nblk * 8) sgemm_wave_tile((t / ntn) * 32, (t % ntn) * 32, 1024, ar, br, e, lane);
}

constexpr int RT_LDS_W = 0, RT_LDS_CNT = 131072, RT_LDS_BASE = RT_LDS_CNT + 128, RT_LDS_REC = RT_LDS_BASE + 128, RT_MAXIT = 32, RT_LDS_END = RT_LDS_REC + 8 * RT_MAXIT * 8 * 4;
__device__ __forceinline__ int rw_off(int prow, int ch) { return prow * 128 + ((ch ^ ((prow >> 1) & 7)) << 4); }
__device__ __forceinline__ void phase_router(const P& p, int bid, int nblk, unsigned char* lds) {
    const int tid = tid_opaque(), wave = tid >> 6, lane = tid & 63;
    int* cnt = (int*)(lds + RT_LDS_CNT); int* base = (int*)(lds + RT_LDS_BASE); int* rec = (int*)(lds + RT_LDS_REC) + wave * RT_MAXIT * 8;
    for (int k = tid; k < 1024; k += 512) { const int l = (k & 255) >> 2, i = k & 3, j = k >> 8, prow = l + 64 * (4 * j + i);
        const f32x4* src = (const f32x4*)(p.router_w + (size_t)k * 32);
#pragma unroll
        for (int ch = 0; ch < 8; ++ch) *(f32x4*)(lds + RT_LDS_W + rw_off(prow, ch)) = src[ch]; }
    if (tid < 32) cnt[tid] = 0;
    __syncthreads();
    const float* mod = (const float*)(p.ws + WS_MOD);
    int* TOPE = (int*)(p.ws + WS_TOPE); float* TOPG = (float*)(p.ws + WS_TOPG); int* SLOT = (int*)(p.ws + WS_SLOT);
    unsigned char* U2 = p.ws + WS_U;
    const int erev = 16 * ((lane >> 4) & 1) + (int)(__builtin_bitreverse32((unsigned)(lane & 15)) >> 28);
    unsigned wb[8];
#pragma unroll
    for (int ch = 0; ch < 8; ++ch) wb[ch] = RT_LDS_W + lane * 128 + ((ch ^ ((lane >> 1) & 7)) << 4);
    int it = 0;
    u32x2 pre[4];
    { const int row0 = bid * 8 + wave; if (row0 < NTOK) { const u32x2* xin0 = (const u32x2*)((const bf16_t*)(p.ws + WS_X1PRE) + (size_t)row0 * DM) + lane;
#pragma unroll
        for (int j = 0; j < 4; ++j) pre[j] = xin0[64 * j]; } }
    for (int row = bid * 8 + wave; row < NTOK; row += nblk * 8, ++it) {
        const int b = row >> 12;
        u32x2* xr = (u32x2*)((bf16_t*)(p.ws + WS_X1) + (size_t)row * DM) + lane;
        f32x4 v[4]; float s = 0.f;
#pragma unroll
        for (int j = 0; j < 4; ++j) { const u32x2 w = pre[j]; v[j] = (f32x4){bflo(w.x), bfhi(w.x), bflo(w.y), bfhi(w.y)}; s += (v[j].x + v[j].y) + (v[j].z + v[j].w); }
        { const int rown = row + nblk * 8; if (rown < NTOK) { const u32x2* xinn = (const u32x2*)((const bf16_t*)(p.ws + WS_X1PRE) + (size_t)rown * DM) + lane;
#pragma unroll
            for (int j = 0; j < 4; ++j) pre[j] = xinn[64 * j]; } }
        const float mean = wave_sum(s) * (1.f / DM); float s2 = 0.f;
#pragma unroll
        for (int j = 0; j < 4; ++j) { v[j] = v[j] - mean; s2 += (v[j].x * v[j].x + v[j].y * v[j].y) + (v[j].z * v[j].z + v[j].w * v[j].w); }
        const float rstd = 1.f / sqrtf(wave_sum(s2) * (1.f / DM) + LN_EPS);
        unsigned* o8 = (unsigned*)(U2 + (size_t)row * DM) + lane;
        int lane_o = lane; asm volatile("" : "+v"(lane_o));
        f32x4 u[4];
#pragma unroll
        for (int j = 0; j < 4; ++j) { const int col = 4 * lane_o + 256 * j;
            const f32x4 gg = *(const f32x4*)(p.ln1_g + col), bb = *(const f32x4*)(p.ln1_b + col);
            const f32x4 shv = *(const f32x4*)(mod + b * 6144 + 3072 + col), scv = *(const f32x4*)(mod + b * 6144 + 4096 + col);
            const f32x4 x1 = (v[j] * rstd) * gg + bb; { u32x2 w; w.x = pk2(x1.x, x1.y); w.y = pk2(x1.z, x1.w); xr[64 * j] = w; }
            u[j] = x1 * (1.0f + scv) + shv;
            int w = 0; w = __builtin_amdgcn_cvt_pk_fp8_f32(u[j].x, u[j].y, w, false); w = __builtin_amdgcn_cvt_pk_fp8_f32(u[j].z, u[j].w, w, true); o8[64 * j] = (unsigned)w; }
        float lg2[2];
#pragma unroll
        for (int hf = 0; hf < 2; ++hf) {
            float a[16];
#pragma unroll
            for (int e = 0; e < 16; ++e) a[e] = 0.f;
#pragma unroll
            for (int j = 0; j < 4; ++j)
#pragma unroll
                for (int i = 0; i < 4; ++i) { const float uv = u[j][i];
#pragma unroll
                    for (int ch = 0; ch < 4; ++ch) { const f32x4 w4 = *(const f32x4*)(lds + wb[4 * hf + ch] + (4 * j + i) * 8192);
                        a[4 * ch + 0] += uv * w4.x; a[4 * ch + 1] += uv * w4.y; a[4 * ch + 2] += uv * w4.z; a[4 * ch + 3] += uv * w4.w; } }
#pragma unroll
            for (int st = 0; st < 4; ++st) { const int n = 8 >> st; const bool up = (lane >> st) & 1;
#pragma unroll
                for (int i = 0; i < n; ++i) { float lo = a[i], hi = a[n + i]; asm volatile("" : "+v"(lo), "+v"(hi));
                    const float keep = up ? hi : lo, send = up ? lo : hi; a[i] = keep + __shfl_xor(send, 1 << st); } }
            float r = a[0]; r += __shfl_xor(r, 16); r += __shfl_xor(r, 32); lg2[hf] = r;
        }
        float logit = ((lane >> 4) & 1) ? lg2[1] : lg2[0];
        logit += p.router_b[erev];
        float cur = logit;
#define TOP_STEP(TV, TE) float TV; int TE; { const float mx = wave_max(cur); int cand = (cur == mx) ? erev : 64; \
            cand = min(cand, __shfl_xor(cand, 1)); cand = min(cand, __shfl_xor(cand, 2)); cand = min(cand, __shfl_xor(cand, 4)); \
            cand = min(cand, __shfl_xor(cand, 8)); cand = min(cand, __shfl_xor(cand, 16)); cand = min(cand, __shfl_xor(cand, 32)); \
            TV = mx; TE = cand; if (erev == cand) cur = -INFINITY; }
        TOP_STEP(tv0, te0) TOP_STEP(tv1, te1) TOP_STEP(tv2, te2) TOP_STEP(tv3, te3)
#undef TOP_STEP
        const float gk0 = 1.0f, gk1 = __expf(tv1 - tv0), gk2 = __expf(tv2 - tv0), gk3 = __expf(tv3 - tv0);
        const float ginv = 1.f / (gk0 + gk1 + gk2 + gk3);
        if (lane < 4) { const int e = lane == 0 ? te0 : lane == 1 ? te1 : lane == 2 ? te2 : te3; const float g = lane == 0 ? gk0 : lane == 1 ? gk1 : lane == 2 ? gk2 : gk3;
            const int pos = atomicAdd(&cnt[e], 1);
            TOPE[row * 4 + lane] = e; TOPG[row * 4 + lane] = g * ginv;
            if (it < RT_MAXIT) { rec[it * 8 + lane * 2] = e; rec[it * 8 + lane * 2 + 1] = pos; } }
    }
    __syncthreads();
    if (tid < 32) base[tid] = atomicAdd((int*)(p.ws + WS_CTL) + tid, cnt[tid]);
    __syncthreads();
    it = 0;
    int* PERM2 = (int*)(p.ws + WS_PERM2);
    for (int row = bid * 8 + wave; row < NTOK; row += nblk * 8, ++it)
        if (lane < 4 && it < RT_MAXIT) { const int e = rec[it * 8 + lane * 2], pos = base[e] + rec[it * 8 + lane * 2 + 1]; SLOT[row * 4 + lane] = pos; PERM2[(size_t)e * NTOK + pos] = row; }
}
constexpr int MT_LDS = 131072 + 1024;
__device__ __forceinline__ void moe_tables(const P& p, unsigned char* lds) {
    const int tid = tid_opaque(); int* cn = (int*)(lds + MT_LDS); int* eb = cn + 32; int* tb = eb + 33;
    __syncthreads();
    if (tid < 32) cn[tid] = __hip_atomic_load((int*)(p.ws + WS_CTL) + tid, __ATOMIC_RELAXED, __HIP_MEMORY_SCOPE_AGENT);
    __syncthreads();
    if (tid == 0) { int s = 0, t = 0; for (int e = 0; e < 32; ++e) { eb[e] = s; tb[e] = t; s += cn[e]; t += (cn[e] + 255) >> 8; } eb[32] = s; tb[32] = t; }
    __syncthreads();
}
struct FinIdx { int e[4]; int pos[4]; float g[4]; };
struct FinData { u32x4 ys[4]; u32x4 x[2]; };
__device__ __forceinline__ void fin_load_idx(const P& p, int row, FinIdx& r) {
    const u32x4 ev = *(const u32x4*)((const int*)(p.ws + WS_TOPE) + row * 4), pv = *(const u32x4*)((const int*)(p.ws + WS_SLOT) + row * 4); const f32x4 gv = *(const f32x4*)((const float*)(p.ws + WS_TOPG) + row * 4);
#pragma unroll
    for (int k = 0; k < 4; ++k) { r.e[k] = (int)ev[k]; r.pos[k] = (int)pv[k]; r.g[k] = gv[k] * (1.0f / YS_F8_SCALE); }
}
__device__ __forceinline__ void fin_load_data(const P& p, const int* eb, int row, const FinIdx& ix, FinData& d, int lane) {
    const unsigned char* YS = p.ws + WS_YS;
#pragma unroll
    for (int k = 0; k < 4; ++k) { const size_t slot = (size_t)(eb[ix.e[k]] + ix.pos[k]); d.ys[k] = *(const u32x4*)(YS + slot * 1024 + 16 * lane); }
    const u32x4* xr = (const u32x4*)((const bf16_t*)(p.ws + WS_X1) + (size_t)row * DM + 16 * lane); d.x[0] = xr[0]; d.x[1] = xr[1];
}
__device__ __forceinline__ void phase_final(const P& p, int bid, int nblk, unsigned char* lds) {
    moe_tables(p, lds); const int* eb = (const int*)(lds + MT_LDS) + 32;
    const int tid = tid_opaque(), wave = tid >> 6, lane = tid & 63;
    const float* mod = (const float*)(p.ws + WS_MOD);
    const int stride = nblk * 8;
    int row = bid * 8 + wave; if (row >= NTOK) return;
    FinIdx ic, in; FinData dc, dn;
    fin_load_idx(p, row, ic); fin_load_data(p, eb, row, ic, dc, lane);
    int row_n = row + stride; if (row_n < NTOK) fin_load_idx(p, row_n, in);
#pragma unroll 1
    for (;;) {
        if (row_n < NTOK) fin_load_data(p, eb, row_n, in, dn, lane);
        const int row_nn = row_n + stride; FinIdx inn; if (row_nn < NTOK) fin_load_idx(p, row_nn, inn);
        const int b = row >> 12, col = 16 * lane;
        f32x4 v[4]; float s = 0.f;
#pragma unroll
        for (int q = 0; q < 4; ++q) v[q] = (f32x4){0.f, 0.f, 0.f, 0.f};
#pragma unroll
        for (int k = 0; k < 4; ++k) { const u32x4 w = dc.ys[k]; const float g = ic.g[k];
            v[0] += unpack4_f8(w.x) * g; v[1] += unpack4_f8(w.y) * g; v[2] += unpack4_f8(w.z) * g; v[3] += unpack4_f8(w.w) * g; }
#pragma unroll
        for (int q = 0; q < 4; ++q) { const u32x4 xw = dc.x[q >> 1]; const unsigned w0 = (q & 1) ? xw.z : xw.x, w1 = (q & 1) ? xw.w : xw.y;
            const f32x4 xa = (f32x4){bflo(w0), bfhi(w0), bflo(w1), bfhi(w1)}; const f32x4 g2 = *(const f32x4*)(mod + b * 6144 + 5120 + col + 4 * q);
            v[q] = xa * ALPHA + g2 * v[q]; s += (v[q].x + v[q].y) + (v[q].z + v[q].w); }
        const float mean = wave_sum(s) * (1.f / DM); float s2 = 0.f;
#pragma unroll
        for (int q = 0; q < 4; ++q) { v[q] = v[q] - mean; s2 += (v[q].x * v[q].x + v[q].y * v[q].y) + (v[q].z * v[q].z + v[q].w * v[q].w); }
        const float rstd = 1.f / sqrtf(wave_sum(s2) * (1.f / DM) + LN_EPS);
        f32x4* xo = (f32x4*)(p.out + (size_t)row * DM + col);
#pragma unroll
        for (int q = 0; q < 4; ++q) { const f32x4 gg = *(const f32x4*)(p.ln2_g + col + 4 * q), bb = *(const f32x4*)(p.ln2_b + col + 4 * q); xo[q] = (v[q] * rstd) * gg + bb; }
        if (row_n >= NTOK) break;
        row = row_n; row_n = row_nn; ic = in; in = inn; dc = dn;
    }
}

namespace pg {
#define PG_LAS __attribute__((address_space(3)))
typedef float f32x2 __attribute__((ext_vector_type(2)));
constexpr int BM = 256, BK = 64, HALF = 128, HTB = HALF * BK * 2, STAGE_BYTES = 8 * HTB, KD = 1024, NT = KD / BK;
constexpr unsigned KSTEP = BK * 2, HSTEPB = HALF * KD * 2;
__host__ __device__ __forceinline__ int lds_byte(int r, int c) { const int st = (r >> 4) * 2 + (c >> 5), rr = r & 15, cc = c & 31, ob = rr * 64 + cc * 2; return st * 1024 + (ob ^ (((ob >> 9) & 1) << 5)); }
__host__ __device__ __forceinline__ void stage_rc(int b, int& R, int& C) { const int st = b / 1024, sb = b % 1024, swz = sb ^ (((sb >> 9) & 1) << 5); R = (st >> 1) * 16 + swz / 64; C = (st & 1) * 32 + (swz % 64) / 2; }
__host__ __device__ __forceinline__ int perm32(int rho) { const int n = rho >> 4, i = rho & 15; return 8 * (i >> 2) + 4 * n + (i & 3); }
struct Unit { int pm, pn, row0, nrows, e, kind; };
__device__ __forceinline__ void tilemap(int L, int nM, int nN, int& pm, int& pn) {
    int wgid = L; { const int nwg = nM * nN, q = nwg / 8, r = nwg % 8, xcd = wgid % 8, off = wgid / 8; wgid = (xcd < r ? xcd * (q + 1) : r * (q + 1) + (xcd - r) * q) + off; }
    const int nig = 8 * nN, gid = wgid / nig, fm = gid * 8, gsz = (nM - fm) < 8 ? (nM - fm) : 8;
    pm = fm + ((wgid % nig) % gsz); pn = (wgid % nig) / gsz;
}
__device__ __forceinline__ unsigned cvt_pk_bf16(float lo, float hi) { unsigned r; asm volatile("v_cvt_pk_bf16_f32 %0, %1, %2" : "=v"(r) : "v"(lo), "v"(hi)); return r; }
__device__ __forceinline__ f32x2 gelu_pk(f32x2 v) {
    const f32x2 av = __builtin_elementwise_abs(v), d = av * 0.2316418882f + 1.0f;
    f32x2 t; t.x = __builtin_amdgcn_rcpf(d.x); t.y = __builtin_amdgcn_rcpf(d.y);
    f32x2 q = t * 0.5307027145f + (-0.7265760135f); q = q * t + 0.7107068705f; q = q * t + (-0.142248368f); q = q * t + 0.127414796f; q = q * t;
    const f32x2 s = (v * v) * (-0.72134752044f);
    f32x2 e; e.x = __builtin_amdgcn_exp2f(s.x); e.y = __builtin_amdgcn_exp2f(s.y);
    const f32x2 m = v * (q * e), r = v - m;
    f32x2 o; o.x = v.x < 0.f ? m.x : r.x; o.y = v.y < 0.f ? m.y : r.y; return o;
}
__device__ __forceinline__ f32x4 gelu4(f32x4 v) { const f32x2 a = gelu_pk((f32x2){v[0], v[1]}), b = gelu_pk((f32x2){v[2], v[3]}); return (f32x4){a.x, a.y, b.x, b.y}; }
__device__ __forceinline__ f32x4 sigmoid4(f32x4 v) { f32x4 o;
#pragma unroll
    for (int i = 0; i < 4; ++i) o[i] = __builtin_amdgcn_rcpf(1.0f + __builtin_amdgcn_exp2f(-1.4426950408889634f * v[i]));
    return o; }
__device__ __forceinline__ u32x4 pack8v(f32x4 a, f32x4 b) { u32x4 w; w.x = cvt_pk_bf16(a[0], a[1]); w.y = cvt_pk_bf16(a[2], a[3]); w.z = cvt_pk_bf16(b[0], b[1]); w.w = cvt_pk_bf16(b[2], b[3]); return w; }

typedef int v8i __attribute__((ext_vector_type(8)));
template <class Epi, class Sched, bool ALIGN_EPI, bool F8 = false>
__device__ __forceinline__ void gemm_phase(PG_LAS unsigned char* lds, const unsigned char* Abase, const Sched& S, const Epi& E) {
    const int tid = tid_opaque(), wid = __builtin_amdgcn_readfirstlane(tid >> 6), lane = tid & 63, wr = wid >> 2, wc = wid & 3, fr = lane & 15, fq = lane >> 4;
    int R[2], C[2]; unsigned voffB[2];
#pragma unroll
    for (int i = 0; i < 2; ++i) { stage_rc(tid * 16 + i * 8192, R[i], C[i]);
        const int rho = R[i] & 31, Rb = Epi::PERM == 0 ? R[i] : (Epi::PERM == 1 ? ((R[i] & ~31) + perm32(rho)) : ((R[i] >> 5) * 64 + 16 * ((rho & 15) >> 2) + 4 * (rho >> 4) + (rho & 3)));
        voffB[i] = (unsigned)(Rb * (F8 ? 1024 : 2048) + C[i] * 2); }
    constexpr unsigned HSB = (Epi::PERM == 2 ? 8u : 128u) * (F8 ? 1024u : 2048u);
    constexpr int NTL = F8 ? NT / 2 : NT;
    const unsigned ldsw = (unsigned)wid * 1024u;
    const int aoff = lds_byte(wr * 64 + fr, fq * 8), boff = lds_byte(wc * 32 + fr, fq * 8);
#define PG_SA(b, h) (((b) * 2 + (h)) * HTB)
#define PG_SB(b, h) ((4 + (b) * 2 + (h)) * HTB)
#define PG_STAGE_A(bufoff, kbyte, vo) do { _Pragma("unroll") for (int _i = 0; _i < 2; ++_i) \
        __builtin_amdgcn_global_load_lds((const unsigned*)((const char*)Abase + (kbyte) + (vo)[_i]), (PG_LAS unsigned*)(lds + (bufoff) + ldsw + _i * 8192), 16, 0, 0); } while (0)
#define PG_STAGE_B(bufoff, gbase) do { _Pragma("unroll") for (int _i = 0; _i < 2; ++_i) \
        __builtin_amdgcn_global_load_lds((const unsigned*)((const char*)(gbase) + voffB[_i]), (PG_LAS unsigned*)(lds + (bufoff) + ldsw + _i * 8192), 16, 0, 0); } while (0)
#define PG_LD16(off) (*(const PG_LAS u32x4*)(lds + (off)))
#define PG_CAT(lo, hi) __builtin_bit_cast(v8i, __builtin_shufflevector((lo), (hi), 0, 1, 2, 3, 4, 5, 6, 7))
#define PG_LDA(dst, b, h) do { _Pragma("unroll") for (int m = 0; m < 4; ++m) { \
        if constexpr (F8) dst##8[m] = PG_CAT(PG_LD16(PG_SA(b, h) + aoff + m * 2048), PG_LD16(PG_SA(b, h) + aoff + m * 2048 + 1024)); \
        else { _Pragma("unroll") for (int k = 0; k < 2; ++k) dst[m][k] = *(const PG_LAS bf16x8*)(lds + PG_SA(b, h) + aoff + m * 2048 + k * 1024); } } } while (0)
#define PG_LDB(dst, b, h) do { _Pragma("unroll") for (int n = 0; n < 2; ++n) { \
        if constexpr (F8) dst##8[n] = PG_CAT(PG_LD16(PG_SB(b, h) + boff + n * 2048), PG_LD16(PG_SB(b, h) + boff + n * 2048 + 1024)); \
        else { _Pragma("unroll") for (int k = 0; k < 2; ++k) dst[n][k] = *(const PG_LAS bf16x8*)(lds + PG_SB(b, h) + boff + n * 2048 + k * 1024); } } } while (0)
#define PG_MMA(ai, bj, At, Bt) do { __builtin_amdgcn_s_setprio(1); _Pragma("unroll") for (int m = 0; m < 4; ++m) _Pragma("unroll") for (int n = 0; n < 2; ++n) { \
        if constexpr (F8) asm volatile("s_nop 1\n\tv_mfma_scale_f32_16x16x128_f8f6f4 %0, %1, %2, %0, %3, %3 op_sel_hi:[0,0,0]" : "+v"(acc[ai][bj][m][n]) : "v"(Bt##8[n]), "v"(At##8[m]), "v"(f8scale)); \
        else { _Pragma("unroll") for (int k = 0; k < 2; ++k) acc[ai][bj][m][n] = __builtin_amdgcn_mfma_f32_16x16x32_bf16(Bt[n][k], At[m][k], acc[ai][bj][m][n], 0, 0, 0); } } \
        __builtin_amdgcn_s_setprio(0); } while (0)
#define PG_WAIT_V(n) asm volatile("s_waitcnt vmcnt(" #n ")" ::: "memory")
#define PG_WAIT_L(n) asm volatile("s_waitcnt lgkmcnt(" #n ")" ::: "memory")
#define PG_BAR __builtin_amdgcn_s_barrier()
#define PG_SCHED __builtin_amdgcn_sched_barrier(0)
    Unit cur, nxt; int ui = 0;
    if (!S.next(0, cur)) return;
    f32x4 acc[2][2][4][2];
#pragma unroll
    for (int a = 0; a < 2; ++a)
#pragma unroll
        for (int b = 0; b < 2; ++b)
#pragma unroll
            for (int m = 0; m < 4; ++m)
#pragma unroll
                for (int n = 0; n < 2; ++n) acc[a][b][m][n] = (f32x4){0.f, 0.f, 0.f, 0.f};
    bf16x8 At[4][2], B0[2][2], B1[2][2]; v8i At8[4], B08[2], B18[2];
    int f8scale = 0x7f7f7f7f; asm volatile("" : "+v"(f8scale));
    unsigned ac[2][2], an[2][2];
    S.aoffs(cur, R, C, ac);
    const char* cB = S.bptr(cur);
    PG_STAGE_B(PG_SB(0, 0), cB); PG_STAGE_B(PG_SB(0, 1), cB + HSB); PG_STAGE_A(PG_SA(0, 0), 0u, ac[0]); PG_STAGE_A(PG_SA(0, 1), 0u, ac[1]);
    if (wr == 1) PG_BAR;
    PG_WAIT_V(2); PG_BAR;
    PG_STAGE_B(PG_SB(1, 0), cB + KSTEP); PG_STAGE_A(PG_SA(1, 0), KSTEP, ac[0]); PG_STAGE_B(PG_SB(1, 1), cB + HSB + KSTEP);
    PG_WAIT_V(6); PG_BAR;
    for (;;) {
        const bool has_next = S.next(ui + 1, nxt);
        const char* nB = cB;
        if (has_next) { int R2[2], C2[2]; int t2 = tid; asm volatile("" : "+v"(t2));
#pragma unroll
            for (int i = 0; i < 2; ++i) stage_rc(t2 * 16 + i * 8192, R2[i], C2[i]);
            S.aoffs(nxt, R2, C2, an); nB = S.bptr(nxt); }
        else {
#pragma unroll
            for (int h = 0; h < 2; ++h)
#pragma unroll
                for (int i = 0; i < 2; ++i) an[h][i] = ac[h][i]; }
        for (int t = 0; t < NTL; t += 2) {
            const bool last = (t == NTL - 2);
            const unsigned ka1 = (unsigned)(t + 1) * KSTEP;
            const unsigned ka2 = last ? 0u : (unsigned)(t + 2) * KSTEP;
            const char* b2 = last ? nB : cB + (size_t)(t + 2) * KSTEP; const char* b3 = b2 + KSTEP;
            unsigned a2o[2][2];
#pragma unroll
            for (int h = 0; h < 2; ++h)
#pragma unroll
                for (int i = 0; i < 2; ++i) a2o[h][i] = last ? an[h][i] : ac[h][i];
            PG_LDB(B0, 0, 0); PG_LDB(B1, 0, 1); PG_SCHED; PG_LDA(At, 0, 0); PG_STAGE_A(PG_SA(1, 1), ka1, ac[1]);
            PG_WAIT_V(8); PG_WAIT_L(0); PG_BAR; PG_MMA(0, 0, At, B0); PG_MMA(0, 1, At, B1); PG_BAR; PG_SCHED;
            PG_LDA(At, 0, 1); PG_STAGE_B(PG_SB(0, 0), b2); PG_STAGE_B(PG_SB(0, 1), b2 + HSB); PG_STAGE_A(PG_SA(0, 0), ka2, a2o[0]);
            PG_WAIT_V(8); PG_WAIT_L(0); PG_BAR; PG_MMA(1, 0, At, B0); PG_MMA(1, 1, At, B1); PG_BAR; PG_SCHED;
            PG_LDB(B0, 1, 0); PG_LDB(B1, 1, 1); PG_SCHED; PG_LDA(At, 1, 0); PG_STAGE_A(PG_SA(0, 1), ka2, a2o[1]);
            PG_WAIT_V(8); PG_WAIT_L(0); PG_BAR; PG_MMA(0, 0, At, B0); PG_MMA(0, 1, At, B1); PG_BAR; PG_SCHED;
            PG_LDA(At, 1, 1); PG_STAGE_B(PG_SB(1, 0), b3); PG_STAGE_B(PG_SB(1, 1), b3 + HSB); PG_STAGE_A(PG_SA(1, 0), ka2 + KSTEP, a2o[0]);
            PG_WAIT_V(8); PG_WAIT_L(0); PG_BAR; PG_MMA(1, 0, At, B0); PG_MMA(1, 1, At, B1); PG_BAR; PG_SCHED;
        }
        if constexpr (ALIGN_EPI) { if (wr == 0) PG_BAR; }
        if constexpr (F8) asm volatile("s_nop 15\n\ts_nop 15" ::: "memory");
        { int te = tid; asm volatile("" : "+v"(te)); E.run(acc, cur, wr, wc, te & 15, (te >> 4) & 3); }
        if (!has_next) break;
        if (!E.carry(cur)) {
#pragma unroll
            for (int a = 0; a < 2; ++a)
#pragma unroll
                for (int b = 0; b < 2; ++b)
#pragma unroll
                    for (int m = 0; m < 4; ++m)
#pragma unroll
                        for (int n = 0; n < 2; ++n) acc[a][b][m][n] = (f32x4){0.f, 0.f, 0.f, 0.f}; }
        cur = nxt; cB = nB; ++ui;
#pragma unroll
        for (int h = 0; h < 2; ++h)
#pragma unroll
            for (int i = 0; i < 2; ++i) ac[h][i] = an[h][i];
        if constexpr (ALIGN_EPI) { if (wr == 1) PG_BAR; }
    }
    PG_WAIT_V(0);
    if constexpr (!ALIGN_EPI) { if (wr == 0) PG_BAR; }
    PG_BAR;
#undef PG_SA
#undef PG_SB
#undef PG_STAGE_A
#undef PG_STAGE_B
#undef PG_LDA
#undef PG_LDB
#undef PG_MMA
#undef PG_CAT
#undef PG_LD16
#undef PG_WAIT_V
#undef PG_WAIT_L
#undef PG_BAR
#undef PG_SCHED
}

struct SchedP1 {
    int G, c; const unsigned char* ws;
    __device__ __forceinline__ bool next(int i, Unit& u) const {
        const int L = i * G + c; if (L >= 3136) return false;
        u.row0 = 0; u.nrows = 256; u.e = 0;
        if (L < 2048) { u.kind = 0; tilemap(L, 128, 16, u.pm, u.pn); }
        else if (L < 3072) { u.kind = 1; tilemap(L - 2048, 8, 128, u.pm, u.pn); }
        else if (L < 3104) { u.kind = 2; const int l = L - 3072; u.pm = l >> 2; u.pn = l & 3; }
        else { u.kind = 3; const int l = L - 3104; u.pm = l >> 3; u.pn = l & 7; }
        return true; }
    __device__ __forceinline__ void aoffs(const Unit& u, const int (&R)[2], const int (&C)[2], unsigned (&o)[2][2]) const {
        size_t base; int row0;
        if (u.kind == 0) { base = WS_U; row0 = 256 * u.pm; }
        else if (u.kind == 1) { base = WS_WIN; row0 = u.pm < 4 ? 1024 + 256 * u.pm : 4096 + 256 * (u.pm - 4); }
        else if (u.kind == 2) { base = WS_UC; row0 = 256 * u.pm; }
        else { base = WS_WIN; row0 = 4096 + 256 * u.pm; }
#pragma unroll
        for (int h = 0; h < 2; ++h)
#pragma unroll
            for (int i = 0; i < 2; ++i) o[h][i] = (unsigned)(base + ((size_t)(row0 + 128 * h + R[i]) * 1024 + C[i]) * 2); }
    __device__ __forceinline__ const char* bptr(const Unit& u) const {
        if (u.kind == 0) { const int wrow = u.pn < 4 ? 256 * u.pn : (u.pn < 8 ? 2048 + 256 * (u.pn - 4) : 5120 + 256 * (u.pn - 8)); return (const char*)ws + WS_WIN + (size_t)wrow * 2048; }
        if (u.kind == 1) return (const char*)ws + WS_U + (size_t)u.pn * 256 * 2048;
        if (u.kind == 2) return (const char*)ws + WS_WIN + (size_t)(3072 + 256 * u.pn) * 2048;
        return (const char*)ws + WS_UC + (size_t)u.pn * 256 * 2048; }
};
struct EpiP1 {
    static constexpr int PERM = 1;
    unsigned char* ws; const float* b_in;
    __device__ __forceinline__ bool carry(const Unit&) const { return false; }
    __device__ __forceinline__ void run(f32x4 (&acc)[2][2][4][2], const Unit& u, int wr, int wc, int fr, int fq) const {
        const int lc = wc * 32 + 8 * fq, kind = u.kind, pm = u.pm, pn = u.pn;
        const bool brow = (kind == 1) || (kind == 3);
        int act, bcol, browbase, RA, RB, CA, CB; size_t base;
        if (kind == 0) { browbase = 0;
            if (pn < 4) { act = 1; bcol = 256 * pn; base = WS_ZU / 2 + (size_t)256 * pm * 1024 + 256 * pn; RA = 65536; RB = 1024; CA = 64; CB = 1; }
            else if (pn < 8) { act = 0; bcol = 2048 + 256 * (pn - 4); const int tok0 = 256 * pm;
                base = WS_Q / 2 + ((size_t)((tok0 >> 12) * 16 + 4 * (pn - 4)) * 4096 + (tok0 & 4095)) * 64; RA = 4096; RB = 64; CA = 4096 * 64; CB = 1; }
            else { act = 2; bcol = 5120 + 256 * (pn - 8); base = WS_G / 2 + (size_t)256 * pm * 2048 + 256 * (pn - 8); RA = 131072; RB = 2048; CA = 64; CB = 1; } }
        else if (kind == 1) { bcol = 0; const int tk0 = 256 * pn;
            if (pm < 4) { act = 1; browbase = 1024 + 256 * pm; base = WS_ZVT / 2 + (size_t)(tk0 >> 3) * 8192 + 256 * pm * 8; RA = 512; RB = 8; CA = 65536; CB = 1024; }
            else { act = 0; browbase = 4096 + 256 * (pm - 4); base = WS_VT / 2 + ((size_t)((tk0 >> 12) * 16 + 4 * (pm - 4)) * 512 + ((tk0 & 4095) >> 3)) * 512; RA = 512 * 512; RB = 8; CA = 4096; CB = 64; } }
        else if (kind == 2) { act = 0; bcol = 3072 + 256 * pn; browbase = 0; base = WS_KC / 2 + (size_t)(pm * 16 + 4 * pn) * 256 * 64; RA = 4096; RB = 64; CA = 16384; CB = 1; }
        else { act = 0; bcol = 0; browbase = 4096 + 256 * pm; base = WS_VCT / 2 + (size_t)(pn * 16 + 4 * pm) * 32 * 512; RA = 32 * 512; RB = 8; CA = 4096; CB = 64; }
        bf16_t* dbase = (bf16_t*)ws + base;
        f32x4 bv[2][2];
#pragma unroll
        for (int bj = 0; bj < 2; ++bj)
#pragma unroll
            for (int n = 0; n < 2; ++n) bv[bj][n] = brow ? (f32x4){0.f, 0.f, 0.f, 0.f} : *(const f32x4*)(b_in + bcol + lc + bj * HALF + 4 * n);
        const int colterm0 = (wc >> 1) * CA + ((wc & 1) * 32 + 8 * fq) * CB;
#pragma unroll
        for (int ai = 0; ai < 2; ++ai)
#pragma unroll
            for (int m = 0; m < 4; ++m) { const int row = ai * HALF + wr * 64 + m * 16 + fr;
                const float rb = brow ? b_in[browbase + row] : 0.f;
                const int rowterm = (2 * ai + wr) * RA + (16 * m + fr) * RB;
#pragma unroll
                for (int bj = 0; bj < 2; ++bj) {
                    f32x4 v0 = acc[ai][bj][m][0] + bv[bj][0] + rb, v1 = acc[ai][bj][m][1] + bv[bj][1] + rb;
                    if (act == 1) { v0 = gelu4(v0); v1 = gelu4(v1); } else if (act == 2) { v0 = sigmoid4(v0); v1 = sigmoid4(v1); }
                    *(u32x4*)(dbase + rowterm + colterm0 + 2 * bj * CA) = pack8v(v0, v1); } }
    }
};
struct SchedK {
    int G, c; const unsigned char* ws;
    __device__ __forceinline__ bool next(int i, Unit& u) const { const int L = i * G + c; if (L >= 512) return false; u.kind = 0; u.row0 = 0; u.nrows = 256; u.e = 0; tilemap(L, 128, 4, u.pm, u.pn); return true; }
    __device__ __forceinline__ void aoffs(const Unit& u, const int (&R)[2], const int (&C)[2], unsigned (&o)[2][2]) const {
#pragma unroll
        for (int h = 0; h < 2; ++h)
#pragma unroll
            for (int i = 0; i < 2; ++i) o[h][i] = (unsigned)(WS_U + ((size_t)(256 * u.pm + 128 * h + R[i]) * 1024 + C[i]) * 2); }
    __device__ __forceinline__ const char* bptr(const Unit& u) const { return (const char*)ws + WS_WIN + (size_t)(3072 + 256 * u.pn) * 2048; }
};
struct EpiRope {
    static constexpr int PERM = 0;
    unsigned char* ws; const float* b_in;
    __device__ __forceinline__ bool carry(const Unit&) const { return false; }
    __device__ __forceinline__ void run(f32x4 (&acc)[2][2][4][2], const Unit& u, int wr, int wc, int fr, int fq) const {
        bf16_t* K = (bf16_t*)(ws + WS_K); const float* tab = (const float*)(ws + WS_ROPE);
        const int lc = wc * 32 + 4 * fq, axis = wc & 1;
        f32x4 b0[2], b1[2];
#pragma unroll
        for (int bj = 0; bj < 2; ++bj) { b0[bj] = *(const f32x4*)(b_in + 3072 + 256 * u.pn + bj * HALF + lc); b1[bj] = *(const f32x4*)(b_in + 3072 + 256 * u.pn + bj * HALF + lc + 16); }
#pragma unroll
        for (int ai = 0; ai < 2; ++ai)
#pragma unroll
            for (int m = 0; m < 4; ++m) { const int tok = 256 * u.pm + ai * HALF + wr * 64 + m * 16 + fr;
                const int pos = axis ? (tok & 63) : ((tok >> 6) & 63);
                const f32x4 t0 = *(const f32x4*)(tab + (pos * 16 + 4 * fq) * 2), t1 = *(const f32x4*)(tab + (pos * 16 + 4 * fq) * 2 + 4);
                const f32x4 cs = (f32x4){t0[0], t0[2], t1[0], t1[2]}, sn = (f32x4){t0[1], t0[3], t1[1], t1[3]};
                const int cc0 = 256 * u.pn + lc;
                bf16_t* rowp = K + ((size_t)((tok >> 12) * 16) * 4096 + (tok & 4095)) * 64;
#pragma unroll
                for (int bj = 0; bj < 2; ++bj) { const f32x4 v0 = acc[ai][bj][m][0] + b0[bj], v1 = acc[ai][bj][m][1] + b1[bj];
                    const f32x4 o0 = v0 * cs - v1 * sn, o1 = v1 * cs + v0 * sn;
                    u32x2 w0, w1; w0.x = cvt_pk_bf16(o0[0], o0[1]); w0.y = cvt_pk_bf16(o0[2], o0[3]); w1.x = cvt_pk_bf16(o1[0], o1[1]); w1.y = cvt_pk_bf16(o1[2], o1[3]);
                    const int cc = cc0 + bj * HALF; bf16_t* dp = rowp + (size_t)(cc >> 6) * 4096 * 64 + (cc & 63);
                    *(u32x2*)dp = w0; *(u32x2*)(dp + 16) = w1; } }
    }
};
struct SchedMerge {
    int G, c; const unsigned char* ws;
    __device__ __forceinline__ bool next(int i, Unit& u) const { const int L = (i >> 1) * G + c; if (L >= 512) return false; u.kind = i & 1; u.row0 = 0; u.nrows = 256; u.e = 0; tilemap(L, 128, 4, u.pm, u.pn); return true; }
    __device__ __forceinline__ void aoffs(const Unit& u, const int (&R)[2], const int (&C)[2], unsigned (&o)[2][2]) const {
        const size_t base = u.kind ? WS_YB : WS_U;
#pragma unroll
        for (int h = 0; h < 2; ++h)
#pragma unroll
            for (int i = 0; i < 2; ++i) o[h][i] = (unsigned)(base + ((size_t)(256 * u.pm + 128 * h + R[i]) * 1024 + C[i]) * 2); }
    __device__ __forceinline__ const char* bptr(const Unit& u) const { return (const char*)ws + (u.kind ? WS_WPB : WS_WPA) + (size_t)u.pn * 256 * 2048; }
};
struct EpiMerge {
    static constexpr int PERM = 1;
    unsigned char* ws;
    __device__ __forceinline__ bool carry(const Unit& u) const { return u.kind == 0; }
    __device__ __forceinline__ void run(f32x4 (&acc)[2][2][4][2], const Unit& u, int wr, int wc, int fr, int fq) const {
        const bf16_t* Gt = (const bf16_t*)(ws + WS_G); bf16_t* INNER = (bf16_t*)(ws + WS_INNER);
        const int lc = 256 * u.pn + wc * 32 + 8 * fq;
#pragma unroll
        for (int ai = 0; ai < 2; ++ai)
#pragma unroll
            for (int m = 0; m < 4; ++m) { const size_t tok = (size_t)(256 * u.pm + ai * HALF + wr * 64 + m * 16 + fr);
#pragma unroll
                for (int bj = 0; bj < 2; ++bj) { const int col = lc + bj * HALF;
                    const u32x4 gbw = *(const u32x4*)(Gt + tok * 2048 + 1024 + col);
                    f32x4 gb0 = (f32x4){bflo(gbw.x), bfhi(gbw.x), bflo(gbw.y), bfhi(gbw.y)}, gb1 = (f32x4){bflo(gbw.z), bfhi(gbw.z), bflo(gbw.w), bfhi(gbw.w)};
                    if (u.kind == 0) { const u32x4 gaw = *(const u32x4*)(Gt + tok * 2048 + col);
                        const f32x4 ga0 = (f32x4){bflo(gaw.x), bfhi(gaw.x), bflo(gaw.y), bfhi(gaw.y)}, ga1 = (f32x4){bflo(gaw.z), bfhi(gaw.z), bflo(gaw.w), bfhi(gaw.w)};
#pragma unroll
                        for (int i = 0; i < 4; ++i) { acc[ai][bj][m][0][i] *= ga0[i] * __builtin_amdgcn_rcpf(fmaxf(gb0[i], 1e-30f)); acc[ai][bj][m][1][i] *= ga1[i] * __builtin_amdgcn_rcpf(fmaxf(gb1[i], 1e-30f)); }
                    } else { *(u32x4*)(INNER + tok * 1024 + col) = pack8v(acc[ai][bj][m][0] * gb0, acc[ai][bj][m][1] * gb1); } } }
    }
};
struct SchedMix {
    int G, c; const unsigned char* ws;
    __device__ __forceinline__ bool next(int i, Unit& u) const { const int L = i * G + c; if (L >= 512) return false; u.kind = 0; u.row0 = 0; u.nrows = 256; u.e = 0; tilemap(L, 128, 4, u.pm, u.pn); return true; }
    __device__ __forceinline__ void aoffs(const Unit& u, const int (&R)[2], const int (&C)[2], unsigned (&o)[2][2]) const {
#pragma unroll
        for (int h = 0; h < 2; ++h)
#pragma unroll
            for (int i = 0; i < 2; ++i) o[h][i] = (unsigned)(WS_INNER + ((size_t)(256 * u.pm + 128 * h + R[i]) * 1024 + C[i]) * 2); }
    __device__ __forceinline__ const char* bptr(const Unit& u) const { return (const char*)ws + WS_WOUT + (size_t)u.pn * 256 * 2048; }
};
struct EpiMix {
    static constexpr int PERM = 0;
    unsigned char* ws; const float *x, *lng, *lnb, *b_out; float* out;
    __device__ __forceinline__ bool carry(const Unit&) const { return false; }
    __device__ __forceinline__ void run(f32x4 (&acc)[2][2][4][2], const Unit& u, int wr, int wc, int fr, int fq) const {
        const float* rowstat = (const float*)(ws + WS_ROWSTAT); const float* mod = (const float*)(ws + WS_MOD) + ((256 * u.pm) >> 12) * 6144 + 2048;
        f32x2 st[2][4];
#pragma unroll
        for (int ai = 0; ai < 2; ++ai)
#pragma unroll
            for (int m = 0; m < 4; ++m) st[ai][m] = *(const f32x2*)(rowstat + 2 * (256 * u.pm + ai * HALF + wr * 64 + m * 16 + fr));
#pragma unroll
        for (int bj = 0; bj < 2; ++bj)
#pragma unroll
            for (int n = 0; n < 2; ++n) { const int col = 256 * u.pn + bj * HALF + wc * 32 + n * 16 + 4 * fq;
                const f32x4 lg = *(const f32x4*)(lng + col), lb = *(const f32x4*)(lnb + col), bo = *(const f32x4*)(b_out + col), g1 = *(const f32x4*)(mod + col);
#pragma unroll
                for (int ai = 0; ai < 2; ++ai)
#pragma unroll
                    for (int m = 0; m < 4; ++m) { const size_t off = (size_t)(256 * u.pm + ai * HALF + wr * 64 + m * 16 + fr) * 1024 + col;
                        const f32x4 xv = *(const f32x4*)(x + off);
                        const f32x4 x0 = (xv - st[ai][m].x) * st[ai][m].y * lg + lb;
                        const f32x4 r = x0 * ALPHA + g1 * (acc[ai][bj][m][n] + bo); u32x2 w; w.x = cvt_pk_bf16(r[0], r[1]); w.y = cvt_pk_bf16(r[2], r[3]);
                        *(u32x2*)((bf16_t*)(ws + WS_X1PRE) + off) = w; }
                asm volatile("" ::: "memory"); }
    }
};
__device__ __forceinline__ int ld_u(const int* p) { return __builtin_amdgcn_readfirstlane(__hip_atomic_load(p, __ATOMIC_RELAXED, __HIP_MEMORY_SCOPE_AGENT)); }
template <int NPN  > struct SchedMoe {
    int G, c; const unsigned char* ws; const int* tabs;
    __device__ __forceinline__ bool next(int i, Unit& u) const {
        const int* cn = tabs; const int* eb = tabs + 32; const int* tb = tabs + 65;
        const int ntiles = tb[32], tpx = (ntiles + 7) >> 3, x = c & 7, s = c >> 3;
        const int tiles_x = min(tpx, ntiles - x * tpx), ll = i * (G >> 3) + s;
        if (ll >= NPN * tiles_x) return false;
        const int T = x * tpx + ll / NPN; u.pn = ll % NPN; u.kind = 0;
        int e = 0;
#pragma unroll 1
        for (int k = 16; k >= 1; k >>= 1) if (tb[e + k] <= T) e += k;
        const int jt = T - tb[e];
        u.e = __builtin_amdgcn_readfirstlane(e); u.pm = __builtin_amdgcn_readfirstlane(jt);
        u.row0 = __builtin_amdgcn_readfirstlane(eb[e] + 256 * jt); u.nrows = __builtin_amdgcn_readfirstlane(min(256, cn[e] - 256 * jt)); return true; }
    __device__ __forceinline__ void aoffs(const Unit& u, const int (&R)[2], const int (&C)[2], unsigned (&o)[2][2]) const {
        const int* PERM2 = (const int*)(ws + WS_PERM2) + (size_t)u.e * NTOK + 256 * u.pm;
#pragma unroll
        for (int h = 0; h < 2; ++h)
#pragma unroll
            for (int i = 0; i < 2; ++i) { const int lr = min(128 * h + R[i], u.nrows - 1);
                if (NPN == 8) { const int tok = PERM2[lr]; o[h][i] = (unsigned)(WS_U + (size_t)tok * 1024 + C[i] * 2); }
                else o[h][i] = (unsigned)(WS_ACT + (size_t)(u.row0 + lr) * 1024 + C[i] * 2); } }
    __device__ __forceinline__ const char* bptr(const Unit& u) const {
        if (NPN == 8) return (const char*)ws + WS_W1 + ((size_t)u.e * 2048 + 256 * u.pn) * 1024;
        return (const char*)ws + WS_W2 + ((size_t)u.e * 1024 + 256 * u.pn) * 1024; }
};
struct EpiMoe1 {
    static constexpr int PERM = 1;
    unsigned char* ws; const float* b1;
    __device__ __forceinline__ bool carry(const Unit&) const { return false; }
    __device__ __forceinline__ void run(f32x4 (&acc)[2][2][4][2], const Unit& u, int wr, int wc, int fr, int fq) const {
        unsigned char* ACT = ws + WS_ACT;
        const int col = 128 * u.pn + wc * 32 + 8 * fq;
        f32x4 bg[2], bl[2];
#pragma unroll
        for (int n = 0; n < 2; ++n) { bg[n] = *(const f32x4*)(b1 + u.e * 2048 + col + 4 * n); bl[n] = *(const f32x4*)(b1 + u.e * 2048 + 1024 + col + 4 * n); }
#pragma unroll
        for (int ai = 0; ai < 2; ++ai)
#pragma unroll
            for (int m = 0; m < 4; ++m) { const int lr = ai * HALF + wr * 64 + m * 16 + fr;
                f32x4 a[2];
#pragma unroll
                for (int n = 0; n < 2; ++n) { const f32x4 zgv = acc[ai][0][m][n] * (1.0f / W_F8_SCALE) + bg[n], zlv = acc[ai][1][m][n] * (1.0f / W_F8_SCALE) + bl[n];
#pragma unroll
                    for (int i = 0; i < 4; ++i) { const float zg = fminf(zgv[i], 7.0f), zl = fminf(fmaxf(zlv[i], -7.0f), 7.0f);
                        a[n][i] = fminf(fmaxf(ACT_F8_SCALE * zg * __builtin_amdgcn_rcpf(1.0f + __builtin_amdgcn_exp2f(-1.702f * 1.4426950408889634f * zg)) * (zl + 1.0f), -448.0f), 448.0f); } }
                if (lr < u.nrows) *(u32x2*)(ACT + (size_t)(u.row0 + lr) * 1024 + col) = pack8_f8(a[0], a[1]); }
    }
};
struct EpiMoe2 {
    static constexpr int PERM = 2;
    unsigned char* ws; const float* b2;
    __device__ __forceinline__ bool carry(const Unit&) const { return false; }
    __device__ __forceinline__ void run(f32x4 (&acc)[2][2][4][2], const Unit& u, int wr, int wc, int fr, int fq) const {
        unsigned char* YS = ws + WS_YS; constexpr float DS = 1.0f / (W_F8_SCALE * ACT_F8_SCALE);
        const int lc = 256 * u.pn + wc * 64 + 16 * fq;
        f32x4 bv[2][2];
#pragma unroll
        for (int bj = 0; bj < 2; ++bj)
#pragma unroll
            for (int n = 0; n < 2; ++n) bv[bj][n] = *(const f32x4*)(b2 + u.e * 1024 + lc + 8 * bj + 4 * n);
#pragma unroll
        for (int ai = 0; ai < 2; ++ai)
#pragma unroll
            for (int m = 0; m < 4; ++m) { const int lr = ai * HALF + wr * 64 + m * 16 + fr;
                if (lr < u.nrows) { const u32x2 lo = pack8_f8((acc[ai][0][m][0] * DS + bv[0][0]) * YS_F8_SCALE, (acc[ai][0][m][1] * DS + bv[0][1]) * YS_F8_SCALE), hi = pack8_f8((acc[ai][1][m][0] * DS + bv[1][0]) * YS_F8_SCALE, (acc[ai][1][m][1] * DS + bv[1][1]) * YS_F8_SCALE);
                    u32x4 w; w.x = lo.x; w.y = lo.y; w.z = hi.x; w.w = hi.y; *(u32x4*)(YS + (size_t)(u.row0 + lr) * 1024 + lc) = w; } }
    }
};
}
__device__ __forceinline__ void phase_merge_fast(const P& p, int bid, int nblk, unsigned char* lds) {
    pg::SchedMerge S{nblk, bid, p.ws}; pg::EpiMerge E{p.ws};
    pg::gemm_phase<pg::EpiMerge, pg::SchedMerge, true>((PG_LAS unsigned char*)lds, p.ws, S, E);
}
__device__ __forceinline__ void phase_mix_fast(const P& p, int bid, int nblk, unsigned char* lds) {
    pg::SchedMix S{nblk, bid, p.ws}; pg::EpiMix E{p.ws, p.x, p.ln_x_g, p.ln_x_b, p.b_out, p.out};
    pg::gemm_phase<pg::EpiMix, pg::SchedMix, true>((PG_LAS unsigned char*)lds, p.ws, S, E);
}
__device__ __forceinline__ void phase_moe1_fast(const P& p, int bid, int nblk, unsigned char* lds) {
    moe_tables(p, lds); pg::SchedMoe<8> S{nblk, bid, p.ws, (const int*)(lds + MT_LDS)}; pg::EpiMoe1 E{p.ws, p.exp_b1};
    pg::gemm_phase<pg::EpiMoe1, pg::SchedMoe<8>, true, true>((PG_LAS unsigned char*)lds, p.ws, S, E);
}
__device__ __forceinline__ void phase_moe2_fast(const P& p, int bid, int nblk, unsigned char* lds) {
    moe_tables(p, lds); pg::SchedMoe<4> S{nblk, bid, p.ws, (const int*)(lds + MT_LDS)}; pg::EpiMoe2 E{p.ws, p.exp_b2};
    pg::gemm_phase<pg::EpiMoe2, pg::SchedMoe<4>, true, true>((PG_LAS unsigned char*)lds, p.ws, S, E);
}
__device__ __forceinline__ void phase_proj_fast(const P& p, int bid, int nblk, unsigned char* lds) {
    { pg::SchedP1 S{nblk, bid, p.ws}; pg::EpiP1 E{p.ws, p.b_in};
      pg::gemm_phase<pg::EpiP1, pg::SchedP1, true>((PG_LAS unsigned char*)lds, p.ws, S, E); }
    { pg::SchedK S{nblk, bid, p.ws}; pg::EpiRope E{p.ws, p.b_in};
      pg::gemm_phase<pg::EpiRope, pg::SchedK, true>((PG_LAS unsigned char*)lds, p.ws, S, E); }
}

#define LAS __attribute__((address_space(3)))
#define XB_TMO      128
#define XB_XCNT(j)  (256  + 64 * (j))
#define XB_XSUB(j)  (1280 + 64 * (j))
#define XB_XGEN(j)  (2304 + 64 * (j))
#define XB_TOP      3328
#define XB_TOPGEN   3392
#define XCD_BAR_WORDS 3456
#define XB_SPIN_CAP (1u << 22)
__device__ __forceinline__ unsigned xb_ld(unsigned* p)              { return __hip_atomic_load(p, __ATOMIC_RELAXED, __HIP_MEMORY_SCOPE_AGENT); }
__device__ __forceinline__ unsigned xb_add(unsigned* p, unsigned v) { return __hip_atomic_fetch_add(p, v, __ATOMIC_RELAXED, __HIP_MEMORY_SCOPE_AGENT); }
__device__ __forceinline__ unsigned xb_xcc_id() { return (unsigned)__builtin_amdgcn_s_getreg((3 << 11) | 20) & 0xFu; }
#define XB_SPIN(cond, bar) do { unsigned _sp = 0; while (cond) { __builtin_amdgcn_s_sleep(1); \
    if ((++_sp & 255u) == 0u) { if (xb_ld(&(bar)[XB_TMO])) break; if (_sp > XB_SPIN_CAP) { atomicAdd(&(bar)[XB_TMO], 1u); break; } } } } while (0)
struct XcdBarrier { unsigned* bar; unsigned x; volatile LAS unsigned* st; };
__device__ __forceinline__ XcdBarrier xcd_barrier_post(unsigned* bar, volatile LAS unsigned* st) {
    XcdBarrier b; b.bar = bar; b.x = xb_xcc_id(); b.st = st;
    if (threadIdx.x == 0) (void)xb_add(&bar[XB_XCNT(b.x)], 1u);
    return b;
}
__device__ __forceinline__ void xcd_barrier_complete(unsigned* bar, unsigned x, unsigned& nloc, unsigned& nx) {
    const unsigned G = gridDim.x * gridDim.y * gridDim.z;
    unsigned sum, cnt, mine, sp = 0u;
    for (;;) {
        sum = 0u; cnt = 0u; mine = 0u;
#pragma unroll
        for (unsigned j = 0; j < 16; ++j) { const unsigned c = xb_ld(&bar[XB_XCNT(j)]); sum += c; cnt += (c > 0u) ? 1u : 0u; mine = (j == x) ? c : mine; }
        if (sum == G) break;
        __builtin_amdgcn_s_sleep(1);
        if ((++sp & 255u) == 0u) { if (xb_ld(&bar[XB_TMO])) break; if (sp > XB_SPIN_CAP) { atomicAdd(&bar[XB_TMO], 1u); break; } }
    }
    nloc = mine > 0u ? mine : 1u; nx = cnt > 0u ? cnt : 1u;
}
__device__ __forceinline__ void xcd_barrier(const XcdBarrier& b) {
    asm volatile("s_waitcnt vmcnt(0)" ::: "memory");
    __syncthreads();
    if (threadIdx.x == 0) {
        unsigned* bar = b.bar;
        __builtin_amdgcn_s_waitcnt(0);
        unsigned nloc = b.st[0], nx = b.st[1];
        if (nloc == 0u) { xcd_barrier_complete(bar, b.x, nloc, nx); b.st[0] = nloc; b.st[1] = nx; }
        const unsigned old = xb_add(&bar[XB_XSUB(b.x)], 1u);
        const unsigned gen = old / nloc;
        if (old + 1u == (gen + 1u) * nloc) {
            __builtin_amdgcn_fence(__ATOMIC_RELEASE, "agent");
            asm volatile("s_waitcnt vmcnt(0)" ::: "memory");
            const unsigned og = xb_add(&bar[XB_TOP], 1u);
            const unsigned tg = og / nx;
            if (og + 1u == (tg + 1u) * nx) xb_add(&bar[XB_TOPGEN], 1u);
            else XB_SPIN(xb_ld(&bar[XB_TOPGEN]) == tg, bar);
            __builtin_amdgcn_fence(__ATOMIC_ACQUIRE, "agent");
            xb_add(&bar[XB_XGEN(b.x)], 1u);
            asm volatile("s_waitcnt vmcnt(0)" ::: "memory");
        } else {
            XB_SPIN(xb_ld(&bar[XB_XGEN(b.x)]) == gen, bar);
            __builtin_amdgcn_fence(__ATOMIC_ACQUIRE, "agent");
            asm volatile("s_waitcnt vmcnt(0)" ::: "memory");
        }
    }
    __syncthreads();
}
#include <hip/hip_cooperative_groups.h>
namespace cg = cooperative_groups;
constexpr int LDS_BYTES = 147456;
constexpr int XB_LDS = LDS_BYTES - 64;
constexpr int CW_BAR = 4096;
constexpr int REP_PA = 1, REP_PB = 1, REP_P1 = 1, REP_GMLP = 1, REP_ATTN = 1, REP_MERGE = 1, REP_MIX = 1, REP_MOE1 = 1, REP_MOE2 = 1, REP_BAR = 0;
__global__ void __launch_bounds__(512, 2) mega(P p) {
    extern __shared__ __attribute__((aligned(16))) unsigned char lds[];
    const int bid = blockIdx.x, nblk = gridDim.x;
    if (threadIdx.x < 16) ((volatile LAS unsigned*)((LAS unsigned char*)lds + XB_LDS))[threadIdx.x] = 0u;
    __syncthreads();
    const XcdBarrier bar = xcd_barrier_post((unsigned*)(p.ws + WS_CTL) + CW_BAR, (volatile LAS unsigned*)((LAS unsigned char*)lds + XB_LDS));
#define GRID_BAR() xcd_barrier(bar)
#define REP(n) _Pragma("unroll 1") for (int rep_ = 0; rep_ < (n); ++rep_)
    REP(REP_PA) { __syncthreads(); phase_prologue_a(p, bid, nblk, lds); } GRID_BAR();
    REP(REP_PB) phase_prologue_b(p, bid, nblk); GRID_BAR();
    REP(REP_P1) phase_proj_fast(p, bid, nblk, lds); GRID_BAR();
    REP(REP_GMLP) phase_gmlp_fast(p, bid, nblk, lds); REP(REP_ATTN) phase_attn_s(p, bid, nblk, lds); GRID_BAR();
    REP(REP_MERGE) phase_merge_fast(p, bid, nblk, lds); GRID_BAR();
    REP(REP_MIX) phase_mix_fast(p, bid, nblk, lds); GRID_BAR();
    phase_router(p, bid, nblk, lds); GRID_BAR();
    REP(REP_BAR) GRID_BAR();
    REP(REP_MOE1) phase_moe1_fast(p, bid, nblk, lds); GRID_BAR();
    REP(REP_MOE2) phase_moe2_fast(p, bid, nblk, lds); GRID_BAR();
#undef REP
    phase_final(p, bid, nblk, lds);
}

extern "C" void kernel_launch(void* const* d_in, const int* in_sizes, int n_in, void* d_out, int out_size, void* d_ws, size_t ws_size, hipStream_t stream) {
    static int grid = 0;
    if (grid == 0) {
        if (n_in != 31 || out_size != NTOK * DM || ws_size < WS_END) { fprintf(stderr, "kernel_launch: unexpected sizes n_in %d out %d ws %zu\n", n_in, out_size, ws_size); grid = -1; return; }
        int dev = 0, cus = 0, per_cu = 0;
        if (hipGetDevice(&dev) != hipSuccess || hipDeviceGetAttribute(&cus, hipDeviceAttributeMultiprocessorCount, dev) != hipSuccess) { grid = -1; return; }
        if (hipFuncSetAttribute((const void*)mega, hipFuncAttributeMaxDynamicSharedMemorySize, LDS_BYTES) != hipSuccess) { fprintf(stderr, "kernel_launch: hipFuncSetAttribute failed\n"); grid = -1; return; }
        if (hipOccupancyMaxActiveBlocksPerMultiprocessor(&per_cu, (const void*)mega, 512, LDS_BYTES) != hipSuccess || per_cu < 1) { fprintf(stderr, "kernel_launch: occupancy query failed (%d)\n", per_cu); grid = -1; return; }
        grid = cus * 1;
    }
    if (grid < 0) return;
    P p{};
    const float** pp = (const float**)&p;
    for (int i = 0; i < 31; ++i) pp[i] = (const float*)d_in[i];
    p.out = (float*)d_out; p.ws = (unsigned char*)d_ws; p.ph_lo = 0; p.ph_hi = 0;
    if (hipMemsetAsync((char*)d_ws + WS_CTL, 0, 1 * MiB, stream) != hipSuccess) { fprintf(stderr, "kernel_launch: memset failed\n"); return; }
    hipLaunchKernelGGL(mega, dim3(grid), dim3(512), LDS_BYTES, stream, p);
    const hipError_t e = hipPeekAtLastError();
    if (e != hipSuccess) fprintf(stderr, "launch failed: %s (grid %d)\n", hipGetErrorString(e), grid);
}
```

```cpp
#include <hip/hip_runtime.h>
#include <cstdio>
#include <cstdint>

typedef unsigned short bf16_t;
typedef short bf16x8 __attribute__((ext_vector_type(8)));
typedef float f32x4 __attribute__((ext_vector_type(4)));
typedef unsigned u32x4 __attribute__((ext_vector_type(4)));
typedef unsigned u32x2 __attribute__((ext_vector_type(2)));

constexpr int DM = 1024, NB = 8, SEQ = 4096, NTOK = NB * SEQ, CTXL = 256, NCTX = NB * CTXL, INW = 7168;
constexpr int NE = 32, TOPK = 4, FF = 1024, NASSIGN = NTOK * TOPK;
constexpr int NHEAD = 16, HD = 64, GW = 64;
constexpr float LN_EPS = 1e-5f;
constexpr float ALPHA = 1.189207115002721f;
constexpr int MAXTILES = NASSIGN / 256 + NE;

constexpr size_t MiB = 1u << 20;
constexpr size_t WS_CTL = 0;
constexpr size_t WS_MOD = 1 * MiB;
constexpr size_t WS_ROPE = 1 * MiB + 512 * 1024;
constexpr size_t WS_ROWSTAT = 2 * MiB;
constexpr size_t WS_ZSTAT = 2 * MiB + 512 * 1024;
constexpr size_t WS_TOPE = 3 * MiB;
constexpr size_t WS_TOPG = 4 * MiB;
constexpr size_t WS_SLOT = 5 * MiB;
constexpr size_t WS_PERM = 6 * MiB;
constexpr size_t WS_TILES = 7 * MiB;
constexpr size_t WS_WIN = 8 * MiB;
constexpr size_t WS_WPA = 22 * MiB, WS_WPB = 24 * MiB, WS_WOUT = 26 * MiB, WS_WSB = 28 * MiB;
constexpr size_t WS_KC = 30 * MiB;
constexpr size_t WS_VCT = 34 * MiB;
constexpr size_t WS_UC = 38 * MiB;
constexpr size_t WS_PERM2 = 42 * MiB;
constexpr size_t WS_W1 = 48 * MiB;
constexpr size_t WS_W2 = 176 * MiB;
constexpr size_t WS_U = 240 * MiB;
constexpr size_t WS_ZU = 304 * MiB;
constexpr size_t WS_ZVT = 368 * MiB;
constexpr size_t WS_Q = 432 * MiB;
constexpr size_t WS_K = 496 * MiB;
constexpr size_t WS_VT = 560 * MiB;
constexpr size_t WS_G = 624 * MiB;
constexpr size_t WS_YB = 752 * MiB;
constexpr size_t WS_INNER = 816 * MiB;
constexpr size_t WS_ACT = WS_ZU;
constexpr size_t WS_YS = WS_G;
constexpr size_t WS_X1PRE = WS_YB;
constexpr size_t WS_X1 = WS_VT;
constexpr size_t WS_END = 880 * MiB;

struct P {
    const float *x, *c, *ctx, *c_ctx, *ln_x_g, *ln_x_b, *ln_ctx_g, *ln_ctx_b, *w_ada, *b_ada, *w_in, *b_in, *gmlp_ln_g, *gmlp_ln_b, *gmlp_ws, *gmlp_bs,
        *na_rpb, *w_pa, *w_pb, *w_out, *b_out, *ln1_g, *ln1_b, *ln2_g, *ln2_b, *router_w, *router_b, *exp_w1, *exp_b1, *exp_w2, *exp_b2;
    float* out; unsigned char* ws; int ph_lo, ph_hi;
};

__device__ __forceinline__ int tid_opaque() { int t = threadIdx.x; asm volatile("" : "+v"(t)); return t; }
typedef float f32x2_ __attribute__((ext_vector_type(2))); typedef __bf16 bf16x2_ __attribute__((ext_vector_type(2)));
__device__ __forceinline__ unsigned pk2(float lo, float hi) { const f32x2_ v = {lo, hi}; return __builtin_bit_cast(unsigned, __builtin_convertvector(v, bf16x2_)); }
__device__ __forceinline__ unsigned f2bf(float f) { return pk2(f, 0.f) & 0xffffu; }
__device__ __forceinline__ float bf2f(unsigned h) { return __builtin_bit_cast(float, (h & 0xffffu) << 16); }
__device__ __forceinline__ float bflo(unsigned w) { return __builtin_bit_cast(float, w << 16); }
__device__ __forceinline__ float bfhi(unsigned w) { return __builtin_bit_cast(float, w & 0xffff0000u); }
__device__ __forceinline__ u32x2 pack8_f8(f32x4 a, f32x4 b) {
    int w0 = 0, w1 = 0;
    w0 = __builtin_amdgcn_cvt_pk_fp8_f32(a[0], a[1], w0, false); w0 = __builtin_amdgcn_cvt_pk_fp8_f32(a[2], a[3], w0, true);
    w1 = __builtin_amdgcn_cvt_pk_fp8_f32(b[0], b[1], w1, false); w1 = __builtin_amdgcn_cvt_pk_fp8_f32(b[2], b[3], w1, true);
    u32x2 r; r.x = (unsigned)w0; r.y = (unsigned)w1; return r;
}
typedef float f32x2u __attribute__((ext_vector_type(2)));
__device__ __forceinline__ f32x4 unpack4_f8(unsigned w) { const f32x2u lo = __builtin_amdgcn_cvt_pk_f32_fp8((int)w, false), hi = __builtin_amdgcn_cvt_pk_f32_fp8((int)w, true); return (f32x4){lo.x, lo.y, hi.x, hi.y}; }
constexpr float YS_F8_SCALE = 16.0f;
__device__ __forceinline__ float wave_sum(float v) {
#pragma unroll
    for (int o = 1; o < 64; o <<= 1) v += __shfl_xor(v, o);
    return v;
}
__device__ __forceinline__ float wave_max(float v) {
#pragma unroll
    for (int o = 1; o < 64; o <<= 1) v = fmaxf(v, __shfl_xor(v, o));
    return v;
}
__device__ __forceinline__ float gelu_exact(float v) { return 0.5f * v * (1.0f + erff(v * 0.70710678118654752f)); }
__device__ __forceinline__ float sigmoidf_(float v) { return 1.0f / (1.0f + __expf(-v)); }

__device__ __forceinline__ void mod_item(const P& p, int item, float* red  ) {
    const int tid = tid_opaque(), wave = tid >> 6, lane = tid & 63;
    const int col = item * 32 + (lane & 31), kpar = lane >> 5;
    float acc[9];
#pragma unroll
    for (int r = 0; r < 9; ++r) acc[r] = 0.f;
    for (int kk = 0; kk < 64; ++kk) {
        const int k = wave * 128 + kk * 2 + kpar;
        const float w = p.w_ada[(size_t)k * 6144 + col];
#pragma unroll
        for (int r = 0; r < 9; ++r) { const float cv = (r < 8) ? p.c[r * 1024 + k] : p.c_ctx[k]; const float s = cv / (1.0f + __expf(-cv)); acc[r] += s * w; }
    }
#pragma unroll
    for (int r = 0; r < 9; ++r) red[((wave * 2 + kpar) * 9 + r) * 32 + (lane & 31)] = acc[r];
    __syncthreads();
    if (tid < 288) {
        const int r = tid >> 5, cc = tid & 31; float s = 0.f;
#pragma unroll
        for (int q = 0; q < 16; ++q) s += red[(q * 9 + r) * 32 + cc];
        ((float*)(p.ws + WS_MOD))[r * 6144 + item * 32 + cc] = s + p.b_ada[item * 32 + cc];
    }
    __syncthreads();
}
__device__ __forceinline__ void transpose_item(const float* W, int K, int N, bf16_t* WT, int k0, int n0, int drow0, float* scr, int lane) {
    const int lr = lane >> 3, lc4 = (lane & 7) * 4;
    f32x4 v[8];
#pragma unroll
    for (int i = 0; i < 8; ++i) v[i] = *(const f32x4*)(W + (size_t)(k0 + 8 * i + lr) * N + n0 + lc4);
#pragma unroll
    for (int i = 0; i < 8; ++i) { float* d = scr + (8 * i + lr) * 33 + lc4; d[0] = v[i].x; d[1] = v[i].y; d[2] = v[i].z; d[3] = v[i].w; }
    __builtin_amdgcn_wave_barrier();
    asm volatile("s_waitcnt lgkmcnt(0)" ::: "memory");
    const int c = lane & 7;
#pragma unroll
    for (int j = 0; j < 4; ++j) { const int n = (lane >> 3) + 8 * j; const float* s = scr + (8 * c) * 33 + n;
        u32x4 o; o.x = pk2(s[0 * 33], s[1 * 33]); o.y = pk2(s[2 * 33], s[3 * 33]); o.z = pk2(s[4 * 33], s[5 * 33]); o.w = pk2(s[6 * 33], s[7 * 33]);
        *(u32x4*)(WT + (size_t)(drow0 + n) * K + k0 + 8 * c) = o; }
    asm volatile("s_waitcnt lgkmcnt(0)" ::: "memory");
    __builtin_amdgcn_wave_barrier();
}
__device__ __forceinline__ void transpose_item_f8(const float* W, int K, int N, unsigned char* WT, int k0, int n0, int drow0, float scale, float* scr, int lane) {
    const int lr = lane >> 3, lc4 = (lane & 7) * 4;
    f32x4 v[8];
#pragma unroll
    for (int i = 0; i < 8; ++i) v[i] = *(const f32x4*)(W + (size_t)(k0 + 8 * i + lr) * N + n0 + lc4);
#pragma unroll
    for (int i = 0; i < 8; ++i) { float* d = scr + (8 * i + lr) * 33 + lc4; d[0] = v[i].x * scale; d[1] = v[i].y * scale; d[2] = v[i].z * scale; d[3] = v[i].w * scale; }
    __builtin_amdgcn_wave_barrier();
    asm volatile("s_waitcnt lgkmcnt(0)" ::: "memory");
    const int c = lane & 7;
#pragma unroll
    for (int j = 0; j < 4; ++j) { const int n = (lane >> 3) + 8 * j; const float* s = scr + (8 * c) * 33 + n;
        *(u32x2*)(WT + (size_t)(drow0 + n) * K + k0 + 8 * c) = pack8_f8((f32x4){s[0 * 33], s[1 * 33], s[2 * 33], s[3 * 33]}, (f32x4){s[4 * 33], s[5 * 33], s[6 * 33], s[7 * 33]}); }
    asm volatile("s_waitcnt lgkmcnt(0)" ::: "memory");
    __builtin_amdgcn_wave_barrier();
}
constexpr float W_F8_SCALE = 256.0f, ACT_F8_SCALE = 4.0f;
constexpr int IT_WIN = 16 * 224, IT_SQ = 16 * 32, IT_W1 = 32 * 16 * 64, IT_W2 = 32 * 16 * 32, IT_WS = 32;
constexpr int IT_TOTAL = IT_WIN + 3 * IT_SQ + IT_W1 + IT_W2 + IT_WS, IT_EXP0 = IT_WIN + 3 * IT_SQ;
__device__ __forceinline__ void convert_item(const P& p, int it, float* scr, int lane) {
    unsigned char* ws = p.ws;
    if (it < IT_WIN) { const int kb = it / 224, nb = it % 224; transpose_item(p.w_in, 1024, INW, (bf16_t*)(ws + WS_WIN), kb * 64, nb * 32, nb * 32, scr, lane); return; } it -= IT_WIN;
    if (it < IT_SQ) { const int kb = it / 32, nb = it % 32; transpose_item(p.w_pa, 1024, 1024, (bf16_t*)(ws + WS_WPA), kb * 64, nb * 32, nb * 32, scr, lane); return; } it -= IT_SQ;
    if (it < IT_SQ) { const int kb = it / 32, nb = it % 32; transpose_item(p.w_pb, 1024, 1024, (bf16_t*)(ws + WS_WPB), kb * 64, nb * 32, nb * 32, scr, lane); return; } it -= IT_SQ;
    if (it < IT_SQ) { const int kb = it / 32, nb = it % 32; transpose_item(p.w_out, 1024, 1024, (bf16_t*)(ws + WS_WOUT), kb * 64, nb * 32, nb * 32, scr, lane); return; } it -= IT_SQ;
    if (it < IT_W1) { const int e = it / 1024, r = it % 1024, kb = r / 64, nb = r % 64, n0 = nb * 32;
        const int half = n0 >> 10, nn = n0 & 1023, drow0 = (nn >> 7) * 256 + half * 128 + (nn & 127);
        transpose_item_f8(p.exp_w1 + (size_t)e * 1024 * 2048, 1024, 2048, ws + WS_W1 + (size_t)e * 2048 * 1024, kb * 64, n0, drow0, W_F8_SCALE, scr, lane); return; } it -= IT_W1;
    if (it < IT_W2) { const int e = it / 512, r = it % 512, kb = r / 32, nb = r % 32;
        transpose_item_f8(p.exp_w2 + (size_t)e * 1024 * 1024, 1024, 1024, ws + WS_W2 + (size_t)e * 1024 * 1024, kb * 64, nb * 32, nb * 32, W_F8_SCALE, scr, lane); return; } it -= IT_W2;
    { bf16_t* o = (bf16_t*)(ws + WS_WSB); const float* s = p.gmlp_ws + it * 4096;
      for (int i = lane; i < 4096; i += 64) o[it * 4096 + i] = (bf16_t)f2bf(s[i]); }
}
__device__ __forceinline__ void phase_prologue_a(const P& p, int bid, int nblk, unsigned char* lds) {
    const int tid = tid_opaque(), wave = tid >> 6, lane = tid & 63;
    for (int item = bid; item < 192; item += nblk) mod_item(p, item, (float*)lds);
    if (bid == nblk - 1) {
        for (int i = tid; i < 1024; i += 512) { const int pos = i >> 4, fi = i & 15;
            const float inv = __builtin_amdgcn_exp2f(-(float)fi * (13.287712379549449f / 16.0f));
            const float ang = (float)pos * inv; const float rev = ang * 0.15915494309189535f;
            float* t = (float*)(p.ws + WS_ROPE); t[2 * i] = __builtin_amdgcn_cosf(rev); t[2 * i + 1] = __builtin_amdgcn_sinf(rev); }
    }
    __syncthreads();
    float* scr = (float*)lds + wave * (64 * 33 + 32);
    const int gw = bid * 8 + wave, ngw = nblk * 8;
    for (int it = gw; it < IT_TOTAL - (IT_W1 + IT_W2); it += ngw) convert_item(p, it < IT_EXP0 ? it : it + (IT_W1 + IT_W2), scr, lane);
}
__device__ __forceinline__ void ln_mod_row(const float* xrow, const float* g, const float* b, const float* sh, const float* sc, bf16_t* orow, float* stat, int lane) {
    const f32x4* xr = (const f32x4*)xrow + lane;
    f32x4 v[4]; float s = 0.f;
#pragma unroll
    for (int j = 0; j < 4; ++j) { v[j] = xr[64 * j]; s += (v[j].x + v[j].y) + (v[j].z + v[j].w); }
    const float mean = wave_sum(s) * (1.f / DM); float s2 = 0.f;
#pragma unroll
    for (int j = 0; j < 4; ++j) { v[j] = v[j] - mean; s2 += (v[j].x * v[j].x + v[j].y * v[j].y) + (v[j].z * v[j].z + v[j].w * v[j].w); }
    const float rstd = 1.f / sqrtf(wave_sum(s2) * (1.f / DM) + LN_EPS);
    if (stat && lane == 0) { stat[0] = mean; stat[1] = rstd; }
    u32x2* o8 = (u32x2*)orow + lane;
#pragma unroll
    for (int j = 0; j < 4; ++j) { const int col = 4 * lane + 256 * j;
        const f32x4 gg = *(const f32x4*)(g + col), bb = *(const f32x4*)(b + col), shv = *(const f32x4*)(sh + col), scv = *(const f32x4*)(sc + col);
        f32x4 y = (v[j] * rstd) * gg + bb; y = y * (1.0f + scv) + shv;
        u32x2 w; w.x = pk2(y.x, y.y); w.y = pk2(y.z, y.w); o8[64 * j] = w; }
}
__device__ __forceinline__ void phase_prologue_b(const P& p, int bid, int nblk) {
    const int tid = tid_opaque(), wave = tid >> 6, lane = tid & 63;
    const int gw = bid * 8 + wave, ngw = nblk * 8;
    const float* mod = (const float*)(p.ws + WS_MOD);
    for (int row = gw; row < NTOK + NCTX; row += ngw) {
        if (row < NTOK) { const int b = row >> 12;
            ln_mod_row(p.x + (size_t)row * DM, p.ln_x_g, p.ln_x_b, mod + b * 6144, mod + b * 6144 + 1024, (bf16_t*)(p.ws + WS_U) + (size_t)row * DM, (float*)(p.ws + WS_ROWSTAT) + 2 * row, lane);
        } else { const int r = row - NTOK;
            ln_mod_row(p.ctx + (size_t)r * DM, p.ln_ctx_g, p.ln_ctx_b, mod + 8 * 6144, mod + 8 * 6144 + 1024, (bf16_t*)(p.ws + WS_UC) + (size_t)r * DM, nullptr, lane); }
    }
}

template <class ARow, class BRow, class Epi>
__device__ __forceinline__ void sgemm_wave_tile(int r0, int n0, int K, const ARow& arow, const BRow& brow, const Epi& epi, int lane) {
    const int fr = lane & 15, fq = lane >> 4;
    f32x4 acc[2][2];
#pragma unroll
    for (int a = 0; a < 2; ++a)
#pragma unroll
        for (int b = 0; b < 2; ++b) acc[a][b] = (f32x4){0.f, 0.f, 0.f, 0.f};
    const bf16_t* ap[2]; const bf16_t* bp[2];
#pragma unroll
    for (int a = 0; a < 2; ++a) { ap[a] = arow(r0 + 16 * a + fr) + 8 * fq; bp[a] = brow(n0 + 16 * a + fr) + 8 * fq; }
    for (int k0 = 0; k0 < K; k0 += 32) {
        bf16x8 af[2], bfr[2];
#pragma unroll
        for (int a = 0; a < 2; ++a) { af[a] = *(const bf16x8*)(ap[a] + k0); bfr[a] = *(const bf16x8*)(bp[a] + k0); }
#pragma unroll
        for (int a = 0; a < 2; ++a)
#pragma unroll
            for (int b = 0; b < 2; ++b) acc[a][b] = __builtin_amdgcn_mfma_f32_16x16x32_bf16(af[a], bfr[b], acc[a][b], 0, 0, 0);
    }
#pragma unroll
    for (int a = 0; a < 2; ++a)
#pragma unroll
        for (int b = 0; b < 2; ++b)
#pragma unroll
            for (int i = 0; i < 4; ++i) epi(r0 + 16 * a + 4 * fq + i, n0 + 16 * b + fr, acc[a][b][i]);
}

struct ARowDense { const bf16_t* A; int lda; __device__ __forceinline__ const bf16_t* operator()(int r) const { return A + (size_t)r * lda; } };
struct EpiProj {
    const float* b_in; bf16_t *ZU, *ZVT, *Q, *K, *VT, *G;
    __device__ __forceinline__ void operator()(int r, int n, float v) const {
        v += b_in[n];
        if (n < 1024) ZU[(size_t)r * 1024 + n] = (bf16_t)f2bf(gelu_exact(v));
        else if (n < 2048) ZVT[(size_t)(n - 1024) * NTOK + r] = (bf16_t)f2bf(gelu_exact(v));
        else if (n < 3072) Q[(size_t)r * 1024 + (n - 2048)] = (bf16_t)f2bf(v);
        else if (n < 4096) K[(size_t)r * 1024 + (n - 3072)] = (bf16_t)f2bf(v);
        else if (n < 5120) VT[(size_t)(n - 4096) * NTOK + r] = (bf16_t)f2bf(v);
        else G[(size_t)r * 2048 + (n - 5120)] = (bf16_t)f2bf(sigmoidf_(v));
    }
};
__device__ __forceinline__ void phase_proj_s(const P& p, int bid, int nblk) {
    const int tid_ = tid_opaque(); const int wave = tid_ >> 6, lane = tid_ & 63; unsigned char* ws = p.ws;
    ARowDense ar{(const bf16_t*)(ws + WS_U), 1024}, br{(const bf16_t*)(ws + WS_WIN), 1024};
    EpiProj e{p.b_in, (bf16_t*)(ws + WS_ZU), (bf16_t*)(ws + WS_ZVT), (bf16_t*)(ws + WS_Q), (bf16_t*)(ws + WS_K), (bf16_t*)(ws + WS_VT), (bf16_t*)(ws + WS_G)};
    const int ntn = INW / 32, ntiles = (NTOK / 32) * ntn;
    for (int t = bid * 8 + wave; t < ntiles; t += nblk * 8) sgemm_wave_tile((t / ntn) * 32, (t % ntn) * 32, 1024, ar, br, e, lane);
}
struct EpiCtxKV {
    const float* b_in; bf16_t *KC, *VCT;
    __device__ __forceinline__ void operator()(int r, int n, float v) const {
        v += b_in[3072 + n];
        if (n < 1024) KC[(size_t)r * 1024 + n] = (bf16_t)f2bf(v); else VCT[(size_t)(n - 1024) * NCTX + r] = (bf16_t)f2bf(v);
    }
};
__device__ __forceinline__ void phase_ctxkv_s(const P& p, int bid, int nblk) {
    const int tid_ = tid_opaque(); const int wave = tid_ >> 6, lane = tid_ & 63; unsigned char* ws = p.ws;
    ARowDense ar{(const bf16_t*)(ws + WS_UC), 1024}, br{(const bf16_t*)(ws + WS_WIN) + (size_t)3072 * 1024, 1024};
    EpiCtxKV e{p.b_in, (bf16_t*)(ws + WS_KC), (bf16_t*)(ws + WS_VCT)};
    const int ntn = 2048 / 32, ntiles = (NCTX / 32) * ntn;
    for (int t = bid * 8 + wave; t < ntiles; t += nblk * 8) sgemm_wave_tile((t / ntn) * 32, (t % ntn) * 32, 1024, ar, br, e, lane);
}
__device__ __forceinline__ void phase_rope_s(const P& p, int bid, int nblk) {
    bf16_t* K = (bf16_t*)(p.ws + WS_K); const float* tab = (const float*)(p.ws + WS_ROPE);
    const size_t total = (size_t)NTOK * NHEAD * 32;
    const int tid_ = tid_opaque();
    for (size_t i = (size_t)bid * 512 + tid_; i < total; i += (size_t)nblk * 512) {
        const int pi = (int)(i & 31), h = (int)((i >> 5) & 15), t = (int)(i >> 9);
        const int pos = t & 4095, axis = pi >> 4, fi = pi & 15, ps = axis ? (pos & 63) : (pos >> 6);
        const float cs = tab[2 * (ps * 16 + fi)], sn = tab[2 * (ps * 16 + fi) + 1];
        bf16_t* base = K + (size_t)t * 1024 + h * 64 + axis * 32 + fi;
        const float x1 = bf2f(base[0]), x2 = bf2f(base[16]);
        base[0] = (bf16_t)f2bf(x1 * cs - x2 * sn); base[16] = (bf16_t)f2bf(x2 * cs + x1 * sn);
    }
}
__device__ __forceinline__ void phase_zstat_s(const P& p, int bid, int nblk) {
    const bf16_t* ZVT = (const bf16_t*)(p.ws + WS_ZVT); float* zs = (float*)(p.ws + WS_ZSTAT);
    const int tid_ = tid_opaque();
    for (int t = bid * 512 + tid_; t < NTOK; t += nblk * 512) {
        float s = 0.f, s2 = 0.f;
        for (int c = 0; c < 1024; ++c) { const float v = bf2f(ZVT[(size_t)c * NTOK + t]); s += v; s2 += v * v; }
        const float mean = s * (1.f / 1024.f); const float var = fmaxf(s2 * (1.f / 1024.f) - mean * mean, 0.f);
        zs[2 * t] = mean; zs[2 * t + 1] = 1.f / sqrtf(var + LN_EPS);
    }
}
__device__ __forceinline__ void phase_gmlp_s(const P& p, int bid, int nblk, unsigned char* lds) {
    float* zvn = (float*)lds;
    float* wsm = zvn + 128 * 128;
    const bf16_t* ZVT = (const bf16_t*)(p.ws + WS_ZVT); const bf16_t* ZU = (const bf16_t*)(p.ws + WS_ZU); const float* zs = (const float*)(p.ws + WS_ZSTAT);
    bf16_t* YA = (bf16_t*)(p.ws + WS_U);
    const int tid = tid_opaque();
    for (int item = bid; item < (NTOK / 128) * 8; item += nblk) {
        const int chunk = item >> 3, g = item & 7, tok0 = chunk * 128;
        __syncthreads();
        for (int i = tid; i < 128 * 128; i += 512) { const int c = i >> 7, q = i & 127; const int ch = g * 128 + c;
            const float v = bf2f(ZVT[(size_t)ch * NTOK + tok0 + q]);
            zvn[q * 128 + c] = (v - zs[2 * (tok0 + q)]) * zs[2 * (tok0 + q) + 1] * p.gmlp_ln_g[ch] + p.gmlp_ln_b[ch];
            wsm[i] = p.gmlp_ws[g * 16384 + i]; }
        __syncthreads();
        const int c = tid & 127, pq = tid >> 7;
        for (int pp = 0; pp < 32; ++pp) { const int pr = pq * 32 + pp; float acc = 0.f;
            for (int q = 0; q < 128; ++q) acc += wsm[pr * 128 + q] * zvn[q * 128 + c];
            acc += p.gmlp_bs[g * 128 + pr];
            const size_t o = (size_t)(tok0 + pr) * 1024 + g * 128 + c;
            YA[o] = (bf16_t)f2bf(bf2f(ZU[o]) * acc); }
    }
}
__device__ __forceinline__ bf16x8 pack8(const float (&v)[8]) { u32x4 w; w.x = pk2(v[0], v[1]); w.y = pk2(v[2], v[3]); w.z = pk2(v[4], v[5]); w.w = pk2(v[6], v[7]); return __builtin_bit_cast(bf16x8, w); }
__device__ __forceinline__ void phase_gmlp_fast(const P& p, int bid, int nblk, unsigned char* lds) {
    const int tid = tid_opaque(), g = tid >> 6, lane = tid & 63, fr = lane & 15, fq = lane >> 4;
    float* part = (float*)lds;
    float* stat = part + 8 * 128 * 2;
    const bf16_t* ZVT = (const bf16_t*)(p.ws + WS_ZVT); const bf16_t* ZU = (const bf16_t*)(p.ws + WS_ZU); const bf16_t* WSB = (const bf16_t*)(p.ws + WS_WSB);
    bf16_t* YA = (bf16_t*)(p.ws + WS_U);
    for (int chunk = bid; chunk < NTOK / 128; chunk += nblk) {
        const int tok0 = chunk * 128;
        __syncthreads();
        { float s1[8], s2[8];
#pragma unroll
          for (int jj = 0; jj < 8; ++jj) { s1[jj] = 0.f; s2[jj] = 0.f; }
          const bf16_t* zp = ZVT + (((size_t)(tok0 >> 3) + fr) * 1024 + 128 * g + fq) * 8;
#pragma unroll 8
          for (int it = 0; it < 32; ++it) { const bf16x8 v = *(const bf16x8*)(zp + (4 * it) * 8);
#pragma unroll
              for (int jj = 0; jj < 8; ++jj) { const float f = bf2f((unsigned)(unsigned short)v[jj]); s1[jj] += f; s2[jj] += f * f; } }
#pragma unroll
          for (int jj = 0; jj < 8; ++jj) { s1[jj] += __shfl_xor(s1[jj], 16); s1[jj] += __shfl_xor(s1[jj], 32); s2[jj] += __shfl_xor(s2[jj], 16); s2[jj] += __shfl_xor(s2[jj], 32); }
          if (fq == 0) {
#pragma unroll
              for (int jj = 0; jj < 8; ++jj) { part[(g * 128 + 8 * fr + jj) * 2] = s1[jj]; part[(g * 128 + 8 * fr + jj) * 2 + 1] = s2[jj]; } } }
        __syncthreads();
        if (tid < 128) { float a = 0.f, b = 0.f;
#pragma unroll
            for (int w = 0; w < 8; ++w) { a += part[(w * 128 + tid) * 2]; b += part[(w * 128 + tid) * 2 + 1]; }
            const float mean = a * (1.f / 1024.f), var = fmaxf(b * (1.f / 1024.f) - mean * mean, 0.f);
            stat[2 * tid] = mean; stat[2 * tid + 1] = 1.f / sqrtf(var + LN_EPS); }
        __syncthreads();
#pragma unroll 1
        for (int ph = 0; ph < 2; ++ph) {
            bf16x8 wf[4][4]; float t1[4], t2[4], bsv[4];
#pragma unroll
            for (int pt = 0; pt < 4; ++pt) { const int pp = 64 * ph + 16 * pt + fr; float t1a = 0.f, t2a = 0.f;
                const __attribute__((address_space(3))) float* stat3 = (const __attribute__((address_space(3))) float*)((const __attribute__((address_space(3))) unsigned char*)lds + 8 * 128 * 2 * 4);
                int so = 16 * fq; asm volatile("" : "+v"(so));
#pragma unroll
                for (int ks = 0; ks < 4; ++ks) { const bf16x8 w = *(const bf16x8*)(WSB + ((size_t)g * 128 + pp) * 128 + 32 * ks + 8 * fq);
                    float wv[8];
#pragma unroll
                    for (int jj = 0; jj < 8; ++jj) { const float w0 = bf2f((unsigned)(unsigned short)w[jj]); t2a += w0; wv[jj] = w0 * stat3[so + 2 * (32 * ks + jj) + 1]; }
                    const bf16x8 wp = pack8(wv); wf[pt][ks] = wp;
#pragma unroll
                    for (int jj = 0; jj < 8; ++jj) t1a += bf2f((unsigned)(unsigned short)wp[jj]) * stat3[so + 2 * (32 * ks + jj)]; }
                t1a += __shfl_xor(t1a, 16); t1a += __shfl_xor(t1a, 32); t2a += __shfl_xor(t2a, 16); t2a += __shfl_xor(t2a, 32);
                t1[pt] = t1a; t2[pt] = t2a; bsv[pt] = p.gmlp_bs[g * 128 + pp]; }
            bf16x8 afn[4];
            { const bf16_t* zp = ZVT + (((size_t)(tok0 >> 3) + fq) * 1024 + 128 * g + fr) * 8;
#pragma unroll
              for (int ks = 0; ks < 4; ++ks) afn[ks] = *(const bf16x8*)(zp + (size_t)ks * 4 * 1024 * 8); }
#pragma unroll 1
            for (int ct = 0; ct < 8; ++ct) {
                bf16x8 af[4];
#pragma unroll
                for (int ks = 0; ks < 4; ++ks) af[ks] = afn[ks];
                if (ct + 1 < 8) { const bf16_t* zp = ZVT + (((size_t)(tok0 >> 3) + fq) * 1024 + 128 * g + 16 * (ct + 1) + fr) * 8;
#pragma unroll
                    for (int ks = 0; ks < 4; ++ks) afn[ks] = *(const bf16x8*)(zp + (size_t)ks * 4 * 1024 * 8); }
                const int c = 128 * g + 16 * ct + 4 * fq;
                u32x2 zuv[4];
#pragma unroll
                for (int pt = 0; pt < 4; ++pt) zuv[pt] = *(const u32x2*)(ZU + (size_t)(tok0 + 64 * ph + 16 * pt + fr) * 1024 + c);
                f32x4 acc[4];
#pragma unroll
                for (int pt = 0; pt < 4; ++pt) { acc[pt] = (f32x4){0.f, 0.f, 0.f, 0.f};
#pragma unroll
                    for (int ks = 0; ks < 4; ++ks) acc[pt] = __builtin_amdgcn_mfma_f32_16x16x32_bf16(af[ks], wf[pt][ks], acc[pt], 0, 0, 0); }
                const f32x4 gc = *(const f32x4*)(p.gmlp_ln_g + c), bc = *(const f32x4*)(p.gmlp_ln_b + c);
#pragma unroll
                for (int pt = 0; pt < 4; ++pt) { const size_t off = (size_t)(tok0 + 64 * ph + 16 * pt + fr) * 1024 + c;
                    const u32x2 zu = zuv[pt];
                    const f32x4 s = gc * (acc[pt] - t1[pt]) + bc * t2[pt] + bsv[pt];
                    u32x2 w; w.x = pk2(bflo(zu.x) * s[0], bfhi(zu.x) * s[1]); w.y = pk2(bflo(zu.y) * s[2], bfhi(zu.y) * s[3]);
                    *(u32x2*)(YA + off) = w; }
            }
        }
    }
}
constexpr int AT_LDS_RPB = 0, AT_LDS_KC = 4096, AT_LDS_VC = AT_LDS_KC + 32768, AT_LDS_END = AT_LDS_VC + 32768;
typedef __attribute__((address_space(3))) const unsigned char* lds_cp;
__device__ __forceinline__ void attn_stage(const P& p, unsigned char* lds, int b, int h, int tid) {
    float* tbl = (float*)(lds + AT_LDS_RPB);
    for (int idx = tid; idx < 15 * 64; idx += 512) { const int dr = idx >> 6, cc = idx & 63; tbl[idx] = (cc >= 16 && cc < 47) ? p.na_rpb[(h * 15 + dr) * 31 + cc - 16] : 0.f; }
    const size_t bh = (size_t)b * 16 + h;
    const u32x4* kc = (const u32x4*)((const bf16_t*)(p.ws + WS_KC) + bh * 256 * 64); const u32x4* vc = (const u32x4*)((const bf16_t*)(p.ws + WS_VCT) + bh * 32 * 512);
#pragma unroll
    for (int i = 0; i < 4; ++i) { const int q = tid + 512 * i, key = q >> 3, c = q & 7; const int fk = ((key >> 1) & 1) | (((key >> 3) & 1) << 1) | (((key >> 4) & 1) << 2);
        *(u32x4*)(lds + AT_LDS_KC + key * 128 + ((c ^ fk) << 4)) = kc[q]; *(u32x4*)(lds + AT_LDS_VC + q * 16) = vc[q]; }
}
__device__ __forceinline__ void attn_wave_unit(const P& p, unsigned char* lds, int b, int r, int j, int h, int lane) {
    const int fr = lane & 15, fq = lane >> 4;
    const bf16_t* Q = (const bf16_t*)(p.ws + WS_Q); const bf16_t* K = (const bf16_t*)(p.ws + WS_K); const bf16_t* VT = (const bf16_t*)(p.ws + WS_VT);
    const float* tab = (const float*)(p.ws + WS_ROPE);
    bf16_t* YB = (bf16_t*)(p.ws + WS_YB);
    const int qc = 16 * j + fr; const size_t tq = (size_t)b * SEQ + r * 64 + qc; const size_t bh = (size_t)b * 16 + h;
    const int r0 = min(max(r - 4, 0), 56), c0 = min(max(qc - 8, 0), 48), cs = min(max(16 * j - 8, 0), 32);
    const int sp0 = 8 * (fr >> 2) + (fr & 3);
    const bf16_t* klat = K + (bh * 4096 + r0 * 64 + cs + sp0) * 64 + 8 * fq;
    const bf16_t* vlat = VT + ((bh * 512 + ((r0 * 64 + cs) >> 3) + fq) * 64 + fr) * 8;
    const int fk = ((fr >> 1) & 1) | (((fr >> 2) & 1) << 1) | (((fr >> 3) & 1) << 2);
    const lds_cp kcl = (lds_cp)lds + AT_LDS_KC + sp0 * 128;
    const int kco0 = (fq ^ fk) << 4, kco1 = ((fq + 4) ^ fk) << 4;
    const lds_cp vcl = (lds_cp)lds + AT_LDS_VC + (fq * 64 + fr) * 16;
    bf16x8 kf[2][2][2];
#define LOADK(buf, st_) do { _Pragma("unroll") for (int t = 0; t < 2; ++t) { \
        const bf16_t* kp_ = klat + (size_t)(st_) * 64 * 64 + t * 4 * 64; kf[buf][t][0] = *(const bf16x8*)kp_; kf[buf][t][1] = *(const bf16x8*)(kp_ + 32); } } while (0)
#define LOADKC(buf, st_) do { _Pragma("unroll") for (int t = 0; t < 2; ++t) { \
        const lds_cp kp_ = kcl + (32 * (st_) + 4 * t) * 128; kf[buf][t][0] = *(const __attribute__((address_space(3))) bf16x8*)(kp_ + kco0); kf[buf][t][1] = *(const __attribute__((address_space(3))) bf16x8*)(kp_ + kco1); } } while (0)
    LOADK(0, 0); LOADK(1, 1);
    bf16x8 qpl[2], qrt[2];
#pragma unroll
    for (int s = 0; s < 2; ++s) {
        const bf16_t* qb = Q + (bh * 4096 + r * 64 + qc) * 64 + 32 * s;
        const bf16x8 me = *(const bf16x8*)(qb + 8 * fq), ot = *(const bf16x8*)(qb + 8 * (fq ^ 2));
        qpl[s] = me;
        const int pos = s ? qc : r; const float* tb = tab + (pos * 16 + 8 * (fq & 1)) * 2;
        float rot[8];
#pragma unroll
        for (int jj = 0; jj < 8; ++jj) { const float cv = tb[2 * jj], sv = tb[2 * jj + 1];
            const float xv = bf2f((unsigned)(unsigned short)me[jj]), ov = bf2f((unsigned)(unsigned short)ot[jj]);
            rot[jj] = (fq < 2) ? (xv * cv - ov * sv) : (xv * cv + ov * sv); }
        qrt[s] = pack8(rot);
    }
    float sc[8][8];
    const __attribute__((address_space(3))) float* tbl3 = (const __attribute__((address_space(3))) float*)((lds_cp)lds + AT_LDS_RPB);
    const int boff0 = (r0 - r + 7) * 64 + (cs + 8 * fq - qc + 31);
#pragma unroll
    for (int st = 0; st < 8; ++st) {
        int boff = boff0 + st * 64; asm volatile("" : "+v"(boff));
#pragma unroll
        for (int t = 0; t < 2; ++t) {
            f32x4 d = __builtin_amdgcn_mfma_f32_16x16x32_bf16(kf[st & 1][t][0], qrt[0], (f32x4){0.f, 0.f, 0.f, 0.f}, 0, 0, 0);
            d = __builtin_amdgcn_mfma_f32_16x16x32_bf16(kf[st & 1][t][1], qrt[1], d, 0, 0, 0);
#pragma unroll
            for (int i = 0; i < 4; ++i) { const int kc = cs + 8 * fq + 4 * t + i; const bool valid = (kc >= c0) && (kc < c0 + 16);
                const float bias = tbl3[boff + 4 * t + i];
                sc[st][4 * t + i] = valid ? (d[i] * 0.125f + bias) : -INFINITY; } }
        if (st + 2 < 8) LOADK(st & 1, st + 2);
    }
    bf16x8 vf[2][4];
#define LOADV(buf, st_) do { _Pragma("unroll") for (int dt = 0; dt < 4; ++dt) vf[buf][dt] = *(const bf16x8*)(vlat + dt * 128 + (st_) * 8 * 512); } while (0)
#define LOADVC(buf, st_) do { _Pragma("unroll") for (int dt = 0; dt < 4; ++dt) vf[buf][dt] = *(const __attribute__((address_space(3))) bf16x8*)(vcl + (st_) * 4096 + dt * 256); } while (0)
    LOADV(0, 0); LOADV(1, 1);
    float m = -INFINITY;
#pragma unroll
    for (int st = 0; st < 8; ++st)
#pragma unroll
        for (int e = 0; e < 8; ++e) m = fmaxf(m, sc[st][e]);
    m = fmaxf(m, __shfl_xor(m, 16)); m = fmaxf(m, __shfl_xor(m, 32));
    float l = 0.f; f32x4 o[4];
#pragma unroll
    for (int dt = 0; dt < 4; ++dt) o[dt] = (f32x4){0.f, 0.f, 0.f, 0.f};
    const float ml2 = m * 1.4426950408889634f;
#pragma unroll
    for (int st = 0; st < 8; ++st) {
        float pv[8];
#pragma unroll
        for (int e = 0; e < 8; ++e) { pv[e] = __builtin_amdgcn_exp2f(sc[st][e] * 1.4426950408889634f - ml2); l += pv[e]; }
        const bf16x8 pf = pack8(pv);
#pragma unroll
        for (int dt = 0; dt < 4; ++dt) o[dt] = __builtin_amdgcn_mfma_f32_16x16x32_bf16(vf[st & 1][dt], pf, o[dt], 0, 0, 0);
        if (st + 2 < 8) LOADV(st & 1, st + 2);
    }
    LOADKC(0, 0);
#pragma unroll
    for (int st = 0; st < 8; ++st) {
        if (st + 1 < 8) LOADKC((st + 1) & 1, st + 1);
#pragma unroll
        for (int t = 0; t < 2; ++t) {
            f32x4 d = __builtin_amdgcn_mfma_f32_16x16x32_bf16(kf[st & 1][t][0], qpl[0], (f32x4){0.f, 0.f, 0.f, 0.f}, 0, 0, 0);
            d = __builtin_amdgcn_mfma_f32_16x16x32_bf16(kf[st & 1][t][1], qpl[1], d, 0, 0, 0);
#pragma unroll
            for (int i = 0; i < 4; ++i) sc[st][4 * t + i] = d[i] * 0.125f; }
    }
    float m2 = -INFINITY;
#pragma unroll
    for (int st = 0; st < 8; ++st)
#pragma unroll
        for (int e = 0; e < 8; ++e) m2 = fmaxf(m2, sc[st][e]);
    m2 = fmaxf(m2, __shfl_xor(m2, 16)); m2 = fmaxf(m2, __shfl_xor(m2, 32));
    const float mn = fmaxf(m, m2), al = __builtin_amdgcn_exp2f((m - mn) * 1.4426950408889634f), mnl2 = mn * 1.4426950408889634f;
    l *= al;
#pragma unroll
    for (int dt = 0; dt < 4; ++dt) o[dt] = o[dt] * al;
    LOADVC(0, 0);
#pragma unroll
    for (int st = 0; st < 8; ++st) {
        if (st + 1 < 8) LOADVC((st + 1) & 1, st + 1);
        float pv[8];
#pragma unroll
        for (int e = 0; e < 8; ++e) { pv[e] = __builtin_amdgcn_exp2f(sc[st][e] * 1.4426950408889634f - mnl2); l += pv[e]; }
        const bf16x8 pf = pack8(pv);
#pragma unroll
        for (int dt = 0; dt < 4; ++dt) o[dt] = __builtin_amdgcn_mfma_f32_16x16x32_bf16(vf[st & 1][dt], pf, o[dt], 0, 0, 0);
    }
#undef LOADK
#undef LOADKC
#undef LOADV
#undef LOADVC
    l += __shfl_xor(l, 16); l += __shfl_xor(l, 32);
    const float inv = 1.0f / l;
#pragma unroll
    for (int dt = 0; dt < 4; ++dt) { u32x2 w; w.x = pk2(o[dt][0] * inv, o[dt][1] * inv); w.y = pk2(o[dt][2] * inv, o[dt][3] * inv);
        *(u32x2*)(YB + tq * 1024 + h * 64 + 16 * dt + 4 * fq) = w; }
}
__device__ __forceinline__ void phase_attn_s(const P& p, int bid, int nblk, unsigned char* lds) {
    const int tid_ = tid_opaque(); const int wave = tid_ >> 6, lane = tid_ & 63;
    float* cscr = (float*)(lds + AT_LDS_END) + wave * (64 * 33 + 32);
    for (int vb = bid; vb < 256; vb += nblk) { const int half = vb & 1, h = (vb >> 1) & 15, b = vb >> 5;
        __syncthreads();
        attn_stage(p, lds, b, h, tid_);
        __syncthreads();
#pragma unroll 1
        for (int it = 0; it < 16; ++it) { int lane_o = lane; asm volatile("" : "+v"(lane_o));
            attn_wave_unit(p, lds, b, 32 * half + 2 * it + (wave >> 2), wave & 3, h, lane_o);
            const int gw = vb * 8 + wave;
            for (int k = it; k * 2048 + gw < IT_W1 + IT_W2; k += 16) convert_item(p, IT_EXP0 + k * 2048 + gw, cscr, lane_o); }
    }
}
struct EpiMergeA { const bf16_t* G; bf16_t* INNER;
    __device__ __forceinline__ void operator()(int r, int n, float v) const { INNER[(size_t)r * 1024 + n] = (bf16_t)f2bf(bf2f(G[(size_t)r * 2048 + n]) * v); } };
struct EpiMergeB { const bf16_t* G; bf16_t* INNER;
    __device__ __forceinline__ void operator()(int r, int n, float v) const { const size_t o = (size_t)r * 1024 + n; INNER[o] = (bf16_t)f2bf(bf2f(INNER[o]) + bf2f(G[(size_t)r * 2048 + 1024 + n]) * v); } };
template <int WHICH> __device__ __forceinline__ void phase_merge_s(const P& p, int bid, int nblk) {
    const int tid_ = tid_opaque(); const int wave = tid_ >> 6, lane = tid_ & 63; unsigned char* ws = p.ws;
    const int ntn = 1024 / 32, ntiles = (NTOK / 32) * ntn;
    if (WHICH == 0) { ARowDense ar{(const bf16_t*)(ws + WS_U), 1024}, br{(const bf16_t*)(ws + WS_WPA), 1024}; EpiMergeA e{(const bf16_t*)(ws + WS_G), (bf16_t*)(ws + WS_INNER)};
        for (int t = bid * 8 + wave; t < ntiles; t += nblk * 8) sgemm_wave_tile((t / ntn) * 32, (t % ntn) * 32, 1024, ar, br, e, lane);
    } else { ARowDense ar{(const bf16_t*)(ws + WS_YB), 1024}, br{(const bf16_t*)(ws + WS_WPB), 1024}; EpiMergeB e{(const bf16_t*)(ws + WS_G), (bf16_t*)(ws + WS_INNER)};
        for (int t = bid * 8 + wave; t < ntiles; t += nblk * 8) sgemm_wave_tile((t / ntn) * 32, (t % ntn) * 32, 1024, ar, br, e, lane); }
}
struct EpiMix { const float *x, *rowstat, *lng, *lnb, *mod, *b_out; float* out;
    __device__ __forceinline__ void operator()(int r, int n, float v) const {
        const int b = r >> 12; const float x0 = (x[(size_t)r * 1024 + n] - rowstat[2 * r]) * rowstat[2 * r + 1] * lng[n] + lnb[n];
        out[(size_t)r * 1024 + n] = ALPHA * x0 + mod[b * 6144 + 2048 + n] * (v + b_out[n]); } };
__device__ __forceinline__ void phase_mix_s(const P& p, int bid, int nblk) {
    const int tid_ = tid_opaque(); const int wave = tid_ >> 6, lane = tid_ & 63; unsigned char* ws = p.ws;
    const int ntn = 1024 / 32, ntiles = (NTOK / 32) * ntn;
    ARowDense ar{(const bf16_t*)(ws + WS_INNER), 1024}, br{(const bf16_t*)(ws + WS_WOUT), 1024};
    EpiMix e{p.x, (const float*)(ws + WS_ROWSTAT), p.ln_x_g, p.ln_x_b, (const float*)(ws + WS_MOD), p.b_out, p.out};
    for (int t = bid * 8 + wave; t < ntiles; t += nblk * 8) sgemm_wave_tile((t / ntn) * 32, (t % ntn) * 32, 1024, ar, br, e, lane);
}

constexpr int RT_LDS_W = 0, RT_LDS_CNT = 131072, RT_LDS_BASE = RT_LDS_CNT + 128, RT_LDS_REC = RT_LDS_BASE + 128, RT_MAXIT = 32, RT_LDS_END = RT_LDS_REC + 8 * RT_MAXIT * 8 * 4;
__device__ __forceinline__ int rw_off(int prow, int ch) { return prow * 128 + ((ch ^ ((prow >> 1) & 7)) << 4); }
__device__ __forceinline__ void phase_router(const P& p, int bid, int nblk, unsigned char* lds) {
    const int tid = tid_opaque(), wave = tid >> 6, lane = tid & 63;
    int* cnt = (int*)(lds + RT_LDS_CNT); int* base = (int*)(lds + RT_LDS_BASE); int* rec = (int*)(lds + RT_LDS_REC) + wave * RT_MAXIT * 8;
    for (int k = tid; k < 1024; k += 512) { const int l = (k & 255) >> 2, i = k & 3, j = k >> 8, prow = l + 64 * (4 * j + i);
        const f32x4* src = (const f32x4*)(p.router_w + (size_t)k * 32);
#pragma unroll
        for (int ch = 0; ch < 8; ++ch) *(f32x4*)(lds + RT_LDS_W + rw_off(prow, ch)) = src[ch]; }
    if (tid < 32) cnt[tid] = 0;
    __syncthreads();
    const float* mod = (const float*)(p.ws + WS_MOD);
    int* TOPE = (int*)(p.ws + WS_TOPE); float* TOPG = (float*)(p.ws + WS_TOPG); int* SLOT = (int*)(p.ws + WS_SLOT);
    unsigned char* U2 = p.ws + WS_U;
    const int erev = 16 * ((lane >> 4) & 1) + (int)(__builtin_bitreverse32((unsigned)(lane & 15)) >> 28);
    unsigned wb[8];
#pragma unroll
    for (int ch = 0; ch < 8; ++ch) wb[ch] = RT_LDS_W + lane * 128 + ((ch ^ ((lane >> 1) & 7)) << 4);
    int it = 0;
    u32x2 pre[4];
    { const int row0 = bid * 8 + wave; if (row0 < NTOK) { const u32x2* xin0 = (const u32x2*)((const bf16_t*)(p.ws + WS_X1PRE) + (size_t)row0 * DM) + lane;
#pragma unroll
        for (int j = 0; j < 4; ++j) pre[j] = xin0[64 * j]; } }
    for (int row = bid * 8 + wave; row < NTOK; row += nblk * 8, ++it) {
        const int b = row >> 12;
        u32x2* xr = (u32x2*)((bf16_t*)(p.ws + WS_X1) + (size_t)row * DM) + lane;
        f32x4 v[4]; float s = 0.f;
#pragma unroll
        for (int j = 0; j < 4; ++j) { const u32x2 w = pre[j]; v[j] = (f32x4){bflo(w.x), bfhi(w.x), bflo(w.y), bfhi(w.y)}; s += (v[j].x + v[j].y) + (v[j].z + v[j].w); }
        { const int rown = row + nblk * 8; if (rown < NTOK) { const u32x2* xinn = (const u32x2*)((const bf16_t*)(p.ws + WS_X1PRE) + (size_t)rown * DM) + lane;
#pragma unroll
            for (int j = 0; j < 4; ++j) pre[j] = xinn[64 * j]; } }
        const float mean = wave_sum(s) * (1.f / DM); float s2 = 0.f;
#pragma unroll
        for (int j = 0; j < 4; ++j) { v[j] = v[j] - mean; s2 += (v[j].x * v[j].x + v[j].y * v[j].y) + (v[j].z * v[j].z + v[j].w * v[j].w); }
        const float rstd = 1.f / sqrtf(wave_sum(s2) * (1.f / DM) + LN_EPS);
        unsigned* o8 = (unsigned*)(U2 + (size_t)row * DM) + lane;
        int lane_o = lane; asm volatile("" : "+v"(lane_o));
        f32x4 u[4];
#pragma unroll
        for (int j = 0; j < 4; ++j) { const int col = 4 * lane_o + 256 * j;
            const f32x4 gg = *(const f32x4*)(p.ln1_g + col), bb = *(const f32x4*)(p.ln1_b + col);
            const f32x4 shv = *(const f32x4*)(mod + b * 6144 + 3072 + col), scv = *(const f32x4*)(mod + b * 6144 + 4096 + col);
            const f32x4 x1 = (v[j] * rstd) * gg + bb; { u32x2 w; w.x = pk2(x1.x, x1.y); w.y = pk2(x1.z, x1.w); xr[64 * j] = w; }
            u[j] = x1 * (1.0f + scv) + shv;
            int w = 0; w = __builtin_amdgcn_cvt_pk_fp8_f32(u[j].x, u[j].y, w, false); w = __builtin_amdgcn_cvt_pk_fp8_f32(u[j].z, u[j].w, w, true); o8[64 * j] = (unsigned)w; }
        float lg2[2];
#pragma unroll
        for (int hf = 0; hf < 2; ++hf) {
            float a[16];
#pragma unroll
            for (int e = 0; e < 16; ++e) a[e] = 0.f;
#pragma unroll
            for (int j = 0; j < 4; ++j)
#pragma unroll
                for (int i = 0; i < 4; ++i) { const float uv = u[j][i];
#pragma unroll
                    for (int ch = 0; ch < 4; ++ch) { const f32x4 w4 = *(const f32x4*)(lds + wb[4 * hf + ch] + (4 * j + i) * 8192);
                        a[4 * ch + 0] += uv * w4.x; a[4 * ch + 1] += uv * w4.y; a[4 * ch + 2] += uv * w4.z; a[4 * ch + 3] += uv * w4.w; } }
#pragma unroll
            for (int st = 0; st < 4; ++st) { const int n = 8 >> st; const bool up = (lane >> st) & 1;
#pragma unroll
                for (int i = 0; i < n; ++i) { float lo = a[i], hi = a[n + i]; asm volatile("" : "+v"(lo), "+v"(hi));
                    const float keep = up ? hi : lo, send = up ? lo : hi; a[i] = keep + __shfl_xor(send, 1 << st); } }
            float r = a[0]; r += __shfl_xor(r, 16); r += __shfl_xor(r, 32); lg2[hf] = r;
        }
        float logit = ((lane >> 4) & 1) ? lg2[1] : lg2[0];
        logit += p.router_b[erev];
        float cur = logit;
#define TOP_STEP(TV, TE) float TV; int TE; { const float mx = wave_max(cur); int cand = (cur == mx) ? erev : 64; \
            cand = min(cand, __shfl_xor(cand, 1)); cand = min(cand, __shfl_xor(cand, 2)); cand = min(cand, __shfl_xor(cand, 4)); \
            cand = min(cand, __shfl_xor(cand, 8)); cand = min(cand, __shfl_xor(cand, 16)); cand = min(cand, __shfl_xor(cand, 32)); \
            TV = mx; TE = cand; if (erev == cand) cur = -INFINITY; }
        TOP_STEP(tv0, te0) TOP_STEP(tv1, te1) TOP_STEP(tv2, te2) TOP_STEP(tv3, te3)
#undef TOP_STEP
        const float gk0 = 1.0f, gk1 = __expf(tv1 - tv0), gk2 = __expf(tv2 - tv0), gk3 = __expf(tv3 - tv0);
        const float ginv = 1.f / (gk0 + gk1 + gk2 + gk3);
        if (lane < 4) { const int e = lane == 0 ? te0 : lane == 1 ? te1 : lane == 2 ? te2 : te3; const float g = lane == 0 ? gk0 : lane == 1 ? gk1 : lane == 2 ? gk2 : gk3;
            const int pos = atomicAdd(&cnt[e], 1);
            TOPE[row * 4 + lane] = e; TOPG[row * 4 + lane] = g * ginv;
            if (it < RT_MAXIT) { rec[it * 8 + lane * 2] = e; rec[it * 8 + lane * 2 + 1] = pos; } }
    }
    __syncthreads();
    if (tid < 32) base[tid] = atomicAdd((int*)(p.ws + WS_CTL) + tid, cnt[tid]);
    __syncthreads();
    it = 0;
    int* PERM2 = (int*)(p.ws + WS_PERM2);
    for (int row = bid * 8 + wave; row < NTOK; row += nblk * 8, ++it)
        if (lane < 4 && it < RT_MAXIT) { const int e = rec[it * 8 + lane * 2], pos = base[e] + rec[it * 8 + lane * 2 + 1]; SLOT[row * 4 + lane] = pos; PERM2[(size_t)e * NTOK + pos] = row; }
}
constexpr int MT_LDS = 131072 + 1024;
__device__ __forceinline__ void moe_tables(const P& p, unsigned char* lds) {
    const int tid = tid_opaque(); int* cn = (int*)(lds + MT_LDS); int* eb = cn + 32; int* tb = eb + 33;
    __syncthreads();
    if (tid < 32) cn[tid] = __hip_atomic_load((int*)(p.ws + WS_CTL) + tid, __ATOMIC_RELAXED, __HIP_MEMORY_SCOPE_AGENT);
    __syncthreads();
    if (tid == 0) { int s = 0, t = 0; for (int e = 0; e < 32; ++e) { eb[e] = s; tb[e] = t; s += cn[e]; t += (cn[e] + 255) >> 8; } eb[32] = s; tb[32] = t; }
    __syncthreads();
}
struct FinIdx { int e[4]; int pos[4]; float g[4]; };
struct FinData { u32x4 ys[4]; u32x4 x[2]; };
__device__ __forceinline__ void fin_load_idx(const P& p, int row, FinIdx& r) {
    const u32x4 ev = *(const u32x4*)((const int*)(p.ws + WS_TOPE) + row * 4), pv = *(const u32x4*)((const int*)(p.ws + WS_SLOT) + row * 4); const f32x4 gv = *(const f32x4*)((const float*)(p.ws + WS_TOPG) + row * 4);
#pragma unroll
    for (int k = 0; k < 4; ++k) { r.e[k] = (int)ev[k]; r.pos[k] = (int)pv[k]; r.g[k] = gv[k] * (1.0f / YS_F8_SCALE); }
}
__device__ __forceinline__ void fin_load_data(const P& p, const int* eb, int row, const FinIdx& ix, FinData& d, int lane) {
    const unsigned char* YS = p.ws + WS_YS;
#pragma unroll
    for (int k = 0; k < 4; ++k) { const size_t slot = (size_t)(eb[ix.e[k]] + ix.pos[k]); d.ys[k] = *(const u32x4*)(YS + slot * 1024 + 16 * lane); }
    const u32x4* xr = (const u32x4*)((const bf16_t*)(p.ws + WS_X1) + (size_t)row * DM + 16 * lane); d.x[0] = xr[0]; d.x[1] = xr[1];
}
__device__ __forceinline__ void phase_final(const P& p, int bid, int nblk, unsigned char* lds) {
    moe_tables(p, lds); const int* eb = (const int*)(lds + MT_LDS) + 32;
    const int tid = tid_opaque(), wave = tid >> 6, lane = tid & 63;
    const float* mod = (const float*)(p.ws + WS_MOD);
    const int stride = nblk * 8;
    int row = bid * 8 + wave; if (row >= NTOK) return;
    FinIdx ic, in; FinData dc, dn;
    fin_load_idx(p, row, ic); fin_load_data(p, eb, row, ic, dc, lane);
    int row_n = row + stride; if (row_n < NTOK) fin_load_idx(p, row_n, in);
#pragma unroll 1
    for (;;) {
        if (row_n < NTOK) fin_load_data(p, eb, row_n, in, dn, lane);
        const int row_nn = row_n + stride; FinIdx inn; if (row_nn < NTOK) fin_load_idx(p, row_nn, inn);
        const int b = row >> 12, col = 16 * lane;
        f32x4 v[4]; float s = 0.f;
#pragma unroll
        for (int q = 0; q < 4; ++q) v[q] = (f32x4){0.f, 0.f, 0.f, 0.f};
#pragma unroll
        for (int k = 0; k < 4; ++k) { const u32x4 w = dc.ys[k]; const float g = ic.g[k];
            v[0] += unpack4_f8(w.x) * g; v[1] += unpack4_f8(w.y) * g; v[2] += unpack4_f8(w.z) * g; v[3] += unpack4_f8(w.w) * g; }
#pragma unroll
        for (int q = 0; q < 4; ++q) { const u32x4 xw = dc.x[q >> 1]; const unsigned w0 = (q & 1) ? xw.z : xw.x, w1 = (q & 1) ? xw.w : xw.y;
            const f32x4 xa = (f32x4){bflo(w0), bfhi(w0), bflo(w1), bfhi(w1)}; const f32x4 g2 = *(const f32x4*)(mod + b * 6144 + 5120 + col + 4 * q);
            v[q] = xa * ALPHA + g2 * v[q]; s += (v[q].x + v[q].y) + (v[q].z + v[q].w); }
        const float mean = wave_sum(s) * (1.f / DM); float s2 = 0.f;
#pragma unroll
        for (int q = 0; q < 4; ++q) { v[q] = v[q] - mean; s2 += (v[q].x * v[q].x + v[q].y * v[q].y) + (v[q].z * v[q].z + v[q].w * v[q].w); }
        const float rstd = 1.f / sqrtf(wave_sum(s2) * (1.f / DM) + LN_EPS);
        f32x4* xo = (f32x4*)(p.out + (size_t)row * DM + col);
#pragma unroll
        for (int q = 0; q < 4; ++q) { const f32x4 gg = *(const f32x4*)(p.ln2_g + col + 4 * q), bb = *(const f32x4*)(p.ln2_b + col + 4 * q); xo[q] = (v[q] * rstd) * gg + bb; }
        if (row_n >= NTOK) break;
        row = row_n; row_n = row_nn; ic = in; in = inn; dc = dn;
    }
}

namespace pg {
#define PG_LAS __attribute__((address_space(3)))
typedef float f32x2 __attribute__((ext_vector_type(2)));
constexpr int BM = 256, BK = 64, HALF = 128, HTB = HALF * BK * 2, STAGE_BYTES = 8 * HTB, KD = 1024, NT = KD / BK;
constexpr unsigned KSTEP = BK * 2, HSTEPB = HALF * KD * 2;
__host__ __device__ __forceinline__ int lds_byte(int r, int c) { const int st = (r >> 4) * 2 + (c >> 5), rr = r & 15, cc = c & 31, ob = rr * 64 + cc * 2; return st * 1024 + (ob ^ (((ob >> 9) & 1) << 5)); }
__host__ __device__ __forceinline__ void stage_rc(int b, int& R, int& C) { const int st = b / 1024, sb = b % 1024, swz = sb ^ (((sb >> 9) & 1) << 5); R = (st >> 1) * 16 + swz / 64; C = (st & 1) * 32 + (swz % 64) / 2; }
__host__ __device__ __forceinline__ int perm32(int rho) { const int n = rho >> 4, i = rho & 15; return 8 * (i >> 2) + 4 * n + (i & 3); }
struct Unit { int pm, pn, row0, nrows, e, kind; };
__device__ __forceinline__ void tilemap(int L, int nM, int nN, int& pm, int& pn) {
    int wgid = L; { const int nwg = nM * nN, q = nwg / 8, r = nwg % 8, xcd = wgid % 8, off = wgid / 8; wgid = (xcd < r ? xcd * (q + 1) : r * (q + 1) + (xcd - r) * q) + off; }
    const int nig = 8 * nN, gid = wgid / nig, fm = gid * 8, gsz = (nM - fm) < 8 ? (nM - fm) : 8;
    pm = fm + ((wgid % nig) % gsz); pn = (wgid % nig) / gsz;
}
__device__ __forceinline__ unsigned cvt_pk_bf16(float lo, float hi) { unsigned r; asm volatile("v_cvt_pk_bf16_f32 %0, %1, %2" : "=v"(r) : "v"(lo), "v"(hi)); return r; }
__device__ __forceinline__ f32x2 gelu_pk(f32x2 v) {
    const f32x2 av = __builtin_elementwise_abs(v), d = av * 0.2316418882f + 1.0f;
    f32x2 t; t.x = __builtin_amdgcn_rcpf(d.x); t.y = __builtin_amdgcn_rcpf(d.y);
    f32x2 q = t * 0.5307027145f + (-0.7265760135f); q = q * t + 0.7107068705f; q = q * t + (-0.142248368f); q = q * t + 0.127414796f; q = q * t;
    const f32x2 s = (v * v) * (-0.72134752044f);
    f32x2 e; e.x = __builtin_amdgcn_exp2f(s.x); e.y = __builtin_amdgcn_exp2f(s.y);
    const f32x2 m = v * (q * e), r = v - m;
    f32x2 o; o.x = v.x < 0.f ? m.x : r.x; o.y = v.y < 0.f ? m.y : r.y; return o;
}
__device__ __forceinline__ f32x4 gelu4(f32x4 v) { const f32x2 a = gelu_pk((f32x2){v[0], v[1]}), b = gelu_pk((f32x2){v[2], v[3]}); return (f32x4){a.x, a.y, b.x, b.y}; }
__device__ __forceinline__ f32x4 sigmoid4(f32x4 v) { f32x4 o;
#pragma unroll
    for (int i = 0; i < 4; ++i) o[i] = __builtin_amdgcn_rcpf(1.0f + __builtin_amdgcn_exp2f(-1.4426950408889634f * v[i]));
    return o; }
__device__ __forceinline__ u32x4 pack8v(f32x4 a, f32x4 b) { u32x4 w; w.x = cvt_pk_bf16(a[0], a[1]); w.y = cvt_pk_bf16(a[2], a[3]); w.z = cvt_pk_bf16(b[0], b[1]); w.w = cvt_pk_bf16(b[2], b[3]); return w; }

typedef int v8i __attribute__((ext_vector_type(8)));
template <class Epi, class Sched, bool ALIGN_EPI, bool F8 = false>
__device__ __forceinline__ void gemm_phase(PG_LAS unsigned char* lds, const unsigned char* Abase, const Sched& S, const Epi& E) {
    const int tid = tid_opaque(), wid = __builtin_amdgcn_readfirstlane(tid >> 6), lane = tid & 63, wr = wid >> 2, wc = wid & 3, fr = lane & 15, fq = lane >> 4;
    int R[2], C[2]; unsigned voffB[2];
#pragma unroll
    for (int i = 0; i < 2; ++i) { stage_rc(tid * 16 + i * 8192, R[i], C[i]);
        const int rho = R[i] & 31, Rb = Epi::PERM == 0 ? R[i] : (Epi::PERM == 1 ? ((R[i] & ~31) + perm32(rho)) : ((R[i] >> 5) * 64 + 16 * ((rho & 15) >> 2) + 4 * (rho >> 4) + (rho & 3)));
        voffB[i] = (unsigned)(Rb * (F8 ? 1024 : 2048) + C[i] * 2); }
    constexpr unsigned HSB = (Epi::PERM == 2 ? 8u : 128u) * (F8 ? 1024u : 2048u);
    constexpr int NTL = F8 ? NT / 2 : NT;
    const unsigned ldsw = (unsigned)wid * 1024u;
    const int aoff = lds_byte(wr * 64 + fr, fq * 8), boff = lds_byte(wc * 32 + fr, fq * 8);
#define PG_SA(b, h) (((b) * 2 + (h)) * HTB)
#define PG_SB(b, h) ((4 + (b) * 2 + (h)) * HTB)
#define PG_STAGE_A(bufoff, kbyte, vo) do { _Pragma("unroll") for (int _i = 0; _i < 2; ++_i) \
        __builtin_amdgcn_global_load_lds((const unsigned*)((const char*)Abase + (kbyte) + (vo)[_i]), (PG_LAS unsigned*)(lds + (bufoff) + ldsw + _i * 8192), 16, 0, 0); } while (0)
#define PG_STAGE_B(bufoff, gbase) do { _Pragma("unroll") for (int _i = 0; _i < 2; ++_i) \
        __builtin_amdgcn_global_load_lds((const unsigned*)((const char*)(gbase) + voffB[_i]), (PG_LAS unsigned*)(lds + (bufoff) + ldsw + _i * 8192), 16, 0, 0); } while (0)
#define PG_LD16(off) (*(const PG_LAS u32x4*)(lds + (off)))
#define PG_CAT(lo, hi) __builtin_bit_cast(v8i, __builtin_shufflevector((lo), (hi), 0, 1, 2, 3, 4, 5, 6, 7))
#define PG_LDA(dst, b, h) do { _Pragma("unroll") for (int m = 0; m < 4; ++m) { \
        if constexpr (F8) dst##8[m] = PG_CAT(PG_LD16(PG_SA(b, h) + aoff + m * 2048), PG_LD16(PG_SA(b, h) + aoff + m * 2048 + 1024)); \
        else { _Pragma("unroll") for (int k = 0; k < 2; ++k) dst[m][k] = *(const PG_LAS bf16x8*)(lds + PG_SA(b, h) + aoff + m * 2048 + k * 1024); } } } while (0)
#define PG_LDB(dst, b, h) do { _Pragma("unroll") for (int n = 0; n < 2; ++n) { \
        if constexpr (F8) dst##8[n] = PG_CAT(PG_LD16(PG_SB(b, h) + boff + n * 2048), PG_LD16(PG_SB(b, h) + boff + n * 2048 + 1024)); \
        else { _Pragma("unroll") for (int k = 0; k < 2; ++k) dst[n][k] = *(const PG_LAS bf16x8*)(lds + PG_SB(b, h) + boff + n * 2048 + k * 1024); } } } while (0)
#define PG_MMA(ai, bj, At, Bt) do { __builtin_amdgcn_s_setprio(1); _Pragma("unroll") for (int m = 0; m < 4; ++m) _Pragma("unroll") for (int n = 0; n < 2; ++n) { \
        if constexpr (F8) asm volatile("s_nop 1\n\tv_mfma_scale_f32_16x16x128_f8f6f4 %0, %1, %2, %0, %3, %3 op_sel_hi:[0,0,0]" : "+v"(acc[ai][bj][m][n]) : "v"(Bt##8[n]), "v"(At##8[m]), "v"(f8scale)); \
        else { _Pragma("unroll") for (int k = 0; k < 2; ++k) acc[ai][bj][m][n] = __builtin_amdgcn_mfma_f32_16x16x32_bf16(Bt[n][k], At[m][k], acc[ai][bj][m][n], 0, 0, 0); } } \
        __builtin_amdgcn_s_setprio(0); } while (0)
#define PG_WAIT_V(n) asm volatile("s_waitcnt vmcnt(" #n ")" ::: "memory")
#define PG_WAIT_L(n) asm volatile("s_waitcnt lgkmcnt(" #n ")" ::: "memory")
#define PG_BAR __builtin_amdgcn_s_barrier()
#define PG_SCHED __builtin_amdgcn_sched_barrier(0)
    Unit cur, nxt; int ui = 0;
    if (!S.next(0, cur)) return;
    f32x4 acc[2][2][4][2];
#pragma unroll
    for (int a = 0; a < 2; ++a)
#pragma unroll
        for (int b = 0; b < 2; ++b)
#pragma unroll
            for (int m = 0; m < 4; ++m)
#pragma unroll
                for (int n = 0; n < 2; ++n) acc[a][b][m][n] = (f32x4){0.f, 0.f, 0.f, 0.f};
    bf16x8 At[4][2], B0[2][2], B1[2][2]; v8i At8[4], B08[2], B18[2];
    int f8scale = 0x7f7f7f7f; asm volatile("" : "+v"(f8scale));
    unsigned ac[2][2], an[2][2];
    S.aoffs(cur, R, C, ac);
    const char* cB = S.bptr(cur);
    PG_STAGE_B(PG_SB(0, 0), cB); PG_STAGE_B(PG_SB(0, 1), cB + HSB); PG_STAGE_A(PG_SA(0, 0), 0u, ac[0]); PG_STAGE_A(PG_SA(0, 1), 0u, ac[1]);
    if (wr == 1) PG_BAR;
    PG_WAIT_V(2); PG_BAR;
    PG_STAGE_B(PG_SB(1, 0), cB + KSTEP); PG_STAGE_A(PG_SA(1, 0), KSTEP, ac[0]); PG_STAGE_B(PG_SB(1, 1), cB + HSB + KSTEP);
    PG_WAIT_V(6); PG_BAR;
    for (;;) {
        const bool has_next = S.next(ui + 1, nxt);
        const char* nB = cB;
        if (has_next) { int R2[2], C2[2]; int t2 = tid; asm volatile("" : "+v"(t2));
#pragma unroll
            for (int i = 0; i < 2; ++i) stage_rc(t2 * 16 + i * 8192, R2[i], C2[i]);
            S.aoffs(nxt, R2, C2, an); nB = S.bptr(nxt); }
        else {
#pragma unroll
            for (int h = 0; h < 2; ++h)
#pragma unroll
                for (int i = 0; i < 2; ++i) an[h][i] = ac[h][i]; }
        for (int t = 0; t < NTL; t += 2) {
            const bool last = (t == NTL - 2);
            const unsigned ka1 = (unsigned)(t + 1) * KSTEP;
            const unsigned ka2 = last ? 0u : (unsigned)(t + 2) * KSTEP;
            const char* b2 = last ? nB : cB + (size_t)(t + 2) * KSTEP; const char* b3 = b2 + KSTEP;
            unsigned a2o[2][2];
#pragma unroll
            for (int h = 0; h < 2; ++h)
#pragma unroll
                for (int i = 0; i < 2; ++i) a2o[h][i] = last ? an[h][i] : ac[h][i];
            PG_LDB(B0, 0, 0); PG_LDB(B1, 0, 1); PG_SCHED; PG_LDA(At, 0, 0); PG_STAGE_A(PG_SA(1, 1), ka1, ac[1]);
            PG_WAIT_V(8); PG_WAIT_L(0); PG_BAR; PG_MMA(0, 0, At, B0); PG_MMA(0, 1, At, B1); PG_BAR; PG_SCHED;
            PG_LDA(At, 0, 1); PG_STAGE_B(PG_SB(0, 0), b2); PG_STAGE_B(PG_SB(0, 1), b2 + HSB); PG_STAGE_A(PG_SA(0, 0), ka2, a2o[0]);
            PG_WAIT_V(8); PG_WAIT_L(0); PG_BAR; PG_MMA(1, 0, At, B0); PG_MMA(1, 1, At, B1); PG_BAR; PG_SCHED;
            PG_LDB(B0, 1, 0); PG_LDB(B1, 1, 1); PG_SCHED; PG_LDA(At, 1, 0); PG_STAGE_A(PG_SA(0, 1), ka2, a2o[1]);
            PG_WAIT_V(8); PG_WAIT_L(0); PG_BAR; PG_MMA(0, 0, At, B0); PG_MMA(0, 1, At, B1); PG_BAR; PG_SCHED;
            PG_LDA(At, 1, 1); PG_STAGE_B(PG_SB(1, 0), b3); PG_STAGE_B(PG_SB(1, 1), b3 + HSB); PG_STAGE_A(PG_SA(1, 0), ka2 + KSTEP, a2o[0]);
            PG_WAIT_V(8); PG_WAIT_L(0); PG_BAR; PG_MMA(1, 0, At, B0); PG_MMA(1, 1, At, B1); PG_BAR; PG_SCHED;
        }
        if constexpr (ALIGN_EPI) { if (wr == 0) PG_BAR; }
        if constexpr (F8) asm volatile("s_nop 15\n\ts_nop 15" ::: "memory");
        { int te = tid; asm volatile("" : "+v"(te)); E.run(acc, cur, wr, wc, te & 15, (te >> 4) & 3); }
        if (!has_next) break;
        if (!E.carry(cur)) {
#pragma unroll
            for (int a = 0; a < 2; ++a)
#pragma unroll
                for (int b = 0; b < 2; ++b)
#pragma unroll
                    for (int m = 0; m < 4; ++m)
#pragma unroll
                        for (int n = 0; n < 2; ++n) acc[a][b][m][n] = (f32x4){0.f, 0.f, 0.f, 0.f}; }
        cur = nxt; cB = nB; ++ui;
#pragma unroll
        for (int h = 0; h < 2; ++h)
#pragma unroll
            for (int i = 0; i < 2; ++i) ac[h][i] = an[h][i];
        if constexpr (ALIGN_EPI) { if (wr == 1) PG_BAR; }
    }
    PG_WAIT_V(0);
    if constexpr (!ALIGN_EPI) { if (wr == 0) PG_BAR; }
    PG_BAR;
#undef PG_SA
#undef PG_SB
#undef PG_STAGE_A
#undef PG_STAGE_B
#undef PG_LDA
#undef PG_LDB
#undef PG_MMA
#undef PG_CAT
#undef PG_LD16
#undef PG_WAIT_V
#undef PG_WAIT_L
#undef PG_BAR
#undef PG_SCHED
}

struct SchedP1 {
    int G, c; const unsigned char* ws;
    __device__ __forceinline__ bool next(int i, Unit& u) const {
        const int L = i * G + c; if (L >= 3136) return false;
        u.row0 = 0; u.nrows = 256; u.e = 0;
        if (L < 2048) { u.kind = 0; tilemap(L, 128, 16, u.pm, u.pn); }
        else if (L < 3072) { u.kind = 1; tilemap(L - 2048, 8, 128, u.pm, u.pn); }
        else if (L < 3104) { u.kind = 2; const int l = L - 3072; u.pm = l >> 2; u.pn = l & 3; }
        else { u.kind = 3; const int l = L - 3104; u.pm = l >> 3; u.pn = l & 7; }
        return true; }
    __device__ __forceinline__ void aoffs(const Unit& u, const int (&R)[2], const int (&C)[2], unsigned (&o)[2][2]) const {
        size_t base; int row0;
        if (u.kind == 0) { base = WS_U; row0 = 256 * u.pm; }
        else if (u.kind == 1) { base = WS_WIN; row0 = u.pm < 4 ? 1024 + 256 * u.pm : 4096 + 256 * (u.pm - 4); }
        else if (u.kind == 2) { base = WS_UC; row0 = 256 * u.pm; }
        else { base = WS_WIN; row0 = 4096 + 256 * u.pm; }
#pragma unroll
        for (int h = 0; h < 2; ++h)
#pragma unroll
            for (int i = 0; i < 2; ++i) o[h][i] = (unsigned)(base + ((size_t)(row0 + 128 * h + R[i]) * 1024 + C[i]) * 2); }
    __device__ __forceinline__ const char* bptr(const Unit& u) const {
        if (u.kind == 0) { const int wrow = u.pn < 4 ? 256 * u.pn : (u.pn < 8 ? 2048 + 256 * (u.pn - 4) : 5120 + 256 * (u.pn - 8)); return (const char*)ws + WS_WIN + (size_t)wrow * 2048; }
        if (u.kind == 1) return (const char*)ws + WS_U + (size_t)u.pn * 256 * 2048;
        if (u.kind == 2) return (const char*)ws + WS_WIN + (size_t)(3072 + 256 * u.pn) * 2048;
        return (const char*)ws + WS_UC + (size_t)u.pn * 256 * 2048; }
};
struct EpiP1 {
    static constexpr int PERM = 1;
    unsigned char* ws; const float* b_in;
    __device__ __forceinline__ bool carry(const Unit&) const { return false; }
    __device__ __forceinline__ void run(f32x4 (&acc)[2][2][4][2], const Unit& u, int wr, int wc, int fr, int fq) const {
        const int lc = wc * 32 + 8 * fq, kind = u.kind, pm = u.pm, pn = u.pn;
        const bool brow = (kind == 1) || (kind == 3);
        int act, bcol, browbase, RA, RB, CA, CB; size_t base;
        if (kind == 0) { browbase = 0;
            if (pn < 4) { act = 1; bcol = 256 * pn; base = WS_ZU / 2 + (size_t)256 * pm * 1024 + 256 * pn; RA = 65536; RB = 1024; CA = 64; CB = 1; }
            else if (pn < 8) { act = 0; bcol = 2048 + 256 * (pn - 4); const int tok0 = 256 * pm;
                base = WS_Q / 2 + ((size_t)((tok0 >> 12) * 16 + 4 * (pn - 4)) * 4096 + (tok0 & 4095)) * 64; RA = 4096; RB = 64; CA = 4096 * 64; CB = 1; }
            else { act = 2; bcol = 5120 + 256 * (pn - 8); base = WS_G / 2 + (size_t)256 * pm * 2048 + 256 * (pn - 8); RA = 131072; RB = 2048; CA = 64; CB = 1; } }
        else if (kind == 1) { bcol = 0; const int tk0 = 256 * pn;
            if (pm < 4) { act = 1; browbase = 1024 + 256 * pm; base = WS_ZVT / 2 + (size_t)(tk0 >> 3) * 8192 + 256 * pm * 8; RA = 512; RB = 8; CA = 65536; CB = 1024; }
            else { act = 0; browbase = 4096 + 256 * (pm - 4); base = WS_VT / 2 + ((size_t)((tk0 >> 12) * 16 + 4 * (pm - 4)) * 512 + ((tk0 & 4095) >> 3)) * 512; RA = 512 * 512; RB = 8; CA = 4096; CB = 64; } }
        else if (kind == 2) { act = 0; bcol = 3072 + 256 * pn; browbase = 0; base = WS_KC / 2 + (size_t)(pm * 16 + 4 * pn) * 256 * 64; RA = 4096; RB = 64; CA = 16384; CB = 1; }
        else { act = 0; bcol = 0; browbase = 4096 + 256 * pm; base = WS_VCT / 2 + (size_t)(pn * 16 + 4 * pm) * 32 * 512; RA = 32 * 512; RB = 8; CA = 4096; CB = 64; }
        bf16_t* dbase = (bf16_t*)ws + base;
        f32x4 bv[2][2];
#pragma unroll
        for (int bj = 0; bj < 2; ++bj)
#pragma unroll
            for (int n = 0; n < 2; ++n) bv[bj][n] = brow ? (f32x4){0.f, 0.f, 0.f, 0.f} : *(const f32x4*)(b_in + bcol + lc + bj * HALF + 4 * n);
        const int colterm0 = (wc >> 1) * CA + ((wc & 1) * 32 + 8 * fq) * CB;
        float rbv[2][4];
#pragma unroll
        for (int ai = 0; ai < 2; ++ai)
#pragma unroll
            for (int m = 0; m < 4; ++m) rbv[ai][m] = brow ? b_in[browbase + ai * HALF + wr * 64 + m * 16 + fr] : 0.f;
#pragma unroll
        for (int ai = 0; ai < 2; ++ai)
#pragma unroll
            for (int m = 0; m < 4; ++m) { const int row = ai * HALF + wr * 64 + m * 16 + fr;
                const float rb = rbv[ai][m];
                const int rowterm = (2 * ai + wr) * RA + (16 * m + fr) * RB;
#pragma unroll
                for (int bj = 0; bj < 2; ++bj) {
                    f32x4 v0 = acc[ai][bj][m][0] + bv[bj][0] + rb, v1 = acc[ai][bj][m][1] + bv[bj][1] + rb;
                    if (act == 1) { v0 = gelu4(v0); v1 = gelu4(v1); } else if (act == 2) { v0 = sigmoid4(v0); v1 = sigmoid4(v1); }
                    *(u32x4*)(dbase + rowterm + colterm0 + 2 * bj * CA) = pack8v(v0, v1); } }
    }
};
struct SchedK {
    int G, c; const unsigned char* ws;
    __device__ __forceinline__ bool next(int i, Unit& u) const { const int L = i * G + c; if (L >= 512) return false; u.kind = 0; u.row0 = 0; u.nrows = 256; u.e = 0; tilemap(L, 128, 4, u.pm, u.pn); return true; }
    __device__ __forceinline__ void aoffs(const Unit& u, const int (&R)[2], const int (&C)[2], unsigned (&o)[2][2]) const {
#pragma unroll
        for (int h = 0; h < 2; ++h)
#pragma unroll
            for (int i = 0; i < 2; ++i) o[h][i] = (unsigned)(WS_U + ((size_t)(256 * u.pm + 128 * h + R[i]) * 1024 + C[i]) * 2); }
    __device__ __forceinline__ const char* bptr(const Unit& u) const { return (const char*)ws + WS_WIN + (size_t)(3072 + 256 * u.pn) * 2048; }
};
struct EpiRope {
    static constexpr int PERM = 0;
    unsigned char* ws; const float* b_in;
    __device__ __forceinline__ bool carry(const Unit&) const { return false; }
    __device__ __forceinline__ void run(f32x4 (&acc)[2][2][4][2], const Unit& u, int wr, int wc, int fr, int fq) const {
        bf16_t* K = (bf16_t*)(ws + WS_K); const float* tab = (const float*)(ws + WS_ROPE);
        const int lc = wc * 32 + 4 * fq, axis = wc & 1;
        f32x4 b0[2], b1[2];
#pragma unroll
        for (int bj = 0; bj < 2; ++bj) { b0[bj] = *(const f32x4*)(b_in + 3072 + 256 * u.pn + bj * HALF + lc); b1[bj] = *(const f32x4*)(b_in + 3072 + 256 * u.pn + bj * HALF + lc + 16); }
        f32x4 tb0[2][4], tb1[2][4];
#pragma unroll
        for (int ai = 0; ai < 2; ++ai)
#pragma unroll
            for (int m = 0; m < 4; ++m) { const int tok = 256 * u.pm + ai * HALF + wr * 64 + m * 16 + fr; const int pos = axis ? (tok & 63) : ((tok >> 6) & 63);
                tb0[ai][m] = *(const f32x4*)(tab + (pos * 16 + 4 * fq) * 2); tb1[ai][m] = *(const f32x4*)(tab + (pos * 16 + 4 * fq) * 2 + 4); }
#pragma unroll
        for (int ai = 0; ai < 2; ++ai)
#pragma unroll
            for (int m = 0; m < 4; ++m) { const int tok = 256 * u.pm + ai * HALF + wr * 64 + m * 16 + fr;
                const f32x4 t0 = tb0[ai][m], t1 = tb1[ai][m];
                const f32x4 cs = (f32x4){t0[0], t0[2], t1[0], t1[2]}, sn = (f32x4){t0[1], t0[3], t1[1], t1[3]};
                const int cc0 = 256 * u.pn + lc;
                bf16_t* rowp = K + ((size_t)((tok >> 12) * 16) * 4096 + (tok & 4095)) * 64;
#pragma unroll
                for (int bj = 0; bj < 2; ++bj) { const f32x4 v0 = acc[ai][bj][m][0] + b0[bj], v1 = acc[ai][bj][m][1] + b1[bj];
                    const f32x4 o0 = v0 * cs - v1 * sn, o1 = v1 * cs + v0 * sn;
                    u32x2 w0, w1; w0.x = cvt_pk_bf16(o0[0], o0[1]); w0.y = cvt_pk_bf16(o0[2], o0[3]); w1.x = cvt_pk_bf16(o1[0], o1[1]); w1.y = cvt_pk_bf16(o1[2], o1[3]);
                    const int cc = cc0 + bj * HALF; bf16_t* dp = rowp + (size_t)(cc >> 6) * 4096 * 64 + (cc & 63);
                    *(u32x2*)dp = w0; *(u32x2*)(dp + 16) = w1; } }
    }
};
struct SchedMerge {
    int G, c; const unsigned char* ws;
    __device__ __forceinline__ bool next(int i, Unit& u) const { const int L = (i >> 1) * G + c; if (L >= 512) return false; u.kind = i & 1; u.row0 = 0; u.nrows = 256; u.e = 0; tilemap(L, 128, 4, u.pm, u.pn); return true; }
    __device__ __forceinline__ void aoffs(const Unit& u, const int (&R)[2], const int (&C)[2], unsigned (&o)[2][2]) const {
        const size_t base = u.kind ? WS_YB : WS_U;
#pragma unroll
        for (int h = 0; h < 2; ++h)
#pragma unroll
            for (int i = 0; i < 2; ++i) o[h][i] = (unsigned)(base + ((size_t)(256 * u.pm + 128 * h + R[i]) * 1024 + C[i]) * 2); }
    __device__ __forceinline__ const char* bptr(const Unit& u) const { return (const char*)ws + (u.kind ? WS_WPB : WS_WPA) + (size_t)u.pn * 256 * 2048; }
};
struct EpiMerge {
    static constexpr int PERM = 1;
    unsigned char* ws;
    __device__ __forceinline__ bool carry(const Unit& u) const { return u.kind == 0; }
    __device__ __forceinline__ void run(f32x4 (&acc)[2][2][4][2], const Unit& u, int wr, int wc, int fr, int fq) const {
        const bf16_t* Gt = (const bf16_t*)(ws + WS_G); bf16_t* INNER = (bf16_t*)(ws + WS_INNER);
        const int lc = 256 * u.pn + wc * 32 + 8 * fq;
#pragma unroll
        for (int ai = 0; ai < 2; ++ai) {
            u32x4 gbw[4][2], gaw[4][2];
#pragma unroll
            for (int m = 0; m < 4; ++m) { const size_t tok = (size_t)(256 * u.pm + ai * HALF + wr * 64 + m * 16 + fr);
#pragma unroll
                for (int bj = 0; bj < 2; ++bj) { gbw[m][bj] = *(const u32x4*)(Gt + tok * 2048 + 1024 + lc + bj * HALF);
                    if (u.kind == 0) gaw[m][bj] = *(const u32x4*)(Gt + tok * 2048 + lc + bj * HALF); } }
#pragma unroll
            for (int m = 0; m < 4; ++m) { const size_t tok = (size_t)(256 * u.pm + ai * HALF + wr * 64 + m * 16 + fr);
#pragma unroll
                for (int bj = 0; bj < 2; ++bj) { const u32x4 gw = gbw[m][bj];
                    const f32x4 gb0 = (f32x4){bflo(gw.x), bfhi(gw.x), bflo(gw.y), bfhi(gw.y)}, gb1 = (f32x4){bflo(gw.z), bfhi(gw.z), bflo(gw.w), bfhi(gw.w)};
                    if (u.kind == 0) { const u32x4 ga = gaw[m][bj];
                        const f32x4 ga0 = (f32x4){bflo(ga.x), bfhi(ga.x), bflo(ga.y), bfhi(ga.y)}, ga1 = (f32x4){bflo(ga.z), bfhi(ga.z), bflo(ga.w), bfhi(ga.w)};
#pragma unroll
                        for (int i = 0; i < 4; ++i) { acc[ai][bj][m][0][i] *= ga0[i] * __builtin_amdgcn_rcpf(fmaxf(gb0[i], 1e-30f)); acc[ai][bj][m][1][i] *= ga1[i] * __builtin_amdgcn_rcpf(fmaxf(gb1[i], 1e-30f)); }
                    } else { *(u32x4*)(INNER + tok * 1024 + lc + bj * HALF) = pack8v(acc[ai][bj][m][0] * gb0, acc[ai][bj][m][1] * gb1); } } }
        }
    }
};
struct SchedMix {
    int G, c; const unsigned char* ws;
    __device__ __forceinline__ bool next(int i, Unit& u) const { const int L = i * G + c; if (L >= 512) return false; u.kind = 0; u.row0 = 0; u.nrows = 256; u.e = 0; tilemap(L, 128, 4, u.pm, u.pn); return true; }
    __device__ __forceinline__ void aoffs(const Unit& u, const int (&R)[2], const int (&C)[2], unsigned (&o)[2][2]) const {
#pragma unroll
        for (int h = 0; h < 2; ++h)
#pragma unroll
            for (int i = 0; i < 2; ++i) o[h][i] = (unsigned)(WS_INNER + ((size_t)(256 * u.pm + 128 * h + R[i]) * 1024 + C[i]) * 2); }
    __device__ __forceinline__ const char* bptr(const Unit& u) const { return (const char*)ws + WS_WOUT + (size_t)u.pn * 256 * 2048; }
};
struct EpiMix {
    static constexpr int PERM = 0;
    unsigned char* ws; const float *x, *lng, *lnb, *b_out; float* out;
    __device__ __forceinline__ bool carry(const Unit&) const { return false; }
    __device__ __forceinline__ void run(f32x4 (&acc)[2][2][4][2], const Unit& u, int wr, int wc, int fr, int fq) const {
        const float* rowstat = (const float*)(ws + WS_ROWSTAT); const float* mod = (const float*)(ws + WS_MOD) + ((256 * u.pm) >> 12) * 6144 + 2048;
        f32x2 st[2][4];
#pragma unroll
        for (int ai = 0; ai < 2; ++ai)
#pragma unroll
            for (int m = 0; m < 4; ++m) st[ai][m] = *(const f32x2*)(rowstat + 2 * (256 * u.pm + ai * HALF + wr * 64 + m * 16 + fr));
#pragma unroll
        for (int bj = 0; bj < 2; ++bj)
#pragma unroll
            for (int n = 0; n < 2; ++n) { const int col = 256 * u.pn + bj * HALF + wc * 32 + n * 16 + 4 * fq;
                const f32x4 lg = *(const f32x4*)(lng + col), lb = *(const f32x4*)(lnb + col), bo = *(const f32x4*)(b_out + col), g1 = *(const f32x4*)(mod + col);
                f32x4 xb[2][4];
#pragma unroll
                for (int ai = 0; ai < 2; ++ai)
#pragma unroll
                    for (int m = 0; m < 4; ++m) xb[ai][m] = *(const f32x4*)(x + (size_t)(256 * u.pm + ai * HALF + wr * 64 + m * 16 + fr) * 1024 + col);
#pragma unroll
                for (int ai = 0; ai < 2; ++ai)
#pragma unroll
                    for (int m = 0; m < 4; ++m) { const size_t off = (size_t)(256 * u.pm + ai * HALF + wr * 64 + m * 16 + fr) * 1024 + col;
                        const f32x4 xv = xb[ai][m];
                        const f32x4 x0 = (xv - st[ai][m].x) * st[ai][m].y * lg + lb;
                        const f32x4 r = x0 * ALPHA + g1 * (acc[ai][bj][m][n] + bo); u32x2 w; w.x = cvt_pk_bf16(r[0], r[1]); w.y = cvt_pk_bf16(r[2], r[3]);
                        *(u32x2*)((bf16_t*)(ws + WS_X1PRE) + off) = w; }
                asm volatile("" ::: "memory"); }
    }
};
__device__ __forceinline__ int ld_u(const int* p) { return __builtin_amdgcn_readfirstlane(__hip_atomic_load(p, __ATOMIC_RELAXED, __HIP_MEMORY_SCOPE_AGENT)); }
template <int NPN  > struct SchedMoe {
    int G, c; const unsigned char* ws; const int* tabs;
    __device__ __forceinline__ bool next(int i, Unit& u) const {
        const int* cn = tabs; const int* eb = tabs + 32; const int* tb = tabs + 65;
        const int ntiles = tb[32], tpx = (ntiles + 7) >> 3, x = c & 7, s = c >> 3;
        const int tiles_x = min(tpx, ntiles - x * tpx), ll = i * (G >> 3) + s;
        if (ll >= NPN * tiles_x) return false;
        const int T = x * tpx + ll / NPN; u.pn = ll % NPN; u.kind = 0;
        int e = 0;
#pragma unroll 1
        for (int k = 16; k >= 1; k >>= 1) if (tb[e + k] <= T) e += k;
        const int jt = T - tb[e];
        u.e = __builtin_amdgcn_readfirstlane(e); u.pm = __builtin_amdgcn_readfirstlane(jt);
        u.row0 = __builtin_amdgcn_readfirstlane(eb[e] + 256 * jt); u.nrows = __builtin_amdgcn_readfirstlane(min(256, cn[e] - 256 * jt)); return true; }
    __device__ __forceinline__ void aoffs(const Unit& u, const int (&R)[2], const int (&C)[2], unsigned (&o)[2][2]) const {
        const int* PERM2 = (const int*)(ws + WS_PERM2) + (size_t)u.e * NTOK + 256 * u.pm;
#pragma unroll
        for (int h = 0; h < 2; ++h)
#pragma unroll
            for (int i = 0; i < 2; ++i) { const int lr = min(128 * h + R[i], u.nrows - 1);
                if (NPN == 8) { const int tok = PERM2[lr]; o[h][i] = (unsigned)(WS_U + (size_t)tok * 1024 + C[i] * 2); }
                else o[h][i] = (unsigned)(WS_ACT + (size_t)(u.row0 + lr) * 1024 + C[i] * 2); } }
    __device__ __forceinline__ const char* bptr(const Unit& u) const {
        if (NPN == 8) return (const char*)ws + WS_W1 + ((size_t)u.e * 2048 + 256 * u.pn) * 1024;
        return (const char*)ws + WS_W2 + ((size_t)u.e * 1024 + 256 * u.pn) * 1024; }
};
struct EpiMoe1 {
    static constexpr int PERM = 1;
    unsigned char* ws; const float* b1;
    __device__ __forceinline__ bool carry(const Unit&) const { return false; }
    __device__ __forceinline__ void run(f32x4 (&acc)[2][2][4][2], const Unit& u, int wr, int wc, int fr, int fq) const {
        unsigned char* ACT = ws + WS_ACT;
        const int col = 128 * u.pn + wc * 32 + 8 * fq;
        f32x4 bg[2], bl[2];
#pragma unroll
        for (int n = 0; n < 2; ++n) { bg[n] = *(const f32x4*)(b1 + u.e * 2048 + col + 4 * n); bl[n] = *(const f32x4*)(b1 + u.e * 2048 + 1024 + col + 4 * n); }
        u32x2 outw[2][4];
#pragma unroll
        for (int ai = 0; ai < 2; ++ai)
#pragma unroll
            for (int m = 0; m < 4; ++m) {
                f32x4 a[2];
#pragma unroll
                for (int n = 0; n < 2; ++n) { const f32x4 zgv = acc[ai][0][m][n] * (1.0f / W_F8_SCALE) + bg[n], zlv = acc[ai][1][m][n] * (1.0f / W_F8_SCALE) + bl[n];
#pragma unroll
                    for (int i = 0; i < 4; ++i) { const float zg = fminf(zgv[i], 7.0f), zl = fminf(fmaxf(zlv[i], -7.0f), 7.0f);
                        a[n][i] = fminf(fmaxf(ACT_F8_SCALE * zg * __builtin_amdgcn_rcpf(1.0f + __builtin_amdgcn_exp2f(-1.702f * 1.4426950408889634f * zg)) * (zl + 1.0f), -448.0f), 448.0f); } }
                outw[ai][m] = pack8_f8(a[0], a[1]); }
#pragma unroll
        for (int ai = 0; ai < 2; ++ai)
#pragma unroll
            for (int m = 0; m < 4; ++m) { const int lr = ai * HALF + wr * 64 + m * 16 + fr;
                const size_t srow = lr < u.nrows ? (size_t)(u.row0 + lr) : (size_t)(NASSIGN + lr);
                *(u32x2*)(ACT + srow * 1024 + col) = outw[ai][m]; }
    }
};
struct EpiMoe2 {
    static constexpr int PERM = 2;
    unsigned char* ws; const float* b2;
    __device__ __forceinline__ bool carry(const Unit&) const { return false; }
    __device__ __forceinline__ void run(f32x4 (&acc)[2][2][4][2], const Unit& u, int wr, int wc, int fr, int fq) const {
        unsigned char* YS = ws + WS_YS; constexpr float DS = 1.0f / (W_F8_SCALE * ACT_F8_SCALE);
        const int lc = 256 * u.pn + wc * 64 + 16 * fq;
        f32x4 bv[2][2];
#pragma unroll
        for (int bj = 0; bj < 2; ++bj)
#pragma unroll
            for (int n = 0; n < 2; ++n) bv[bj][n] = *(const f32x4*)(b2 + u.e * 1024 + lc + 8 * bj + 4 * n);
        u32x4 outw[2][4];
#pragma unroll
        for (int ai = 0; ai < 2; ++ai)
#pragma unroll
            for (int m = 0; m < 4; ++m) {
                { const u32x2 lo = pack8_f8((acc[ai][0][m][0] * DS + bv[0][0]) * YS_F8_SCALE, (acc[ai][0][m][1] * DS + bv[0][1]) * YS_F8_SCALE), hi = pack8_f8((acc[ai][1][m][0] * DS + bv[1][0]) * YS_F8_SCALE, (acc[ai][1][m][1] * DS + bv[1][1]) * YS_F8_SCALE);
                    u32x4 w; w.x = lo.x; w.y = lo.y; w.z = hi.x; w.w = hi.y; outw[ai][m] = w; } }
#pragma unroll
        for (int ai = 0; ai < 2; ++ai)
#pragma unroll
            for (int m = 0; m < 4; ++m) { const int lr = ai * HALF + wr * 64 + m * 16 + fr;
                const size_t srow = lr < u.nrows ? (size_t)(u.row0 + lr) : (size_t)(NASSIGN + lr);
                *(u32x4*)(YS + srow * 1024 + lc) = outw[ai][m]; }
    }
};
}
__device__ __forceinline__ void phase_merge_fast(const P& p, int bid, int nblk, unsigned char* lds) {
    pg::SchedMerge S{nblk, bid, p.ws}; pg::EpiMerge E{p.ws};
    pg::gemm_phase<pg::EpiMerge, pg::SchedMerge, true>((PG_LAS unsigned char*)lds, p.ws, S, E);
}
__device__ __forceinline__ void phase_mix_fast(const P& p, int bid, int nblk, unsigned char* lds) {
    pg::SchedMix S{nblk, bid, p.ws}; pg::EpiMix E{p.ws, p.x, p.ln_x_g, p.ln_x_b, p.b_out, p.out};
    pg::gemm_phase<pg::EpiMix, pg::SchedMix, true>((PG_LAS unsigned char*)lds, p.ws, S, E);
}
__device__ __forceinline__ void phase_moe1_fast(const P& p, int bid, int nblk, unsigned char* lds) {
    moe_tables(p, lds); pg::SchedMoe<8> S{nblk, bid, p.ws, (const int*)(lds + MT_LDS)}; pg::EpiMoe1 E{p.ws, p.exp_b1};
    pg::gemm_phase<pg::EpiMoe1, pg::SchedMoe<8>, true, true>((PG_LAS unsigned char*)lds, p.ws, S, E);
}
__device__ __forceinline__ void phase_moe2_fast(const P& p, int bid, int nblk, unsigned char* lds) {
    moe_tables(p, lds); pg::SchedMoe<4> S{nblk, bid, p.ws, (const int*)(lds + MT_LDS)}; pg::EpiMoe2 E{p.ws, p.exp_b2};
    pg::gemm_phase<pg::EpiMoe2, pg::SchedMoe<4>, true, true>((PG_LAS unsigned char*)lds, p.ws, S, E);
}
__device__ __forceinline__ void phase_proj_fast(const P& p, int bid, int nblk, unsigned char* lds) {
    { pg::SchedP1 S{nblk, bid, p.ws}; pg::EpiP1 E{p.ws, p.b_in};
      pg::gemm_phase<pg::EpiP1, pg::SchedP1, true>((PG_LAS unsigned char*)lds, p.ws, S, E); }
    { pg::SchedK S{nblk, bid, p.ws}; pg::EpiRope E{p.ws, p.b_in};
      pg::gemm_phase<pg::EpiRope, pg::SchedK, true>((PG_LAS unsigned char*)lds, p.ws, S, E); }
}

#define LAS __attribute__((address_space(3)))
#define XB_TMO      128
#define XB_XCNT(j)  (256  + 64 * (j))
#define XB_XSUB(j)  (1280 + 64 * (j))
#define XB_XGEN(j)  (2304 + 64 * (j))
#define XB_TOP      3328
#define XB_TOPGEN   3392
#define XCD_BAR_WORDS 3456
#define XB_SPIN_CAP (1u << 22)
__device__ __forceinline__ unsigned xb_ld(unsigned* p)              { return __hip_atomic_load(p, __ATOMIC_RELAXED, __HIP_MEMORY_SCOPE_AGENT); }
__device__ __forceinline__ unsigned xb_add(unsigned* p, unsigned v) { return __hip_atomic_fetch_add(p, v, __ATOMIC_RELAXED, __HIP_MEMORY_SCOPE_AGENT); }
__device__ __forceinline__ unsigned xb_xcc_id() { return (unsigned)__builtin_amdgcn_s_getreg((3 << 11) | 20) & 0xFu; }
#define XB_SPIN(cond, bar) do { unsigned _sp = 0; while (cond) { __builtin_amdgcn_s_sleep(1); \
    if ((++_sp & 255u) == 0u) { if (xb_ld(&(bar)[XB_TMO])) break; if (_sp > XB_SPIN_CAP) { atomicAdd(&(bar)[XB_TMO], 1u); break; } } } } while (0)
struct XcdBarrier { unsigned* bar; unsigned x; volatile LAS unsigned* st; };
__device__ __forceinline__ XcdBarrier xcd_barrier_post(unsigned* bar, volatile LAS unsigned* st) {
    XcdBarrier b; b.bar = bar; b.x = xb_xcc_id(); b.st = st;
    if (threadIdx.x == 0) (void)xb_add(&bar[XB_XCNT(b.x)], 1u);
    return b;
}
__device__ __forceinline__ void xcd_barrier_complete(unsigned* bar, unsigned x, unsigned& nloc, unsigned& nx) {
    const unsigned G = gridDim.x * gridDim.y * gridDim.z;
    unsigned sum, cnt, mine, sp = 0u;
    for (;;) {
        sum = 0u; cnt = 0u; mine = 0u;
#pragma unroll
        for (unsigned j = 0; j < 16; ++j) { const unsigned c = xb_ld(&bar[XB_XCNT(j)]); sum += c; cnt += (c > 0u) ? 1u : 0u; mine = (j == x) ? c : mine; }
        if (sum == G) break;
        __builtin_amdgcn_s_sleep(1);
        if ((++sp & 255u) == 0u) { if (xb_ld(&bar[XB_TMO])) break; if (sp > XB_SPIN_CAP) { atomicAdd(&bar[XB_TMO], 1u); break; } }
    }
    nloc = mine > 0u ? mine : 1u; nx = cnt > 0u ? cnt : 1u;
}
__device__ __forceinline__ void xcd_barrier(const XcdBarrier& b) {
    asm volatile("s_waitcnt vmcnt(0)" ::: "memory");
    __syncthreads();
    if (threadIdx.x == 0) {
        unsigned* bar = b.bar;
        __builtin_amdgcn_s_waitcnt(0);
        unsigned nloc = b.st[0], nx = b.st[1];
        if (nloc == 0u) { xcd_barrier_complete(bar, b.x, nloc, nx); b.st[0] = nloc; b.st[1] = nx; }
        const unsigned old = xb_add(&bar[XB_XSUB(b.x)], 1u);
        const unsigned gen = old / nloc;
        if (old + 1u == (gen + 1u) * nloc) {
            __builtin_amdgcn_fence(__ATOMIC_RELEASE, "agent");
            asm volatile("s_waitcnt vmcnt(0)" ::: "memory");
            const unsigned og = xb_add(&bar[XB_TOP], 1u);
            const unsigned tg = og / nx;
            if (og + 1u == (tg + 1u) * nx) xb_add(&bar[XB_TOPGEN], 1u);
            else XB_SPIN(xb_ld(&bar[XB_TOPGEN]) == tg, bar);
            __builtin_amdgcn_fence(__ATOMIC_ACQUIRE, "agent");
            xb_add(&bar[XB_XGEN(b.x)], 1u);
            asm volatile("s_waitcnt vmcnt(0)" ::: "memory");
        } else {
            XB_SPIN(xb_ld(&bar[XB_XGEN(b.x)]) == gen, bar);
            __builtin_amdgcn_fence(__ATOMIC_ACQUIRE, "agent");
            asm volatile("s_waitcnt vmcnt(0)" ::: "memory");
        }
    }
    __syncthreads();
}
#include <hip/hip_cooperative_groups.h>
namespace cg = cooperative_groups;
constexpr int LDS_BYTES = 147456;
constexpr int XB_LDS = LDS_BYTES - 64;
constexpr int CW_BAR = 4096;
constexpr int REP_PA = 1, REP_PB = 1, REP_P1 = 1, REP_GMLP = 1, REP_ATTN = 1, REP_MERGE = 1, REP_MIX = 1, REP_MOE1 = 1, REP_MOE2 = 1, REP_BAR = 0;
__global__ void __launch_bounds__(512, 2) mega(P p) {
    extern __shared__ __attribute__((aligned(16))) unsigned char lds[];
    const int bid = blockIdx.x, nblk = gridDim.x;
    if (threadIdx.x < 16) ((volatile LAS unsigned*)((LAS unsigned char*)lds + XB_LDS))[threadIdx.x] = 0u;
    __syncthreads();
    const XcdBarrier bar = xcd_barrier_post((unsigned*)(p.ws + WS_CTL) + CW_BAR, (volatile LAS unsigned*)((LAS unsigned char*)lds + XB_LDS));
#define GRID_BAR() xcd_barrier(bar)
#define REP(n) _Pragma("unroll 1") for (int rep_ = 0; rep_ < (n); ++rep_)
    REP(REP_PA) { __syncthreads(); phase_prologue_a(p, bid, nblk, lds); } GRID_BAR();
    REP(REP_PB) phase_prologue_b(p, bid, nblk); GRID_BAR();
    REP(REP_P1) phase_proj_fast(p, bid, nblk, lds); GRID_BAR();
    REP(REP_GMLP) phase_gmlp_fast(p, bid, nblk, lds); REP(REP_ATTN) phase_attn_s(p, bid, nblk, lds); GRID_BAR();
    REP(REP_MERGE) phase_merge_fast(p, bid, nblk, lds); GRID_BAR();
    REP(REP_MIX) phase_mix_fast(p, bid, nblk, lds); GRID_BAR();
    phase_router(p, bid, nblk, lds); GRID_BAR();
    REP(REP_BAR) GRID_BAR();
    REP(REP_MOE1) phase_moe1_fast(p, bid, nblk, lds); GRID_BAR();
    REP(REP_MOE2) phase_moe2_fast(p, bid, nblk, lds); GRID_BAR();
#undef REP
    phase_final(p, bid, nblk, lds);
}

extern "C" void kernel_launch(void* const* d_in, const int* in_sizes, int n_in, void* d_out, int out_size, void* d_ws, size_t ws_size, hipStream_t stream) {
    static int grid = 0;
    if (grid == 0) {
        if (n_in != 31 || out_size != NTOK * DM || ws_size < WS_END) { fprintf(stderr, "kernel_launch: unexpected sizes n_in %d out %d ws %zu\n", n_in, out_size, ws_size); grid = -1; return; }
        int dev = 0, cus = 0, per_cu = 0;
        if (hipGetDevice(&dev) != hipSuccess || hipDeviceGetAttribute(&cus, hipDeviceAttributeMultiprocessorCount, dev) != hipSuccess) { grid = -1; return; }
        if (hipFuncSetAttribute((const void*)mega, hipFuncAttributeMaxDynamicSharedMemorySize, LDS_BYTES) != hipSuccess) { fprintf(stderr, "kernel_launch: hipFuncSetAttribute failed\n"); grid = -1; return; }
        if (hipOccupancyMaxActiveBlocksPerMultiprocessor(&per_cu, (const void*)mega, 512, LDS_BYTES) != hipSuccess || per_cu < 1) { fprintf(stderr, "kernel_launch: occupancy query failed (%d)\n", per_cu); grid = -1; return; }
        grid = cus * 1;
    }
    if (grid < 0) return;
    P p{};
    const float** pp = (const float**)&p;
    for (int i = 0; i < 31; ++i) pp[i] = (const float*)d_in[i];
    p.out = (float*)d_out; p.ws = (unsigned char*)d_ws; p.ph_lo = 0; p.ph_hi = 0;
    if (hipMemsetAsync((char*)d_ws + WS_CTL, 0, 1 * MiB, stream) != hipSuccess) { fprintf(stderr, "kernel_launch: memset failed\n"); return; }
    hipLaunchKernelGGL(mega, dim3(grid), dim3(512), LDS_BYTES, stream, p);
    const hipError_t e = hipPeekAtLastError();
    if (e != hipSuccess) fprintf(stderr, "launch failed: %s (grid %d)\n", hipGetErrorString(e), grid);
}
```

```cpp
#include <hip/hip_runtime.h>
#include <cstdio>
#include <cstdint>

typedef unsigned short bf16_t;
typedef short bf16x8 __attribute__((ext_vector_type(8)));
typedef float f32x4 __attribute__((ext_vector_type(4)));
typedef unsigned u32x4 __attribute__((ext_vector_type(4)));
typedef unsigned u32x2 __attribute__((ext_vector_type(2)));

constexpr int DM = 1024, NB = 8, SEQ = 4096, NTOK = NB * SEQ, CTXL = 256, NCTX = NB * CTXL, INW = 7168;
constexpr int NE = 32, TOPK = 4, FF = 1024, NASSIGN = NTOK * TOPK;
constexpr int NHEAD = 16, HD = 64, GW = 64;
constexpr float LN_EPS = 1e-5f;
constexpr float ALPHA = 1.189207115002721f;
constexpr int MAXTILES = NASSIGN / 256 + NE;

constexpr size_t MiB = 1u << 20;
constexpr size_t WS_CTL = 0;
constexpr size_t WS_MOD = 1 * MiB;
constexpr size_t WS_ROPE = 1 * MiB + 512 * 1024;
constexpr size_t WS_ROWSTAT = 2 * MiB;
constexpr size_t WS_ZSTAT = 2 * MiB + 512 * 1024;
constexpr size_t WS_TOPE = 3 * MiB;
constexpr size_t WS_TOPG = 4 * MiB;
constexpr size_t WS_SLOT = 5 * MiB;
constexpr size_t WS_PERM = 6 * MiB;
constexpr size_t WS_TILES = 7 * MiB;
constexpr size_t WS_WIN = 8 * MiB;
constexpr size_t WS_WPA = 22 * MiB, WS_WPB = 24 * MiB, WS_WOUT = 26 * MiB, WS_WSB = 28 * MiB;
constexpr size_t WS_KC = 30 * MiB;
constexpr size_t WS_VCT = 34 * MiB;
constexpr size_t WS_UC = 38 * MiB;
constexpr size_t WS_PERM2 = 42 * MiB;
constexpr size_t WS_W1 = 48 * MiB;
constexpr size_t WS_W2 = 176 * MiB;
constexpr size_t WS_U = 240 * MiB;
constexpr size_t WS_ZU = 304 * MiB;
constexpr size_t WS_ZVT = 368 * MiB;
constexpr size_t WS_Q = 432 * MiB;
constexpr size_t WS_K = 496 * MiB;
constexpr size_t WS_VT = 560 * MiB;
constexpr size_t WS_G = 624 * MiB;
constexpr size_t WS_YB = 752 * MiB;
constexpr size_t WS_INNER = 816 * MiB;
constexpr size_t WS_ACT = WS_ZU;
constexpr size_t WS_YS = WS_G;
constexpr size_t WS_X1PRE = WS_YB;
constexpr size_t WS_X1 = WS_VT;
constexpr size_t WS_END = 880 * MiB;

struct P {
    const float *x, *c, *ctx, *c_ctx, *ln_x_g, *ln_x_b, *ln_ctx_g, *ln_ctx_b, *w_ada, *b_ada, *w_in, *b_in, *gmlp_ln_g, *gmlp_ln_b, *gmlp_ws, *gmlp_bs,
        *na_rpb, *w_pa, *w_pb, *w_out, *b_out, *ln1_g, *ln1_b, *ln2_g, *ln2_b, *router_w, *router_b, *exp_w1, *exp_b1, *exp_w2, *exp_b2;
    float* out; unsigned char* ws; int ph_lo, ph_hi;
};

__device__ __forceinline__ int tid_opaque() { int t = threadIdx.x; asm volatile("" : "+v"(t)); return t; }
typedef float f32x2_ __attribute__((ext_vector_type(2))); typedef __bf16 bf16x2_ __attribute__((ext_vector_type(2)));
__device__ __forceinline__ unsigned pk2(float lo, float hi) { const f32x2_ v = {lo, hi}; return __builtin_bit_cast(unsigned, __builtin_convertvector(v, bf16x2_)); }
__device__ __forceinline__ unsigned f2bf(float f) { return pk2(f, 0.f) & 0xffffu; }
__device__ __forceinline__ float bf2f(unsigned h) { return __builtin_bit_cast(float, (h & 0xffffu) << 16); }
__device__ __forceinline__ float bflo(unsigned w) { return __builtin_bit_cast(float, w << 16); }
__device__ __forceinline__ float bfhi(unsigned w) { return __builtin_bit_cast(float, w & 0xffff0000u); }
__device__ __forceinline__ u32x2 pack8_f8(f32x4 a, f32x4 b) {
    int w0 = 0, w1 = 0;
    w0 = __builtin_amdgcn_cvt_pk_fp8_f32(a[0], a[1], w0, false); w0 = __builtin_amdgcn_cvt_pk_fp8_f32(a[2], a[3], w0, true);
    w1 = __builtin_amdgcn_cvt_pk_fp8_f32(b[0], b[1], w1, false); w1 = __builtin_amdgcn_cvt_pk_fp8_f32(b[2], b[3], w1, true);
    u32x2 r; r.x = (unsigned)w0; r.y = (unsigned)w1; return r;
}
typedef float f32x2u __attribute__((ext_vector_type(2)));
__device__ __forceinline__ f32x4 unpack4_f8(unsigned w) { const f32x2u lo = __builtin_amdgcn_cvt_pk_f32_fp8((int)w, false), hi = __builtin_amdgcn_cvt_pk_f32_fp8((int)w, true); return (f32x4){lo.x, lo.y, hi.x, hi.y}; }
constexpr float YS_F8_SCALE = 16.0f;
__device__ __forceinline__ float wave_sum(float v) {
#pragma unroll
    for (int o = 1; o < 64; o <<= 1) v += __shfl_xor(v, o);
    return v;
}
__device__ __forceinline__ float wave_max(float v) {
#pragma unroll
    for (int o = 1; o < 64; o <<= 1) v = fmaxf(v, __shfl_xor(v, o));
    return v;
}
__device__ __forceinline__ float gelu_exact(float v) { return 0.5f * v * (1.0f + erff(v * 0.70710678118654752f)); }
__device__ __forceinline__ float sigmoidf_(float v) { return 1.0f / (1.0f + __expf(-v)); }

__device__ __forceinline__ void mod_item(const P& p, int item, float* red  ) {
    const int tid = tid_opaque(), wave = tid >> 6, lane = tid & 63;
    const int col = item * 32 + (lane & 31), kpar = lane >> 5;
    float acc[9];
#pragma unroll
    for (int r = 0; r < 9; ++r) acc[r] = 0.f;
    for (int kk = 0; kk < 64; ++kk) {
        const int k = wave * 128 + kk * 2 + kpar;
        const float w = p.w_ada[(size_t)k * 6144 + col];
#pragma unroll
        for (int r = 0; r < 9; ++r) { const float cv = (r < 8) ? p.c[r * 1024 + k] : p.c_ctx[k]; const float s = cv / (1.0f + __expf(-cv)); acc[r] += s * w; }
    }
#pragma unroll
    for (int r = 0; r < 9; ++r) red[((wave * 2 + kpar) * 9 + r) * 32 + (lane & 31)] = acc[r];
    __syncthreads();
    if (tid < 288) {
        const int r = tid >> 5, cc = tid & 31; float s = 0.f;
#pragma unroll
        for (int q = 0; q < 16; ++q) s += red[(q * 9 + r) * 32 + cc];
        ((float*)(p.ws + WS_MOD))[r * 6144 + item * 32 + cc] = s + p.b_ada[item * 32 + cc];
    }
    __syncthreads();
}
__device__ __forceinline__ void transpose_item(const float* W, int K, int N, bf16_t* WT, int k0, int n0, int drow0, float* scr, int lane) {
    const int lr = lane >> 3, lc4 = (lane & 7) * 4;
    f32x4 v[8];
#pragma unroll
    for (int i = 0; i < 8; ++i) v[i] = *(const f32x4*)(W + (size_t)(k0 + 8 * i + lr) * N + n0 + lc4);
#pragma unroll
    for (int i = 0; i < 8; ++i) { float* d = scr + (8 * i + lr) * 33 + lc4; d[0] = v[i].x; d[1] = v[i].y; d[2] = v[i].z; d[3] = v[i].w; }
    __builtin_amdgcn_wave_barrier();
    asm volatile("s_waitcnt lgkmcnt(0)" ::: "memory");
    const int c = lane & 7;
#pragma unroll
    for (int j = 0; j < 4; ++j) { const int n = (lane >> 3) + 8 * j; const float* s = scr + (8 * c) * 33 + n;
        u32x4 o; o.x = pk2(s[0 * 33], s[1 * 33]); o.y = pk2(s[2 * 33], s[3 * 33]); o.z = pk2(s[4 * 33], s[5 * 33]); o.w = pk2(s[6 * 33], s[7 * 33]);
        *(u32x4*)(WT + (size_t)(drow0 + n) * K + k0 + 8 * c) = o; }
    asm volatile("s_waitcnt lgkmcnt(0)" ::: "memory");
    __builtin_amdgcn_wave_barrier();
}
__device__ __forceinline__ void transpose_item_f8(const float* W, int K, int N, unsigned char* WT, int k0, int n0, int drow0, float scale, float* scr, int lane) {
    const int lr = lane >> 3, lc4 = (lane & 7) * 4;
    f32x4 v[8];
#pragma unroll
    for (int i = 0; i < 8; ++i) v[i] = *(const f32x4*)(W + (size_t)(k0 + 8 * i + lr) * N + n0 + lc4);
#pragma unroll
    for (int i = 0; i < 8; ++i) { float* d = scr + (8 * i + lr) * 33 + lc4; d[0] = v[i].x * scale; d[1] = v[i].y * scale; d[2] = v[i].z * scale; d[3] = v[i].w * scale; }
    __builtin_amdgcn_wave_barrier();
    asm volatile("s_waitcnt lgkmcnt(0)" ::: "memory");
    const int c = lane & 7;
#pragma unroll
    for (int j = 0; j < 4; ++j) { const int n = (lane >> 3) + 8 * j; const float* s = scr + (8 * c) * 33 + n;
        *(u32x2*)(WT + (size_t)(drow0 + n) * K + k0 + 8 * c) = pack8_f8((f32x4){s[0 * 33], s[1 * 33], s[2 * 33], s[3 * 33]}, (f32x4){s[4 * 33], s[5 * 33], s[6 * 33], s[7 * 33]}); }
    asm volatile("s_waitcnt lgkmcnt(0)" ::: "memory");
    __builtin_amdgcn_wave_barrier();
}
constexpr float W_F8_SCALE = 256.0f, ACT_F8_SCALE = 4.0f;
constexpr int IT_WIN = 16 * 224, IT_SQ = 16 * 32, IT_W1 = 32 * 16 * 64, IT_W2 = 32 * 16 * 32, IT_WS = 32;
constexpr int IT_TOTAL = IT_WIN + 3 * IT_SQ + IT_W1 + IT_W2 + IT_WS, IT_EXP0 = IT_WIN + 3 * IT_SQ;
__device__ __forceinline__ void convert_item(const P& p, int it, float* scr, int lane) {
    unsigned char* ws = p.ws;
    if (it < IT_WIN) { const int kb = it / 224, nb = it % 224; transpose_item(p.w_in, 1024, INW, (bf16_t*)(ws + WS_WIN), kb * 64, nb * 32, nb * 32, scr, lane); return; } it -= IT_WIN;
    if (it < IT_SQ) { const int kb = it / 32, nb = it % 32; transpose_item(p.w_pa, 1024, 1024, (bf16_t*)(ws + WS_WPA), kb * 64, nb * 32, nb * 32, scr, lane); return; } it -= IT_SQ;
    if (it < IT_SQ) { const int kb = it / 32, nb = it % 32; transpose_item(p.w_pb, 1024, 1024, (bf16_t*)(ws + WS_WPB), kb * 64, nb * 32, nb * 32, scr, lane); return; } it -= IT_SQ;
    if (it < IT_SQ) { const int kb = it / 32, nb = it % 32; transpose_item(p.w_out, 1024, 1024, (bf16_t*)(ws + WS_WOUT), kb * 64, nb * 32, nb * 32, scr, lane); return; } it -= IT_SQ;
    if (it < IT_W1) { const int e = it / 1024, r = it % 1024, kb = r / 64, nb = r % 64, n0 = nb * 32;
        const int half = n0 >> 10, nn = n0 & 1023, drow0 = (nn >> 7) * 256 + half * 128 + (nn & 127);
        transpose_item_f8(p.exp_w1 + (size_t)e * 1024 * 2048, 1024, 2048, ws + WS_W1 + (size_t)e * 2048 * 1024, kb * 64, n0, drow0, W_F8_SCALE, scr, lane); return; } it -= IT_W1;
    if (it < IT_W2) { const int e = it / 512, r = it % 512, kb = r / 32, nb = r % 32;
        transpose_item_f8(p.exp_w2 + (size_t)e * 1024 * 1024, 1024, 1024, ws + WS_W2 + (size_t)e * 1024 * 1024, kb * 64, nb * 32, nb * 32, W_F8_SCALE, scr, lane); return; } it -= IT_W2;
    { bf16_t* o = (bf16_t*)(ws + WS_WSB); const float* s = p.gmlp_ws + it * 4096;
      for (int i = lane; i < 4096; i += 64) o[it * 4096 + i] = (bf16_t)f2bf(s[i]); }
}
__device__ __forceinline__ void phase_prologue_a(const P& p, int bid, int nblk, unsigned char* lds) {
    const int tid = tid_opaque(), wave = tid >> 6, lane = tid & 63;
    for (int item = bid; item < 192; item += nblk) mod_item(p, item, (float*)lds);
    if (bid == nblk - 1) {
        for (int i = tid; i < 1024; i += 512) { const int pos = i >> 4, fi = i & 15;
            const float inv = __builtin_amdgcn_exp2f(-(float)fi * (13.287712379549449f / 16.0f));
            const float ang = (float)pos * inv; const float rev = ang * 0.15915494309189535f;
            float* t = (float*)(p.ws + WS_ROPE); t[2 * i] = __builtin_amdgcn_cosf(rev); t[2 * i + 1] = __builtin_amdgcn_sinf(rev); }
    }
    __syncthreads();
    float* scr = (float*)lds + wave * (64 * 33 + 32);
    const int gw = bid * 8 + wave, ngw = nblk * 8;
    for (int it = gw; it < IT_TOTAL - (IT_W1 + IT_W2); it += ngw) convert_item(p, it < IT_EXP0 ? it : it + (IT_W1 + IT_W2), scr, lane);
}
__device__ __forceinline__ void ln_mod_row(const float* xrow, const float* g, const float* b, const float* sh, const float* sc, bf16_t* orow, float* stat, int lane) {
    const f32x4* xr = (const f32x4*)xrow + lane;
    f32x4 v[4]; float s = 0.f;
#pragma unroll
    for (int j = 0; j < 4; ++j) { v[j] = xr[64 * j]; s += (v[j].x + v[j].y) + (v[j].z + v[j].w); }
    const float mean = wave_sum(s) * (1.f / DM); float s2 = 0.f;
#pragma unroll
    for (int j = 0; j < 4; ++j) { v[j] = v[j] - mean; s2 += (v[j].x * v[j].x + v[j].y * v[j].y) + (v[j].z * v[j].z + v[j].w * v[j].w); }
    const float rstd = 1.f / sqrtf(wave_sum(s2) * (1.f / DM) + LN_EPS);
    if (stat && lane == 0) { stat[0] = mean; stat[1] = rstd; }
    u32x2* o8 = (u32x2*)orow + lane;
#pragma unroll
    for (int j = 0; j < 4; ++j) { const int col = 4 * lane + 256 * j;
        const f32x4 gg = *(const f32x4*)(g + col), bb = *(const f32x4*)(b + col), shv = *(const f32x4*)(sh + col), scv = *(const f32x4*)(sc + col);
        f32x4 y = (v[j] * rstd) * gg + bb; y = y * (1.0f + scv) + shv;
        u32x2 w; w.x = pk2(y.x, y.y); w.y = pk2(y.z, y.w); o8[64 * j] = w; }
}
__device__ __forceinline__ void phase_prologue_b(const P& p, int bid, int nblk) {
    const int tid = tid_opaque(), wave = tid >> 6, lane = tid & 63;
    const int gw = bid * 8 + wave, ngw = nblk * 8;
    const float* mod = (const float*)(p.ws + WS_MOD);
    for (int row = gw; row < NTOK + NCTX; row += ngw) {
        if (row < NTOK) { const int b = row >> 12;
            ln_mod_row(p.x + (size_t)row * DM, p.ln_x_g, p.ln_x_b, mod + b * 6144, mod + b * 6144 + 1024, (bf16_t*)(p.ws + WS_U) + (size_t)row * DM, (float*)(p.ws + WS_ROWSTAT) + 2 * row, lane);
        } else { const int r = row - NTOK;
            ln_mod_row(p.ctx + (size_t)r * DM, p.ln_ctx_g, p.ln_ctx_b, mod + 8 * 6144, mod + 8 * 6144 + 1024, (bf16_t*)(p.ws + WS_UC) + (size_t)r * DM, nullptr, lane); }
    }
}

template <class ARow, class BRow, class Epi>
__device__ __forceinline__ void sgemm_wave_tile(int r0, int n0, int K, const ARow& arow, const BRow& brow, const Epi& epi, int lane) {
    const int fr = lane & 15, fq = lane >> 4;
    f32x4 acc[2][2];
#pragma unroll
    for (int a = 0; a < 2; ++a)
#pragma unroll
        for (int b = 0; b < 2; ++b) acc[a][b] = (f32x4){0.f, 0.f, 0.f, 0.f};
    const bf16_t* ap[2]; const bf16_t* bp[2];
#pragma unroll
    for (int a = 0; a < 2; ++a) { ap[a] = arow(r0 + 16 * a + fr) + 8 * fq; bp[a] = brow(n0 + 16 * a + fr) + 8 * fq; }
    for (int k0 = 0; k0 < K; k0 += 32) {
        bf16x8 af[2], bfr[2];
#pragma unroll
        for (int a = 0; a < 2; ++a) { af[a] = *(const bf16x8*)(ap[a] + k0); bfr[a] = *(const bf16x8*)(bp[a] + k0); }
#pragma unroll
        for (int a = 0; a < 2; ++a)
#pragma unroll
            for (int b = 0; b < 2; ++b) acc[a][b] = __builtin_amdgcn_mfma_f32_16x16x32_bf16(af[a], bfr[b], acc[a][b], 0, 0, 0);
    }
#pragma unroll
    for (int a = 0; a < 2; ++a)
#pragma unroll
        for (int b = 0; b < 2; ++b)
#pragma unroll
            for (int i = 0; i < 4; ++i) epi(r0 + 16 * a + 4 * fq + i, n0 + 16 * b + fr, acc[a][b][i]);
}

struct ARowDense { const bf16_t* A; int lda; __device__ __forceinline__ const bf16_t* operator()(int r) const { return A + (size_t)r * lda; } };
struct EpiProj {
    const float* b_in; bf16_t *ZU, *ZVT, *Q, *K, *VT, *G;
    __device__ __forceinline__ void operator()(int r, int n, float v) const {
        v += b_in[n];
        if (n < 1024) ZU[(size_t)r * 1024 + n] = (bf16_t)f2bf(gelu_exact(v));
        else if (n < 2048) ZVT[(size_t)(n - 1024) * NTOK + r] = (bf16_t)f2bf(gelu_exact(v));
        else if (n < 3072) Q[(size_t)r * 1024 + (n - 2048)] = (bf16_t)f2bf(v);
        else if (n < 4096) K[(size_t)r * 1024 + (n - 3072)] = (bf16_t)f2bf(v);
        else if (n < 5120) VT[(size_t)(n - 4096) * NTOK + r] = (bf16_t)f2bf(v);
        else G[(size_t)r * 2048 + (n - 5120)] = (bf16_t)f2bf(sigmoidf_(v));
    }
};
__device__ __forceinline__ void phase_proj_s(const P& p, int bid, int nblk) {
    const int tid_ = tid_opaque(); const int wave = tid_ >> 6, lane = tid_ & 63; unsigned char* ws = p.ws;
    ARowDense ar{(const bf16_t*)(ws + WS_U), 1024}, br{(const bf16_t*)(ws + WS_WIN), 1024};
    EpiProj e{p.b_in, (bf16_t*)(ws + WS_ZU), (bf16_t*)(ws + WS_ZVT), (bf16_t*)(ws + WS_Q), (bf16_t*)(ws + WS_K), (bf16_t*)(ws + WS_VT), (bf16_t*)(ws + WS_G)};
    const int ntn = INW / 32, ntiles = (NTOK / 32) * ntn;
    for (int t = bid * 8 + wave; t < ntiles; t += nblk * 8) sgemm_wave_tile((t / ntn) * 32, (t % ntn) * 32, 1024, ar, br, e, lane);
}
struct EpiCtxKV {
    const float* b_in; bf16_t *KC, *VCT;
    __device__ __forceinline__ void operator()(int r, int n, float v) const {
        v += b_in[3072 + n];
        if (n < 1024) KC[(size_t)r * 1024 + n] = (bf16_t)f2bf(v); else VCT[(size_t)(n - 1024) * NCTX + r] = (bf16_t)f2bf(v);
    }
};
__device__ __forceinline__ void phase_ctxkv_s(const P& p, int bid, int nblk) {
    const int tid_ = tid_opaque(); const int wave = tid_ >> 6, lane = tid_ & 63; unsigned char* ws = p.ws;
    ARowDense ar{(const bf16_t*)(ws + WS_UC), 1024}, br{(const bf16_t*)(ws + WS_WIN) + (size_t)3072 * 1024, 1024};
    EpiCtxKV e{p.b_in, (bf16_t*)(ws + WS_KC), (bf16_t*)(ws + WS_VCT)};
    const int ntn = 2048 / 32, ntiles = (NCTX / 32) * ntn;
    for (int t = bid * 8 + wave; t < ntiles; t += nblk * 8) sgemm_wave_tile((t / ntn) * 32, (t % ntn) * 32, 1024, ar, br, e, lane);
}
__device__ __forceinline__ void phase_rope_s(const P& p, int bid, int nblk) {
    bf16_t* K = (bf16_t*)(p.ws + WS_K); const float* tab = (const float*)(p.ws + WS_ROPE);
    const size_t total = (size_t)NTOK * NHEAD * 32;
    const int tid_ = tid_opaque();
    for (size_t i = (size_t)bid * 512 + tid_; i < total; i += (size_t)nblk * 512) {
        const int pi = (int)(i & 31), h = (int)((i >> 5) & 15), t = (int)(i >> 9);
        const int pos = t & 4095, axis = pi >> 4, fi = pi & 15, ps = axis ? (pos & 63) : (pos >> 6);
        const float cs = tab[2 * (ps * 16 + fi)], sn = tab[2 * (ps * 16 + fi) + 1];
        bf16_t* base = K + (size_t)t * 1024 + h * 64 + axis * 32 + fi;
        const float x1 = bf2f(base[0]), x2 = bf2f(base[16]);
        base[0] = (bf16_t)f2bf(x1 * cs - x2 * sn); base[16] = (bf16_t)f2bf(x2 * cs + x1 * sn);
    }
}
__device__ __forceinline__ void phase_zstat_s(const P& p, int bid, int nblk) {
    const bf16_t* ZVT = (const bf16_t*)(p.ws + WS_ZVT); float* zs = (float*)(p.ws + WS_ZSTAT);
    const int tid_ = tid_opaque();
    for (int t = bid * 512 + tid_; t < NTOK; t += nblk * 512) {
        float s = 0.f, s2 = 0.f;
        for (int c = 0; c < 1024; ++c) { const float v = bf2f(ZVT[(size_t)c * NTOK + t]); s += v; s2 += v * v; }
        const float mean = s * (1.f / 1024.f); const float var = fmaxf(s2 * (1.f / 1024.f) - mean * mean, 0.f);
        zs[2 * t] = mean; zs[2 * t + 1] = 1.f / sqrtf(var + LN_EPS);
    }
}
__device__ __forceinline__ void phase_gmlp_s(const P& p, int bid, int nblk, unsigned char* lds) {
    float* zvn = (float*)lds;
    float* wsm = zvn + 128 * 128;
    const bf16_t* ZVT = (const bf16_t*)(p.ws + WS_ZVT); const bf16_t* ZU = (const bf16_t*)(p.ws + WS_ZU); const float* zs = (const float*)(p.ws + WS_ZSTAT);
    bf16_t* YA = (bf16_t*)(p.ws + WS_U);
    const int tid = tid_opaque();
    for (int item = bid; item < (NTOK / 128) * 8; item += nblk) {
        const int chunk = item >> 3, g = item & 7, tok0 = chunk * 128;
        __syncthreads();
        for (int i = tid; i < 128 * 128; i += 512) { const int c = i >> 7, q = i & 127; const int ch = g * 128 + c;
            const float v = bf2f(ZVT[(size_t)ch * NTOK + tok0 + q]);
            zvn[q * 128 + c] = (v - zs[2 * (tok0 + q)]) * zs[2 * (tok0 + q) + 1] * p.gmlp_ln_g[ch] + p.gmlp_ln_b[ch];
            wsm[i] = p.gmlp_ws[g * 16384 + i]; }
        __syncthreads();
        const int c = tid & 127, pq = tid >> 7;
        for (int pp = 0; pp < 32; ++pp) { const int pr = pq * 32 + pp; float acc = 0.f;
            for (int q = 0; q < 128; ++q) acc += wsm[pr * 128 + q] * zvn[q * 128 + c];
            acc += p.gmlp_bs[g * 128 + pr];
            const size_t o = (size_t)(tok0 + pr) * 1024 + g * 128 + c;
            YA[o] = (bf16_t)f2bf(bf2f(ZU[o]) * acc); }
    }
}
__device__ __forceinline__ bf16x8 pack8(const float (&v)[8]) { u32x4 w; w.x = pk2(v[0], v[1]); w.y = pk2(v[2], v[3]); w.z = pk2(v[4], v[5]); w.w = pk2(v[6], v[7]); return __builtin_bit_cast(bf16x8, w); }
__device__ __forceinline__ void phase_gmlp_fast(const P& p, int bid, int nblk, unsigned char* lds) {
    const int tid = tid_opaque(), g = tid >> 6, lane = tid & 63, fr = lane & 15, fq = lane >> 4;
    float* part = (float*)lds;
    float* stat = part + 8 * 128 * 2;
    const bf16_t* ZVT = (const bf16_t*)(p.ws + WS_ZVT); const bf16_t* ZU = (const bf16_t*)(p.ws + WS_ZU); const bf16_t* WSB = (const bf16_t*)(p.ws + WS_WSB);
    bf16_t* YA = (bf16_t*)(p.ws + WS_U);
    for (int chunk = bid; chunk < NTOK / 128; chunk += nblk) {
        const int tok0 = chunk * 128;
        __syncthreads();
        { float s1[8], s2[8];
#pragma unroll
          for (int jj = 0; jj < 8; ++jj) { s1[jj] = 0.f; s2[jj] = 0.f; }
          const bf16_t* zp = ZVT + (((size_t)(tok0 >> 3) + fr) * 1024 + 128 * g + fq) * 8;
#pragma unroll 8
          for (int it = 0; it < 32; ++it) { const bf16x8 v = *(const bf16x8*)(zp + (4 * it) * 8);
#pragma unroll
              for (int jj = 0; jj < 8; ++jj) { const float f = bf2f((unsigned)(unsigned short)v[jj]); s1[jj] += f; s2[jj] += f * f; } }
#pragma unroll
          for (int jj = 0; jj < 8; ++jj) { s1[jj] += __shfl_xor(s1[jj], 16); s1[jj] += __shfl_xor(s1[jj], 32); s2[jj] += __shfl_xor(s2[jj], 16); s2[jj] += __shfl_xor(s2[jj], 32); }
          if (fq == 0) {
#pragma unroll
              for (int jj = 0; jj < 8; ++jj) { part[(g * 128 + 8 * fr + jj) * 2] = s1[jj]; part[(g * 128 + 8 * fr + jj) * 2 + 1] = s2[jj]; } } }
        __syncthreads();
        if (tid < 128) { float a = 0.f, b = 0.f;
#pragma unroll
            for (int w = 0; w < 8; ++w) { a += part[(w * 128 + tid) * 2]; b += part[(w * 128 + tid) * 2 + 1]; }
            const float mean = a * (1.f / 1024.f), var = fmaxf(b * (1.f / 1024.f) - mean * mean, 0.f);
            stat[2 * tid] = mean; stat[2 * tid + 1] = 1.f / sqrtf(var + LN_EPS); }
        __syncthreads();
#pragma unroll 1
        for (int ph = 0; ph < 2; ++ph) {
            bf16x8 wf[4][4]; float t1[4], t2[4], bsv[4];
#pragma unroll
            for (int pt = 0; pt < 4; ++pt) { const int pp = 64 * ph + 16 * pt + fr; float t1a = 0.f, t2a = 0.f;
                const __attribute__((address_space(3))) float* stat3 = (const __attribute__((address_space(3))) float*)((const __attribute__((address_space(3))) unsigned char*)lds + 8 * 128 * 2 * 4);
                int so = 16 * fq; asm volatile("" : "+v"(so));
#pragma unroll
                for (int ks = 0; ks < 4; ++ks) { const bf16x8 w = *(const bf16x8*)(WSB + ((size_t)g * 128 + pp) * 128 + 32 * ks + 8 * fq);
                    float wv[8];
#pragma unroll
                    for (int jj = 0; jj < 8; ++jj) { const float w0 = bf2f((unsigned)(unsigned short)w[jj]); t2a += w0; wv[jj] = w0 * stat3[so + 2 * (32 * ks + jj) + 1]; }
                    const bf16x8 wp = pack8(wv); wf[pt][ks] = wp;
#pragma unroll
                    for (int jj = 0; jj < 8; ++jj) t1a += bf2f((unsigned)(unsigned short)wp[jj]) * stat3[so + 2 * (32 * ks + jj)]; }
                t1a += __shfl_xor(t1a, 16); t1a += __shfl_xor(t1a, 32); t2a += __shfl_xor(t2a, 16); t2a += __shfl_xor(t2a, 32);
                t1[pt] = t1a; t2[pt] = t2a; bsv[pt] = p.gmlp_bs[g * 128 + pp]; }
            bf16x8 afn[4];
            { const bf16_t* zp = ZVT + (((size_t)(tok0 >> 3) + fq) * 1024 + 128 * g + fr) * 8;
#pragma unroll
              for (int ks = 0; ks < 4; ++ks) afn[ks] = *(const bf16x8*)(zp + (size_t)ks * 4 * 1024 * 8); }
#pragma unroll 1
            for (int ct = 0; ct < 8; ++ct) {
                bf16x8 af[4];
#pragma unroll
                for (int ks = 0; ks < 4; ++ks) af[ks] = afn[ks];
                if (ct + 1 < 8) { const bf16_t* zp = ZVT + (((size_t)(tok0 >> 3) + fq) * 1024 + 128 * g + 16 * (ct + 1) + fr) * 8;
#pragma unroll
                    for (int ks = 0; ks < 4; ++ks) afn[ks] = *(const bf16x8*)(zp + (size_t)ks * 4 * 1024 * 8); }
                const int c = 128 * g + 16 * ct + 4 * fq;
                u32x2 zuv[4];
#pragma unroll
                for (int pt = 0; pt < 4; ++pt) zuv[pt] = *(const u32x2*)(ZU + (size_t)(tok0 + 64 * ph + 16 * pt + fr) * 1024 + c);
                f32x4 acc[4];
#pragma unroll
                for (int pt = 0; pt < 4; ++pt) { acc[pt] = (f32x4){0.f, 0.f, 0.f, 0.f};
#pragma unroll
                    for (int ks = 0; ks < 4; ++ks) acc[pt] = __builtin_amdgcn_mfma_f32_16x16x32_bf16(af[ks], wf[pt][ks], acc[pt], 0, 0, 0); }
                const f32x4 gc = *(const f32x4*)(p.gmlp_ln_g + c), bc = *(const f32x4*)(p.gmlp_ln_b + c);
#pragma unroll
                for (int pt = 0; pt < 4; ++pt) { const size_t off = (size_t)(tok0 + 64 * ph + 16 * pt + fr) * 1024 + c;
                    const u32x2 zu = zuv[pt];
                    const f32x4 s = gc * (acc[pt] - t1[pt]) + bc * t2[pt] + bsv[pt];
                    u32x2 w; w.x = pk2(bflo(zu.x) * s[0], bfhi(zu.x) * s[1]); w.y = pk2(bflo(zu.y) * s[2], bfhi(zu.y) * s[3]);
                    *(u32x2*)(YA + off) = w; }
            }
        }
    }
}
constexpr int AT_LDS_RPB = 0, AT_LDS_KC = 4096, AT_LDS_VC = AT_LDS_KC + 32768, AT_LDS_END = AT_LDS_VC + 32768;
typedef __attribute__((address_space(3))) const unsigned char* lds_cp;
__device__ __forceinline__ void attn_stage(const P& p, unsigned char* lds, int b, int h, int tid) {
    float* tbl = (float*)(lds + AT_LDS_RPB);
    for (int idx = tid; idx < 15 * 64; idx += 512) { const int dr = idx >> 6, cc = idx & 63; tbl[idx] = (cc >= 16 && cc < 47) ? p.na_rpb[(h * 15 + dr) * 31 + cc - 16] : 0.f; }
    const size_t bh = (size_t)b * 16 + h;
    const u32x4* kc = (const u32x4*)((const bf16_t*)(p.ws + WS_KC) + bh * 256 * 64); const u32x4* vc = (const u32x4*)((const bf16_t*)(p.ws + WS_VCT) + bh * 32 * 512);
#pragma unroll
    for (int i = 0; i < 4; ++i) { const int q = tid + 512 * i, key = q >> 3, c = q & 7; const int fk = ((key >> 1) & 1) | (((key >> 3) & 1) << 1) | (((key >> 4) & 1) << 2);
        *(u32x4*)(lds + AT_LDS_KC + key * 128 + ((c ^ fk) << 4)) = kc[q]; *(u32x4*)(lds + AT_LDS_VC + q * 16) = vc[q]; }
}
struct AttnTile { bf16x8 qpl[2], qrt[2]; f32x4 o[4]; float m, l; };
__device__ __forceinline__ void attn_tile_init(const P& p, AttnTile& T, size_t bh, int r, int qc, int fq) {
    const bf16_t* Q = (const bf16_t*)(p.ws + WS_Q); const float* tab = (const float*)(p.ws + WS_ROPE);
#pragma unroll
    for (int s = 0; s < 2; ++s) {
        const bf16_t* qb = Q + (bh * 4096 + r * 64 + qc) * 64 + 32 * s;
        const bf16x8 me = *(const bf16x8*)(qb + 8 * fq), ot = *(const bf16x8*)(qb + 8 * (fq ^ 2));
        T.qpl[s] = me;
        const int pos = s ? qc : r; const float* tb = tab + (pos * 16 + 8 * (fq & 1)) * 2;
        float rot[8];
#pragma unroll
        for (int jj = 0; jj < 8; ++jj) { const float cv = tb[2 * jj], sv = tb[2 * jj + 1];
            const float xv = bf2f((unsigned)(unsigned short)me[jj]), ov = bf2f((unsigned)(unsigned short)ot[jj]);
            rot[jj] = (fq < 2) ? (xv * cv - ov * sv) : (xv * cv + ov * sv); }
        T.qrt[s] = pack8(rot);
    }
#pragma unroll
    for (int dt = 0; dt < 4; ++dt) T.o[dt] = (f32x4){0.f, 0.f, 0.f, 0.f};
    T.m = -INFINITY; T.l = 0.f;
}
__device__ __forceinline__ void attn_tile_step(AttnTile& T, float (&sv)[8], const bf16x8 (&vf)[4]) {
    float smax = fmaxf(fmaxf(fmaxf(sv[0], sv[1]), fmaxf(sv[2], sv[3])), fmaxf(fmaxf(sv[4], sv[5]), fmaxf(sv[6], sv[7])));
    smax = fmaxf(smax, __shfl_xor(smax, 16)); smax = fmaxf(smax, __shfl_xor(smax, 32));
    if (__any(smax > T.m + 8.0f)) {
        const float mn = fmaxf(T.m, smax), al = __builtin_amdgcn_exp2f((T.m - mn) * 1.4426950408889634f);
        T.l *= al;
#pragma unroll
        for (int dt = 0; dt < 4; ++dt) T.o[dt] = T.o[dt] * al;
        T.m = mn; }
    const float ml2 = T.m * 1.4426950408889634f;
    float pv[8];
#pragma unroll
    for (int e = 0; e < 8; ++e) { pv[e] = __builtin_amdgcn_exp2f(sv[e] * 1.4426950408889634f - ml2); T.l += pv[e]; }
    const bf16x8 pf = pack8(pv);
#pragma unroll
    for (int dt = 0; dt < 4; ++dt) T.o[dt] = __builtin_amdgcn_mfma_f32_16x16x32_bf16(vf[dt], pf, T.o[dt], 0, 0, 0);
}
__device__ __forceinline__ void attn_pair_unit(const P& p, unsigned char* lds, int b, int r, int j, int h, int lane) {
    const int fr = lane & 15, fq = lane >> 4;
    const bf16_t* K = (const bf16_t*)(p.ws + WS_K); const bf16_t* VT = (const bf16_t*)(p.ws + WS_VT); bf16_t* YB = (bf16_t*)(p.ws + WS_YB);
    const int qc = 16 * j + fr; const size_t bh = (size_t)b * 16 + h;
    const int r0A = min(max(r - 4, 0), 56), r0B = min(max(r + 1 - 4, 0), 56), nst = r0B + 8 - r0A;
    const int c0 = min(max(qc - 8, 0), 48), cs = min(max(16 * j - 8, 0), 32);
    const int sp0 = 8 * (fr >> 2) + (fr & 3);
    const bf16_t* klat = K + (bh * 4096 + r0A * 64 + cs + sp0) * 64 + 8 * fq;
    const bf16_t* vlat = VT + ((bh * 512 + ((r0A * 64 + cs) >> 3) + fq) * 64 + fr) * 8;
    const int fk = ((fr >> 1) & 1) | (((fr >> 2) & 1) << 1) | (((fr >> 3) & 1) << 2);
    const lds_cp kcl = (lds_cp)lds + AT_LDS_KC + sp0 * 128;
    const int kco0 = (fq ^ fk) << 4, kco1 = ((fq + 4) ^ fk) << 4;
    const lds_cp vcl = (lds_cp)lds + AT_LDS_VC + (fq * 64 + fr) * 16;
    const __attribute__((address_space(3))) float* tbl3 = (const __attribute__((address_space(3))) float*)((lds_cp)lds + AT_LDS_RPB);
    const int boffA = (r0A - r + 7) * 64 + (cs + 8 * fq - qc + 31);
    unsigned cmask = 0;
#pragma unroll
    for (int jj = 0; jj < 8; ++jj) { const int kc = cs + 8 * fq + jj; if (kc >= c0 && kc < c0 + 16) cmask |= 1u << jj; }
    AttnTile TA, TB;
    attn_tile_init(p, TA, bh, r, qc, fq); attn_tile_init(p, TB, bh, r + 1, qc, fq);
    bf16x8 kf[2][2][2], vf[2][4];
#define LOADKV(buf, st_) do { _Pragma("unroll") for (int t = 0; t < 2; ++t) { const bf16_t* kp_ = klat + (size_t)(st_) * 64 * 64 + t * 4 * 64; kf[buf][t][0] = *(const bf16x8*)kp_; kf[buf][t][1] = *(const bf16x8*)(kp_ + 32); } \
        _Pragma("unroll") for (int dt = 0; dt < 4; ++dt) vf[buf][dt] = *(const bf16x8*)(vlat + dt * 128 + (st_) * 8 * 512); } while (0)
#define SCORES(T, buf, sv, boff_, rowok) do { _Pragma("unroll") for (int t = 0; t < 2; ++t) { \
        f32x4 d_ = __builtin_amdgcn_mfma_f32_16x16x32_bf16(kf[buf][t][0], T.qrt[0], (f32x4){0.f, 0.f, 0.f, 0.f}, 0, 0, 0); \
        d_ = __builtin_amdgcn_mfma_f32_16x16x32_bf16(kf[buf][t][1], T.qrt[1], d_, 0, 0, 0); \
        _Pragma("unroll") for (int i = 0; i < 4; ++i) { const int jj_ = 4 * t + i; const float bias_ = tbl3[(boff_) + jj_]; \
            sv[jj_] = ((rowok) && ((cmask >> jj_) & 1u)) ? (d_[i] * 0.125f + bias_) : -INFINITY; } } } while (0)
    LOADKV(0, 0);
#pragma unroll 1
    for (int st = 0; st < nst; st += 2) {
        if (st + 1 < nst) LOADKV(1, st + 1);
        { const int kr = r0A + st; int bo = boffA + st * 64; asm volatile("" : "+v"(bo));
          if (kr <= r0A + 7) { float sv[8]; SCORES(TA, 0, sv, bo, true); attn_tile_step(TA, sv, vf[0]); }
          if (kr >= r0B) { float sv[8]; SCORES(TB, 0, sv, bo - 64, true); attn_tile_step(TB, sv, vf[0]); } }
        if (st + 1 < nst) {
            if (st + 2 < nst) LOADKV(0, st + 2);
            const int kr = r0A + st + 1; int bo = boffA + (st + 1) * 64; asm volatile("" : "+v"(bo));
            if (kr <= r0A + 7) { float sv[8]; SCORES(TA, 1, sv, bo, true); attn_tile_step(TA, sv, vf[1]); }
            if (kr >= r0B) { float sv[8]; SCORES(TB, 1, sv, bo - 64, true); attn_tile_step(TB, sv, vf[1]); } }
    }
#undef LOADKV
#undef SCORES
#pragma unroll 1
    for (int st = 0; st < 8; ++st) {
        bf16x8 kc[2][2], vc[4];
#pragma unroll
        for (int t = 0; t < 2; ++t) { const lds_cp kp_ = kcl + (32 * st + 4 * t) * 128; kc[t][0] = *(const __attribute__((address_space(3))) bf16x8*)(kp_ + kco0); kc[t][1] = *(const __attribute__((address_space(3))) bf16x8*)(kp_ + kco1); }
#pragma unroll
        for (int dt = 0; dt < 4; ++dt) vc[dt] = *(const __attribute__((address_space(3))) bf16x8*)(vcl + st * 4096 + dt * 256);
#define CSCORES(T, sv) do { _Pragma("unroll") for (int t = 0; t < 2; ++t) { \
        f32x4 d_ = __builtin_amdgcn_mfma_f32_16x16x32_bf16(kc[t][0], T.qpl[0], (f32x4){0.f, 0.f, 0.f, 0.f}, 0, 0, 0); \
        d_ = __builtin_amdgcn_mfma_f32_16x16x32_bf16(kc[t][1], T.qpl[1], d_, 0, 0, 0); \
        _Pragma("unroll") for (int i = 0; i < 4; ++i) sv[4 * t + i] = d_[i] * 0.125f; } } while (0)
        { float sv[8]; CSCORES(TA, sv); attn_tile_step(TA, sv, vc); }
        { float sv[8]; CSCORES(TB, sv); attn_tile_step(TB, sv, vc); }
#undef CSCORES
    }
#pragma unroll
    for (int w = 0; w < 2; ++w) { AttnTile& T = w ? TB : TA;
        float l = T.l; l += __shfl_xor(l, 16); l += __shfl_xor(l, 32);
        const float inv = 1.0f / l; const size_t tq = (size_t)b * SEQ + (r + w) * 64 + qc;
#pragma unroll
        for (int dt = 0; dt < 4; ++dt) { u32x2 ww; ww.x = pk2(T.o[dt][0] * inv, T.o[dt][1] * inv); ww.y = pk2(T.o[dt][2] * inv, T.o[dt][3] * inv);
            *(u32x2*)(YB + tq * 1024 + h * 64 + 16 * dt + 4 * fq) = ww; } }
}
__device__ __forceinline__ void phase_attn_s(const P& p, int bid, int nblk, unsigned char* lds) {
    const int tid_ = tid_opaque(); const int wave = tid_ >> 6, lane = tid_ & 63;
    float* cscr = (float*)(lds + AT_LDS_END) + wave * (64 * 33 + 32);
    for (int vb = bid; vb < 256; vb += nblk) { const int half = vb & 1, h = (vb >> 1) & 15, b = vb >> 5;
        __syncthreads();
        attn_stage(p, lds, b, h, tid_);
        __syncthreads();
#pragma unroll 1
        for (int it = 0; it < 16; ++it) { int lane_o = lane; asm volatile("" : "+v"(lane_o));
            if ((it & 1) == 0) attn_pair_unit(p, lds, b, 32 * half + 2 * it + 2 * (wave >> 2), wave & 3, h, lane_o);
            const int gw = vb * 8 + wave;
            for (int k = it; k * 2048 + gw < IT_W1 + IT_W2; k += 16) convert_item(p, IT_EXP0 + k * 2048 + gw, cscr, lane_o); }
    }
}
struct EpiMergeA { const bf16_t* G; bf16_t* INNER;
    __device__ __forceinline__ void operator()(int r, int n, float v) const { INNER[(size_t)r * 1024 + n] = (bf16_t)f2bf(bf2f(G[(size_t)r * 2048 + n]) * v); } };
struct EpiMergeB { const bf16_t* G; bf16_t* INNER;
    __device__ __forceinline__ void operator()(int r, int n, float v) const { const size_t o = (size_t)r * 1024 + n; INNER[o] = (bf16_t)f2bf(bf2f(INNER[o]) + bf2f(G[(size_t)r * 2048 + 1024 + n]) * v); } };
template <int WHICH> __device__ __forceinline__ void phase_merge_s(const P& p, int bid, int nblk) {
    const int tid_ = tid_opaque(); const int wave = tid_ >> 6, lane = tid_ & 63; unsigned char* ws = p.ws;
    const int ntn = 1024 / 32, ntiles = (NTOK / 32) * ntn;
    if (WHICH == 0) { ARowDense ar{(const bf16_t*)(ws + WS_U), 1024}, br{(const bf16_t*)(ws + WS_WPA), 1024}; EpiMergeA e{(const bf16_t*)(ws + WS_G), (bf16_t*)(ws + WS_INNER)};
        for (int t = bid * 8 + wave; t < ntiles; t += nblk * 8) sgemm_wave_tile((t / ntn) * 32, (t % ntn) * 32, 1024, ar, br, e, lane);
    } else { ARowDense ar{(const bf16_t*)(ws + WS_YB), 1024}, br{(const bf16_t*)(ws + WS_WPB), 1024}; EpiMergeB e{(const bf16_t*)(ws + WS_G), (bf16_t*)(ws + WS_INNER)};
        for (int t = bid * 8 + wave; t < ntiles; t += nblk * 8) sgemm_wave_tile((t / ntn) * 32, (t % ntn) * 32, 1024, ar, br, e, lane); }
}
struct EpiMix { const float *x, *rowstat, *lng, *lnb, *mod, *b_out; float* out;
    __device__ __forceinline__ void operator()(int r, int n, float v) const {
        const int b = r >> 12; const float x0 = (x[(size_t)r * 1024 + n] - rowstat[2 * r]) * rowstat[2 * r + 1] * lng[n] + lnb[n];
        out[(size_t)r * 1024 + n] = ALPHA * x0 + mod[b * 6144 + 2048 + n] * (v + b_out[n]); } };
__device__ __forceinline__ void phase_mix_s(const P& p, int bid, int nblk) {
    const int tid_ = tid_opaque(); const int wave = tid_ >> 6, lane = tid_ & 63; unsigned char* ws = p.ws;
    const int ntn = 1024 / 32, ntiles = (NTOK / 32) * ntn;
    ARowDense ar{(const bf16_t*)(ws + WS_INNER), 1024}, br{(const bf16_t*)(ws + WS_WOUT), 1024};
    EpiMix e{p.x, (const float*)(ws + WS_ROWSTAT), p.ln_x_g, p.ln_x_b, (const float*)(ws + WS_MOD), p.b_out, p.out};
    for (int t = bid * 8 + wave; t < ntiles; t += nblk * 8) sgemm_wave_tile((t / ntn) * 32, (t % ntn) * 32, 1024, ar, br, e, lane);
}

constexpr int RT_LDS_W = 0, RT_LDS_CNT = 131072, RT_LDS_BASE = RT_LDS_CNT + 128, RT_LDS_REC = RT_LDS_BASE + 128, RT_MAXIT = 32, RT_LDS_END = RT_LDS_REC + 8 * RT_MAXIT * 8 * 4;
__device__ __forceinline__ int rw_off(int prow, int ch) { return prow * 128 + ((ch ^ ((prow >> 1) & 7)) << 4); }
__device__ __forceinline__ void phase_router(const P& p, int bid, int nblk, unsigned char* lds) {
    const int tid = tid_opaque(), wave = tid >> 6, lane = tid & 63;
    int* cnt = (int*)(lds + RT_LDS_CNT); int* base = (int*)(lds + RT_LDS_BASE); int* rec = (int*)(lds + RT_LDS_REC) + wave * RT_MAXIT * 8;
    for (int k = tid; k < 1024; k += 512) { const int l = (k & 255) >> 2, i = k & 3, j = k >> 8, prow = l + 64 * (4 * j + i);
        const f32x4* src = (const f32x4*)(p.router_w + (size_t)k * 32);
#pragma unroll
        for (int ch = 0; ch < 8; ++ch) *(f32x4*)(lds + RT_LDS_W + rw_off(prow, ch)) = src[ch]; }
    if (tid < 32) cnt[tid] = 0;
    __syncthreads();
    const float* mod = (const float*)(p.ws + WS_MOD);
    int* TOPE = (int*)(p.ws + WS_TOPE); float* TOPG = (float*)(p.ws + WS_TOPG); int* SLOT = (int*)(p.ws + WS_SLOT);
    unsigned char* U2 = p.ws + WS_U;
    const int erev = 16 * ((lane >> 4) & 1) + (int)(__builtin_bitreverse32((unsigned)(lane & 15)) >> 28);
    unsigned wb[8];
#pragma unroll
    for (int ch = 0; ch < 8; ++ch) wb[ch] = RT_LDS_W + lane * 128 + ((ch ^ ((lane >> 1) & 7)) << 4);
    int it = 0;
    u32x2 pre[4];
    { const int row0 = bid * 8 + wave; if (row0 < NTOK) { const u32x2* xin0 = (const u32x2*)((const bf16_t*)(p.ws + WS_X1PRE) + (size_t)row0 * DM) + lane;
#pragma unroll
        for (int j = 0; j < 4; ++j) pre[j] = xin0[64 * j]; } }
    for (int row = bid * 8 + wave; row < NTOK; row += nblk * 8, ++it) {
        const int b = row >> 12;
        u32x2* xr = (u32x2*)((bf16_t*)(p.ws + WS_X1) + (size_t)row * DM) + lane;
        f32x4 v[4]; float s = 0.f;
#pragma unroll
        for (int j = 0; j < 4; ++j) { const u32x2 w = pre[j]; v[j] = (f32x4){bflo(w.x), bfhi(w.x), bflo(w.y), bfhi(w.y)}; s += (v[j].x + v[j].y) + (v[j].z + v[j].w); }
        { const int rown = row + nblk * 8; if (rown < NTOK) { const u32x2* xinn = (const u32x2*)((const bf16_t*)(p.ws + WS_X1PRE) + (size_t)rown * DM) + lane;
#pragma unroll
            for (int j = 0; j < 4; ++j) pre[j] = xinn[64 * j]; } }
        const float mean = wave_sum(s) * (1.f / DM); float s2 = 0.f;
#pragma unroll
        for (int j = 0; j < 4; ++j) { v[j] = v[j] - mean; s2 += (v[j].x * v[j].x + v[j].y * v[j].y) + (v[j].z * v[j].z + v[j].w * v[j].w); }
        const float rstd = 1.f / sqrtf(wave_sum(s2) * (1.f / DM) + LN_EPS);
        unsigned* o8 = (unsigned*)(U2 + (size_t)row * DM) + lane;
        int lane_o = lane; asm volatile("" : "+v"(lane_o));
        f32x4 u[4];
#pragma unroll
        for (int j = 0; j < 4; ++j) { const int col = 4 * lane_o + 256 * j;
            const f32x4 gg = *(const f32x4*)(p.ln1_g + col), bb = *(const f32x4*)(p.ln1_b + col);
            const f32x4 shv = *(const f32x4*)(mod + b * 6144 + 3072 + col), scv = *(const f32x4*)(mod + b * 6144 + 4096 + col);
            const f32x4 x1 = (v[j] * rstd) * gg + bb; { u32x2 w; w.x = pk2(x1.x, x1.y); w.y = pk2(x1.z, x1.w); xr[64 * j] = w; }
            u[j] = x1 * (1.0f + scv) + shv;
            int w = 0; w = __builtin_amdgcn_cvt_pk_fp8_f32(u[j].x, u[j].y, w, false); w = __builtin_amdgcn_cvt_pk_fp8_f32(u[j].z, u[j].w, w, true); o8[64 * j] = (unsigned)w; }
        float lg2[2];
#pragma unroll
        for (int hf = 0; hf < 2; ++hf) {
            float a[16];
#pragma unroll
            for (int e = 0; e < 16; ++e) a[e] = 0.f;
#pragma unroll
            for (int j = 0; j < 4; ++j)
#pragma unroll
                for (int i = 0; i < 4; ++i) { const float uv = u[j][i];
#pragma unroll
                    for (int ch = 0; ch < 4; ++ch) { const f32x4 w4 = *(const f32x4*)(lds + wb[4 * hf + ch] + (4 * j + i) * 8192);
                        a[4 * ch + 0] += uv * w4.x; a[4 * ch + 1] += uv * w4.y; a[4 * ch + 2] += uv * w4.z; a[4 * ch + 3] += uv * w4.w; } }
#pragma unroll
            for (int st = 0; st < 4; ++st) { const int n = 8 >> st; const bool up = (lane >> st) & 1;
#pragma unroll
                for (int i = 0; i < n; ++i) { float lo = a[i], hi = a[n + i]; asm volatile("" : "+v"(lo), "+v"(hi));
                    const float keep = up ? hi : lo, send = up ? lo : hi; a[i] = keep + __shfl_xor(send, 1 << st); } }
            float r = a[0]; r += __shfl_xor(r, 16); r += __shfl_xor(r, 32); lg2[hf] = r;
        }
        float logit = ((lane >> 4) & 1) ? lg2[1] : lg2[0];
        logit += p.router_b[erev];
        float cur = logit;
#define TOP_STEP(TV, TE) float TV; int TE; { const float mx = wave_max(cur); int cand = (cur == mx) ? erev : 64; \
            cand = min(cand, __shfl_xor(cand, 1)); cand = min(cand, __shfl_xor(cand, 2)); cand = min(cand, __shfl_xor(cand, 4)); \
            cand = min(cand, __shfl_xor(cand, 8)); cand = min(cand, __shfl_xor(cand, 16)); cand = min(cand, __shfl_xor(cand, 32)); \
            TV = mx; TE = cand; if (erev == cand) cur = -INFINITY; }
        TOP_STEP(tv0, te0) TOP_STEP(tv1, te1) TOP_STEP(tv2, te2) TOP_STEP(tv3, te3)
#undef TOP_STEP
        const float gk0 = 1.0f, gk1 = __expf(tv1 - tv0), gk2 = __expf(tv2 - tv0), gk3 = __expf(tv3 - tv0);
        const float ginv = 1.f / (gk0 + gk1 + gk2 + gk3);
        if (lane < 4) { const int e = lane == 0 ? te0 : lane == 1 ? te1 : lane == 2 ? te2 : te3; const float g = lane == 0 ? gk0 : lane == 1 ? gk1 : lane == 2 ? gk2 : gk3;
            const int pos = atomicAdd(&cnt[e], 1);
            TOPE[row * 4 + lane] = e; TOPG[row * 4 + lane] = g * ginv;
            if (it < RT_MAXIT) { rec[it * 8 + lane * 2] = e; rec[it * 8 + lane * 2 + 1] = pos; } }
    }
    __syncthreads();
    if (tid < 32) base[tid] = atomicAdd((int*)(p.ws + WS_CTL) + tid, cnt[tid]);
    __syncthreads();
    it = 0;
    int* PERM2 = (int*)(p.ws + WS_PERM2);
    for (int row = bid * 8 + wave; row < NTOK; row += nblk * 8, ++it)
        if (lane < 4 && it < RT_MAXIT) { const int e = rec[it * 8 + lane * 2], pos = base[e] + rec[it * 8 + lane * 2 + 1]; SLOT[row * 4 + lane] = pos; PERM2[(size_t)e * NTOK + pos] = row; }
}
constexpr int MT_LDS = 131072 + 1024;
__device__ __forceinline__ void moe_tables(const P& p, unsigned char* lds) {
    const int tid = tid_opaque(); int* cn = (int*)(lds + MT_LDS); int* eb = cn + 32; int* tb = eb + 33;
    __syncthreads();
    if (tid < 32) cn[tid] = __hip_atomic_load((int*)(p.ws + WS_CTL) + tid, __ATOMIC_RELAXED, __HIP_MEMORY_SCOPE_AGENT);
    __syncthreads();
    if (tid == 0) { int s = 0, t = 0; for (int e = 0; e < 32; ++e) { eb[e] = s; tb[e] = t; s += cn[e]; t += (cn[e] + 255) >> 8; } eb[32] = s; tb[32] = t; }
    __syncthreads();
}
struct FinIdx { int e[4]; int pos[4]; float g[4]; };
struct FinData { u32x4 ys[4]; u32x4 x[2]; };
__device__ __forceinline__ void fin_load_idx(const P& p, int row, FinIdx& r) {
    const u32x4 ev = *(const u32x4*)((const int*)(p.ws + WS_TOPE) + row * 4), pv = *(const u32x4*)((const int*)(p.ws + WS_SLOT) + row * 4); const f32x4 gv = *(const f32x4*)((const float*)(p.ws + WS_TOPG) + row * 4);
#pragma unroll
    for (int k = 0; k < 4; ++k) { r.e[k] = (int)ev[k]; r.pos[k] = (int)pv[k]; r.g[k] = gv[k] * (1.0f / YS_F8_SCALE); }
}
__device__ __forceinline__ void fin_load_data(const P& p, const int* eb, int row, const FinIdx& ix, FinData& d, int lane) {
    const unsigned char* YS = p.ws + WS_YS;
#pragma unroll
    for (int k = 0; k < 4; ++k) { const size_t slot = (size_t)(eb[ix.e[k]] + ix.pos[k]); d.ys[k] = *(const u32x4*)(YS + slot * 1024 + 16 * lane); }
    const u32x4* xr = (const u32x4*)((const bf16_t*)(p.ws + WS_X1) + (size_t)row * DM + 16 * lane); d.x[0] = xr[0]; d.x[1] = xr[1];
}
__device__ __forceinline__ void phase_final(const P& p, int bid, int nblk, unsigned char* lds) {
    moe_tables(p, lds); const int* eb = (const int*)(lds + MT_LDS) + 32;
    const int tid = tid_opaque(), wave = tid >> 6, lane = tid & 63;
    const float* mod = (const float*)(p.ws + WS_MOD);
    const int stride = nblk * 8;
    int row = bid * 8 + wave; if (row >= NTOK) return;
    FinIdx ic, in; FinData dc, dn;
    fin_load_idx(p, row, ic); fin_load_data(p, eb, row, ic, dc, lane);
    int row_n = row + stride; if (row_n < NTOK) fin_load_idx(p, row_n, in);
#pragma unroll 1
    for (;;) {
        if (row_n < NTOK) fin_load_data(p, eb, row_n, in, dn, lane);
        const int row_nn = row_n + stride; FinIdx inn; if (row_nn < NTOK) fin_load_idx(p, row_nn, inn);
        const int b = row >> 12, col = 16 * lane;
        f32x4 v[4]; float s = 0.f;
#pragma unroll
        for (int q = 0; q < 4; ++q) v[q] = (f32x4){0.f, 0.f, 0.f, 0.f};
#pragma unroll
        for (int k = 0; k < 4; ++k) { const u32x4 w = dc.ys[k]; const float g = ic.g[k];
            v[0] += unpack4_f8(w.x) * g; v[1] += unpack4_f8(w.y) * g; v[2] += unpack4_f8(w.z) * g; v[3] += unpack4_f8(w.w) * g; }
#pragma unroll
        for (int q = 0; q < 4; ++q) { const u32x4 xw = dc.x[q >> 1]; const unsigned w0 = (q & 1) ? xw.z : xw.x, w1 = (q & 1) ? xw.w : xw.y;
            const f32x4 xa = (f32x4){bflo(w0), bfhi(w0), bflo(w1), bfhi(w1)}; const f32x4 g2 = *(const f32x4*)(mod + b * 6144 + 5120 + col + 4 * q);
            v[q] = xa * ALPHA + g2 * v[q]; s += (v[q].x + v[q].y) + (v[q].z + v[q].w); }
        const float mean = wave_sum(s) * (1.f / DM); float s2 = 0.f;
#pragma unroll
        for (int q = 0; q < 4; ++q) { v[q] = v[q] - mean; s2 += (v[q].x * v[q].x + v[q].y * v[q].y) + (v[q].z * v[q].z + v[q].w * v[q].w); }
        const float rstd = 1.f / sqrtf(wave_sum(s2) * (1.f / DM) + LN_EPS);
        f32x4* xo = (f32x4*)(p.out + (size_t)row * DM + col);
#pragma unroll
        for (int q = 0; q < 4; ++q) { const f32x4 gg = *(const f32x4*)(p.ln2_g + col + 4 * q), bb = *(const f32x4*)(p.ln2_b + col + 4 * q); xo[q] = (v[q] * rstd) * gg + bb; }
        if (row_n >= NTOK) break;
        row = row_n; row_n = row_nn; ic = in; in = inn; dc = dn;
    }
}

namespace pg {
#define PG_LAS __attribute__((address_space(3)))
typedef float f32x2 __attribute__((ext_vector_type(2)));
constexpr int BM = 256, BK = 64, HALF = 128, HTB = HALF * BK * 2, STAGE_BYTES = 8 * HTB, KD = 1024, NT = KD / BK;
constexpr unsigned KSTEP = BK * 2, HSTEPB = HALF * KD * 2;
__host__ __device__ __forceinline__ int lds_byte(int r, int c) { const int st = (r >> 4) * 2 + (c >> 5), rr = r & 15, cc = c & 31, ob = rr * 64 + cc * 2; return st * 1024 + (ob ^ (((ob >> 9) & 1) << 5)); }
__host__ __device__ __forceinline__ void stage_rc(int b, int& R, int& C) { const int st = b / 1024, sb = b % 1024, swz = sb ^ (((sb >> 9) & 1) << 5); R = (st >> 1) * 16 + swz / 64; C = (st & 1) * 32 + (swz % 64) / 2; }
__host__ __device__ __forceinline__ int perm32(int rho) { const int n = rho >> 4, i = rho & 15; return 8 * (i >> 2) + 4 * n + (i & 3); }
struct Unit { int pm, pn, row0, nrows, e, kind; };
__device__ __forceinline__ void tilemap(int L, int nM, int nN, int& pm, int& pn) {
    int wgid = L; { const int nwg = nM * nN, q = nwg / 8, r = nwg % 8, xcd = wgid % 8, off = wgid / 8; wgid = (xcd < r ? xcd * (q + 1) : r * (q + 1) + (xcd - r) * q) + off; }
    const int nig = 8 * nN, gid = wgid / nig, fm = gid * 8, gsz = (nM - fm) < 8 ? (nM - fm) : 8;
    pm = fm + ((wgid % nig) % gsz); pn = (wgid % nig) / gsz;
}
__device__ __forceinline__ unsigned cvt_pk_bf16(float lo, float hi) { unsigned r; asm volatile("v_cvt_pk_bf16_f32 %0, %1, %2" : "=v"(r) : "v"(lo), "v"(hi)); return r; }
__device__ __forceinline__ f32x2 gelu_pk(f32x2 v) {
    const f32x2 av = __builtin_elementwise_abs(v), d = av * 0.2316418882f + 1.0f;
    f32x2 t; t.x = __builtin_amdgcn_rcpf(d.x); t.y = __builtin_amdgcn_rcpf(d.y);
    f32x2 q = t * 0.5307027145f + (-0.7265760135f); q = q * t + 0.7107068705f; q = q * t + (-0.142248368f); q = q * t + 0.127414796f; q = q * t;
    const f32x2 s = (v * v) * (-0.72134752044f);
    f32x2 e; e.x = __builtin_amdgcn_exp2f(s.x); e.y = __builtin_amdgcn_exp2f(s.y);
    const f32x2 m = v * (q * e), r = v - m;
    f32x2 o; o.x = v.x < 0.f ? m.x : r.x; o.y = v.y < 0.f ? m.y : r.y; return o;
}
__device__ __forceinline__ f32x4 gelu4(f32x4 v) { const f32x2 a = gelu_pk((f32x2){v[0], v[1]}), b = gelu_pk((f32x2){v[2], v[3]}); return (f32x4){a.x, a.y, b.x, b.y}; }
__device__ __forceinline__ f32x4 sigmoid4(f32x4 v) { f32x4 o;
#pragma unroll
    for (int i = 0; i < 4; ++i) o[i] = __builtin_amdgcn_rcpf(1.0f + __builtin_amdgcn_exp2f(-1.4426950408889634f * v[i]));
    return o; }
__device__ __forceinline__ u32x4 pack8v(f32x4 a, f32x4 b) { u32x4 w; w.x = cvt_pk_bf16(a[0], a[1]); w.y = cvt_pk_bf16(a[2], a[3]); w.z = cvt_pk_bf16(b[0], b[1]); w.w = cvt_pk_bf16(b[2], b[3]); return w; }

typedef int v8i __attribute__((ext_vector_type(8)));
template <class Epi, class Sched, bool ALIGN_EPI, bool F8 = false>
__device__ __forceinline__ void gemm_phase(PG_LAS unsigned char* lds, const unsigned char* Abase, const Sched& S, const Epi& E) {
    const int tid = tid_opaque(), wid = __builtin_amdgcn_readfirstlane(tid >> 6), lane = tid & 63, wr = wid >> 2, wc = wid & 3, fr = lane & 15, fq = lane >> 4;
    int R[2], C[2]; unsigned voffB[2];
#pragma unroll
    for (int i = 0; i < 2; ++i) { stage_rc(tid * 16 + i * 8192, R[i], C[i]);
        const int rho = R[i] & 31, Rb = Epi::PERM == 0 ? R[i] : (Epi::PERM == 1 ? ((R[i] & ~31) + perm32(rho)) : ((R[i] >> 5) * 64 + 16 * ((rho & 15) >> 2) + 4 * (rho >> 4) + (rho & 3)));
        voffB[i] = (unsigned)(Rb * (F8 ? 1024 : 2048) + C[i] * 2); }
    constexpr unsigned HSB = (Epi::PERM == 2 ? 8u : 128u) * (F8 ? 1024u : 2048u);
    constexpr int NTL = F8 ? NT / 2 : NT;
    const unsigned ldsw = (unsigned)wid * 1024u;
    const int aoff = lds_byte(wr * 64 + fr, fq * 8), boff = lds_byte(wc * 32 + fr, fq * 8);
#define PG_SA(b, h) (((b) * 2 + (h)) * HTB)
#define PG_SB(b, h) ((4 + (b) * 2 + (h)) * HTB)
#define PG_STAGE_A(bufoff, kbyte, vo) do { _Pragma("unroll") for (int _i = 0; _i < 2; ++_i) \
        __builtin_amdgcn_global_load_lds((const unsigned*)((const char*)Abase + (kbyte) + (vo)[_i]), (PG_LAS unsigned*)(lds + (bufoff) + ldsw + _i * 8192), 16, 0, 0); } while (0)
#define PG_STAGE_B(bufoff, gbase) do { _Pragma("unroll") for (int _i = 0; _i < 2; ++_i) \
        __builtin_amdgcn_global_load_lds((const unsigned*)((const char*)(gbase) + voffB[_i]), (PG_LAS unsigned*)(lds + (bufoff) + ldsw + _i * 8192), 16, 0, 0); } while (0)
#define PG_LD16(off) (*(const PG_LAS u32x4*)(lds + (off)))
#define PG_CAT(lo, hi) __builtin_bit_cast(v8i, __builtin_shufflevector((lo), (hi), 0, 1, 2, 3, 4, 5, 6, 7))
#define PG_LDA(dst, b, h) do { _Pragma("unroll") for (int m = 0; m < 4; ++m) { \
        if constexpr (F8) dst##8[m] = PG_CAT(PG_LD16(PG_SA(b, h) + aoff + m * 2048), PG_LD16(PG_SA(b, h) + aoff + m * 2048 + 1024)); \
        else { _Pragma("unroll") for (int k = 0; k < 2; ++k) dst[m][k] = *(const PG_LAS bf16x8*)(lds + PG_SA(b, h) + aoff + m * 2048 + k * 1024); } } } while (0)
#define PG_LDB(dst, b, h) do { _Pragma("unroll") for (int n = 0; n < 2; ++n) { \
        if constexpr (F8) dst##8[n] = PG_CAT(PG_LD16(PG_SB(b, h) + boff + n * 2048), PG_LD16(PG_SB(b, h) + boff + n * 2048 + 1024)); \
        else { _Pragma("unroll") for (int k = 0; k < 2; ++k) dst[n][k] = *(const PG_LAS bf16x8*)(lds + PG_SB(b, h) + boff + n * 2048 + k * 1024); } } } while (0)
#define PG_MMA(ai, bj, At, Bt) do { __builtin_amdgcn_s_setprio(1); _Pragma("unroll") for (int m = 0; m < 4; ++m) _Pragma("unroll") for (int n = 0; n < 2; ++n) { \
        if constexpr (F8) asm volatile("s_nop 1\n\tv_mfma_scale_f32_16x16x128_f8f6f4 %0, %1, %2, %0, %3, %3 op_sel_hi:[0,0,0]" : "+v"(acc[ai][bj][m][n]) : "v"(Bt##8[n]), "v"(At##8[m]), "v"(f8scale)); \
        else { _Pragma("unroll") for (int k = 0; k < 2; ++k) acc[ai][bj][m][n] = __builtin_amdgcn_mfma_f32_16x16x32_bf16(Bt[n][k], At[m][k], acc[ai][bj][m][n], 0, 0, 0); } } \
        __builtin_amdgcn_s_setprio(0); } while (0)
#define PG_WAIT_V(n) asm volatile("s_waitcnt vmcnt(" #n ")" ::: "memory")
#define PG_WAIT_L(n) asm volatile("s_waitcnt lgkmcnt(" #n ")" ::: "memory")
#define PG_BAR __builtin_amdgcn_s_barrier()
#define PG_SCHED __builtin_amdgcn_sched_barrier(0)
    Unit cur, nxt; int ui = 0;
    if (!S.next(0, cur)) return;
    f32x4 acc[2][2][4][2];
#pragma unroll
    for (int a = 0; a < 2; ++a)
#pragma unroll
        for (int b = 0; b < 2; ++b)
#pragma unroll
            for (int m = 0; m < 4; ++m)
#pragma unroll
                for (int n = 0; n < 2; ++n) acc[a][b][m][n] = (f32x4){0.f, 0.f, 0.f, 0.f};
    bf16x8 At[4][2], B0[2][2], B1[2][2]; v8i At8[4], B08[2], B18[2];
    int f8scale = 0x7f7f7f7f; asm volatile("" : "+v"(f8scale));
    unsigned ac[2][2], an[2][2];
    S.aoffs(cur, R, C, ac);
    const char* cB = S.bptr(cur);
    PG_STAGE_B(PG_SB(0, 0), cB); PG_STAGE_B(PG_SB(0, 1), cB + HSB); PG_STAGE_A(PG_SA(0, 0), 0u, ac[0]); PG_STAGE_A(PG_SA(0, 1), 0u, ac[1]);
    if (wr == 1) PG_BAR;
    PG_WAIT_V(2); PG_BAR;
    PG_STAGE_B(PG_SB(1, 0), cB + KSTEP); PG_STAGE_A(PG_SA(1, 0), KSTEP, ac[0]); PG_STAGE_B(PG_SB(1, 1), cB + HSB + KSTEP);
    PG_WAIT_V(6); PG_BAR;
    for (;;) {
        const bool has_next = S.next(ui + 1, nxt);
        const char* nB = cB;
        if (has_next) { int R2[2], C2[2]; int t2 = tid; asm volatile("" : "+v"(t2));
#pragma unroll
            for (int i = 0; i < 2; ++i) stage_rc(t2 * 16 + i * 8192, R2[i], C2[i]);
            S.aoffs(nxt, R2, C2, an); nB = S.bptr(nxt); }
        else {
#pragma unroll
            for (int h = 0; h < 2; ++h)
#pragma unroll
                for (int i = 0; i < 2; ++i) an[h][i] = ac[h][i]; }
        for (int t = 0; t < NTL; t += 2) {
            const bool last = (t == NTL - 2);
            const unsigned ka1 = (unsigned)(t + 1) * KSTEP;
            const unsigned ka2 = last ? 0u : (unsigned)(t + 2) * KSTEP;
            const char* b2 = last ? nB : cB + (size_t)(t + 2) * KSTEP; const char* b3 = b2 + KSTEP;
            unsigned a2o[2][2];
#pragma unroll
            for (int h = 0; h < 2; ++h)
#pragma unroll
                for (int i = 0; i < 2; ++i) a2o[h][i] = last ? an[h][i] : ac[h][i];
            PG_LDB(B0, 0, 0); PG_LDB(B1, 0, 1); PG_SCHED; PG_LDA(At, 0, 0); PG_STAGE_A(PG_SA(1, 1), ka1, ac[1]);
            PG_WAIT_V(8); PG_WAIT_L(0); PG_BAR; PG_MMA(0, 0, At, B0); PG_MMA(0, 1, At, B1); PG_BAR; PG_SCHED;
            PG_LDA(At, 0, 1); PG_STAGE_B(PG_SB(0, 0), b2); PG_STAGE_B(PG_SB(0, 1), b2 + HSB); PG_STAGE_A(PG_SA(0, 0), ka2, a2o[0]);
            PG_WAIT_V(8); PG_WAIT_L(0); PG_BAR; PG_MMA(1, 0, At, B0); PG_MMA(1, 1, At, B1); PG_BAR; PG_SCHED;
            PG_LDB(B0, 1, 0); PG_LDB(B1, 1, 1); PG_SCHED; PG_LDA(At, 1, 0); PG_STAGE_A(PG_SA(0, 1), ka2, a2o[1]);
            PG_WAIT_V(8); PG_WAIT_L(0); PG_BAR; PG_MMA(0, 0, At, B0); PG_MMA(0, 1, At, B1); PG_BAR; PG_SCHED;
            PG_LDA(At, 1, 1); PG_STAGE_B(PG_SB(1, 0), b3); PG_STAGE_B(PG_SB(1, 1), b3 + HSB); PG_STAGE_A(PG_SA(1, 0), ka2 + KSTEP, a2o[0]);
            PG_WAIT_V(8); PG_WAIT_L(0); PG_BAR; PG_MMA(1, 0, At, B0); PG_MMA(1, 1, At, B1); PG_BAR; PG_SCHED;
        }
        if constexpr (ALIGN_EPI) { if (wr == 0) PG_BAR; }
        if constexpr (F8) asm volatile("s_nop 15\n\ts_nop 15" ::: "memory");
        { int te = tid; asm volatile("" : "+v"(te)); E.run(acc, cur, wr, wc, te & 15, (te >> 4) & 3); }
        if (!has_next) break;
        if (!E.carry(cur)) {
#pragma unroll
            for (int a = 0; a < 2; ++a)
#pragma unroll
                for (int b = 0; b < 2; ++b)
#pragma unroll
                    for (int m = 0; m < 4; ++m)
#pragma unroll
                        for (int n = 0; n < 2; ++n) acc[a][b][m][n] = (f32x4){0.f, 0.f, 0.f, 0.f}; }
        cur = nxt; cB = nB; ++ui;
#pragma unroll
        for (int h = 0; h < 2; ++h)
#pragma unroll
            for (int i = 0; i < 2; ++i) ac[h][i] = an[h][i];
        if constexpr (ALIGN_EPI) { if (wr == 1) PG_BAR; }
    }
    PG_WAIT_V(0);
    if constexpr (!ALIGN_EPI) { if (wr == 0) PG_BAR; }
    PG_BAR;
#undef PG_SA
#undef PG_SB
#undef PG_STAGE_A
#undef PG_STAGE_B
#undef PG_LDA
#undef PG_LDB
#undef PG_MMA
#undef PG_CAT
#undef PG_LD16
#undef PG_WAIT_V
#undef PG_WAIT_L
#undef PG_BAR
#undef PG_SCHED
}

struct SchedP1 {
    int G, c; const unsigned char* ws;
    __device__ __forceinline__ bool next(int i, Unit& u) const {
        const int L = i * G + c; if (L >= 3136) return false;
        u.row0 = 0; u.nrows = 256; u.e = 0;
        if (L < 2048) { u.kind = 0; tilemap(L, 128, 16, u.pm, u.pn); }
        else if (L < 3072) { u.kind = 1; tilemap(L - 2048, 8, 128, u.pm, u.pn); }
        else if (L < 3104) { u.kind = 2; const int l = L - 3072; u.pm = l >> 2; u.pn = l & 3; }
        else { u.kind = 3; const int l = L - 3104; u.pm = l >> 3; u.pn = l & 7; }
        return true; }
    __device__ __forceinline__ void aoffs(const Unit& u, const int (&R)[2], const int (&C)[2], unsigned (&o)[2][2]) const {
        size_t base; int row0;
        if (u.kind == 0) { base = WS_U; row0 = 256 * u.pm; }
        else if (u.kind == 1) { base = WS_WIN; row0 = u.pm < 4 ? 1024 + 256 * u.pm : 4096 + 256 * (u.pm - 4); }
        else if (u.kind == 2) { base = WS_UC; row0 = 256 * u.pm; }
        else { base = WS_WIN; row0 = 4096 + 256 * u.pm; }
#pragma unroll
        for (int h = 0; h < 2; ++h)
#pragma unroll
            for (int i = 0; i < 2; ++i) o[h][i] = (unsigned)(base + ((size_t)(row0 + 128 * h + R[i]) * 1024 + C[i]) * 2); }
    __device__ __forceinline__ const char* bptr(const Unit& u) const {
        if (u.kind == 0) { const int wrow = u.pn < 4 ? 256 * u.pn : (u.pn < 8 ? 2048 + 256 * (u.pn - 4) : 5120 + 256 * (u.pn - 8)); return (const char*)ws + WS_WIN + (size_t)wrow * 2048; }
        if (u.kind == 1) return (const char*)ws + WS_U + (size_t)u.pn * 256 * 2048;
        if (u.kind == 2) return (const char*)ws + WS_WIN + (size_t)(3072 + 256 * u.pn) * 2048;
        return (const char*)ws + WS_UC + (size_t)u.pn * 256 * 2048; }
};
struct EpiP1 {
    static constexpr int PERM = 1;
    unsigned char* ws; const float* b_in;
    __device__ __forceinline__ bool carry(const Unit&) const { return false; }
    __device__ __forceinline__ void run(f32x4 (&acc)[2][2][4][2], const Unit& u, int wr, int wc, int fr, int fq) const {
        const int lc = wc * 32 + 8 * fq, kind = u.kind, pm = u.pm, pn = u.pn;
        const bool brow = (kind == 1) || (kind == 3);
        int act, bcol, browbase, RA, RB, CA, CB; size_t base;
        if (kind == 0) { browbase = 0;
            if (pn < 4) { act = 1; bcol = 256 * pn; base = WS_ZU / 2 + (size_t)256 * pm * 1024 + 256 * pn; RA = 65536; RB = 1024; CA = 64; CB = 1; }
            else if (pn < 8) { act = 0; bcol = 2048 + 256 * (pn - 4); const int tok0 = 256 * pm;
                base = WS_Q / 2 + ((size_t)((tok0 >> 12) * 16 + 4 * (pn - 4)) * 4096 + (tok0 & 4095)) * 64; RA = 4096; RB = 64; CA = 4096 * 64; CB = 1; }
            else { act = 2; bcol = 5120 + 256 * (pn - 8); base = WS_G / 2 + (size_t)256 * pm * 2048 + 256 * (pn - 8); RA = 131072; RB = 2048; CA = 64; CB = 1; } }
        else if (kind == 1) { bcol = 0; const int tk0 = 256 * pn;
            if (pm < 4) { act = 1; browbase = 1024 + 256 * pm; base = WS_ZVT / 2 + (size_t)(tk0 >> 3) * 8192 + 256 * pm * 8; RA = 512; RB = 8; CA = 65536; CB = 1024; }
            else { act = 0; browbase = 4096 + 256 * (pm - 4); base = WS_VT / 2 + ((size_t)((tk0 >> 12) * 16 + 4 * (pm - 4)) * 512 + ((tk0 & 4095) >> 3)) * 512; RA = 512 * 512; RB = 8; CA = 4096; CB = 64; } }
        else if (kind == 2) { act = 0; bcol = 3072 + 256 * pn; browbase = 0; base = WS_KC / 2 + (size_t)(pm * 16 + 4 * pn) * 256 * 64; RA = 4096; RB = 64; CA = 16384; CB = 1; }
        else { act = 0; bcol = 0; browbase = 4096 + 256 * pm; base = WS_VCT / 2 + (size_t)(pn * 16 + 4 * pm) * 32 * 512; RA = 32 * 512; RB = 8; CA = 4096; CB = 64; }
        bf16_t* dbase = (bf16_t*)ws + base;
        f32x4 bv[2][2];
#pragma unroll
        for (int bj = 0; bj < 2; ++bj)
#pragma unroll
            for (int n = 0; n < 2; ++n) bv[bj][n] = brow ? (f32x4){0.f, 0.f, 0.f, 0.f} : *(const f32x4*)(b_in + bcol + lc + bj * HALF + 4 * n);
        const int colterm0 = (wc >> 1) * CA + ((wc & 1) * 32 + 8 * fq) * CB;
        float rbv[2][4];
#pragma unroll
        for (int ai = 0; ai < 2; ++ai)
#pragma unroll
            for (int m = 0; m < 4; ++m) rbv[ai][m] = brow ? b_in[browbase + ai * HALF + wr * 64 + m * 16 + fr] : 0.f;
#pragma unroll
        for (int ai = 0; ai < 2; ++ai)
#pragma unroll
            for (int m = 0; m < 4; ++m) { const int row = ai * HALF + wr * 64 + m * 16 + fr;
                const float rb = rbv[ai][m];
                const int rowterm = (2 * ai + wr) * RA + (16 * m + fr) * RB;
#pragma unroll
                for (int bj = 0; bj < 2; ++bj) {
                    f32x4 v0 = acc[ai][bj][m][0] + bv[bj][0] + rb, v1 = acc[ai][bj][m][1] + bv[bj][1] + rb;
                    if (act == 1) { v0 = gelu4(v0); v1 = gelu4(v1); } else if (act == 2) { v0 = sigmoid4(v0); v1 = sigmoid4(v1); }
                    *(u32x4*)(dbase + rowterm + colterm0 + 2 * bj * CA) = pack8v(v0, v1); } }
    }
};
struct SchedK {
    int G, c; const unsigned char* ws;
    __device__ __forceinline__ bool next(int i, Unit& u) const { const int L = i * G + c; if (L >= 512) return false; u.kind = 0; u.row0 = 0; u.nrows = 256; u.e = 0; tilemap(L, 128, 4, u.pm, u.pn); return true; }
    __device__ __forceinline__ void aoffs(const Unit& u, const int (&R)[2], const int (&C)[2], unsigned (&o)[2][2]) const {
#pragma unroll
        for (int h = 0; h < 2; ++h)
#pragma unroll
            for (int i = 0; i < 2; ++i) o[h][i] = (unsigned)(WS_U + ((size_t)(256 * u.pm + 128 * h + R[i]) * 1024 + C[i]) * 2); }
    __device__ __forceinline__ const char* bptr(const Unit& u) const { return (const char*)ws + WS_WIN + (size_t)(3072 + 256 * u.pn) * 2048; }
};
struct EpiRope {
    static constexpr int PERM = 0;
    unsigned char* ws; const float* b_in;
    __device__ __forceinline__ bool carry(const Unit&) const { return false; }
    __device__ __forceinline__ void run(f32x4 (&acc)[2][2][4][2], const Unit& u, int wr, int wc, int fr, int fq) const {
        bf16_t* K = (bf16_t*)(ws + WS_K); const float* tab = (const float*)(ws + WS_ROPE);
        const int lc = wc * 32 + 4 * fq, axis = wc & 1;
        f32x4 b0[2], b1[2];
#pragma unroll
        for (int bj = 0; bj < 2; ++bj) { b0[bj] = *(const f32x4*)(b_in + 3072 + 256 * u.pn + bj * HALF + lc); b1[bj] = *(const f32x4*)(b_in + 3072 + 256 * u.pn + bj * HALF + lc + 16); }
        f32x4 tb0[2][4], tb1[2][4];
#pragma unroll
        for (int ai = 0; ai < 2; ++ai)
#pragma unroll
            for (int m = 0; m < 4; ++m) { const int tok = 256 * u.pm + ai * HALF + wr * 64 + m * 16 + fr; const int pos = axis ? (tok & 63) : ((tok >> 6) & 63);
                tb0[ai][m] = *(const f32x4*)(tab + (pos * 16 + 4 * fq) * 2); tb1[ai][m] = *(const f32x4*)(tab + (pos * 16 + 4 * fq) * 2 + 4); }
#pragma unroll
        for (int ai = 0; ai < 2; ++ai)
#pragma unroll
            for (int m = 0; m < 4; ++m) { const int tok = 256 * u.pm + ai * HALF + wr * 64 + m * 16 + fr;
                const f32x4 t0 = tb0[ai][m], t1 = tb1[ai][m];
                const f32x4 cs = (f32x4){t0[0], t0[2], t1[0], t1[2]}, sn = (f32x4){t0[1], t0[3], t1[1], t1[3]};
                const int cc0 = 256 * u.pn + lc;
                bf16_t* rowp = K + ((size_t)((tok >> 12) * 16) * 4096 + (tok & 4095)) * 64;
#pragma unroll
                for (int bj = 0; bj < 2; ++bj) { const f32x4 v0 = acc[ai][bj][m][0] + b0[bj], v1 = acc[ai][bj][m][1] + b1[bj];
                    const f32x4 o0 = v0 * cs - v1 * sn, o1 = v1 * cs + v0 * sn;
                    u32x2 w0, w1; w0.x = cvt_pk_bf16(o0[0], o0[1]); w0.y = cvt_pk_bf16(o0[2], o0[3]); w1.x = cvt_pk_bf16(o1[0], o1[1]); w1.y = cvt_pk_bf16(o1[2], o1[3]);
                    const int cc = cc0 + bj * HALF; bf16_t* dp = rowp + (size_t)(cc >> 6) * 4096 * 64 + (cc & 63);
                    *(u32x2*)dp = w0; *(u32x2*)(dp + 16) = w1; } }
    }
};
struct SchedMerge {
    int G, c; const unsigned char* ws;
    __device__ __forceinline__ bool next(int i, Unit& u) const { const int L = (i >> 1) * G + c; if (L >= 512) return false; u.kind = i & 1; u.row0 = 0; u.nrows = 256; u.e = 0; tilemap(L, 128, 4, u.pm, u.pn); return true; }
    __device__ __forceinline__ void aoffs(const Unit& u, const int (&R)[2], const int (&C)[2], unsigned (&o)[2][2]) const {
        const size_t base = u.kind ? WS_YB : WS_U;
#pragma unroll
        for (int h = 0; h < 2; ++h)
#pragma unroll
            for (int i = 0; i < 2; ++i) o[h][i] = (unsigned)(base + ((size_t)(256 * u.pm + 128 * h + R[i]) * 1024 + C[i]) * 2); }
    __device__ __forceinline__ const char* bptr(const Unit& u) const { return (const char*)ws + (u.kind ? WS_WPB : WS_WPA) + (size_t)u.pn * 256 * 2048; }
};
struct EpiMerge {
    static constexpr int PERM = 1;
    unsigned char* ws;
    __device__ __forceinline__ bool carry(const Unit& u) const { return u.kind == 0; }
    __device__ __forceinline__ void run(f32x4 (&acc)[2][2][4][2], const Unit& u, int wr, int wc, int fr, int fq) const {
        const bf16_t* Gt = (const bf16_t*)(ws + WS_G); bf16_t* INNER = (bf16_t*)(ws + WS_INNER);
        const int lc = 256 * u.pn + wc * 32 + 8 * fq;
#pragma unroll
        for (int ai = 0; ai < 2; ++ai) {
            u32x4 gbw[4][2], gaw[4][2];
#pragma unroll
            for (int m = 0; m < 4; ++m) { const size_t tok = (size_t)(256 * u.pm + ai * HALF + wr * 64 + m * 16 + fr);
#pragma unroll
                for (int bj = 0; bj < 2; ++bj) { gbw[m][bj] = *(const u32x4*)(Gt + tok * 2048 + 1024 + lc + bj * HALF);
                    if (u.kind == 0) gaw[m][bj] = *(const u32x4*)(Gt + tok * 2048 + lc + bj * HALF); } }
#pragma unroll
            for (int m = 0; m < 4; ++m) { const size_t tok = (size_t)(256 * u.pm + ai * HALF + wr * 64 + m * 16 + fr);
#pragma unroll
                for (int bj = 0; bj < 2; ++bj) { const u32x4 gw = gbw[m][bj];
                    const f32x4 gb0 = (f32x4){bflo(gw.x), bfhi(gw.x), bflo(gw.y), bfhi(gw.y)}, gb1 = (f32x4){bflo(gw.z), bfhi(gw.z), bflo(gw.w), bfhi(gw.w)};
                    if (u.kind == 0) { const u32x4 ga = gaw[m][bj];
                        const f32x4 ga0 = (f32x4){bflo(ga.x), bfhi(ga.x), bflo(ga.y), bfhi(ga.y)}, ga1 = (f32x4){bflo(ga.z), bfhi(ga.z), bflo(ga.w), bfhi(ga.w)};
#pragma unroll
                        for (int i = 0; i < 4; ++i) { acc[ai][bj][m][0][i] *= ga0[i] * __builtin_amdgcn_rcpf(fmaxf(gb0[i], 1e-30f)); acc[ai][bj][m][1][i] *= ga1[i] * __builtin_amdgcn_rcpf(fmaxf(gb1[i], 1e-30f)); }
                    } else { *(u32x4*)(INNER + tok * 1024 + lc + bj * HALF) = pack8v(acc[ai][bj][m][0] * gb0, acc[ai][bj][m][1] * gb1); } } }
        }
    }
};
struct SchedMix {
    int G, c; const unsigned char* ws;
    __device__ __forceinline__ bool next(int i, Unit& u) const { const int L = i * G + c; if (L >= 512) return false; u.kind = 0; u.row0 = 0; u.nrows = 256; u.e = 0; tilemap(L, 128, 4, u.pm, u.pn); return true; }
    __device__ __forceinline__ void aoffs(const Unit& u, const int (&R)[2], const int (&C)[2], unsigned (&o)[2][2]) const {
#pragma unroll
        for (int h = 0; h < 2; ++h)
#pragma unroll
            for (int i = 0; i < 2; ++i) o[h][i] = (unsigned)(WS_INNER + ((size_t)(256 * u.pm + 128 * h + R[i]) * 1024 + C[i]) * 2); }
    __device__ __forceinline__ const char* bptr(const Unit& u) const { return (const char*)ws + WS_WOUT + (size_t)u.pn * 256 * 2048; }
};
struct EpiMix {
    static constexpr int PERM = 0;
    unsigned char* ws; const float *x, *lng, *lnb, *b_out; float* out;
    __device__ __forceinline__ bool carry(const Unit&) const { return false; }
    __device__ __forceinline__ void run(f32x4 (&acc)[2][2][4][2], const Unit& u, int wr, int wc, int fr, int fq) const {
        const float* rowstat = (const float*)(ws + WS_ROWSTAT); const float* mod = (const float*)(ws + WS_MOD) + ((256 * u.pm) >> 12) * 6144 + 2048;
        f32x2 st[2][4];
#pragma unroll
        for (int ai = 0; ai < 2; ++ai)
#pragma unroll
            for (int m = 0; m < 4; ++m) st[ai][m] = *(const f32x2*)(rowstat + 2 * (256 * u.pm + ai * HALF + wr * 64 + m * 16 + fr));
#pragma unroll
        for (int bj = 0; bj < 2; ++bj)
#pragma unroll
            for (int n = 0; n < 2; ++n) { const int col = 256 * u.pn + bj * HALF + wc * 32 + n * 16 + 4 * fq;
                const f32x4 lg = *(const f32x4*)(lng + col), lb = *(const f32x4*)(lnb + col), bo = *(const f32x4*)(b_out + col), g1 = *(const f32x4*)(mod + col);
                f32x4 xb[2][4];
#pragma unroll
                for (int ai = 0; ai < 2; ++ai)
#pragma unroll
                    for (int m = 0; m < 4; ++m) xb[ai][m] = *(const f32x4*)(x + (size_t)(256 * u.pm + ai * HALF + wr * 64 + m * 16 + fr) * 1024 + col);
#pragma unroll
                for (int ai = 0; ai < 2; ++ai)
#pragma unroll
                    for (int m = 0; m < 4; ++m) { const size_t off = (size_t)(256 * u.pm + ai * HALF + wr * 64 + m * 16 + fr) * 1024 + col;
                        const f32x4 xv = xb[ai][m];
                        const f32x4 x0 = (xv - st[ai][m].x) * st[ai][m].y * lg + lb;
                        const f32x4 r = x0 * ALPHA + g1 * (acc[ai][bj][m][n] + bo); u32x2 w; w.x = cvt_pk_bf16(r[0], r[1]); w.y = cvt_pk_bf16(r[2], r[3]);
                        *(u32x2*)((bf16_t*)(ws + WS_X1PRE) + off) = w; }
                asm volatile("" ::: "memory"); }
    }
};
__device__ __forceinline__ int ld_u(const int* p) { return __builtin_amdgcn_readfirstlane(__hip_atomic_load(p, __ATOMIC_RELAXED, __HIP_MEMORY_SCOPE_AGENT)); }
template <int NPN  > struct SchedMoe {
    int G, c; const unsigned char* ws; const int* tabs;
    __device__ __forceinline__ bool next(int i, Unit& u) const {
        const int* cn = tabs; const int* eb = tabs + 32; const int* tb = tabs + 65;
        const int ntiles = tb[32], tpx = (ntiles + 7) >> 3, x = c & 7, s = c >> 3;
        const int tiles_x = min(tpx, ntiles - x * tpx), ll = i * (G >> 3) + s;
        if (ll >= NPN * tiles_x) return false;
        const int T = x * tpx + ll / NPN; u.pn = ll % NPN; u.kind = 0;
        int e = 0;
#pragma unroll 1
        for (int k = 16; k >= 1; k >>= 1) if (tb[e + k] <= T) e += k;
        const int jt = T - tb[e];
        u.e = __builtin_amdgcn_readfirstlane(e); u.pm = __builtin_amdgcn_readfirstlane(jt);
        u.row0 = __builtin_amdgcn_readfirstlane(eb[e] + 256 * jt); u.nrows = __builtin_amdgcn_readfirstlane(min(256, cn[e] - 256 * jt)); return true; }
    __device__ __forceinline__ void aoffs(const Unit& u, const int (&R)[2], const int (&C)[2], unsigned (&o)[2][2]) const {
        const int* PERM2 = (const int*)(ws + WS_PERM2) + (size_t)u.e * NTOK + 256 * u.pm;
#pragma unroll
        for (int h = 0; h < 2; ++h)
#pragma unroll
            for (int i = 0; i < 2; ++i) { const int lr = min(128 * h + R[i], u.nrows - 1);
                if (NPN == 8) { const int tok = PERM2[lr]; o[h][i] = (unsigned)(WS_U + (size_t)tok * 1024 + C[i] * 2); }
                else o[h][i] = (unsigned)(WS_ACT + (size_t)(u.row0 + lr) * 1024 + C[i] * 2); } }
    __device__ __forceinline__ const char* bptr(const Unit& u) const {
        if (NPN == 8) return (const char*)ws + WS_W1 + ((size_t)u.e * 2048 + 256 * u.pn) * 1024;
        return (const char*)ws + WS_W2 + ((size_t)u.e * 1024 + 256 * u.pn) * 1024; }
};
struct EpiMoe1 {
    static constexpr int PERM = 1;
    unsigned char* ws; const float* b1;
    __device__ __forceinline__ bool carry(const Unit&) const { return false; }
    __device__ __forceinline__ void run(f32x4 (&acc)[2][2][4][2], const Unit& u, int wr, int wc, int fr, int fq) const {
        unsigned char* ACT = ws + WS_ACT;
        const int col = 128 * u.pn + wc * 32 + 8 * fq;
        f32x4 bg[2], bl[2];
#pragma unroll
        for (int n = 0; n < 2; ++n) { bg[n] = *(const f32x4*)(b1 + u.e * 2048 + col + 4 * n); bl[n] = *(const f32x4*)(b1 + u.e * 2048 + 1024 + col + 4 * n); }
        u32x2 outw[2][4];
#pragma unroll
        for (int ai = 0; ai < 2; ++ai)
#pragma unroll
            for (int m = 0; m < 4; ++m) {
                f32x4 a[2];
#pragma unroll
                for (int n = 0; n < 2; ++n) { const f32x4 zgv = acc[ai][0][m][n] * (1.0f / W_F8_SCALE) + bg[n], zlv = acc[ai][1][m][n] * (1.0f / W_F8_SCALE) + bl[n];
#pragma unroll
                    for (int i = 0; i < 4; ++i) { const float zg = fminf(zgv[i], 7.0f), zl = fminf(fmaxf(zlv[i], -7.0f), 7.0f);
                        a[n][i] = fminf(fmaxf(ACT_F8_SCALE * zg * __builtin_amdgcn_rcpf(1.0f + __builtin_amdgcn_exp2f(-1.702f * 1.4426950408889634f * zg)) * (zl + 1.0f), -448.0f), 448.0f); } }
                outw[ai][m] = pack8_f8(a[0], a[1]); }
#pragma unroll
        for (int ai = 0; ai < 2; ++ai)
#pragma unroll
            for (int m = 0; m < 4; ++m) { const int lr = ai * HALF + wr * 64 + m * 16 + fr;
                const size_t srow = lr < u.nrows ? (size_t)(u.row0 + lr) : (size_t)(NASSIGN + lr);
                *(u32x2*)(ACT + srow * 1024 + col) = outw[ai][m]; }
    }
};
struct EpiMoe2 {
    static constexpr int PERM = 2;
    unsigned char* ws; const float* b2;
    __device__ __forceinline__ bool carry(const Unit&) const { return false; }
    __device__ __forceinline__ void run(f32x4 (&acc)[2][2][4][2], const Unit& u, int wr, int wc, int fr, int fq) const {
        unsigned char* YS = ws + WS_YS; constexpr float DS = 1.0f / (W_F8_SCALE * ACT_F8_SCALE);
        const int lc = 256 * u.pn + wc * 64 + 16 * fq;
        f32x4 bv[2][2];
#pragma unroll
        for (int bj = 0; bj < 2; ++bj)
#pragma unroll
            for (int n = 0; n < 2; ++n) bv[bj][n] = *(const f32x4*)(b2 + u.e * 1024 + lc + 8 * bj + 4 * n);
        u32x4 outw[2][4];
#pragma unroll
        for (int ai = 0; ai < 2; ++ai)
#pragma unroll
            for (int m = 0; m < 4; ++m) {
                { const u32x2 lo = pack8_f8((acc[ai][0][m][0] * DS + bv[0][0]) * YS_F8_SCALE, (acc[ai][0][m][1] * DS + bv[0][1]) * YS_F8_SCALE), hi = pack8_f8((acc[ai][1][m][0] * DS + bv[1][0]) * YS_F8_SCALE, (acc[ai][1][m][1] * DS + bv[1][1]) * YS_F8_SCALE);
                    u32x4 w; w.x = lo.x; w.y = lo.y; w.z = hi.x; w.w = hi.y; outw[ai][m] = w; } }
#pragma unroll
        for (int ai = 0; ai < 2; ++ai)
#pragma unroll
            for (int m = 0; m < 4; ++m) { const int lr = ai * HALF + wr * 64 + m * 16 + fr;
                const size_t srow = lr < u.nrows ? (size_t)(u.row0 + lr) : (size_t)(NASSIGN + lr);
                *(u32x4*)(YS + srow * 1024 + lc) = outw[ai][m]; }
    }
};
}
__device__ __forceinline__ void phase_merge_fast(const P& p, int bid, int nblk, unsigned char* lds) {
    pg::SchedMerge S{nblk, bid, p.ws}; pg::EpiMerge E{p.ws};
    pg::gemm_phase<pg::EpiMerge, pg::SchedMerge, true>((PG_LAS unsigned char*)lds, p.ws, S, E);
}
__device__ __forceinline__ void phase_mix_fast(const P& p, int bid, int nblk, unsigned char* lds) {
    pg::SchedMix S{nblk, bid, p.ws}; pg::EpiMix E{p.ws, p.x, p.ln_x_g, p.ln_x_b, p.b_out, p.out};
    pg::gemm_phase<pg::EpiMix, pg::SchedMix, true>((PG_LAS unsigned char*)lds, p.ws, S, E);
}
__device__ __forceinline__ void phase_moe1_fast(const P& p, int bid, int nblk, unsigned char* lds) {
    moe_tables(p, lds); pg::SchedMoe<8> S{nblk, bid, p.ws, (const int*)(lds + MT_LDS)}; pg::EpiMoe1 E{p.ws, p.exp_b1};
    pg::gemm_phase<pg::EpiMoe1, pg::SchedMoe<8>, true, true>((PG_LAS unsigned char*)lds, p.ws, S, E);
}
__device__ __forceinline__ void phase_moe2_fast(const P& p, int bid, int nblk, unsigned char* lds) {
    moe_tables(p, lds); pg::SchedMoe<4> S{nblk, bid, p.ws, (const int*)(lds + MT_LDS)}; pg::EpiMoe2 E{p.ws, p.exp_b2};
    pg::gemm_phase<pg::EpiMoe2, pg::SchedMoe<4>, true, true>((PG_LAS unsigned char*)lds, p.ws, S, E);
}
__device__ __forceinline__ void phase_proj_fast(const P& p, int bid, int nblk, unsigned char* lds) {
    { pg::SchedP1 S{nblk, bid, p.ws}; pg::EpiP1 E{p.ws, p.b_in};
      pg::gemm_phase<pg::EpiP1, pg::SchedP1, true>((PG_LAS unsigned char*)lds, p.ws, S, E); }
    { pg::SchedK S{nblk, bid, p.ws}; pg::EpiRope E{p.ws, p.b_in};
      pg::gemm_phase<pg::EpiRope, pg::SchedK, true>((PG_LAS unsigned char*)lds, p.ws, S, E); }
}

#define LAS __attribute__((address_space(3)))
#define XB_TMO      128
#define XB_XCNT(j)  (256  + 64 * (j))
#define XB_XSUB(j)  (1280 + 64 * (j))
#define XB_XGEN(j)  (2304 + 64 * (j))
#define XB_TOP      3328
#define XB_TOPGEN   3392
#define XCD_BAR_WORDS 3456
#define XB_SPIN_CAP (1u << 22)
__device__ __forceinline__ unsigned xb_ld(unsigned* p)              { return __hip_atomic_load(p, __ATOMIC_RELAXED, __HIP_MEMORY_SCOPE_AGENT); }
__device__ __forceinline__ unsigned xb_add(unsigned* p, unsigned v) { return __hip_atomic_fetch_add(p, v, __ATOMIC_RELAXED, __HIP_MEMORY_SCOPE_AGENT); }
__device__ __forceinline__ unsigned xb_xcc_id() { return (unsigned)__builtin_amdgcn_s_getreg((3 << 11) | 20) & 0xFu; }
#define XB_SPIN(cond, bar) do { unsigned _sp = 0; while (cond) { __builtin_amdgcn_s_sleep(1); \
    if ((++_sp & 255u) == 0u) { if (xb_ld(&(bar)[XB_TMO])) break; if (_sp > XB_SPIN_CAP) { atomicAdd(&(bar)[XB_TMO], 1u); break; } } } } while (0)
struct XcdBarrier { unsigned* bar; unsigned x; volatile LAS unsigned* st; };
__device__ __forceinline__ XcdBarrier xcd_barrier_post(unsigned* bar, volatile LAS unsigned* st) {
    XcdBarrier b; b.bar = bar; b.x = xb_xcc_id(); b.st = st;
    if (threadIdx.x == 0) (void)xb_add(&bar[XB_XCNT(b.x)], 1u);
    return b;
}
__device__ __forceinline__ void xcd_barrier_complete(unsigned* bar, unsigned x, unsigned& nloc, unsigned& nx) {
    const unsigned G = gridDim.x * gridDim.y * gridDim.z;
    unsigned sum, cnt, mine, sp = 0u;
    for (;;) {
        sum = 0u; cnt = 0u; mine = 0u;
#pragma unroll
        for (unsigned j = 0; j < 16; ++j) { const unsigned c = xb_ld(&bar[XB_XCNT(j)]); sum += c; cnt += (c > 0u) ? 1u : 0u; mine = (j == x) ? c : mine; }
        if (sum == G) break;
        __builtin_amdgcn_s_sleep(1);
        if ((++sp & 255u) == 0u) { if (xb_ld(&bar[XB_TMO])) break; if (sp > XB_SPIN_CAP) { atomicAdd(&bar[XB_TMO], 1u); break; } }
    }
    nloc = mine > 0u ? mine : 1u; nx = cnt > 0u ? cnt : 1u;
}
__device__ __forceinline__ void xcd_barrier(const XcdBarrier& b) {
    asm volatile("s_waitcnt vmcnt(0)" ::: "memory");
    __syncthreads();
    if (threadIdx.x == 0) {
        unsigned* bar = b.bar;
        __builtin_amdgcn_s_waitcnt(0);
        unsigned nloc = b.st[0], nx = b.st[1];
        if (nloc == 0u) { xcd_barrier_complete(bar, b.x, nloc, nx); b.st[0] = nloc; b.st[1] = nx; }
        const unsigned old = xb_add(&bar[XB_XSUB(b.x)], 1u);
        const unsigned gen = old / nloc;
        if (old + 1u == (gen + 1u) * nloc) {
            __builtin_amdgcn_fence(__ATOMIC_RELEASE, "agent");
            asm volatile("s_waitcnt vmcnt(0)" ::: "memory");
            const unsigned og = xb_add(&bar[XB_TOP], 1u);
            const unsigned tg = og / nx;
            if (og + 1u == (tg + 1u) * nx) xb_add(&bar[XB_TOPGEN], 1u);
            else XB_SPIN(xb_ld(&bar[XB_TOPGEN]) == tg, bar);
            __builtin_amdgcn_fence(__ATOMIC_ACQUIRE, "agent");
            xb_add(&bar[XB_XGEN(b.x)], 1u);
            asm volatile("s_waitcnt vmcnt(0)" ::: "memory");
        } else {
            XB_SPIN(xb_ld(&bar[XB_XGEN(b.x)]) == gen, bar);
            __builtin_amdgcn_fence(__ATOMIC_ACQUIRE, "agent");
            asm volatile("s_waitcnt vmcnt(0)" ::: "memory");
        }
    }
    __syncthreads();
}
#include <hip/hip_cooperative_groups.h>
namespace cg = cooperative_groups;
constexpr int LDS_BYTES = 147456;
constexpr int XB_LDS = LDS_BYTES - 64;
constexpr int CW_BAR = 4096;
constexpr int REP_PA = 1, REP_PB = 1, REP_P1 = 1, REP_GMLP = 1, REP_ATTN = 1, REP_MERGE = 1, REP_MIX = 1, REP_MOE1 = 1, REP_MOE2 = 1, REP_BAR = 0;
__global__ void __launch_bounds__(512, 2) mega(P p) {
    extern __shared__ __attribute__((aligned(16))) unsigned char lds[];
    const int bid = blockIdx.x, nblk = gridDim.x;
    if (threadIdx.x < 16) ((volatile LAS unsigned*)((LAS unsigned char*)lds + XB_LDS))[threadIdx.x] = 0u;
    __syncthreads();
    const XcdBarrier bar = xcd_barrier_post((unsigned*)(p.ws + WS_CTL) + CW_BAR, (volatile LAS unsigned*)((LAS unsigned char*)lds + XB_LDS));
#define GRID_BAR() xcd_barrier(bar)
#define REP(n) _Pragma("unroll 1") for (int rep_ = 0; rep_ < (n); ++rep_)
    REP(REP_PA) { __syncthreads(); phase_prologue_a(p, bid, nblk, lds); } GRID_BAR();
    REP(REP_PB) phase_prologue_b(p, bid, nblk); GRID_BAR();
    REP(REP_P1) phase_proj_fast(p, bid, nblk, lds); GRID_BAR();
    REP(REP_GMLP) phase_gmlp_fast(p, bid, nblk, lds); REP(REP_ATTN) phase_attn_s(p, bid, nblk, lds); GRID_BAR();
    REP(REP_MERGE) phase_merge_fast(p, bid, nblk, lds); GRID_BAR();
    REP(REP_MIX) phase_mix_fast(p, bid, nblk, lds); GRID_BAR();
    phase_router(p, bid, nblk, lds); GRID_BAR();
    REP(REP_BAR) GRID_BAR();
    REP(REP_MOE1) phase_moe1_fast(p, bid, nblk, lds); GRID_BAR();
    REP(REP_MOE2) phase_moe2_fast(p, bid, nblk, lds); GRID_BAR();
#undef REP
    phase_final(p, bid, nblk, lds);
}

extern "C" void kernel_launch(void* const* d_in, const int* in_sizes, int n_in, void* d_out, int out_size, void* d_ws, size_t ws_size, hipStream_t stream) {
    static int grid = 0;
    if (grid == 0) {
        if (n_in != 31 || out_size != NTOK * DM || ws_size < WS_END) { fprintf(stderr, "kernel_launch: unexpected sizes n_in %d out %d ws %zu\n", n_in, out_size, ws_size); grid = -1; return; }
        int dev = 0, cus = 0, per_cu = 0;
        if (hipGetDevice(&dev) != hipSuccess || hipDeviceGetAttribute(&cus, hipDeviceAttributeMultiprocessorCount, dev) != hipSuccess) { grid = -1; return; }
        if (hipFuncSetAttribute((const void*)mega, hipFuncAttributeMaxDynamicSharedMemorySize, LDS_BYTES) != hipSuccess) { fprintf(stderr, "kernel_launch: hipFuncSetAttribute failed\n"); grid = -1; return; }
        if (hipOccupancyMaxActiveBlocksPerMultiprocessor(&per_cu, (const void*)mega, 512, LDS_BYTES) != hipSuccess || per_cu < 1) { fprintf(stderr, "kernel_launch: occupancy query failed (%d)\n", per_cu); grid = -1; return; }
        grid = cus * 1;
    }
    if (grid < 0) return;
    P p{};
    const float** pp = (const float**)&p;
    for (int i = 0; i < 31; ++i) pp[i] = (const float*)d_in[i];
    p.out = (float*)d_out; p.ws = (unsigned char*)d_ws; p.ph_lo = 0; p.ph_hi = 0;
    if (hipMemsetAsync((char*)d_ws + WS_CTL, 0, 1 * MiB, stream) != hipSuccess) { fprintf(stderr, "kernel_launch: memset failed\n"); return; }
    hipLaunchKernelGGL(mega, dim3(grid), dim3(512), LDS_BYTES, stream, p);
    const hipError_t e = hipPeekAtLastError();
    if (e != hipSuccess) fprintf(stderr, "launch failed: %s (grid %d)\n", hipGetErrorString(e), grid);
}
```

```cpp
#include <hip/hip_runtime.h>
#include <cstdio>
#include <cstdint>

typedef unsigned short bf16_t;
typedef short bf16x8 __attribute__((ext_vector_type(8)));
typedef float f32x4 __attribute__((ext_vector_type(4)));
typedef unsigned u32x4 __attribute__((ext_vector_type(4)));
typedef unsigned u32x2 __attribute__((ext_vector_type(2)));

constexpr int DM = 1024, NB = 8, SEQ = 4096, NTOK = NB * SEQ, CTXL = 256, NCTX = NB * CTXL, INW = 7168;
constexpr int NE = 32, TOPK = 4, FF = 1024, NASSIGN = NTOK * TOPK;
constexpr int NHEAD = 16, HD = 64, GW = 64;
constexpr float LN_EPS = 1e-5f;
constexpr float ALPHA = 1.189207115002721f;
constexpr int MAXTILES = NASSIGN / 256 + NE;

constexpr size_t MiB = 1u << 20;
constexpr size_t WS_CTL = 0;
constexpr size_t WS_MOD = 1 * MiB;
constexpr size_t WS_ROPE = 1 * MiB + 512 * 1024;
constexpr size_t WS_ROWSTAT = 2 * MiB;
constexpr size_t WS_ZSTAT = 2 * MiB + 512 * 1024;
constexpr size_t WS_TOPE = 3 * MiB;
constexpr size_t WS_TOPG = 4 * MiB;
constexpr size_t WS_SLOT = 5 * MiB;
constexpr size_t WS_PERM = 6 * MiB;
constexpr size_t WS_TILES = 7 * MiB;
constexpr size_t WS_WIN = 8 * MiB;
constexpr size_t WS_WPA = 22 * MiB, WS_WPB = 24 * MiB, WS_WOUT = 26 * MiB, WS_WSB = 28 * MiB;
constexpr size_t WS_KC = 30 * MiB;
constexpr size_t WS_VCT = 34 * MiB;
constexpr size_t WS_UC = 38 * MiB;
constexpr size_t WS_PERM2 = 42 * MiB;
constexpr size_t WS_W1 = 48 * MiB;
constexpr size_t WS_W2 = 176 * MiB;
constexpr size_t WS_U = 240 * MiB;
constexpr size_t WS_ZU = 304 * MiB;
constexpr size_t WS_ZVT = 368 * MiB;
constexpr size_t WS_Q = 432 * MiB;
constexpr size_t WS_K = 496 * MiB;
constexpr size_t WS_VT = 560 * MiB;
constexpr size_t WS_G = 624 * MiB;
constexpr size_t WS_YB = 752 * MiB;
constexpr size_t WS_INNER = 816 * MiB;
constexpr size_t WS_ACT = WS_ZU;
constexpr size_t WS_YS = WS_G;
constexpr size_t WS_X1PRE = WS_YB;
constexpr size_t WS_X1 = WS_VT;
constexpr size_t WS_END = 880 * MiB;

struct P {
    const float *x, *c, *ctx, *c_ctx, *ln_x_g, *ln_x_b, *ln_ctx_g, *ln_ctx_b, *w_ada, *b_ada, *w_in, *b_in, *gmlp_ln_g, *gmlp_ln_b, *gmlp_ws, *gmlp_bs,
        *na_rpb, *w_pa, *w_pb, *w_out, *b_out, *ln1_g, *ln1_b, *ln2_g, *ln2_b, *router_w, *router_b, *exp_w1, *exp_b1, *exp_w2, *exp_b2;
    float* out; unsigned char* ws; int ph_lo, ph_hi;
};

__device__ __forceinline__ int tid_opaque() { int t = threadIdx.x; asm volatile("" : "+v"(t)); return t; }
typedef float f32x2_ __attribute__((ext_vector_type(2))); typedef __bf16 bf16x2_ __attribute__((ext_vector_type(2)));
__device__ __forceinline__ unsigned pk2(float lo, float hi) { const f32x2_ v = {lo, hi}; return __builtin_bit_cast(unsigned, __builtin_convertvector(v, bf16x2_)); }
__device__ __forceinline__ unsigned f2bf(float f) { return pk2(f, 0.f) & 0xffffu; }
__device__ __forceinline__ float bf2f(unsigned h) { return __builtin_bit_cast(float, (h & 0xffffu) << 16); }
__device__ __forceinline__ float bflo(unsigned w) { return __builtin_bit_cast(float, w << 16); }
__device__ __forceinline__ float bfhi(unsigned w) { return __builtin_bit_cast(float, w & 0xffff0000u); }
__device__ __forceinline__ u32x2 pack8_f8(f32x4 a, f32x4 b) {
    int w0 = 0, w1 = 0;
    w0 = __builtin_amdgcn_cvt_pk_fp8_f32(a[0], a[1], w0, false); w0 = __builtin_amdgcn_cvt_pk_fp8_f32(a[2], a[3], w0, true);
    w1 = __builtin_amdgcn_cvt_pk_fp8_f32(b[0], b[1], w1, false); w1 = __builtin_amdgcn_cvt_pk_fp8_f32(b[2], b[3], w1, true);
    u32x2 r; r.x = (unsigned)w0; r.y = (unsigned)w1; return r;
}
typedef float f32x2u __attribute__((ext_vector_type(2)));
__device__ __forceinline__ f32x4 unpack4_f8(unsigned w) { const f32x2u lo = __builtin_amdgcn_cvt_pk_f32_fp8((int)w, false), hi = __builtin_amdgcn_cvt_pk_f32_fp8((int)w, true); return (f32x4){lo.x, lo.y, hi.x, hi.y}; }
constexpr float YS_F8_SCALE = 16.0f;
constexpr float YA_F8_SCALE = 4.0f, YB_F8_SCALE = 16.0f, WP_F8_SCALE = 256.0f;
constexpr float U_F8_SCALE = 16.0f, WIN_F8_SCALE = 256.0f;
template <int CTRL> __device__ __forceinline__ float dpp_f(float v) { return __builtin_bit_cast(float, __builtin_amdgcn_update_dpp(0, __builtin_bit_cast(int, v), CTRL, 0xF, 0xF, true)); }
template <int CTRL> __device__ __forceinline__ int dpp_i(int v) { return __builtin_amdgcn_update_dpp(0, v, CTRL, 0xF, 0xF, true); }
constexpr int DPP_XOR1 = 0xB1, DPP_XOR2 = 0x4E, DPP_QREV = 0x1B, DPP_HMIRROR = 0x141, DPP_MIRROR = 0x140, DPP_ROR8 = 0x128;
__device__ __forceinline__ void swap16(float v, float& x, float& y) { x = v; y = v; asm volatile("s_nop 1\n\tv_permlane16_swap_b32 %0, %1" : "+v"(x), "+v"(y)); }
__device__ __forceinline__ void swap32(float v, float& x, float& y) { x = v; y = v; asm volatile("s_nop 1\n\tv_permlane32_swap_b32 %0, %1" : "+v"(x), "+v"(y)); }
__device__ __forceinline__ float rows_sum(float v) { float x, y; swap16(v, x, y); v = x + y; swap32(v, x, y); return x + y; }
__device__ __forceinline__ float rows_max(float v) { float x, y; swap16(v, x, y); v = fmaxf(x, y); swap32(v, x, y); return fmaxf(x, y); }
__device__ __forceinline__ float wave_sum(float v) {
    v += dpp_f<DPP_XOR1>(v); v += dpp_f<DPP_XOR2>(v); v += dpp_f<DPP_HMIRROR>(v); v += dpp_f<DPP_MIRROR>(v);
    return rows_sum(v);
}
__device__ __forceinline__ float wave_max(float v) {
    v = fmaxf(v, dpp_f<DPP_XOR1>(v)); v = fmaxf(v, dpp_f<DPP_XOR2>(v)); v = fmaxf(v, dpp_f<DPP_HMIRROR>(v)); v = fmaxf(v, dpp_f<DPP_MIRROR>(v));
    return rows_max(v);
}
__device__ __forceinline__ int wave_min_i(int v) {
    v = min(v, dpp_i<DPP_XOR1>(v)); v = min(v, dpp_i<DPP_XOR2>(v)); v = min(v, dpp_i<DPP_HMIRROR>(v)); v = min(v, dpp_i<DPP_MIRROR>(v));
    float x, y; swap16(__builtin_bit_cast(float, v), x, y); v = min(__builtin_bit_cast(int, x), __builtin_bit_cast(int, y));
    swap32(__builtin_bit_cast(float, v), x, y); return min(__builtin_bit_cast(int, x), __builtin_bit_cast(int, y));
}
template <int ST> __device__ __forceinline__ float xor_row(float v) {
    if constexpr (ST == 0) return dpp_f<DPP_XOR1>(v);
    else if constexpr (ST == 1) return dpp_f<DPP_XOR2>(v);
    else if constexpr (ST == 2) return dpp_f<DPP_QREV>(dpp_f<DPP_HMIRROR>(v));
    else return dpp_f<DPP_ROR8>(v);
}
__device__ __forceinline__ float gelu_exact(float v) { return 0.5f * v * (1.0f + erff(v * 0.70710678118654752f)); }
__device__ __forceinline__ float sigmoidf_(float v) { return 1.0f / (1.0f + __expf(-v)); }

__device__ __forceinline__ void mod_item(const P& p, int item, float* ldsf) {
    const int tid = tid_opaque(), wave = tid >> 6, lane = tid & 63;
    float* sl = ldsf; float* red = ldsf + 9 * 1024;
    for (int i = tid; i < 9 * 1024; i += 512) { const int r = i >> 10, k = i & 1023; const float cv = (r < 8) ? p.c[r * 1024 + k] : p.c_ctx[k]; sl[i] = cv / (1.0f + __expf(-cv)); }
    __syncthreads();
    const int col = item * 32 + (lane & 31), kpar = lane >> 5;
    float acc[9];
#pragma unroll
    for (int r = 0; r < 9; ++r) acc[r] = 0.f;
    const float* wp = p.w_ada + (size_t)(wave * 128 + kpar) * 6144 + col; const float* sp = sl + wave * 128 + kpar;
#pragma unroll 1
    for (int k8 = 0; k8 < 64; k8 += 8) {
        float w[8];
#pragma unroll
        for (int u = 0; u < 8; ++u) w[u] = wp[(size_t)(k8 + u) * 2 * 6144];
#pragma unroll
        for (int u = 0; u < 8; ++u)
#pragma unroll
            for (int r = 0; r < 9; ++r) acc[r] += sp[r * 1024 + (k8 + u) * 2] * w[u];
    }
#pragma unroll
    for (int r = 0; r < 9; ++r) red[((wave * 2 + kpar) * 9 + r) * 32 + (lane & 31)] = acc[r];
    __syncthreads();
    if (tid < 288) {
        const int r = tid >> 5, cc = tid & 31; float s = 0.f;
#pragma unroll
        for (int q = 0; q < 16; ++q) s += red[(q * 9 + r) * 32 + cc];
        ((float*)(p.ws + WS_MOD))[r * 6144 + item * 32 + cc] = s + p.b_ada[item * 32 + cc];
    }
    __syncthreads();
}
__device__ __forceinline__ void transpose_item(const float* W, int K, int N, bf16_t* WT, int k0, int n0, int drow0, int lane) {
    const int kg = lane >> 3, ng = lane & 7;
    f32x4 v[8];
#pragma unroll
    for (int i = 0; i < 8; ++i) v[i] = *(const f32x4*)(W + (size_t)(k0 + 8 * kg + i) * N + n0 + 4 * ng);
#pragma unroll
    for (int q = 0; q < 4; ++q) { u32x4 o; o.x = pk2(v[0][q], v[1][q]); o.y = pk2(v[2][q], v[3][q]); o.z = pk2(v[4][q], v[5][q]); o.w = pk2(v[6][q], v[7][q]);
        *(u32x4*)(WT + (size_t)(drow0 + 4 * ng + q) * K + k0 + 8 * kg) = o; }
}
__device__ __forceinline__ void f8t_load(const float* W, int N, int k0, int n0, int lane, f32x4 (&v)[8]) {
    const int kg = lane >> 3, ng = lane & 7;
#pragma unroll
    for (int i = 0; i < 8; ++i) v[i] = __builtin_nontemporal_load((const f32x4*)(W + (size_t)(k0 + 8 * kg + i) * N + n0 + 4 * ng));
}
__device__ __forceinline__ void f8t_finish(const f32x4 (&v)[8], int K, unsigned char* WT, int k0, int drow0, float scale, int lane) {
    const int kg = lane >> 3, ng = lane & 7;
#pragma unroll
    for (int q = 0; q < 4; ++q)
        __builtin_nontemporal_store(pack8_f8((f32x4){v[0][q], v[1][q], v[2][q], v[3][q]} * scale, (f32x4){v[4][q], v[5][q], v[6][q], v[7][q]} * scale), (u32x2*)(WT + (size_t)(drow0 + 4 * ng + q) * K + k0 + 8 * kg));
}
__device__ __forceinline__ void transpose_item_f8(const float* W, int K, int N, unsigned char* WT, int k0, int n0, int drow0, float scale, int lane) {
    f32x4 v[8]; f8t_load(W, N, k0, n0, lane, v); f8t_finish(v, K, WT, k0, drow0, scale, lane);
}
constexpr float W_F8_SCALE = 256.0f, ACT_F8_SCALE = 4.0f;
constexpr int IT_WIN = 16 * 224, IT_SQ = 16 * 32, IT_W1 = 32 * 16 * 64, IT_W2 = 32 * 16 * 32, IT_WS = 32;
constexpr int IT_EXP0 = IT_WIN + 3 * IT_SQ;
__device__ __forceinline__ void convert_item(const P& p, int it, int lane) {
    unsigned char* ws = p.ws;
    if (it < IT_WIN) { const int kb = it / 224, nb = it % 224; transpose_item_f8(p.w_in, 1024, INW, ws + WS_WIN, kb * 64, nb * 32, nb * 32, WIN_F8_SCALE, lane); return; } it -= IT_WIN;
    if (it < IT_SQ) { const int kb = it / 32, nb = it % 32; transpose_item_f8(p.w_pa, 1024, 1024, ws + WS_WPA, kb * 64, nb * 32, nb * 32, WP_F8_SCALE, lane); return; } it -= IT_SQ;
    if (it < IT_SQ) { const int kb = it / 32, nb = it % 32; transpose_item_f8(p.w_pb, 1024, 1024, ws + WS_WPB, kb * 64, nb * 32, nb * 32, WP_F8_SCALE, lane); return; } it -= IT_SQ;
    if (it < IT_SQ) { const int kb = it / 32, nb = it % 32; transpose_item(p.w_out, 1024, 1024, (bf16_t*)(ws + WS_WOUT), kb * 64, nb * 32, nb * 32, lane); return; } it -= IT_SQ;
    { bf16_t* o = (bf16_t*)(ws + WS_WSB); const float* s = p.gmlp_ws + it * 4096;
      for (int i = lane; i < 4096; i += 64) o[it * 4096 + i] = (bf16_t)f2bf(s[i]); }
}
__device__ __forceinline__ void phase_prologue_a(const P& p, int bid, int nblk, unsigned char* lds) {
    const int tid = tid_opaque(), wave = tid >> 6, lane = tid & 63;
    for (int item = bid; item < 192; item += nblk) mod_item(p, item, (float*)lds);
    if (bid == nblk - 1) {
        for (int i = tid; i < 1024; i += 512) { const int pos = i >> 4, fi = i & 15;
            const float inv = __builtin_amdgcn_exp2f(-(float)fi * (13.287712379549449f / 16.0f));
            const float ang = (float)pos * inv; const float rev = ang * 0.15915494309189535f;
            float* t = (float*)(p.ws + WS_ROPE); t[2 * i] = __builtin_amdgcn_cosf(rev); t[2 * i + 1] = __builtin_amdgcn_sinf(rev); }
    }
    __syncthreads();
    const int gw = bid * 8 + wave, ngw = nblk * 8;
    for (int it = gw; it < IT_EXP0 + IT_WS; it += ngw) convert_item(p, it, lane);
}
struct PbSrc { const float *x, *g, *b, *sh, *sc; unsigned char* o; float* stat; };
struct PbData { f32x4 v[4], pg[4], pb[4], psh[4], psc[4]; };
__device__ __forceinline__ PbSrc pb_src(const P& p, int row) {
    const float* mod = (const float*)(p.ws + WS_MOD); PbSrc s;
    if (row < NTOK) { const int b = row >> 12; s.x = p.x + (size_t)row * DM; s.g = p.ln_x_g; s.b = p.ln_x_b; s.sh = mod + b * 6144; s.sc = mod + b * 6144 + 1024; s.o = p.ws + WS_U + (size_t)row * DM; s.stat = (float*)(p.ws + WS_ROWSTAT) + 2 * row; }
    else { const int r = row - NTOK; s.x = p.ctx + (size_t)r * DM; s.g = p.ln_ctx_g; s.b = p.ln_ctx_b; s.sh = mod + 8 * 6144; s.sc = mod + 8 * 6144 + 1024; s.o = p.ws + WS_UC + (size_t)r * DM; s.stat = nullptr; }
    return s;
}
__device__ __forceinline__ void pb_load(const PbSrc& s, PbData& d, int lane) {
#pragma unroll
    for (int j = 0; j < 4; ++j) d.v[j] = ((const f32x4*)s.x + lane)[64 * j];
#pragma unroll
    for (int j = 0; j < 4; ++j) { const int col = 4 * lane + 256 * j; d.pg[j] = *(const f32x4*)(s.g + col); d.pb[j] = *(const f32x4*)(s.b + col); d.psh[j] = *(const f32x4*)(s.sh + col); d.psc[j] = *(const f32x4*)(s.sc + col); }
}
__device__ __forceinline__ void pb_row(const PbSrc& src, PbData& d, int lane) {
    float s = 0.f;
#pragma unroll
    for (int j = 0; j < 4; ++j) s += (d.v[j].x + d.v[j].y) + (d.v[j].z + d.v[j].w);
    const float mean = wave_sum(s) * (1.f / DM); float s2 = 0.f;
#pragma unroll
    for (int j = 0; j < 4; ++j) { d.v[j] = d.v[j] - mean; s2 += (d.v[j].x * d.v[j].x + d.v[j].y * d.v[j].y) + (d.v[j].z * d.v[j].z + d.v[j].w * d.v[j].w); }
    const float rstd = 1.f / sqrtf(wave_sum(s2) * (1.f / DM) + LN_EPS);
    if (src.stat && lane == 0) { src.stat[0] = mean; src.stat[1] = rstd; }
    unsigned* o4 = (unsigned*)src.o + lane;
#pragma unroll
    for (int j = 0; j < 4; ++j) {
        f32x4 y = (d.v[j] * rstd) * d.pg[j] + d.pb[j]; y = y * (1.0f + d.psc[j]) + d.psh[j];
        y = __builtin_elementwise_min(__builtin_elementwise_max(y * U_F8_SCALE, (f32x4){-448.f, -448.f, -448.f, -448.f}), (f32x4){448.f, 448.f, 448.f, 448.f});
        int w = 0; w = __builtin_amdgcn_cvt_pk_fp8_f32(y.x, y.y, w, false); w = __builtin_amdgcn_cvt_pk_fp8_f32(y.z, y.w, w, true); o4[64 * j] = (unsigned)w; }
}
__device__ __forceinline__ void phase_prologue_b(const P& p, int bid, int nblk) {
    const int tid = tid_opaque(), wave = tid >> 6, lane = tid & 63;
    const int ngw = nblk * 8;
    int row = bid * 8 + wave; if (row >= NTOK + NCTX) return;
    PbSrc sc = pb_src(p, row); PbData dc, dn; pb_load(sc, dc, lane);
#pragma unroll 1
    for (;;) {
        const int row_n = row + ngw; PbSrc sn = sc;
        if (row_n < NTOK + NCTX) { sn = pb_src(p, row_n); pb_load(sn, dn, lane); }
        pb_row(sc, dc, lane);
        if (row_n >= NTOK + NCTX) break;
        row = row_n; sc = sn; dc = dn;
    }
}

__device__ __forceinline__ bf16x8 pack8(const float (&v)[8]) { u32x4 w; w.x = pk2(v[0], v[1]); w.y = pk2(v[2], v[3]); w.z = pk2(v[4], v[5]); w.w = pk2(v[6], v[7]); return __builtin_bit_cast(bf16x8, w); }
__device__ __forceinline__ void phase_gmlp_fast(const P& p, int bid, int nblk, unsigned char* lds) {
    const int tid = tid_opaque(), g = tid >> 6, lane = tid & 63, fr = lane & 15, fq = lane >> 4;
    float* part = (float*)lds;
    float* stat = part + 8 * 128 * 2;
    const bf16_t* ZVT = (const bf16_t*)(p.ws + WS_ZVT); const bf16_t* ZU = (const bf16_t*)(p.ws + WS_ZU); const bf16_t* WSB = (const bf16_t*)(p.ws + WS_WSB);
    unsigned char* YA = p.ws + WS_U;
    for (int chunk = bid; chunk < NTOK / 128; chunk += nblk) {
        const int tok0 = chunk * 128;
        __syncthreads();
        { float s1[8], s2[8];
#pragma unroll
          for (int jj = 0; jj < 8; ++jj) { s1[jj] = 0.f; s2[jj] = 0.f; }
          const bf16_t* zp = ZVT + (((size_t)(tok0 >> 3) + fr) * 1024 + 128 * g + fq) * 8;
#pragma unroll 8
          for (int it = 0; it < 32; ++it) { const bf16x8 v = *(const bf16x8*)(zp + (4 * it) * 8);
#pragma unroll
              for (int jj = 0; jj < 8; ++jj) { const float f = bf2f((unsigned)(unsigned short)v[jj]); s1[jj] += f; s2[jj] += f * f; } }
#pragma unroll
          for (int jj = 0; jj < 8; ++jj) { s1[jj] = rows_sum(s1[jj]); s2[jj] = rows_sum(s2[jj]); }
          if (fq == 0) {
#pragma unroll
              for (int jj = 0; jj < 8; ++jj) { part[(g * 128 + 8 * fr + jj) * 2] = s1[jj]; part[(g * 128 + 8 * fr + jj) * 2 + 1] = s2[jj]; } } }
        __syncthreads();
        if (tid < 128) { float a = 0.f, b = 0.f;
#pragma unroll
            for (int w = 0; w < 8; ++w) { a += part[(w * 128 + tid) * 2]; b += part[(w * 128 + tid) * 2 + 1]; }
            const float mean = a * (1.f / 1024.f), var = fmaxf(b * (1.f / 1024.f) - mean * mean, 0.f);
            stat[2 * tid] = mean; stat[2 * tid + 1] = 1.f / sqrtf(var + LN_EPS); }
        __syncthreads();
#pragma unroll 1
        for (int ph = 0; ph < 2; ++ph) {
            int tp = tid; asm volatile("" : "+v"(tp));
            const int g = __builtin_amdgcn_readfirstlane(tp >> 6), fr = tp & 15, fq = (tp >> 4) & 3;
            bf16x8 wf[4][4]; float t1[4], t2[4], bsv[4];
#pragma unroll
            for (int pt = 0; pt < 4; ++pt) { const int pp = 64 * ph + 16 * pt + fr; float t1a = 0.f, t2a = 0.f;
                const __attribute__((address_space(3))) float* stat3 = (const __attribute__((address_space(3))) float*)((const __attribute__((address_space(3))) unsigned char*)lds + 8 * 128 * 2 * 4);
                int so = 16 * fq; asm volatile("" : "+v"(so));
#pragma unroll
                for (int ks = 0; ks < 4; ++ks) { const bf16x8 w = *(const bf16x8*)(WSB + ((size_t)g * 128 + pp) * 128 + 32 * ks + 8 * fq);
                    float wv[8];
#pragma unroll
                    for (int jj = 0; jj < 8; ++jj) { const float w0 = bf2f((unsigned)(unsigned short)w[jj]); t2a += w0; wv[jj] = w0 * stat3[so + 2 * (32 * ks + jj) + 1]; }
                    const bf16x8 wp = pack8(wv); wf[pt][ks] = wp;
#pragma unroll
                    for (int jj = 0; jj < 8; ++jj) t1a += bf2f((unsigned)(unsigned short)wp[jj]) * stat3[so + 2 * (32 * ks + jj)]; }
                t1a = rows_sum(t1a); t2a = rows_sum(t2a);
                t1[pt] = t1a; t2[pt] = t2a; bsv[pt] = p.gmlp_bs[g * 128 + pp]; }
            constexpr int GM_D = 3;
            bf16x8 afn[GM_D][4]; u32x2 zun[GM_D][4]; f32x4 gcn[GM_D], bcn[GM_D];
#define GM_LOAD(ct_) do { constexpr int s_ = (ct_) % GM_D; const bf16_t* zp_ = ZVT + (((size_t)(tok0 >> 3) + fq) * 1024 + 128 * g + 16 * (ct_) + fr) * 8; const int c_ = 128 * g + 16 * (ct_) + 4 * fq; \
                _Pragma("unroll") for (int ks = 0; ks < 4; ++ks) afn[s_][ks] = *(const bf16x8*)(zp_ + (size_t)ks * 4 * 1024 * 8); \
                _Pragma("unroll") for (int pt = 0; pt < 4; ++pt) zun[s_][pt] = *(const u32x2*)(ZU + (size_t)(tok0 + 64 * ph + 16 * pt + fr) * 1024 + c_); \
                gcn[s_] = *(const f32x4*)(p.gmlp_ln_g + c_); bcn[s_] = *(const f32x4*)(p.gmlp_ln_b + c_); asm volatile("" ::: "memory"); } while (0)
#define GM_TILE(ct_) do { constexpr int s_ = (ct_) % GM_D; if ((ct_) + GM_D - 1 < 8) GM_LOAD(((ct_) + GM_D - 1) % 8); \
                const int c = 128 * g + 16 * (ct_) + 4 * fq; \
                f32x4 acc[4]; \
                _Pragma("unroll") for (int pt = 0; pt < 4; ++pt) { acc[pt] = (f32x4){0.f, 0.f, 0.f, 0.f}; \
                    _Pragma("unroll") for (int ks = 0; ks < 4; ++ks) acc[pt] = __builtin_amdgcn_mfma_f32_16x16x32_bf16(afn[s_][ks], wf[pt][ks], acc[pt], 0, 0, 0); } \
                _Pragma("unroll") for (int pt = 0; pt < 4; ++pt) { const size_t off = (size_t)(tok0 + 64 * ph + 16 * pt + fr) * 1024 + c; \
                    const u32x2 zu = zun[s_][pt]; \
                    const f32x4 s = gcn[s_] * (acc[pt] - t1[pt]) + bcn[s_] * t2[pt] + bsv[pt]; \
                    const f32x4 y = __builtin_elementwise_min(__builtin_elementwise_max((f32x4){bflo(zu.x) * s[0], bfhi(zu.x) * s[1], bflo(zu.y) * s[2], bfhi(zu.y) * s[3]} * YA_F8_SCALE, (f32x4){-448.f, -448.f, -448.f, -448.f}), (f32x4){448.f, 448.f, 448.f, 448.f}); \
                    int w = 0; w = __builtin_amdgcn_cvt_pk_fp8_f32(y[0], y[1], w, false); w = __builtin_amdgcn_cvt_pk_fp8_f32(y[2], y[3], w, true); \
                    *(unsigned*)(YA + off) = (unsigned)w; } \
                asm volatile("" ::: "memory"); } while (0)
            GM_LOAD(0); GM_LOAD(1);
            GM_TILE(0); GM_TILE(1); GM_TILE(2); GM_TILE(3); GM_TILE(4); GM_TILE(5); GM_TILE(6); GM_TILE(7);
#undef GM_TILE
#undef GM_LOAD
        }
    }
}
constexpr int AT_LDS_RPB = 0, AT_LDS_KC = 4096, AT_LDS_VC = AT_LDS_KC + 32768, AT_LDS_END = AT_LDS_VC + 32768;
typedef __attribute__((address_space(3))) const unsigned char* lds_cp;
__device__ __forceinline__ void attn_stage(const P& p, unsigned char* lds, int b, int h, int tid) {
    float* tbl = (float*)(lds + AT_LDS_RPB);
    for (int idx = tid; idx < 15 * 64; idx += 512) { const int dr = idx >> 6, cc = idx & 63; tbl[idx] = (cc >= 16 && cc < 47) ? p.na_rpb[(h * 15 + dr) * 31 + cc - 16] * 1.4426950408889634f : 0.f; }
    const size_t bh = (size_t)b * 16 + h;
    const u32x4* kc = (const u32x4*)((const bf16_t*)(p.ws + WS_KC) + bh * 256 * 64); const u32x4* vc = (const u32x4*)((const bf16_t*)(p.ws + WS_VCT) + bh * 32 * 512);
#pragma unroll
    for (int i = 0; i < 4; ++i) { const int q = tid + 512 * i, key = q >> 3, c = q & 7; const int fk = ((key >> 1) & 1) | (((key >> 3) & 1) << 1) | (((key >> 4) & 1) << 2);
        *(u32x4*)(lds + AT_LDS_KC + key * 128 + ((c ^ fk) << 4)) = kc[q]; *(u32x4*)(lds + AT_LDS_VC + q * 16) = vc[q]; }
}
struct AttnTile { bf16x8 qrt[2]; f32x4 o[4], nm; f32x2_ l2; float m2; };
__device__ __forceinline__ void attn_tile_init(const P& p, AttnTile& T, size_t bh, int r, int qc, int fq) {
    const bf16_t* Q = (const bf16_t*)(p.ws + WS_Q); const float* tab = (const float*)(p.ws + WS_ROPE);
    constexpr float QS = 0.125f * 1.4426950408889634f;
#pragma unroll
    for (int s = 0; s < 2; ++s) {
        const bf16_t* qb = Q + (bh * 4096 + r * 64 + qc) * 64 + 32 * s;
        const bf16x8 me = *(const bf16x8*)(qb + 8 * fq), ot = *(const bf16x8*)(qb + 8 * (fq ^ 2));
        const int pos = s ? qc : r; const float* tb = tab + (pos * 16 + 8 * (fq & 1)) * 2;
        float rot[8];
#pragma unroll
        for (int jj = 0; jj < 8; ++jj) { const float cv = tb[2 * jj] * QS, sv = tb[2 * jj + 1] * QS;
            const float xv = bf2f((unsigned)(unsigned short)me[jj]), ov = bf2f((unsigned)(unsigned short)ot[jj]);
            rot[jj] = (fq < 2) ? (xv * cv - ov * sv) : (xv * cv + ov * sv); }
        T.qrt[s] = pack8(rot);
    }
#pragma unroll
    for (int dt = 0; dt < 4; ++dt) T.o[dt] = (f32x4){0.f, 0.f, 0.f, 0.f};
    T.m2 = 0.f; T.l2 = (f32x2_){0.f, 0.f}; T.nm = (f32x4){0.f, 0.f, 0.f, 0.f};
}
__device__ __forceinline__ void attn_tiles_qplain(const P& p, AttnTile& TA, AttnTile& TB, size_t bh, int r, int qc, int fq) {
    const bf16_t* Q = (const bf16_t*)(p.ws + WS_Q); constexpr float QS = 0.125f * 1.4426950408889634f;
    bf16x8 me[2][2];
#pragma unroll
    for (int w = 0; w < 2; ++w)
#pragma unroll
        for (int s = 0; s < 2; ++s) me[w][s] = *(const bf16x8*)(Q + (bh * 4096 + (r + w) * 64 + qc) * 64 + 32 * s + 8 * fq);
#pragma unroll
    for (int w = 0; w < 2; ++w)
#pragma unroll
        for (int s = 0; s < 2; ++s) { float pl[8];
#pragma unroll
            for (int jj = 0; jj < 8; ++jj) pl[jj] = bf2f((unsigned)(unsigned short)me[w][s][jj]) * QS;
            (w ? TB : TA).qrt[s] = pack8(pl); }
}
typedef __attribute__((address_space(3))) const float* lds_fp;
__device__ __forceinline__ float fmax_nc(float a, float b) { return __builtin_amdgcn_fmed3f(a, b, INFINITY); }
__device__ __forceinline__ float attn_rowmax(const f32x4 (&d)[2]) {
    float s = fmax_nc(fmax_nc(fmax_nc(d[0][0], d[0][1]), fmax_nc(d[0][2], d[0][3])), fmax_nc(fmax_nc(d[1][0], d[1][1]), fmax_nc(d[1][2], d[1][3])));
    const u32x2 a = __builtin_amdgcn_permlane16_swap(__builtin_bit_cast(unsigned, s), __builtin_bit_cast(unsigned, s), false, false);
    asm("v_max_f32 %0, %1, %2" : "=v"(s) : "v"(a.x), "v"(a.y));
    const u32x2 c = __builtin_amdgcn_permlane32_swap(__builtin_bit_cast(unsigned, s), __builtin_bit_cast(unsigned, s), false, false);
    asm("v_max_f32 %0, %1, %2" : "=v"(s) : "v"(c.x), "v"(c.y)); return s;
}
__device__ __forceinline__ int attn_imax(const f32x4 (&d)[2]) {
    const int a = max(max(__builtin_bit_cast(int, d[0][0]), __builtin_bit_cast(int, d[0][1])), __builtin_bit_cast(int, d[0][2]));
    const int b = max(max(__builtin_bit_cast(int, d[0][3]), __builtin_bit_cast(int, d[1][0])), __builtin_bit_cast(int, d[1][1]));
    return max(max(a, b), max(__builtin_bit_cast(int, d[1][2]), __builtin_bit_cast(int, d[1][3])));
}
constexpr float AT_GUARD = 64.0f;
__device__ __forceinline__ void attn_shift(AttnTile& T, f32x4 (&d)[2], float shift, bool first) {
    const float al = first ? 1.0f : __builtin_amdgcn_exp2f(-shift);
    T.l2 = T.l2 * al;
#pragma unroll
    for (int dt = 0; dt < 4; ++dt) T.o[dt] = T.o[dt] * al;
    T.m2 += shift; T.nm = T.nm - shift; d[0] = d[0] - shift; d[1] = d[1] - shift;
}
__device__ __forceinline__ void attn_pv(AttnTile& T, const f32x4 (&d)[2], const bf16x8 (&vf)[4]) {
    float pv[8];
#pragma unroll
    for (int e = 0; e < 8; ++e) pv[e] = __builtin_amdgcn_exp2f(d[e >> 2][e & 3]);
    T.l2 = T.l2 + (((f32x2_){pv[0], pv[1]} + (f32x2_){pv[2], pv[3]}) + ((f32x2_){pv[4], pv[5]} + (f32x2_){pv[6], pv[7]}));
    const bf16x8 pf = pack8(pv);
#pragma unroll
    for (int dt = 0; dt < 4; ++dt) T.o[dt] = __builtin_amdgcn_mfma_f32_16x16x32_bf16(vf[dt], pf, T.o[dt], 0, 0, 0);
}
template <bool BIAS> __device__ __forceinline__ void attn_step1(AttnTile& T, const bf16x8 (&kf)[2][2], const bf16x8 (&q)[2], const bf16x8 (&vf)[4], const f32x4 (&ma)[2], const f32x4 (&bias)[2], bool first) {
    f32x4 d[2];
#pragma unroll
    for (int t = 0; t < 2; ++t) { const f32x4 c = BIAS ? ma[t] + T.nm : T.nm;
        d[t] = __builtin_amdgcn_mfma_f32_16x16x32_bf16(kf[t][0], q[0], c, 0, 0, 0); d[t] = __builtin_amdgcn_mfma_f32_16x16x32_bf16(kf[t][1], q[1], d[t], 0, 0, 0); }
    if (BIAS) { d[0] = d[0] + bias[0]; d[1] = d[1] + bias[1]; }
    if (first || __any(attn_imax(d) > __builtin_bit_cast(int, AT_GUARD))) { const float smax = attn_rowmax(d); attn_shift(T, d, first ? smax : fmaxf(smax, 0.f), first); }
    attn_pv(T, d, vf);
}
template <bool BIAS> __device__ __forceinline__ void attn_step2(AttnTile& TA, AttnTile& TB, const bf16x8 (&kf)[2][2], const bf16x8 (&qA)[2], const bf16x8 (&qB)[2], const bf16x8 (&vf)[4],
                                           const f32x4 (&ma)[2], const f32x4 (&biasA)[2], const f32x4 (&biasB)[2], bool firstA, bool firstB) {
    f32x4 dA[2], dB[2];
#pragma unroll
    for (int t = 0; t < 2; ++t) { const f32x4 cA = BIAS ? ma[t] + TA.nm : TA.nm, cB = BIAS ? ma[t] + TB.nm : TB.nm;
        dA[t] = __builtin_amdgcn_mfma_f32_16x16x32_bf16(kf[t][0], qA[0], cA, 0, 0, 0); dB[t] = __builtin_amdgcn_mfma_f32_16x16x32_bf16(kf[t][0], qB[0], cB, 0, 0, 0);
        dA[t] = __builtin_amdgcn_mfma_f32_16x16x32_bf16(kf[t][1], qA[1], dA[t], 0, 0, 0); dB[t] = __builtin_amdgcn_mfma_f32_16x16x32_bf16(kf[t][1], qB[1], dB[t], 0, 0, 0); }
    if (BIAS) { dA[0] = dA[0] + biasA[0]; dA[1] = dA[1] + biasA[1]; dB[0] = dB[0] + biasB[0]; dB[1] = dB[1] + biasB[1]; }
    if (firstA || firstB || __any(max(attn_imax(dA), attn_imax(dB)) > __builtin_bit_cast(int, AT_GUARD))) { const float smA = attn_rowmax(dA), smB = attn_rowmax(dB);
        attn_shift(TA, dA, firstA ? smA : fmaxf(smA, 0.f), firstA); attn_shift(TB, dB, firstB ? smB : fmaxf(smB, 0.f), firstB); }
    attn_pv(TA, dA, vf); attn_pv(TB, dB, vf);
}
__device__ __forceinline__ void attn_pair_unit(const P& p, unsigned char* lds, int b, int r, int j, int h, int lane) {
    const int fr = lane & 15, fq = lane >> 4;
    const bf16_t* K = (const bf16_t*)(p.ws + WS_K); const bf16_t* VT = (const bf16_t*)(p.ws + WS_VT); unsigned char* YB = p.ws + WS_YB;
    const int qc = 16 * j + fr; const size_t bh = (size_t)b * 16 + h;
    r = __builtin_amdgcn_readfirstlane(r); j = __builtin_amdgcn_readfirstlane(j);
    const int r0A = min(max(r - 4, 0), 56), r0B = min(max(r + 1 - 4, 0), 56), nst = r0B + 8 - r0A;
    const int c0 = min(max(qc - 8, 0), 48), cs = min(max(16 * j - 8, 0), 32);
    const int sp0 = 8 * (fr >> 2) + (fr & 3);
    const bf16_t* klat = K + (bh * 4096 + r0A * 64 + cs + sp0) * 64 + 8 * fq;
    const bf16_t* vlat = VT + ((bh * 512 + ((r0A * 64 + cs) >> 3) + fq) * 64 + fr) * 8;
    const int fk = ((fr >> 1) & 1) | (((fr >> 2) & 1) << 1) | (((fr >> 3) & 1) << 2);
    const lds_cp kcl = (lds_cp)lds + AT_LDS_KC + sp0 * 128;
    const int kco0 = (fq ^ fk) << 4, kco1 = ((fq + 4) ^ fk) << 4;
    const lds_cp vcl = (lds_cp)lds + AT_LDS_VC + (fq * 64 + fr) * 16;
    const __attribute__((address_space(3))) float* tbl3 = (const __attribute__((address_space(3))) float*)((lds_cp)lds + AT_LDS_RPB);
    const int boffA = (r0A - r + 7) * 64 + (cs + 8 * fq - qc + 31);
    f32x4 ma[2];
#pragma unroll
    for (int jj = 0; jj < 8; ++jj) { const int kc = cs + 8 * fq + jj; ma[jj >> 2][jj & 3] = (kc >= c0 && kc < c0 + 16) ? 0.f : -INFINITY; }
    AttnTile TA, TB;
    attn_tile_init(p, TA, bh, r, qc, fq); attn_tile_init(p, TB, bh, r + 1, qc, fq);
    bf16x8 kf[3][2][2], vf[3][4];
#define LOADKV(buf, st_) do { _Pragma("unroll") for (int t = 0; t < 2; ++t) { const bf16_t* kp_ = klat + (size_t)(st_) * 64 * 64 + t * 4 * 64; kf[buf][t][0] = *(const bf16x8*)kp_; kf[buf][t][1] = *(const bf16x8*)(kp_ + 32); } \
        _Pragma("unroll") for (int dt = 0; dt < 4; ++dt) vf[buf][dt] = *(const bf16x8*)(vlat + dt * 128 + (st_) * 8 * 512); } while (0)
#define LOADBIAS(dst, s_) do { int bo_ = boffA + (s_) * 64; asm volatile("" : "+v"(bo_)); const lds_fp tb_ = tbl3 + bo_; \
        dst[0] = (f32x4){tb_[0], tb_[1], tb_[2], tb_[3]}; dst[1] = (f32x4){tb_[4], tb_[5], tb_[6], tb_[7]}; } while (0)
    const int dB = r0B - r0A;
    f32x4 bp[2], bc[2];
    LOADKV(0, 0); LOADKV(1, 1); LOADBIAS(bc, -1);
#define ATT_STEP(buf, s_) do { const int kr_ = r0A + (s_); const bool doA_ = kr_ <= r0A + 7, doB_ = kr_ >= r0B; \
        bp[0] = bc[0]; bp[1] = bc[1]; LOADBIAS(bc, s_); \
        if (doA_ && doB_) attn_step2<true>(TA, TB, kf[buf], TA.qrt, TB.qrt, vf[buf], ma, bc, bp, (s_) == 0, (s_) == dB); \
        else if (doA_) attn_step1<true>(TA, kf[buf], TA.qrt, vf[buf], ma, bc, (s_) == 0); \
        else attn_step1<true>(TB, kf[buf], TB.qrt, vf[buf], ma, bp, (s_) == dB); } while (0)
#pragma unroll 1
    for (int st = 0; st < nst; st += 3) {
        if (st + 2 < nst) LOADKV(2, st + 2);
        ATT_STEP(0, st);
        if (st + 1 < nst) { if (st + 3 < nst) LOADKV(0, st + 3); ATT_STEP(1, st + 1); }
        if (st + 2 < nst) { if (st + 4 < nst) LOADKV(1, st + 4); ATT_STEP(2, st + 2); }
    }
#undef LOADKV
#undef LOADBIAS
#undef ATT_STEP
    attn_tiles_qplain(p, TA, TB, bh, r, qc, fq);
#pragma unroll 1
    for (int st = 0; st < 8; ++st) {
        bf16x8 kc[2][2], vc[4];
#pragma unroll
        for (int t = 0; t < 2; ++t) { const lds_cp kp_ = kcl + (32 * st + 4 * t) * 128; kc[t][0] = *(const __attribute__((address_space(3))) bf16x8*)(kp_ + kco0); kc[t][1] = *(const __attribute__((address_space(3))) bf16x8*)(kp_ + kco1); }
#pragma unroll
        for (int dt = 0; dt < 4; ++dt) vc[dt] = *(const __attribute__((address_space(3))) bf16x8*)(vcl + st * 4096 + dt * 256);
        attn_step2<false>(TA, TB, kc, TA.qrt, TB.qrt, vc, ma, ma, ma, false, false);
    }
#pragma unroll
    for (int w = 0; w < 2; ++w) { AttnTile& T = w ? TB : TA;
        const float l = rows_sum(T.l2.x + T.l2.y);
        const float inv = YB_F8_SCALE / l; const size_t tq = (size_t)b * SEQ + (r + w) * 64 + qc;
#pragma unroll
        for (int dt = 0; dt < 4; ++dt) { const f32x4 y = __builtin_elementwise_min(__builtin_elementwise_max(T.o[dt] * inv, (f32x4){-448.f, -448.f, -448.f, -448.f}), (f32x4){448.f, 448.f, 448.f, 448.f});
            int ww = 0; ww = __builtin_amdgcn_cvt_pk_fp8_f32(y[0], y[1], ww, false); ww = __builtin_amdgcn_cvt_pk_fp8_f32(y[2], y[3], ww, true);
            *(unsigned*)(YB + tq * 1024 + h * 64 + 16 * dt + 4 * fq) = (unsigned)ww; } }
}
struct ExpItem { const float* W; unsigned char* WT; int N, k0, n0, drow0; };
__device__ __forceinline__ ExpItem exp_item(const P& p, int x) {
    ExpItem I;
    if (x < IT_W1) { const int e = x / 1024, r = x % 1024, kb = r / 64, nb = r % 64, n0 = nb * 32, hf = n0 >> 10, nn = n0 & 1023;
        I.W = p.exp_w1 + (size_t)e * 1024 * 2048; I.WT = p.ws + WS_W1 + (size_t)e * 2048 * 1024; I.N = 2048; I.k0 = kb * 64; I.n0 = n0; I.drow0 = (nn >> 7) * 256 + hf * 128 + (nn & 127); }
    else { x -= IT_W1; const int e = x / 512, r = x % 512, kb = r / 32, nb = r % 32;
        I.W = p.exp_w2 + (size_t)e * 1024 * 1024; I.WT = p.ws + WS_W2 + (size_t)e * 1024 * 1024; I.N = 1024; I.k0 = kb * 64; I.n0 = nb * 32; I.drow0 = nb * 32; }
    return I;
}
constexpr int CV_D = 4, RT_CONV_ITEMS = 160;
__device__ __forceinline__ void convert_stream(const P& p, int vb, int lane, int n0, int n1) {
    f32x4 v[CV_D][8];
#define CV_X(n_) (((n_) >> 3) * 2048 + 8 * vb + ((n_) & 7))
#pragma unroll
    for (int s = 0; s < CV_D; ++s) { const ExpItem I = exp_item(p, CV_X(n0 + s)); f8t_load(I.W, I.N, I.k0, I.n0, lane, v[s]); }
#pragma unroll 1
    for (int n = n0; n < n1; n += CV_D) {
#pragma unroll
        for (int s = 0; s < CV_D; ++s) {
            { const ExpItem I = exp_item(p, CV_X(n + s)); f8t_finish(v[s], 1024, I.WT, I.k0, I.drow0, W_F8_SCALE, lane); }
            if (n + s + CV_D < n1) { const ExpItem I = exp_item(p, CV_X(n + s + CV_D)); f8t_load(I.W, I.N, I.k0, I.n0, lane, v[s]); }
            asm volatile("" ::: "memory"); }
    }
#undef CV_X
}
constexpr int AT_LDS_CNT = AT_LDS_END;
__device__ __forceinline__ void phase_attn_s(const P& p, int bid, int nblk, unsigned char* lds) {
    const int tid_ = tid_opaque(); const int wave = __builtin_amdgcn_readfirstlane(tid_ >> 6), lane = tid_ & 63;
    int* ucnt = (int*)(lds + AT_LDS_CNT);
    for (int vb = bid; vb < 256; vb += nblk) { const int half = vb & 1, h = (vb >> 1) & 15, b = vb >> 5;
        __syncthreads();
        { int ts = tid_; asm volatile("" : "+v"(ts)); attn_stage(p, lds, b, h, ts); }
        if (tid_ == 0) *ucnt = 0;
        __syncthreads();
        if (wave == 7) convert_stream(p, vb, lane, RT_CONV_ITEMS, 192);
        {
#pragma unroll 1
            for (;;) { int lane_o = lane; asm volatile("" : "+v"(lane_o));
                int u = 0; if (lane_o == 0) u = __hip_atomic_fetch_add(ucnt, 1, __ATOMIC_RELAXED, __HIP_MEMORY_SCOPE_WORKGROUP);
                u = __builtin_amdgcn_readfirstlane(u);
                if (u >= 64) break;
                attn_pair_unit(p, lds, b, 32 * half + 2 * (u >> 2), u & 3, h, lane_o); }
        }
    }
}
constexpr int RT_LDS_W = 0, RT_LDS_CNT = 131072, RT_LDS_BASE = RT_LDS_CNT + 128, RT_LDS_REC = RT_LDS_BASE + 128, RT_MAXIT = 32, RT_LDS_END = RT_LDS_REC + 8 * RT_MAXIT * 8 * 4;
__device__ __forceinline__ int rw_off(int prow, int ch) { return prow * 128 + ((ch ^ ((prow >> 1) & 7)) << 4); }
constexpr int RT_RWAVES = 7;
__device__ __forceinline__ void phase_router(const P& p, int bid, int nblk, unsigned char* lds) {
    const int tid = tid_opaque(), wave = __builtin_amdgcn_readfirstlane(tid >> 6), lane = tid & 63;
    int* cnt = (int*)(lds + RT_LDS_CNT); int* base = (int*)(lds + RT_LDS_BASE); int* rec = (int*)(lds + RT_LDS_REC) + wave * RT_MAXIT * 8;
    for (int k = tid; k < 1024; k += 512) { const int l = (k & 255) >> 2, i = k & 3, j = k >> 8, prow = l + 64 * (4 * j + i);
        const f32x4* src = (const f32x4*)(p.router_w + (size_t)k * 32);
#pragma unroll
        for (int ch = 0; ch < 8; ++ch) *(f32x4*)(lds + RT_LDS_W + rw_off(prow, ch)) = src[ch]; }
    if (tid < 32) cnt[tid] = 0;
    __syncthreads();
    const float* mod = (const float*)(p.ws + WS_MOD);
    int* TOPE = (int*)(p.ws + WS_TOPE); float* TOPG = (float*)(p.ws + WS_TOPG); int* SLOT = (int*)(p.ws + WS_SLOT);
    unsigned char* U2 = p.ws + WS_U;
    const int erev = 16 * ((lane >> 4) & 1) + (int)(__builtin_bitreverse32((unsigned)(lane & 15)) >> 28);
    unsigned wb[8];
#pragma unroll
    for (int ch = 0; ch < 8; ++ch) wb[ch] = RT_LDS_W + lane * 128 + ((ch ^ ((lane >> 1) & 7)) << 4);
    unsigned wbh[8];
#pragma unroll
    for (int ch = 0; ch < 8; ++ch) wbh[ch] = wb[ch] + 65536;
    int it = 0;
    const int NRI = 8 * ((NTOK + nblk * 8 - 1) / (nblk * 8));
#define RT_ROW(ri_) (bid * 8 + ((ri_) & 7) + ((ri_) >> 3) * nblk * 8)
    if (wave >= RT_RWAVES) { for (int vb = bid; vb < 256; vb += nblk) convert_stream(p, vb, lane, 0, RT_CONV_ITEMS); }
    else {
    u32x2 pre[4];
    { const int row0 = RT_ROW(wave); if (row0 < NTOK) { const u32x2* xin0 = (const u32x2*)((const bf16_t*)(p.ws + WS_X1PRE) + (size_t)row0 * DM) + lane;
#pragma unroll
        for (int j = 0; j < 4; ++j) pre[j] = xin0[64 * j]; } }
    for (int ri = wave; ri < NRI; ri += RT_RWAVES, ++it) { const int row = RT_ROW(ri); if (row >= NTOK) continue;
        const int b = row >> 12;
        u32x2* xr = (u32x2*)((bf16_t*)(p.ws + WS_X1) + (size_t)row * DM) + lane;
        f32x4 v[4]; float s = 0.f;
#pragma unroll
        for (int j = 0; j < 4; ++j) { const u32x2 w = pre[j]; v[j] = (f32x4){bflo(w.x), bfhi(w.x), bflo(w.y), bfhi(w.y)}; s += (v[j].x + v[j].y) + (v[j].z + v[j].w); }
        { const int rown = (ri + RT_RWAVES < NRI) ? RT_ROW(ri + RT_RWAVES) : NTOK; if (rown < NTOK) { const u32x2* xinn = (const u32x2*)((const bf16_t*)(p.ws + WS_X1PRE) + (size_t)rown * DM) + lane;
#pragma unroll
            for (int j = 0; j < 4; ++j) pre[j] = xinn[64 * j]; } }
        const float mean = wave_sum(s) * (1.f / DM); float s2 = 0.f;
#pragma unroll
        for (int j = 0; j < 4; ++j) { v[j] = v[j] - mean; s2 += (v[j].x * v[j].x + v[j].y * v[j].y) + (v[j].z * v[j].z + v[j].w * v[j].w); }
        const float rstd = 1.f / sqrtf(wave_sum(s2) * (1.f / DM) + LN_EPS);
        unsigned* o8 = (unsigned*)(U2 + (size_t)row * DM) + lane;
        int lane_o = lane; asm volatile("" : "+v"(lane_o));
        f32x4 u[4], pg[4], pb[4], psh[4], psc[4];
#pragma unroll
        for (int j = 0; j < 4; ++j) { const int col = 4 * lane_o + 256 * j;
            pg[j] = *(const f32x4*)(p.ln1_g + col); pb[j] = *(const f32x4*)(p.ln1_b + col); psh[j] = *(const f32x4*)(mod + b * 6144 + 3072 + col); psc[j] = *(const f32x4*)(mod + b * 6144 + 4096 + col); }
#pragma unroll
        for (int j = 0; j < 4; ++j) {
            const f32x4 gg = pg[j], bb = pb[j], shv = psh[j], scv = psc[j];
            const f32x4 x1 = (v[j] * rstd) * gg + bb; { u32x2 w; w.x = pk2(x1.x, x1.y); w.y = pk2(x1.z, x1.w); xr[64 * j] = w; }
            u[j] = x1 * (1.0f + scv) + shv;
            int w = 0; w = __builtin_amdgcn_cvt_pk_fp8_f32(u[j].x, u[j].y, w, false); w = __builtin_amdgcn_cvt_pk_fp8_f32(u[j].z, u[j].w, w, true); o8[64 * j] = (unsigned)w; }
        float lg2[2];
#pragma unroll
        for (int hf = 0; hf < 2; ++hf) {
            f32x2_ a2[8];
#pragma unroll
            for (int e = 0; e < 8; ++e) a2[e] = (f32x2_){0.f, 0.f};
            const __attribute__((address_space(3))) unsigned char* lw = (const __attribute__((address_space(3))) unsigned char*)lds;
#pragma unroll
            for (int j = 0; j < 4; ++j)
#pragma unroll
                for (int i = 0; i < 4; ++i) { const f32x2_ uv = (f32x2_){u[j][i], u[j][i]};
#pragma unroll
                    for (int ch = 0; ch < 4; ++ch) {
                        const f32x4 w4 = (4 * j + i < 8) ? *(const __attribute__((address_space(3))) f32x4*)(lw + wb[4 * hf + ch] + (4 * j + i) * 8192) : *(const __attribute__((address_space(3))) f32x4*)(lw + wbh[4 * hf + ch] + (4 * j + i - 8) * 8192);
                        a2[2 * ch] = __builtin_elementwise_fma((f32x2_){w4.x, w4.y}, uv, a2[2 * ch]); a2[2 * ch + 1] = __builtin_elementwise_fma((f32x2_){w4.z, w4.w}, uv, a2[2 * ch + 1]); } }
            float a[16];
#pragma unroll
            for (int e = 0; e < 8; ++e) { a[2 * e] = a2[e].x; a[2 * e + 1] = a2[e].y; }
#define RS_STAGE(st) { constexpr int n = 8 >> st; const bool up = (lane >> st) & 1; \
                _Pragma("unroll") for (int i = 0; i < n; ++i) { float lo = a[i], hi = a[n + i]; asm volatile("" : "+v"(lo), "+v"(hi));     \
                    const float keep = up ? hi : lo, send = up ? lo : hi; a[i] = keep + xor_row<st>(send); } }
            RS_STAGE(0) RS_STAGE(1) RS_STAGE(2) RS_STAGE(3)
#undef RS_STAGE
            lg2[hf] = rows_sum(a[0]);
        }
        float logit = ((lane >> 4) & 1) ? lg2[1] : lg2[0];
        logit += p.router_b[erev];
        float cur = logit;
#define TOP_STEP(TV, TE) float TV; int TE; { const float mx = wave_max(cur); int cand = (cur == mx) ? erev : 64; \
            cand = wave_min_i(cand); \
            TV = mx; TE = cand; if (erev == cand) cur = -INFINITY; }
        TOP_STEP(tv0, te0) TOP_STEP(tv1, te1) TOP_STEP(tv2, te2) TOP_STEP(tv3, te3)
#undef TOP_STEP
        const float gk0 = 1.0f, gk1 = __expf(tv1 - tv0), gk2 = __expf(tv2 - tv0), gk3 = __expf(tv3 - tv0);
        const float ginv = 1.f / (gk0 + gk1 + gk2 + gk3);
        if (lane < 4) { const int e = lane == 0 ? te0 : lane == 1 ? te1 : lane == 2 ? te2 : te3; const float g = lane == 0 ? gk0 : lane == 1 ? gk1 : lane == 2 ? gk2 : gk3;
            const int pos = atomicAdd(&cnt[e], 1);
            TOPE[row * 4 + lane] = e; TOPG[row * 4 + lane] = g * ginv;
            if (it < RT_MAXIT) { rec[it * 8 + lane * 2] = e; rec[it * 8 + lane * 2 + 1] = pos; } }
    }
    }
    __syncthreads();
    if (tid < 32) base[tid] = atomicAdd((int*)(p.ws + WS_CTL) + tid, cnt[tid]);
    __syncthreads();
    it = 0;
    int* PERM2 = (int*)(p.ws + WS_PERM2);
    if (wave < RT_RWAVES) for (int ri = wave; ri < NRI; ri += RT_RWAVES, ++it) { const int row = RT_ROW(ri);
        if (row < NTOK && lane < 4 && it < RT_MAXIT) { const int e = rec[it * 8 + lane * 2], pos = base[e] + rec[it * 8 + lane * 2 + 1]; SLOT[row * 4 + lane] = pos; PERM2[(size_t)e * NTOK + pos] = row; } }
#undef RT_ROW
}
constexpr int MT_LDS = 131072 + 1024;
__device__ __forceinline__ void moe_tables(const P& p, unsigned char* lds) {
    const int tid = tid_opaque(); int* cn = (int*)(lds + MT_LDS); int* eb = cn + 32; int* tb = eb + 33;
    __syncthreads();
    if (tid < 32) cn[tid] = __hip_atomic_load((int*)(p.ws + WS_CTL) + tid, __ATOMIC_RELAXED, __HIP_MEMORY_SCOPE_AGENT);
    __syncthreads();
    if (tid == 0) { int s = 0, t = 0; for (int e = 0; e < 32; ++e) { eb[e] = s; tb[e] = t; s += cn[e]; t += (cn[e] + 255) >> 8; } eb[32] = s; tb[32] = t; }
    __syncthreads();
}
struct FinIdx { int e[4]; int pos[4]; float g[4]; };
struct FinData { u32x4 ys[4]; u32x4 x[2]; f32x4 g2[4]; };
__device__ __forceinline__ void fin_load_idx(const P& p, int row, FinIdx& r) {
    const u32x4 ev = *(const u32x4*)((const int*)(p.ws + WS_TOPE) + row * 4), pv = *(const u32x4*)((const int*)(p.ws + WS_SLOT) + row * 4); const f32x4 gv = *(const f32x4*)((const float*)(p.ws + WS_TOPG) + row * 4);
#pragma unroll
    for (int k = 0; k < 4; ++k) { r.e[k] = (int)ev[k]; r.pos[k] = (int)pv[k]; r.g[k] = gv[k] * (1.0f / YS_F8_SCALE); }
}
__device__ __forceinline__ void fin_load_data(const P& p, const int* eb, int row, const FinIdx& ix, FinData& d, int lane) {
    const unsigned char* YS = p.ws + WS_YS;
#pragma unroll
    for (int k = 0; k < 4; ++k) { const size_t slot = (size_t)(eb[ix.e[k]] + ix.pos[k]); d.ys[k] = *(const u32x4*)(YS + slot * 1024 + 16 * lane); }
    const u32x4* xr = (const u32x4*)((const bf16_t*)(p.ws + WS_X1) + (size_t)row * DM + 16 * lane); d.x[0] = xr[0]; d.x[1] = xr[1];
    const float* g2p = (const float*)(p.ws + WS_MOD) + (row >> 12) * 6144 + 5120 + 16 * lane;
#pragma unroll
    for (int q = 0; q < 4; ++q) d.g2[q] = *(const f32x4*)(g2p + 4 * q);
}
__device__ __forceinline__ void phase_final(const P& p, int bid, int nblk, unsigned char* lds) {
    moe_tables(p, lds); const int* eb = (const int*)(lds + MT_LDS) + 32;
    const int tid = tid_opaque(), wave = tid >> 6, lane = tid & 63;
    const float* mod = (const float*)(p.ws + WS_MOD);
    const int stride = nblk * 8;
    int row = bid * 8 + wave; if (row >= NTOK) return;
    FinIdx ic, in; FinData dc, dn;
    f32x4 l2g[4], l2b[4];
#pragma unroll
    for (int q = 0; q < 4; ++q) { l2g[q] = *(const f32x4*)(p.ln2_g + 16 * lane + 4 * q); l2b[q] = *(const f32x4*)(p.ln2_b + 16 * lane + 4 * q); }
    fin_load_idx(p, row, ic); fin_load_data(p, eb, row, ic, dc, lane);
    int row_n = row + stride; if (row_n < NTOK) fin_load_idx(p, row_n, in);
#pragma unroll 1
    for (;;) {
        if (row_n < NTOK) fin_load_data(p, eb, row_n, in, dn, lane);
        const int row_nn = row_n + stride; FinIdx inn; if (row_nn < NTOK) fin_load_idx(p, row_nn, inn);
        const int b = row >> 12, col = 16 * lane;
        f32x4 v[4]; float s = 0.f;
#pragma unroll
        for (int q = 0; q < 4; ++q) v[q] = (f32x4){0.f, 0.f, 0.f, 0.f};
#pragma unroll
        for (int k = 0; k < 4; ++k) { const u32x4 w = dc.ys[k]; const float g = ic.g[k];
            v[0] += unpack4_f8(w.x) * g; v[1] += unpack4_f8(w.y) * g; v[2] += unpack4_f8(w.z) * g; v[3] += unpack4_f8(w.w) * g; }
#pragma unroll
        for (int q = 0; q < 4; ++q) { const u32x4 xw = dc.x[q >> 1]; const unsigned w0 = (q & 1) ? xw.z : xw.x, w1 = (q & 1) ? xw.w : xw.y;
            const f32x4 xa = (f32x4){bflo(w0), bfhi(w0), bflo(w1), bfhi(w1)}; const f32x4 g2 = dc.g2[q];
            v[q] = xa * ALPHA + g2 * v[q]; s += (v[q].x + v[q].y) + (v[q].z + v[q].w); }
        const float mean = wave_sum(s) * (1.f / DM); float s2 = 0.f;
#pragma unroll
        for (int q = 0; q < 4; ++q) { v[q] = v[q] - mean; s2 += (v[q].x * v[q].x + v[q].y * v[q].y) + (v[q].z * v[q].z + v[q].w * v[q].w); }
        const float rstd = 1.f / sqrtf(wave_sum(s2) * (1.f / DM) + LN_EPS);
        f32x4* xo = (f32x4*)(p.out + (size_t)row * DM + col);
#pragma unroll
        for (int q = 0; q < 4; ++q) xo[q] = (v[q] * rstd) * l2g[q] + l2b[q];
        if (row_n >= NTOK) break;
        row = row_n; row_n = row_nn; ic = in; in = inn; dc = dn;
    }
}

namespace pg {
#define PG_LAS __attribute__((address_space(3)))
typedef float f32x2 __attribute__((ext_vector_type(2)));
constexpr int BM = 256, BK = 64, HALF = 128, HTB = HALF * BK * 2, STAGE_BYTES = 8 * HTB, KD = 1024, NT = KD / BK;
constexpr unsigned KSTEP = BK * 2, HSTEPB = HALF * KD * 2;
__host__ __device__ __forceinline__ int lds_byte(int r, int c) { const int st = (r >> 4) * 2 + (c >> 5), rr = r & 15, cc = c & 31, ob = rr * 64 + cc * 2; return st * 1024 + (ob ^ (((ob >> 9) & 1) << 5)); }
__host__ __device__ __forceinline__ void stage_rc(int b, int& R, int& C) { const int st = b / 1024, sb = b % 1024, swz = sb ^ (((sb >> 9) & 1) << 5); R = (st >> 1) * 16 + swz / 64; C = (st & 1) * 32 + (swz % 64) / 2; }
__host__ __device__ __forceinline__ int perm32(int rho) { const int n = rho >> 4, i = rho & 15; return 8 * (i >> 2) + 4 * n + (i & 3); }
struct Unit { int pm, pn, row0, nrows, e, kind; };
__device__ __forceinline__ void tilemap(int L, int nM, int nN, int& pm, int& pn) {
    int wgid = L; { const int nwg = nM * nN, q = nwg / 8, r = nwg % 8, xcd = wgid % 8, off = wgid / 8; wgid = (xcd < r ? xcd * (q + 1) : r * (q + 1) + (xcd - r) * q) + off; }
    const int nig = 8 * nN, gid = wgid / nig, fm = gid * 8, gsz = (nM - fm) < 8 ? (nM - fm) : 8;
    pm = fm + ((wgid % nig) % gsz); pn = (wgid % nig) / gsz;
}
__device__ __forceinline__ unsigned cvt_pk_bf16(float lo, float hi) { unsigned r; asm volatile("v_cvt_pk_bf16_f32 %0, %1, %2" : "=v"(r) : "v"(lo), "v"(hi)); return r; }
__device__ __forceinline__ f32x2 gelu_pk(f32x2 v) {
    const f32x2 av = __builtin_elementwise_abs(v), d = av * 0.2316418882f + 1.0f;
    f32x2 t; t.x = __builtin_amdgcn_rcpf(d.x); t.y = __builtin_amdgcn_rcpf(d.y);
    f32x2 q = t * 0.5307027145f + (-0.7265760135f); q = q * t + 0.7107068705f; q = q * t + (-0.142248368f); q = q * t + 0.127414796f; q = q * t;
    const f32x2 s = (v * v) * (-0.72134752044f);
    f32x2 e; e.x = __builtin_amdgcn_exp2f(s.x); e.y = __builtin_amdgcn_exp2f(s.y);
    const f32x2 m = v * (q * e), r = v - m;
    f32x2 o; o.x = v.x < 0.f ? m.x : r.x; o.y = v.y < 0.f ? m.y : r.y; return o;
}
__device__ __forceinline__ f32x4 gelu4(f32x4 v) { const f32x2 a = gelu_pk((f32x2){v[0], v[1]}), b = gelu_pk((f32x2){v[2], v[3]}); return (f32x4){a.x, a.y, b.x, b.y}; }
__device__ __forceinline__ f32x4 sigmoid4(f32x4 v) { f32x4 o;
#pragma unroll
    for (int i = 0; i < 4; ++i) o[i] = __builtin_amdgcn_rcpf(1.0f + __builtin_amdgcn_exp2f(-1.4426950408889634f * v[i]));
    return o; }
__device__ __forceinline__ u32x4 pack8v(f32x4 a, f32x4 b) { u32x4 w; w.x = cvt_pk_bf16(a[0], a[1]); w.y = cvt_pk_bf16(a[2], a[3]); w.z = cvt_pk_bf16(b[0], b[1]); w.w = cvt_pk_bf16(b[2], b[3]); return w; }

typedef int v8i __attribute__((ext_vector_type(8)));
template <class Epi, class Sched, bool ALIGN_EPI, bool F8 = false>
__device__ __forceinline__ void gemm_phase(PG_LAS unsigned char* lds, const unsigned char* Abase, const Sched& S, const Epi& E) {
    const int tid = tid_opaque(), wid = __builtin_amdgcn_readfirstlane(tid >> 6), lane = tid & 63, wr = wid >> 2, wc = wid & 3, fr = lane & 15, fq = lane >> 4;
    int R[2], C[2]; unsigned voffB[2];
#pragma unroll
    for (int i = 0; i < 2; ++i) { stage_rc(tid * 16 + i * 8192, R[i], C[i]);
        const int rho = R[i] & 31, Rb = Epi::PERM == 0 ? R[i] : (Epi::PERM == 1 ? ((R[i] & ~31) + perm32(rho)) : ((R[i] >> 5) * 64 + 16 * ((rho & 15) >> 2) + 4 * (rho >> 4) + (rho & 3)));
        voffB[i] = (unsigned)(Rb * (F8 ? 1024 : 2048) + C[i] * 2); }
    constexpr unsigned HSB = (Epi::PERM == 2 ? 8u : 128u) * (F8 ? 1024u : 2048u);
    constexpr int NTL = F8 ? NT / 2 : NT;
    const unsigned ldsw = (unsigned)wid * 1024u;
    const int aoff = lds_byte(wr * 64 + fr, fq * 8), boff = lds_byte(wc * 32 + fr, fq * 8);
#define PG_SA(b, h) (((b) * 2 + (h)) * HTB)
#define PG_SB(b, h) ((4 + (b) * 2 + (h)) * HTB)
#define PG_STAGE_A(bufoff, kbyte, vo) do { _Pragma("unroll") for (int _i = 0; _i < 2; ++_i) \
        __builtin_amdgcn_global_load_lds((const unsigned*)((const char*)Abase + (kbyte) + (vo)[_i]), (PG_LAS unsigned*)(lds + (bufoff) + ldsw + _i * 8192), 16, 0, 0); } while (0)
#define PG_STAGE_B(bufoff, gbase) do { _Pragma("unroll") for (int _i = 0; _i < 2; ++_i) \
        __builtin_amdgcn_global_load_lds((const unsigned*)((const char*)(gbase) + voffB[_i]), (PG_LAS unsigned*)(lds + (bufoff) + ldsw + _i * 8192), 16, 0, 0); } while (0)
#define PG_LD16(off) (*(const PG_LAS u32x4*)(lds + (off)))
#define PG_CAT(lo, hi) __builtin_bit_cast(v8i, __builtin_shufflevector((lo), (hi), 0, 1, 2, 3, 4, 5, 6, 7))
#define PG_LDA(dst, b, h) do { _Pragma("unroll") for (int m = 0; m < 4; ++m) { \
        if constexpr (F8) dst##8[m] = PG_CAT(PG_LD16(PG_SA(b, h) + aoff + m * 2048), PG_LD16(PG_SA(b, h) + aoff + m * 2048 + 1024)); \
        else { _Pragma("unroll") for (int k = 0; k < 2; ++k) dst[m][k] = *(const PG_LAS bf16x8*)(lds + PG_SA(b, h) + aoff + m * 2048 + k * 1024); } } } while (0)
#define PG_LDB(dst, b, h) do { _Pragma("unroll") for (int n = 0; n < 2; ++n) { \
        if constexpr (F8) dst##8[n] = PG_CAT(PG_LD16(PG_SB(b, h) + boff + n * 2048), PG_LD16(PG_SB(b, h) + boff + n * 2048 + 1024)); \
        else { _Pragma("unroll") for (int k = 0; k < 2; ++k) dst[n][k] = *(const PG_LAS bf16x8*)(lds + PG_SB(b, h) + boff + n * 2048 + k * 1024); } } } while (0)
#define PG_MMA(ai, bj, At, Bt) do { __builtin_amdgcn_s_setprio(1); _Pragma("unroll") for (int m = 0; m < 4; ++m) _Pragma("unroll") for (int n = 0; n < 2; ++n) { \
        if constexpr (F8) asm volatile("s_nop 1\n\tv_mfma_scale_f32_16x16x128_f8f6f4 %0, %1, %2, %0, %3, %3 op_sel_hi:[0,0,0]" : "+v"(acc[ai][bj][m][n]) : "v"(Bt##8[n]), "v"(At##8[m]), "v"(f8scale)); \
        else { _Pragma("unroll") for (int k = 0; k < 2; ++k) acc[ai][bj][m][n] = __builtin_amdgcn_mfma_f32_16x16x32_bf16(Bt[n][k], At[m][k], acc[ai][bj][m][n], 0, 0, 0); } } \
        __builtin_amdgcn_s_setprio(0); } while (0)
#define PG_WAIT_V(n) asm volatile("s_waitcnt vmcnt(" #n ")" ::: "memory")
#define PG_WAIT_L(n) asm volatile("s_waitcnt lgkmcnt(" #n ")" ::: "memory")
#define PG_BAR __builtin_amdgcn_s_barrier()
#define PG_SCHED __builtin_amdgcn_sched_barrier(0)
    Unit cur, nxt; int ui = 0;
    if (!S.next(0, cur)) return;
    f32x4 acc[2][2][4][2];
#pragma unroll
    for (int a = 0; a < 2; ++a)
#pragma unroll
        for (int b = 0; b < 2; ++b)
#pragma unroll
            for (int m = 0; m < 4; ++m)
#pragma unroll
                for (int n = 0; n < 2; ++n) acc[a][b][m][n] = (f32x4){0.f, 0.f, 0.f, 0.f};
    bf16x8 At[4][2], B0[2][2], B1[2][2]; v8i At8[4], B08[2], B18[2];
    int f8scale = 0x7f7f7f7f; asm volatile("" : "+v"(f8scale));
    unsigned ac[2][2], an[2][2];
    S.aoffs(cur, R, C, ac);
    const char* cB = S.bptr(cur);
    PG_STAGE_B(PG_SB(0, 0), cB); PG_STAGE_B(PG_SB(0, 1), cB + HSB); PG_STAGE_A(PG_SA(0, 0), 0u, ac[0]); PG_STAGE_A(PG_SA(0, 1), 0u, ac[1]);
    if (wr == 1) PG_BAR;
    PG_WAIT_V(2); PG_BAR;
    PG_STAGE_B(PG_SB(1, 0), cB + KSTEP); PG_STAGE_A(PG_SA(1, 0), KSTEP, ac[0]); PG_STAGE_B(PG_SB(1, 1), cB + HSB + KSTEP);
    PG_WAIT_V(6); PG_BAR;
    for (;;) {
        const bool has_next = S.next(ui + 1, nxt);
        const char* nB = cB;
        if (has_next) { int R2[2], C2[2]; int t2 = tid; asm volatile("" : "+v"(t2));
#pragma unroll
            for (int i = 0; i < 2; ++i) stage_rc(t2 * 16 + i * 8192, R2[i], C2[i]);
            S.aoffs(nxt, R2, C2, an); nB = S.bptr(nxt); }
        else {
#pragma unroll
            for (int h = 0; h < 2; ++h)
#pragma unroll
                for (int i = 0; i < 2; ++i) an[h][i] = ac[h][i]; }
        for (int t = 0; t < NTL; t += 2) {
            const bool last = (t == NTL - 2);
            const unsigned ka1 = (unsigned)(t + 1) * KSTEP;
            const unsigned ka2 = last ? 0u : (unsigned)(t + 2) * KSTEP;
            const char* b2 = last ? nB : cB + (size_t)(t + 2) * KSTEP; const char* b3 = b2 + KSTEP;
            unsigned a2o[2][2];
#pragma unroll
            for (int h = 0; h < 2; ++h)
#pragma unroll
                for (int i = 0; i < 2; ++i) a2o[h][i] = last ? an[h][i] : ac[h][i];
            PG_LDB(B0, 0, 0); PG_LDB(B1, 0, 1); PG_SCHED; PG_LDA(At, 0, 0); PG_STAGE_A(PG_SA(1, 1), ka1, ac[1]);
            PG_WAIT_V(8); PG_WAIT_L(0); PG_BAR; PG_MMA(0, 0, At, B0); PG_MMA(0, 1, At, B1); PG_BAR; PG_SCHED;
            PG_LDA(At, 0, 1); PG_STAGE_B(PG_SB(0, 0), b2); PG_STAGE_B(PG_SB(0, 1), b2 + HSB); PG_STAGE_A(PG_SA(0, 0), ka2, a2o[0]);
            PG_WAIT_V(8); PG_WAIT_L(0); PG_BAR; PG_MMA(1, 0, At, B0); PG_MMA(1, 1, At, B1); PG_BAR; PG_SCHED;
            PG_LDB(B0, 1, 0); PG_LDB(B1, 1, 1); PG_SCHED; PG_LDA(At, 1, 0); PG_STAGE_A(PG_SA(0, 1), ka2, a2o[1]);
            PG_WAIT_V(8); PG_WAIT_L(0); PG_BAR; PG_MMA(0, 0, At, B0); PG_MMA(0, 1, At, B1); PG_BAR; PG_SCHED;
            PG_LDA(At, 1, 1); PG_STAGE_B(PG_SB(1, 0), b3); PG_STAGE_B(PG_SB(1, 1), b3 + HSB); PG_STAGE_A(PG_SA(1, 0), ka2 + KSTEP, a2o[0]);
            PG_WAIT_V(8); PG_WAIT_L(0); PG_BAR; PG_MMA(1, 0, At, B0); PG_MMA(1, 1, At, B1); PG_BAR; PG_SCHED;
        }
        if constexpr (ALIGN_EPI) { if (wr == 0) PG_BAR; }
        if constexpr (F8) asm volatile("s_nop 15\n\ts_nop 15" ::: "memory");
        { int te = tid; asm volatile("" : "+v"(te)); E.run(acc, cur, wr, wc, te & 15, (te >> 4) & 3); }
        if (!has_next) break;
        if (!E.carry(cur)) {
#pragma unroll
            for (int a = 0; a < 2; ++a)
#pragma unroll
                for (int b = 0; b < 2; ++b)
#pragma unroll
                    for (int m = 0; m < 4; ++m)
#pragma unroll
                        for (int n = 0; n < 2; ++n) acc[a][b][m][n] = (f32x4){0.f, 0.f, 0.f, 0.f}; }
        cur = nxt; cB = nB; ++ui;
#pragma unroll
        for (int h = 0; h < 2; ++h)
#pragma unroll
            for (int i = 0; i < 2; ++i) ac[h][i] = an[h][i];
        if constexpr (ALIGN_EPI) { if (wr == 1) PG_BAR; }
    }
    PG_WAIT_V(0);
    if constexpr (!ALIGN_EPI) { if (wr == 0) PG_BAR; }
    PG_BAR;
#undef PG_SA
#undef PG_SB
#undef PG_STAGE_A
#undef PG_STAGE_B
#undef PG_LDA
#undef PG_LDB
#undef PG_MMA
#undef PG_CAT
#undef PG_LD16
#undef PG_WAIT_V
#undef PG_WAIT_L
#undef PG_BAR
#undef PG_SCHED
}

struct SchedP1 {
    int G, c; const unsigned char* ws;
    __device__ __forceinline__ bool next(int i, Unit& u) const {
        const int L = i * G + c; if (L >= 3136) return false;
        u.row0 = 0; u.nrows = 256; u.e = 0;
        if (L < 2048) { u.kind = 0; tilemap(L, 128, 16, u.pm, u.pn); }
        else if (L < 3072) { u.kind = 1; tilemap(L - 2048, 8, 128, u.pm, u.pn); }
        else if (L < 3104) { u.kind = 2; const int l = L - 3072; u.pm = l >> 2; u.pn = l & 3; }
        else { u.kind = 3; const int l = L - 3104; u.pm = l >> 3; u.pn = l & 7; }
        return true; }
    __device__ __forceinline__ void aoffs(const Unit& u, const int (&R)[2], const int (&C)[2], unsigned (&o)[2][2]) const {
        size_t base; int row0;
        if (u.kind == 0) { base = WS_U; row0 = 256 * u.pm; }
        else if (u.kind == 1) { base = WS_WIN; row0 = u.pm < 4 ? 1024 + 256 * u.pm : 4096 + 256 * (u.pm - 4); }
        else if (u.kind == 2) { base = WS_UC; row0 = 256 * u.pm; }
        else { base = WS_WIN; row0 = 4096 + 256 * u.pm; }
#pragma unroll
        for (int h = 0; h < 2; ++h)
#pragma unroll
            for (int i = 0; i < 2; ++i) o[h][i] = (unsigned)(base + (size_t)(row0 + 128 * h + R[i]) * 1024 + C[i] * 2); }
    __device__ __forceinline__ const char* bptr(const Unit& u) const {
        if (u.kind == 0) { const int wrow = u.pn < 4 ? 256 * u.pn : (u.pn < 8 ? 2048 + 256 * (u.pn - 4) : 5120 + 256 * (u.pn - 8)); return (const char*)ws + WS_WIN + (size_t)wrow * 1024; }
        if (u.kind == 1) return (const char*)ws + WS_U + (size_t)u.pn * 256 * 1024;
        if (u.kind == 2) return (const char*)ws + WS_WIN + (size_t)(3072 + 256 * u.pn) * 1024;
        return (const char*)ws + WS_UC + (size_t)u.pn * 256 * 1024; }
};
constexpr float P1_DS = 1.0f / (U_F8_SCALE * WIN_F8_SCALE);
struct EpiP1 {
    static constexpr int PERM = 1;
    unsigned char* ws; const float* b_in;
    __device__ __forceinline__ bool carry(const Unit&) const { return false; }
    __device__ __forceinline__ void run(f32x4 (&acc)[2][2][4][2], const Unit& u, int wr, int wc, int fr, int fq) const {
        const int lc = wc * 32 + 8 * fq, kind = u.kind, pm = u.pm, pn = u.pn;
        const bool brow = (kind == 1) || (kind == 3);
        int act, bcol, browbase, RA, RB, CA, CB; size_t base;
        if (kind == 0) { browbase = 0;
            if (pn < 4) { act = 1; bcol = 256 * pn; base = WS_ZU / 2 + (size_t)256 * pm * 1024 + 256 * pn; RA = 65536; RB = 1024; CA = 64; CB = 1; }
            else if (pn < 8) { act = 0; bcol = 2048 + 256 * (pn - 4); const int tok0 = 256 * pm;
                base = WS_Q / 2 + ((size_t)((tok0 >> 12) * 16 + 4 * (pn - 4)) * 4096 + (tok0 & 4095)) * 64; RA = 4096; RB = 64; CA = 4096 * 64; CB = 1; }
            else { act = 2; bcol = 5120 + 256 * (pn - 8); base = WS_G / 2 + (size_t)256 * pm * 2048 + 256 * (pn - 8); RA = 131072; RB = 2048; CA = 64; CB = 1; } }
        else if (kind == 1) { bcol = 0; const int tk0 = 256 * pn;
            if (pm < 4) { act = 1; browbase = 1024 + 256 * pm; base = WS_ZVT / 2 + (size_t)(tk0 >> 3) * 8192 + 256 * pm * 8; RA = 512; RB = 8; CA = 65536; CB = 1024; }
            else { act = 0; browbase = 4096 + 256 * (pm - 4); base = WS_VT / 2 + ((size_t)((tk0 >> 12) * 16 + 4 * (pm - 4)) * 512 + ((tk0 & 4095) >> 3)) * 512; RA = 512 * 512; RB = 8; CA = 4096; CB = 64; } }
        else if (kind == 2) { act = 0; bcol = 3072 + 256 * pn; browbase = 0; base = WS_KC / 2 + (size_t)(pm * 16 + 4 * pn) * 256 * 64; RA = 4096; RB = 64; CA = 16384; CB = 1; }
        else { act = 0; bcol = 0; browbase = 4096 + 256 * pm; base = WS_VCT / 2 + (size_t)(pn * 16 + 4 * pm) * 32 * 512; RA = 32 * 512; RB = 8; CA = 4096; CB = 64; }
        bf16_t* dbase = (bf16_t*)ws + base;
        f32x4 bv[2][2];
#pragma unroll
        for (int bj = 0; bj < 2; ++bj)
#pragma unroll
            for (int n = 0; n < 2; ++n) bv[bj][n] = brow ? (f32x4){0.f, 0.f, 0.f, 0.f} : *(const f32x4*)(b_in + bcol + lc + bj * HALF + 4 * n);
        const int colterm0 = (wc >> 1) * CA + ((wc & 1) * 32 + 8 * fq) * CB;
        float rbv[2][4];
#pragma unroll
        for (int ai = 0; ai < 2; ++ai)
#pragma unroll
            for (int m = 0; m < 4; ++m) rbv[ai][m] = brow ? b_in[browbase + ai * HALF + wr * 64 + m * 16 + fr] : 0.f;
#pragma unroll
        for (int ai = 0; ai < 2; ++ai)
#pragma unroll
            for (int m = 0; m < 4; ++m) { const int row = ai * HALF + wr * 64 + m * 16 + fr;
                const float rb = rbv[ai][m];
                const int rowterm = (2 * ai + wr) * RA + (16 * m + fr) * RB;
#pragma unroll
                for (int bj = 0; bj < 2; ++bj) {
                    f32x4 v0 = acc[ai][bj][m][0] * P1_DS + bv[bj][0] + rb, v1 = acc[ai][bj][m][1] * P1_DS + bv[bj][1] + rb;
                    if (act == 1) { v0 = gelu4(v0); v1 = gelu4(v1); } else if (act == 2) { v0 = sigmoid4(v0); v1 = sigmoid4(v1); }
                    *(u32x4*)(dbase + rowterm + colterm0 + 2 * bj * CA) = pack8v(v0, v1); } }
    }
};
struct SchedK {
    int G, c; const unsigned char* ws;
    __device__ __forceinline__ bool next(int i, Unit& u) const { const int L = i * G + c; if (L >= 512) return false; u.kind = 0; u.row0 = 0; u.nrows = 256; u.e = 0; tilemap(L, 128, 4, u.pm, u.pn); return true; }
    __device__ __forceinline__ void aoffs(const Unit& u, const int (&R)[2], const int (&C)[2], unsigned (&o)[2][2]) const {
#pragma unroll
        for (int h = 0; h < 2; ++h)
#pragma unroll
            for (int i = 0; i < 2; ++i) o[h][i] = (unsigned)(WS_U + (size_t)(256 * u.pm + 128 * h + R[i]) * 1024 + C[i] * 2); }
    __device__ __forceinline__ const char* bptr(const Unit& u) const { return (const char*)ws + WS_WIN + (size_t)(3072 + 256 * u.pn) * 1024; }
};
struct EpiRope {
    static constexpr int PERM = 0;
    unsigned char* ws; const float* b_in;
    __device__ __forceinline__ bool carry(const Unit&) const { return false; }
    __device__ __forceinline__ void run(f32x4 (&acc)[2][2][4][2], const Unit& u, int wr, int wc, int fr, int fq) const {
        bf16_t* K = (bf16_t*)(ws + WS_K); const float* tab = (const float*)(ws + WS_ROPE);
        const int lc = wc * 32 + 4 * fq, axis = wc & 1;
        f32x4 b0[2], b1[2];
#pragma unroll
        for (int bj = 0; bj < 2; ++bj) { b0[bj] = *(const f32x4*)(b_in + 3072 + 256 * u.pn + bj * HALF + lc); b1[bj] = *(const f32x4*)(b_in + 3072 + 256 * u.pn + bj * HALF + lc + 16); }
        f32x4 tb0[2][4], tb1[2][4];
#pragma unroll
        for (int ai = 0; ai < 2; ++ai)
#pragma unroll
            for (int m = 0; m < 4; ++m) { const int tok = 256 * u.pm + ai * HALF + wr * 64 + m * 16 + fr; const int pos = axis ? (tok & 63) : ((tok >> 6) & 63);
                tb0[ai][m] = *(const f32x4*)(tab + (pos * 16 + 4 * fq) * 2); tb1[ai][m] = *(const f32x4*)(tab + (pos * 16 + 4 * fq) * 2 + 4); }
#pragma unroll
        for (int ai = 0; ai < 2; ++ai)
#pragma unroll
            for (int m = 0; m < 4; ++m) { const int tok = 256 * u.pm + ai * HALF + wr * 64 + m * 16 + fr;
                const f32x4 t0 = tb0[ai][m], t1 = tb1[ai][m];
                const f32x4 cs = (f32x4){t0[0], t0[2], t1[0], t1[2]}, sn = (f32x4){t0[1], t0[3], t1[1], t1[3]};
                const int cc0 = 256 * u.pn + lc;
                bf16_t* rowp = K + ((size_t)((tok >> 12) * 16) * 4096 + (tok & 4095)) * 64;
#pragma unroll
                for (int bj = 0; bj < 2; ++bj) { const f32x4 v0 = acc[ai][bj][m][0] * P1_DS + b0[bj], v1 = acc[ai][bj][m][1] * P1_DS + b1[bj];
                    const f32x4 o0 = v0 * cs - v1 * sn, o1 = v1 * cs + v0 * sn;
                    u32x2 w0, w1; w0.x = cvt_pk_bf16(o0[0], o0[1]); w0.y = cvt_pk_bf16(o0[2], o0[3]); w1.x = cvt_pk_bf16(o1[0], o1[1]); w1.y = cvt_pk_bf16(o1[2], o1[3]);
                    const int cc = cc0 + bj * HALF; bf16_t* dp = rowp + (size_t)(cc >> 6) * 4096 * 64 + (cc & 63);
                    *(u32x2*)dp = w0; *(u32x2*)(dp + 16) = w1; } }
    }
};
struct SchedMerge {
    int G, c; const unsigned char* ws;
    __device__ __forceinline__ bool next(int i, Unit& u) const { const int L = (i >> 1) * G + c; if (L >= 512) return false; u.kind = i & 1; u.row0 = 0; u.nrows = 256; u.e = 0; tilemap(L, 128, 4, u.pm, u.pn); return true; }
    __device__ __forceinline__ void aoffs(const Unit& u, const int (&R)[2], const int (&C)[2], unsigned (&o)[2][2]) const {
        const size_t base = u.kind ? WS_YB : WS_U;
#pragma unroll
        for (int h = 0; h < 2; ++h)
#pragma unroll
            for (int i = 0; i < 2; ++i) o[h][i] = (unsigned)(base + (size_t)(256 * u.pm + 128 * h + R[i]) * 1024 + C[i] * 2); }
    __device__ __forceinline__ const char* bptr(const Unit& u) const { return (const char*)ws + (u.kind ? WS_WPB : WS_WPA) + (size_t)u.pn * 256 * 1024; }
};
constexpr float MERGE_DS = 1.0f / (YB_F8_SCALE * WP_F8_SCALE);
struct EpiMerge {
    static constexpr int PERM = 1;
    unsigned char* ws;
    __device__ __forceinline__ bool carry(const Unit& u) const { return u.kind == 0; }
    __device__ __forceinline__ void run(f32x4 (&acc)[2][2][4][2], const Unit& u, int wr, int wc, int fr, int fq) const {
        const bf16_t* Gt = (const bf16_t*)(ws + WS_G); bf16_t* INNER = (bf16_t*)(ws + WS_INNER);
        const int lc = 256 * u.pn + wc * 32 + 8 * fq;
#pragma unroll
        for (int ai = 0; ai < 2; ++ai) {
            u32x4 gbw[4][2], gaw[4][2];
#pragma unroll
            for (int m = 0; m < 4; ++m) { const size_t tok = (size_t)(256 * u.pm + ai * HALF + wr * 64 + m * 16 + fr);
#pragma unroll
                for (int bj = 0; bj < 2; ++bj) { gbw[m][bj] = *(const u32x4*)(Gt + tok * 2048 + 1024 + lc + bj * HALF);
                    if (u.kind == 0) gaw[m][bj] = *(const u32x4*)(Gt + tok * 2048 + lc + bj * HALF); } }
#pragma unroll
            for (int m = 0; m < 4; ++m) { const size_t tok = (size_t)(256 * u.pm + ai * HALF + wr * 64 + m * 16 + fr);
#pragma unroll
                for (int bj = 0; bj < 2; ++bj) { const u32x4 gw = gbw[m][bj];
                    const f32x4 gb0 = (f32x4){bflo(gw.x), bfhi(gw.x), bflo(gw.y), bfhi(gw.y)}, gb1 = (f32x4){bflo(gw.z), bfhi(gw.z), bflo(gw.w), bfhi(gw.w)};
                    if (u.kind == 0) { const u32x4 ga = gaw[m][bj];
                        const f32x4 ga0 = (f32x4){bflo(ga.x), bfhi(ga.x), bflo(ga.y), bfhi(ga.y)}, ga1 = (f32x4){bflo(ga.z), bfhi(ga.z), bflo(ga.w), bfhi(ga.w)};
#pragma unroll
                        for (int i = 0; i < 4; ++i) { acc[ai][bj][m][0][i] *= (YB_F8_SCALE / YA_F8_SCALE) * ga0[i] * __builtin_amdgcn_rcpf(fmaxf(gb0[i], 1e-30f)); acc[ai][bj][m][1][i] *= (YB_F8_SCALE / YA_F8_SCALE) * ga1[i] * __builtin_amdgcn_rcpf(fmaxf(gb1[i], 1e-30f)); }
                    } else { *(u32x4*)(INNER + tok * 1024 + lc + bj * HALF) = pack8v(acc[ai][bj][m][0] * (gb0 * MERGE_DS), acc[ai][bj][m][1] * (gb1 * MERGE_DS)); } } }
        }
    }
};
struct SchedMix {
    int G, c; const unsigned char* ws;
    __device__ __forceinline__ bool next(int i, Unit& u) const { const int L = i * G + c; if (L >= 512) return false; u.kind = 0; u.row0 = 0; u.nrows = 256; u.e = 0; tilemap(L, 128, 4, u.pm, u.pn); return true; }
    __device__ __forceinline__ void aoffs(const Unit& u, const int (&R)[2], const int (&C)[2], unsigned (&o)[2][2]) const {
#pragma unroll
        for (int h = 0; h < 2; ++h)
#pragma unroll
            for (int i = 0; i < 2; ++i) o[h][i] = (unsigned)(WS_INNER + ((size_t)(256 * u.pm + 128 * h + R[i]) * 1024 + C[i]) * 2); }
    __device__ __forceinline__ const char* bptr(const Unit& u) const { return (const char*)ws + WS_WOUT + (size_t)u.pn * 256 * 2048; }
};
struct EpiMix {
    static constexpr int PERM = 0;
    unsigned char* ws; const float *x, *lng, *lnb, *b_out; float* out;
    __device__ __forceinline__ bool carry(const Unit&) const { return false; }
    __device__ __forceinline__ void run(f32x4 (&acc)[2][2][4][2], const Unit& u, int wr, int wc, int fr, int fq) const {
        const float* rowstat = (const float*)(ws + WS_ROWSTAT); const float* mod = (const float*)(ws + WS_MOD) + ((256 * u.pm) >> 12) * 6144 + 2048;
        f32x2 st[2][4];
#pragma unroll
        for (int ai = 0; ai < 2; ++ai)
#pragma unroll
            for (int m = 0; m < 4; ++m) st[ai][m] = *(const f32x2*)(rowstat + 2 * (256 * u.pm + ai * HALF + wr * 64 + m * 16 + fr));
#pragma unroll
        for (int bj = 0; bj < 2; ++bj)
#pragma unroll
            for (int n = 0; n < 2; ++n) { const int col = 256 * u.pn + bj * HALF + wc * 32 + n * 16 + 4 * fq;
                const f32x4 lg = *(const f32x4*)(lng + col), lb = *(const f32x4*)(lnb + col), bo = *(const f32x4*)(b_out + col), g1 = *(const f32x4*)(mod + col);
                f32x4 xb[2][4];
#pragma unroll
                for (int ai = 0; ai < 2; ++ai)
#pragma unroll
                    for (int m = 0; m < 4; ++m) xb[ai][m] = *(const f32x4*)(x + (size_t)(256 * u.pm + ai * HALF + wr * 64 + m * 16 + fr) * 1024 + col);
#pragma unroll
                for (int ai = 0; ai < 2; ++ai)
#pragma unroll
                    for (int m = 0; m < 4; ++m) { const size_t off = (size_t)(256 * u.pm + ai * HALF + wr * 64 + m * 16 + fr) * 1024 + col;
                        const f32x4 xv = xb[ai][m];
                        const f32x4 x0 = (xv - st[ai][m].x) * st[ai][m].y * lg + lb;
                        const f32x4 r = x0 * ALPHA + g1 * (acc[ai][bj][m][n] + bo); u32x2 w; w.x = cvt_pk_bf16(r[0], r[1]); w.y = cvt_pk_bf16(r[2], r[3]);
                        *(u32x2*)((bf16_t*)(ws + WS_X1PRE) + off) = w; }
                asm volatile("" ::: "memory"); }
    }
};
__device__ __forceinline__ int ld_u(const int* p) { return __builtin_amdgcn_readfirstlane(__hip_atomic_load(p, __ATOMIC_RELAXED, __HIP_MEMORY_SCOPE_AGENT)); }
template <int NPN  > struct SchedMoe {
    int G, c; const unsigned char* ws; const int* tabs;
    __device__ __forceinline__ bool next(int i, Unit& u) const {
        const int* cn = tabs; const int* eb = tabs + 32; const int* tb = tabs + 65;
        const int ntiles = tb[32], tpx = (ntiles + 7) >> 3, x = c & 7, s = c >> 3;
        const int tiles_x = min(tpx, ntiles - x * tpx), ll = i * (G >> 3) + s;
        if (ll >= NPN * tiles_x) return false;
        const int T = x * tpx + ll / NPN; u.pn = ll % NPN; u.kind = 0;
        int e = 0;
#pragma unroll 1
        for (int k = 16; k >= 1; k >>= 1) if (tb[e + k] <= T) e += k;
        const int jt = T - tb[e];
        u.e = __builtin_amdgcn_readfirstlane(e); u.pm = __builtin_amdgcn_readfirstlane(jt);
        u.row0 = __builtin_amdgcn_readfirstlane(eb[e] + 256 * jt); u.nrows = __builtin_amdgcn_readfirstlane(min(256, cn[e] - 256 * jt)); return true; }
    __device__ __forceinline__ void aoffs(const Unit& u, const int (&R)[2], const int (&C)[2], unsigned (&o)[2][2]) const {
        const int* PERM2 = (const int*)(ws + WS_PERM2) + (size_t)u.e * NTOK + 256 * u.pm;
#pragma unroll
        for (int h = 0; h < 2; ++h)
#pragma unroll
            for (int i = 0; i < 2; ++i) { const int lr = min(128 * h + R[i], u.nrows - 1);
                if (NPN == 8) { const int tok = PERM2[lr]; o[h][i] = (unsigned)(WS_U + (size_t)tok * 1024 + C[i] * 2); }
                else o[h][i] = (unsigned)(WS_ACT + (size_t)(u.row0 + lr) * 1024 + C[i] * 2); } }
    __device__ __forceinline__ const char* bptr(const Unit& u) const {
        if (NPN == 8) return (const char*)ws + WS_W1 + ((size_t)u.e * 2048 + 256 * u.pn) * 1024;
        return (const char*)ws + WS_W2 + ((size_t)u.e * 1024 + 256 * u.pn) * 1024; }
};
struct EpiMoe1 {
    static constexpr int PERM = 1;
    unsigned char* ws; const float* b1;
    __device__ __forceinline__ bool carry(const Unit&) const { return false; }
    __device__ __forceinline__ void run(f32x4 (&acc)[2][2][4][2], const Unit& u, int wr, int wc, int fr, int fq) const {
        unsigned char* ACT = ws + WS_ACT;
        const int col = 128 * u.pn + wc * 32 + 8 * fq;
        f32x4 bg[2], bl[2];
#pragma unroll
        for (int n = 0; n < 2; ++n) { bg[n] = *(const f32x4*)(b1 + u.e * 2048 + col + 4 * n); bl[n] = *(const f32x4*)(b1 + u.e * 2048 + 1024 + col + 4 * n); }
        u32x2 outw[2][4];
#pragma unroll
        for (int ai = 0; ai < 2; ++ai)
#pragma unroll
            for (int m = 0; m < 4; ++m) {
                f32x4 a[2];
#pragma unroll
                for (int n = 0; n < 2; ++n) { const f32x4 zgv = acc[ai][0][m][n] * (1.0f / W_F8_SCALE) + bg[n], zlv = acc[ai][1][m][n] * (1.0f / W_F8_SCALE) + bl[n];
                    f32x4 zg, zl;
#pragma unroll
                    for (int i = 0; i < 4; ++i) { zg[i] = __builtin_amdgcn_fmed3f(zgv[i], -INFINITY, 7.0f); zl[i] = __builtin_amdgcn_fmed3f(zlv[i], -7.0f, 7.0f); }
                    const f32x4 ea = zg * (-1.702f * 1.4426950408889634f); f32x4 d;
#pragma unroll
                    for (int i = 0; i < 4; ++i) d[i] = __builtin_amdgcn_exp2f(ea[i]);
                    d = d + 1.0f; f32x4 r;
#pragma unroll
                    for (int i = 0; i < 4; ++i) r[i] = __builtin_amdgcn_rcpf(d[i]);
                    a[n] = (zg * r) * (zl * ACT_F8_SCALE + ACT_F8_SCALE); }
                outw[ai][m] = pack8_f8(a[0], a[1]); }
#pragma unroll
        for (int ai = 0; ai < 2; ++ai)
#pragma unroll
            for (int m = 0; m < 4; ++m) { const int lr = ai * HALF + wr * 64 + m * 16 + fr;
                const size_t srow = lr < u.nrows ? (size_t)(u.row0 + lr) : (size_t)(NASSIGN + lr);
                *(u32x2*)(ACT + srow * 1024 + col) = outw[ai][m]; }
    }
};
struct EpiMoe2 {
    static constexpr int PERM = 2;
    unsigned char* ws; const float* b2;
    __device__ __forceinline__ bool carry(const Unit&) const { return false; }
    __device__ __forceinline__ void run(f32x4 (&acc)[2][2][4][2], const Unit& u, int wr, int wc, int fr, int fq) const {
        unsigned char* YS = ws + WS_YS; constexpr float DS = 1.0f / (W_F8_SCALE * ACT_F8_SCALE);
        const int lc = 256 * u.pn + wc * 64 + 16 * fq;
        f32x4 bv[2][2];
#pragma unroll
        for (int bj = 0; bj < 2; ++bj)
#pragma unroll
            for (int n = 0; n < 2; ++n) bv[bj][n] = *(const f32x4*)(b2 + u.e * 1024 + lc + 8 * bj + 4 * n);
        u32x4 outw[2][4];
#pragma unroll
        for (int ai = 0; ai < 2; ++ai)
#pragma unroll
            for (int m = 0; m < 4; ++m) {
                { const u32x2 lo = pack8_f8((acc[ai][0][m][0] * DS + bv[0][0]) * YS_F8_SCALE, (acc[ai][0][m][1] * DS + bv[0][1]) * YS_F8_SCALE), hi = pack8_f8((acc[ai][1][m][0] * DS + bv[1][0]) * YS_F8_SCALE, (acc[ai][1][m][1] * DS + bv[1][1]) * YS_F8_SCALE);
                    u32x4 w; w.x = lo.x; w.y = lo.y; w.z = hi.x; w.w = hi.y; outw[ai][m] = w; } }
#pragma unroll
        for (int ai = 0; ai < 2; ++ai)
#pragma unroll
            for (int m = 0; m < 4; ++m) { const int lr = ai * HALF + wr * 64 + m * 16 + fr;
                const size_t srow = lr < u.nrows ? (size_t)(u.row0 + lr) : (size_t)(NASSIGN + lr);
                *(u32x4*)(YS + srow * 1024 + lc) = outw[ai][m]; }
    }
};
}
__device__ __forceinline__ void phase_merge_fast(const P& p, int bid, int nblk, unsigned char* lds) {
    pg::SchedMerge S{nblk, bid, p.ws}; pg::EpiMerge E{p.ws};
    pg::gemm_phase<pg::EpiMerge, pg::SchedMerge, true, true>((PG_LAS unsigned char*)lds, p.ws, S, E);
}
__device__ __forceinline__ void phase_mix_fast(const P& p, int bid, int nblk, unsigned char* lds) {
    pg::SchedMix S{nblk, bid, p.ws}; pg::EpiMix E{p.ws, p.x, p.ln_x_g, p.ln_x_b, p.b_out, p.out};
    pg::gemm_phase<pg::EpiMix, pg::SchedMix, true>((PG_LAS unsigned char*)lds, p.ws, S, E);
}
__device__ __forceinline__ void phase_moe1_fast(const P& p, int bid, int nblk, unsigned char* lds) {
    moe_tables(p, lds); pg::SchedMoe<8> S{nblk, bid, p.ws, (const int*)(lds + MT_LDS)}; pg::EpiMoe1 E{p.ws, p.exp_b1};
    pg::gemm_phase<pg::EpiMoe1, pg::SchedMoe<8>, true, true>((PG_LAS unsigned char*)lds, p.ws, S, E);
}
__device__ __forceinline__ void phase_moe2_fast(const P& p, int bid, int nblk, unsigned char* lds) {
    moe_tables(p, lds); pg::SchedMoe<4> S{nblk, bid, p.ws, (const int*)(lds + MT_LDS)}; pg::EpiMoe2 E{p.ws, p.exp_b2};
    pg::gemm_phase<pg::EpiMoe2, pg::SchedMoe<4>, true, true>((PG_LAS unsigned char*)lds, p.ws, S, E);
}
__device__ __forceinline__ void phase_proj_fast(const P& p, int bid, int nblk, unsigned char* lds) {
    { pg::SchedP1 S{nblk, bid, p.ws}; pg::EpiP1 E{p.ws, p.b_in};
      pg::gemm_phase<pg::EpiP1, pg::SchedP1, true, true>((PG_LAS unsigned char*)lds, p.ws, S, E); }
    { pg::SchedK S{nblk, bid, p.ws}; pg::EpiRope E{p.ws, p.b_in};
      pg::gemm_phase<pg::EpiRope, pg::SchedK, true, true>((PG_LAS unsigned char*)lds, p.ws, S, E); }
}

#define LAS __attribute__((address_space(3)))
#define XB_TMO      128
#define XB_XCNT(j)  (256  + 64 * (j))
#define XB_XSUB(j)  (1280 + 64 * (j))
#define XB_XGEN(j)  (2304 + 64 * (j))
#define XB_TOP      3328
#define XB_TOPGEN   3392
#define XCD_BAR_WORDS 3456
#define XB_SPIN_CAP (1u << 22)
__device__ __forceinline__ unsigned xb_ld(unsigned* p)              { return __hip_atomic_load(p, __ATOMIC_RELAXED, __HIP_MEMORY_SCOPE_AGENT); }
__device__ __forceinline__ unsigned xb_add(unsigned* p, unsigned v) { return __hip_atomic_fetch_add(p, v, __ATOMIC_RELAXED, __HIP_MEMORY_SCOPE_AGENT); }
__device__ __forceinline__ unsigned xb_xcc_id() { return (unsigned)__builtin_amdgcn_s_getreg((3 << 11) | 20) & 0xFu; }
#define XB_SPIN(cond, bar) do { unsigned _sp = 0; while (cond) { __builtin_amdgcn_s_sleep(1); \
    if ((++_sp & 255u) == 0u) { if (xb_ld(&(bar)[XB_TMO])) break; if (_sp > XB_SPIN_CAP) { atomicAdd(&(bar)[XB_TMO], 1u); break; } } } } while (0)
struct XcdBarrier { unsigned* bar; unsigned x; volatile LAS unsigned* st; };
__device__ __forceinline__ XcdBarrier xcd_barrier_post(unsigned* bar, volatile LAS unsigned* st) {
    XcdBarrier b; b.bar = bar; b.x = xb_xcc_id(); b.st = st;
    if (threadIdx.x == 0) (void)xb_add(&bar[XB_XCNT(b.x)], 1u);
    return b;
}
__device__ __forceinline__ void xcd_barrier_complete(unsigned* bar, unsigned x, unsigned& nloc, unsigned& nx) {
    const unsigned G = gridDim.x * gridDim.y * gridDim.z;
    unsigned sum, cnt, mine, sp = 0u;
    for (;;) {
        sum = 0u; cnt = 0u; mine = 0u;
#pragma unroll
        for (unsigned j = 0; j < 16; ++j) { const unsigned c = xb_ld(&bar[XB_XCNT(j)]); sum += c; cnt += (c > 0u) ? 1u : 0u; mine = (j == x) ? c : mine; }
        if (sum == G) break;
        __builtin_amdgcn_s_sleep(1);
        if ((++sp & 255u) == 0u) { if (xb_ld(&bar[XB_TMO])) break; if (sp > XB_SPIN_CAP) { atomicAdd(&bar[XB_TMO], 1u); break; } }
    }
    nloc = mine > 0u ? mine : 1u; nx = cnt > 0u ? cnt : 1u;
}
__device__ __forceinline__ void xcd_barrier(const XcdBarrier& b) {
    asm volatile("s_waitcnt vmcnt(0)" ::: "memory");
    __syncthreads();
    if (threadIdx.x == 0) {
        unsigned* bar = b.bar;
        __builtin_amdgcn_s_waitcnt(0);
        unsigned nloc = b.st[0], nx = b.st[1];
        if (nloc == 0u) { xcd_barrier_complete(bar, b.x, nloc, nx); b.st[0] = nloc; b.st[1] = nx; }
        const unsigned old = xb_add(&bar[XB_XSUB(b.x)], 1u);
        const unsigned gen = old / nloc;
        if (old + 1u == (gen + 1u) * nloc) {
            __builtin_amdgcn_fence(__ATOMIC_RELEASE, "agent");
            asm volatile("s_waitcnt vmcnt(0)" ::: "memory");
            const unsigned og = xb_add(&bar[XB_TOP], 1u);
            const unsigned tg = og / nx;
            if (og + 1u == (tg + 1u) * nx) xb_add(&bar[XB_TOPGEN], 1u);
            else XB_SPIN(xb_ld(&bar[XB_TOPGEN]) == tg, bar);
            __builtin_amdgcn_fence(__ATOMIC_ACQUIRE, "agent");
            xb_add(&bar[XB_XGEN(b.x)], 1u);
            asm volatile("s_waitcnt vmcnt(0)" ::: "memory");
        } else {
            XB_SPIN(xb_ld(&bar[XB_XGEN(b.x)]) == gen, bar);
            __builtin_amdgcn_fence(__ATOMIC_ACQUIRE, "agent");
            asm volatile("s_waitcnt vmcnt(0)" ::: "memory");
        }
    }
    __syncthreads();
}
#include <hip/hip_cooperative_groups.h>
namespace cg = cooperative_groups;
constexpr int LDS_BYTES = 147456;
constexpr int XB_LDS = LDS_BYTES - 64;
constexpr int CW_BAR = 4096;
constexpr int REP_PA = 1, REP_PB = 1, REP_P1 = 1, REP_GMLP = 1, REP_ATTN = 1, REP_MERGE = 1, REP_MIX = 1, REP_MOE1 = 1, REP_MOE2 = 1, REP_BAR = 0;
__global__ void __launch_bounds__(512, 2) mega(P p) {
    extern __shared__ __attribute__((aligned(16))) unsigned char lds[];
    const int bid = blockIdx.x, nblk = gridDim.x;
    if (threadIdx.x < 16) ((volatile LAS unsigned*)((LAS unsigned char*)lds + XB_LDS))[threadIdx.x] = 0u;
    __syncthreads();
    const XcdBarrier bar = xcd_barrier_post((unsigned*)(p.ws + WS_CTL) + CW_BAR, (volatile LAS unsigned*)((LAS unsigned char*)lds + XB_LDS));
#define GRID_BAR() xcd_barrier(bar)
#define REP(n) _Pragma("unroll 1") for (int rep_ = 0; rep_ < (n); ++rep_)
    REP(REP_PA) { __syncthreads(); phase_prologue_a(p, bid, nblk, lds); } GRID_BAR();
    REP(REP_PB) phase_prologue_b(p, bid, nblk); GRID_BAR();
    REP(REP_P1) phase_proj_fast(p, bid, nblk, lds); GRID_BAR();
    REP(REP_GMLP) phase_gmlp_fast(p, bid, nblk, lds); REP(REP_ATTN) phase_attn_s(p, bid, nblk, lds); GRID_BAR();
    REP(REP_MERGE) phase_merge_fast(p, bid, nblk, lds); GRID_BAR();
    REP(REP_MIX) phase_mix_fast(p, bid, nblk, lds); GRID_BAR();
    phase_router(p, bid, nblk, lds); GRID_BAR();
    REP(REP_BAR) GRID_BAR();
    REP(REP_MOE1) phase_moe1_fast(p, bid, nblk, lds); GRID_BAR();
    REP(REP_MOE2) phase_moe2_fast(p, bid, nblk, lds); GRID_BAR();
#undef REP
    phase_final(p, bid, nblk, lds);
}

extern "C" void kernel_launch(void* const* d_in, const int* in_sizes, int n_in, void* d_out, int out_size, void* d_ws, size_t ws_size, hipStream_t stream) {
    static int grid = 0;
    if (grid == 0) {
        if (n_in != 31 || out_size != NTOK * DM || ws_size < WS_END) { fprintf(stderr, "kernel_launch: unexpected sizes n_in %d out %d ws %zu\n", n_in, out_size, ws_size); grid = -1; return; }
        int dev = 0, cus = 0, per_cu = 0;
        if (hipGetDevice(&dev) != hipSuccess || hipDeviceGetAttribute(&cus, hipDeviceAttributeMultiprocessorCount, dev) != hipSuccess) { grid = -1; return; }
        if (hipFuncSetAttribute((const void*)mega, hipFuncAttributeMaxDynamicSharedMemorySize, LDS_BYTES) != hipSuccess) { fprintf(stderr, "kernel_launch: hipFuncSetAttribute failed\n"); grid = -1; return; }
        if (hipOccupancyMaxActiveBlocksPerMultiprocessor(&per_cu, (const void*)mega, 512, LDS_BYTES) != hipSuccess || per_cu < 1) { fprintf(stderr, "kernel_launch: occupancy query failed (%d)\n", per_cu); grid = -1; return; }
        grid = cus * 1;
    }
    if (grid < 0) return;
    P p{};
    const float** pp = (const float**)&p;
    for (int i = 0; i < 31; ++i) pp[i] = (const float*)d_in[i];
    p.out = (float*)d_out; p.ws = (unsigned char*)d_ws; p.ph_lo = 0; p.ph_hi = 0;
    if (hipMemsetAsync((char*)d_ws + WS_CTL, 0, 1 * MiB, stream) != hipSuccess) { fprintf(stderr, "kernel_launch: memset failed\n"); return; }
    hipLaunchKernelGGL(mega, dim3(grid), dim3(512), LDS_BYTES, stream, p);
    const hipError_t e = hipPeekAtLastError();
    if (e != hipSuccess) fprintf(stderr, "launch failed: %s (grid %d)\n", hipGetErrorString(e), grid);
}
```

```cpp
#include <hip/hip_runtime.h>
#include <cstdio>
#include <cstdint>

typedef unsigned short bf16_t;
typedef short bf16x8 __attribute__((ext_vector_type(8)));
typedef float f32x4 __attribute__((ext_vector_type(4)));
typedef unsigned u32x4 __attribute__((ext_vector_type(4)));
typedef unsigned u32x2 __attribute__((ext_vector_type(2)));

constexpr int DM = 1024, NB = 8, SEQ = 4096, NTOK = NB * SEQ, CTXL = 256, NCTX = NB * CTXL, INW = 7168;
constexpr int NE = 32, TOPK = 4, FF = 1024, NASSIGN = NTOK * TOPK;
constexpr int NHEAD = 16, HD = 64, GW = 64;
constexpr float LN_EPS = 1e-5f;
constexpr float ALPHA = 1.189207115002721f;
constexpr int MAXTILES = NASSIGN / 256 + NE;

constexpr size_t MiB = 1u << 20;
constexpr size_t WS_CTL = 0;
constexpr size_t WS_MOD = 1 * MiB;
constexpr size_t WS_ROPE = 1 * MiB + 512 * 1024;
constexpr size_t WS_ROWSTAT = 2 * MiB;
constexpr size_t WS_ZSTAT = 2 * MiB + 512 * 1024;
constexpr size_t WS_TOPE = 3 * MiB;
constexpr size_t WS_TOPG = 4 * MiB;
constexpr size_t WS_SLOT = 5 * MiB;
constexpr size_t WS_PERM = 6 * MiB;
constexpr size_t WS_TILES = 7 * MiB;
constexpr size_t WS_WIN = 8 * MiB;
constexpr size_t WS_WPA = 22 * MiB, WS_WPB = 24 * MiB, WS_WOUT = 26 * MiB, WS_WSB = 28 * MiB;
constexpr size_t WS_KC = 30 * MiB;
constexpr size_t WS_VCT = 34 * MiB;
constexpr size_t WS_UC = 38 * MiB;
constexpr size_t WS_PERM2 = 42 * MiB;
constexpr size_t WS_W1 = 48 * MiB;
constexpr size_t WS_W2 = 176 * MiB;
constexpr size_t WS_U = 240 * MiB;
constexpr size_t WS_ZU = 304 * MiB;
constexpr size_t WS_ZVT = 368 * MiB;
constexpr size_t WS_Q = 432 * MiB;
constexpr size_t WS_K = 496 * MiB;
constexpr size_t WS_VT = 560 * MiB;
constexpr size_t WS_G = 624 * MiB;
constexpr size_t WS_YB = 752 * MiB;
constexpr size_t WS_INNER = 816 * MiB;
constexpr size_t WS_ACT = WS_ZU;
constexpr size_t WS_YS = WS_G;
constexpr size_t WS_X1PRE = WS_YB;
constexpr size_t WS_X1 = WS_VT;
constexpr size_t WS_END = 880 * MiB;

struct P {
    const float *x, *c, *ctx, *c_ctx, *ln_x_g, *ln_x_b, *ln_ctx_g, *ln_ctx_b, *w_ada, *b_ada, *w_in, *b_in, *gmlp_ln_g, *gmlp_ln_b, *gmlp_ws, *gmlp_bs,
        *na_rpb, *w_pa, *w_pb, *w_out, *b_out, *ln1_g, *ln1_b, *ln2_g, *ln2_b, *router_w, *router_b, *exp_w1, *exp_b1, *exp_w2, *exp_b2;
    float* out; unsigned char* ws; int ph_lo, ph_hi;
};

__device__ __forceinline__ int tid_opaque() { int t = threadIdx.x; asm volatile("" : "+v"(t)); return t; }
typedef float f32x2_ __attribute__((ext_vector_type(2))); typedef __bf16 bf16x2_ __attribute__((ext_vector_type(2)));
__device__ __forceinline__ unsigned pk2(float lo, float hi) { const f32x2_ v = {lo, hi}; return __builtin_bit_cast(unsigned, __builtin_convertvector(v, bf16x2_)); }
__device__ __forceinline__ unsigned f2bf(float f) { return pk2(f, 0.f) & 0xffffu; }
__device__ __forceinline__ float bf2f(unsigned h) { return __builtin_bit_cast(float, (h & 0xffffu) << 16); }
__device__ __forceinline__ float bflo(unsigned w) { return __builtin_bit_cast(float, w << 16); }
__device__ __forceinline__ float bfhi(unsigned w) { return __builtin_bit_cast(float, w & 0xffff0000u); }
__device__ __forceinline__ u32x2 pack8_f8(f32x4 a, f32x4 b) {
    int w0 = 0, w1 = 0;
    w0 = __builtin_amdgcn_cvt_pk_fp8_f32(a[0], a[1], w0, false); w0 = __builtin_amdgcn_cvt_pk_fp8_f32(a[2], a[3], w0, true);
    w1 = __builtin_amdgcn_cvt_pk_fp8_f32(b[0], b[1], w1, false); w1 = __builtin_amdgcn_cvt_pk_fp8_f32(b[2], b[3], w1, true);
    u32x2 r; r.x = (unsigned)w0; r.y = (unsigned)w1; return r;
}
typedef float f32x2u __attribute__((ext_vector_type(2)));
__device__ __forceinline__ f32x4 unpack4_f8(unsigned w) { const f32x2u lo = __builtin_amdgcn_cvt_pk_f32_fp8((int)w, false), hi = __builtin_amdgcn_cvt_pk_f32_fp8((int)w, true); return (f32x4){lo.x, lo.y, hi.x, hi.y}; }
constexpr float YS_F8_SCALE = 16.0f;
constexpr float YA_F8_SCALE = 4.0f, YB_F8_SCALE = 16.0f, WP_F8_SCALE = 256.0f;
constexpr float U_F8_SCALE = 16.0f, WIN_F8_SCALE = 256.0f;
template <int CTRL> __device__ __forceinline__ float dpp_f(float v) { return __builtin_bit_cast(float, __builtin_amdgcn_update_dpp(0, __builtin_bit_cast(int, v), CTRL, 0xF, 0xF, true)); }
template <int CTRL> __device__ __forceinline__ int dpp_i(int v) { return __builtin_amdgcn_update_dpp(0, v, CTRL, 0xF, 0xF, true); }
constexpr int DPP_XOR1 = 0xB1, DPP_XOR2 = 0x4E, DPP_QREV = 0x1B, DPP_HMIRROR = 0x141, DPP_MIRROR = 0x140, DPP_ROR8 = 0x128;
__device__ __forceinline__ void swap16(float v, float& x, float& y) { x = v; y = v; asm volatile("s_nop 1\n\tv_permlane16_swap_b32 %0, %1" : "+v"(x), "+v"(y)); }
__device__ __forceinline__ void swap32(float v, float& x, float& y) { x = v; y = v; asm volatile("s_nop 1\n\tv_permlane32_swap_b32 %0, %1" : "+v"(x), "+v"(y)); }
__device__ __forceinline__ float rows_sum(float v) { float x, y; swap16(v, x, y); v = x + y; swap32(v, x, y); return x + y; }
__device__ __forceinline__ float rows_max(float v) { float x, y; swap16(v, x, y); v = fmaxf(x, y); swap32(v, x, y); return fmaxf(x, y); }
__device__ __forceinline__ float wave_sum(float v) {
    v += dpp_f<DPP_XOR1>(v); v += dpp_f<DPP_XOR2>(v); v += dpp_f<DPP_HMIRROR>(v); v += dpp_f<DPP_MIRROR>(v);
    return rows_sum(v);
}
__device__ __forceinline__ float wave_max(float v) {
    v = fmaxf(v, dpp_f<DPP_XOR1>(v)); v = fmaxf(v, dpp_f<DPP_XOR2>(v)); v = fmaxf(v, dpp_f<DPP_HMIRROR>(v)); v = fmaxf(v, dpp_f<DPP_MIRROR>(v));
    return rows_max(v);
}
__device__ __forceinline__ int wave_min_i(int v) {
    v = min(v, dpp_i<DPP_XOR1>(v)); v = min(v, dpp_i<DPP_XOR2>(v)); v = min(v, dpp_i<DPP_HMIRROR>(v)); v = min(v, dpp_i<DPP_MIRROR>(v));
    float x, y; swap16(__builtin_bit_cast(float, v), x, y); v = min(__builtin_bit_cast(int, x), __builtin_bit_cast(int, y));
    swap32(__builtin_bit_cast(float, v), x, y); return min(__builtin_bit_cast(int, x), __builtin_bit_cast(int, y));
}
template <int ST> __device__ __forceinline__ float xor_row(float v) {
    if constexpr (ST == 0) return dpp_f<DPP_XOR1>(v);
    else if constexpr (ST == 1) return dpp_f<DPP_XOR2>(v);
    else if constexpr (ST == 2) return dpp_f<DPP_QREV>(dpp_f<DPP_HMIRROR>(v));
    else return dpp_f<DPP_ROR8>(v);
}
__device__ __forceinline__ float gelu_exact(float v) { return 0.5f * v * (1.0f + erff(v * 0.70710678118654752f)); }
__device__ __forceinline__ float sigmoidf_(float v) { return 1.0f / (1.0f + __expf(-v)); }

__device__ __forceinline__ void mod_item(const P& p, int item, float* ldsf) {
    const int tid = tid_opaque(), wave = tid >> 6, lane = tid & 63;
    float* sl = ldsf; float* red = ldsf + 9 * 1024;
    for (int i = tid; i < 9 * 1024; i += 512) { const int r = i >> 10, k = i & 1023; const float cv = (r < 8) ? p.c[r * 1024 + k] : p.c_ctx[k]; sl[i] = cv / (1.0f + __expf(-cv)); }
    __syncthreads();
    const int col = item * 32 + (lane & 31), kpar = lane >> 5;
    float acc[9];
#pragma unroll
    for (int r = 0; r < 9; ++r) acc[r] = 0.f;
    const float* wp = p.w_ada + (size_t)(wave * 128 + kpar) * 6144 + col; const float* sp = sl + wave * 128 + kpar;
#pragma unroll 1
    for (int k8 = 0; k8 < 64; k8 += 8) {
        float w[8];
#pragma unroll
        for (int u = 0; u < 8; ++u) w[u] = wp[(size_t)(k8 + u) * 2 * 6144];
#pragma unroll
        for (int u = 0; u < 8; ++u)
#pragma unroll
            for (int r = 0; r < 9; ++r) acc[r] += sp[r * 1024 + (k8 + u) * 2] * w[u];
    }
#pragma unroll
    for (int r = 0; r < 9; ++r) red[((wave * 2 + kpar) * 9 + r) * 32 + (lane & 31)] = acc[r];
    __syncthreads();
    if (tid < 288) {
        const int r = tid >> 5, cc = tid & 31; float s = 0.f;
#pragma unroll
        for (int q = 0; q < 16; ++q) s += red[(q * 9 + r) * 32 + cc];
        ((float*)(p.ws + WS_MOD))[r * 6144 + item * 32 + cc] = s + p.b_ada[item * 32 + cc];
    }
    __syncthreads();
}
__device__ __forceinline__ void transpose_item(const float* W, int K, int N, bf16_t* WT, int k0, int n0, int drow0, int lane) {
    const int kg = lane >> 3, ng = lane & 7;
    f32x4 v[8];
#pragma unroll
    for (int i = 0; i < 8; ++i) v[i] = *(const f32x4*)(W + (size_t)(k0 + 8 * kg + i) * N + n0 + 4 * ng);
#pragma unroll
    for (int q = 0; q < 4; ++q) { u32x4 o; o.x = pk2(v[0][q], v[1][q]); o.y = pk2(v[2][q], v[3][q]); o.z = pk2(v[4][q], v[5][q]); o.w = pk2(v[6][q], v[7][q]);
        *(u32x4*)(WT + (size_t)(drow0 + 4 * ng + q) * K + k0 + 8 * kg) = o; }
}
__device__ __forceinline__ void f8t_load(const float* W, int N, int k0, int n0, int lane, f32x4 (&v)[8]) {
    const int kg = lane >> 3, ng = lane & 7;
#pragma unroll
    for (int i = 0; i < 8; ++i) v[i] = __builtin_nontemporal_load((const f32x4*)(W + (size_t)(k0 + 8 * kg + i) * N + n0 + 4 * ng));
}
__device__ __forceinline__ void f8t_finish(const f32x4 (&v)[8], int K, unsigned char* WT, int k0, int drow0, float scale, int lane) {
    const int kg = lane >> 3, ng = lane & 7;
#pragma unroll
    for (int q = 0; q < 4; ++q)
        __builtin_nontemporal_store(pack8_f8((f32x4){v[0][q], v[1][q], v[2][q], v[3][q]} * scale, (f32x4){v[4][q], v[5][q], v[6][q], v[7][q]} * scale), (u32x2*)(WT + (size_t)(drow0 + 4 * ng + q) * K + k0 + 8 * kg));
}
__device__ __forceinline__ void transpose_item_f8(const float* W, int K, int N, unsigned char* WT, int k0, int n0, int drow0, float scale, int lane) {
    f32x4 v[8]; f8t_load(W, N, k0, n0, lane, v); f8t_finish(v, K, WT, k0, drow0, scale, lane);
}
constexpr float W_F8_SCALE = 256.0f, ACT_F8_SCALE = 4.0f;
constexpr int IT_WIN = 16 * 224, IT_SQ = 16 * 32, IT_W1 = 32 * 16 * 64, IT_W2 = 32 * 16 * 32, IT_WS = 32;
constexpr int IT_EXP0 = IT_WIN + 3 * IT_SQ;
__device__ __forceinline__ void convert_item(const P& p, int it, int lane) {
    unsigned char* ws = p.ws;
    if (it < IT_WIN) { const int kb = it / 224, nb = it % 224; transpose_item_f8(p.w_in, 1024, INW, ws + WS_WIN, kb * 64, nb * 32, nb * 32, WIN_F8_SCALE, lane); return; } it -= IT_WIN;
    if (it < IT_SQ) { const int kb = it / 32, nb = it % 32; transpose_item_f8(p.w_pa, 1024, 1024, ws + WS_WPA, kb * 64, nb * 32, nb * 32, WP_F8_SCALE, lane); return; } it -= IT_SQ;
    if (it < IT_SQ) { const int kb = it / 32, nb = it % 32; transpose_item_f8(p.w_pb, 1024, 1024, ws + WS_WPB, kb * 64, nb * 32, nb * 32, WP_F8_SCALE, lane); return; } it -= IT_SQ;
    if (it < IT_SQ) { const int kb = it / 32, nb = it % 32; transpose_item(p.w_out, 1024, 1024, (bf16_t*)(ws + WS_WOUT), kb * 64, nb * 32, nb * 32, lane); return; } it -= IT_SQ;
    { bf16_t* o = (bf16_t*)(ws + WS_WSB); const float* s = p.gmlp_ws + it * 4096;
      for (int i = lane; i < 4096; i += 64) o[it * 4096 + i] = (bf16_t)f2bf(s[i]); }
}
__device__ __forceinline__ void phase_prologue_a(const P& p, int bid, int nblk, unsigned char* lds) {
    const int tid = tid_opaque(), wave = tid >> 6, lane = tid & 63;
    for (int item = bid; item < 192; item += nblk) mod_item(p, item, (float*)lds);
    if (bid == nblk - 1) {
        for (int i = tid; i < 1024; i += 512) { const int pos = i >> 4, fi = i & 15;
            const float inv = __builtin_amdgcn_exp2f(-(float)fi * (13.287712379549449f / 16.0f));
            const float ang = (float)pos * inv; const float rev = ang * 0.15915494309189535f;
            float* t = (float*)(p.ws + WS_ROPE); t[2 * i] = __builtin_amdgcn_cosf(rev); t[2 * i + 1] = __builtin_amdgcn_sinf(rev); }
    }
    __syncthreads();
    const int gw = bid * 8 + wave, ngw = nblk * 8;
    for (int it = gw; it < IT_EXP0 + IT_WS; it += ngw) convert_item(p, it, lane);
}
struct PbSrc { const float *x, *g, *b, *sh, *sc; unsigned char* o; float* stat; };
struct PbData { f32x4 v[4], pg[4], pb[4], psh[4], psc[4]; };
__device__ __forceinline__ PbSrc pb_src(const P& p, int row) {
    const float* mod = (const float*)(p.ws + WS_MOD); PbSrc s;
    if (row < NTOK) { const int b = row >> 12; s.x = p.x + (size_t)row * DM; s.g = p.ln_x_g; s.b = p.ln_x_b; s.sh = mod + b * 6144; s.sc = mod + b * 6144 + 1024; s.o = p.ws + WS_U + (size_t)row * DM; s.stat = (float*)(p.ws + WS_ROWSTAT) + 2 * row; }
    else { const int r = row - NTOK; s.x = p.ctx + (size_t)r * DM; s.g = p.ln_ctx_g; s.b = p.ln_ctx_b; s.sh = mod + 8 * 6144; s.sc = mod + 8 * 6144 + 1024; s.o = p.ws + WS_UC + (size_t)r * DM; s.stat = nullptr; }
    return s;
}
__device__ __forceinline__ void pb_load(const PbSrc& s, PbData& d, int lane) {
#pragma unroll
    for (int j = 0; j < 4; ++j) d.v[j] = ((const f32x4*)s.x + lane)[64 * j];
#pragma unroll
    for (int j = 0; j < 4; ++j) { const int col = 4 * lane + 256 * j; d.pg[j] = *(const f32x4*)(s.g + col); d.pb[j] = *(const f32x4*)(s.b + col); d.psh[j] = *(const f32x4*)(s.sh + col); d.psc[j] = *(const f32x4*)(s.sc + col); }
}
__device__ __forceinline__ void pb_row(const PbSrc& src, PbData& d, int lane) {
    float s = 0.f;
#pragma unroll
    for (int j = 0; j < 4; ++j) s += (d.v[j].x + d.v[j].y) + (d.v[j].z + d.v[j].w);
    const float mean = wave_sum(s) * (1.f / DM); float s2 = 0.f;
#pragma unroll
    for (int j = 0; j < 4; ++j) { d.v[j] = d.v[j] - mean; s2 += (d.v[j].x * d.v[j].x + d.v[j].y * d.v[j].y) + (d.v[j].z * d.v[j].z + d.v[j].w * d.v[j].w); }
    const float rstd = 1.f / sqrtf(wave_sum(s2) * (1.f / DM) + LN_EPS);
    if (src.stat && lane == 0) { src.stat[0] = mean; src.stat[1] = rstd; }
    unsigned* o4 = (unsigned*)src.o + lane;
#pragma unroll
    for (int j = 0; j < 4; ++j) {
        f32x4 y = (d.v[j] * rstd) * d.pg[j] + d.pb[j]; y = y * (1.0f + d.psc[j]) + d.psh[j];
        y = __builtin_elementwise_min(__builtin_elementwise_max(y * U_F8_SCALE, (f32x4){-448.f, -448.f, -448.f, -448.f}), (f32x4){448.f, 448.f, 448.f, 448.f});
        int w = 0; w = __builtin_amdgcn_cvt_pk_fp8_f32(y.x, y.y, w, false); w = __builtin_amdgcn_cvt_pk_fp8_f32(y.z, y.w, w, true); o4[64 * j] = (unsigned)w; }
}
__device__ __forceinline__ void phase_prologue_b(const P& p, int bid, int nblk) {
    const int tid = tid_opaque(), wave = tid >> 6, lane = tid & 63;
    const int ngw = nblk * 8;
    int row = bid * 8 + wave; if (row >= NTOK + NCTX) return;
    PbSrc sc = pb_src(p, row); PbData dc, dn; pb_load(sc, dc, lane);
#pragma unroll 1
    for (;;) {
        const int row_n = row + ngw; PbSrc sn = sc;
        if (row_n < NTOK + NCTX) { sn = pb_src(p, row_n); pb_load(sn, dn, lane); }
        pb_row(sc, dc, lane);
        if (row_n >= NTOK + NCTX) break;
        row = row_n; sc = sn; dc = dn;
    }
}

__device__ __forceinline__ bf16x8 pack8(const float (&v)[8]) { u32x4 w; w.x = pk2(v[0], v[1]); w.y = pk2(v[2], v[3]); w.z = pk2(v[4], v[5]); w.w = pk2(v[6], v[7]); return __builtin_bit_cast(bf16x8, w); }
__device__ __forceinline__ void phase_gmlp_fast(const P& p, int bid, int nblk, unsigned char* lds) {
    const int tid = tid_opaque(), g = tid >> 6, lane = tid & 63, fr = lane & 15, fq = lane >> 4;
    float* part = (float*)lds;
    float* stat = part + 8 * 128 * 2;
    const bf16_t* ZVT = (const bf16_t*)(p.ws + WS_ZVT); const bf16_t* ZU = (const bf16_t*)(p.ws + WS_ZU); const bf16_t* WSB = (const bf16_t*)(p.ws + WS_WSB);
    unsigned char* YA = p.ws + WS_U;
    for (int chunk = bid; chunk < NTOK / 128; chunk += nblk) {
        const int tok0 = chunk * 128;
        __syncthreads();
        { float s1[8], s2[8];
#pragma unroll
          for (int jj = 0; jj < 8; ++jj) { s1[jj] = 0.f; s2[jj] = 0.f; }
          const bf16_t* zp = ZVT + (((size_t)(tok0 >> 3) + fr) * 1024 + 128 * g + fq) * 8;
#pragma unroll 8
          for (int it = 0; it < 32; ++it) { const bf16x8 v = *(const bf16x8*)(zp + (4 * it) * 8);
#pragma unroll
              for (int jj = 0; jj < 8; ++jj) { const float f = bf2f((unsigned)(unsigned short)v[jj]); s1[jj] += f; s2[jj] += f * f; } }
#pragma unroll
          for (int jj = 0; jj < 8; ++jj) { s1[jj] = rows_sum(s1[jj]); s2[jj] = rows_sum(s2[jj]); }
          if (fq == 0) {
#pragma unroll
              for (int jj = 0; jj < 8; ++jj) { part[(g * 128 + 8 * fr + jj) * 2] = s1[jj]; part[(g * 128 + 8 * fr + jj) * 2 + 1] = s2[jj]; } } }
        __syncthreads();
        if (tid < 128) { float a = 0.f, b = 0.f;
#pragma unroll
            for (int w = 0; w < 8; ++w) { a += part[(w * 128 + tid) * 2]; b += part[(w * 128 + tid) * 2 + 1]; }
            const float mean = a * (1.f / 1024.f), var = fmaxf(b * (1.f / 1024.f) - mean * mean, 0.f);
            stat[2 * tid] = mean; stat[2 * tid + 1] = 1.f / sqrtf(var + LN_EPS); }
        __syncthreads();
#pragma unroll 1
        for (int ph = 0; ph < 2; ++ph) {
            int tp = tid; asm volatile("" : "+v"(tp));
            const int g = __builtin_amdgcn_readfirstlane(tp >> 6), fr = tp & 15, fq = (tp >> 4) & 3;
            bf16x8 wf[4][4]; float t1[4], t2[4], bsv[4];
#pragma unroll
            for (int pt = 0; pt < 4; ++pt) { const int pp = 64 * ph + 16 * pt + fr; float t1a = 0.f, t2a = 0.f;
                const __attribute__((address_space(3))) float* stat3 = (const __attribute__((address_space(3))) float*)((const __attribute__((address_space(3))) unsigned char*)lds + 8 * 128 * 2 * 4);
                int so = 16 * fq; asm volatile("" : "+v"(so));
#pragma unroll
                for (int ks = 0; ks < 4; ++ks) { const bf16x8 w = *(const bf16x8*)(WSB + ((size_t)g * 128 + pp) * 128 + 32 * ks + 8 * fq);
                    float wv[8];
#pragma unroll
                    for (int jj = 0; jj < 8; ++jj) { const float w0 = bf2f((unsigned)(unsigned short)w[jj]); t2a += w0; wv[jj] = w0 * stat3[so + 2 * (32 * ks + jj) + 1]; }
                    const bf16x8 wp = pack8(wv); wf[pt][ks] = wp;
#pragma unroll
                    for (int jj = 0; jj < 8; ++jj) t1a += bf2f((unsigned)(unsigned short)wp[jj]) * stat3[so + 2 * (32 * ks + jj)]; }
                t1a = rows_sum(t1a); t2a = rows_sum(t2a);
                t1[pt] = t1a; t2[pt] = t2a; bsv[pt] = p.gmlp_bs[g * 128 + pp]; }
            constexpr int GM_D = 3;
            bf16x8 afn[GM_D][4]; u32x2 zun[GM_D][4]; f32x4 gcn[GM_D], bcn[GM_D];
#define GM_LOAD(ct_) do { constexpr int s_ = (ct_) % GM_D; const bf16_t* zp_ = ZVT + (((size_t)(tok0 >> 3) + fq) * 1024 + 128 * g + 16 * (ct_) + fr) * 8; const int c_ = 128 * g + 16 * (ct_) + 4 * fq; \
                _Pragma("unroll") for (int ks = 0; ks < 4; ++ks) afn[s_][ks] = *(const bf16x8*)(zp_ + (size_t)ks * 4 * 1024 * 8); \
                _Pragma("unroll") for (int pt = 0; pt < 4; ++pt) zun[s_][pt] = *(const u32x2*)(ZU + (size_t)(tok0 + 64 * ph + 16 * pt + fr) * 1024 + c_); \
                gcn[s_] = *(const f32x4*)(p.gmlp_ln_g + c_); bcn[s_] = *(const f32x4*)(p.gmlp_ln_b + c_); asm volatile("" ::: "memory"); } while (0)
#define GM_TILE(ct_) do { constexpr int s_ = (ct_) % GM_D; if ((ct_) + GM_D - 1 < 8) GM_LOAD(((ct_) + GM_D - 1) % 8); \
                const int c = 128 * g + 16 * (ct_) + 4 * fq; \
                f32x4 acc[4]; \
                _Pragma("unroll") for (int pt = 0; pt < 4; ++pt) { acc[pt] = (f32x4){0.f, 0.f, 0.f, 0.f}; \
                    _Pragma("unroll") for (int ks = 0; ks < 4; ++ks) acc[pt] = __builtin_amdgcn_mfma_f32_16x16x32_bf16(afn[s_][ks], wf[pt][ks], acc[pt], 0, 0, 0); } \
                _Pragma("unroll") for (int pt = 0; pt < 4; ++pt) { const size_t off = (size_t)(tok0 + 64 * ph + 16 * pt + fr) * 1024 + c; \
                    const u32x2 zu = zun[s_][pt]; \
                    const f32x4 s = gcn[s_] * (acc[pt] - t1[pt]) + bcn[s_] * t2[pt] + bsv[pt]; \
                    const f32x4 y = __builtin_elementwise_min(__builtin_elementwise_max((f32x4){bflo(zu.x) * s[0], bfhi(zu.x) * s[1], bflo(zu.y) * s[2], bfhi(zu.y) * s[3]} * YA_F8_SCALE, (f32x4){-448.f, -448.f, -448.f, -448.f}), (f32x4){448.f, 448.f, 448.f, 448.f}); \
                    int w = 0; w = __builtin_amdgcn_cvt_pk_fp8_f32(y[0], y[1], w, false); w = __builtin_amdgcn_cvt_pk_fp8_f32(y[2], y[3], w, true); \
                    *(unsigned*)(YA + off) = (unsigned)w; } \
                asm volatile("" ::: "memory"); } while (0)
            GM_LOAD(0); GM_LOAD(1);
            GM_TILE(0); GM_TILE(1); GM_TILE(2); GM_TILE(3); GM_TILE(4); GM_TILE(5); GM_TILE(6); GM_TILE(7);
#undef GM_TILE
#undef GM_LOAD
        }
    }
}
constexpr int AT_LDS_RPB = 0, AT_LDS_KC = 4096, AT_LDS_VC = AT_LDS_KC + 32768, AT_LDS_END = AT_LDS_VC + 32768;
typedef __attribute__((address_space(3))) const unsigned char* lds_cp;
__device__ __forceinline__ void attn_stage(const P& p, unsigned char* lds, int b, int h, int tid) {
    float* tbl = (float*)(lds + AT_LDS_RPB);
    for (int idx = tid; idx < 15 * 64; idx += 512) { const int dr = idx >> 6, cc = idx & 63; tbl[idx] = (cc >= 16 && cc < 47) ? p.na_rpb[(h * 15 + dr) * 31 + cc - 16] * 1.4426950408889634f : 0.f; }
    const size_t bh = (size_t)b * 16 + h;
    const u32x4* kc = (const u32x4*)((const bf16_t*)(p.ws + WS_KC) + bh * 256 * 64); const u32x4* vc = (const u32x4*)((const bf16_t*)(p.ws + WS_VCT) + bh * 32 * 512);
#pragma unroll
    for (int i = 0; i < 4; ++i) { const int q = tid + 512 * i, key = q >> 3, c = q & 7; const int fk = ((key >> 1) & 1) | (((key >> 3) & 1) << 1) | (((key >> 4) & 1) << 2);
        *(u32x4*)(lds + AT_LDS_KC + key * 128 + ((c ^ fk) << 4)) = kc[q]; *(u32x4*)(lds + AT_LDS_VC + q * 16) = vc[q]; }
}
struct AttnTile { bf16x8 qrt[2]; f32x4 o[4], nm; f32x2_ l2; float m2; };
__device__ __forceinline__ void attn_tile_init(const P& p, AttnTile& T, size_t bh, int r, int qc, int fq) {
    const bf16_t* Q = (const bf16_t*)(p.ws + WS_Q); const float* tab = (const float*)(p.ws + WS_ROPE);
    constexpr float QS = 0.125f * 1.4426950408889634f;
#pragma unroll
    for (int s = 0; s < 2; ++s) {
        const bf16_t* qb = Q + (bh * 4096 + r * 64 + qc) * 64 + 32 * s;
        const bf16x8 me = *(const bf16x8*)(qb + 8 * fq), ot = *(const bf16x8*)(qb + 8 * (fq ^ 2));
        const int pos = s ? qc : r; const float* tb = tab + (pos * 16 + 8 * (fq & 1)) * 2;
        float rot[8];
#pragma unroll
        for (int jj = 0; jj < 8; ++jj) { const float cv = tb[2 * jj] * QS, sv = tb[2 * jj + 1] * QS;
            const float xv = bf2f((unsigned)(unsigned short)me[jj]), ov = bf2f((unsigned)(unsigned short)ot[jj]);
            rot[jj] = (fq < 2) ? (xv * cv - ov * sv) : (xv * cv + ov * sv); }
        T.qrt[s] = pack8(rot);
    }
#pragma unroll
    for (int dt = 0; dt < 4; ++dt) T.o[dt] = (f32x4){0.f, 0.f, 0.f, 0.f};
    T.m2 = 0.f; T.l2 = (f32x2_){0.f, 0.f}; T.nm = (f32x4){0.f, 0.f, 0.f, 0.f};
}
__device__ __forceinline__ void attn_tiles_qplain(const P& p, AttnTile& TA, AttnTile& TB, size_t bh, int r, int qc, int fq) {
    const bf16_t* Q = (const bf16_t*)(p.ws + WS_Q); constexpr float QS = 0.125f * 1.4426950408889634f;
    bf16x8 me[2][2];
#pragma unroll
    for (int w = 0; w < 2; ++w)
#pragma unroll
        for (int s = 0; s < 2; ++s) me[w][s] = *(const bf16x8*)(Q + (bh * 4096 + (r + w) * 64 + qc) * 64 + 32 * s + 8 * fq);
#pragma unroll
    for (int w = 0; w < 2; ++w)
#pragma unroll
        for (int s = 0; s < 2; ++s) { float pl[8];
#pragma unroll
            for (int jj = 0; jj < 8; ++jj) pl[jj] = bf2f((unsigned)(unsigned short)me[w][s][jj]) * QS;
            (w ? TB : TA).qrt[s] = pack8(pl); }
}
typedef __attribute__((address_space(3))) const float* lds_fp;
__device__ __forceinline__ float fmax_nc(float a, float b) { return __builtin_amdgcn_fmed3f(a, b, INFINITY); }
__device__ __forceinline__ float attn_rowmax(const f32x4 (&d)[2]) {
    float s = fmax_nc(fmax_nc(fmax_nc(d[0][0], d[0][1]), fmax_nc(d[0][2], d[0][3])), fmax_nc(fmax_nc(d[1][0], d[1][1]), fmax_nc(d[1][2], d[1][3])));
    const u32x2 a = __builtin_amdgcn_permlane16_swap(__builtin_bit_cast(unsigned, s), __builtin_bit_cast(unsigned, s), false, false);
    asm("v_max_f32 %0, %1, %2" : "=v"(s) : "v"(a.x), "v"(a.y));
    const u32x2 c = __builtin_amdgcn_permlane32_swap(__builtin_bit_cast(unsigned, s), __builtin_bit_cast(unsigned, s), false, false);
    asm("v_max_f32 %0, %1, %2" : "=v"(s) : "v"(c.x), "v"(c.y)); return s;
}
__device__ __forceinline__ int attn_imax(const f32x4 (&d)[2]) {
    const int a = max(max(__builtin_bit_cast(int, d[0][0]), __builtin_bit_cast(int, d[0][1])), __builtin_bit_cast(int, d[0][2]));
    const int b = max(max(__builtin_bit_cast(int, d[0][3]), __builtin_bit_cast(int, d[1][0])), __builtin_bit_cast(int, d[1][1]));
    return max(max(a, b), max(__builtin_bit_cast(int, d[1][2]), __builtin_bit_cast(int, d[1][3])));
}
constexpr float AT_GUARD = 64.0f;
__device__ __forceinline__ void attn_shift(AttnTile& T, f32x4 (&d)[2], float shift, bool first) {
    const float al = first ? 1.0f : __builtin_amdgcn_exp2f(-shift);
    T.l2 = T.l2 * al;
#pragma unroll
    for (int dt = 0; dt < 4; ++dt) T.o[dt] = T.o[dt] * al;
    T.m2 += shift; T.nm = T.nm - shift; d[0] = d[0] - shift; d[1] = d[1] - shift;
}
__device__ __forceinline__ void attn_pv(AttnTile& T, const f32x4 (&d)[2], const bf16x8 (&vf)[4]) {
    float pv[8];
#pragma unroll
    for (int e = 0; e < 8; ++e) pv[e] = __builtin_amdgcn_exp2f(d[e >> 2][e & 3]);
    T.l2 = T.l2 + (((f32x2_){pv[0], pv[1]} + (f32x2_){pv[2], pv[3]}) + ((f32x2_){pv[4], pv[5]} + (f32x2_){pv[6], pv[7]}));
    const bf16x8 pf = pack8(pv);
#pragma unroll
    for (int dt = 0; dt < 4; ++dt) T.o[dt] = __builtin_amdgcn_mfma_f32_16x16x32_bf16(vf[dt], pf, T.o[dt], 0, 0, 0);
}
template <bool BIAS> __device__ __forceinline__ void attn_step1(AttnTile& T, const bf16x8 (&kf)[2][2], const bf16x8 (&q)[2], const bf16x8 (&vf)[4], const f32x4 (&ma)[2], const f32x4 (&bias)[2], bool first) {
    f32x4 d[2];
#pragma unroll
    for (int t = 0; t < 2; ++t) { const f32x4 c = BIAS ? ma[t] + T.nm : T.nm;
        d[t] = __builtin_amdgcn_mfma_f32_16x16x32_bf16(kf[t][0], q[0], c, 0, 0, 0); d[t] = __builtin_amdgcn_mfma_f32_16x16x32_bf16(kf[t][1], q[1], d[t], 0, 0, 0); }
    if (BIAS) { d[0] = d[0] + bias[0]; d[1] = d[1] + bias[1]; }
    if (first || __any(attn_imax(d) > __builtin_bit_cast(int, AT_GUARD))) { const float smax = attn_rowmax(d); attn_shift(T, d, first ? smax : fmaxf(smax, 0.f), first); }
    attn_pv(T, d, vf);
}
template <bool BIAS> __device__ __forceinline__ void attn_step2(AttnTile& TA, AttnTile& TB, const bf16x8 (&kf)[2][2], const bf16x8 (&qA)[2], const bf16x8 (&qB)[2], const bf16x8 (&vf)[4],
                                           const f32x4 (&ma)[2], const f32x4 (&biasA)[2], const f32x4 (&biasB)[2], bool firstA, bool firstB) {
    f32x4 dA[2], dB[2];
#pragma unroll
    for (int t = 0; t < 2; ++t) { const f32x4 cA = BIAS ? ma[t] + TA.nm : TA.nm, cB = BIAS ? ma[t] + TB.nm : TB.nm;
        dA[t] = __builtin_amdgcn_mfma_f32_16x16x32_bf16(kf[t][0], qA[0], cA, 0, 0, 0); dB[t] = __builtin_amdgcn_mfma_f32_16x16x32_bf16(kf[t][0], qB[0], cB, 0, 0, 0);
        dA[t] = __builtin_amdgcn_mfma_f32_16x16x32_bf16(kf[t][1], qA[1], dA[t], 0, 0, 0); dB[t] = __builtin_amdgcn_mfma_f32_16x16x32_bf16(kf[t][1], qB[1], dB[t], 0, 0, 0); }
    if (BIAS) { dA[0] = dA[0] + biasA[0]; dA[1] = dA[1] + biasA[1]; dB[0] = dB[0] + biasB[0]; dB[1] = dB[1] + biasB[1]; }
    if (firstA || firstB || __any(max(attn_imax(dA), attn_imax(dB)) > __builtin_bit_cast(int, AT_GUARD))) { const float smA = attn_rowmax(dA), smB = attn_rowmax(dB);
        attn_shift(TA, dA, firstA ? smA : fmaxf(smA, 0.f), firstA); attn_shift(TB, dB, firstB ? smB : fmaxf(smB, 0.f), firstB); }
    attn_pv(TA, dA, vf); attn_pv(TB, dB, vf);
}
__device__ __forceinline__ void attn_pair_unit(const P& p, unsigned char* lds, int b, int r, int j, int h, int lane) {
    const int fr = lane & 15, fq = lane >> 4;
    const bf16_t* K = (const bf16_t*)(p.ws + WS_K); const bf16_t* VT = (const bf16_t*)(p.ws + WS_VT); unsigned char* YB = p.ws + WS_YB;
    const int qc = 16 * j + fr; const size_t bh = (size_t)b * 16 + h;
    r = __builtin_amdgcn_readfirstlane(r); j = __builtin_amdgcn_readfirstlane(j);
    const int r0A = min(max(r - 4, 0), 56), r0B = min(max(r + 1 - 4, 0), 56), nst = r0B + 8 - r0A;
    const int c0 = min(max(qc - 8, 0), 48), cs = min(max(16 * j - 8, 0), 32);
    const int sp0 = 8 * (fr >> 2) + (fr & 3);
    const bf16_t* klat = K + (bh * 4096 + r0A * 64 + cs + sp0) * 64 + 8 * fq;
    const bf16_t* vlat = VT + ((bh * 512 + ((r0A * 64 + cs) >> 3) + fq) * 64 + fr) * 8;
    const int fk = ((fr >> 1) & 1) | (((fr >> 2) & 1) << 1) | (((fr >> 3) & 1) << 2);
    const lds_cp kcl = (lds_cp)lds + AT_LDS_KC + sp0 * 128;
    const int kco0 = (fq ^ fk) << 4, kco1 = ((fq + 4) ^ fk) << 4;
    const lds_cp vcl = (lds_cp)lds + AT_LDS_VC + (fq * 64 + fr) * 16;
    const __attribute__((address_space(3))) float* tbl3 = (const __attribute__((address_space(3))) float*)((lds_cp)lds + AT_LDS_RPB);
    const int boffA = (r0A - r + 7) * 64 + (cs + 8 * fq - qc + 31);
    f32x4 ma[2];
#pragma unroll
    for (int jj = 0; jj < 8; ++jj) { const int kc = cs + 8 * fq + jj; ma[jj >> 2][jj & 3] = (kc >= c0 && kc < c0 + 16) ? 0.f : -INFINITY; }
    AttnTile TA, TB;
    attn_tile_init(p, TA, bh, r, qc, fq); attn_tile_init(p, TB, bh, r + 1, qc, fq);
    bf16x8 kf[3][2][2], vf[3][4];
#define LOADKV(buf, st_) do { _Pragma("unroll") for (int t = 0; t < 2; ++t) { const bf16_t* kp_ = klat + (size_t)(st_) * 64 * 64 + t * 4 * 64; kf[buf][t][0] = *(const bf16x8*)kp_; kf[buf][t][1] = *(const bf16x8*)(kp_ + 32); } \
        _Pragma("unroll") for (int dt = 0; dt < 4; ++dt) vf[buf][dt] = *(const bf16x8*)(vlat + dt * 128 + (st_) * 8 * 512); } while (0)
#define LOADBIAS(dst, s_) do { int bo_ = boffA + (s_) * 64; asm volatile("" : "+v"(bo_)); const lds_fp tb_ = tbl3 + bo_; \
        dst[0] = (f32x4){tb_[0], tb_[1], tb_[2], tb_[3]}; dst[1] = (f32x4){tb_[4], tb_[5], tb_[6], tb_[7]}; } while (0)
    const int dB = r0B - r0A;
    f32x4 bp[2], bc[2];
    LOADKV(0, 0); LOADKV(1, 1); LOADBIAS(bc, -1);
#define ATT_STEP(buf, s_) do { const int kr_ = r0A + (s_); const bool doA_ = kr_ <= r0A + 7, doB_ = kr_ >= r0B; \
        bp[0] = bc[0]; bp[1] = bc[1]; LOADBIAS(bc, s_); \
        if (doA_ && doB_) attn_step2<true>(TA, TB, kf[buf], TA.qrt, TB.qrt, vf[buf], ma, bc, bp, (s_) == 0, (s_) == dB); \
        else if (doA_) attn_step1<true>(TA, kf[buf], TA.qrt, vf[buf], ma, bc, (s_) == 0); \
        else attn_step1<true>(TB, kf[buf], TB.qrt, vf[buf], ma, bp, (s_) == dB); } while (0)
#pragma unroll 1
    for (int st = 0; st < nst; st += 3) {
        if (st + 2 < nst) LOADKV(2, st + 2);
        ATT_STEP(0, st);
        if (st + 1 < nst) { if (st + 3 < nst) LOADKV(0, st + 3); ATT_STEP(1, st + 1); }
        if (st + 2 < nst) { if (st + 4 < nst) LOADKV(1, st + 4); ATT_STEP(2, st + 2); }
    }
#undef LOADKV
#undef LOADBIAS
#undef ATT_STEP
    attn_tiles_qplain(p, TA, TB, bh, r, qc, fq);
#pragma unroll 1
    for (int st = 0; st < 8; ++st) {
        bf16x8 kc[2][2], vc[4];
#pragma unroll
        for (int t = 0; t < 2; ++t) { const lds_cp kp_ = kcl + (32 * st + 4 * t) * 128; kc[t][0] = *(const __attribute__((address_space(3))) bf16x8*)(kp_ + kco0); kc[t][1] = *(const __attribute__((address_space(3))) bf16x8*)(kp_ + kco1); }
#pragma unroll
        for (int dt = 0; dt < 4; ++dt) vc[dt] = *(const __attribute__((address_space(3))) bf16x8*)(vcl + st * 4096 + dt * 256);
        attn_step2<false>(TA, TB, kc, TA.qrt, TB.qrt, vc, ma, ma, ma, false, false);
    }
#pragma unroll
    for (int w = 0; w < 2; ++w) { AttnTile& T = w ? TB : TA;
        const float l = rows_sum(T.l2.x + T.l2.y);
        const float inv = YB_F8_SCALE / l; const size_t tq = (size_t)b * SEQ + (r + w) * 64 + qc;
#pragma unroll
        for (int dt = 0; dt < 4; ++dt) { const f32x4 y = __builtin_elementwise_min(__builtin_elementwise_max(T.o[dt] * inv, (f32x4){-448.f, -448.f, -448.f, -448.f}), (f32x4){448.f, 448.f, 448.f, 448.f});
            int ww = 0; ww = __builtin_amdgcn_cvt_pk_fp8_f32(y[0], y[1], ww, false); ww = __builtin_amdgcn_cvt_pk_fp8_f32(y[2], y[3], ww, true);
            *(unsigned*)(YB + tq * 1024 + h * 64 + 16 * dt + 4 * fq) = (unsigned)ww; } }
}
struct ExpItem { const float* W; unsigned char* WT; int N, k0, n0, drow0; };
__device__ __forceinline__ ExpItem exp_item(const P& p, int x) {
    ExpItem I;
    if (x < IT_W1) { const int e = x / 1024, r = x % 1024, kb = r / 64, nb = r % 64, n0 = nb * 32, hf = n0 >> 10, nn = n0 & 1023;
        I.W = p.exp_w1 + (size_t)e * 1024 * 2048; I.WT = p.ws + WS_W1 + (size_t)e * 2048 * 1024; I.N = 2048; I.k0 = kb * 64; I.n0 = n0; I.drow0 = (nn >> 7) * 256 + hf * 128 + (nn & 127); }
    else { x -= IT_W1; const int e = x / 512, r = x % 512, kb = r / 32, nb = r % 32;
        I.W = p.exp_w2 + (size_t)e * 1024 * 1024; I.WT = p.ws + WS_W2 + (size_t)e * 1024 * 1024; I.N = 1024; I.k0 = kb * 64; I.n0 = nb * 32; I.drow0 = nb * 32; }
    return I;
}
constexpr int CV_D = 4, RT_CONV_ITEMS = 112;
__device__ __forceinline__ void convert_stream(const P& p, int vb, int lane, int n0, int n1) {
    f32x4 v[CV_D][8];
#define CV_X(n_) (((n_) >> 3) * 2048 + 8 * vb + ((n_) & 7))
#pragma unroll
    for (int s = 0; s < CV_D; ++s) { const ExpItem I = exp_item(p, CV_X(n0 + s)); f8t_load(I.W, I.N, I.k0, I.n0, lane, v[s]); }
#pragma unroll 1
    for (int n = n0; n < n1; n += CV_D) {
#pragma unroll
        for (int s = 0; s < CV_D; ++s) {
            { const ExpItem I = exp_item(p, CV_X(n + s)); f8t_finish(v[s], 1024, I.WT, I.k0, I.drow0, W_F8_SCALE, lane); }
            if (n + s + CV_D < n1) { const ExpItem I = exp_item(p, CV_X(n + s + CV_D)); f8t_load(I.W, I.N, I.k0, I.n0, lane, v[s]); }
            asm volatile("" ::: "memory"); }
    }
#undef CV_X
}
constexpr int AT_LDS_CNT = AT_LDS_END;
__device__ __forceinline__ void phase_attn_s(const P& p, int bid, int nblk, unsigned char* lds) {
    const int tid_ = tid_opaque(); const int wave = __builtin_amdgcn_readfirstlane(tid_ >> 6), lane = tid_ & 63;
    int* ucnt = (int*)(lds + AT_LDS_CNT);
    for (int vb = bid; vb < 256; vb += nblk) { const int half = vb & 1, h = (vb >> 1) & 15, b = vb >> 5;
        __syncthreads();
        { int ts = tid_; asm volatile("" : "+v"(ts)); attn_stage(p, lds, b, h, ts); }
        if (tid_ == 0) *ucnt = 0;
        __syncthreads();
        if (wave == 7) convert_stream(p, vb, lane, RT_CONV_ITEMS, 192);
        {
#pragma unroll 1
            for (;;) { int lane_o = lane; asm volatile("" : "+v"(lane_o));
                int u = 0; if (lane_o == 0) u = __hip_atomic_fetch_add(ucnt, 1, __ATOMIC_RELAXED, __HIP_MEMORY_SCOPE_WORKGROUP);
                u = __builtin_amdgcn_readfirstlane(u);
                if (u >= 64) break;
                attn_pair_unit(p, lds, b, 32 * half + 2 * (u >> 2), u & 3, h, lane_o); }
        }
    }
}
constexpr int RT_LDS_W = 0, RT_LDS_CNT = 131072, RT_LDS_BASE = RT_LDS_CNT + 128, RT_LDS_REC = RT_LDS_BASE + 128, RT_MAXIT = 32, RT_LDS_END = RT_LDS_REC + 8 * RT_MAXIT * 8 * 4;
__device__ __forceinline__ int rw_off(int prow, int ch) { return prow * 128 + ((ch ^ ((prow >> 1) & 7)) << 4); }
constexpr int RT_RWAVES = 7;
__device__ __forceinline__ void phase_router(const P& p, int bid, int nblk, unsigned char* lds) {
    const int tid = tid_opaque(), wave = __builtin_amdgcn_readfirstlane(tid >> 6), lane = tid & 63;
    int* cnt = (int*)(lds + RT_LDS_CNT); int* base = (int*)(lds + RT_LDS_BASE); int* rec = (int*)(lds + RT_LDS_REC) + wave * RT_MAXIT * 8;
    for (int k = tid; k < 1024; k += 512) { const int l = (k & 255) >> 2, i = k & 3, j = k >> 8, prow = l + 64 * (4 * j + i);
        const f32x4* src = (const f32x4*)(p.router_w + (size_t)k * 32);
#pragma unroll
        for (int ch = 0; ch < 8; ++ch) *(f32x4*)(lds + RT_LDS_W + rw_off(prow, ch)) = src[ch]; }
    if (tid < 32) cnt[tid] = 0;
    __syncthreads();
    const float* mod = (const float*)(p.ws + WS_MOD);
    int* TOPE = (int*)(p.ws + WS_TOPE); float* TOPG = (float*)(p.ws + WS_TOPG); int* SLOT = (int*)(p.ws + WS_SLOT);
    unsigned char* U2 = p.ws + WS_U;
    const int erev = 16 * ((lane >> 4) & 1) + (int)(__builtin_bitreverse32((unsigned)(lane & 15)) >> 28);
    unsigned wb[8];
#pragma unroll
    for (int ch = 0; ch < 8; ++ch) wb[ch] = RT_LDS_W + lane * 128 + ((ch ^ ((lane >> 1) & 7)) << 4);
    unsigned wbh[8];
#pragma unroll
    for (int ch = 0; ch < 8; ++ch) wbh[ch] = wb[ch] + 65536;
    int it = 0;
    const int NRI = 8 * ((NTOK + nblk * 8 - 1) / (nblk * 8));
#define RT_ROW(ri_) (bid * 8 + ((ri_) & 7) + ((ri_) >> 3) * nblk * 8)
    if (wave >= RT_RWAVES) { for (int vb = bid; vb < 256; vb += nblk) convert_stream(p, vb, lane, 0, RT_CONV_ITEMS); }
    else {
    u32x2 pre[4];
    { const int row0 = RT_ROW(wave); if (row0 < NTOK) { const u32x2* xin0 = (const u32x2*)((const bf16_t*)(p.ws + WS_X1PRE) + (size_t)row0 * DM) + lane;
#pragma unroll
        for (int j = 0; j < 4; ++j) pre[j] = xin0[64 * j]; } }
    for (int ri = wave; ri < NRI; ri += RT_RWAVES, ++it) { const int row = RT_ROW(ri); if (row >= NTOK) continue;
        const int b = row >> 12;
        u32x2* xr = (u32x2*)((bf16_t*)(p.ws + WS_X1) + (size_t)row * DM) + lane;
        f32x4 v[4]; float s = 0.f;
#pragma unroll
        for (int j = 0; j < 4; ++j) { const u32x2 w = pre[j]; v[j] = (f32x4){bflo(w.x), bfhi(w.x), bflo(w.y), bfhi(w.y)}; s += (v[j].x + v[j].y) + (v[j].z + v[j].w); }
        { const int rown = (ri + RT_RWAVES < NRI) ? RT_ROW(ri + RT_RWAVES) : NTOK; if (rown < NTOK) { const u32x2* xinn = (const u32x2*)((const bf16_t*)(p.ws + WS_X1PRE) + (size_t)rown * DM) + lane;
#pragma unroll
            for (int j = 0; j < 4; ++j) pre[j] = xinn[64 * j]; } }
        const float mean = wave_sum(s) * (1.f / DM); float s2 = 0.f;
#pragma unroll
        for (int j = 0; j < 4; ++j) { v[j] = v[j] - mean; s2 += (v[j].x * v[j].x + v[j].y * v[j].y) + (v[j].z * v[j].z + v[j].w * v[j].w); }
        const float rstd = 1.f / sqrtf(wave_sum(s2) * (1.f / DM) + LN_EPS);
        unsigned* o8 = (unsigned*)(U2 + (size_t)row * DM) + lane;
        int lane_o = lane; asm volatile("" : "+v"(lane_o));
        f32x4 u[4], pg[4], pb[4], psh[4], psc[4];
#pragma unroll
        for (int j = 0; j < 4; ++j) { const int col = 4 * lane_o + 256 * j;
            pg[j] = *(const f32x4*)(p.ln1_g + col); pb[j] = *(const f32x4*)(p.ln1_b + col); psh[j] = *(const f32x4*)(mod + b * 6144 + 3072 + col); psc[j] = *(const f32x4*)(mod + b * 6144 + 4096 + col); }
#pragma unroll
        for (int j = 0; j < 4; ++j) {
            const f32x4 gg = pg[j], bb = pb[j], shv = psh[j], scv = psc[j];
            const f32x4 x1 = (v[j] * rstd) * gg + bb; { u32x2 w; w.x = pk2(x1.x, x1.y); w.y = pk2(x1.z, x1.w); xr[64 * j] = w; }
            u[j] = x1 * (1.0f + scv) + shv;
            int w = 0; w = __builtin_amdgcn_cvt_pk_fp8_f32(u[j].x, u[j].y, w, false); w = __builtin_amdgcn_cvt_pk_fp8_f32(u[j].z, u[j].w, w, true); o8[64 * j] = (unsigned)w; }
        float lg2[2];
#pragma unroll
        for (int hf = 0; hf < 2; ++hf) {
            f32x2_ a2[8];
#pragma unroll
            for (int e = 0; e < 8; ++e) a2[e] = (f32x2_){0.f, 0.f};
            const __attribute__((address_space(3))) unsigned char* lw = (const __attribute__((address_space(3))) unsigned char*)lds;
#pragma unroll
            for (int j = 0; j < 4; ++j)
#pragma unroll
                for (int i = 0; i < 4; ++i) { const f32x2_ uv = (f32x2_){u[j][i], u[j][i]};
#pragma unroll
                    for (int ch = 0; ch < 4; ++ch) {
                        const f32x4 w4 = (4 * j + i < 8) ? *(const __attribute__((address_space(3))) f32x4*)(lw + wb[4 * hf + ch] + (4 * j + i) * 8192) : *(const __attribute__((address_space(3))) f32x4*)(lw + wbh[4 * hf + ch] + (4 * j + i - 8) * 8192);
                        a2[2 * ch] = __builtin_elementwise_fma((f32x2_){w4.x, w4.y}, uv, a2[2 * ch]); a2[2 * ch + 1] = __builtin_elementwise_fma((f32x2_){w4.z, w4.w}, uv, a2[2 * ch + 1]); } }
            float a[16];
#pragma unroll
            for (int e = 0; e < 8; ++e) { a[2 * e] = a2[e].x; a[2 * e + 1] = a2[e].y; }
#define RS_STAGE(st) { constexpr int n = 8 >> st; const bool up = (lane >> st) & 1; \
                _Pragma("unroll") for (int i = 0; i < n; ++i) { float lo = a[i], hi = a[n + i]; asm volatile("" : "+v"(lo), "+v"(hi));     \
                    const float keep = up ? hi : lo, send = up ? lo : hi; a[i] = keep + xor_row<st>(send); } }
            RS_STAGE(0) RS_STAGE(1) RS_STAGE(2) RS_STAGE(3)
#undef RS_STAGE
            lg2[hf] = rows_sum(a[0]);
        }
        float logit = ((lane >> 4) & 1) ? lg2[1] : lg2[0];
        logit += p.router_b[erev];
        float cur = logit;
#define TOP_STEP(TV, TE) float TV; int TE; { const float mx = wave_max(cur); int cand = (cur == mx) ? erev : 64; \
            cand = wave_min_i(cand); \
            TV = mx; TE = cand; if (erev == cand) cur = -INFINITY; }
        TOP_STEP(tv0, te0) TOP_STEP(tv1, te1) TOP_STEP(tv2, te2) TOP_STEP(tv3, te3)
#undef TOP_STEP
        const float gk0 = 1.0f, gk1 = __expf(tv1 - tv0), gk2 = __expf(tv2 - tv0), gk3 = __expf(tv3 - tv0);
        const float ginv = 1.f / (gk0 + gk1 + gk2 + gk3);
        if (lane < 4) { const int e = lane == 0 ? te0 : lane == 1 ? te1 : lane == 2 ? te2 : te3; const float g = lane == 0 ? gk0 : lane == 1 ? gk1 : lane == 2 ? gk2 : gk3;
            const int pos = atomicAdd(&cnt[e], 1);
            TOPE[row * 4 + lane] = e; TOPG[row * 4 + lane] = g * ginv;
            if (it < RT_MAXIT) { rec[it * 8 + lane * 2] = e; rec[it * 8 + lane * 2 + 1] = pos; } }
    }
    }
    __syncthreads();
    if (tid < 32) base[tid] = atomicAdd((int*)(p.ws + WS_CTL) + tid, cnt[tid]);
    __syncthreads();
    it = 0;
    int* PERM2 = (int*)(p.ws + WS_PERM2);
    if (wave < RT_RWAVES) for (int ri = wave; ri < NRI; ri += RT_RWAVES, ++it) { const int row = RT_ROW(ri);
        if (row < NTOK && lane < 4 && it < RT_MAXIT) { const int e = rec[it * 8 + lane * 2], pos = base[e] + rec[it * 8 + lane * 2 + 1]; SLOT[row * 4 + lane] = pos; PERM2[(size_t)e * NTOK + pos] = row; } }
#undef RT_ROW
}
constexpr int MT_LDS = 131072 + 1024;
__device__ __forceinline__ void moe_tables(const P& p, unsigned char* lds) {
    const int tid = tid_opaque(); int* cn = (int*)(lds + MT_LDS); int* eb = cn + 32; int* tb = eb + 33;
    __syncthreads();
    if (tid < 32) cn[tid] = __hip_atomic_load((int*)(p.ws + WS_CTL) + tid, __ATOMIC_RELAXED, __HIP_MEMORY_SCOPE_AGENT);
    __syncthreads();
    if (tid == 0) { int s = 0, t = 0; for (int e = 0; e < 32; ++e) { eb[e] = s; tb[e] = t; s += cn[e]; t += (cn[e] + 255) >> 8; } eb[32] = s; tb[32] = t; }
    __syncthreads();
}
struct FinIdx { int e[4]; int pos[4]; float g[4]; };
struct FinData { u32x4 ys[4]; u32x4 x[2]; f32x4 g2[4]; };
__device__ __forceinline__ void fin_load_idx(const P& p, int row, FinIdx& r) {
    const u32x4 ev = *(const u32x4*)((const int*)(p.ws + WS_TOPE) + row * 4), pv = *(const u32x4*)((const int*)(p.ws + WS_SLOT) + row * 4); const f32x4 gv = *(const f32x4*)((const float*)(p.ws + WS_TOPG) + row * 4);
#pragma unroll
    for (int k = 0; k < 4; ++k) { r.e[k] = (int)ev[k]; r.pos[k] = (int)pv[k]; r.g[k] = gv[k] * (1.0f / YS_F8_SCALE); }
}
__device__ __forceinline__ void fin_load_data(const P& p, const int* eb, int row, const FinIdx& ix, FinData& d, int lane) {
    const unsigned char* YS = p.ws + WS_YS;
#pragma unroll
    for (int k = 0; k < 4; ++k) { const size_t slot = (size_t)(eb[ix.e[k]] + ix.pos[k]); d.ys[k] = *(const u32x4*)(YS + slot * 1024 + 16 * lane); }
    const u32x4* xr = (const u32x4*)((const bf16_t*)(p.ws + WS_X1) + (size_t)row * DM + 16 * lane); d.x[0] = xr[0]; d.x[1] = xr[1];
    const float* g2p = (const float*)(p.ws + WS_MOD) + (row >> 12) * 6144 + 5120 + 16 * lane;
#pragma unroll
    for (int q = 0; q < 4; ++q) d.g2[q] = *(const f32x4*)(g2p + 4 * q);
}
__device__ __forceinline__ void phase_final(const P& p, int bid, int nblk, unsigned char* lds) {
    moe_tables(p, lds); const int* eb = (const int*)(lds + MT_LDS) + 32;
    const int tid = tid_opaque(), wave = tid >> 6, lane = tid & 63;
    const float* mod = (const float*)(p.ws + WS_MOD);
    const int stride = nblk * 8;
    int row = bid * 8 + wave; if (row >= NTOK) return;
    FinIdx ic, in; FinData dc, dn;
    f32x4 l2g[4], l2b[4];
#pragma unroll
    for (int q = 0; q < 4; ++q) { l2g[q] = *(const f32x4*)(p.ln2_g + 16 * lane + 4 * q); l2b[q] = *(const f32x4*)(p.ln2_b + 16 * lane + 4 * q); }
    fin_load_idx(p, row, ic); fin_load_data(p, eb, row, ic, dc, lane);
    int row_n = row + stride; if (row_n < NTOK) fin_load_idx(p, row_n, in);
#pragma unroll 1
    for (;;) {
        if (row_n < NTOK) fin_load_data(p, eb, row_n, in, dn, lane);
        const int row_nn = row_n + stride; FinIdx inn; if (row_nn < NTOK) fin_load_idx(p, row_nn, inn);
        const int b = row >> 12, col = 16 * lane;
        f32x4 v[4]; float s = 0.f;
#pragma unroll
        for (int q = 0; q < 4; ++q) v[q] = (f32x4){0.f, 0.f, 0.f, 0.f};
#pragma unroll
        for (int k = 0; k < 4; ++k) { const u32x4 w = dc.ys[k]; const float g = ic.g[k];
            v[0] += unpack4_f8(w.x) * g; v[1] += unpack4_f8(w.y) * g; v[2] += unpack4_f8(w.z) * g; v[3] += unpack4_f8(w.w) * g; }
#pragma unroll
        for (int q = 0; q < 4; ++q) { const u32x4 xw = dc.x[q >> 1]; const unsigned w0 = (q & 1) ? xw.z : xw.x, w1 = (q & 1) ? xw.w : xw.y;
            const f32x4 xa = (f32x4){bflo(w0), bfhi(w0), bflo(w1), bfhi(w1)}; const f32x4 g2 = dc.g2[q];
            v[q] = xa * ALPHA + g2 * v[q]; s += (v[q].x + v[q].y) + (v[q].z + v[q].w); }
        const float mean = wave_sum(s) * (1.f / DM); float s2 = 0.f;
#pragma unroll
        for (int q = 0; q < 4; ++q) { v[q] = v[q] - mean; s2 += (v[q].x * v[q].x + v[q].y * v[q].y) + (v[q].z * v[q].z + v[q].w * v[q].w); }
        const float rstd = 1.f / sqrtf(wave_sum(s2) * (1.f / DM) + LN_EPS);
        f32x4* xo = (f32x4*)(p.out + (size_t)row * DM + col);
#pragma unroll
        for (int q = 0; q < 4; ++q) xo[q] = (v[q] * rstd) * l2g[q] + l2b[q];
        if (row_n >= NTOK) break;
        row = row_n; row_n = row_nn; ic = in; in = inn; dc = dn;
    }
}

namespace pg {
#define PG_LAS __attribute__((address_space(3)))
typedef float f32x2 __attribute__((ext_vector_type(2)));
constexpr int BM = 256, BK = 64, HALF = 128, HTB = HALF * BK * 2, STAGE_BYTES = 8 * HTB, KD = 1024, NT = KD / BK;
constexpr unsigned KSTEP = BK * 2, HSTEPB = HALF * KD * 2;
__host__ __device__ __forceinline__ int lds_byte(int r, int c) { const int st = (r >> 4) * 2 + (c >> 5), rr = r & 15, cc = c & 31, ob = rr * 64 + cc * 2; return st * 1024 + (ob ^ (((ob >> 9) & 1) << 5)); }
__host__ __device__ __forceinline__ void stage_rc(int b, int& R, int& C) { const int st = b / 1024, sb = b % 1024, swz = sb ^ (((sb >> 9) & 1) << 5); R = (st >> 1) * 16 + swz / 64; C = (st & 1) * 32 + (swz % 64) / 2; }
__host__ __device__ __forceinline__ int perm32(int rho) { const int n = rho >> 4, i = rho & 15; return 8 * (i >> 2) + 4 * n + (i & 3); }
struct Unit { int pm, pn, row0, nrows, e, kind; };
__device__ __forceinline__ void tilemap(int L, int nM, int nN, int& pm, int& pn) {
    int wgid = L; { const int nwg = nM * nN, q = nwg / 8, r = nwg % 8, xcd = wgid % 8, off = wgid / 8; wgid = (xcd < r ? xcd * (q + 1) : r * (q + 1) + (xcd - r) * q) + off; }
    const int nig = 8 * nN, gid = wgid / nig, fm = gid * 8, gsz = (nM - fm) < 8 ? (nM - fm) : 8;
    pm = fm + ((wgid % nig) % gsz); pn = (wgid % nig) / gsz;
}
__device__ __forceinline__ unsigned cvt_pk_bf16(float lo, float hi) { unsigned r; asm volatile("v_cvt_pk_bf16_f32 %0, %1, %2" : "=v"(r) : "v"(lo), "v"(hi)); return r; }
__device__ __forceinline__ f32x2 gelu_pk(f32x2 v) {
    const f32x2 av = __builtin_elementwise_abs(v), d = av * 0.2316418882f + 1.0f;
    f32x2 t; t.x = __builtin_amdgcn_rcpf(d.x); t.y = __builtin_amdgcn_rcpf(d.y);
    f32x2 q = t * 0.5307027145f + (-0.7265760135f); q = q * t + 0.7107068705f; q = q * t + (-0.142248368f); q = q * t + 0.127414796f; q = q * t;
    const f32x2 s = (v * v) * (-0.72134752044f);
    f32x2 e; e.x = __builtin_amdgcn_exp2f(s.x); e.y = __builtin_amdgcn_exp2f(s.y);
    const f32x2 m = v * (q * e), r = v - m;
    f32x2 o; o.x = v.x < 0.f ? m.x : r.x; o.y = v.y < 0.f ? m.y : r.y; return o;
}
__device__ __forceinline__ f32x4 gelu4(f32x4 v) { const f32x2 a = gelu_pk((f32x2){v[0], v[1]}), b = gelu_pk((f32x2){v[2], v[3]}); return (f32x4){a.x, a.y, b.x, b.y}; }
__device__ __forceinline__ f32x4 sigmoid4(f32x4 v) { f32x4 o;
#pragma unroll
    for (int i = 0; i < 4; ++i) o[i] = __builtin_amdgcn_rcpf(1.0f + __builtin_amdgcn_exp2f(-1.4426950408889634f * v[i]));
    return o; }
__device__ __forceinline__ u32x4 pack8v(f32x4 a, f32x4 b) { u32x4 w; w.x = cvt_pk_bf16(a[0], a[1]); w.y = cvt_pk_bf16(a[2], a[3]); w.z = cvt_pk_bf16(b[0], b[1]); w.w = cvt_pk_bf16(b[2], b[3]); return w; }

typedef int v8i __attribute__((ext_vector_type(8)));
template <class Epi, class Sched, bool ALIGN_EPI, bool F8 = false>
__device__ __forceinline__ void gemm_phase(PG_LAS unsigned char* lds, const unsigned char* Abase, const Sched& S, const Epi& E) {
    const int tid = tid_opaque(), wid = __builtin_amdgcn_readfirstlane(tid >> 6), lane = tid & 63, wr = wid >> 2, wc = wid & 3, fr = lane & 15, fq = lane >> 4;
    int R[2], C[2]; unsigned voffB[2];
#pragma unroll
    for (int i = 0; i < 2; ++i) { stage_rc(tid * 16 + i * 8192, R[i], C[i]);
        const int rho = R[i] & 31, Rb = Epi::PERM == 0 ? R[i] : (Epi::PERM == 1 ? ((R[i] & ~31) + perm32(rho)) : ((R[i] >> 5) * 64 + 16 * ((rho & 15) >> 2) + 4 * (rho >> 4) + (rho & 3)));
        voffB[i] = (unsigned)(Rb * (F8 ? 1024 : 2048) + C[i] * 2); }
    constexpr unsigned HSB = (Epi::PERM == 2 ? 8u : 128u) * (F8 ? 1024u : 2048u);
    constexpr int NTL = F8 ? NT / 2 : NT;
    const unsigned ldsw = (unsigned)wid * 1024u;
    const int aoff = lds_byte(wr * 64 + fr, fq * 8), boff = lds_byte(wc * 32 + fr, fq * 8);
#define PG_SA(b, h) (((b) * 2 + (h)) * HTB)
#define PG_SB(b, h) ((4 + (b) * 2 + (h)) * HTB)
#define PG_STAGE_A(bufoff, kbyte, vo) do { _Pragma("unroll") for (int _i = 0; _i < 2; ++_i) \
        __builtin_amdgcn_global_load_lds((const unsigned*)((const char*)Abase + (kbyte) + (vo)[_i]), (PG_LAS unsigned*)(lds + (bufoff) + ldsw + _i * 8192), 16, 0, 0); } while (0)
#define PG_STAGE_B(bufoff, gbase) do { _Pragma("unroll") for (int _i = 0; _i < 2; ++_i) \
        __builtin_amdgcn_global_load_lds((const unsigned*)((const char*)(gbase) + voffB[_i]), (PG_LAS unsigned*)(lds + (bufoff) + ldsw + _i * 8192), 16, 0, 0); } while (0)
#define PG_LD16(off) (*(const PG_LAS u32x4*)(lds + (off)))
#define PG_CAT(lo, hi) __builtin_bit_cast(v8i, __builtin_shufflevector((lo), (hi), 0, 1, 2, 3, 4, 5, 6, 7))
#define PG_LDA(dst, b, h) do { _Pragma("unroll") for (int m = 0; m < 4; ++m) { \
        if constexpr (F8) dst##8[m] = PG_CAT(PG_LD16(PG_SA(b, h) + aoff + m * 2048), PG_LD16(PG_SA(b, h) + aoff + m * 2048 + 1024)); \
        else { _Pragma("unroll") for (int k = 0; k < 2; ++k) dst[m][k] = *(const PG_LAS bf16x8*)(lds + PG_SA(b, h) + aoff + m * 2048 + k * 1024); } } } while (0)
#define PG_LDB(dst, b, h) do { _Pragma("unroll") for (int n = 0; n < 2; ++n) { \
        if constexpr (F8) dst##8[n] = PG_CAT(PG_LD16(PG_SB(b, h) + boff + n * 2048), PG_LD16(PG_SB(b, h) + boff + n * 2048 + 1024)); \
        else { _Pragma("unroll") for (int k = 0; k < 2; ++k) dst[n][k] = *(const PG_LAS bf16x8*)(lds + PG_SB(b, h) + boff + n * 2048 + k * 1024); } } } while (0)
#define PG_MMA(ai, bj, At, Bt) do { __builtin_amdgcn_s_setprio(1); _Pragma("unroll") for (int m = 0; m < 4; ++m) _Pragma("unroll") for (int n = 0; n < 2; ++n) { \
        if constexpr (F8) asm volatile("s_nop 1\n\tv_mfma_scale_f32_16x16x128_f8f6f4 %0, %1, %2, %0, %3, %3 op_sel_hi:[0,0,0]" : "+v"(acc[ai][bj][m][n]) : "v"(Bt##8[n]), "v"(At##8[m]), "v"(f8scale)); \
        else { _Pragma("unroll") for (int k = 0; k < 2; ++k) acc[ai][bj][m][n] = __builtin_amdgcn_mfma_f32_16x16x32_bf16(Bt[n][k], At[m][k], acc[ai][bj][m][n], 0, 0, 0); } } \
        __builtin_amdgcn_s_setprio(0); } while (0)
#define PG_WAIT_V(n) asm volatile("s_waitcnt vmcnt(" #n ")" ::: "memory")
#define PG_WAIT_L(n) asm volatile("s_waitcnt lgkmcnt(" #n ")" ::: "memory")
#define PG_BAR __builtin_amdgcn_s_barrier()
#define PG_SCHED __builtin_amdgcn_sched_barrier(0)
    Unit cur, nxt; int ui = 0;
    if (!S.next(0, cur)) return;
    f32x4 acc[2][2][4][2];
#pragma unroll
    for (int a = 0; a < 2; ++a)
#pragma unroll
        for (int b = 0; b < 2; ++b)
#pragma unroll
            for (int m = 0; m < 4; ++m)
#pragma unroll
                for (int n = 0; n < 2; ++n) acc[a][b][m][n] = (f32x4){0.f, 0.f, 0.f, 0.f};
    bf16x8 At[4][2], B0[2][2], B1[2][2]; v8i At8[4], B08[2], B18[2];
    int f8scale = 0x7f7f7f7f; asm volatile("" : "+v"(f8scale));
    unsigned ac[2][2], an[2][2];
    S.aoffs(cur, R, C, ac);
    const char* cB = S.bptr(cur);
    PG_STAGE_B(PG_SB(0, 0), cB); PG_STAGE_B(PG_SB(0, 1), cB + HSB); PG_STAGE_A(PG_SA(0, 0), 0u, ac[0]); PG_STAGE_A(PG_SA(0, 1), 0u, ac[1]);
    if (wr == 1) PG_BAR;
    PG_WAIT_V(2); PG_BAR;
    PG_STAGE_B(PG_SB(1, 0), cB + KSTEP); PG_STAGE_A(PG_SA(1, 0), KSTEP, ac[0]); PG_STAGE_B(PG_SB(1, 1), cB + HSB + KSTEP);
    PG_WAIT_V(6); PG_BAR;
    for (;;) {
        const bool has_next = S.next(ui + 1, nxt);
        const char* nB = cB;
        if (has_next) { int R2[2], C2[2]; int t2 = tid; asm volatile("" : "+v"(t2));
#pragma unroll
            for (int i = 0; i < 2; ++i) stage_rc(t2 * 16 + i * 8192, R2[i], C2[i]);
            S.aoffs(nxt, R2, C2, an); nB = S.bptr(nxt); }
        else {
#pragma unroll
            for (int h = 0; h < 2; ++h)
#pragma unroll
                for (int i = 0; i < 2; ++i) an[h][i] = ac[h][i]; }
        for (int t = 0; t < NTL; t += 2) {
            const bool last = (t == NTL - 2);
            const unsigned ka1 = (unsigned)(t + 1) * KSTEP;
            const unsigned ka2 = last ? 0u : (unsigned)(t + 2) * KSTEP;
            const char* b2 = last ? nB : cB + (size_t)(t + 2) * KSTEP; const char* b3 = b2 + KSTEP;
            unsigned a2o[2][2];
#pragma unroll
            for (int h = 0; h < 2; ++h)
#pragma unroll
                for (int i = 0; i < 2; ++i) a2o[h][i] = last ? an[h][i] : ac[h][i];
            PG_LDB(B0, 0, 0); PG_LDB(B1, 0, 1); PG_SCHED; PG_LDA(At, 0, 0); PG_STAGE_A(PG_SA(1, 1), ka1, ac[1]);
            PG_WAIT_V(8); PG_WAIT_L(0); PG_BAR; PG_MMA(0, 0, At, B0); PG_MMA(0, 1, At, B1); PG_BAR; PG_SCHED;
            PG_LDA(At, 0, 1); PG_STAGE_B(PG_SB(0, 0), b2); PG_STAGE_B(PG_SB(0, 1), b2 + HSB); PG_STAGE_A(PG_SA(0, 0), ka2, a2o[0]);
            PG_WAIT_V(8); PG_WAIT_L(0); PG_BAR; PG_MMA(1, 0, At, B0); PG_MMA(1, 1, At, B1); PG_BAR; PG_SCHED;
            PG_LDB(B0, 1, 0); PG_LDB(B1, 1, 1); PG_SCHED; PG_LDA(At, 1, 0); PG_STAGE_A(PG_SA(0, 1), ka2, a2o[1]);
            PG_WAIT_V(8); PG_WAIT_L(0); PG_BAR; PG_MMA(0, 0, At, B0); PG_MMA(0, 1, At, B1); PG_BAR; PG_SCHED;
            PG_LDA(At, 1, 1); PG_STAGE_B(PG_SB(1, 0), b3); PG_STAGE_B(PG_SB(1, 1), b3 + HSB); PG_STAGE_A(PG_SA(1, 0), ka2 + KSTEP, a2o[0]);
            PG_WAIT_V(8); PG_WAIT_L(0); PG_BAR; PG_MMA(1, 0, At, B0); PG_MMA(1, 1, At, B1); PG_BAR; PG_SCHED;
        }
        if constexpr (ALIGN_EPI) { if (wr == 0) PG_BAR; }
        if constexpr (F8) asm volatile("s_nop 15\n\ts_nop 15" ::: "memory");
        { int te = tid; asm volatile("" : "+v"(te)); E.run(acc, cur, wr, wc, te & 15, (te >> 4) & 3); }
        if (!has_next) break;
        if (!E.carry(cur)) {
#pragma unroll
            for (int a = 0; a < 2; ++a)
#pragma unroll
                for (int b = 0; b < 2; ++b)
#pragma unroll
                    for (int m = 0; m < 4; ++m)
#pragma unroll
                        for (int n = 0; n < 2; ++n) acc[a][b][m][n] = (f32x4){0.f, 0.f, 0.f, 0.f}; }
        cur = nxt; cB = nB; ++ui;
#pragma unroll
        for (int h = 0; h < 2; ++h)
#pragma unroll
            for (int i = 0; i < 2; ++i) ac[h][i] = an[h][i];
        if constexpr (ALIGN_EPI) { if (wr == 1) PG_BAR; }
    }
    PG_WAIT_V(0);
    if constexpr (!ALIGN_EPI) { if (wr == 0) PG_BAR; }
    PG_BAR;
#undef PG_SA
#undef PG_SB
#undef PG_STAGE_A
#undef PG_STAGE_B
#undef PG_LDA
#undef PG_LDB
#undef PG_MMA
#undef PG_CAT
#undef PG_LD16
#undef PG_WAIT_V
#undef PG_WAIT_L
#undef PG_BAR
#undef PG_SCHED
}

struct SchedP1 {
    int G, c; const unsigned char* ws;
    __device__ __forceinline__ bool next(int i, Unit& u) const {
        const int L = i * G + c; if (L >= 3136) return false;
        u.row0 = 0; u.nrows = 256; u.e = 0;
        if (L < 2048) { u.kind = 0; tilemap(L, 128, 16, u.pm, u.pn); }
        else if (L < 3072) { u.kind = 1; tilemap(L - 2048, 8, 128, u.pm, u.pn); }
        else if (L < 3104) { u.kind = 2; const int l = L - 3072; u.pm = l >> 2; u.pn = l & 3; }
        else { u.kind = 3; const int l = L - 3104; u.pm = l >> 3; u.pn = l & 7; }
        return true; }
    __device__ __forceinline__ void aoffs(const Unit& u, const int (&R)[2], const int (&C)[2], unsigned (&o)[2][2]) const {
        size_t base; int row0;
        if (u.kind == 0) { base = WS_U; row0 = 256 * u.pm; }
        else if (u.kind == 1) { base = WS_WIN; row0 = u.pm < 4 ? 1024 + 256 * u.pm : 4096 + 256 * (u.pm - 4); }
        else if (u.kind == 2) { base = WS_UC; row0 = 256 * u.pm; }
        else { base = WS_WIN; row0 = 4096 + 256 * u.pm; }
#pragma unroll
        for (int h = 0; h < 2; ++h)
#pragma unroll
            for (int i = 0; i < 2; ++i) o[h][i] = (unsigned)(base + (size_t)(row0 + 128 * h + R[i]) * 1024 + C[i] * 2); }
    __device__ __forceinline__ const char* bptr(const Unit& u) const {
        if (u.kind == 0) { const int wrow = u.pn < 4 ? 256 * u.pn : (u.pn < 8 ? 2048 + 256 * (u.pn - 4) : 5120 + 256 * (u.pn - 8)); return (const char*)ws + WS_WIN + (size_t)wrow * 1024; }
        if (u.kind == 1) return (const char*)ws + WS_U + (size_t)u.pn * 256 * 1024;
        if (u.kind == 2) return (const char*)ws + WS_WIN + (size_t)(3072 + 256 * u.pn) * 1024;
        return (const char*)ws + WS_UC + (size_t)u.pn * 256 * 1024; }
};
constexpr float P1_DS = 1.0f / (U_F8_SCALE * WIN_F8_SCALE);
struct EpiP1 {
    static constexpr int PERM = 1;
    unsigned char* ws; const float* b_in;
    __device__ __forceinline__ bool carry(const Unit&) const { return false; }
    __device__ __forceinline__ void run(f32x4 (&acc)[2][2][4][2], const Unit& u, int wr, int wc, int fr, int fq) const {
        const int lc = wc * 32 + 8 * fq, kind = u.kind, pm = u.pm, pn = u.pn;
        const bool brow = (kind == 1) || (kind == 3);
        int act, bcol, browbase, RA, RB, CA, CB; size_t base;
        if (kind == 0) { browbase = 0;
            if (pn < 4) { act = 1; bcol = 256 * pn; base = WS_ZU / 2 + (size_t)256 * pm * 1024 + 256 * pn; RA = 65536; RB = 1024; CA = 64; CB = 1; }
            else if (pn < 8) { act = 0; bcol = 2048 + 256 * (pn - 4); const int tok0 = 256 * pm;
                base = WS_Q / 2 + ((size_t)((tok0 >> 12) * 16 + 4 * (pn - 4)) * 4096 + (tok0 & 4095)) * 64; RA = 4096; RB = 64; CA = 4096 * 64; CB = 1; }
            else { act = 2; bcol = 5120 + 256 * (pn - 8); base = WS_G / 2 + (size_t)256 * pm * 2048 + 256 * (pn - 8); RA = 131072; RB = 2048; CA = 64; CB = 1; } }
        else if (kind == 1) { bcol = 0; const int tk0 = 256 * pn;
            if (pm < 4) { act = 1; browbase = 1024 + 256 * pm; base = WS_ZVT / 2 + (size_t)(tk0 >> 3) * 8192 + 256 * pm * 8; RA = 512; RB = 8; CA = 65536; CB = 1024; }
            else { act = 0; browbase = 4096 + 256 * (pm - 4); base = WS_VT / 2 + ((size_t)((tk0 >> 12) * 16 + 4 * (pm - 4)) * 512 + ((tk0 & 4095) >> 3)) * 512; RA = 512 * 512; RB = 8; CA = 4096; CB = 64; } }
        else if (kind == 2) { act = 0; bcol = 3072 + 256 * pn; browbase = 0; base = WS_KC / 2 + (size_t)(pm * 16 + 4 * pn) * 256 * 64; RA = 4096; RB = 64; CA = 16384; CB = 1; }
        else { act = 0; bcol = 0; browbase = 4096 + 256 * pm; base = WS_VCT / 2 + (size_t)(pn * 16 + 4 * pm) * 32 * 512; RA = 32 * 512; RB = 8; CA = 4096; CB = 64; }
        bf16_t* dbase = (bf16_t*)ws + base;
        f32x4 bv[2][2];
#pragma unroll
        for (int bj = 0; bj < 2; ++bj)
#pragma unroll
            for (int n = 0; n < 2; ++n) bv[bj][n] = brow ? (f32x4){0.f, 0.f, 0.f, 0.f} : *(const f32x4*)(b_in + bcol + lc + bj * HALF + 4 * n);
        const int colterm0 = (wc >> 1) * CA + ((wc & 1) * 32 + 8 * fq) * CB;
        float rbv[2][4];
#pragma unroll
        for (int ai = 0; ai < 2; ++ai)
#pragma unroll
            for (int m = 0; m < 4; ++m) rbv[ai][m] = brow ? b_in[browbase + ai * HALF + wr * 64 + m * 16 + fr] : 0.f;
#pragma unroll
        for (int ai = 0; ai < 2; ++ai)
#pragma unroll
            for (int m = 0; m < 4; ++m) { const int row = ai * HALF + wr * 64 + m * 16 + fr;
                const float rb = rbv[ai][m];
                const int rowterm = (2 * ai + wr) * RA + (16 * m + fr) * RB;
#pragma unroll
                for (int bj = 0; bj < 2; ++bj) {
                    f32x4 v0 = acc[ai][bj][m][0] * P1_DS + bv[bj][0] + rb, v1 = acc[ai][bj][m][1] * P1_DS + bv[bj][1] + rb;
                    if (act == 1) { v0 = gelu4(v0); v1 = gelu4(v1); } else if (act == 2) { v0 = sigmoid4(v0); v1 = sigmoid4(v1); }
                    *(u32x4*)(dbase + rowterm + colterm0 + 2 * bj * CA) = pack8v(v0, v1); } }
    }
};
struct SchedK {
    int G, c; const unsigned char* ws;
    __device__ __forceinline__ bool next(int i, Unit& u) const { const int L = i * G + c; if (L >= 512) return false; u.kind = 0; u.row0 = 0; u.nrows = 256; u.e = 0; tilemap(L, 128, 4, u.pm, u.pn); return true; }
    __device__ __forceinline__ void aoffs(const Unit& u, const int (&R)[2], const int (&C)[2], unsigned (&o)[2][2]) const {
#pragma unroll
        for (int h = 0; h < 2; ++h)
#pragma unroll
            for (int i = 0; i < 2; ++i) o[h][i] = (unsigned)(WS_U + (size_t)(256 * u.pm + 128 * h + R[i]) * 1024 + C[i] * 2); }
    __device__ __forceinline__ const char* bptr(const Unit& u) const { return (const char*)ws + WS_WIN + (size_t)(3072 + 256 * u.pn) * 1024; }
};
struct EpiRope {
    static constexpr int PERM = 0;
    unsigned char* ws; const float* b_in;
    __device__ __forceinline__ bool carry(const Unit&) const { return false; }
    __device__ __forceinline__ void run(f32x4 (&acc)[2][2][4][2], const Unit& u, int wr, int wc, int fr, int fq) const {
        bf16_t* K = (bf16_t*)(ws + WS_K); const float* tab = (const float*)(ws + WS_ROPE);
        const int lc = wc * 32 + 4 * fq, axis = wc & 1;
        f32x4 b0[2], b1[2];
#pragma unroll
        for (int bj = 0; bj < 2; ++bj) { b0[bj] = *(const f32x4*)(b_in + 3072 + 256 * u.pn + bj * HALF + lc); b1[bj] = *(const f32x4*)(b_in + 3072 + 256 * u.pn + bj * HALF + lc + 16); }
        f32x4 tb0[2][4], tb1[2][4];
#pragma unroll
        for (int ai = 0; ai < 2; ++ai)
#pragma unroll
            for (int m = 0; m < 4; ++m) { const int tok = 256 * u.pm + ai * HALF + wr * 64 + m * 16 + fr; const int pos = axis ? (tok & 63) : ((tok >> 6) & 63);
                tb0[ai][m] = *(const f32x4*)(tab + (pos * 16 + 4 * fq) * 2); tb1[ai][m] = *(const f32x4*)(tab + (pos * 16 + 4 * fq) * 2 + 4); }
#pragma unroll
        for (int ai = 0; ai < 2; ++ai)
#pragma unroll
            for (int m = 0; m < 4; ++m) { const int tok = 256 * u.pm + ai * HALF + wr * 64 + m * 16 + fr;
                const f32x4 t0 = tb0[ai][m], t1 = tb1[ai][m];
                const f32x4 cs = (f32x4){t0[0], t0[2], t1[0], t1[2]}, sn = (f32x4){t0[1], t0[3], t1[1], t1[3]};
                const int cc0 = 256 * u.pn + lc;
                bf16_t* rowp = K + ((size_t)((tok >> 12) * 16) * 4096 + (tok & 4095)) * 64;
#pragma unroll
                for (int bj = 0; bj < 2; ++bj) { const f32x4 v0 = acc[ai][bj][m][0] * P1_DS + b0[bj], v1 = acc[ai][bj][m][1] * P1_DS + b1[bj];
                    const f32x4 o0 = v0 * cs - v1 * sn, o1 = v1 * cs + v0 * sn;
                    u32x2 w0, w1; w0.x = cvt_pk_bf16(o0[0], o0[1]); w0.y = cvt_pk_bf16(o0[2], o0[3]); w1.x = cvt_pk_bf16(o1[0], o1[1]); w1.y = cvt_pk_bf16(o1[2], o1[3]);
                    const int cc = cc0 + bj * HALF; bf16_t* dp = rowp + (size_t)(cc >> 6) * 4096 * 64 + (cc & 63);
                    *(u32x2*)dp = w0; *(u32x2*)(dp + 16) = w1; } }
    }
};
struct SchedMerge {
    int G, c; const unsigned char* ws;
    __device__ __forceinline__ bool next(int i, Unit& u) const { const int L = (i >> 1) * G + c; if (L >= 512) return false; u.kind = i & 1; u.row0 = 0; u.nrows = 256; u.e = 0; tilemap(L, 128, 4, u.pm, u.pn); return true; }
    __device__ __forceinline__ void aoffs(const Unit& u, const int (&R)[2], const int (&C)[2], unsigned (&o)[2][2]) const {
        const size_t base = u.kind ? WS_YB : WS_U;
#pragma unroll
        for (int h = 0; h < 2; ++h)
#pragma unroll
            for (int i = 0; i < 2; ++i) o[h][i] = (unsigned)(base + (size_t)(256 * u.pm + 128 * h + R[i]) * 1024 + C[i] * 2); }
    __device__ __forceinline__ const char* bptr(const Unit& u) const { return (const char*)ws + (u.kind ? WS_WPB : WS_WPA) + (size_t)u.pn * 256 * 1024; }
};
constexpr float MERGE_DS = 1.0f / (YB_F8_SCALE * WP_F8_SCALE);
struct EpiMerge {
    static constexpr int PERM = 1;
    unsigned char* ws;
    __device__ __forceinline__ bool carry(const Unit& u) const { return u.kind == 0; }
    __device__ __forceinline__ void run(f32x4 (&acc)[2][2][4][2], const Unit& u, int wr, int wc, int fr, int fq) const {
        const bf16_t* Gt = (const bf16_t*)(ws + WS_G); bf16_t* INNER = (bf16_t*)(ws + WS_INNER);
        const int lc = 256 * u.pn + wc * 32 + 8 * fq;
#pragma unroll
        for (int ai = 0; ai < 2; ++ai) {
            u32x4 gbw[4][2], gaw[4][2];
#pragma unroll
            for (int m = 0; m < 4; ++m) { const size_t tok = (size_t)(256 * u.pm + ai * HALF + wr * 64 + m * 16 + fr);
#pragma unroll
                for (int bj = 0; bj < 2; ++bj) { gbw[m][bj] = *(const u32x4*)(Gt + tok * 2048 + 1024 + lc + bj * HALF);
                    if (u.kind == 0) gaw[m][bj] = *(const u32x4*)(Gt + tok * 2048 + lc + bj * HALF); } }
#pragma unroll
            for (int m = 0; m < 4; ++m) { const size_t tok = (size_t)(256 * u.pm + ai * HALF + wr * 64 + m * 16 + fr);
#pragma unroll
                for (int bj = 0; bj < 2; ++bj) { const u32x4 gw = gbw[m][bj];
                    const f32x4 gb0 = (f32x4){bflo(gw.x), bfhi(gw.x), bflo(gw.y), bfhi(gw.y)}, gb1 = (f32x4){bflo(gw.z), bfhi(gw.z), bflo(gw.w), bfhi(gw.w)};
                    if (u.kind == 0) { const u32x4 ga = gaw[m][bj];
                        const f32x4 ga0 = (f32x4){bflo(ga.x), bfhi(ga.x), bflo(ga.y), bfhi(ga.y)}, ga1 = (f32x4){bflo(ga.z), bfhi(ga.z), bflo(ga.w), bfhi(ga.w)};
#pragma unroll
                        for (int i = 0; i < 4; ++i) { acc[ai][bj][m][0][i] *= (YB_F8_SCALE / YA_F8_SCALE) * ga0[i] * __builtin_amdgcn_rcpf(fmaxf(gb0[i], 1e-30f)); acc[ai][bj][m][1][i] *= (YB_F8_SCALE / YA_F8_SCALE) * ga1[i] * __builtin_amdgcn_rcpf(fmaxf(gb1[i], 1e-30f)); }
                    } else { *(u32x4*)(INNER + tok * 1024 + lc + bj * HALF) = pack8v(acc[ai][bj][m][0] * (gb0 * MERGE_DS), acc[ai][bj][m][1] * (gb1 * MERGE_DS)); } } }
        }
    }
};
struct SchedMix {
    int G, c; const unsigned char* ws;
    __device__ __forceinline__ bool next(int i, Unit& u) const { const int L = i * G + c; if (L >= 512) return false; u.kind = 0; u.row0 = 0; u.nrows = 256; u.e = 0; tilemap(L, 128, 4, u.pm, u.pn); return true; }
    __device__ __forceinline__ void aoffs(const Unit& u, const int (&R)[2], const int (&C)[2], unsigned (&o)[2][2]) const {
#pragma unroll
        for (int h = 0; h < 2; ++h)
#pragma unroll
            for (int i = 0; i < 2; ++i) o[h][i] = (unsigned)(WS_INNER + ((size_t)(256 * u.pm + 128 * h + R[i]) * 1024 + C[i]) * 2); }
    __device__ __forceinline__ const char* bptr(const Unit& u) const { return (const char*)ws + WS_WOUT + (size_t)u.pn * 256 * 2048; }
};
struct EpiMix {
    static constexpr int PERM = 0;
    unsigned char* ws; const float *x, *lng, *lnb, *b_out; float* out;
    __device__ __forceinline__ bool carry(const Unit&) const { return false; }
    __device__ __forceinline__ void run(f32x4 (&acc)[2][2][4][2], const Unit& u, int wr, int wc, int fr, int fq) const {
        const float* rowstat = (const float*)(ws + WS_ROWSTAT); const float* mod = (const float*)(ws + WS_MOD) + ((256 * u.pm) >> 12) * 6144 + 2048;
        f32x2 st[2][4];
#pragma unroll
        for (int ai = 0; ai < 2; ++ai)
#pragma unroll
            for (int m = 0; m < 4; ++m) st[ai][m] = *(const f32x2*)(rowstat + 2 * (256 * u.pm + ai * HALF + wr * 64 + m * 16 + fr));
#pragma unroll
        for (int bj = 0; bj < 2; ++bj)
#pragma unroll
            for (int n = 0; n < 2; ++n) { const int col = 256 * u.pn + bj * HALF + wc * 32 + n * 16 + 4 * fq;
                const f32x4 lg = *(const f32x4*)(lng + col), lb = *(const f32x4*)(lnb + col), bo = *(const f32x4*)(b_out + col), g1 = *(const f32x4*)(mod + col);
                f32x4 xb[2][4];
#pragma unroll
                for (int ai = 0; ai < 2; ++ai)
#pragma unroll
                    for (int m = 0; m < 4; ++m) xb[ai][m] = *(const f32x4*)(x + (size_t)(256 * u.pm + ai * HALF + wr * 64 + m * 16 + fr) * 1024 + col);
#pragma unroll
                for (int ai = 0; ai < 2; ++ai)
#pragma unroll
                    for (int m = 0; m < 4; ++m) { const size_t off = (size_t)(256 * u.pm + ai * HALF + wr * 64 + m * 16 + fr) * 1024 + col;
                        const f32x4 xv = xb[ai][m];
                        const f32x4 x0 = (xv - st[ai][m].x) * st[ai][m].y * lg + lb;
                        const f32x4 r = x0 * ALPHA + g1 * (acc[ai][bj][m][n] + bo); u32x2 w; w.x = cvt_pk_bf16(r[0], r[1]); w.y = cvt_pk_bf16(r[2], r[3]);
                        *(u32x2*)((bf16_t*)(ws + WS_X1PRE) + off) = w; }
                asm volatile("" ::: "memory"); }
    }
};
__device__ __forceinline__ int ld_u(const int* p) { return __builtin_amdgcn_readfirstlane(__hip_atomic_load(p, __ATOMIC_RELAXED, __HIP_MEMORY_SCOPE_AGENT)); }
template <int NPN  > struct SchedMoe {
    int G, c; const unsigned char* ws; const int* tabs;
    __device__ __forceinline__ bool next(int i, Unit& u) const {
        const int* cn = tabs; const int* eb = tabs + 32; const int* tb = tabs + 65;
        const int ntiles = tb[32], tpx = (ntiles + 7) >> 3, x = c & 7, s = c >> 3;
        const int tiles_x = min(tpx, ntiles - x * tpx), ll = i * (G >> 3) + s;
        if (ll >= NPN * tiles_x) return false;
        const int T = x * tpx + ll / NPN; u.pn = ll % NPN; u.kind = 0;
        int e = 0;
#pragma unroll 1
        for (int k = 16; k >= 1; k >>= 1) if (tb[e + k] <= T) e += k;
        const int jt = T - tb[e];
        u.e = __builtin_amdgcn_readfirstlane(e); u.pm = __builtin_amdgcn_readfirstlane(jt);
        u.row0 = __builtin_amdgcn_readfirstlane(eb[e] + 256 * jt); u.nrows = __builtin_amdgcn_readfirstlane(min(256, cn[e] - 256 * jt)); return true; }
    __device__ __forceinline__ void aoffs(const Unit& u, const int (&R)[2], const int (&C)[2], unsigned (&o)[2][2]) const {
        const int* PERM2 = (const int*)(ws + WS_PERM2) + (size_t)u.e * NTOK + 256 * u.pm;
#pragma unroll
        for (int h = 0; h < 2; ++h)
#pragma unroll
            for (int i = 0; i < 2; ++i) { const int lr = min(128 * h + R[i], u.nrows - 1);
                if (NPN == 8) { const int tok = PERM2[lr]; o[h][i] = (unsigned)(WS_U + (size_t)tok * 1024 + C[i] * 2); }
                else o[h][i] = (unsigned)(WS_ACT + (size_t)(u.row0 + lr) * 1024 + C[i] * 2); } }
    __device__ __forceinline__ const char* bptr(const Unit& u) const {
        if (NPN == 8) return (const char*)ws + WS_W1 + ((size_t)u.e * 2048 + 256 * u.pn) * 1024;
        return (const char*)ws + WS_W2 + ((size_t)u.e * 1024 + 256 * u.pn) * 1024; }
};
struct EpiMoe1 {
    static constexpr int PERM = 1;
    unsigned char* ws; const float* b1;
    __device__ __forceinline__ bool carry(const Unit&) const { return false; }
    __device__ __forceinline__ void run(f32x4 (&acc)[2][2][4][2], const Unit& u, int wr, int wc, int fr, int fq) const {
        unsigned char* ACT = ws + WS_ACT;
        const int col = 128 * u.pn + wc * 32 + 8 * fq;
        f32x4 bg[2], bl[2];
#pragma unroll
        for (int n = 0; n < 2; ++n) { bg[n] = *(const f32x4*)(b1 + u.e * 2048 + col + 4 * n); bl[n] = *(const f32x4*)(b1 + u.e * 2048 + 1024 + col + 4 * n); }
        u32x2 outw[2][4];
#pragma unroll
        for (int ai = 0; ai < 2; ++ai)
#pragma unroll
            for (int m = 0; m < 4; ++m) {
                f32x4 a[2];
#pragma unroll
                for (int n = 0; n < 2; ++n) { const f32x4 zgv = acc[ai][0][m][n] * (1.0f / W_F8_SCALE) + bg[n], zlv = acc[ai][1][m][n] * (1.0f / W_F8_SCALE) + bl[n];
                    f32x4 zg, zl;
#pragma unroll
                    for (int i = 0; i < 4; ++i) { zg[i] = __builtin_amdgcn_fmed3f(zgv[i], -INFINITY, 7.0f); zl[i] = __builtin_amdgcn_fmed3f(zlv[i], -7.0f, 7.0f); }
                    const f32x4 ea = zg * (-1.702f * 1.4426950408889634f); f32x4 d;
#pragma unroll
                    for (int i = 0; i < 4; ++i) d[i] = __builtin_amdgcn_exp2f(ea[i]);
                    d = d + 1.0f; f32x4 r;
#pragma unroll
                    for (int i = 0; i < 4; ++i) r[i] = __builtin_amdgcn_rcpf(d[i]);
                    a[n] = (zg * r) * (zl * ACT_F8_SCALE + ACT_F8_SCALE); }
                outw[ai][m] = pack8_f8(a[0], a[1]); }
#pragma unroll
        for (int ai = 0; ai < 2; ++ai)
#pragma unroll
            for (int m = 0; m < 4; ++m) { const int lr = ai * HALF + wr * 64 + m * 16 + fr;
                const size_t srow = lr < u.nrows ? (size_t)(u.row0 + lr) : (size_t)(NASSIGN + lr);
                *(u32x2*)(ACT + srow * 1024 + col) = outw[ai][m]; }
    }
};
struct EpiMoe2 {
    static constexpr int PERM = 2;
    unsigned char* ws; const float* b2;
    __device__ __forceinline__ bool carry(const Unit&) const { return false; }
    __device__ __forceinline__ void run(f32x4 (&acc)[2][2][4][2], const Unit& u, int wr, int wc, int fr, int fq) const {
        unsigned char* YS = ws + WS_YS; constexpr float DS = 1.0f / (W_F8_SCALE * ACT_F8_SCALE);
        const int lc = 256 * u.pn + wc * 64 + 16 * fq;
        f32x4 bv[2][2];
#pragma unroll
        for (int bj = 0; bj < 2; ++bj)
#pragma unroll
            for (int n = 0; n < 2; ++n) bv[bj][n] = *(const f32x4*)(b2 + u.e * 1024 + lc + 8 * bj + 4 * n);
        u32x4 outw[2][4];
#pragma unroll
        for (int ai = 0; ai < 2; ++ai)
#pragma unroll
            for (int m = 0; m < 4; ++m) {
                { const u32x2 lo = pack8_f8((acc[ai][0][m][0] * DS + bv[0][0]) * YS_F8_SCALE, (acc[ai][0][m][1] * DS + bv[0][1]) * YS_F8_SCALE), hi = pack8_f8((acc[ai][1][m][0] * DS + bv[1][0]) * YS_F8_SCALE, (acc[ai][1][m][1] * DS + bv[1][1]) * YS_F8_SCALE);
                    u32x4 w; w.x = lo.x; w.y = lo.y; w.z = hi.x; w.w = hi.y; outw[ai][m] = w; } }
#pragma unroll
        for (int ai = 0; ai < 2; ++ai)
#pragma unroll
            for (int m = 0; m < 4; ++m) { const int lr = ai * HALF + wr * 64 + m * 16 + fr;
                const size_t srow = lr < u.nrows ? (size_t)(u.row0 + lr) : (size_t)(NASSIGN + lr);
                *(u32x4*)(YS + srow * 1024 + lc) = outw[ai][m]; }
    }
};
}
__device__ __forceinline__ void phase_merge_fast(const P& p, int bid, int nblk, unsigned char* lds) {
    pg::SchedMerge S{nblk, bid, p.ws}; pg::EpiMerge E{p.ws};
    pg::gemm_phase<pg::EpiMerge, pg::SchedMerge, true, true>((PG_LAS unsigned char*)lds, p.ws, S, E);
}
__device__ __forceinline__ void phase_mix_fast(const P& p, int bid, int nblk, unsigned char* lds) {
    pg::SchedMix S{nblk, bid, p.ws}; pg::EpiMix E{p.ws, p.x, p.ln_x_g, p.ln_x_b, p.b_out, p.out};
    pg::gemm_phase<pg::EpiMix, pg::SchedMix, true>((PG_LAS unsigned char*)lds, p.ws, S, E);
}
__device__ __forceinline__ void phase_moe1_fast(const P& p, int bid, int nblk, unsigned char* lds) {
    moe_tables(p, lds); pg::SchedMoe<8> S{nblk, bid, p.ws, (const int*)(lds + MT_LDS)}; pg::EpiMoe1 E{p.ws, p.exp_b1};
    pg::gemm_phase<pg::EpiMoe1, pg::SchedMoe<8>, true, true>((PG_LAS unsigned char*)lds, p.ws, S, E);
}
__device__ __forceinline__ void phase_moe2_fast(const P& p, int bid, int nblk, unsigned char* lds) {
    moe_tables(p, lds); pg::SchedMoe<4> S{nblk, bid, p.ws, (const int*)(lds + MT_LDS)}; pg::EpiMoe2 E{p.ws, p.exp_b2};
    pg::gemm_phase<pg::EpiMoe2, pg::SchedMoe<4>, true, true>((PG_LAS unsigned char*)lds, p.ws, S, E);
}
__device__ __forceinline__ void phase_proj_fast(const P& p, int bid, int nblk, unsigned char* lds) {
    { pg::SchedP1 S{nblk, bid, p.ws}; pg::EpiP1 E{p.ws, p.b_in};
      pg::gemm_phase<pg::EpiP1, pg::SchedP1, true, true>((PG_LAS unsigned char*)lds, p.ws, S, E); }
    { pg::SchedK S{nblk, bid, p.ws}; pg::EpiRope E{p.ws, p.b_in};
      pg::gemm_phase<pg::EpiRope, pg::SchedK, true, true>((PG_LAS unsigned char*)lds, p.ws, S, E); }
}

#define LAS __attribute__((address_space(3)))
#define XB_TMO      128
#define XB_XCNT(j)  (256  + 64 * (j))
#define XB_XSUB(j)  (1280 + 64 * (j))
#define XB_XGEN(j)  (2304 + 64 * (j))
#define XB_TOP      3328
#define XB_TOPGEN   3392
#define XCD_BAR_WORDS 3456
#define XB_SPIN_CAP (1u << 22)
__device__ __forceinline__ unsigned xb_ld(unsigned* p)              { return __hip_atomic_load(p, __ATOMIC_RELAXED, __HIP_MEMORY_SCOPE_AGENT); }
__device__ __forceinline__ unsigned xb_add(unsigned* p, unsigned v) { return __hip_atomic_fetch_add(p, v, __ATOMIC_RELAXED, __HIP_MEMORY_SCOPE_AGENT); }
__device__ __forceinline__ unsigned xb_xcc_id() { return (unsigned)__builtin_amdgcn_s_getreg((3 << 11) | 20) & 0xFu; }
#define XB_SPIN(cond, bar) do { unsigned _sp = 0; while (cond) { __builtin_amdgcn_s_sleep(1); \
    if ((++_sp & 255u) == 0u) { if (xb_ld(&(bar)[XB_TMO])) break; if (_sp > XB_SPIN_CAP) { atomicAdd(&(bar)[XB_TMO], 1u); break; } } } } while (0)
struct XcdBarrier { unsigned* bar; unsigned x; volatile LAS unsigned* st; };
__device__ __forceinline__ XcdBarrier xcd_barrier_post(unsigned* bar, volatile LAS unsigned* st) {
    XcdBarrier b; b.bar = bar; b.x = xb_xcc_id(); b.st = st;
    if (threadIdx.x == 0) (void)xb_add(&bar[XB_XCNT(b.x)], 1u);
    return b;
}
__device__ __forceinline__ void xcd_barrier_complete(unsigned* bar, unsigned x, unsigned& nloc, unsigned& nx) {
    const unsigned G = gridDim.x * gridDim.y * gridDim.z;
    unsigned sum, cnt, mine, sp = 0u;
    for (;;) {
        sum = 0u; cnt = 0u; mine = 0u;
#pragma unroll
        for (unsigned j = 0; j < 16; ++j) { const unsigned c = xb_ld(&bar[XB_XCNT(j)]); sum += c; cnt += (c > 0u) ? 1u : 0u; mine = (j == x) ? c : mine; }
        if (sum == G) break;
        __builtin_amdgcn_s_sleep(1);
        if ((++sp & 255u) == 0u) { if (xb_ld(&bar[XB_TMO])) break; if (sp > XB_SPIN_CAP) { atomicAdd(&bar[XB_TMO], 1u); break; } }
    }
    nloc = mine > 0u ? mine : 1u; nx = cnt > 0u ? cnt : 1u;
}
__device__ __forceinline__ void xcd_barrier(const XcdBarrier& b) {
    asm volatile("s_waitcnt vmcnt(0)" ::: "memory");
    __syncthreads();
    if (threadIdx.x == 0) {
        unsigned* bar = b.bar;
        __builtin_amdgcn_s_waitcnt(0);
        unsigned nloc = b.st[0], nx = b.st[1];
        if (nloc == 0u) { xcd_barrier_complete(bar, b.x, nloc, nx); b.st[0] = nloc; b.st[1] = nx; }
        const unsigned old = xb_add(&bar[XB_XSUB(b.x)], 1u);
        const unsigned gen = old / nloc;
        if (old + 1u == (gen + 1u) * nloc) {
            __builtin_amdgcn_fence(__ATOMIC_RELEASE, "agent");
            asm volatile("s_waitcnt vmcnt(0)" ::: "memory");
            const unsigned og = xb_add(&bar[XB_TOP], 1u);
            const unsigned tg = og / nx;
            if (og + 1u == (tg + 1u) * nx) xb_add(&bar[XB_TOPGEN], 1u);
            else XB_SPIN(xb_ld(&bar[XB_TOPGEN]) == tg, bar);
            __builtin_amdgcn_fence(__ATOMIC_ACQUIRE, "agent");
            xb_add(&bar[XB_XGEN(b.x)], 1u);
            asm volatile("s_waitcnt vmcnt(0)" ::: "memory");
        } else {
            XB_SPIN(xb_ld(&bar[XB_XGEN(b.x)]) == gen, bar);
            __builtin_amdgcn_fence(__ATOMIC_ACQUIRE, "agent");
            asm volatile("s_waitcnt vmcnt(0)" ::: "memory");
        }
    }
    __syncthreads();
}
#include <hip/hip_cooperative_groups.h>
namespace cg = cooperative_groups;
constexpr int LDS_BYTES = 147456;
constexpr int XB_LDS = LDS_BYTES - 64;
constexpr int CW_BAR = 4096;
constexpr int REP_PA = 1, REP_PB = 1, REP_P1 = 1, REP_GMLP = 1, REP_ATTN = 1, REP_MERGE = 1, REP_MIX = 1, REP_MOE1 = 1, REP_MOE2 = 1, REP_BAR = 0;
__global__ void __launch_bounds__(512, 2) mega(P p) {
    extern __shared__ __attribute__((aligned(16))) unsigned char lds[];
    const int bid = blockIdx.x, nblk = gridDim.x;
    if (threadIdx.x < 16) ((volatile LAS unsigned*)((LAS unsigned char*)lds + XB_LDS))[threadIdx.x] = 0u;
    __syncthreads();
    const XcdBarrier bar = xcd_barrier_post((unsigned*)(p.ws + WS_CTL) + CW_BAR, (volatile LAS unsigned*)((LAS unsigned char*)lds + XB_LDS));
#define GRID_BAR() xcd_barrier(bar)
#define REP(n) _Pragma("unroll 1") for (int rep_ = 0; rep_ < (n); ++rep_)
    REP(REP_PA) { __syncthreads(); phase_prologue_a(p, bid, nblk, lds); } GRID_BAR();
    REP(REP_PB) phase_prologue_b(p, bid, nblk); GRID_BAR();
    REP(REP_P1) phase_proj_fast(p, bid, nblk, lds); GRID_BAR();
    REP(REP_GMLP) phase_gmlp_fast(p, bid, nblk, lds); REP(REP_ATTN) phase_attn_s(p, bid, nblk, lds); GRID_BAR();
    REP(REP_MERGE) phase_merge_fast(p, bid, nblk, lds); GRID_BAR();
    REP(REP_MIX) phase_mix_fast(p, bid, nblk, lds); GRID_BAR();
    phase_router(p, bid, nblk, lds); GRID_BAR();
    REP(REP_BAR) GRID_BAR();
    REP(REP_MOE1) phase_moe1_fast(p, bid, nblk, lds); GRID_BAR();
    REP(REP_MOE2) phase_moe2_fast(p, bid, nblk, lds); GRID_BAR();
#undef REP
    phase_final(p, bid, nblk, lds);
}

extern "C" void kernel_launch(void* const* d_in, const int* in_sizes, int n_in, void* d_out, int out_size, void* d_ws, size_t ws_size, hipStream_t stream) {
    static int grid = 0;
    if (grid == 0) {
        if (n_in != 31 || out_size != NTOK * DM || ws_size < WS_END) { fprintf(stderr, "kernel_launch: unexpected sizes n_in %d out %d ws %zu\n", n_in, out_size, ws_size); grid = -1; return; }
        int dev = 0, cus = 0, per_cu = 0;
        if (hipGetDevice(&dev) != hipSuccess || hipDeviceGetAttribute(&cus, hipDeviceAttributeMultiprocessorCount, dev) != hipSuccess) { grid = -1; return; }
        if (hipFuncSetAttribute((const void*)mega, hipFuncAttributeMaxDynamicSharedMemorySize, LDS_BYTES) != hipSuccess) { fprintf(stderr, "kernel_launch: hipFuncSetAttribute failed\n"); grid = -1; return; }
        if (hipOccupancyMaxActiveBlocksPerMultiprocessor(&per_cu, (const void*)mega, 512, LDS_BYTES) != hipSuccess || per_cu < 1) { fprintf(stderr, "kernel_launch: occupancy query failed (%d)\n", per_cu); grid = -1; return; }
        grid = cus * 1;
    }
    if (grid < 0) return;
    P p{};
    const float** pp = (const float**)&p;
    for (int i = 0; i < 31; ++i) pp[i] = (const float*)d_in[i];
    p.out = (float*)d_out; p.ws = (unsigned char*)d_ws; p.ph_lo = 0; p.ph_hi = 0;
    if (hipMemsetAsync((char*)d_ws + WS_CTL, 0, 1 * MiB, stream) != hipSuccess) { fprintf(stderr, "kernel_launch: memset failed\n"); return; }
    hipLaunchKernelGGL(mega, dim3(grid), dim3(512), LDS_BYTES, stream, p);
    const hipError_t e = hipPeekAtLastError();
    if (e != hipSuccess) fprintf(stderr, "launch failed: %s (grid %d)\n", hipGetErrorString(e), grid);
}
```

```cpp
#include <hip/hip_runtime.h>
#include <cstdio>
#include <cstdint>

typedef unsigned short bf16_t;
typedef short bf16x8 __attribute__((ext_vector_type(8)));
typedef float f32x4 __attribute__((ext_vector_type(4)));
typedef unsigned u32x4 __attribute__((ext_vector_type(4)));
typedef unsigned u32x2 __attribute__((ext_vector_type(2)));

constexpr int DM = 1024, NB = 8, SEQ = 4096, NTOK = NB * SEQ, CTXL = 256, NCTX = NB * CTXL, INW = 7168;
constexpr int NE = 32, TOPK = 4, FF = 1024, NASSIGN = NTOK * TOPK;
constexpr int NHEAD = 16, HD = 64, GW = 64;
constexpr float LN_EPS = 1e-5f;
constexpr float ALPHA = 1.189207115002721f;
constexpr int MAXTILES = NASSIGN / 256 + NE;

constexpr size_t MiB = 1u << 20;
constexpr size_t WS_CTL = 0;
constexpr size_t WS_MOD = 1 * MiB;
constexpr size_t WS_ROPE = 1 * MiB + 512 * 1024;
constexpr size_t WS_ROWSTAT = 2 * MiB;
constexpr size_t WS_ZSTAT = 2 * MiB + 512 * 1024;
constexpr size_t WS_TOPE = 3 * MiB;
constexpr size_t WS_TOPG = 4 * MiB;
constexpr size_t WS_SLOT = 5 * MiB;
constexpr size_t WS_PERM = 6 * MiB;
constexpr size_t WS_TILES = 7 * MiB;
constexpr size_t WS_WIN = 8 * MiB;
constexpr size_t WS_WPA = 22 * MiB, WS_WPB = 24 * MiB, WS_WOUT = 26 * MiB, WS_WSB = 28 * MiB;
constexpr size_t WS_KC = 30 * MiB;
constexpr size_t WS_VCT = 34 * MiB;
constexpr size_t WS_UC = 38 * MiB;
constexpr size_t WS_PERM2 = 42 * MiB;
constexpr size_t WS_W1 = 48 * MiB;
constexpr size_t WS_W2 = 176 * MiB;
constexpr size_t WS_U = 240 * MiB;
constexpr size_t WS_ZU = 304 * MiB;
constexpr size_t WS_ZVT = 368 * MiB;
constexpr size_t WS_Q = 432 * MiB;
constexpr size_t WS_K = 496 * MiB;
constexpr size_t WS_VT = 560 * MiB;
constexpr size_t WS_G = 624 * MiB;
constexpr size_t WS_YB = 752 * MiB;
constexpr size_t WS_INNER = 816 * MiB;
constexpr size_t WS_ACT = WS_ZU;
constexpr size_t WS_YS = WS_G;
constexpr size_t WS_X1PRE = WS_YB;
constexpr size_t WS_X1 = WS_VT;
constexpr size_t WS_END = 880 * MiB;

struct P {
    const float *x, *c, *ctx, *c_ctx, *ln_x_g, *ln_x_b, *ln_ctx_g, *ln_ctx_b, *w_ada, *b_ada, *w_in, *b_in, *gmlp_ln_g, *gmlp_ln_b, *gmlp_ws, *gmlp_bs,
        *na_rpb, *w_pa, *w_pb, *w_out, *b_out, *ln1_g, *ln1_b, *ln2_g, *ln2_b, *router_w, *router_b, *exp_w1, *exp_b1, *exp_w2, *exp_b2;
    float* out; unsigned char* ws; int ph_lo, ph_hi;
};

__device__ __forceinline__ int tid_opaque() { int t = threadIdx.x; asm volatile("" : "+v"(t)); return t; }
typedef float f32x2_ __attribute__((ext_vector_type(2))); typedef __bf16 bf16x2_ __attribute__((ext_vector_type(2)));
__device__ __forceinline__ unsigned pk2(float lo, float hi) { const f32x2_ v = {lo, hi}; return __builtin_bit_cast(unsigned, __builtin_convertvector(v, bf16x2_)); }
__device__ __forceinline__ unsigned f2bf(float f) { return pk2(f, 0.f) & 0xffffu; }
__device__ __forceinline__ float bf2f(unsigned h) { return __builtin_bit_cast(float, (h & 0xffffu) << 16); }
__device__ __forceinline__ float bflo(unsigned w) { return __builtin_bit_cast(float, w << 16); }
__device__ __forceinline__ float bfhi(unsigned w) { return __builtin_bit_cast(float, w & 0xffff0000u); }
__device__ __forceinline__ u32x2 pack8_f8(f32x4 a, f32x4 b) {
    int w0 = 0, w1 = 0;
    w0 = __builtin_amdgcn_cvt_pk_fp8_f32(a[0], a[1], w0, false); w0 = __builtin_amdgcn_cvt_pk_fp8_f32(a[2], a[3], w0, true);
    w1 = __builtin_amdgcn_cvt_pk_fp8_f32(b[0], b[1], w1, false); w1 = __builtin_amdgcn_cvt_pk_fp8_f32(b[2], b[3], w1, true);
    u32x2 r; r.x = (unsigned)w0; r.y = (unsigned)w1; return r;
}
typedef float f32x2u __attribute__((ext_vector_type(2)));
__device__ __forceinline__ f32x4 unpack4_f8(unsigned w) { const f32x2u lo = __builtin_amdgcn_cvt_pk_f32_fp8((int)w, false), hi = __builtin_amdgcn_cvt_pk_f32_fp8((int)w, true); return (f32x4){lo.x, lo.y, hi.x, hi.y}; }
constexpr float YS_F8_SCALE = 16.0f;
constexpr float INNER_F8_SCALE = 16.0f, WOUT_F8_SCALE = 256.0f;
constexpr float YA_F8_SCALE = 4.0f, YB_F8_SCALE = 16.0f, WP_F8_SCALE = 256.0f;
constexpr float U_F8_SCALE = 16.0f, WIN_F8_SCALE = 256.0f;
template <int CTRL> __device__ __forceinline__ float dpp_f(float v) { return __builtin_bit_cast(float, __builtin_amdgcn_update_dpp(0, __builtin_bit_cast(int, v), CTRL, 0xF, 0xF, true)); }
template <int CTRL> __device__ __forceinline__ int dpp_i(int v) { return __builtin_amdgcn_update_dpp(0, v, CTRL, 0xF, 0xF, true); }
constexpr int DPP_XOR1 = 0xB1, DPP_XOR2 = 0x4E, DPP_QREV = 0x1B, DPP_HMIRROR = 0x141, DPP_MIRROR = 0x140, DPP_ROR8 = 0x128;
__device__ __forceinline__ void swap16(float v, float& x, float& y) { x = v; y = v; asm volatile("s_nop 1\n\tv_permlane16_swap_b32 %0, %1" : "+v"(x), "+v"(y)); }
__device__ __forceinline__ void swap32(float v, float& x, float& y) { x = v; y = v; asm volatile("s_nop 1\n\tv_permlane32_swap_b32 %0, %1" : "+v"(x), "+v"(y)); }
__device__ __forceinline__ float rows_sum(float v) { float x, y; swap16(v, x, y); v = x + y; swap32(v, x, y); return x + y; }
__device__ __forceinline__ float rows_max(float v) { float x, y; swap16(v, x, y); v = fmaxf(x, y); swap32(v, x, y); return fmaxf(x, y); }
__device__ __forceinline__ float wave_sum(float v) {
    v += dpp_f<DPP_XOR1>(v); v += dpp_f<DPP_XOR2>(v); v += dpp_f<DPP_HMIRROR>(v); v += dpp_f<DPP_MIRROR>(v);
    return rows_sum(v);
}
__device__ __forceinline__ float wave_max(float v) {
    v = fmaxf(v, dpp_f<DPP_XOR1>(v)); v = fmaxf(v, dpp_f<DPP_XOR2>(v)); v = fmaxf(v, dpp_f<DPP_HMIRROR>(v)); v = fmaxf(v, dpp_f<DPP_MIRROR>(v));
    return rows_max(v);
}
__device__ __forceinline__ int wave_min_i(int v) {
    v = min(v, dpp_i<DPP_XOR1>(v)); v = min(v, dpp_i<DPP_XOR2>(v)); v = min(v, dpp_i<DPP_HMIRROR>(v)); v = min(v, dpp_i<DPP_MIRROR>(v));
    float x, y; swap16(__builtin_bit_cast(float, v), x, y); v = min(__builtin_bit_cast(int, x), __builtin_bit_cast(int, y));
    swap32(__builtin_bit_cast(float, v), x, y); return min(__builtin_bit_cast(int, x), __builtin_bit_cast(int, y));
}
template <int ST> __device__ __forceinline__ float xor_row(float v) {
    if constexpr (ST == 0) return dpp_f<DPP_XOR1>(v);
    else if constexpr (ST == 1) return dpp_f<DPP_XOR2>(v);
    else if constexpr (ST == 2) return dpp_f<DPP_QREV>(dpp_f<DPP_HMIRROR>(v));
    else return dpp_f<DPP_ROR8>(v);
}
__device__ __forceinline__ float gelu_exact(float v) { return 0.5f * v * (1.0f + erff(v * 0.70710678118654752f)); }
__device__ __forceinline__ float sigmoidf_(float v) { return 1.0f / (1.0f + __expf(-v)); }

__device__ __forceinline__ void mod_item(const P& p, int item, float* ldsf) {
    const int tid = tid_opaque(), wave = tid >> 6, lane = tid & 63;
    float* sl = ldsf; float* red = ldsf + 9 * 1024;
    for (int i = tid; i < 9 * 1024; i += 512) { const int r = i >> 10, k = i & 1023; const float cv = (r < 8) ? p.c[r * 1024 + k] : p.c_ctx[k]; sl[i] = cv / (1.0f + __expf(-cv)); }
    __syncthreads();
    const int col = item * 32 + (lane & 31), kpar = lane >> 5;
    float acc[9];
#pragma unroll
    for (int r = 0; r < 9; ++r) acc[r] = 0.f;
    const float* wp = p.w_ada + (size_t)(wave * 128 + kpar) * 6144 + col; const float* sp = sl + wave * 128 + kpar;
#pragma unroll 1
    for (int k8 = 0; k8 < 64; k8 += 8) {
        float w[8];
#pragma unroll
        for (int u = 0; u < 8; ++u) w[u] = wp[(size_t)(k8 + u) * 2 * 6144];
#pragma unroll
        for (int u = 0; u < 8; ++u)
#pragma unroll
            for (int r = 0; r < 9; ++r) acc[r] += sp[r * 1024 + (k8 + u) * 2] * w[u];
    }
#pragma unroll
    for (int r = 0; r < 9; ++r) red[((wave * 2 + kpar) * 9 + r) * 32 + (lane & 31)] = acc[r];
    __syncthreads();
    if (tid < 288) {
        const int r = tid >> 5, cc = tid & 31; float s = 0.f;
#pragma unroll
        for (int q = 0; q < 16; ++q) s += red[(q * 9 + r) * 32 + cc];
        ((float*)(p.ws + WS_MOD))[r * 6144 + item * 32 + cc] = s + p.b_ada[item * 32 + cc];
    }
    __syncthreads();
}
__device__ __forceinline__ void transpose_item(const float* W, int K, int N, bf16_t* WT, int k0, int n0, int drow0, int lane) {
    const int kg = lane >> 3, ng = lane & 7;
    f32x4 v[8];
#pragma unroll
    for (int i = 0; i < 8; ++i) v[i] = *(const f32x4*)(W + (size_t)(k0 + 8 * kg + i) * N + n0 + 4 * ng);
#pragma unroll
    for (int q = 0; q < 4; ++q) { u32x4 o; o.x = pk2(v[0][q], v[1][q]); o.y = pk2(v[2][q], v[3][q]); o.z = pk2(v[4][q], v[5][q]); o.w = pk2(v[6][q], v[7][q]);
        *(u32x4*)(WT + (size_t)(drow0 + 4 * ng + q) * K + k0 + 8 * kg) = o; }
}
__device__ __forceinline__ void f8t_load(const float* W, int N, int k0, int n0, int lane, f32x4 (&v)[8]) {
    const int kg = lane >> 3, ng = lane & 7;
#pragma unroll
    for (int i = 0; i < 8; ++i) v[i] = __builtin_nontemporal_load((const f32x4*)(W + (size_t)(k0 + 8 * kg + i) * N + n0 + 4 * ng));
}
__device__ __forceinline__ void f8t_finish(const f32x4 (&v)[8], int K, unsigned char* WT, int k0, int drow0, float scale, int lane) {
    const int kg = lane >> 3, ng = lane & 7;
#pragma unroll
    for (int q = 0; q < 4; ++q)
        __builtin_nontemporal_store(pack8_f8((f32x4){v[0][q], v[1][q], v[2][q], v[3][q]} * scale, (f32x4){v[4][q], v[5][q], v[6][q], v[7][q]} * scale), (u32x2*)(WT + (size_t)(drow0 + 4 * ng + q) * K + k0 + 8 * kg));
}
__device__ __forceinline__ void transpose_item_f8(const float* W, int K, int N, unsigned char* WT, int k0, int n0, int drow0, float scale, int lane) {
    f32x4 v[8]; f8t_load(W, N, k0, n0, lane, v); f8t_finish(v, K, WT, k0, drow0, scale, lane);
}
constexpr float W_F8_SCALE = 256.0f, ACT_F8_SCALE = 4.0f;
constexpr int IT_WIN = 16 * 224, IT_SQ = 16 * 32, IT_W1 = 32 * 16 * 64, IT_W2 = 32 * 16 * 32, IT_WS = 32;
constexpr int IT_EXP0 = IT_WIN + 3 * IT_SQ;
__device__ __forceinline__ void convert_item(const P& p, int it, int lane) {
    unsigned char* ws = p.ws;
    if (it < IT_WIN) { const int kb = it / 224, nb = it % 224; transpose_item_f8(p.w_in, 1024, INW, ws + WS_WIN, kb * 64, nb * 32, nb * 32, WIN_F8_SCALE, lane); return; } it -= IT_WIN;
    if (it < IT_SQ) { const int kb = it / 32, nb = it % 32; transpose_item_f8(p.w_pa, 1024, 1024, ws + WS_WPA, kb * 64, nb * 32, nb * 32, WP_F8_SCALE, lane); return; } it -= IT_SQ;
    if (it < IT_SQ) { const int kb = it / 32, nb = it % 32; transpose_item_f8(p.w_pb, 1024, 1024, ws + WS_WPB, kb * 64, nb * 32, nb * 32, WP_F8_SCALE, lane); return; } it -= IT_SQ;
    if (it < IT_SQ) { const int kb = it / 32, nb = it % 32; transpose_item_f8(p.w_out, 1024, 1024, ws + WS_WOUT, kb * 64, nb * 32, nb * 32, WOUT_F8_SCALE, lane); return; } it -= IT_SQ;
    { bf16_t* o = (bf16_t*)(ws + WS_WSB); const float* s = p.gmlp_ws + it * 4096;
      for (int i = lane; i < 4096; i += 64) o[it * 4096 + i] = (bf16_t)f2bf(s[i]); }
}
__device__ __forceinline__ void phase_prologue_a(const P& p, int bid, int nblk, unsigned char* lds) {
    const int tid = tid_opaque(), wave = tid >> 6, lane = tid & 63;
    for (int item = bid; item < 192; item += nblk) mod_item(p, item, (float*)lds);
    if (bid == nblk - 1) {
        for (int i = tid; i < 1024; i += 512) { const int pos = i >> 4, fi = i & 15;
            const float inv = __builtin_amdgcn_exp2f(-(float)fi * (13.287712379549449f / 16.0f));
            const float ang = (float)pos * inv; const float rev = ang * 0.15915494309189535f;
            float* t = (float*)(p.ws + WS_ROPE); t[2 * i] = __builtin_amdgcn_cosf(rev); t[2 * i + 1] = __builtin_amdgcn_sinf(rev); }
    }
    __syncthreads();
    const int gw = bid * 8 + wave, ngw = nblk * 8;
    for (int it = gw; it < IT_EXP0 + IT_WS; it += ngw) convert_item(p, it, lane);
}
struct PbSrc { const float *x, *g, *b, *sh, *sc; unsigned char* o; float* stat; };
struct PbData { f32x4 v[4], psh[4], psc[4]; };
__device__ __forceinline__ PbSrc pb_src(const P& p, int row) {
    const float* mod = (const float*)(p.ws + WS_MOD); PbSrc s;
    if (row < NTOK) { const int b = row >> 12; s.x = p.x + (size_t)row * DM; s.g = p.ln_x_g; s.b = p.ln_x_b; s.sh = mod + b * 6144; s.sc = mod + b * 6144 + 1024; s.o = p.ws + WS_U + (size_t)row * DM; s.stat = (float*)(p.ws + WS_ROWSTAT) + 2 * row; }
    else { const int r = row - NTOK; s.x = p.ctx + (size_t)r * DM; s.g = p.ln_ctx_g; s.b = p.ln_ctx_b; s.sh = mod + 8 * 6144; s.sc = mod + 8 * 6144 + 1024; s.o = p.ws + WS_UC + (size_t)r * DM; s.stat = nullptr; }
    return s;
}
__device__ __forceinline__ void pb_load(const PbSrc& s, PbData& d, int lane) {
#pragma unroll
    for (int j = 0; j < 4; ++j) d.v[j] = ((const f32x4*)s.x + lane)[64 * j];
#pragma unroll
    for (int j = 0; j < 4; ++j) { const int col = 4 * lane + 256 * j; d.psh[j] = *(const f32x4*)(s.sh + col); d.psc[j] = *(const f32x4*)(s.sc + col); }
}
__device__ __forceinline__ void pb_row(const PbSrc& src, PbData& d, const f32x4 (&pg)[4], const f32x4 (&pb)[4], int lane) {
    float s = 0.f;
#pragma unroll
    for (int j = 0; j < 4; ++j) s += (d.v[j].x + d.v[j].y) + (d.v[j].z + d.v[j].w);
    const float mean = wave_sum(s) * (1.f / DM); float s2 = 0.f;
#pragma unroll
    for (int j = 0; j < 4; ++j) { d.v[j] = d.v[j] - mean; s2 += (d.v[j].x * d.v[j].x + d.v[j].y * d.v[j].y) + (d.v[j].z * d.v[j].z + d.v[j].w * d.v[j].w); }
    const float rstd = 1.f / sqrtf(wave_sum(s2) * (1.f / DM) + LN_EPS);
    if (src.stat && lane == 0) { src.stat[0] = mean; src.stat[1] = rstd; }
    unsigned* o4 = (unsigned*)src.o + lane;
#pragma unroll
    for (int j = 0; j < 4; ++j) {
        f32x4 y = (d.v[j] * rstd) * pg[j] + pb[j]; y = y * (1.0f + d.psc[j]) + d.psh[j];
        y = __builtin_elementwise_min(__builtin_elementwise_max(y * U_F8_SCALE, (f32x4){-448.f, -448.f, -448.f, -448.f}), (f32x4){448.f, 448.f, 448.f, 448.f});
        int w = 0; w = __builtin_amdgcn_cvt_pk_fp8_f32(y.x, y.y, w, false); w = __builtin_amdgcn_cvt_pk_fp8_f32(y.z, y.w, w, true); o4[64 * j] = (unsigned)w; }
}
__device__ __forceinline__ void phase_prologue_b(const P& p, int bid, int nblk) {
    const int tid = tid_opaque(), wave = tid >> 6, lane = tid & 63;
    const int ngw = nblk * 8;
    int row = bid * 8 + wave; if (row >= NTOK + NCTX) return;
    PbSrc sc = pb_src(p, row); PbData dc, dn; pb_load(sc, dc, lane);
    f32x4 pg[4], pb[4];
#pragma unroll
    for (int j = 0; j < 4; ++j) { pg[j] = *(const f32x4*)(sc.g + 4 * lane + 256 * j); pb[j] = *(const f32x4*)(sc.b + 4 * lane + 256 * j); }
#pragma unroll 1
    for (;;) {
        const int row_n = row + ngw; PbSrc sn = sc;
        if (row_n < NTOK + NCTX) { sn = pb_src(p, row_n); pb_load(sn, dn, lane); }
        pb_row(sc, dc, pg, pb, lane);
        if (row_n >= NTOK + NCTX) break;
        if (sn.g != sc.g) {
#pragma unroll
            for (int j = 0; j < 4; ++j) { pg[j] = *(const f32x4*)(sn.g + 4 * lane + 256 * j); pb[j] = *(const f32x4*)(sn.b + 4 * lane + 256 * j); } }
        row = row_n; sc = sn; dc = dn;
    }
}

__device__ __forceinline__ bf16x8 pack8(const float (&v)[8]) { u32x4 w; w.x = pk2(v[0], v[1]); w.y = pk2(v[2], v[3]); w.z = pk2(v[4], v[5]); w.w = pk2(v[6], v[7]); return __builtin_bit_cast(bf16x8, w); }
__device__ __forceinline__ void phase_gmlp_fast(const P& p, int bid, int nblk, unsigned char* lds) {
    const int tid = tid_opaque(), g = tid >> 6, lane = tid & 63, fr = lane & 15, fq = lane >> 4;
    float* part = (float*)lds;
    float* stat = part + 8 * 128 * 2;
    const bf16_t* ZVT = (const bf16_t*)(p.ws + WS_ZVT); const bf16_t* ZU = (const bf16_t*)(p.ws + WS_ZU); const bf16_t* WSB = (const bf16_t*)(p.ws + WS_WSB);
    unsigned char* YA = p.ws + WS_U;
    for (int chunk = bid; chunk < NTOK / 128; chunk += nblk) {
        const int tok0 = chunk * 128;
        __syncthreads();
        { float s1[8], s2[8];
#pragma unroll
          for (int jj = 0; jj < 8; ++jj) { s1[jj] = 0.f; s2[jj] = 0.f; }
          const bf16_t* zp = ZVT + (((size_t)(tok0 >> 3) + fr) * 1024 + 128 * g + fq) * 8;
#pragma unroll 8
          for (int it = 0; it < 32; ++it) { const bf16x8 v = *(const bf16x8*)(zp + (4 * it) * 8);
#pragma unroll
              for (int jj = 0; jj < 8; ++jj) { const float f = bf2f((unsigned)(unsigned short)v[jj]); s1[jj] += f; s2[jj] += f * f; } }
#pragma unroll
          for (int jj = 0; jj < 8; ++jj) { s1[jj] = rows_sum(s1[jj]); s2[jj] = rows_sum(s2[jj]); }
          if (fq == 0) {
#pragma unroll
              for (int jj = 0; jj < 8; ++jj) { part[(g * 128 + 8 * fr + jj) * 2] = s1[jj]; part[(g * 128 + 8 * fr + jj) * 2 + 1] = s2[jj]; } } }
        __syncthreads();
        if (tid < 128) { float a = 0.f, b = 0.f;
#pragma unroll
            for (int w = 0; w < 8; ++w) { a += part[(w * 128 + tid) * 2]; b += part[(w * 128 + tid) * 2 + 1]; }
            const float mean = a * (1.f / 1024.f), var = fmaxf(b * (1.f / 1024.f) - mean * mean, 0.f);
            stat[2 * tid] = mean; stat[2 * tid + 1] = 1.f / sqrtf(var + LN_EPS); }
        __syncthreads();
#pragma unroll 1
        for (int ph = 0; ph < 2; ++ph) {
            int tp = tid; asm volatile("" : "+v"(tp));
            const int g = __builtin_amdgcn_readfirstlane(tp >> 6), fr = tp & 15, fq = (tp >> 4) & 3;
            bf16x8 wf[4][4]; float t1[4], t2[4], bsv[4];
#pragma unroll
            for (int pt = 0; pt < 4; ++pt) { const int pp = 64 * ph + 16 * pt + fr; float t1a = 0.f, t2a = 0.f;
                const __attribute__((address_space(3))) float* stat3 = (const __attribute__((address_space(3))) float*)((const __attribute__((address_space(3))) unsigned char*)lds + 8 * 128 * 2 * 4);
                int so = 16 * fq; asm volatile("" : "+v"(so));
#pragma unroll
                for (int ks = 0; ks < 4; ++ks) { const bf16x8 w = *(const bf16x8*)(WSB + ((size_t)g * 128 + pp) * 128 + 32 * ks + 8 * fq);
                    float wv[8];
#pragma unroll
                    for (int jj = 0; jj < 8; ++jj) { const float w0 = bf2f((unsigned)(unsigned short)w[jj]); t2a += w0; wv[jj] = w0 * stat3[so + 2 * (32 * ks + jj) + 1]; }
                    const bf16x8 wp = pack8(wv); wf[pt][ks] = wp;
#pragma unroll
                    for (int jj = 0; jj < 8; ++jj) t1a += bf2f((unsigned)(unsigned short)wp[jj]) * stat3[so + 2 * (32 * ks + jj)]; }
                t1a = rows_sum(t1a); t2a = rows_sum(t2a);
                t1[pt] = t1a; t2[pt] = t2a; bsv[pt] = p.gmlp_bs[g * 128 + pp]; }
            constexpr int GM_D = 2;
            bf16x8 afn[GM_D][4]; u32x4 zu8[2][4]; f32x4 gcn[GM_D], bcn[GM_D]; unsigned yw[4][4];
#define GM_LOAD(ct_) do { constexpr int s_ = (ct_) % GM_D; const bf16_t* zp_ = ZVT + (((size_t)(tok0 >> 3) + fq) * 1024 + 128 * g + 64 * ((ct_) >> 2) + 16 * (fr >> 2) + 4 * ((ct_) & 3) + (fr & 3)) * 8; const int c_ = 128 * g + 64 * ((ct_) >> 2) + 16 * fq + 4 * ((ct_) & 3); \
                _Pragma("unroll") for (int ks = 0; ks < 4; ++ks) afn[s_][ks] = *(const bf16x8*)(zp_ + (size_t)ks * 4 * 1024 * 8); \
                if (((ct_) & 1) == 0) { _Pragma("unroll") for (int pt = 0; pt < 4; ++pt) zu8[((ct_) >> 1) & 1][pt] = *(const u32x4*)(ZU + (size_t)(tok0 + 64 * ph + 16 * pt + fr) * 1024 + c_); } \
                gcn[s_] = *(const f32x4*)(p.gmlp_ln_g + c_); bcn[s_] = *(const f32x4*)(p.gmlp_ln_b + c_); asm volatile("" ::: "memory"); } while (0)
#define GM_TILE(ct_) do { constexpr int s_ = (ct_) % GM_D; if ((ct_) + GM_D - 1 < 8) GM_LOAD(((ct_) + GM_D - 1) % 8); \
                f32x4 acc[4]; \
                _Pragma("unroll") for (int pt = 0; pt < 4; ++pt) { acc[pt] = (f32x4){0.f, 0.f, 0.f, 0.f}; \
                    _Pragma("unroll") for (int ks = 0; ks < 4; ++ks) acc[pt] = __builtin_amdgcn_mfma_f32_16x16x32_bf16(afn[s_][ks], wf[pt][ks], acc[pt], 0, 0, 0); } \
                _Pragma("unroll") for (int pt = 0; pt < 4; ++pt) { \
                    u32x2 zu; zu.x = ((ct_) & 1) ? zu8[((ct_) >> 1) & 1][pt].z : zu8[((ct_) >> 1) & 1][pt].x; zu.y = ((ct_) & 1) ? zu8[((ct_) >> 1) & 1][pt].w : zu8[((ct_) >> 1) & 1][pt].y; \
                    const f32x4 s = gcn[s_] * (acc[pt] - t1[pt]) + bcn[s_] * t2[pt] + bsv[pt]; \
                    const f32x4 y = __builtin_elementwise_min(__builtin_elementwise_max((f32x4){bflo(zu.x) * s[0], bfhi(zu.x) * s[1], bflo(zu.y) * s[2], bfhi(zu.y) * s[3]} * YA_F8_SCALE, (f32x4){-448.f, -448.f, -448.f, -448.f}), (f32x4){448.f, 448.f, 448.f, 448.f}); \
                    int w = 0; w = __builtin_amdgcn_cvt_pk_fp8_f32(y[0], y[1], w, false); w = __builtin_amdgcn_cvt_pk_fp8_f32(y[2], y[3], w, true); \
                    yw[pt][(ct_) & 3] = (unsigned)w; \
                    if (((ct_) & 3) == 3) { u32x4 w4; w4.x = yw[pt][0]; w4.y = yw[pt][1]; w4.z = yw[pt][2]; w4.w = yw[pt][3]; \
                        *(u32x4*)(YA + (size_t)(tok0 + 64 * ph + 16 * pt + fr) * 1024 + 128 * g + 64 * ((ct_) >> 2) + 16 * fq) = w4; } } \
                asm volatile("" ::: "memory"); } while (0)
            GM_LOAD(0); if (GM_D > 2) GM_LOAD(1);
            GM_TILE(0); GM_TILE(1); GM_TILE(2); GM_TILE(3); GM_TILE(4); GM_TILE(5); GM_TILE(6); GM_TILE(7);
#undef GM_TILE
#undef GM_LOAD
        }
    }
}
constexpr int AT_LDS_RPB = 0, AT_LDS_KC = 4096, AT_LDS_VC = AT_LDS_KC + 32768, AT_LDS_END = AT_LDS_VC + 32768, AT_LDS_ROPE = AT_LDS_END + 64;
typedef __attribute__((address_space(3))) const unsigned char* lds_cp;
__device__ __forceinline__ void attn_stage(const P& p, unsigned char* lds, int b, int h, int tid) {
    float* tbl = (float*)(lds + AT_LDS_RPB);
    for (int idx = tid; idx < 15 * 64; idx += 512) { const int dr = idx >> 6, cc = idx & 63; tbl[idx] = (cc >= 16 && cc < 47) ? p.na_rpb[(h * 15 + dr) * 31 + cc - 16] * 1.4426950408889634f : 0.f; }
    { const f32x4 t4 = ((const f32x4*)(p.ws + WS_ROPE))[tid]; *(f32x4*)(lds + AT_LDS_ROPE + tid * 16) = t4 * (0.125f * 1.4426950408889634f); }
    const size_t bh = (size_t)b * 16 + h;
    const u32x4* kc = (const u32x4*)((const bf16_t*)(p.ws + WS_KC) + bh * 256 * 64); const u32x4* vc = (const u32x4*)((const bf16_t*)(p.ws + WS_VCT) + bh * 32 * 512);
#pragma unroll
    for (int i = 0; i < 4; ++i) { const int q = tid + 512 * i, key = q >> 3, c = q & 7; const int fk = ((key >> 1) & 1) | (((key >> 3) & 1) << 1) | (((key >> 4) & 1) << 2);
        *(u32x4*)(lds + AT_LDS_KC + key * 128 + ((c ^ fk) << 4)) = kc[q]; *(u32x4*)(lds + AT_LDS_VC + q * 16) = vc[q]; }
}
struct AttnTile { bf16x8 qrt[2]; f32x4 o[4], nm; f32x2_ l2; float m2; };
__device__ __forceinline__ void attn_tile_init(const P& p, const unsigned char* lds, AttnTile& T, size_t bh, int r, int qc, int fq) {
    const bf16_t* Q = (const bf16_t*)(p.ws + WS_Q);
    const __attribute__((address_space(3))) float* tab = (const __attribute__((address_space(3))) float*)((const __attribute__((address_space(3))) unsigned char*)lds + AT_LDS_ROPE);
#pragma unroll
    for (int s = 0; s < 2; ++s) {
        const bf16_t* qb = Q + (bh * 4096 + r * 64 + qc) * 64 + 32 * s;
        const bf16x8 me = *(const bf16x8*)(qb + 8 * fq), ot = *(const bf16x8*)(qb + 8 * (fq ^ 2));
        const int pos = s ? qc : r; const __attribute__((address_space(3))) float* tb = tab + (pos * 16 + 8 * (fq & 1)) * 2;
        float rot[8];
#pragma unroll
        for (int jj = 0; jj < 8; ++jj) { const float cv = tb[2 * jj], sv = tb[2 * jj + 1];
            const float xv = bf2f((unsigned)(unsigned short)me[jj]), ov = bf2f((unsigned)(unsigned short)ot[jj]);
            rot[jj] = (fq < 2) ? (xv * cv - ov * sv) : (xv * cv + ov * sv); }
        T.qrt[s] = pack8(rot);
    }
#pragma unroll
    for (int dt = 0; dt < 4; ++dt) T.o[dt] = (f32x4){0.f, 0.f, 0.f, 0.f};
    T.m2 = 0.f; T.l2 = (f32x2_){0.f, 0.f}; T.nm = (f32x4){0.f, 0.f, 0.f, 0.f};
}
__device__ __forceinline__ void attn_tiles_qplain(const P& p, AttnTile& TA, AttnTile& TB, size_t bh, int r, int qc, int fq) {
    const bf16_t* Q = (const bf16_t*)(p.ws + WS_Q); constexpr float QS = 0.125f * 1.4426950408889634f;
    bf16x8 me[2][2];
#pragma unroll
    for (int w = 0; w < 2; ++w)
#pragma unroll
        for (int s = 0; s < 2; ++s) me[w][s] = *(const bf16x8*)(Q + (bh * 4096 + (r + w) * 64 + qc) * 64 + 32 * s + 8 * fq);
#pragma unroll
    for (int w = 0; w < 2; ++w)
#pragma unroll
        for (int s = 0; s < 2; ++s) { float pl[8];
#pragma unroll
            for (int jj = 0; jj < 8; ++jj) pl[jj] = bf2f((unsigned)(unsigned short)me[w][s][jj]) * QS;
            (w ? TB : TA).qrt[s] = pack8(pl); }
}
typedef __attribute__((address_space(3))) const float* lds_fp;
__device__ __forceinline__ float fmax_nc(float a, float b) { return __builtin_amdgcn_fmed3f(a, b, INFINITY); }
__device__ __forceinline__ float attn_rowmax(const f32x4 (&d)[2]) {
    float s = fmax_nc(fmax_nc(fmax_nc(d[0][0], d[0][1]), fmax_nc(d[0][2], d[0][3])), fmax_nc(fmax_nc(d[1][0], d[1][1]), fmax_nc(d[1][2], d[1][3])));
    const u32x2 a = __builtin_amdgcn_permlane16_swap(__builtin_bit_cast(unsigned, s), __builtin_bit_cast(unsigned, s), false, false);
    asm("v_max_f32 %0, %1, %2" : "=v"(s) : "v"(a.x), "v"(a.y));
    const u32x2 c = __builtin_amdgcn_permlane32_swap(__builtin_bit_cast(unsigned, s), __builtin_bit_cast(unsigned, s), false, false);
    asm("v_max_f32 %0, %1, %2" : "=v"(s) : "v"(c.x), "v"(c.y)); return s;
}
__device__ __forceinline__ int attn_imax(const f32x4 (&d)[2]) {
    const int a = max(max(__builtin_bit_cast(int, d[0][0]), __builtin_bit_cast(int, d[0][1])), __builtin_bit_cast(int, d[0][2]));
    const int b = max(max(__builtin_bit_cast(int, d[0][3]), __builtin_bit_cast(int, d[1][0])), __builtin_bit_cast(int, d[1][1]));
    return max(max(a, b), max(__builtin_bit_cast(int, d[1][2]), __builtin_bit_cast(int, d[1][3])));
}
constexpr float AT_GUARD = 64.0f;
__device__ __forceinline__ void attn_shift(AttnTile& T, f32x4 (&d)[2], float shift, bool first) {
    const float al = first ? 1.0f : __builtin_amdgcn_exp2f(-shift);
    T.l2 = T.l2 * al;
#pragma unroll
    for (int dt = 0; dt < 4; ++dt) T.o[dt] = T.o[dt] * al;
    T.m2 += shift; T.nm = T.nm - shift; d[0] = d[0] - shift; d[1] = d[1] - shift;
}
__device__ __forceinline__ void attn_pv(AttnTile& T, const f32x4 (&d)[2], const bf16x8 (&vf)[4]) {
    float pv[8];
#pragma unroll
    for (int e = 0; e < 8; ++e) pv[e] = __builtin_amdgcn_exp2f(d[e >> 2][e & 3]);
    T.l2 = T.l2 + (((f32x2_){pv[0], pv[1]} + (f32x2_){pv[2], pv[3]}) + ((f32x2_){pv[4], pv[5]} + (f32x2_){pv[6], pv[7]}));
    const bf16x8 pf = pack8(pv);
#pragma unroll
    for (int dt = 0; dt < 4; ++dt) T.o[dt] = __builtin_amdgcn_mfma_f32_16x16x32_bf16(vf[dt], pf, T.o[dt], 0, 0, 0);
}
template <bool BIAS> __device__ __forceinline__ void attn_step1(AttnTile& T, const bf16x8 (&kf)[2][2], const bf16x8 (&q)[2], const bf16x8 (&vf)[4], const f32x4 (&ma)[2], const f32x4 (&bias)[2], bool first) {
    f32x4 d[2];
#pragma unroll
    for (int t = 0; t < 2; ++t) { const f32x4 c = BIAS ? ma[t] + T.nm : T.nm;
        d[t] = __builtin_amdgcn_mfma_f32_16x16x32_bf16(kf[t][0], q[0], c, 0, 0, 0); d[t] = __builtin_amdgcn_mfma_f32_16x16x32_bf16(kf[t][1], q[1], d[t], 0, 0, 0); }
    if (BIAS) { d[0] = d[0] + bias[0]; d[1] = d[1] + bias[1]; }
    if (first || __any(attn_imax(d) > __builtin_bit_cast(int, AT_GUARD))) { const float smax = attn_rowmax(d); attn_shift(T, d, first ? smax : fmaxf(smax, 0.f), first); }
    attn_pv(T, d, vf);
}
template <bool BIAS> __device__ __forceinline__ void attn_step2(AttnTile& TA, AttnTile& TB, const bf16x8 (&kf)[2][2], const bf16x8 (&qA)[2], const bf16x8 (&qB)[2], const bf16x8 (&vf)[4],
                                           const f32x4 (&ma)[2], const f32x4 (&biasA)[2], const f32x4 (&biasB)[2], bool firstA, bool firstB) {
    f32x4 dA[2], dB[2];
#pragma unroll
    for (int t = 0; t < 2; ++t) { const f32x4 cA = BIAS ? ma[t] + TA.nm : TA.nm, cB = BIAS ? ma[t] + TB.nm : TB.nm;
        dA[t] = __builtin_amdgcn_mfma_f32_16x16x32_bf16(kf[t][0], qA[0], cA, 0, 0, 0); dB[t] = __builtin_amdgcn_mfma_f32_16x16x32_bf16(kf[t][0], qB[0], cB, 0, 0, 0);
        dA[t] = __builtin_amdgcn_mfma_f32_16x16x32_bf16(kf[t][1], qA[1], dA[t], 0, 0, 0); dB[t] = __builtin_amdgcn_mfma_f32_16x16x32_bf16(kf[t][1], qB[1], dB[t], 0, 0, 0); }
    if (BIAS) { dA[0] = dA[0] + biasA[0]; dA[1] = dA[1] + biasA[1]; dB[0] = dB[0] + biasB[0]; dB[1] = dB[1] + biasB[1]; }
    if (firstA || firstB || __any(max(attn_imax(dA), attn_imax(dB)) > __builtin_bit_cast(int, AT_GUARD))) { const float smA = attn_rowmax(dA), smB = attn_rowmax(dB);
        attn_shift(TA, dA, firstA ? smA : fmaxf(smA, 0.f), firstA); attn_shift(TB, dB, firstB ? smB : fmaxf(smB, 0.f), firstB); }
    attn_pv(TA, dA, vf); attn_pv(TB, dB, vf);
}
__device__ __forceinline__ void attn_pair_unit(const P& p, unsigned char* lds, int b, int r, int j, int h, int lane) {
    const int fr = lane & 15, fq = lane >> 4;
    const bf16_t* K = (const bf16_t*)(p.ws + WS_K); const bf16_t* VT = (const bf16_t*)(p.ws + WS_VT); unsigned char* YB = p.ws + WS_YB;
    const int qc = 16 * j + fr; const size_t bh = (size_t)b * 16 + h;
    r = __builtin_amdgcn_readfirstlane(r); j = __builtin_amdgcn_readfirstlane(j);
    const int r0A = min(max(r - 4, 0), 56), r0B = min(max(r + 1 - 4, 0), 56), nst = r0B + 8 - r0A;
    const int c0 = min(max(qc - 8, 0), 48), cs = min(max(16 * j - 8, 0), 32);
    const int sp0 = 8 * (fr >> 2) + (fr & 3);
    const char* kbase = (const char*)(K + bh * 4096 * 64 + (size_t)(r0A * 64 + cs) * 32);
    const unsigned koff = (unsigned)((sp0 * 32 + 8 * fq) * 2);
    const char* vbase = (const char*)(VT + (bh * 512 + ((r0A * 64 + cs) >> 3)) * 512);
    const unsigned voff = (unsigned)(((fq * 64 + fr) * 8) * 2);
    const int fk = ((fr >> 1) & 1) | (((fr >> 2) & 1) << 1) | (((fr >> 3) & 1) << 2);
    const lds_cp kcl = (lds_cp)lds + AT_LDS_KC + sp0 * 128;
    const int kco0 = (fq ^ fk) << 4, kco1 = ((fq + 4) ^ fk) << 4;
    const lds_cp vcl = (lds_cp)lds + AT_LDS_VC + (fq * 64 + fr) * 16;
    const __attribute__((address_space(3))) float* tbl3 = (const __attribute__((address_space(3))) float*)((lds_cp)lds + AT_LDS_RPB);
    const int boffA = (r0A - r + 7) * 64 + (cs + 8 * fq - qc + 31);
    f32x4 ma[2];
#pragma unroll
    for (int jj = 0; jj < 8; ++jj) { const int kc = cs + 8 * fq + jj; ma[jj >> 2][jj & 3] = (kc >= c0 && kc < c0 + 16) ? 0.f : -INFINITY; }
    AttnTile TA, TB;
    attn_tile_init(p, lds, TA, bh, r, qc, fq); attn_tile_init(p, lds, TB, bh, r + 1, qc, fq);
    bf16x8 kf[2][2][2], vf[2][4];
#define LOADKV(buf, st_) do { const char* k0_ = kbase + (size_t)(st_) * (64 * 32 * 2); const char* k1_ = k0_ + 4096 * 32 * 2; const char* v_ = vbase + (size_t)(st_) * (8 * 512 * 2); \
        _Pragma("unroll") for (int t = 0; t < 2; ++t) { kf[buf][t][0] = *(const bf16x8*)(k0_ + (size_t)(koff + t * 256u)); kf[buf][t][1] = *(const bf16x8*)(k1_ + (size_t)(koff + t * 256u)); } \
        _Pragma("unroll") for (int dt = 0; dt < 4; ++dt) vf[buf][dt] = *(const bf16x8*)(v_ + (size_t)(voff + dt * 256u)); } while (0)
#define LOADBIAS(dst, s_) do { int bo_ = boffA + (s_) * 64; asm volatile("" : "+v"(bo_)); const lds_fp tb_ = tbl3 + bo_; \
        dst[0] = (f32x4){tb_[0], tb_[1], tb_[2], tb_[3]}; dst[1] = (f32x4){tb_[4], tb_[5], tb_[6], tb_[7]}; } while (0)
    const int dB = r0B - r0A;
    f32x4 bx[2][2];
    LOADKV(0, 0); LOADBIAS(bx[1], -1);
#define ATT_STEP(buf, s_) do { const int kr_ = r0A + (s_); const bool doA_ = kr_ <= r0A + 7, doB_ = kr_ >= r0B; \
        LOADBIAS(bx[buf], s_); \
        if (doA_ && doB_) attn_step2<true>(TA, TB, kf[buf], TA.qrt, TB.qrt, vf[buf], ma, bx[buf], bx[(buf) ^ 1], (s_) == 0, (s_) == dB); \
        else if (doA_) attn_step1<true>(TA, kf[buf], TA.qrt, vf[buf], ma, bx[buf], (s_) == 0); \
        else attn_step1<true>(TB, kf[buf], TB.qrt, vf[buf], ma, bx[(buf) ^ 1], (s_) == dB); } while (0)
#pragma unroll 1
    for (int st = 0; st < nst; st += 2) {
        if (st + 1 < nst) LOADKV(1, st + 1);
        ATT_STEP(0, st);
        if (st + 1 < nst) { if (st + 2 < nst) LOADKV(0, st + 2); ATT_STEP(1, st + 1); }
    }
#undef LOADKV
#undef LOADBIAS
#undef ATT_STEP
    attn_tiles_qplain(p, TA, TB, bh, r, qc, fq);
#pragma unroll 1
    for (int st = 0; st < 8; ++st) {
        bf16x8 kc[2][2], vc[4];
#pragma unroll
        for (int t = 0; t < 2; ++t) { const lds_cp kp_ = kcl + (32 * st + 4 * t) * 128; kc[t][0] = *(const __attribute__((address_space(3))) bf16x8*)(kp_ + kco0); kc[t][1] = *(const __attribute__((address_space(3))) bf16x8*)(kp_ + kco1); }
#pragma unroll
        for (int dt = 0; dt < 4; ++dt) vc[dt] = *(const __attribute__((address_space(3))) bf16x8*)(vcl + st * 4096 + dt * 256);
        attn_step2<false>(TA, TB, kc, TA.qrt, TB.qrt, vc, ma, ma, ma, false, false);
    }
#pragma unroll
    for (int w = 0; w < 2; ++w) { AttnTile& T = w ? TB : TA;
        const float l = rows_sum(T.l2.x + T.l2.y);
        const float inv = YB_F8_SCALE / l; const size_t tq = (size_t)b * SEQ + (r + w) * 64 + qc;
        u32x4 w4;
#pragma unroll
        for (int dt = 0; dt < 4; ++dt) { const f32x4 y = __builtin_elementwise_min(__builtin_elementwise_max(T.o[dt] * inv, (f32x4){-448.f, -448.f, -448.f, -448.f}), (f32x4){448.f, 448.f, 448.f, 448.f});
            int ww = 0; ww = __builtin_amdgcn_cvt_pk_fp8_f32(y[0], y[1], ww, false); ww = __builtin_amdgcn_cvt_pk_fp8_f32(y[2], y[3], ww, true); w4[dt] = (unsigned)ww; }
        *(u32x4*)(YB + tq * 1024 + h * 64 + 16 * fq) = w4; }
}
struct ExpItem { const float* W; unsigned char* WT; int N, k0, n0, drow0; };
__device__ __forceinline__ ExpItem exp_item(const P& p, int x) {
    ExpItem I;
    if (x < IT_W1) { const int e = x / 1024, r = x % 1024, kb = r / 64, nb = r % 64, n0 = nb * 32, hf = n0 >> 10, nn = n0 & 1023;
        I.W = p.exp_w1 + (size_t)e * 1024 * 2048; I.WT = p.ws + WS_W1 + (size_t)e * 2048 * 1024; I.N = 2048; I.k0 = kb * 64; I.n0 = n0; I.drow0 = (nn >> 7) * 256 + hf * 128 + (nn & 127); }
    else { x -= IT_W1; const int e = x / 512, r = x % 512, kb = r / 32, nb = r % 32;
        I.W = p.exp_w2 + (size_t)e * 1024 * 1024; I.WT = p.ws + WS_W2 + (size_t)e * 1024 * 1024; I.N = 1024; I.k0 = kb * 64; I.n0 = nb * 32; I.drow0 = nb * 32; }
    return I;
}
constexpr int CV_D = 4, RT_CONV_ITEMS = 112;
__device__ __forceinline__ void convert_stream(const P& p, int vb, int lane, int n0, int n1) {
    f32x4 v[CV_D][8];
#define CV_X(n_) (((n_) >> 3) * 2048 + 8 * vb + ((n_) & 7))
#pragma unroll
    for (int s = 0; s < CV_D; ++s) { const ExpItem I = exp_item(p, CV_X(n0 + s)); f8t_load(I.W, I.N, I.k0, I.n0, lane, v[s]); }
#pragma unroll 1
    for (int n = n0; n < n1; n += CV_D) {
#pragma unroll
        for (int s = 0; s < CV_D; ++s) {
            { const ExpItem I = exp_item(p, CV_X(n + s)); f8t_finish(v[s], 1024, I.WT, I.k0, I.drow0, W_F8_SCALE, lane); }
            if (n + s + CV_D < n1) { const ExpItem I = exp_item(p, CV_X(n + s + CV_D)); f8t_load(I.W, I.N, I.k0, I.n0, lane, v[s]); }
            asm volatile("" ::: "memory"); }
    }
#undef CV_X
}
constexpr int AT_LDS_CNT = AT_LDS_END;
__device__ __forceinline__ void phase_attn_s(const P& p, int bid, int nblk, unsigned char* lds) {
    const int tid_ = tid_opaque(); const int wave = __builtin_amdgcn_readfirstlane(tid_ >> 6), lane = tid_ & 63;
    int* ucnt = (int*)(lds + AT_LDS_CNT);
    for (int vb = bid; vb < 256; vb += nblk) { const int par = (vb >> 3) & 1, bh = (vb & 7) * 16 + (vb >> 4), h = bh & 15, b = bh >> 4;
        __syncthreads();
        { int ts = tid_; asm volatile("" : "+v"(ts)); attn_stage(p, lds, b, h, ts); }
        if (tid_ == 0) *ucnt = 0;
        __syncthreads();
        if (wave == 7) convert_stream(p, vb, lane, RT_CONV_ITEMS, 192);
        {
#pragma unroll 1
            for (;;) { int lane_o = lane; asm volatile("" : "+v"(lane_o));
                int u = 0; if (lane_o == 0) u = __hip_atomic_fetch_add(ucnt, 1, __ATOMIC_RELAXED, __HIP_MEMORY_SCOPE_WORKGROUP);
                u = __builtin_amdgcn_readfirstlane(u);
                if (u >= 64) break;
                attn_pair_unit(p, lds, b, 4 * (u >> 2) + 2 * par, u & 3, h, lane_o); }
        }
    }
}
constexpr int RT_LDS_W = 0, RT_LDS_CNT = 131072, RT_LDS_BASE = RT_LDS_CNT + 128, RT_LDS_REC = RT_LDS_BASE + 128, RT_MAXIT = 32, RT_LDS_END = RT_LDS_REC + 8 * RT_MAXIT * 8 * 4;
__device__ __forceinline__ int rw_off(int prow, int ch) { return prow * 128 + ((ch ^ ((prow >> 1) & 7)) << 4); }
constexpr int RT_RWAVES = 7;
__device__ __forceinline__ void phase_router(const P& p, int bid, int nblk, unsigned char* lds) {
    const int tid = tid_opaque(), wave = __builtin_amdgcn_readfirstlane(tid >> 6), lane = tid & 63;
    int* cnt = (int*)(lds + RT_LDS_CNT); int* base = (int*)(lds + RT_LDS_BASE); int* rec = (int*)(lds + RT_LDS_REC) + wave * RT_MAXIT * 8;
    for (int k = tid; k < 1024; k += 512) { const int l = (k & 255) >> 2, i = k & 3, j = k >> 8, prow = l + 64 * (4 * j + i);
        const f32x4* src = (const f32x4*)(p.router_w + (size_t)k * 32);
#pragma unroll
        for (int ch = 0; ch < 8; ++ch) *(f32x4*)(lds + RT_LDS_W + rw_off(prow, ch)) = src[ch]; }
    if (tid < 32) cnt[tid] = 0;
    __syncthreads();
    const float* mod = (const float*)(p.ws + WS_MOD);
    int* TOPE = (int*)(p.ws + WS_TOPE); float* TOPG = (float*)(p.ws + WS_TOPG); int* SLOT = (int*)(p.ws + WS_SLOT);
    unsigned char* U2 = p.ws + WS_U;
    const int erev = 16 * ((lane >> 4) & 1) + (int)(__builtin_bitreverse32((unsigned)(lane & 15)) >> 28);
    unsigned wb[8];
#pragma unroll
    for (int ch = 0; ch < 8; ++ch) wb[ch] = RT_LDS_W + lane * 128 + ((ch ^ ((lane >> 1) & 7)) << 4);
    unsigned wbh[8];
#pragma unroll
    for (int ch = 0; ch < 8; ++ch) wbh[ch] = wb[ch] + 65536;
    int it = 0;
    const int NRI = 8 * ((NTOK + nblk * 8 - 1) / (nblk * 8));
#define RT_ROW(ri_) (bid * 8 + ((ri_) & 7) + ((ri_) >> 3) * nblk * 8)
    if (wave >= RT_RWAVES) { for (int vb = bid; vb < 256; vb += nblk) convert_stream(p, vb, lane, 0, RT_CONV_ITEMS); }
    else {
    u32x2 preA[4], preB[4];
#define RT_PREF(dst, ri_) { const int rq0_ = ((ri_) < NRI) ? RT_ROW(ri_) : 0; const int rq_ = rq0_ < NTOK ? rq0_ : 0;     \
        const u32x2* xin_ = (const u32x2*)((const bf16_t*)(p.ws + WS_X1PRE) + (size_t)rq_ * DM) + lane; \
        _Pragma("unroll") for (int j = 0; j < 4; ++j) dst[j] = xin_[64 * j]; }
    RT_PREF(preA, wave) RT_PREF(preB, wave + RT_RWAVES)
    f32x4 pg[4], pb[4];
#pragma unroll
    for (int j = 0; j < 4; ++j) { pg[j] = *(const f32x4*)(p.ln1_g + 4 * lane + 256 * j); pb[j] = *(const f32x4*)(p.ln1_b + 4 * lane + 256 * j); }
    const float rbias = p.router_b[erev];
#define RT_LNROW(row_, ok_, pre_, u_, rinext_) { \
        const int b = (row_) >> 12; \
        int lane_o = lane; asm volatile("" : "+v"(lane_o));     \
        f32x4 psh[4], psc[4]; \
        _Pragma("unroll") for (int j = 0; j < 4; ++j) { const int col = 4 * lane_o + 256 * j; psh[j] = *(const f32x4*)(mod + b * 6144 + 3072 + col); psc[j] = *(const f32x4*)(mod + b * 6144 + 4096 + col); } \
        f32x4 v[4]; float s = 0.f; \
        _Pragma("unroll") for (int j = 0; j < 4; ++j) { const u32x2 w = pre_[j]; v[j] = (f32x4){bflo(w.x), bfhi(w.x), bflo(w.y), bfhi(w.y)}; s += (v[j].x + v[j].y) + (v[j].z + v[j].w); } \
        RT_PREF(pre_, rinext_) \
        const float mean = wave_sum(s) * (1.f / DM); float s2 = 0.f; \
        _Pragma("unroll") for (int j = 0; j < 4; ++j) { v[j] = v[j] - mean; s2 += (v[j].x * v[j].x + v[j].y * v[j].y) + (v[j].z * v[j].z + v[j].w * v[j].w); } \
        const float rstd = 1.f / sqrtf(wave_sum(s2) * (1.f / DM) + LN_EPS); \
        u32x2 xw[4]; unsigned ow[4]; \
        _Pragma("unroll") for (int j = 0; j < 4; ++j) { \
            const f32x4 x1 = (v[j] * rstd) * pg[j] + pb[j]; xw[j].x = pk2(x1.x, x1.y); xw[j].y = pk2(x1.z, x1.w); \
            u_[j] = x1 * (1.0f + psc[j]) + psh[j]; \
            int w = 0; w = __builtin_amdgcn_cvt_pk_fp8_f32(u_[j].x, u_[j].y, w, false); w = __builtin_amdgcn_cvt_pk_fp8_f32(u_[j].z, u_[j].w, w, true); ow[j] = (unsigned)w; } \
        { const int rst_ = (ok_) ? (row_) : NTOK;     \
            u32x2* xr = (u32x2*)((bf16_t*)(p.ws + WS_X1) + (size_t)rst_ * DM) + lane; unsigned* o8 = (unsigned*)(U2 + (size_t)rst_ * DM) + lane; \
            _Pragma("unroll") for (int j = 0; j < 4; ++j) { xr[64 * j] = xw[j]; o8[64 * j] = ow[j]; } } }
#define RS_STAGE(a, st) { constexpr int n = 8 >> st; const bool up = (lane >> st) & 1; \
                _Pragma("unroll") for (int i = 0; i < n; ++i) { float lo = a[i], hi = a[n + i]; asm volatile("" : "+v"(lo), "+v"(hi));     \
                    const float keep = up ? hi : lo, send = up ? lo : hi; a[i] = keep + xor_row<st>(send); } }
#define RT_REDUCE(a2_, out_) { float a[16]; _Pragma("unroll") for (int e = 0; e < 8; ++e) { a[2 * e] = a2_[e].x; a[2 * e + 1] = a2_[e].y; } \
            RS_STAGE(a, 0) RS_STAGE(a, 1) RS_STAGE(a, 2) RS_STAGE(a, 3) out_ = rows_sum(a[0]); }
#define TOP_STEP(TV, TE) float TV; int TE; { const float mx = wave_max(cur); int cand = (cur == mx) ? erev : 64; \
            cand = wave_min_i(cand); \
            TV = mx; TE = cand; if (erev == cand) cur = -INFINITY; }
#define RT_TOP4(row_, ok_, lg2_, it_) { \
        float logit = ((lane >> 4) & 1) ? lg2_[1] : lg2_[0]; \
        logit += rbias; \
        float cur = logit; \
        TOP_STEP(tv0, te0) TOP_STEP(tv1, te1) TOP_STEP(tv2, te2) TOP_STEP(tv3, te3) \
        const float gk0 = 1.0f, gk1 = __expf(tv1 - tv0), gk2 = __expf(tv2 - tv0), gk3 = __expf(tv3 - tv0); \
        const float ginv = 1.f / (gk0 + gk1 + gk2 + gk3); \
        if ((ok_) && lane < 4) { const int e = lane == 0 ? te0 : lane == 1 ? te1 : lane == 2 ? te2 : te3; const float g = lane == 0 ? gk0 : lane == 1 ? gk1 : lane == 2 ? gk2 : gk3; \
            const int pos = atomicAdd(&cnt[e], 1); \
            TOPE[(row_) * 4 + lane] = e; TOPG[(row_) * 4 + lane] = g * ginv; \
            if ((it_) < RT_MAXIT) { rec[(it_) * 8 + lane * 2] = e; rec[(it_) * 8 + lane * 2 + 1] = pos; } } }
    for (int ri = wave; ri < NRI; ri += 2 * RT_RWAVES, it += 2) { const int rowA = RT_ROW(ri); if (rowA >= NTOK) continue;
        const int riB = ri + RT_RWAVES; const int rowBv = riB < NRI ? RT_ROW(riB) : NTOK; const bool hasB = rowBv < NTOK; const int rowB = hasB ? rowBv : rowA;
        f32x4 uA[4], uB[4];
        RT_LNROW(rowA, true, preA, uA, ri + 2 * RT_RWAVES)
        RT_LNROW(rowB, hasB, preB, uB, riB + 2 * RT_RWAVES)
        float lgA[2], lgB[2];
#pragma unroll
        for (int hf = 0; hf < 2; ++hf) {
            f32x2_ a2A[8], a2B[8];
#pragma unroll
            for (int e = 0; e < 8; ++e) { a2A[e] = (f32x2_){0.f, 0.f}; a2B[e] = (f32x2_){0.f, 0.f}; }
            const __attribute__((address_space(3))) unsigned char* lw = (const __attribute__((address_space(3))) unsigned char*)lds;
#pragma unroll
            for (int j = 0; j < 4; ++j)
#pragma unroll
                for (int i = 0; i < 4; ++i) { const f32x2_ uvA = (f32x2_){uA[j][i], uA[j][i]}, uvB = (f32x2_){uB[j][i], uB[j][i]};
#pragma unroll
                    for (int ch = 0; ch < 4; ++ch) {
                        const f32x4 w4 = (4 * j + i < 8) ? *(const __attribute__((address_space(3))) f32x4*)(lw + wb[4 * hf + ch] + (4 * j + i) * 8192) : *(const __attribute__((address_space(3))) f32x4*)(lw + wbh[4 * hf + ch] + (4 * j + i - 8) * 8192);
                        a2A[2 * ch] = __builtin_elementwise_fma((f32x2_){w4.x, w4.y}, uvA, a2A[2 * ch]); a2A[2 * ch + 1] = __builtin_elementwise_fma((f32x2_){w4.z, w4.w}, uvA, a2A[2 * ch + 1]);
                        a2B[2 * ch] = __builtin_elementwise_fma((f32x2_){w4.x, w4.y}, uvB, a2B[2 * ch]); a2B[2 * ch + 1] = __builtin_elementwise_fma((f32x2_){w4.z, w4.w}, uvB, a2B[2 * ch + 1]); } }
            RT_REDUCE(a2A, lgA[hf]) RT_REDUCE(a2B, lgB[hf])
        }
        RT_TOP4(rowA, true, lgA, it)
        RT_TOP4(rowB, hasB, lgB, it + 1)
    }
#undef RT_PREF
#undef RT_LNROW
#undef RS_STAGE
#undef RT_REDUCE
#undef TOP_STEP
#undef RT_TOP4
    }
    __syncthreads();
    if (tid < 32) base[tid] = atomicAdd((int*)(p.ws + WS_CTL) + tid, cnt[tid]);
    __syncthreads();
    it = 0;
    int* PERM2 = (int*)(p.ws + WS_PERM2);
    if (wave < RT_RWAVES) for (int ri = wave; ri < NRI; ri += RT_RWAVES, ++it) { const int row = RT_ROW(ri);
        if (row < NTOK && lane < 4 && it < RT_MAXIT) { const int e = rec[it * 8 + lane * 2], pos = base[e] + rec[it * 8 + lane * 2 + 1]; SLOT[row * 4 + lane] = pos; PERM2[(size_t)e * NTOK + pos] = row; } }
#undef RT_ROW
}
constexpr int MT_LDS = 131072 + 1024;
__device__ __forceinline__ void moe_tables(const P& p, unsigned char* lds) {
    const int tid = tid_opaque(); int* cn = (int*)(lds + MT_LDS); int* eb = cn + 32; int* tb = eb + 33;
    __syncthreads();
    if (tid < 32) cn[tid] = __hip_atomic_load((int*)(p.ws + WS_CTL) + tid, __ATOMIC_RELAXED, __HIP_MEMORY_SCOPE_AGENT);
    __syncthreads();
    if (tid == 0) { int s = 0, t = 0; for (int e = 0; e < 32; ++e) { eb[e] = s; tb[e] = t; s += cn[e]; t += (cn[e] + 255) >> 8; } eb[32] = s; tb[32] = t; }
    __syncthreads();
}
struct FinIdx { int e[4]; int pos[4]; float g[4]; };
struct FinData { u32x4 ys[4]; u32x4 x[2]; f32x4 g2[4]; };
__device__ __forceinline__ void fin_load_idx(const P& p, int row, FinIdx& r) {
    const u32x4 ev = *(const u32x4*)((const int*)(p.ws + WS_TOPE) + row * 4), pv = *(const u32x4*)((const int*)(p.ws + WS_SLOT) + row * 4); const f32x4 gv = *(const f32x4*)((const float*)(p.ws + WS_TOPG) + row * 4);
#pragma unroll
    for (int k = 0; k < 4; ++k) { r.e[k] = (int)ev[k]; r.pos[k] = (int)pv[k]; r.g[k] = gv[k] * (1.0f / YS_F8_SCALE); }
}
__device__ __forceinline__ void fin_load_data(const P& p, const int* eb, int row, const FinIdx& ix, FinData& d, int lane) {
    const unsigned char* YS = p.ws + WS_YS;
#pragma unroll
    for (int k = 0; k < 4; ++k) { const size_t slot = (size_t)(eb[ix.e[k]] + ix.pos[k]); d.ys[k] = *(const u32x4*)(YS + slot * 1024 + 16 * lane); }
    const u32x4* xr = (const u32x4*)((const bf16_t*)(p.ws + WS_X1) + (size_t)row * DM + 16 * lane); d.x[0] = xr[0]; d.x[1] = xr[1];
    const float* g2p = (const float*)(p.ws + WS_MOD) + (row >> 12) * 6144 + 5120 + 16 * lane;
#pragma unroll
    for (int q = 0; q < 4; ++q) d.g2[q] = *(const f32x4*)(g2p + 4 * q);
}
__device__ __forceinline__ void phase_final(const P& p, int bid, int nblk, unsigned char* lds) {
    moe_tables(p, lds); const int* eb = (const int*)(lds + MT_LDS) + 32;
    const int tid = tid_opaque(), wave = tid >> 6, lane = tid & 63;
    const float* mod = (const float*)(p.ws + WS_MOD);
    const int stride = nblk * 8;
    int row = bid * 8 + wave; if (row >= NTOK) return;
    FinIdx ic, in; FinData dc, dn;
    f32x4 l2g[4], l2b[4];
#pragma unroll
    for (int q = 0; q < 4; ++q) { l2g[q] = *(const f32x4*)(p.ln2_g + 16 * lane + 4 * q); l2b[q] = *(const f32x4*)(p.ln2_b + 16 * lane + 4 * q); }
    fin_load_idx(p, row, ic); fin_load_data(p, eb, row, ic, dc, lane);
    int row_n = row + stride; fin_load_idx(p, row_n < NTOK ? row_n : row, in);
#pragma unroll 1
    for (;;) {
        fin_load_data(p, eb, row_n < NTOK ? row_n : row, in, dn, lane);
        const int row_nn = row_n + stride; FinIdx inn; fin_load_idx(p, row_nn < NTOK ? row_nn : row, inn);
        const int b = row >> 12, col = 16 * lane;
        f32x4 v[4]; float s = 0.f;
#pragma unroll
        for (int q = 0; q < 4; ++q) v[q] = (f32x4){0.f, 0.f, 0.f, 0.f};
#pragma unroll
        for (int k = 0; k < 4; ++k) { const u32x4 w = dc.ys[k]; const float g = ic.g[k];
            v[0] += unpack4_f8(w.x) * g; v[1] += unpack4_f8(w.y) * g; v[2] += unpack4_f8(w.z) * g; v[3] += unpack4_f8(w.w) * g; }
#pragma unroll
        for (int q = 0; q < 4; ++q) { const u32x4 xw = dc.x[q >> 1]; const unsigned w0 = (q & 1) ? xw.z : xw.x, w1 = (q & 1) ? xw.w : xw.y;
            const f32x4 xa = (f32x4){bflo(w0), bfhi(w0), bflo(w1), bfhi(w1)}; const f32x4 g2 = dc.g2[q];
            v[q] = xa * ALPHA + g2 * v[q]; s += (v[q].x + v[q].y) + (v[q].z + v[q].w); }
        const float mean = wave_sum(s) * (1.f / DM); float s2 = 0.f;
#pragma unroll
        for (int q = 0; q < 4; ++q) { v[q] = v[q] - mean; s2 += (v[q].x * v[q].x + v[q].y * v[q].y) + (v[q].z * v[q].z + v[q].w * v[q].w); }
        const float rstd = 1.f / sqrtf(wave_sum(s2) * (1.f / DM) + LN_EPS);
        f32x4* xo = (f32x4*)(p.out + (size_t)row * DM + col);
#pragma unroll
        for (int q = 0; q < 4; ++q) xo[q] = (v[q] * rstd) * l2g[q] + l2b[q];
        if (row_n >= NTOK) break;
        row = row_n; row_n = row_nn; ic = in; in = inn; dc = dn;
    }
}

namespace pg {
#define PG_LAS __attribute__((address_space(3)))
typedef float f32x2 __attribute__((ext_vector_type(2)));
constexpr int BM = 256, BK = 64, HALF = 128, HTB = HALF * BK * 2, STAGE_BYTES = 8 * HTB, KD = 1024, NT = KD / BK;
constexpr unsigned KSTEP = BK * 2, HSTEPB = HALF * KD * 2;
__host__ __device__ __forceinline__ int lds_byte(int r, int c) { const int st = (r >> 4) * 2 + (c >> 5), rr = r & 15, cc = c & 31, ob = rr * 64 + cc * 2; return st * 1024 + (ob ^ (((ob >> 9) & 1) << 5)); }
__host__ __device__ __forceinline__ void stage_rc(int b, int& R, int& C) { const int st = b / 1024, sb = b % 1024, swz = sb ^ (((sb >> 9) & 1) << 5); R = (st >> 1) * 16 + swz / 64; C = (st & 1) * 32 + (swz % 64) / 2; }
__host__ __device__ __forceinline__ int perm32(int rho) { const int n = rho >> 4, i = rho & 15; return 8 * (i >> 2) + 4 * n + (i & 3); }
struct Unit { int pm, pn, row0, nrows, e, kind; };
__device__ __forceinline__ void tilemap(int L, int nM, int nN, int& pm, int& pn) {
    int wgid = L; { const int nwg = nM * nN, q = nwg / 8, r = nwg % 8, xcd = wgid % 8, off = wgid / 8; wgid = (xcd < r ? xcd * (q + 1) : r * (q + 1) + (xcd - r) * q) + off; }
    const int nig = 8 * nN, gid = wgid / nig, fm = gid * 8, gsz = (nM - fm) < 8 ? (nM - fm) : 8;
    pm = fm + ((wgid % nig) % gsz); pn = (wgid % nig) / gsz;
}
__device__ __forceinline__ unsigned cvt_pk_bf16(float lo, float hi) { unsigned r; asm volatile("v_cvt_pk_bf16_f32 %0, %1, %2" : "=v"(r) : "v"(lo), "v"(hi)); return r; }
__device__ __forceinline__ f32x2 gelu_pk(f32x2 v) {
    const f32x2 av = __builtin_elementwise_abs(v), d = av * 0.2316418882f + 1.0f;
    f32x2 t; t.x = __builtin_amdgcn_rcpf(d.x); t.y = __builtin_amdgcn_rcpf(d.y);
    f32x2 q = t * 0.5307027145f + (-0.7265760135f); q = q * t + 0.7107068705f; q = q * t + (-0.142248368f); q = q * t + 0.127414796f; q = q * t;
    const f32x2 s = (v * v) * (-0.72134752044f);
    f32x2 e; e.x = __builtin_amdgcn_exp2f(s.x); e.y = __builtin_amdgcn_exp2f(s.y);
    const f32x2 m = v * (q * e), r = v - m;
    f32x2 o; o.x = v.x < 0.f ? m.x : r.x; o.y = v.y < 0.f ? m.y : r.y; return o;
}
__device__ __forceinline__ f32x4 gelu4(f32x4 v) { const f32x2 a = gelu_pk((f32x2){v[0], v[1]}), b = gelu_pk((f32x2){v[2], v[3]}); return (f32x4){a.x, a.y, b.x, b.y}; }
__device__ __forceinline__ f32x4 sigmoid4(f32x4 v) { f32x4 o;
#pragma unroll
    for (int i = 0; i < 4; ++i) o[i] = __builtin_amdgcn_rcpf(1.0f + __builtin_amdgcn_exp2f(-1.4426950408889634f * v[i]));
    return o; }
__device__ __forceinline__ u32x4 pack8v(f32x4 a, f32x4 b) { u32x4 w; w.x = cvt_pk_bf16(a[0], a[1]); w.y = cvt_pk_bf16(a[2], a[3]); w.z = cvt_pk_bf16(b[0], b[1]); w.w = cvt_pk_bf16(b[2], b[3]); return w; }

typedef int v8i __attribute__((ext_vector_type(8)));
template <class Epi, class Sched, bool ALIGN_EPI, bool F8 = false>
__device__ __forceinline__ void gemm_phase(PG_LAS unsigned char* lds, const unsigned char* Abase, const Sched& S, const Epi& E) {
    const int tid = tid_opaque(), wid = __builtin_amdgcn_readfirstlane(tid >> 6), lane = tid & 63, wr = wid >> 2, wc = wid & 3, fr = lane & 15, fq = lane >> 4;
    int R[2], C[2]; unsigned voffB[2];
#pragma unroll
    for (int i = 0; i < 2; ++i) { stage_rc(tid * 16 + i * 8192, R[i], C[i]);
        const int rho = R[i] & 31, Rb = Epi::PERM == 0 ? R[i] : (Epi::PERM == 1 ? ((R[i] & ~31) + perm32(rho)) : ((R[i] >> 5) * 64 + 16 * ((rho & 15) >> 2) + 4 * (rho >> 4) + (rho & 3)));
        voffB[i] = (unsigned)(Rb * (F8 ? 1024 : 2048) + C[i] * 2); }
    constexpr unsigned HSB = (Epi::PERM == 2 ? 8u : 128u) * (F8 ? 1024u : 2048u);
    constexpr int NTL = F8 ? NT / 2 : NT;
    const unsigned ldsw = (unsigned)wid * 1024u;
    const int aoff = lds_byte(wr * 64 + fr, fq * 8), boff = lds_byte(wc * 32 + fr, fq * 8);
#define PG_SA(b, h) (((b) * 2 + (h)) * HTB)
#define PG_SB(b, h) ((4 + (b) * 2 + (h)) * HTB)
#define PG_STAGE_A(bufoff, kbyte, vo) do { _Pragma("unroll") for (int _i = 0; _i < 2; ++_i) \
        __builtin_amdgcn_global_load_lds((const unsigned*)((const char*)Abase + (kbyte) + (vo)[_i]), (PG_LAS unsigned*)(lds + (bufoff) + ldsw + _i * 8192), 16, 0, 0); } while (0)
#define PG_STAGE_B(bufoff, gbase) do { _Pragma("unroll") for (int _i = 0; _i < 2; ++_i) \
        __builtin_amdgcn_global_load_lds((const unsigned*)((const char*)(gbase) + voffB[_i]), (PG_LAS unsigned*)(lds + (bufoff) + ldsw + _i * 8192), 16, 0, 0); } while (0)
#define PG_LD16(off) (*(const PG_LAS u32x4*)(lds + (off)))
#define PG_CAT(lo, hi) __builtin_bit_cast(v8i, __builtin_shufflevector((lo), (hi), 0, 1, 2, 3, 4, 5, 6, 7))
#define PG_LDA(dst, b, h) do { _Pragma("unroll") for (int m = 0; m < 4; ++m) { \
        if constexpr (F8) dst##8[m] = PG_CAT(PG_LD16(PG_SA(b, h) + aoff + m * 2048), PG_LD16(PG_SA(b, h) + aoff + m * 2048 + 1024)); \
        else { _Pragma("unroll") for (int k = 0; k < 2; ++k) dst[m][k] = *(const PG_LAS bf16x8*)(lds + PG_SA(b, h) + aoff + m * 2048 + k * 1024); } } } while (0)
#define PG_LDB(dst, b, h) do { _Pragma("unroll") for (int n = 0; n < 2; ++n) { \
        if constexpr (F8) dst##8[n] = PG_CAT(PG_LD16(PG_SB(b, h) + boff + n * 2048), PG_LD16(PG_SB(b, h) + boff + n * 2048 + 1024)); \
        else { _Pragma("unroll") for (int k = 0; k < 2; ++k) dst[n][k] = *(const PG_LAS bf16x8*)(lds + PG_SB(b, h) + boff + n * 2048 + k * 1024); } } } while (0)
#define PG_MMA(ai, bj, At, Bt) do { __builtin_amdgcn_s_setprio(1); _Pragma("unroll") for (int m = 0; m < 4; ++m) _Pragma("unroll") for (int n = 0; n < 2; ++n) { \
        if constexpr (F8) asm volatile("s_nop 1\n\tv_mfma_scale_f32_16x16x128_f8f6f4 %0, %1, %2, %0, %3, %3 op_sel_hi:[0,0,0]" : "+v"(acc[ai][bj][m][n]) : "v"(Bt##8[n]), "v"(At##8[m]), "v"(f8scale)); \
        else { _Pragma("unroll") for (int k = 0; k < 2; ++k) acc[ai][bj][m][n] = __builtin_amdgcn_mfma_f32_16x16x32_bf16(Bt[n][k], At[m][k], acc[ai][bj][m][n], 0, 0, 0); } } \
        __builtin_amdgcn_s_setprio(0); } while (0)
#define PG_WAIT_V(n) asm volatile("s_waitcnt vmcnt(" #n ")" ::: "memory")
#define PG_WAIT_L(n) asm volatile("s_waitcnt lgkmcnt(" #n ")" ::: "memory")
#define PG_BAR __builtin_amdgcn_s_barrier()
#define PG_SCHED __builtin_amdgcn_sched_barrier(0)
    Unit cur, nxt; int ui = 0;
    if (!S.next(0, cur)) return;
    f32x4 acc[2][2][4][2];
#pragma unroll
    for (int a = 0; a < 2; ++a)
#pragma unroll
        for (int b = 0; b < 2; ++b)
#pragma unroll
            for (int m = 0; m < 4; ++m)
#pragma unroll
                for (int n = 0; n < 2; ++n) acc[a][b][m][n] = (f32x4){0.f, 0.f, 0.f, 0.f};
    bf16x8 At[4][2], B0[2][2], B1[2][2]; v8i At8[4], B08[2], B18[2];
    int f8scale = 0x7f7f7f7f; asm volatile("" : "+v"(f8scale));
    unsigned ac[2][2], an[2][2];
    S.aoffs(cur, R, C, ac);
    const char* cB = S.bptr(cur);
    PG_STAGE_B(PG_SB(0, 0), cB); PG_STAGE_B(PG_SB(0, 1), cB + HSB); PG_STAGE_A(PG_SA(0, 0), 0u, ac[0]); PG_STAGE_A(PG_SA(0, 1), 0u, ac[1]);
    if (wr == 1) PG_BAR;
    PG_WAIT_V(2); PG_BAR;
    PG_STAGE_B(PG_SB(1, 0), cB + KSTEP); PG_STAGE_A(PG_SA(1, 0), KSTEP, ac[0]); PG_STAGE_B(PG_SB(1, 1), cB + HSB + KSTEP);
    PG_WAIT_V(6); PG_BAR;
    for (;;) {
        const bool has_next = S.next(ui + 1, nxt);
        const char* nB = cB;
        if (has_next) { int R2[2], C2[2]; int t2 = tid; asm volatile("" : "+v"(t2));
#pragma unroll
            for (int i = 0; i < 2; ++i) stage_rc(t2 * 16 + i * 8192, R2[i], C2[i]);
            S.aoffs(nxt, R2, C2, an); nB = S.bptr(nxt); }
        else {
#pragma unroll
            for (int h = 0; h < 2; ++h)
#pragma unroll
                for (int i = 0; i < 2; ++i) an[h][i] = ac[h][i]; }
        for (int t = 0; t < NTL; t += 2) {
            const bool last = (t == NTL - 2);
            const unsigned ka1 = (unsigned)(t + 1) * KSTEP;
            const unsigned ka2 = last ? 0u : (unsigned)(t + 2) * KSTEP;
            const char* b2 = last ? nB : cB + (size_t)(t + 2) * KSTEP; const char* b3 = b2 + KSTEP;
            unsigned a2o[2][2];
#pragma unroll
            for (int h = 0; h < 2; ++h)
#pragma unroll
                for (int i = 0; i < 2; ++i) a2o[h][i] = last ? an[h][i] : ac[h][i];
            PG_LDB(B0, 0, 0); PG_LDB(B1, 0, 1); PG_SCHED; PG_LDA(At, 0, 0); PG_STAGE_A(PG_SA(1, 1), ka1, ac[1]);
            PG_WAIT_V(8); PG_WAIT_L(0); PG_BAR; PG_MMA(0, 0, At, B0); PG_MMA(0, 1, At, B1); PG_BAR; PG_SCHED;
            PG_LDA(At, 0, 1); PG_STAGE_B(PG_SB(0, 0), b2); PG_STAGE_B(PG_SB(0, 1), b2 + HSB); PG_STAGE_A(PG_SA(0, 0), ka2, a2o[0]);
            PG_WAIT_V(8); PG_WAIT_L(0); PG_BAR; PG_MMA(1, 0, At, B0); PG_MMA(1, 1, At, B1); PG_BAR; PG_SCHED;
            PG_LDB(B0, 1, 0); PG_LDB(B1, 1, 1); PG_SCHED; PG_LDA(At, 1, 0); PG_STAGE_A(PG_SA(0, 1), ka2, a2o[1]);
            PG_WAIT_V(8); PG_WAIT_L(0); PG_BAR; PG_MMA(0, 0, At, B0); PG_MMA(0, 1, At, B1); PG_BAR; PG_SCHED;
            PG_LDA(At, 1, 1); PG_STAGE_B(PG_SB(1, 0), b3); PG_STAGE_B(PG_SB(1, 1), b3 + HSB); PG_STAGE_A(PG_SA(1, 0), ka2 + KSTEP, a2o[0]);
            PG_WAIT_V(8); PG_WAIT_L(0); PG_BAR; PG_MMA(1, 0, At, B0); PG_MMA(1, 1, At, B1); PG_BAR; PG_SCHED;
        }
        if constexpr (ALIGN_EPI) { if (wr == 0) PG_BAR; }
        if constexpr (F8) asm volatile("s_nop 15\n\ts_nop 15" ::: "memory");
        { int te = tid; asm volatile("" : "+v"(te)); E.run(acc, cur, wr, wc, te & 15, (te >> 4) & 3); }
        if (!has_next) break;
        if (!E.carry(cur)) {
#pragma unroll
            for (int a = 0; a < 2; ++a)
#pragma unroll
                for (int b = 0; b < 2; ++b)
#pragma unroll
                    for (int m = 0; m < 4; ++m)
#pragma unroll
                        for (int n = 0; n < 2; ++n) acc[a][b][m][n] = (f32x4){0.f, 0.f, 0.f, 0.f}; }
        cur = nxt; cB = nB; ++ui;
#pragma unroll
        for (int h = 0; h < 2; ++h)
#pragma unroll
            for (int i = 0; i < 2; ++i) ac[h][i] = an[h][i];
        if constexpr (ALIGN_EPI) { if (wr == 1) PG_BAR; }
    }
    PG_WAIT_V(0);
    if constexpr (!ALIGN_EPI) { if (wr == 0) PG_BAR; }
    PG_BAR;
#undef PG_SA
#undef PG_SB
#undef PG_STAGE_A
#undef PG_STAGE_B
#undef PG_LDA
#undef PG_LDB
#undef PG_MMA
#undef PG_CAT
#undef PG_LD16
#undef PG_WAIT_V
#undef PG_WAIT_L
#undef PG_BAR
#undef PG_SCHED
}

struct SchedP1 {
    int G, c; const unsigned char* ws;
    __device__ __forceinline__ bool next(int i, Unit& u) const {
        const int L = i * G + c; if (L >= 3136) return false;
        u.row0 = 0; u.nrows = 256; u.e = 0;
        if (L < 2048) { u.kind = 0; tilemap(L, 128, 16, u.pm, u.pn); }
        else if (L < 3072) { u.kind = 1; tilemap(L - 2048, 8, 128, u.pm, u.pn); }
        else if (L < 3104) { u.kind = 2; const int l = L - 3072; u.pm = l >> 2; u.pn = l & 3; }
        else { u.kind = 3; const int l = L - 3104; u.pm = l >> 3; u.pn = l & 7; }
        return true; }
    __device__ __forceinline__ void aoffs(const Unit& u, const int (&R)[2], const int (&C)[2], unsigned (&o)[2][2]) const {
        size_t base; int row0;
        if (u.kind == 0) { base = WS_U; row0 = 256 * u.pm; }
        else if (u.kind == 1) { base = WS_WIN; row0 = u.pm < 4 ? 1024 + 256 * u.pm : 4096 + 256 * (u.pm - 4); }
        else if (u.kind == 2) { base = WS_UC; row0 = 256 * u.pm; }
        else { base = WS_WIN; row0 = 4096 + 256 * u.pm; }
#pragma unroll
        for (int h = 0; h < 2; ++h)
#pragma unroll
            for (int i = 0; i < 2; ++i) o[h][i] = (unsigned)(base + (size_t)(row0 + 128 * h + R[i]) * 1024 + C[i] * 2); }
    __device__ __forceinline__ const char* bptr(const Unit& u) const {
        if (u.kind == 0) { const int wrow = u.pn < 4 ? 256 * u.pn : (u.pn < 8 ? 2048 + 256 * (u.pn - 4) : 5120 + 256 * (u.pn - 8)); return (const char*)ws + WS_WIN + (size_t)wrow * 1024; }
        if (u.kind == 1) return (const char*)ws + WS_U + (size_t)u.pn * 256 * 1024;
        if (u.kind == 2) return (const char*)ws + WS_WIN + (size_t)(3072 + 256 * u.pn) * 1024;
        return (const char*)ws + WS_UC + (size_t)u.pn * 256 * 1024; }
};
constexpr float P1_DS = 1.0f / (U_F8_SCALE * WIN_F8_SCALE);
struct EpiP1 {
    static constexpr int PERM = 1;
    unsigned char* ws; const float* b_in;
    __device__ __forceinline__ bool carry(const Unit&) const { return false; }
    __device__ __forceinline__ void run(f32x4 (&acc)[2][2][4][2], const Unit& u, int wr, int wc, int fr, int fq) const {
        const int lc = wc * 32 + 8 * fq, kind = u.kind, pm = u.pm, pn = u.pn;
        const bool brow = (kind == 1) || (kind == 3);
        int act, bcol, browbase, RA, RB, CA, CB; size_t base;
        if (kind == 0) { browbase = 0;
            if (pn < 4) { act = 1; bcol = 256 * pn; base = WS_ZU / 2 + (size_t)256 * pm * 1024 + 256 * pn; RA = 65536; RB = 1024; CA = 64; CB = 1; }
            else if (pn < 8) { act = 0; bcol = 2048 + 256 * (pn - 4); const int tok0 = 256 * pm;
                base = WS_Q / 2 + ((size_t)((tok0 >> 12) * 16 + 4 * (pn - 4)) * 4096 + (tok0 & 4095)) * 64; RA = 4096; RB = 64; CA = 4096 * 64; CB = 1; }
            else { act = 2; bcol = 5120 + 256 * (pn - 8); base = WS_G / 2 + (size_t)256 * pm * 2048 + 256 * (pn - 8); RA = 131072; RB = 2048; CA = 64; CB = 1; } }
        else if (kind == 1) { bcol = 0; const int tk0 = 256 * pn;
            if (pm < 4) { act = 1; browbase = 1024 + 256 * pm; base = WS_ZVT / 2 + (size_t)(tk0 >> 3) * 8192 + 256 * pm * 8; RA = 512; RB = 8; CA = 65536; CB = 1024; }
            else { act = 0; browbase = 4096 + 256 * (pm - 4); base = WS_VT / 2 + ((size_t)((tk0 >> 12) * 16 + 4 * (pm - 4)) * 512 + ((tk0 & 4095) >> 3)) * 512; RA = 512 * 512; RB = 8; CA = 4096; CB = 64; } }
        else if (kind == 2) { act = 0; bcol = 3072 + 256 * pn; browbase = 0; base = WS_KC / 2 + (size_t)(pm * 16 + 4 * pn) * 256 * 64; RA = 4096; RB = 64; CA = 16384; CB = 1; }
        else { act = 0; bcol = 0; browbase = 4096 + 256 * pm; base = WS_VCT / 2 + (size_t)(pn * 16 + 4 * pm) * 32 * 512; RA = 32 * 512; RB = 8; CA = 4096; CB = 64; }
        const bool vperm = (kind == 1 && pm >= 4) || kind == 3;
        bf16_t* dbase = (bf16_t*)ws + base;
        f32x4 bv[2][2];
#pragma unroll
        for (int bj = 0; bj < 2; ++bj)
#pragma unroll
            for (int n = 0; n < 2; ++n) bv[bj][n] = brow ? (f32x4){0.f, 0.f, 0.f, 0.f} : *(const f32x4*)(b_in + bcol + lc + bj * HALF + 4 * n);
        const int colterm0 = (wc >> 1) * CA + ((wc & 1) * 32 + 8 * fq) * CB;
        float rbv[2][4];
#pragma unroll
        for (int ai = 0; ai < 2; ++ai)
#pragma unroll
            for (int m = 0; m < 4; ++m) rbv[ai][m] = brow ? b_in[browbase + ai * HALF + wr * 64 + m * 16 + fr] : 0.f;
#pragma unroll
        for (int ai = 0; ai < 2; ++ai)
#pragma unroll
            for (int m = 0; m < 4; ++m) { const int row = ai * HALF + wr * 64 + m * 16 + fr;
                const float rb = rbv[ai][m];
                const int rowterm = (2 * ai + wr) * RA + (vperm ? (16 * ((fr >> 2) & 3) + 4 * m + (fr & 3)) : (16 * m + fr)) * RB;
#pragma unroll
                for (int bj = 0; bj < 2; ++bj) {
                    f32x4 v0 = acc[ai][bj][m][0] * P1_DS + bv[bj][0] + rb, v1 = acc[ai][bj][m][1] * P1_DS + bv[bj][1] + rb;
                    if (act == 1) { v0 = gelu4(v0); v1 = gelu4(v1); } else if (act == 2) { v0 = sigmoid4(v0); v1 = sigmoid4(v1); }
                    *(u32x4*)(dbase + rowterm + colterm0 + 2 * bj * CA) = pack8v(v0, v1); } }
    }
};
struct SchedK {
    int G, c; const unsigned char* ws;
    __device__ __forceinline__ bool next(int i, Unit& u) const { const int L = i * G + c; if (L >= 512) return false; u.kind = 0; u.row0 = 0; u.nrows = 256; u.e = 0; tilemap(L, 128, 4, u.pm, u.pn); return true; }
    __device__ __forceinline__ void aoffs(const Unit& u, const int (&R)[2], const int (&C)[2], unsigned (&o)[2][2]) const {
#pragma unroll
        for (int h = 0; h < 2; ++h)
#pragma unroll
            for (int i = 0; i < 2; ++i) o[h][i] = (unsigned)(WS_U + (size_t)(256 * u.pm + 128 * h + R[i]) * 1024 + C[i] * 2); }
    __device__ __forceinline__ const char* bptr(const Unit& u) const { return (const char*)ws + WS_WIN + (size_t)(3072 + 256 * u.pn) * 1024; }
};
struct EpiRope {
    static constexpr int PERM = 0;
    unsigned char* ws; const float* b_in;
    __device__ __forceinline__ bool carry(const Unit&) const { return false; }
    __device__ __forceinline__ void run(f32x4 (&acc)[2][2][4][2], const Unit& u, int wr, int wc, int fr, int fq) const {
        bf16_t* K = (bf16_t*)(ws + WS_K); const float* tab = (const float*)(ws + WS_ROPE);
        const int lc = wc * 32 + 4 * fq, axis = wc & 1;
        f32x4 b0[2], b1[2];
#pragma unroll
        for (int bj = 0; bj < 2; ++bj) { b0[bj] = *(const f32x4*)(b_in + 3072 + 256 * u.pn + bj * HALF + lc); b1[bj] = *(const f32x4*)(b_in + 3072 + 256 * u.pn + bj * HALF + lc + 16); }
        f32x4 tb0[2][4], tb1[2][4];
#pragma unroll
        for (int ai = 0; ai < 2; ++ai)
#pragma unroll
            for (int m = 0; m < 4; ++m) { const int tok = 256 * u.pm + ai * HALF + wr * 64 + m * 16 + fr; const int pos = axis ? (tok & 63) : ((tok >> 6) & 63);
                tb0[ai][m] = *(const f32x4*)(tab + (pos * 16 + 4 * fq) * 2); tb1[ai][m] = *(const f32x4*)(tab + (pos * 16 + 4 * fq) * 2 + 4); }
#pragma unroll
        for (int ai = 0; ai < 2; ++ai)
#pragma unroll
            for (int m = 0; m < 4; ++m) { const int tok = 256 * u.pm + ai * HALF + wr * 64 + m * 16 + fr;
                const f32x4 t0 = tb0[ai][m], t1 = tb1[ai][m];
                const f32x4 cs = (f32x4){t0[0], t0[2], t1[0], t1[2]}, sn = (f32x4){t0[1], t0[3], t1[1], t1[3]};
                const int cc0 = 256 * u.pn + lc;
                bf16_t* rowp = K + (size_t)((tok >> 12) * 16) * 4096 * 64 + (size_t)(tok & 4095) * 32;
#pragma unroll
                for (int bj = 0; bj < 2; ++bj) { const f32x4 v0 = acc[ai][bj][m][0] * P1_DS + b0[bj], v1 = acc[ai][bj][m][1] * P1_DS + b1[bj];
                    const f32x4 o0 = v0 * cs - v1 * sn, o1 = v1 * cs + v0 * sn;
                    u32x2 w0, w1; w0.x = cvt_pk_bf16(o0[0], o0[1]); w0.y = cvt_pk_bf16(o0[2], o0[3]); w1.x = cvt_pk_bf16(o1[0], o1[1]); w1.y = cvt_pk_bf16(o1[2], o1[3]);
                    const int cc = cc0 + bj * HALF; bf16_t* dp = rowp + (size_t)(cc >> 6) * 4096 * 64 + (size_t)((cc >> 5) & 1) * 4096 * 32 + (cc & 31);
                    *(u32x2*)dp = w0; *(u32x2*)(dp + 16) = w1; } }
    }
};
struct SchedMerge {
    int G, c; const unsigned char* ws;
    __device__ __forceinline__ bool next(int i, Unit& u) const { const int L = (i >> 1) * G + c; if (L >= 512) return false; u.kind = i & 1; u.row0 = 0; u.nrows = 256; u.e = 0; tilemap(L, 128, 4, u.pm, u.pn); return true; }
    __device__ __forceinline__ void aoffs(const Unit& u, const int (&R)[2], const int (&C)[2], unsigned (&o)[2][2]) const {
        const size_t base = u.kind ? WS_YB : WS_U;
#pragma unroll
        for (int h = 0; h < 2; ++h)
#pragma unroll
            for (int i = 0; i < 2; ++i) o[h][i] = (unsigned)(base + (size_t)(256 * u.pm + 128 * h + R[i]) * 1024 + C[i] * 2); }
    __device__ __forceinline__ const char* bptr(const Unit& u) const { return (const char*)ws + (u.kind ? WS_WPB : WS_WPA) + (size_t)u.pn * 256 * 1024; }
};
constexpr float MERGE_DS = 1.0f / (YB_F8_SCALE * WP_F8_SCALE);
struct EpiMerge {
    static constexpr int PERM = 2;
    unsigned char* ws;
    __device__ __forceinline__ bool carry(const Unit& u) const { return u.kind == 0; }
    __device__ __forceinline__ void run(f32x4 (&acc)[2][2][4][2], const Unit& u, int wr, int wc, int fr, int fq) const {
        const bf16_t* Gt = (const bf16_t*)(ws + WS_G); unsigned char* INNER = ws + WS_INNER;
        const int lc = 256 * u.pn + wc * 64 + 16 * fq;
#pragma unroll
        for (int ai = 0; ai < 2; ++ai) {
            u32x4 gbw[4][2], gaw[4][2];
#pragma unroll
            for (int m = 0; m < 4; ++m) { const size_t tok = (size_t)(256 * u.pm + ai * HALF + wr * 64 + m * 16 + fr);
#pragma unroll
                for (int bj = 0; bj < 2; ++bj) { gbw[m][bj] = *(const u32x4*)(Gt + tok * 2048 + 1024 + lc + 8 * bj);
                    if (u.kind == 0) gaw[m][bj] = *(const u32x4*)(Gt + tok * 2048 + lc + 8 * bj); } }
#pragma unroll
            for (int m = 0; m < 4; ++m) { const size_t tok = (size_t)(256 * u.pm + ai * HALF + wr * 64 + m * 16 + fr);
                u32x2 pk[2];
#pragma unroll
                for (int bj = 0; bj < 2; ++bj) { const u32x4 gw = gbw[m][bj];
                    const f32x4 gb0 = (f32x4){bflo(gw.x), bfhi(gw.x), bflo(gw.y), bfhi(gw.y)}, gb1 = (f32x4){bflo(gw.z), bfhi(gw.z), bflo(gw.w), bfhi(gw.w)};
                    if (u.kind == 0) { const u32x4 ga = gaw[m][bj];
                        const f32x4 ga0 = (f32x4){bflo(ga.x), bfhi(ga.x), bflo(ga.y), bfhi(ga.y)}, ga1 = (f32x4){bflo(ga.z), bfhi(ga.z), bflo(ga.w), bfhi(ga.w)};
#pragma unroll
                        for (int i = 0; i < 4; ++i) { acc[ai][bj][m][0][i] *= (YB_F8_SCALE / YA_F8_SCALE) * ga0[i] * __builtin_amdgcn_rcpf(fmaxf(gb0[i], 1e-30f)); acc[ai][bj][m][1][i] *= (YB_F8_SCALE / YA_F8_SCALE) * ga1[i] * __builtin_amdgcn_rcpf(fmaxf(gb1[i], 1e-30f)); }
                    } else { f32x4 y0 = acc[ai][bj][m][0] * (gb0 * (MERGE_DS * INNER_F8_SCALE)), y1 = acc[ai][bj][m][1] * (gb1 * (MERGE_DS * INNER_F8_SCALE));
#pragma unroll
                        for (int i = 0; i < 4; ++i) { y0[i] = __builtin_amdgcn_fmed3f(y0[i], -448.f, 448.f); y1[i] = __builtin_amdgcn_fmed3f(y1[i], -448.f, 448.f); }
                        pk[bj] = pack8_f8(y0, y1); } }
                if (u.kind != 0) { u32x4 w; w.x = pk[0].x; w.y = pk[0].y; w.z = pk[1].x; w.w = pk[1].y; *(u32x4*)(INNER + tok * 1024 + lc) = w; } }
        }
    }
};
struct SchedMix {
    int G, c; const unsigned char* ws;
    __device__ __forceinline__ bool next(int i, Unit& u) const { const int L = i * G + c; if (L >= 512) return false; u.kind = 0; u.row0 = 0; u.nrows = 256; u.e = 0; tilemap(L, 128, 4, u.pm, u.pn); return true; }
    __device__ __forceinline__ void aoffs(const Unit& u, const int (&R)[2], const int (&C)[2], unsigned (&o)[2][2]) const {
#pragma unroll
        for (int h = 0; h < 2; ++h)
#pragma unroll
            for (int i = 0; i < 2; ++i) o[h][i] = (unsigned)(WS_INNER + (size_t)(256 * u.pm + 128 * h + R[i]) * 1024 + C[i] * 2); }
    __device__ __forceinline__ const char* bptr(const Unit& u) const { return (const char*)ws + WS_WOUT + (size_t)u.pn * 256 * 1024; }
};
struct EpiMix {
    static constexpr int PERM = 1;
    unsigned char* ws; const float *x, *lng, *lnb, *b_out; float* out;
    __device__ __forceinline__ bool carry(const Unit&) const { return false; }
    __device__ __forceinline__ void run(f32x4 (&acc)[2][2][4][2], const Unit& u, int wr, int wc, int fr, int fq) const {
        const float* mod = (const float*)(ws + WS_MOD) + ((256 * u.pm) >> 12) * 6144 + 2048;
        const char* xc = (const char*)x; const char* rsc = (const char*)(ws + WS_ROWSTAT); char* x1c = (char*)(ws + WS_X1PRE);
        const unsigned row0 = (unsigned)(256 * u.pm + wr * 64 + fr);
        constexpr float DS = 1.0f / (INNER_F8_SCALE * WOUT_F8_SCALE);
#pragma unroll
        for (int bj = 0; bj < 2; ++bj) { const unsigned col = (unsigned)(256 * u.pn + bj * HALF + wc * 32 + 8 * fq);
            f32x4 lg[2], lb[2], bo[2], g1[2];
#pragma unroll
            for (int n = 0; n < 2; ++n) { lg[n] = *(const f32x4*)(lng + col + 4 * n); lb[n] = *(const f32x4*)(lnb + col + 4 * n); bo[n] = *(const f32x4*)(b_out + col + 4 * n); g1[n] = *(const f32x4*)(mod + col + 4 * n); }
#pragma unroll
            for (int ai = 0; ai < 2; ++ai) {
                f32x4 xb[4][2]; f32x2 st[4];
#pragma unroll
                for (int m = 0; m < 4; ++m) { const unsigned row = row0 + (unsigned)(ai * HALF + m * 16);
                    xb[m][0] = *(const f32x4*)(xc + (size_t)((row * 1024u + col) * 4u)); xb[m][1] = *(const f32x4*)(xc + (size_t)((row * 1024u + col) * 4u + 16u)); st[m] = *(const f32x2*)(rsc + (size_t)(row * 8u)); }
#pragma unroll
                for (int m = 0; m < 4; ++m) { const unsigned row = row0 + (unsigned)(ai * HALF + m * 16);
                    f32x4 r[2];
#pragma unroll
                    for (int n = 0; n < 2; ++n) { const f32x4 x0 = (xb[m][n] - st[m].x) * st[m].y * lg[n] + lb[n]; r[n] = x0 * ALPHA + g1[n] * (acc[ai][bj][m][n] * DS + bo[n]); }
                    *(u32x4*)(x1c + (size_t)((row * 1024u + col) * 2u)) = pack8v(r[0], r[1]); }
                asm volatile("" ::: "memory"); } }
    }
};
__device__ __forceinline__ int ld_u(const int* p) { return __builtin_amdgcn_readfirstlane(__hip_atomic_load(p, __ATOMIC_RELAXED, __HIP_MEMORY_SCOPE_AGENT)); }
template <int NPN  > struct SchedMoe {
    int G, c; const unsigned char* ws; const int* tabs;
    __device__ __forceinline__ bool next(int i, Unit& u) const {
        const int* cn = tabs; const int* eb = tabs + 32; const int* tb = tabs + 65;
        const int ntiles = tb[32], tpx = (ntiles + 7) >> 3, x = c & 7, s = c >> 3;
        const int tiles_x = min(tpx, ntiles - x * tpx), ll = i * (G >> 3) + s;
        if (ll >= NPN * tiles_x) return false;
        const int T = x * tpx + ll / NPN; u.pn = ll % NPN; u.kind = 0;
        int e = 0;
#pragma unroll 1
        for (int k = 16; k >= 1; k >>= 1) if (tb[e + k] <= T) e += k;
        const int jt = T - tb[e];
        u.e = __builtin_amdgcn_readfirstlane(e); u.pm = __builtin_amdgcn_readfirstlane(jt);
        u.row0 = __builtin_amdgcn_readfirstlane(eb[e] + 256 * jt); u.nrows = __builtin_amdgcn_readfirstlane(min(256, cn[e] - 256 * jt)); return true; }
    __device__ __forceinline__ void aoffs(const Unit& u, const int (&R)[2], const int (&C)[2], unsigned (&o)[2][2]) const {
        const int* PERM2 = (const int*)(ws + WS_PERM2) + (size_t)u.e * NTOK + 256 * u.pm;
#pragma unroll
        for (int h = 0; h < 2; ++h)
#pragma unroll
            for (int i = 0; i < 2; ++i) { const int lr = min(128 * h + R[i], u.nrows - 1);
                if (NPN == 8) { const int tok = PERM2[lr]; o[h][i] = (unsigned)(WS_U + (size_t)tok * 1024 + C[i] * 2); }
                else o[h][i] = (unsigned)(WS_ACT + (size_t)(u.row0 + lr) * 1024 + C[i] * 2); } }
    __device__ __forceinline__ const char* bptr(const Unit& u) const {
        if (NPN == 8) return (const char*)ws + WS_W1 + ((size_t)u.e * 2048 + 256 * u.pn) * 1024;
        return (const char*)ws + WS_W2 + ((size_t)u.e * 1024 + 256 * u.pn) * 1024; }
};
struct EpiMoe1 {
    static constexpr int PERM = 1;
    unsigned char* ws; const float* b1;
    __device__ __forceinline__ bool carry(const Unit&) const { return false; }
    __device__ __forceinline__ void run(f32x4 (&acc)[2][2][4][2], const Unit& u, int wr, int wc, int fr, int fq) const {
        unsigned char* ACT = ws + WS_ACT;
        const int col = 128 * u.pn + wc * 32 + 8 * fq;
        f32x4 bg[2], bl[2];
#pragma unroll
        for (int n = 0; n < 2; ++n) { bg[n] = *(const f32x4*)(b1 + u.e * 2048 + col + 4 * n); bl[n] = *(const f32x4*)(b1 + u.e * 2048 + 1024 + col + 4 * n); }
        u32x2 outw[2][4];
#pragma unroll
        for (int ai = 0; ai < 2; ++ai)
#pragma unroll
            for (int m = 0; m < 4; ++m) {
                f32x4 a[2];
#pragma unroll
                for (int n = 0; n < 2; ++n) { const f32x4 zgv = acc[ai][0][m][n] * (1.0f / W_F8_SCALE) + bg[n], zlv = acc[ai][1][m][n] * (1.0f / W_F8_SCALE) + bl[n];
                    f32x4 zg, zl;
#pragma unroll
                    for (int i = 0; i < 4; ++i) { zg[i] = __builtin_amdgcn_fmed3f(zgv[i], -INFINITY, 7.0f); zl[i] = __builtin_amdgcn_fmed3f(zlv[i], -7.0f, 7.0f); }
                    const f32x4 ea = zg * (-1.702f * 1.4426950408889634f); f32x4 d;
#pragma unroll
                    for (int i = 0; i < 4; ++i) d[i] = __builtin_amdgcn_exp2f(ea[i]);
                    d = d + 1.0f; f32x4 r;
#pragma unroll
                    for (int i = 0; i < 4; ++i) r[i] = __builtin_amdgcn_rcpf(d[i]);
                    a[n] = (zg * r) * (zl * ACT_F8_SCALE + ACT_F8_SCALE); }
                outw[ai][m] = pack8_f8(a[0], a[1]); }
#pragma unroll
        for (int ai = 0; ai < 2; ++ai)
#pragma unroll
            for (int m = 0; m < 4; ++m) { const int lr = ai * HALF + wr * 64 + m * 16 + fr;
                const size_t srow = lr < u.nrows ? (size_t)(u.row0 + lr) : (size_t)(NASSIGN + lr);
                *(u32x2*)(ACT + srow * 1024 + col) = outw[ai][m]; }
    }
};
struct EpiMoe2 {
    static constexpr int PERM = 2;
    unsigned char* ws; const float* b2;
    __device__ __forceinline__ bool carry(const Unit&) const { return false; }
    __device__ __forceinline__ void run(f32x4 (&acc)[2][2][4][2], const Unit& u, int wr, int wc, int fr, int fq) const {
        unsigned char* YS = ws + WS_YS; constexpr float DS = 1.0f / (W_F8_SCALE * ACT_F8_SCALE);
        const int lc = 256 * u.pn + wc * 64 + 16 * fq;
        f32x4 bv[2][2];
#pragma unroll
        for (int bj = 0; bj < 2; ++bj)
#pragma unroll
            for (int n = 0; n < 2; ++n) bv[bj][n] = *(const f32x4*)(b2 + u.e * 1024 + lc + 8 * bj + 4 * n);
        u32x4 outw[2][4];
#pragma unroll
        for (int ai = 0; ai < 2; ++ai)
#pragma unroll
            for (int m = 0; m < 4; ++m) {
                { const u32x2 lo = pack8_f8((acc[ai][0][m][0] * DS + bv[0][0]) * YS_F8_SCALE, (acc[ai][0][m][1] * DS + bv[0][1]) * YS_F8_SCALE), hi = pack8_f8((acc[ai][1][m][0] * DS + bv[1][0]) * YS_F8_SCALE, (acc[ai][1][m][1] * DS + bv[1][1]) * YS_F8_SCALE);
                    u32x4 w; w.x = lo.x; w.y = lo.y; w.z = hi.x; w.w = hi.y; outw[ai][m] = w; } }
#pragma unroll
        for (int ai = 0; ai < 2; ++ai)
#pragma unroll
            for (int m = 0; m < 4; ++m) { const int lr = ai * HALF + wr * 64 + m * 16 + fr;
                const size_t srow = lr < u.nrows ? (size_t)(u.row0 + lr) : (size_t)(NASSIGN + lr);
                *(u32x4*)(YS + srow * 1024 + lc) = outw[ai][m]; }
    }
};
}
__device__ __forceinline__ void phase_merge_fast(const P& p, int bid, int nblk, unsigned char* lds) {
    pg::SchedMerge S{nblk, bid, p.ws}; pg::EpiMerge E{p.ws};
    pg::gemm_phase<pg::EpiMerge, pg::SchedMerge, true, true>((PG_LAS unsigned char*)lds, p.ws, S, E);
}
__device__ __forceinline__ void phase_mix_fast(const P& p, int bid, int nblk, unsigned char* lds) {
    pg::SchedMix S{nblk, bid, p.ws}; pg::EpiMix E{p.ws, p.x, p.ln_x_g, p.ln_x_b, p.b_out, p.out};
    pg::gemm_phase<pg::EpiMix, pg::SchedMix, true, true>((PG_LAS unsigned char*)lds, p.ws, S, E);
}
__device__ __forceinline__ void phase_moe1_fast(const P& p, int bid, int nblk, unsigned char* lds) {
    moe_tables(p, lds); pg::SchedMoe<8> S{nblk, bid, p.ws, (const int*)(lds + MT_LDS)}; pg::EpiMoe1 E{p.ws, p.exp_b1};
    pg::gemm_phase<pg::EpiMoe1, pg::SchedMoe<8>, true, true>((PG_LAS unsigned char*)lds, p.ws, S, E);
}
__device__ __forceinline__ void phase_moe2_fast(const P& p, int bid, int nblk, unsigned char* lds) {
    moe_tables(p, lds); pg::SchedMoe<4> S{nblk, bid, p.ws, (const int*)(lds + MT_LDS)}; pg::EpiMoe2 E{p.ws, p.exp_b2};
    pg::gemm_phase<pg::EpiMoe2, pg::SchedMoe<4>, true, true>((PG_LAS unsigned char*)lds, p.ws, S, E);
}
__device__ __forceinline__ void phase_proj_fast(const P& p, int bid, int nblk, unsigned char* lds) {
    { pg::SchedP1 S{nblk, bid, p.ws}; pg::EpiP1 E{p.ws, p.b_in};
      pg::gemm_phase<pg::EpiP1, pg::SchedP1, true, true>((PG_LAS unsigned char*)lds, p.ws, S, E); }
    { pg::SchedK S{nblk, bid, p.ws}; pg::EpiRope E{p.ws, p.b_in};
      pg::gemm_phase<pg::EpiRope, pg::SchedK, true, true>((PG_LAS unsigned char*)lds, p.ws, S, E); }
}

#define LAS __attribute__((address_space(3)))
#define XB_TMO      128
#define XB_XCNT(j)  (256  + 64 * (j))
#define XB_XSUB(j)  (1280 + 64 * (j))
#define XB_XGEN(j)  (2304 + 64 * (j))
#define XB_TOP      3328
#define XB_TOPGEN   3392
#define XCD_BAR_WORDS 3456
#define XB_SPIN_CAP (1u << 22)
__device__ __forceinline__ unsigned xb_ld(unsigned* p)              { return __hip_atomic_load(p, __ATOMIC_RELAXED, __HIP_MEMORY_SCOPE_AGENT); }
__device__ __forceinline__ unsigned xb_add(unsigned* p, unsigned v) { return __hip_atomic_fetch_add(p, v, __ATOMIC_RELAXED, __HIP_MEMORY_SCOPE_AGENT); }
__device__ __forceinline__ unsigned xb_xcc_id() { return (unsigned)__builtin_amdgcn_s_getreg((3 << 11) | 20) & 0xFu; }
#define XB_SPIN(cond, bar) do { unsigned _sp = 0; while (cond) { __builtin_amdgcn_s_sleep(1); \
    if ((++_sp & 255u) == 0u) { if (xb_ld(&(bar)[XB_TMO])) break; if (_sp > XB_SPIN_CAP) { atomicAdd(&(bar)[XB_TMO], 1u); break; } } } } while (0)
struct XcdBarrier { unsigned* bar; unsigned x; volatile LAS unsigned* st; };
__device__ __forceinline__ XcdBarrier xcd_barrier_post(unsigned* bar, volatile LAS unsigned* st) {
    XcdBarrier b; b.bar = bar; b.x = xb_xcc_id(); b.st = st;
    if (threadIdx.x == 0) (void)xb_add(&bar[XB_XCNT(b.x)], 1u);
    return b;
}
__device__ __forceinline__ void xcd_barrier_complete(unsigned* bar, unsigned x, unsigned& nloc, unsigned& nx) {
    const unsigned G = gridDim.x * gridDim.y * gridDim.z;
    unsigned sum, cnt, mine, sp = 0u;
    for (;;) {
        sum = 0u; cnt = 0u; mine = 0u;
#pragma unroll
        for (unsigned j = 0; j < 16; ++j) { const unsigned c = xb_ld(&bar[XB_XCNT(j)]); sum += c; cnt += (c > 0u) ? 1u : 0u; mine = (j == x) ? c : mine; }
        if (sum == G) break;
        __builtin_amdgcn_s_sleep(1);
        if ((++sp & 255u) == 0u) { if (xb_ld(&bar[XB_TMO])) break; if (sp > XB_SPIN_CAP) { atomicAdd(&bar[XB_TMO], 1u); break; } }
    }
    nloc = mine > 0u ? mine : 1u; nx = cnt > 0u ? cnt : 1u;
}
__device__ __forceinline__ void xcd_barrier(const XcdBarrier& b) {
    asm volatile("s_waitcnt vmcnt(0)" ::: "memory");
    __syncthreads();
    if (threadIdx.x == 0) {
        unsigned* bar = b.bar;
        __builtin_amdgcn_s_waitcnt(0);
        unsigned nloc = b.st[0], nx = b.st[1];
        if (nloc == 0u) { xcd_barrier_complete(bar, b.x, nloc, nx); b.st[0] = nloc; b.st[1] = nx; }
        const unsigned old = xb_add(&bar[XB_XSUB(b.x)], 1u);
        const unsigned gen = old / nloc;
        if (old + 1u == (gen + 1u) * nloc) {
            __builtin_amdgcn_fence(__ATOMIC_RELEASE, "agent");
            asm volatile("s_waitcnt vmcnt(0)" ::: "memory");
            const unsigned og = xb_add(&bar[XB_TOP], 1u);
            const unsigned tg = og / nx;
            if (og + 1u == (tg + 1u) * nx) xb_add(&bar[XB_TOPGEN], 1u);
            else XB_SPIN(xb_ld(&bar[XB_TOPGEN]) == tg, bar);
            __builtin_amdgcn_fence(__ATOMIC_ACQUIRE, "agent");
            xb_add(&bar[XB_XGEN(b.x)], 1u);
            asm volatile("s_waitcnt vmcnt(0)" ::: "memory");
        } else {
            __builtin_amdgcn_fence(__ATOMIC_ACQUIRE, "agent");
            XB_SPIN(xb_ld(&bar[XB_XGEN(b.x)]) == gen, bar);
            asm volatile("s_waitcnt vmcnt(0)" ::: "memory");
        }
    }
    __syncthreads();
}
#include <hip/hip_cooperative_groups.h>
namespace cg = cooperative_groups;
constexpr int LDS_BYTES = 147456;
constexpr int XB_LDS = LDS_BYTES - 64;
constexpr int CW_BAR = 4096;
constexpr int REP_PA = 1, REP_PB = 1, REP_P1 = 1, REP_GMLP = 1, REP_ATTN = 1, REP_MERGE = 1, REP_MIX = 1, REP_MOE1 = 1, REP_MOE2 = 1, REP_BAR = 0;
__global__ void __launch_bounds__(512, 2) mega(P p) {
    extern __shared__ __attribute__((aligned(16))) unsigned char lds[];
    const int bid = blockIdx.x, nblk = gridDim.x;
    if (threadIdx.x < 16) ((volatile LAS unsigned*)((LAS unsigned char*)lds + XB_LDS))[threadIdx.x] = 0u;
    __syncthreads();
    const XcdBarrier bar = xcd_barrier_post((unsigned*)(p.ws + WS_CTL) + CW_BAR, (volatile LAS unsigned*)((LAS unsigned char*)lds + XB_LDS));
#define GRID_BAR() xcd_barrier(bar)
#define REP(n) _Pragma("unroll 1") for (int rep_ = 0; rep_ < (n); ++rep_)
    REP(REP_PA) { __syncthreads(); phase_prologue_a(p, bid, nblk, lds); } GRID_BAR();
    REP(REP_PB) phase_prologue_b(p, bid, nblk); GRID_BAR();
    REP(REP_P1) phase_proj_fast(p, bid, nblk, lds); GRID_BAR();
    REP(REP_GMLP) phase_gmlp_fast(p, bid, nblk, lds); REP(REP_ATTN) phase_attn_s(p, bid, nblk, lds); GRID_BAR();
    REP(REP_MERGE) phase_merge_fast(p, bid, nblk, lds); GRID_BAR();
    REP(REP_MIX) phase_mix_fast(p, bid, nblk, lds); GRID_BAR();
    phase_router(p, bid, nblk, lds); GRID_BAR();
    REP(REP_BAR) GRID_BAR();
    REP(REP_MOE1) phase_moe1_fast(p, bid, nblk, lds); GRID_BAR();
    REP(REP_MOE2) phase_moe2_fast(p, bid, nblk, lds); GRID_BAR();
#undef REP
    phase_final(p, bid, nblk, lds);
}

extern "C" void kernel_launch(void* const* d_in, const int* in_sizes, int n_in, void* d_out, int out_size, void* d_ws, size_t ws_size, hipStream_t stream) {
    static int grid = 0;
    if (grid == 0) {
        if (n_in != 31 || out_size != NTOK * DM || ws_size < WS_END) { fprintf(stderr, "kernel_launch: unexpected sizes n_in %d out %d ws %zu\n", n_in, out_size, ws_size); grid = -1; return; }
        int dev = 0, cus = 0, per_cu = 0;
        if (hipGetDevice(&dev) != hipSuccess || hipDeviceGetAttribute(&cus, hipDeviceAttributeMultiprocessorCount, dev) != hipSuccess) { grid = -1; return; }
        if (hipFuncSetAttribute((const void*)mega, hipFuncAttributeMaxDynamicSharedMemorySize, LDS_BYTES) != hipSuccess) { fprintf(stderr, "kernel_launch: hipFuncSetAttribute failed\n"); grid = -1; return; }
        if (hipOccupancyMaxActiveBlocksPerMultiprocessor(&per_cu, (const void*)mega, 512, LDS_BYTES) != hipSuccess || per_cu < 1) { fprintf(stderr, "kernel_launch: occupancy query failed (%d)\n", per_cu); grid = -1; return; }
        grid = cus * 1;
    }
    if (grid < 0) return;
    P p{};
    const float** pp = (const float**)&p;
    for (int i = 0; i < 31; ++i) pp[i] = (const float*)d_in[i];
    p.out = (float*)d_out; p.ws = (unsigned char*)d_ws; p.ph_lo = 0; p.ph_hi = 0;
    if (hipMemsetAsync((char*)d_ws + WS_CTL, 0, 1 * MiB, stream) != hipSuccess) { fprintf(stderr, "kernel_launch: memset failed\n"); return; }
    hipLaunchKernelGGL(mega, dim3(grid), dim3(512), LDS_BYTES, stream, p);
    const hipError_t e = hipPeekAtLastError();
    if (e != hipSuccess) fprintf(stderr, "launch failed: %s (grid %d)\n", hipGetErrorString(e), grid);
}
```
